# Optimizing an MI355X kernel written in HIP

```python
import math
import jax, jax.numpy as jnp
from jax import lax
import numpy as np

D_MODEL = 1024
BATCH = 8
SEQ = 4096
DEPTH = 1

MIX_WIDTH = D_MODEL
A_HEADS = 8
A_HEAD_DIM = 64
A_WIDTH = A_HEADS * A_HEAD_DIM
A_PATTERNS = ((128, 1), (512, 4), (2048, 16))
A_BLOCK = 64
REL_BUCKETS = 32
REL_MAX_DIST = 1024
B_HEADS = 8
B_NOPE = 64
B_ROPE = 32
B_VDIM = 64
B_WIDTH = B_HEADS * B_VDIM
Q_LORA = 384
KV_LORA = 256
ROPE_THETA = 10000.0
MLA_QBLOCK = 128
IN_COLS = 3 * A_WIDTH + Q_LORA + KV_LORA + B_ROPE
N_EXPERTS = 256
TOP_K = 8
N_GROUPS = 8
TOPK_GROUPS = 4
EXPERT_FF = 256
SHARED_FF = 256
ROUTED_SCALE = 2.5
MOE_BLOCK = 128
EPS = 1e-6
NEG_INF = -1e30

kernel_name = "hybrid_dilated_mla_moe_adaln_encoder"


def rmsnorm(x, g):
    xf = x.astype(jnp.float32)
    y = xf * lax.rsqrt(jnp.mean(xf * xf, axis=-1, keepdims=True) + EPS)
    return (y * g.astype(jnp.float32)).astype(x.dtype)


def t5_bucket(rel):
    half = REL_BUCKETS // 2
    max_exact = half // 2
    ret = jnp.where(rel > 0, half, 0)
    n = jnp.abs(rel)
    nf = jnp.maximum(n, 1).astype(jnp.float32)
    large = max_exact + (jnp.log(nf / max_exact) / math.log(REL_MAX_DIST / max_exact)
                         * (half - max_exact)).astype(jnp.int32)
    large = jnp.minimum(large, half - 1)
    return ret + jnp.where(n < max_exact, n, large)


def dilated_branch(q, k, v, rel_table, window, dilation):
    b, s, h, dh = q.shape
    radius = window // (2 * dilation)
    L = s // dilation
    nb = -(-L // A_BLOCK)
    Lp = nb * A_BLOCK

    def to_sub(t):
        t = t.reshape(b, L, dilation, h, dh).transpose(0, 2, 1, 3, 4).reshape(b * dilation, L, h, dh)
        return jnp.pad(t, ((0, 0), (0, Lp - L), (0, 0), (0, 0)))

    qs, ks, vs = to_sub(q), to_sub(k), to_sub(v)
    pad = ((0, 0), (A_BLOCK, A_BLOCK), (0, 0), (0, 0))
    kp, vp = jnp.pad(ks, pad), jnp.pad(vs, pad)

    def band(t):
        parts = [t[:, i * A_BLOCK: i * A_BLOCK + Lp].reshape(-1, nb, A_BLOCK, h, dh) for i in range(3)]
        return jnp.concatenate(parts, axis=2)

    kb, vb = band(kp), band(vp)
    qb = qs.reshape(-1, nb, A_BLOCK, h, dh)

    qi = jnp.arange(A_BLOCK, dtype=jnp.int32)[:, None]
    ki = jnp.arange(3 * A_BLOCK, dtype=jnp.int32)[None, :]
    off = ki - A_BLOCK - qi
    bias = rel_table[t5_bucket(off * dilation)].transpose(2, 0, 1).astype(jnp.float32)
    key_pos = jnp.arange(nb, dtype=jnp.int32)[:, None] * A_BLOCK + ki - A_BLOCK
    valid = (jnp.abs(off) <= radius)[None] & ((key_pos >= 0) & (key_pos < L))[:, None, :]

    scores = jnp.einsum('znqhd,znkhd->znhqk', qb, kb, preferred_element_type=jnp.float32) / math.sqrt(dh)
    scores = jnp.where(valid[None, :, None], scores + bias[None, None], NEG_INF)
    lse = jax.nn.logsumexp(scores, axis=-1)
    p = jnp.exp(scores - lse[..., None])
    o = jnp.einsum('znhqk,znkhd->znqhd', p.astype(v.dtype), vb)

    o = o.reshape(b, dilation, Lp, h, dh)[:, :, :L].transpose(0, 2, 1, 3, 4).reshape(b, s, h, dh)
    lse = lse.transpose(0, 1, 3, 2).reshape(b, dilation, Lp, h)[:, :, :L].transpose(0, 2, 1, 3).reshape(b, s, h)
    return o, lse


def dilated_attention(q, k, v, rel_table):
    outs, lses = [], []
    for window, dilation in A_PATTERNS:
        o, l = dilated_branch(q, k, v, rel_table, window, dilation)
        outs.append(o)
        lses.append(l)
    w = jax.nn.softmax(jnp.stack(lses, axis=0), axis=0)
    out = jnp.sum(w[..., None] * jnp.stack(outs, axis=0).astype(jnp.float32), axis=0)
    return out.astype(q.dtype)


def rope(t):
    s, r = t.shape[1], t.shape[-1]
    inv = ROPE_THETA ** (-jnp.arange(0, r, 2, dtype=jnp.float32) / r)
    ang = jnp.arange(s, dtype=jnp.float32)[:, None] * inv[None, :]
    cos, sin = jnp.cos(ang)[None, :, None, :], jnp.sin(ang)[None, :, None, :]
    t1, t2 = jnp.split(t.astype(jnp.float32), 2, axis=-1)
    return jnp.concatenate([t1 * cos - t2 * sin, t2 * cos + t1 * sin], axis=-1).astype(t.dtype)


def mla_attention(q, k, v):
    b, s, h, dq = q.shape
    nq = s // MLA_QBLOCK
    qb = q.reshape(b, nq, MLA_QBLOCK, h, dq).transpose(1, 0, 2, 3, 4)
    scale = 1.0 / math.sqrt(dq)

    def block(qblk):
        sc = jnp.einsum('bqhd,bkhd->bhqk', qblk, k, preferred_element_type=jnp.float32) * scale
        p = jax.nn.softmax(sc, axis=-1)
        return jnp.einsum('bhqk,bkhd->bqhd', p.astype(v.dtype), v)

    o = lax.map(block, qb)
    return o.transpose(1, 0, 2, 3, 4).reshape(b, s, h, v.shape[-1])


def routed_experts(xf, w_router, e_bias, w1, w3, w2):
    n, d = xf.shape
    scores = jax.nn.sigmoid(jnp.einsum('nd,de->ne', xf, w_router, preferred_element_type=jnp.float32))
    sel = scores + e_bias.astype(jnp.float32)
    grp = lax.top_k(sel.reshape(n, N_GROUPS, N_EXPERTS // N_GROUPS), 2)[0].sum(-1)
    _, gidx = lax.top_k(grp, TOPK_GROUPS)
    gmask = jnp.any(gidx[:, :, None] == jnp.arange(N_GROUPS, dtype=gidx.dtype)[None, None, :], axis=1)
    emask = jnp.repeat(gmask, N_EXPERTS // N_GROUPS, axis=1)
    _, eidx = lax.top_k(jnp.where(emask, sel, -jnp.inf), TOP_K)
    g = jnp.take_along_axis(scores, eidx, axis=1)
    g = g / jnp.sum(g, axis=-1, keepdims=True) * ROUTED_SCALE

    nk = n * TOP_K
    flat_e = eidx.reshape(nk).astype(jnp.int32)
    flat_t = jnp.repeat(jnp.arange(n, dtype=jnp.int32), TOP_K)
    flat_g = g.reshape(nk)
    order = jnp.argsort(flat_e)
    se, st, sg = flat_e[order], flat_t[order], flat_g[order]
    counts = jnp.zeros((N_EXPERTS,), jnp.int32).at[flat_e].add(1)
    padded = (counts + MOE_BLOCK - 1) // MOE_BLOCK * MOE_BLOCK
    start = jnp.cumsum(counts) - counts
    pends = jnp.cumsum(padded)
    pstart = pends - padded
    dest = pstart[se] + jnp.arange(nk, dtype=jnp.int32) - start[se]
    nblk = -(-(nk + N_EXPERTS * (MOE_BLOCK - 1)) // MOE_BLOCK)
    total = nblk * MOE_BLOCK
    tok_buf = jnp.zeros((total,), jnp.int32).at[dest].set(st)
    w_buf = jnp.zeros((total,), jnp.float32).at[dest].set(sg)
    blk_e = jnp.searchsorted(pends, jnp.arange(nblk, dtype=jnp.int32) * MOE_BLOCK, side='right')
    blk_e = jnp.minimum(blk_e, N_EXPERTS - 1)

    def expert_block(args):
        tok, wt, e = args
        xb = xf[tok]
        hdn = jax.nn.silu(xb @ w1[e]) * (xb @ w3[e])
        return (hdn @ w2[e]) * wt[:, None].astype(xf.dtype)

    yb = lax.map(expert_block, (tok_buf.reshape(nblk, MOE_BLOCK), w_buf.reshape(nblk, MOE_BLOCK), blk_e))
    return jax.ops.segment_sum(yb.reshape(total, d), tok_buf, num_segments=n)


def setup_inputs(seed: int = 0) -> dict:
    key = jax.random.key(seed)
    ks = jax.random.split(key, 24)
    D = D_MODEL

    def nrm(k, shape, fan_in, scale=1.0):
        return jax.random.normal(k, shape, jnp.float32) * (scale * fan_in ** -0.5)

    def gain(k, shape):
        return 1.0 + 0.05 * jax.random.normal(k, shape, jnp.float32)

    return {
        "x": jax.random.normal(ks[0], (BATCH, SEQ, D), jnp.float32),
        "c": jax.random.normal(ks[1], (BATCH, D), jnp.float32),
        "w_ada": nrm(ks[2], (DEPTH, D, 6 * D), D, 0.5),
        "b_ada": 0.02 * jax.random.normal(ks[3], (DEPTH, 6 * D), jnp.float32),
        "norm1_g": gain(ks[4], (DEPTH, D)),
        "w_in": nrm(ks[5], (DEPTH, D, IN_COLS), D),
        "q_norm_g": gain(ks[6], (DEPTH, Q_LORA)),
        "w_uq": nrm(ks[7], (DEPTH, Q_LORA, B_HEADS * (B_NOPE + B_ROPE)), Q_LORA),
        "kv_norm_g": gain(ks[8], (DEPTH, KV_LORA)),
        "w_ukv": nrm(ks[9], (DEPTH, KV_LORA, B_HEADS * (B_NOPE + B_VDIM)), KV_LORA),
        "rel_table": 0.5 * jax.random.normal(ks[10], (REL_BUCKETS, A_HEADS), jnp.float32),
        "a_out_g": gain(ks[11], (DEPTH, A_WIDTH)),
        "b_out_g": gain(ks[12], (DEPTH, B_WIDTH)),
        "w_o": nrm(ks[13], (DEPTH, MIX_WIDTH, D), MIX_WIDTH),
        "norm2_g": gain(ks[14], (DEPTH, D)),
        "w_router": nrm(ks[15], (DEPTH, D, N_EXPERTS), D),
        "e_bias": 0.01 * jax.random.normal(ks[16], (DEPTH, N_EXPERTS), jnp.float32),
        "w1": nrm(ks[17], (DEPTH, N_EXPERTS, D, EXPERT_FF), D),
        "w3": nrm(ks[18], (DEPTH, N_EXPERTS, D, EXPERT_FF), D),
        "w2": nrm(ks[19], (DEPTH, N_EXPERTS, EXPERT_FF, D), EXPERT_FF),
        "ws1": nrm(ks[20], (DEPTH, D, SHARED_FF), D),
        "ws3": nrm(ks[21], (DEPTH, D, SHARED_FF), D),
        "ws2": nrm(ks[22], (DEPTH, SHARED_FF, D), SHARED_FF),
        "final_g": gain(ks[23], (D,)),
    }


def reference(x, c, w_ada, b_ada, norm1_g, w_in, q_norm_g, w_uq, kv_norm_g, w_ukv, rel_table,
              a_out_g, b_out_g, w_o, norm2_g, w_router, e_bias, w1, w3, w2, ws1, ws3, ws2, final_g):
    b, s, d = x.shape
    for l in range(DEPTH):
        mod = jnp.einsum('bd,de->be', jax.nn.silu(c), w_ada[l]) + b_ada[l]
        sh1, sc1, g1, sh2, sc2, g2 = [m[:, None, :] for m in jnp.split(mod, 6, axis=-1)]

        h = rmsnorm(x, norm1_g[l]) * (1 + sc1) + sh1
        proj = jnp.einsum('bsd,dc->bsc', h, w_in[l])
        qkv_a, q_lat, kv_lat, k_pe = jnp.split(
            proj, [3 * A_WIDTH, 3 * A_WIDTH + Q_LORA, 3 * A_WIDTH + Q_LORA + KV_LORA], axis=-1)

        qkv_a = qkv_a.reshape(b, s, 3, A_HEADS, A_HEAD_DIM)
        a_out = dilated_attention(qkv_a[:, :, 0], qkv_a[:, :, 1], qkv_a[:, :, 2], rel_table)
        a_out = a_out.reshape(b, s, A_WIDTH)

        qm = jnp.einsum('bsr,rc->bsc', rmsnorm(q_lat, q_norm_g[l]), w_uq[l]).reshape(b, s, B_HEADS, B_NOPE + B_ROPE)
        kv = jnp.einsum('bsr,rc->bsc', rmsnorm(kv_lat, kv_norm_g[l]), w_ukv[l]).reshape(b, s, B_HEADS, B_NOPE + B_VDIM)
        q_nope, q_pe = jnp.split(qm, [B_NOPE], axis=-1)
        k_nope, v_b = jnp.split(kv, [B_NOPE], axis=-1)
        q_b = jnp.concatenate([q_nope, rope(q_pe)], axis=-1)
        k_pe = jnp.broadcast_to(rope(k_pe[:, :, None, :]), (b, s, B_HEADS, B_ROPE))
        k_b = jnp.concatenate([k_nope, k_pe], axis=-1)
        b_out = mla_attention(q_b, k_b, v_b).reshape(b, s, B_WIDTH)

        mix = jnp.concatenate([rmsnorm(a_out, a_out_g[l]), rmsnorm(b_out, b_out_g[l])], axis=-1)
        x = x + g1 * jnp.einsum('bsc,cd->bsd', mix, w_o[l])

        h2 = rmsnorm(x, norm2_g[l]) * (1 + sc2) + sh2
        xf = h2.reshape(b * s, d)
        shared = (jax.nn.silu(xf @ ws1[l]) * (xf @ ws3[l])) @ ws2[l]
        routed = routed_experts(xf, w_router[l], e_bias[l], w1[l], w3[l], w2[l])
        x = x + g2 * (shared + routed).reshape(b, s, d)
    return rmsnorm(x, final_g)
```

```cpp
#include <hip/hip_runtime.h>
#include <stdint.h>
#include <stdio.h>

#ifndef MK_N_LAUNCHES
#define MK_N_LAUNCHES 1
#endif

#define DEVI __device__ __forceinline__
typedef unsigned short bf16_t;
typedef short bf16x8 __attribute__((ext_vector_type(8)));
typedef short s16x4 __attribute__((ext_vector_type(4)));
typedef float f32x4 __attribute__((ext_vector_type(4)));
typedef float f32x16 __attribute__((ext_vector_type(16)));
typedef unsigned u32x4 __attribute__((ext_vector_type(4)));
typedef unsigned u32x2 __attribute__((ext_vector_type(2)));

constexpr int NTOK = 32768, SEQ = 4096, DM = 1024;
constexpr int INC = 2208, INCP = 2304;
constexpr int QLORA = 384, KVLORA = 256;
constexpr int NEXP = 256, EFF = 256;
constexpr int NASG = NTOK * 8;
constexpr int NROWS = NASG + NTOK;
constexpr float EPS = 1e-6f;
constexpr float LOG2E = 1.4426950408889634f;

constexpr size_t MiB = 1u << 20;
constexpr size_t OFF_CTL = 0, CTL_BYTES = 1 * MiB;
constexpr size_t OFF_MOD = 1 * MiB;
constexpr size_t OFF_ROPE = OFF_MOD + 256 * 1024;
constexpr size_t OFF_BIAS = OFF_ROPE + 512 * 1024;
constexpr size_t OFF_WIN = 2 * MiB;
constexpr size_t OFF_WUQ = OFF_WIN + 4608 * 1024;
constexpr size_t OFF_WUKV = OFF_WUQ + 1 * MiB;
constexpr size_t OFF_WO = OFF_WUKV + 512 * 1024;
constexpr size_t OFF_WR = OFF_WO + 2 * MiB;
constexpr size_t OFF_WS13 = OFF_WR + 512 * 1024;
constexpr size_t OFF_WS2 = OFF_WS13 + 1 * MiB;
constexpr size_t OFF_H = 12 * MiB;
constexpr size_t OFF_LOGITS = OFF_H + 64 * MiB;
constexpr size_t OFF_EIDX = OFF_LOGITS + 32 * MiB;
constexpr size_t OFF_GATE = OFF_EIDX + 1 * MiB;
constexpr size_t OFF_RNK = OFF_GATE + 1 * MiB;
constexpr size_t OFF_POS = OFF_RNK + 1 * MiB;
constexpr size_t OFF_TOKS = OFF_POS + 1 * MiB;
constexpr size_t OFF_WTS = OFF_TOKS + 1 * MiB;
constexpr size_t OFF_SCR = OFF_WTS + 1 * MiB;
constexpr size_t OFF_HDN = OFF_SCR + 128 * MiB;
constexpr size_t OFF_Y = OFF_HDN + 144 * MiB;
constexpr size_t WS_END = OFF_Y + 576 * MiB;
constexpr size_t OFF_PROJ = OFF_Y;
constexpr size_t OFF_QB = OFF_PROJ + 144 * MiB;
constexpr size_t OFF_KVB = OFF_QB + 48 * MiB;
constexpr size_t OFF_BOUT = OFF_KVB + 64 * MiB;
constexpr size_t OFF_APARTS = OFF_BOUT + 32 * MiB;
constexpr size_t OFF_LSE = OFF_APARTS + 96 * MiB;
constexpr size_t OFF_MIX = OFF_LSE + 4 * MiB;
static_assert(OFF_MIX + 64 * MiB <= WS_END, "alias map");
constexpr int CNT_WORD0 = 8192, CNT_STRIDE = 16;

constexpr int LDS_STAGE = 0;
constexpr int LDS_ROWOFF = 131072;
constexpr int LDS_ROWSC = LDS_ROWOFF + 1024;
constexpr int LDS_MISC = LDS_ROWSC + 1024;
constexpr int LDS_START = LDS_MISC + 256;
constexpr int LDS_CNT = LDS_START + 1280;
constexpr int LDS_BYTES = 147456;
static_assert(LDS_CNT + 1024 <= LDS_BYTES, "lds map");

#define XB_TMO      128
#define XB_XCNT(j)  (256  + 64 * (j))
#define XB_XSUB(j)  (1280 + 64 * (j))
#define XB_XGEN(j)  (2304 + 64 * (j))
#define XB_TOP      3328
#define XB_TOPGEN   3392
#define XCD_BAR_WORDS 3456
#define XB_SPIN_CAP (1u << 22)
#define LAS __attribute__((address_space(3)))

__device__ __forceinline__ unsigned xb_ld(unsigned* p)              { return __hip_atomic_load(p, __ATOMIC_RELAXED, __HIP_MEMORY_SCOPE_AGENT); }
__device__ __forceinline__ unsigned xb_add(unsigned* p, unsigned v) { return __hip_atomic_fetch_add(p, v, __ATOMIC_RELAXED, __HIP_MEMORY_SCOPE_AGENT); }
__device__ __forceinline__ unsigned xb_xcc_id() { return (unsigned)__builtin_amdgcn_s_getreg((3 << 11) | 20) & 0xFu; }
#define XB_SPIN(cond, bar) do { unsigned _sp = 0; while (cond) { __builtin_amdgcn_s_sleep(1); \
    if ((++_sp & 255u) == 0u) { if (xb_ld(&(bar)[XB_TMO])) break; if (_sp > XB_SPIN_CAP) { atomicAdd(&(bar)[XB_TMO], 1u); break; } } } } while (0)

struct XcdBarrier { unsigned* bar; unsigned x; volatile LAS unsigned* st; };

__device__ __forceinline__ XcdBarrier xcd_barrier_post(unsigned* bar, volatile LAS unsigned* st, const bool leader) {
    XcdBarrier b; b.bar = bar; b.x = xb_xcc_id(); b.st = st;
    if (leader) (void)xb_add(&bar[XB_XCNT(b.x)], 1u);
    return b;
}
__device__ __forceinline__ void xcd_barrier_complete(unsigned* bar, unsigned x, unsigned& nloc, unsigned& nx) {
    const unsigned G = gridDim.x * gridDim.y * gridDim.z;
    unsigned sum, cnt, mine, sp = 0u;
    for (;;) {
        sum = 0u; cnt = 0u; mine = 0u;
#pragma unroll
        for (unsigned j = 0; j < 16; ++j) { const unsigned c = xb_ld(&bar[XB_XCNT(j)]); sum += c; cnt += (c > 0u) ? 1u : 0u; mine = (j == x) ? c : mine; }
        if (sum == G) break;
        __builtin_amdgcn_s_sleep(1);
        if ((++sp & 255u) == 0u) { if (xb_ld(&bar[XB_TMO])) break; if (sp > XB_SPIN_CAP) { atomicAdd(&bar[XB_TMO], 1u); break; } }
    }
    nloc = mine > 0u ? mine : 1u; nx = cnt > 0u ? cnt : 1u;
}
__device__ __forceinline__ void xcd_barrier(const XcdBarrier& b, const bool leader) {
    asm volatile("s_waitcnt vmcnt(0)" ::: "memory");
    __syncthreads();
    if (leader) {
        unsigned* bar = b.bar;
        __builtin_amdgcn_s_waitcnt(0);
        unsigned nloc = b.st[0], nx = b.st[1];
        if (nloc == 0u) { xcd_barrier_complete(bar, b.x, nloc, nx); b.st[0] = nloc; b.st[1] = nx; }
        const unsigned old = xb_add(&bar[XB_XSUB(b.x)], 1u);
        const unsigned gen = old / nloc;
        if (old + 1u == (gen + 1u) * nloc) {
            __builtin_amdgcn_fence(__ATOMIC_RELEASE, "agent");
            asm volatile("s_waitcnt vmcnt(0)" ::: "memory");
            const unsigned og = xb_add(&bar[XB_TOP], 1u);
            const unsigned tg = og / nx;
            if (og + 1u == (tg + 1u) * nx) xb_add(&bar[XB_TOPGEN], 1u);
            else XB_SPIN(xb_ld(&bar[XB_TOPGEN]) == tg, bar);
            __builtin_amdgcn_fence(__ATOMIC_ACQUIRE, "agent");
            xb_add(&bar[XB_XGEN(b.x)], 1u);
            asm volatile("s_waitcnt vmcnt(0)" ::: "memory");
        } else {
            XB_SPIN(xb_ld(&bar[XB_XGEN(b.x)]) == gen, bar);
            __builtin_amdgcn_fence(__ATOMIC_ACQUIRE, "agent");
            asm volatile("s_waitcnt vmcnt(0)" ::: "memory");
        }
    }
    __syncthreads();
}

DEVI float bf2f(bf16_t v) { return __uint_as_float(((unsigned)v) << 16); }
typedef float f32x2_t __attribute__((ext_vector_type(2)));
typedef __bf16 bf16x2_t __attribute__((ext_vector_type(2)));
DEVI unsigned pk2(float lo, float hi) { f32x2_t v = {lo, hi}; bf16x2_t b = __builtin_convertvector(v, bf16x2_t); return __builtin_bit_cast(unsigned, b); }
#define dppf(v, ctrl) __int_as_float(__builtin_amdgcn_update_dpp(0, __float_as_int(v), (ctrl), 0xf, 0xf, false))
#define dppi(v, ctrl) __builtin_amdgcn_update_dpp(0, (v), (ctrl), 0xf, 0xf, false)
#define DPP_X1 0xB1
#define DPP_X2 0x4E
#define DPP_HM 0x141
#define DPP_RM 0x140
DEVI float x16f(float v, float& o) { auto r = __builtin_amdgcn_permlane16_swap(__float_as_uint(v), __float_as_uint(v), false, false); o = __uint_as_float(r[1]); return __uint_as_float(r[0]); }
DEVI float x32f(float v, float& o) { auto r = __builtin_amdgcn_permlane32_swap(__float_as_uint(v), __float_as_uint(v), false, false); o = __uint_as_float(r[1]); return __uint_as_float(r[0]); }
DEVI float sum32(float v) { float o; const float a = x32f(v, o); return a + o; }
DEVI float max32(float v) { float o; const float a = x32f(v, o); return fmaxf(a, o); }
DEVI float wave_sum(float v) {
    v += dppf(v, DPP_X1); v += dppf(v, DPP_X2); v += dppf(v, DPP_HM); v += dppf(v, DPP_RM);
    { float o; const float a = x16f(v, o); v = a + o; }
    { float o; const float a = x32f(v, o); v = a + o; }
    return v;
}
DEVI float ex2(float x) { return __builtin_amdgcn_exp2f(x); }
DEVI float siluf(float v) { return v / (1.0f + __expf(-v)); }

namespace g8 {
constexpr int BK = 64, HALF = 128, HT = HALF * BK;
DEVI int lds_byte(int r, int c) { int st = (r >> 4) * 2 + (c >> 5), rr = r & 15, cc = c & 31, ob = rr * 64 + cc * 2; return st * 1024 + (ob ^ (((ob >> 9) & 1) << 5)); }
DEVI void stage_rc(int b, int& R, int& C) { int st = b / 1024, sb = b % 1024, swz = sb ^ (((sb >> 9) & 1) << 5); R = (st >> 1) * 16 + swz / 64; C = (st & 1) * 32 + (swz % 64) / 2; }
}

DEVI void g8_rc(int tid, int& R0, int& C0) { g8::stage_rc(tid * 16, R0, C0); }
DEVI void g8_voff_lin(unsigned (&v)[4], int ld, int tid) { int R0, C0; g8_rc(tid, R0, C0);
    v[0] = (unsigned)(R0 * ld + C0) * 2u; v[1] = (unsigned)((R0 + 64) * ld + C0) * 2u; v[2] = (unsigned)((R0 + 128) * ld + C0) * 2u; v[3] = (unsigned)((R0 + 192) * ld + C0) * 2u; }
DEVI void g8_voff_tab(unsigned (&v)[4], const LAS unsigned* tab, int tid) { int R0, C0; g8_rc(tid, R0, C0);
    v[0] = (tab[R0] + C0) * 2u; v[1] = (tab[R0 + 64] + C0) * 2u; v[2] = (tab[R0 + 128] + C0) * 2u; v[3] = (tab[R0 + 192] + C0) * 2u; }

template <class Epi>
DEVI void gemm_tile(LAS unsigned char* lds, const int tid_in, const char* Ab, const unsigned (&voffA_)[4], const char* Bb, const int K, const Epi& epi) {
    using namespace g8;
    constexpr int HTB = HALF * BK * 2;
    int tz = tid_in; asm volatile("" : "+v"(tz));
    int wid = tz >> 6, lane = tz & 63, wr = wid >> 2, wc = wid & 3, fr = lane & 15, fq = lane >> 4;
    unsigned voffA[4] = {voffA_[0], voffA_[1], voffA_[2], voffA_[3]};
    asm volatile("" : "+v"(voffA[0]), "+v"(voffA[1]), "+v"(voffA[2]), "+v"(voffA[3]));
    unsigned voffB[2];
    { int R0, C0; stage_rc(tz * 16, R0, C0); voffB[0] = (unsigned)(R0 * K + C0) * 2u; voffB[1] = (unsigned)((R0 + 64) * K + C0) * 2u; }
    const size_t kstep = (size_t)(BK * 2);
    const size_t hstepB = (size_t)HALF * K * 2;
    const unsigned ldsw = (unsigned)wid * 1024u;
    const int aoff = lds_byte(wr * 64 + fr, fq * 8), boff = lds_byte(wc * 32 + fr, fq * 8);
#define G8_SA(b, h) (((b) * 2 + (h)) * HTB)
#define G8_SB(b, h) ((4 + (b) * 2 + (h)) * HTB)
#define G8_GL(gp, lofs) __builtin_amdgcn_global_load_lds((const unsigned*)(gp), (LAS unsigned*)(lds + (lofs)), 16, 0, 0)
#define STAGE_A(b, h, kt) do { const char* g_ = Ab + (size_t)(kt) * kstep; G8_GL(g_ + voffA[(h) * 2], G8_SA(b, h) + ldsw); G8_GL(g_ + voffA[(h) * 2 + 1], G8_SA(b, h) + ldsw + 8192); } while (0)
#define STAGE_B(b, h, kt) do { const char* g_ = Bb + (size_t)(kt) * kstep + ((h) ? hstepB : 0); G8_GL(g_ + voffB[0], G8_SB(b, h) + ldsw); G8_GL(g_ + voffB[1], G8_SB(b, h) + ldsw + 8192); } while (0)
#define LDA(dst, b, h) do { _Pragma("unroll") for (int m = 0; m < 4; ++m) _Pragma("unroll") for (int k = 0; k < 2; ++k) dst[m][k] = *(const LAS bf16x8*)(lds + G8_SA(b, h) + aoff + m * 2048 + k * 1024); } while (0)
#define LDB(dst, b, h) do { _Pragma("unroll") for (int n = 0; n < 2; ++n) _Pragma("unroll") for (int k = 0; k < 2; ++k) dst[n][k] = *(const LAS bf16x8*)(lds + G8_SB(b, h) + boff + n * 2048 + k * 1024); } while (0)
#define MMA(ai, bj, Af, Bf) do { __builtin_amdgcn_s_setprio(1); \
    _Pragma("unroll") for (int m = 0; m < 4; ++m) _Pragma("unroll") for (int n = 0; n < 2; ++n) _Pragma("unroll") for (int k = 0; k < 2; ++k) \
      acc[ai][bj][m][n] = __builtin_amdgcn_mfma_f32_16x16x32_bf16(Bf[n][k], Af[m][k], acc[ai][bj][m][n], 0, 0, 0); \
    __builtin_amdgcn_s_setprio(0); } while (0)
#define WAIT_V(n) asm volatile("s_waitcnt vmcnt(" #n ")" ::: "memory")
#define WAIT_L(n) asm volatile("s_waitcnt lgkmcnt(" #n ")" ::: "memory")
#define BAR __builtin_amdgcn_s_barrier()
#define SCHED __builtin_amdgcn_sched_barrier(0)
    f32x4 acc[2][2][4][2];
#pragma unroll
    for (int a = 0; a < 2; ++a)
#pragma unroll
        for (int b = 0; b < 2; ++b)
#pragma unroll
            for (int m = 0; m < 4; ++m)
#pragma unroll
                for (int n = 0; n < 2; ++n) acc[a][b][m][n] = (f32x4){0.f, 0.f, 0.f, 0.f};
    bf16x8 At[4][2], B0[2][2], B1[2][2];
    const int nt = K / BK;
    STAGE_B(0, 0, 0); STAGE_A(0, 0, 0); STAGE_B(0, 1, 0); STAGE_A(0, 1, 0);
    if (wr == 1) BAR;
    WAIT_V(4); BAR;
    STAGE_B(1, 0, 1); STAGE_A(1, 0, 1); STAGE_B(1, 1, 1);
    WAIT_V(6); BAR;
#pragma unroll 1
    for (int t = 0; t < nt; t += 2) {
        const int t2 = (t == nt - 2) ? 0 : t + 2;
        const int t3 = t2 + 1;
        LDB(B0, 0, 0); SCHED; LDA(At, 0, 0); STAGE_A(1, 1, t + 1);
        WAIT_L(8); BAR; WAIT_L(0); MMA(0, 0, At, B0); BAR; SCHED;
        LDB(B1, 0, 1); STAGE_B(0, 0, t2);
        BAR; WAIT_L(0); MMA(0, 1, At, B1); BAR;
        LDA(At, 0, 1); STAGE_A(0, 0, t2);
        BAR; WAIT_L(0); MMA(1, 0, At, B0); BAR; SCHED;
        STAGE_B(0, 1, t2);
        WAIT_V(6); BAR; MMA(1, 1, At, B1); BAR;
        LDB(B0, 1, 0); SCHED; LDA(At, 1, 0); STAGE_A(0, 1, t2);
        WAIT_L(8); BAR; WAIT_L(0); MMA(0, 0, At, B0); BAR; SCHED;
        LDB(B1, 1, 1); STAGE_B(1, 0, t3);
        BAR; WAIT_L(0); MMA(0, 1, At, B1); BAR;
        LDA(At, 1, 1); STAGE_A(1, 0, t3);
        BAR; WAIT_L(0); MMA(1, 0, At, B0); BAR; SCHED;
        STAGE_B(1, 1, t3);
        WAIT_V(6); BAR; MMA(1, 1, At, B1); BAR;
    }
    WAIT_V(0);
    if (wr == 0) BAR;
    BAR;
    asm volatile("" : "+v"(tz)); wid = tz >> 6; lane = tz & 63; wr = wid >> 2; wc = wid & 3; fr = lane & 15; fq = lane >> 4;
    epi(acc, wr, wc, fr, fq);
#undef G8_SA
#undef G8_SB
#undef G8_GL
#undef STAGE_A
#undef STAGE_B
#undef LDA
#undef LDB
#undef MMA
}
#define EPI_FOREACH(acc, wr, wc, fr, fq, ROW, COL, V, ...) \
    _Pragma("unroll") for (int ai_ = 0; ai_ < 2; ++ai_) _Pragma("unroll") for (int m_ = 0; m_ < 4; ++m_) { const int ROW = ai_ * 128 + (wr) * 64 + m_ * 16 + (fr); \
    _Pragma("unroll") for (int bj_ = 0; bj_ < 2; ++bj_) _Pragma("unroll") for (int n_ = 0; n_ < 2; ++n_) { const int COL = bj_ * 128 + (wc) * 32 + n_ * 16 + (fq) * 4; const f32x4 V = acc[ai_][bj_][m_][n_]; __VA_ARGS__ } __builtin_amdgcn_sched_barrier(0); }

template <class SCol, class DRow, class KS, class NS>
DEVI void convert_T(bf16_t* __restrict__ dst, const float* __restrict__ src, int ld, int K, int NR, SCol scol, DRow drow, KS ks, NS ns, int wi, int nw) {
    const int k8n = K >> 3; const int items = NR * k8n;
    for (int it = wi; it < items; it += nw) {
        const int n = it % NR, k0 = (it / NR) << 3;
        const int sc = scol(n);
        float v[8];
#pragma unroll
        for (int j = 0; j < 8; ++j) v[j] = (sc >= 0) ? src[(size_t)(k0 + j) * ld + sc] * ks(k0 + j) : 0.f;
        const float s = ns(n);
        u32x4 w; w.x = pk2(v[0] * s, v[1] * s); w.y = pk2(v[2] * s, v[3] * s); w.z = pk2(v[4] * s, v[5] * s); w.w = pk2(v[6] * s, v[7] * s);
        *(u32x4*)(dst + (size_t)drow(n) * K + k0) = w;
    }
}
struct IdCol { DEVI int operator()(int n) const { return n; } };
struct OneK { DEVI float operator()(int) const { return 1.f; } };
struct VecK { const float* g; DEVI float operator()(int k) const { return g[k]; } };

struct Params {
    const float* in[24];
    float* out;
    unsigned char* ws;
    int ph_lo, ph_hi;
};
enum { I_X = 0, I_C, I_WADA, I_BADA, I_N1G, I_WIN, I_QNG, I_WUQ, I_KVNG, I_WUKV, I_REL, I_AOG, I_BOG, I_WO, I_N2G, I_WR, I_EB, I_W1, I_W3, I_W2, I_WS1, I_WS3, I_WS2, I_FG };
constexpr int NPHASE = 15;

#define W_x (P.in[I_X])
#define W_mod ((float*)(ws + OFF_MOD))
#define W_ropecs ((float*)(ws + OFF_ROPE))
#define W_biasT ((float*)(ws + OFF_BIAS))
#define W_WinT ((bf16_t*)(ws + OFF_WIN))
#define W_WuqT ((bf16_t*)(ws + OFF_WUQ))
#define W_WukvT ((bf16_t*)(ws + OFF_WUKV))
#define W_WoT ((bf16_t*)(ws + OFF_WO))
#define W_WrT ((bf16_t*)(ws + OFF_WR))
#define W_Ws13T ((bf16_t*)(ws + OFF_WS13))
#define W_Ws2T ((bf16_t*)(ws + OFF_WS2))
#define W_hbuf ((bf16_t*)(ws + OFF_H))
#define W_logits ((float*)(ws + OFF_LOGITS))
#define W_eidx ((int*)(ws + OFF_EIDX))
#define W_gate ((float*)(ws + OFF_GATE))
#define W_rnk ((int*)(ws + OFF_RNK))
#define W_pos ((int*)(ws + OFF_POS))
#define W_toks ((int*)(ws + OFF_TOKS))
#define W_wts ((float*)(ws + OFF_WTS))
#define W_scr ((bf16_t*)(ws + OFF_SCR + (size_t)blk * 512 * 1024))
#define W_hdn ((bf16_t*)(ws + OFF_HDN))
#define W_ybuf ((bf16_t*)(ws + OFF_Y))
#define W_proj ((bf16_t*)(ws + OFF_PROJ))
#define W_qb ((bf16_t*)(ws + OFF_QB))
#define W_kvb ((bf16_t*)(ws + OFF_KVB))
#define W_bout ((bf16_t*)(ws + OFF_BOUT))
#define W_aparts ((bf16_t*)(ws + OFF_APARTS))
#define W_lsebuf ((float*)(ws + OFF_LSE))
#define W_mixb ((bf16_t*)(ws + OFF_MIX))

__global__ void __launch_bounds__(512, 2) fwd_kernel(Params P) {
    extern __shared__ __attribute__((aligned(16))) unsigned char lds[];
    const int blk = blockIdx.x, G = gridDim.x;
    const int wave_s = __builtin_amdgcn_readfirstlane((int)threadIdx.x >> 6);
#define TIDS0 int tid; asm volatile("v_mbcnt_lo_u32_b32 %0, -1, 0\n\tv_mbcnt_hi_u32_b32 %0, -1, %0" : "=v"(tid)); tid += wave_s * 64;
    const int vblk = (G % 8 == 0) ? (blk % 8) * (G / 8) + blk / 8 : blk;
    unsigned char* ws = P.ws;
    unsigned* ctl = (unsigned*)(ws + OFF_CTL);
    { TIDS0 if (tid < 64) ((LAS unsigned*)(lds + LDS_MISC))[tid] = 0u; }
    __syncthreads();
    XcdBarrier bar; bar.bar = ctl; bar.x = 0; bar.st = nullptr;
    if (MK_N_LAUNCHES == 1) { TIDS0 bar = xcd_barrier_post(ctl, (volatile LAS unsigned*)(lds + LDS_MISC), tid == 0); }
#ifndef PH_MASK
#define PH_MASK 0xffffffffu
#endif
#define TIDS int tid; asm volatile("v_mbcnt_lo_u32_b32 %0, -1, 0\n\tv_mbcnt_hi_u32_b32 %0, -1, %0" : "=v"(tid)); tid += wave_s * 64; const int lane = tid & 63; const int wave = wave_s; (void)lane; (void)wave;
#define IN(k) ((((PH_MASK) >> (k)) & 1u) && P.ph_lo <= (k) && (k) < P.ph_hi)
#define SEAM(k) do { if (MK_N_LAUNCHES == 1 && IN(k) && IN((k) + 1)) { TIDS0 xcd_barrier(bar, tid == 0); } } while (0)

    unsigned* cntg = ctl + CNT_WORD0;
    LAS unsigned* rowoff = (LAS unsigned*)(lds + LDS_ROWOFF);
    LAS float* rowsc = (LAS float*)(lds + LDS_ROWSC);
    LAS int* startL = (LAS int*)(lds + LDS_START);
    LAS int* cntL = (LAS int*)(lds + LDS_CNT);
    char* stage = (char*)lds + LDS_STAGE;
    LAS unsigned char* ldsL = (LAS unsigned char*)lds;

    if (IN(0)) {
        TIDS
        {
            float* sc = (float*)(lds);
            float* red = (float*)(lds + 32768);
            const float* c = P.in[I_C];
            for (int i = tid; i < 8192; i += 512) sc[i] = siluf(c[i]);
            __syncthreads();
            for (int cb = blk; cb < 256; cb += G) {
                const int cj = tid & 31, kg = tid >> 5;
                float a0 = 0, a1 = 0, a2 = 0, a3 = 0, a4 = 0, a5 = 0, a6 = 0, a7 = 0;
                if (cj < 24) {
                    const float* w = P.in[I_WADA] + cb * 24 + cj;
                    for (int k = kg * 64; k < kg * 64 + 64; ++k) {
                        const float wv = w[(size_t)k * 6144];
                        a0 += sc[k] * wv; a1 += sc[1024 + k] * wv; a2 += sc[2048 + k] * wv; a3 += sc[3072 + k] * wv;
                        a4 += sc[4096 + k] * wv; a5 += sc[5120 + k] * wv; a6 += sc[6144 + k] * wv; a7 += sc[7168 + k] * wv;
                    }
                }
                float* rp = red + (kg * 8) * 32 + cj;
                rp[0] = a0; rp[32] = a1; rp[64] = a2; rp[96] = a3; rp[128] = a4; rp[160] = a5; rp[192] = a6; rp[224] = a7;
                __syncthreads();
                if (tid < 256) {
                    const int b = tid >> 5, j = tid & 31;
                    if (j < 24) {
                        float s = 0.f;
                        for (int g = 0; g < 16; ++g) s += red[(g * 8 + b) * 32 + j];
                        const int col = cb * 24 + j;
                        W_mod[b * 6144 + col] = s + P.in[I_BADA][col];
                    }
                }
                __syncthreads();
            }
        }
        {
            for (int idx = blk * 512 + tid; idx < 4096 * 16; idx += G * 512) {
                const int s = idx >> 4, i = idx & 15;
                double inv = 1.0; for (int j = 0; j < i; ++j) inv *= 0.5623413251903491;
                const float invf = (float)inv;
                const float angf = (float)s * invf;
                const double xa = (double)angf;
                const double nrev = __builtin_rint(xa * 0.15915494309189535);
                const double r = xa - nrev * 6.283185307179586;
                const double r2 = r * r;
                double ts = r, ss = r, tc = 1.0, cc = 1.0;
#pragma unroll
                for (int n = 1; n <= 14; ++n) {
                    ts *= -r2 / (double)((2 * n) * (2 * n + 1)); ss += ts;
                    tc *= -r2 / (double)((2 * n - 1) * (2 * n)); cc += tc;
                }
                W_ropecs[idx * 2] = (float)cc; W_ropecs[idx * 2 + 1] = (float)ss;
            }
        }
        {
            for (int idx = blk * 512 + tid; idx < 3 * 8 * 129; idx += G * 512) {
                const int j = idx % 129, hh = (idx / 129) % 8, p = idx / (129 * 8);
                const int dil = (p == 0) ? 1 : (p == 1 ? 4 : 16);
                const int rel = (j - 64) * dil;
                const int n = rel < 0 ? -rel : rel;
                const float nf = (float)(n > 1 ? n : 1);
                int large = 8 + (int)(__logf(nf * 0.125f) / 4.852030263919617f * 8.0f);
                large = large < 15 ? large : 15;
                const int bucket = (rel > 0 ? 16 : 0) + (n < 8 ? n : large);
                W_biasT[idx] = P.in[I_REL][bucket * 8 + hh] * LOG2E;
            }
        }
        {
            const int wi = blk * 512 + tid, nw = G * 512;
            convert_T(W_WinT, P.in[I_WIN], INC, 1024, INCP,
                      [](int n) { if (n >= INC) return -1; if (n < 2176) return n; const int i = n - 2176; return 2176 + ((i & 1) ? 16 : 0) + (i >> 1); },
                      IdCol{}, OneK{}, [](int n) { return n < 512 ? 0.125f * LOG2E : 1.0f; }, wi, nw);
            convert_T(W_WuqT, P.in[I_WUQ], 768, 384, 768,
                      [](int n) { if (n < 512) return (n >> 6) * 96 + (n & 63); const int hh = (n - 512) >> 5, i = n & 31; return hh * 96 + 64 + ((i & 1) ? 16 : 0) + (i >> 1); },
                      IdCol{}, VecK{P.in[I_QNG]}, [](int) { return 0.10206207261596577f * LOG2E; }, wi, nw);
            convert_T(W_WukvT, P.in[I_WUKV], 1024, 256, 1024, IdCol{}, IdCol{}, VecK{P.in[I_KVNG]}, [](int) { return 1.f; }, wi, nw);
            {
                const float* ag = P.in[I_AOG]; const float* bg = P.in[I_BOG];
                convert_T(W_WoT, P.in[I_WO], 1024, 1024, 1024, IdCol{}, IdCol{}, [=](int k) { return k < 512 ? ag[k] : bg[k - 512]; }, [](int) { return 1.f; }, wi, nw);
            }
            convert_T(W_WrT, P.in[I_WR], 256, 1024, 256, IdCol{}, IdCol{}, OneK{}, [](int) { return 1.f; }, wi, nw);
            convert_T(W_Ws13T, P.in[I_WS1], 256, 1024, 256, IdCol{}, [](int n) { return (n >> 7) * 256 + (n & 127); }, OneK{}, [](int) { return 1.f; }, wi, nw);
            convert_T(W_Ws13T, P.in[I_WS3], 256, 1024, 256, IdCol{}, [](int n) { return (n >> 7) * 256 + 128 + (n & 127); }, OneK{}, [](int) { return 1.f; }, wi, nw);
            convert_T(W_Ws2T, P.in[I_WS2], 1024, 256, 1024, IdCol{}, IdCol{}, OneK{}, [](int) { return 1.f; }, wi, nw);
        }
    }
    SEAM(0);

    if (IN(1)) {
        TIDS
        const float* g = P.in[I_N1G];
        for (int row = blk * 8 + wave; row < NTOK; row += G * 8) {
            const int b = row >> 12;
            const float* xr = W_x + (size_t)row * DM;
            f32x4 v[4]; float ss = 0.f;
#pragma unroll
            for (int i = 0; i < 4; ++i) { v[i] = *(const f32x4*)(xr + i * 256 + lane * 4); ss += v[i][0] * v[i][0] + v[i][1] * v[i][1] + v[i][2] * v[i][2] + v[i][3] * v[i][3]; }
            ss = wave_sum(ss);
            const float rinv = rsqrtf(ss * (1.0f / 1024.0f) + EPS);
            const float* mb = W_mod + b * 6144;
#pragma unroll
            for (int i = 0; i < 4; ++i) {
                const int c = i * 256 + lane * 4;
                const f32x4 gg = *(const f32x4*)(g + c), sh = *(const f32x4*)(mb + c), sc = *(const f32x4*)(mb + 1024 + c);
                float o[4];
#pragma unroll
                for (int j = 0; j < 4; ++j) o[j] = v[i][j] * rinv * gg[j] * (1.0f + sc[j]) + sh[j];
                u32x2 w; w.x = pk2(o[0], o[1]); w.y = pk2(o[2], o[3]);
                *(u32x2*)(W_hbuf + (size_t)row * DM + c) = w;
            }
        }
    }
    SEAM(1);

    if (IN(2)) {
        TIDS
        for (int u = blk; u < 128 * 9; u += G) {
            const int pm = u / 9, pn = u % 9;
            const char* aB_ = (const char*)(W_hbuf + (size_t)pm * 256 * DM); unsigned va_[4]; g8_voff_lin(va_, DM, tid);
            auto epi = [&](const f32x4 (&acc)[2][2][4][2], int wr, int wc, int fr, int fq) {
                if (pn < 8) {
                    EPI_FOREACH(acc, wr, wc, fr, fq, r, c, v, {
                        u32x2 w; w.x = pk2(v[0], v[1]); w.y = pk2(v[2], v[3]);
                        *(u32x2*)(W_proj + (size_t)(pm * 256 + r) * INCP + pn * 256 + c) = w;
                    })
                } else {
                    EPI_FOREACH(acc, wr, wc, fr, fq, r, c, v, {
                        const int row = pm * 256 + r;
                        if (c < 160) {
                            float o0 = v[0], o1 = v[1], o2 = v[2], o3 = v[3];
                            if (c >= 128) {
                                const int i = (c - 128) >> 1; const int s = row & 4095;
                                const f32x4 cs = *(const f32x4*)(W_ropecs + (s * 16 + i) * 2);
                                o0 = v[0] * cs[0] - v[1] * cs[1]; o1 = v[1] * cs[0] + v[0] * cs[1];
                                o2 = v[2] * cs[2] - v[3] * cs[3]; o3 = v[3] * cs[2] + v[2] * cs[3];
                            }
                            u32x2 w; w.x = pk2(o0, o1); w.y = pk2(o2, o3);
                            *(u32x2*)(W_proj + (size_t)row * INCP + 2048 + c) = w;
                        }
                    })
                }
            };
            gemm_tile(ldsL, tid, aB_, va_, (const char*)(W_WinT + (size_t)pn * 256 * DM), DM, epi);
        }
    }
    SEAM(2);

    if (IN(3)) {
        TIDS
        for (int u = blk; u < 128 * 3; u += G) {
            TIDS
            const int pm = u / 3, pn = u % 3;
            __syncthreads();
#pragma unroll 4
            for (int rr = 0; rr < 32; ++rr) {
                const int r = wave * 32 + rr;
                float ss = 0.f;
                if (lane < 48) { const u32x4 w = *(const u32x4*)(W_proj + (size_t)(pm * 256 + r) * INCP + 1536 + lane * 8);
#pragma unroll
                    for (int j = 0; j < 4; ++j) { const float a = __uint_as_float(w[j] << 16), b = __uint_as_float(w[j] & 0xffff0000u); ss += a * a + b * b; } }
                ss = wave_sum(ss);
                if (lane == 0) rowsc[r] = rsqrtf(ss * (1.0f / 384.0f) + EPS);
            }
            __syncthreads();
            const char* aB_ = (const char*)(W_proj + (size_t)pm * 256 * INCP + 1536); unsigned va_[4]; g8_voff_lin(va_, INCP, tid);
            auto epi = [&](const f32x4 (&acc)[2][2][4][2], int wr, int wc, int fr, int fq) {
                if (pn < 2) {
                    EPI_FOREACH(acc, wr, wc, fr, fq, r, c, v, {
                        const float rs = rowsc[r];
                        u32x2 w; w.x = pk2(v[0] * rs, v[1] * rs); w.y = pk2(v[2] * rs, v[3] * rs);
                        *(u32x2*)(W_qb + (size_t)(pm * 256 + r) * 768 + pn * 256 + c) = w;
                    })
                } else {
                    EPI_FOREACH(acc, wr, wc, fr, fq, r, c, v, {
                        const int row = pm * 256 + r;
                        const float rs = rowsc[r];
                        const int i = (c & 31) >> 1; const int s = row & 4095;
                        const f32x4 cs = *(const f32x4*)(W_ropecs + (s * 16 + i) * 2);
                        const float t0 = v[0] * rs, t1 = v[1] * rs, t2 = v[2] * rs, t3 = v[3] * rs;
                        u32x2 w; w.x = pk2(t0 * cs[0] - t1 * cs[1], t1 * cs[0] + t0 * cs[1]); w.y = pk2(t2 * cs[2] - t3 * cs[3], t3 * cs[2] + t2 * cs[3]);
                        *(u32x2*)(W_qb + (size_t)row * 768 + 512 + c) = w;
                    })
                }
            };
            gemm_tile(ldsL, tid, aB_, va_, (const char*)(W_WuqT + (size_t)pn * 256 * QLORA), QLORA, epi);
        }
        for (int u = (blk + 128) % G; u < 128 * 4; u += G) {
            TIDS
            const int pm = u / 4, pn = u % 4;
            __syncthreads();
#pragma unroll 4
            for (int rr = 0; rr < 32; ++rr) {
                const int r = wave * 32 + rr;
                float ss = 0.f;
                if (lane < 32) { const u32x4 w = *(const u32x4*)(W_proj + (size_t)(pm * 256 + r) * INCP + 1920 + lane * 8);
#pragma unroll
                    for (int j = 0; j < 4; ++j) { const float a = __uint_as_float(w[j] << 16), b = __uint_as_float(w[j] & 0xffff0000u); ss += a * a + b * b; } }
                ss = wave_sum(ss);
                if (lane == 0) rowsc[r] = rsqrtf(ss * (1.0f / 256.0f) + EPS);
            }
            __syncthreads();
            const char* aB_ = (const char*)(W_proj + (size_t)pm * 256 * INCP + 1920); unsigned va_[4]; g8_voff_lin(va_, INCP, tid);
            auto epi = [&](const f32x4 (&acc)[2][2][4][2], int wr, int wc, int fr, int fq) {
                EPI_FOREACH(acc, wr, wc, fr, fq, r, c, v, {
                    const int col = pn * 256 + c; const int row = pm * 256 + r;
                    const float rs = rowsc[r];
                    u32x2 w; w.x = pk2(v[0] * rs, v[1] * rs); w.y = pk2(v[2] * rs, v[3] * rs);
                    *(u32x2*)(W_kvb + (size_t)row * 1024 + col) = w;
                })
            };
            gemm_tile(ldsL, tid, aB_, va_, (const char*)(W_WukvT + (size_t)pn * 256 * KVLORA), KVLORA, epi);
        }
    }
    SEAM(3);

    if (IN(4)) {
        for (int ui = 0; ui < 4; ++ui) {
            TIDS
            const int r32 = lane & 31, hh = lane >> 5;
            const int u = vblk * 4 + ui;
            if (u >= 1024) break;
            const int qblk = u & 15, bh = u >> 4, h = bh & 7, b = bh >> 3;
            const size_t tok0 = (size_t)b * SEQ;
            bf16x8 qf[6];
            {
                const size_t tq = tok0 + qblk * 256 + wave * 32 + r32;
#pragma unroll
                for (int d0 = 0; d0 < 6; ++d0) qf[d0] = *(const bf16x8*)(W_qb + tq * 768 + (d0 < 4 ? h * 64 + d0 * 16 : 512 + h * 32 + (d0 - 4) * 16) + hh * 8);
            }
            f32x16 o0 = {}, o1 = {};
            float m_run = -INFINITY, l_run = 0.f;
            const int skey = tid >> 3, sch = tid & 7;
            const bf16_t* kn_src = W_kvb + (tok0 + skey) * 1024 + h * 128 + sch * 8;
            const int pkey = (tid & 255) >> 2, pch = tid & 3;
            const bf16_t* kp_src = W_proj + (tok0 + pkey) * INCP + 2176 + pch * 8;
            const int k_dst = sch * 1024 + ((skey ^ sch) * 16);
            const int kp_dst = (8 + pch) * 1024 + ((pkey ^ pch) * 16);
            const int v_dst = 24576 + (sch >> 2) * 4096 + skey * 64 + (sch & 3) * 16;
            const int kfo = hh * 1024;
            const int vfo = 24576 + (4 * hh + ((lane & 15) >> 2)) * 64 + ((lane >> 4) & 1) * 32 + (lane & 3) * 8;
            __syncthreads();
            {
                const u32x4 kr = *(const u32x4*)kn_src; const u32x4 vr = *(const u32x4*)(kn_src + 64);
                u32x4 pr = {0, 0, 0, 0}; if (tid < 256) pr = *(const u32x4*)kp_src;
                *(LAS u32x4*)(ldsL + k_dst) = kr; *(LAS u32x4*)(ldsL + v_dst) = vr; if (tid < 256) *(LAS u32x4*)(ldsL + kp_dst) = pr;
            }
            __syncthreads();
#pragma unroll 1
            for (int t = 0; t < 64; ++t) {
                const int cur = t & 1;
                const int tn = (t + 1 < 64) ? t + 1 : t;
                const u32x4 kr = *(const u32x4*)(kn_src + (size_t)tn * 64 * 1024); const u32x4 vr = *(const u32x4*)(kn_src + 64 + (size_t)tn * 64 * 1024);
                u32x4 pr = {0, 0, 0, 0}; if (tid < 256) pr = *(const u32x4*)(kp_src + (size_t)tn * 64 * INCP);
                const int kb = cur * 12288 + kfo, vb = cur * 8192 + vfo;
                f32x16 s0 = {}, s1 = {};
#pragma unroll
                for (int d0 = 0; d0 < 6; ++d0) {
                    const int sw = (2 * d0 + hh) & 7;
                    const bf16x8 k0 = *(const LAS bf16x8*)(ldsL + kb + d0 * 2048 + ((r32 ^ sw) * 16));
                    const bf16x8 k1 = *(const LAS bf16x8*)(ldsL + kb + d0 * 2048 + (((32 + r32) ^ sw) * 16));
                    s0 = __builtin_amdgcn_mfma_f32_32x32x16_bf16(k0, qf[d0], s0, 0, 0, 0);
                    s1 = __builtin_amdgcn_mfma_f32_32x32x16_bf16(k1, qf[d0], s1, 0, 0, 0);
                }
                float mx = s0[0];
#pragma unroll
                for (int i = 0; i < 16; ++i) { mx = fmaxf(mx, s0[i]); mx = fmaxf(mx, s1[i]); }
                mx = max32(mx);
                const float m_new = fmaxf(m_run, mx);
                const float alpha = ex2(m_run - m_new);
                m_run = m_new;
                float ps = 0.f;
#pragma unroll
                for (int i = 0; i < 16; ++i) { s0[i] = ex2(s0[i] - m_new); s1[i] = ex2(s1[i] - m_new); ps += s0[i] + s1[i]; }
                l_run = l_run * alpha + ps;
#pragma unroll
                for (int i = 0; i < 16; ++i) { o0[i] *= alpha; o1[i] *= alpha; }
                bf16x8 pf[2][2];
#pragma unroll
                for (int s = 0; s < 2; ++s) {
                    u32x4 w0, w1;
                    w0.x = pk2(s0[8 * s + 0], s0[8 * s + 1]); w0.y = pk2(s0[8 * s + 2], s0[8 * s + 3]); w0.z = pk2(s0[8 * s + 4], s0[8 * s + 5]); w0.w = pk2(s0[8 * s + 6], s0[8 * s + 7]);
                    w1.x = pk2(s1[8 * s + 0], s1[8 * s + 1]); w1.y = pk2(s1[8 * s + 2], s1[8 * s + 3]); w1.z = pk2(s1[8 * s + 4], s1[8 * s + 5]); w1.w = pk2(s1[8 * s + 6], s1[8 * s + 7]);
                    pf[0][s] = __builtin_bit_cast(bf16x8, w0); pf[1][s] = __builtin_bit_cast(bf16x8, w1);
                }
#pragma unroll
                for (int n = 0; n < 2; ++n)
#pragma unroll
                    for (int s = 0; s < 2; ++s) {
                        const int ko = (32 * n + 16 * s) * 64;
#pragma unroll
                        for (int db = 0; db < 2; ++db) {
                            const s16x4 lo = __builtin_bit_cast(s16x4, __builtin_amdgcn_ds_read_tr16_b64_v4i16((LAS s16x4*)(ldsL + vb + db * 4096 + ko)));
                            const s16x4 hi = __builtin_bit_cast(s16x4, __builtin_amdgcn_ds_read_tr16_b64_v4i16((LAS s16x4*)(ldsL + vb + db * 4096 + ko + 512)));
                            const bf16x8 vf = {lo[0], lo[1], lo[2], lo[3], hi[0], hi[1], hi[2], hi[3]};
                            if (db == 0) o0 = __builtin_amdgcn_mfma_f32_32x32x16_bf16(vf, pf[n][s], o0, 0, 0, 0);
                            else o1 = __builtin_amdgcn_mfma_f32_32x32x16_bf16(vf, pf[n][s], o1, 0, 0, 0);
                        }
                    }
                {
                    const int nb = cur ^ 1;
                    *(LAS u32x4*)(ldsL + nb * 12288 + k_dst) = kr; *(LAS u32x4*)(ldsL + nb * 8192 + v_dst) = vr; if (tid < 256) *(LAS u32x4*)(ldsL + nb * 12288 + kp_dst) = pr;
                }
                __syncthreads();
            }
            {
                const float lt = sum32(l_run);
                const float inv = 1.0f / lt;
                const int sc = 40960 + wave * 4352;
#pragma unroll
                for (int g = 0; g < 4; ++g) {
                    u32x2 w;
                    w.x = pk2(o0[4 * g] * inv, o0[4 * g + 1] * inv); w.y = pk2(o0[4 * g + 2] * inv, o0[4 * g + 3] * inv);
                    *(LAS u32x2*)(ldsL + sc + r32 * 136 + (8 * g + 4 * hh) * 2) = w;
                    w.x = pk2(o1[4 * g] * inv, o1[4 * g + 1] * inv); w.y = pk2(o1[4 * g + 2] * inv, o1[4 * g + 3] * inv);
                    *(LAS u32x2*)(ldsL + sc + r32 * 136 + (32 + 8 * g + 4 * hh) * 2) = w;
                }
                __syncthreads();
#pragma unroll
                for (int it = 0; it < 8; ++it) {
                    const int row = it * 4 + (lane >> 4), pc = lane & 15;
                    const u32x2 w = *(const LAS u32x2*)(ldsL + sc + row * 136 + pc * 8);
                    *(u32x2*)(W_bout + (tok0 + qblk * 256 + wave * 32 + row) * 512 + h * 64 + pc * 4) = w;
                }
            }
        }
        for (int ui = 0; ui < 12; ++ui) {
            TIDS
            const int r32 = lane & 31, hh = lane >> 5;
            const int u = vblk * 12 + ui;
            if (u >= 3072) break;
            const int bh = u / 48, w48 = u % 48, h = bh & 7, b = bh >> 3;
            const int p = w48 >> 4, j16 = w48 & 15;
            const int dil = (p == 0) ? 1 : (p == 1 ? 4 : 16);
            const int res = (p == 0) ? 0 : (p == 1 ? (j16 >> 2) : j16);
            const int m0 = (p == 0) ? j16 * 256 : (p == 1 ? (j16 & 3) * 256 : 0);
            const int L = SEQ / dil;
            const size_t tok0 = (size_t)b * SEQ;
            __syncthreads();
            if (tid < 129) *(LAS float*)(ldsL + 98304 + tid * 4) = W_biasT[(p * 8 + h) * 129 + tid];
#pragma unroll 2
            for (int it = 0; it < 6; ++it) {
                const int idx = it * 512 + tid, row = idx >> 3, ch = idx & 7;
                const int mk = m0 - 64 + row;
                u32x4 kr = {0, 0, 0, 0}, vr = {0, 0, 0, 0};
                if (mk >= 0 && mk < L) {
                    const bf16_t* src = W_proj + (tok0 + (size_t)mk * dil + res) * INCP + 512 + h * 64 + ch * 8;
                    kr = *(const u32x4*)src; vr = *(const u32x4*)(src + 512);
                }
                *(LAS u32x4*)(ldsL + ch * 6144 + ((row ^ ch) * 16)) = kr;
                *(LAS u32x4*)(ldsL + 49152 + (ch >> 2) * 24576 + row * 64 + (ch & 3) * 16) = vr;
            }
            const int qrel = wave * 32 + r32;
            const size_t tq = tok0 + (size_t)(m0 + qrel) * dil + res;
            bf16x8 qf[4];
#pragma unroll
            for (int d0 = 0; d0 < 4; ++d0) qf[d0] = *(const bf16x8*)(W_proj + tq * INCP + h * 64 + d0 * 16 + hh * 8);
            __syncthreads();
            f32x16 o0 = {}, o1 = {};
            float m_run = -1e30f, l_run = 0.f;
            const int vfo = 49152 + (4 * hh + ((lane & 15) >> 2)) * 64 + ((lane >> 4) & 1) * 32 + (lane & 3) * 8;
#pragma unroll 1
            for (int jj = 0; jj < 3; ++jj) {
                const int jt = (wave >> 1) + jj;
                f32x16 s0 = {}, s1 = {};
#pragma unroll
                for (int d0 = 0; d0 < 4; ++d0) {
                    const int ch = 2 * d0 + hh;
                    const bf16x8 k0 = *(const LAS bf16x8*)(ldsL + ch * 6144 + (((64 * jt + r32) ^ ch) * 16));
                    const bf16x8 k1 = *(const LAS bf16x8*)(ldsL + ch * 6144 + (((64 * jt + 32 + r32) ^ ch) * 16));
                    s0 = __builtin_amdgcn_mfma_f32_32x32x16_bf16(k0, qf[d0], s0, 0, 0, 0);
                    s1 = __builtin_amdgcn_mfma_f32_32x32x16_bf16(k1, qf[d0], s1, 0, 0, 0);
                }
                float mx = -1e30f;
#pragma unroll
                for (int i = 0; i < 16; ++i) {
                    const int cr = (i & 3) + 8 * (i >> 2) + 4 * hh;
                    const int i0 = 64 * jt + cr, i1 = i0 + 32;
                    const int oi0 = i0 - qrel, oi1 = i1 - qrel;
                    const int mk0 = m0 - 64 + i0, mk1 = mk0 + 32;
                    const bool v0 = (oi0 >= 0) && (oi0 <= 128) && (mk0 >= 0) && (mk0 < L);
                    const bool v1 = (oi1 >= 0) && (oi1 <= 128) && (mk1 >= 0) && (mk1 < L);
                    const float b0 = *(const LAS float*)(ldsL + 98304 + (v0 ? oi0 : 0) * 4);
                    const float b1 = *(const LAS float*)(ldsL + 98304 + (v1 ? oi1 : 0) * 4);
                    s0[i] = v0 ? s0[i] + b0 : -1e30f;
                    s1[i] = v1 ? s1[i] + b1 : -1e30f;
                    mx = fmaxf(mx, fmaxf(s0[i], s1[i]));
                }
                mx = max32(mx);
                const float m_new = fmaxf(m_run, mx);
                const float alpha = ex2(m_run - m_new);
                m_run = m_new;
                float ps = 0.f;
#pragma unroll
                for (int i = 0; i < 16; ++i) {
                    s0[i] = (s0[i] > -1e29f) ? ex2(s0[i] - m_new) : 0.f;
                    s1[i] = (s1[i] > -1e29f) ? ex2(s1[i] - m_new) : 0.f;
                    ps += s0[i] + s1[i];
                }
                l_run = l_run * alpha + ps;
#pragma unroll
                for (int i = 0; i < 16; ++i) { o0[i] *= alpha; o1[i] *= alpha; }
                bf16x8 pf[2][2];
#pragma unroll
                for (int s = 0; s < 2; ++s) {
                    u32x4 w0, w1;
                    w0.x = pk2(s0[8 * s + 0], s0[8 * s + 1]); w0.y = pk2(s0[8 * s + 2], s0[8 * s + 3]); w0.z = pk2(s0[8 * s + 4], s0[8 * s + 5]); w0.w = pk2(s0[8 * s + 6], s0[8 * s + 7]);
                    w1.x = pk2(s1[8 * s + 0], s1[8 * s + 1]); w1.y = pk2(s1[8 * s + 2], s1[8 * s + 3]); w1.z = pk2(s1[8 * s + 4], s1[8 * s + 5]); w1.w = pk2(s1[8 * s + 6], s1[8 * s + 7]);
                    pf[0][s] = __builtin_bit_cast(bf16x8, w0); pf[1][s] = __builtin_bit_cast(bf16x8, w1);
                }
#pragma unroll
                for (int n = 0; n < 2; ++n)
#pragma unroll
                    for (int s = 0; s < 2; ++s) {
                        const int ko = (64 * jt + 32 * n + 16 * s) * 64;
#pragma unroll
                        for (int db = 0; db < 2; ++db) {
                            const s16x4 lo = __builtin_bit_cast(s16x4, __builtin_amdgcn_ds_read_tr16_b64_v4i16((LAS s16x4*)(ldsL + vfo + db * 24576 + ko)));
                            const s16x4 hi = __builtin_bit_cast(s16x4, __builtin_amdgcn_ds_read_tr16_b64_v4i16((LAS s16x4*)(ldsL + vfo + db * 24576 + ko + 512)));
                            const bf16x8 vf = {lo[0], lo[1], lo[2], lo[3], hi[0], hi[1], hi[2], hi[3]};
                            if (db == 0) o0 = __builtin_amdgcn_mfma_f32_32x32x16_bf16(vf, pf[n][s], o0, 0, 0, 0);
                            else o1 = __builtin_amdgcn_mfma_f32_32x32x16_bf16(vf, pf[n][s], o1, 0, 0, 0);
                        }
                    }
            }
            __syncthreads();
            {
                const float lt = sum32(l_run);
                const float inv = 1.0f / lt;
                if (hh == 0) W_lsebuf[((size_t)p * NTOK + tq) * 8 + h] = m_run + __log2f(lt);
                const int sc = wave * 4352;
#pragma unroll
                for (int g = 0; g < 4; ++g) {
                    u32x2 w;
                    w.x = pk2(o0[4 * g] * inv, o0[4 * g + 1] * inv); w.y = pk2(o0[4 * g + 2] * inv, o0[4 * g + 3] * inv);
                    *(LAS u32x2*)(ldsL + sc + r32 * 136 + (8 * g + 4 * hh) * 2) = w;
                    w.x = pk2(o1[4 * g] * inv, o1[4 * g + 1] * inv); w.y = pk2(o1[4 * g + 2] * inv, o1[4 * g + 3] * inv);
                    *(LAS u32x2*)(ldsL + sc + r32 * 136 + (32 + 8 * g + 4 * hh) * 2) = w;
                }
                __syncthreads();
#pragma unroll
                for (int it = 0; it < 8; ++it) {
                    const int row = it * 4 + (lane >> 4), pc = lane & 15;
                    const u32x2 w = *(const LAS u32x2*)(ldsL + sc + row * 136 + pc * 8);
                    const size_t tr = tok0 + (size_t)(m0 + wave * 32 + row) * dil + res;
                    *(u32x2*)(W_aparts + ((size_t)p * NTOK + tr) * 512 + h * 64 + pc * 4) = w;
                }
            }
        }
    }
    SEAM(4);

    if (IN(5)) {
        TIDS
        for (int row = blk * 8 + wave; row < NTOK; row += G * 8) {
            const int hd = lane >> 3;
            float ls0 = W_lsebuf[((size_t)0 * NTOK + row) * 8 + hd], ls1 = W_lsebuf[((size_t)1 * NTOK + row) * 8 + hd], ls2 = W_lsebuf[((size_t)2 * NTOK + row) * 8 + hd];
            const float M = fmaxf(ls0, fmaxf(ls1, ls2));
            float w0 = ex2(ls0 - M), w1 = ex2(ls1 - M), w2 = ex2(ls2 - M);
            const float wsn = 1.0f / (w0 + w1 + w2); w0 *= wsn; w1 *= wsn; w2 *= wsn;
            const u32x4 a0 = *(const u32x4*)(W_aparts + ((size_t)0 * NTOK + row) * 512 + lane * 8);
            const u32x4 a1 = *(const u32x4*)(W_aparts + ((size_t)1 * NTOK + row) * 512 + lane * 8);
            const u32x4 a2 = *(const u32x4*)(W_aparts + ((size_t)2 * NTOK + row) * 512 + lane * 8);
            const u32x4 bb = *(const u32x4*)(W_bout + (size_t)row * 512 + lane * 8);
            float av[8], bv[8]; float sa = 0.f, sb = 0.f;
#pragma unroll
            for (int j = 0; j < 4; ++j) {
                av[2 * j] = w0 * __uint_as_float(a0[j] << 16) + w1 * __uint_as_float(a1[j] << 16) + w2 * __uint_as_float(a2[j] << 16);
                av[2 * j + 1] = w0 * __uint_as_float(a0[j] & 0xffff0000u) + w1 * __uint_as_float(a1[j] & 0xffff0000u) + w2 * __uint_as_float(a2[j] & 0xffff0000u);
                bv[2 * j] = __uint_as_float(bb[j] << 16); bv[2 * j + 1] = __uint_as_float(bb[j] & 0xffff0000u);
                sa += av[2 * j] * av[2 * j] + av[2 * j + 1] * av[2 * j + 1];
                sb += bv[2 * j] * bv[2 * j] + bv[2 * j + 1] * bv[2 * j + 1];
            }
            sa = wave_sum(sa); sb = wave_sum(sb);
            const float ra = rsqrtf(sa * (1.0f / 512.0f) + EPS), rb = rsqrtf(sb * (1.0f / 512.0f) + EPS);
            u32x4 wa, wb;
            wa.x = pk2(av[0] * ra, av[1] * ra); wa.y = pk2(av[2] * ra, av[3] * ra); wa.z = pk2(av[4] * ra, av[5] * ra); wa.w = pk2(av[6] * ra, av[7] * ra);
            wb.x = pk2(bv[0] * rb, bv[1] * rb); wb.y = pk2(bv[2] * rb, bv[3] * rb); wb.z = pk2(bv[4] * rb, bv[5] * rb); wb.w = pk2(bv[6] * rb, bv[7] * rb);
            *(u32x4*)(W_mixb + (size_t)row * DM + lane * 8) = wa;
            *(u32x4*)(W_mixb + (size_t)row * DM + 512 + lane * 8) = wb;
        }
    }
    SEAM(5);

    if (IN(6)) {
        TIDS
        for (int u = blk; u < 128 * 4; u += G) {
            const int pm = u >> 2, pn = u & 3;
            const char* aB_ = (const char*)(W_mixb + (size_t)pm * 256 * DM); unsigned va_[4]; g8_voff_lin(va_, DM, tid);
            auto epi = [&](const f32x4 (&acc)[2][2][4][2], int wr, int wc, int fr, int fq) {
                EPI_FOREACH(acc, wr, wc, fr, fq, r, c, v, {
                    const int col = pn * 256 + c; const int row = pm * 256 + r;
                    const f32x4 xv = *(const f32x4*)(W_x + (size_t)row * DM + col);
                    const f32x4 g1 = *(const f32x4*)(W_mod + (row >> 12) * 6144 + 2048 + col);
                    f32x4 o; o[0] = xv[0] + g1[0] * v[0]; o[1] = xv[1] + g1[1] * v[1]; o[2] = xv[2] + g1[2] * v[2]; o[3] = xv[3] + g1[3] * v[3];
                    *(f32x4*)(P.out + (size_t)row * DM + col) = o;
                })
            };
            gemm_tile(ldsL, tid, aB_, va_, (const char*)(W_WoT + (size_t)pn * 256 * DM), DM, epi);
        }
    }
    SEAM(6);

    if (IN(7)) {
        TIDS
        const float* g = P.in[I_N2G];
        for (int row = blk * 8 + wave; row < NTOK; row += G * 8) {
            const int b = row >> 12;
            const float* xr = P.out + (size_t)row * DM;
            f32x4 v[4]; float ss = 0.f;
#pragma unroll
            for (int i = 0; i < 4; ++i) { v[i] = *(const f32x4*)(xr + i * 256 + lane * 4); ss += v[i][0] * v[i][0] + v[i][1] * v[i][1] + v[i][2] * v[i][2] + v[i][3] * v[i][3]; }
            ss = wave_sum(ss);
            const float rinv = rsqrtf(ss * (1.0f / 1024.0f) + EPS);
            const float* mb = W_mod + b * 6144 + 3072;
#pragma unroll
            for (int i = 0; i < 4; ++i) {
                const int c = i * 256 + lane * 4;
                const f32x4 gg = *(const f32x4*)(g + c), sh = *(const f32x4*)(mb + c), sc = *(const f32x4*)(mb + 1024 + c);
                float o[4];
#pragma unroll
                for (int j = 0; j < 4; ++j) o[j] = v[i][j] * rinv * gg[j] * (1.0f + sc[j]) + sh[j];
                u32x2 w; w.x = pk2(o[0], o[1]); w.y = pk2(o[2], o[3]);
                *(u32x2*)(W_hbuf + (size_t)row * DM + c) = w;
            }
        }
    }
    SEAM(7);

    if (IN(8)) {
        TIDS
        for (int u = blk; u < 256; u += G) {
            const int pm = u >> 1, pn = u & 1;
            const char* aB_ = (const char*)(W_hbuf + (size_t)pm * 256 * DM); unsigned va_[4]; g8_voff_lin(va_, DM, tid);
            auto epi = [&](const f32x4 (&acc)[2][2][4][2], int wr, int wc, int fr, int fq) {
#pragma unroll
                for (int ai = 0; ai < 2; ++ai)
#pragma unroll
                    for (int m = 0; m < 4; ++m) {
                        const int r = ai * 128 + wr * 64 + m * 16 + fr;
#pragma unroll
                        for (int n = 0; n < 2; ++n) {
                            const f32x4 a = acc[ai][0][m][n], bq = acc[ai][1][m][n];
                            const int c = wc * 32 + n * 16 + fq * 4;
                            u32x2 w; w.x = pk2(siluf(a[0]) * bq[0], siluf(a[1]) * bq[1]); w.y = pk2(siluf(a[2]) * bq[2], siluf(a[3]) * bq[3]);
                            *(u32x2*)(W_hdn + (size_t)(NASG + pm * 256 + r) * EFF + pn * 128 + c) = w;
                        }
                        __builtin_amdgcn_sched_barrier(0);
                    }
            };
            gemm_tile(ldsL, tid, aB_, va_, (const char*)(W_Ws13T + (size_t)pn * 256 * DM), DM, epi);
        }
        for (int u = (blk + 128) % G; u < 128; u += G) {
            const int pm = u;
            const char* aB_ = (const char*)(W_hbuf + (size_t)pm * 256 * DM); unsigned va_[4]; g8_voff_lin(va_, DM, tid);
            auto epi = [&](const f32x4 (&acc)[2][2][4][2], int wr, int wc, int fr, int fq) {
                EPI_FOREACH(acc, wr, wc, fr, fq, r, c, v, {
                    *(f32x4*)(W_logits + (size_t)(pm * 256 + r) * 256 + c) = v;
                })
            };
            gemm_tile(ldsL, tid, aB_, va_, (const char*)(W_WrT), DM, epi);
        }
    }
    SEAM(8);

    if (IN(9)) {
        TIDS
        const float* ebias = P.in[I_EB];
        const f32x4 eb = *(const f32x4*)(ebias + lane * 4);
        for (int t = blk * 8 + wave; t < NTOK; t += G * 8) {
            const f32x4 lg = *(const f32x4*)(W_logits + (size_t)t * 256 + lane * 4);
            float sc[4], sel[4];
#pragma unroll
            for (int i = 0; i < 4; ++i) { sc[i] = 1.0f / (1.0f + expf(-lg[i])); sel[i] = sc[i] + eb[i]; }
            float a1 = fmaxf(sel[0], sel[1]), a2 = fminf(sel[0], sel[1]);
#pragma unroll
            for (int i = 2; i < 4; ++i) { const float v = sel[i]; a2 = fmaxf(a2, fminf(a1, v)); a1 = fmaxf(a1, v); }
            {
                float b1, b2, n1, n2;
                b1 = dppf(a1, DPP_X1); b2 = dppf(a2, DPP_X1); n1 = fmaxf(a1, b1); n2 = fmaxf(fminf(a1, b1), fmaxf(a2, b2)); a1 = n1; a2 = n2;
                b1 = dppf(a1, DPP_X2); b2 = dppf(a2, DPP_X2); n1 = fmaxf(a1, b1); n2 = fmaxf(fminf(a1, b1), fmaxf(a2, b2)); a1 = n1; a2 = n2;
                b1 = dppf(a1, DPP_HM); b2 = dppf(a2, DPP_HM); n1 = fmaxf(a1, b1); n2 = fmaxf(fminf(a1, b1), fmaxf(a2, b2)); a1 = n1; a2 = n2;
            }
            const float gs = a1 + a2; const int myg = lane >> 3;
            int rank = 0;
#pragma unroll
            for (int g = 0; g < 8; ++g) { const float v = __int_as_float(__builtin_amdgcn_readlane(__float_as_int(gs), g * 8)); rank += (v > gs || (v == gs && g < myg)) ? 1 : 0; }
            const bool gsel = rank < 4;
            float cand[4];
#pragma unroll
            for (int i = 0; i < 4; ++i) cand[i] = gsel ? sel[i] : -INFINITY;
            int my_e = 0; float my_g = 0.f; float gsum = 0.f;
#pragma unroll
            for (int k = 0; k < 8; ++k) {
                float bv = cand[0]; int bi = 0;
#pragma unroll
                for (int i = 1; i < 4; ++i) if (cand[i] > bv) { bv = cand[i]; bi = i; }
                float v = bv; int ix = lane * 4 + bi;
#define AMX(ov, oi) do { const float ov_ = (ov); const int oi_ = (oi); if (ov_ > v || (ov_ == v && oi_ < ix)) { v = ov_; ix = oi_; } } while (0)
                AMX(dppf(v, DPP_X1), dppi(ix, DPP_X1)); AMX(dppf(v, DPP_X2), dppi(ix, DPP_X2)); AMX(dppf(v, DPP_HM), dppi(ix, DPP_HM)); AMX(dppf(v, DPP_RM), dppi(ix, DPP_RM));
                { auto rv = __builtin_amdgcn_permlane16_swap(__float_as_uint(v), __float_as_uint(v), false, false); auto ri = __builtin_amdgcn_permlane16_swap((unsigned)ix, (unsigned)ix, false, false);
                  v = __uint_as_float(rv[0]); ix = (int)ri[0]; AMX(__uint_as_float(rv[1]), (int)ri[1]); }
                { auto rv = __builtin_amdgcn_permlane32_swap(__float_as_uint(v), __float_as_uint(v), false, false); auto ri = __builtin_amdgcn_permlane32_swap((unsigned)ix, (unsigned)ix, false, false);
                  v = __uint_as_float(rv[0]); ix = (int)ri[0]; AMX(__uint_as_float(rv[1]), (int)ri[1]); }
#undef AMX
                ix = __builtin_amdgcn_readfirstlane(ix);
                float myscore = 0.f;
#pragma unroll
                for (int i = 0; i < 4; ++i) if (lane * 4 + i == ix) { cand[i] = -INFINITY; myscore = sc[i]; }
                const float gw = __int_as_float(__builtin_amdgcn_readlane(__float_as_int(myscore), ix >> 2));
                gsum += gw;
                if (lane == k) { my_e = ix; my_g = gw; }
            }
            if (lane < 8) {
                const unsigned rk = atomicAdd(&cntg[my_e * CNT_STRIDE], 1u);
                W_eidx[t * 8 + lane] = my_e; W_gate[t * 8 + lane] = my_g / gsum * 2.5f; W_rnk[t * 8 + lane] = (int)rk;
            }
        }
    }
    SEAM(9);

    if (IN(10)) {
        TIDS
        if (tid < 256) cntL[tid] = (int)__hip_atomic_load(&cntg[tid * CNT_STRIDE], __ATOMIC_RELAXED, __HIP_MEMORY_SCOPE_AGENT);
        __syncthreads();
        if (tid < 256) { int s = 0; for (int j = 0; j < tid; ++j) s += cntL[j]; startL[tid] = s; }
        __syncthreads();
        for (int t = blk * 8 + wave; t < NTOK; t += G * 8) {
            if (lane < 8) {
                const int e = W_eidx[t * 8 + lane];
                const int d = startL[e] + W_rnk[t * 8 + lane];
                W_toks[d] = t; W_wts[d] = W_gate[t * 8 + lane]; W_pos[t * 8 + lane] = d;
            }
        }
    }
    SEAM(10);

    if (IN(11)) {
        TIDS
        __syncthreads();
        if (tid < 256) cntL[tid] = (int)__hip_atomic_load(&cntg[tid * CNT_STRIDE], __ATOMIC_RELAXED, __HIP_MEMORY_SCOPE_AGENT);
        __syncthreads();
        if (tid < 256) { int s = 0; for (int j = 0; j < tid; ++j) s += cntL[j]; startL[tid] = s; }
        __syncthreads();
        for (int u = blk; u < 512; u += G) {
            const int e = u >> 1, pn = u & 1;
            const int cnt = cntL[e], st = startL[e];
            if (cnt == 0) continue;
            __syncthreads();
            convert_T(W_scr, P.in[I_W1] + (size_t)e * 1024 * 256 + pn * 128, 256, 1024, 128, IdCol{}, IdCol{}, OneK{}, [](int) { return 1.f; }, tid, 512);
            convert_T(W_scr + 128 * 1024, P.in[I_W3] + (size_t)e * 1024 * 256 + pn * 128, 256, 1024, 128, IdCol{}, IdCol{}, OneK{}, [](int) { return 1.f; }, tid, 512);
            asm volatile("s_waitcnt vmcnt(0)" ::: "memory");
            __syncthreads();
            const int ntile = (cnt + 255) >> 8;
            for (int ti = 0; ti < ntile; ++ti) {
                TIDS
                __syncthreads();
                if (tid < 256) { const int rr = ti * 256 + tid; const int s = st + (rr < cnt ? rr : 0); rowoff[tid] = (unsigned)W_toks[s] * DM; }
                __syncthreads();
                const char* aB_ = (const char*)(W_hbuf); unsigned va_[4]; g8_voff_tab(va_, rowoff, tid);
                auto epi = [&](const f32x4 (&acc)[2][2][4][2], int wr, int wc, int fr, int fq) {
#pragma unroll
                    for (int ai = 0; ai < 2; ++ai)
#pragma unroll
                        for (int m = 0; m < 4; ++m) {
                            const int r = ai * 128 + wr * 64 + m * 16 + fr;
                            const int rr = ti * 256 + r;
                            if (rr < cnt) {
#pragma unroll
                                for (int n = 0; n < 2; ++n) {
                                    const f32x4 a = acc[ai][0][m][n], bq = acc[ai][1][m][n];
                                    const int c = wc * 32 + n * 16 + fq * 4;
                                    u32x2 w; w.x = pk2(siluf(a[0]) * bq[0], siluf(a[1]) * bq[1]); w.y = pk2(siluf(a[2]) * bq[2], siluf(a[3]) * bq[3]);
                                    *(u32x2*)(W_hdn + (size_t)(st + rr) * EFF + pn * 128 + c) = w;
                                }
                            }
                            __builtin_amdgcn_sched_barrier(0);
                        }
                };
                gemm_tile(ldsL, tid, aB_, va_, (const char*)(W_scr), DM, epi);
            }
        }
    }
    SEAM(11);

    if (IN(12)) {
        TIDS
        __syncthreads();
        if (tid < 256) cntL[tid] = (int)__hip_atomic_load(&cntg[tid * CNT_STRIDE], __ATOMIC_RELAXED, __HIP_MEMORY_SCOPE_AGENT);
        __syncthreads();
        if (tid < 256) { int s = 0; for (int j = 0; j < tid; ++j) s += cntL[j]; startL[tid] = s; }
        __syncthreads();
        for (int u = blk; u < 1024; u += G) {
            const int e = u >> 2, pn = u & 3;
            const int cnt = cntL[e], st = startL[e];
            if (cnt == 0) continue;
            __syncthreads();
            convert_T(W_scr, P.in[I_W2] + (size_t)e * 256 * 1024 + pn * 256, 1024, 256, 256, IdCol{}, IdCol{}, OneK{}, [](int) { return 1.f; }, tid, 512);
            asm volatile("s_waitcnt vmcnt(0)" ::: "memory");
            __syncthreads();
            const int ntile = (cnt + 255) >> 8;
            for (int ti = 0; ti < ntile; ++ti) {
                TIDS
                __syncthreads();
                if (tid < 256) { const int rr = ti * 256 + tid; const int s = st + (rr < cnt ? rr : 0); rowoff[tid] = (unsigned)s * EFF; rowsc[tid] = W_wts[s]; }
                __syncthreads();
                const char* aB_ = (const char*)(W_hdn); unsigned va_[4]; g8_voff_tab(va_, rowoff, tid);
                auto epi = [&](const f32x4 (&acc)[2][2][4][2], int wr, int wc, int fr, int fq) {
                    EPI_FOREACH(acc, wr, wc, fr, fq, r, c, v, {
                        const int rr = ti * 256 + r;
                        if (rr < cnt) {
                            const float g = rowsc[r];
                            u32x2 w; w.x = pk2(v[0] * g, v[1] * g); w.y = pk2(v[2] * g, v[3] * g);
                            *(u32x2*)(W_ybuf + (size_t)(st + rr) * DM + pn * 256 + c) = w;
                        }
                    })
                };
                gemm_tile(ldsL, tid, aB_, va_, (const char*)(W_scr), EFF, epi);
            }
        }
        for (int u = blk; u < 512; u += G) {
            TIDS
            const int pm = u >> 2, pn = u & 3;
            const char* aB_ = (const char*)(W_hdn + (size_t)(NASG + pm * 256) * EFF); unsigned va_[4]; g8_voff_lin(va_, EFF, tid);
            auto epi = [&](const f32x4 (&acc)[2][2][4][2], int wr, int wc, int fr, int fq) {
                EPI_FOREACH(acc, wr, wc, fr, fq, r, c, v, {
                    u32x2 w; w.x = pk2(v[0], v[1]); w.y = pk2(v[2], v[3]);
                    *(u32x2*)(W_ybuf + (size_t)(NASG + pm * 256 + r) * DM + pn * 256 + c) = w;
                })
            };
            gemm_tile(ldsL, tid, aB_, va_, (const char*)(W_Ws2T + (size_t)pn * 256 * EFF), EFF, epi);
        }
    }
    SEAM(12);

    if (IN(13)) {
        TIDS
        const float* fg = P.in[I_FG];
        for (int row = blk * 8 + wave; row < NTOK; row += G * 8) {
            const int b = row >> 12;
            float a0[8], a1[8];
#pragma unroll
            for (int j = 0; j < 8; ++j) { a0[j] = 0.f; a1[j] = 0.f; }
#pragma unroll
            for (int k = 0; k < 9; ++k) {
                const int pr = (k < 8) ? W_pos[row * 8 + k] : (NASG + row);
                const bf16_t* yr = W_ybuf + (size_t)pr * DM;
                const u32x4 w0 = *(const u32x4*)(yr + lane * 8), w1 = *(const u32x4*)(yr + 512 + lane * 8);
#pragma unroll
                for (int j = 0; j < 4; ++j) {
                    a0[2 * j] += __uint_as_float(w0[j] << 16); a0[2 * j + 1] += __uint_as_float(w0[j] & 0xffff0000u);
                    a1[2 * j] += __uint_as_float(w1[j] << 16); a1[2 * j + 1] += __uint_as_float(w1[j] & 0xffff0000u);
                }
            }
            float* xr = P.out + (size_t)row * DM;
            const float* g2 = W_mod + b * 6144 + 5120;
            float v0[8], v1[8]; float ss = 0.f;
#pragma unroll
            for (int q = 0; q < 2; ++q) {
                const f32x4 xa = *(const f32x4*)(xr + lane * 8 + q * 4), xb = *(const f32x4*)(xr + 512 + lane * 8 + q * 4);
                const f32x4 ga = *(const f32x4*)(g2 + lane * 8 + q * 4), gb = *(const f32x4*)(g2 + 512 + lane * 8 + q * 4);
#pragma unroll
                for (int j = 0; j < 4; ++j) {
                    v0[q * 4 + j] = xa[j] + ga[j] * a0[q * 4 + j]; v1[q * 4 + j] = xb[j] + gb[j] * a1[q * 4 + j];
                    ss += v0[q * 4 + j] * v0[q * 4 + j] + v1[q * 4 + j] * v1[q * 4 + j];
                }
            }
            ss = wave_sum(ss);
            const float rinv = rsqrtf(ss * (1.0f / 1024.0f) + EPS);
#pragma unroll
            for (int q = 0; q < 2; ++q) {
                const f32x4 fa = *(const f32x4*)(fg + lane * 8 + q * 4), fb = *(const f32x4*)(fg + 512 + lane * 8 + q * 4);
                f32x4 oa, ob;
#pragma unroll
                for (int j = 0; j < 4; ++j) { oa[j] = v0[q * 4 + j] * rinv * fa[j]; ob[j] = v1[q * 4 + j] * rinv * fb[j]; }
                *(f32x4*)(xr + lane * 8 + q * 4) = oa; *(f32x4*)(xr + 512 + lane * 8 + q * 4) = ob;
            }
        }
    }

#ifdef DBG_STOP
    if (IN(14)) {
        TIDS
        const size_t NO = (size_t)NTOK * DM;
        for (size_t i = (size_t)blk * 512 + tid; i < NO; i += (size_t)G * 512) {
            unsigned hsh = 0u;
            const size_t row = i >> 10, c = i & 1023;
#define RB(p, idx) ((unsigned)(p)[(idx)])
#define RF(p, idx) (__float_as_uint((p)[(idx)]))
#if DBG_STOP == 0
            hsh = RB(W_WinT, i % (2304 * 1024)) ^ RB(W_WoT, i % (1024 * 1024)) ^ RB(W_WuqT, i % (768 * 384)) ^ RB(W_WukvT, i % (1024 * 256)) ^ RB(W_Ws13T, i % (512 * 1024)) ^ RB(W_Ws2T, i % (1024 * 256)) ^ RB(W_WrT, i % (256 * 1024))
                ^ RF(W_mod, i % (8 * 6144)) ^ RF(W_ropecs, i % (4096 * 32)) ^ RF(W_biasT, i % (3 * 8 * 129));
#elif DBG_STOP == 1 || DBG_STOP == 7
            hsh = RB(W_hbuf, i);
#elif DBG_STOP == 2
            hsh = RB(W_proj, row * INCP + c) ^ (RB(W_proj, row * INCP + 1024 + c) << 1) ^ (c < 160 ? (RB(W_proj, row * INCP + 2048 + c) << 2) : 0u);
#elif DBG_STOP == 3
            hsh = RB(W_kvb, i) ^ (c < 768 ? (RB(W_qb, row * 768 + c) << 1) : 0u);
#elif DBG_STOP == 4
            if (c < 512) hsh = RB(W_bout, row * 512 + c); else if (DBG_SUB) { const size_t cc = c - 512; hsh = RB(W_aparts, row * 512 + cc) ^ (RB(W_aparts, ((size_t)NTOK + row) * 512 + cc) << 1) ^ (RB(W_aparts, ((size_t)2 * NTOK + row) * 512 + cc) << 2) ^ RF(W_lsebuf, row * 8 + (cc >> 6)) ^ (RF(W_lsebuf, ((size_t)NTOK + row) * 8 + (cc >> 6)) << 1) ^ (RF(W_lsebuf, ((size_t)2 * NTOK + row) * 8 + (cc >> 6)) << 2); }
#elif DBG_STOP == 5
            hsh = RB(W_mixb, i);
#elif DBG_STOP == 6
            hsh = RF(P.out, i);
#elif DBG_STOP == 8
            if (c < 256) hsh = RF(W_logits, row * 256 + c); else if (c < 512) hsh = RB(W_hdn, ((size_t)NASG + row) * EFF + (c - 256));
#elif DBG_STOP == 9
            if (c < 8) hsh = (unsigned)W_eidx[row * 8 + c]; else if (c < 16) hsh = RF(W_gate, row * 8 + (c - 8));
#elif DBG_STOP == 11
            { const int k = (int)(c >> 8); hsh = RB(W_hdn, (size_t)W_pos[row * 8 + k] * EFF + (c & 255)) ^ (RB(W_hdn, (size_t)W_pos[row * 8 + 4 + k] * EFF + (c & 255)) << 1); }
#elif DBG_STOP == 12
            { for (int k = 0; k < 8; ++k) hsh ^= RB(W_ybuf, (size_t)W_pos[row * 8 + k] * DM + c) << (k & 3); hsh ^= RB(W_ybuf, ((size_t)NASG + row) * DM + c); }
#endif
            P.out[i] = (float)(hsh & 0xFu);
        }
    }
#endif
#undef IN
#undef SEAM
}

extern "C" void kernel_launch(void* const* d_in, const int* in_sizes, int n_in, void* d_out, int out_size, void* d_ws, size_t ws_size, hipStream_t stream) {
    static int grid = 0;
    if (grid == 0) {
        if (n_in != 24 || ws_size < WS_END) { fprintf(stderr, "kernel_launch: need 24 inputs and %zu bytes of workspace (got %d, %zu)\n", (size_t)WS_END, n_in, ws_size); grid = -1; return; }
        int dev = 0, cus = 0, per_cu = 0;
        if (hipGetDevice(&dev) != hipSuccess || hipDeviceGetAttribute(&cus, hipDeviceAttributeMultiprocessorCount, dev) != hipSuccess) { grid = -1; return; }
        if (hipFuncSetAttribute((const void*)fwd_kernel, hipFuncAttributeMaxDynamicSharedMemorySize, LDS_BYTES) != hipSuccess) { fprintf(stderr, "kernel_launch: hipFuncSetAttribute failed\n"); grid = -1; return; }
        if (hipOccupancyMaxActiveBlocksPerMultiprocessor(&per_cu, (const void*)fwd_kernel, 512, LDS_BYTES) != hipSuccess || per_cu < 1) { fprintf(stderr, "kernel_launch: occupancy query says %d\n", per_cu); }
        (void)hipGetLastError();
        grid = cus;
    }
    if (grid < 0) return;
    (void)hipMemsetAsync((char*)d_ws + OFF_CTL, 0, CTL_BYTES, stream);
    Params p{};
    for (int i = 0; i < 24; ++i) p.in[i] = (const float*)d_in[i];
    p.out = (float*)d_out; p.ws = (unsigned char*)d_ws;
#if MK_N_LAUNCHES == 1
    p.ph_lo = 0; p.ph_hi = NPHASE;
    hipLaunchKernelGGL(fwd_kernel, dim3(grid), dim3(512), LDS_BYTES, stream, p);
#else
#ifdef DBG_STOP
    for (int k = 0; k <= DBG_STOP; ++k) { p.ph_lo = k; p.ph_hi = k + 1; hipLaunchKernelGGL(fwd_kernel, dim3(grid), dim3(512), LDS_BYTES, stream, p); }
    p.ph_lo = 14; p.ph_hi = 15; hipLaunchKernelGGL(fwd_kernel, dim3(grid), dim3(512), LDS_BYTES, stream, p);
#else
    for (int k = 0; k < 14; ++k) { p.ph_lo = k; p.ph_hi = k + 1; hipLaunchKernelGGL(fwd_kernel, dim3(grid), dim3(512), LDS_BYTES, stream, p); }
#endif
#endif
}
```

```cpp
#include <hip/hip_runtime.h>
#include <stdint.h>
#include <stdio.h>

#ifndef MK_N_LAUNCHES
#define MK_N_LAUNCHES 1
#endif

#define DEVI __device__ __forceinline__
typedef unsigned short bf16_t;
typedef short bf16x8 __attribute__((ext_vector_type(8)));
typedef short s16x4 __attribute__((ext_vector_type(4)));
typedef float f32x4 __attribute__((ext_vector_type(4)));
typedef float f32x16 __attribute__((ext_vector_type(16)));
typedef unsigned u32x4 __attribute__((ext_vector_type(4)));
typedef unsigned u32x2 __attribute__((ext_vector_type(2)));

constexpr int NTOK = 32768, SEQ = 4096, DM = 1024;
constexpr int INC = 2208, INCP = 2304;
constexpr int QLORA = 384, KVLORA = 256;
constexpr int NEXP = 256, EFF = 256;
constexpr int NASG = NTOK * 8;
constexpr int NROWS = NASG + NTOK;
constexpr float EPS = 1e-6f;
constexpr float LOG2E = 1.4426950408889634f;

constexpr size_t MiB = 1u << 20;
constexpr size_t OFF_CTL = 0, CTL_BYTES = 1 * MiB;
constexpr size_t OFF_MOD = 1 * MiB;
constexpr size_t OFF_ROPE = OFF_MOD + 256 * 1024;
constexpr size_t OFF_BIAS = OFF_ROPE + 512 * 1024;
constexpr size_t OFF_WIN = 2 * MiB;
constexpr size_t OFF_WUQ = OFF_WIN + 4608 * 1024;
constexpr size_t OFF_WUKV = OFF_WUQ + 1 * MiB;
constexpr size_t OFF_WO = OFF_WUKV + 512 * 1024;
constexpr size_t OFF_WR = OFF_WO + 2 * MiB;
constexpr size_t OFF_WS13 = OFF_WR + 512 * 1024;
constexpr size_t OFF_WS2 = OFF_WS13 + 1 * MiB;
constexpr size_t OFF_H = 12 * MiB;
constexpr size_t OFF_LOGITS = OFF_H + 64 * MiB;
constexpr size_t OFF_EIDX = OFF_LOGITS + 32 * MiB;
constexpr size_t OFF_GATE = OFF_EIDX + 1 * MiB;
constexpr size_t OFF_RNK = OFF_GATE + 1 * MiB;
constexpr size_t OFF_POS = OFF_RNK + 1 * MiB;
constexpr size_t OFF_TOKS = OFF_POS + 1 * MiB;
constexpr size_t OFF_WTS = OFF_TOKS + 1 * MiB;
constexpr size_t OFF_SSQ = OFF_WTS + 1 * MiB;
constexpr size_t OFF_SCR = OFF_SSQ + 4 * MiB;
constexpr size_t OFF_HDN = OFF_SCR + 128 * MiB;
constexpr size_t OFF_Y = OFF_HDN + 144 * MiB;
constexpr size_t WS_END = OFF_Y + 576 * MiB;
constexpr size_t OFF_PROJ = OFF_Y;
constexpr size_t OFF_QB = OFF_PROJ + 144 * MiB;
constexpr size_t OFF_KVB = OFF_QB + 48 * MiB;
constexpr size_t OFF_BOUT = OFF_KVB + 64 * MiB;
constexpr size_t OFF_APARTS = OFF_BOUT + 32 * MiB;
constexpr size_t OFF_LSE = OFF_APARTS + 96 * MiB;
constexpr size_t OFF_MIX = OFF_LSE + 4 * MiB;
static_assert(OFF_MIX + 64 * MiB <= WS_END, "alias map");
constexpr int CNT_WORD0 = 8192, CNT_STRIDE = 16;

constexpr int LDS_STAGE = 0;
constexpr int LDS_ROWOFF = 131072;
constexpr int LDS_ROWSC = LDS_ROWOFF + 8192;
constexpr int LDS_MISC = LDS_ROWSC + 8192;
constexpr int LDS_START = LDS_MISC + 256;
constexpr int LDS_CNT = LDS_START + 1280;
constexpr int LDS_BYTES = 155648;
static_assert(LDS_CNT + 1024 <= LDS_BYTES, "lds map");

#define XB_TMO      128
#define XB_XCNT(j)  (256  + 64 * (j))
#define XB_XSUB(j)  (1280 + 64 * (j))
#define XB_XGEN(j)  (2304 + 64 * (j))
#define XB_TOP      3328
#define XB_TOPGEN   3392
#define XCD_BAR_WORDS 3456
#define XB_SPIN_CAP (1u << 22)
#define LAS __attribute__((address_space(3)))

__device__ __forceinline__ unsigned xb_ld(unsigned* p)              { return __hip_atomic_load(p, __ATOMIC_RELAXED, __HIP_MEMORY_SCOPE_AGENT); }
__device__ __forceinline__ unsigned xb_add(unsigned* p, unsigned v) { return __hip_atomic_fetch_add(p, v, __ATOMIC_RELAXED, __HIP_MEMORY_SCOPE_AGENT); }
__device__ __forceinline__ unsigned xb_xcc_id() { return (unsigned)__builtin_amdgcn_s_getreg((3 << 11) | 20) & 0xFu; }
#define XB_SPIN(cond, bar) do { unsigned _sp = 0; while (cond) { __builtin_amdgcn_s_sleep(1); \
    if ((++_sp & 255u) == 0u) { if (xb_ld(&(bar)[XB_TMO])) break; if (_sp > XB_SPIN_CAP) { atomicAdd(&(bar)[XB_TMO], 1u); break; } } } } while (0)

struct XcdBarrier { unsigned* bar; unsigned x; volatile LAS unsigned* st; };

__device__ __forceinline__ XcdBarrier xcd_barrier_post(unsigned* bar, volatile LAS unsigned* st, const bool leader) {
    XcdBarrier b; b.bar = bar; b.x = xb_xcc_id(); b.st = st;
    if (leader) (void)xb_add(&bar[XB_XCNT(b.x)], 1u);
    return b;
}
__device__ __forceinline__ void xcd_barrier_complete(unsigned* bar, unsigned x, unsigned& nloc, unsigned& nx) {
    const unsigned G = gridDim.x * gridDim.y * gridDim.z;
    unsigned sum, cnt, mine, sp = 0u;
    for (;;) {
        sum = 0u; cnt = 0u; mine = 0u;
#pragma unroll
        for (unsigned j = 0; j < 16; ++j) { const unsigned c = xb_ld(&bar[XB_XCNT(j)]); sum += c; cnt += (c > 0u) ? 1u : 0u; mine = (j == x) ? c : mine; }
        if (sum == G) break;
        __builtin_amdgcn_s_sleep(1);
        if ((++sp & 255u) == 0u) { if (xb_ld(&bar[XB_TMO])) break; if (sp > XB_SPIN_CAP) { atomicAdd(&bar[XB_TMO], 1u); break; } }
    }
    nloc = mine > 0u ? mine : 1u; nx = cnt > 0u ? cnt : 1u;
}
__device__ __forceinline__ void xcd_barrier(const XcdBarrier& b, const bool leader) {
    asm volatile("s_waitcnt vmcnt(0)" ::: "memory");
    __syncthreads();
    if (leader) {
        unsigned* bar = b.bar;
        __builtin_amdgcn_s_waitcnt(0);
        unsigned nloc = b.st[0], nx = b.st[1];
        if (nloc == 0u) { xcd_barrier_complete(bar, b.x, nloc, nx); b.st[0] = nloc; b.st[1] = nx; }
        const unsigned old = xb_add(&bar[XB_XSUB(b.x)], 1u);
        const unsigned gen = old / nloc;
        if (old + 1u == (gen + 1u) * nloc) {
            __builtin_amdgcn_fence(__ATOMIC_RELEASE, "agent");
            asm volatile("s_waitcnt vmcnt(0)" ::: "memory");
            const unsigned og = xb_add(&bar[XB_TOP], 1u);
            const unsigned tg = og / nx;
            if (og + 1u == (tg + 1u) * nx) xb_add(&bar[XB_TOPGEN], 1u);
            else XB_SPIN(xb_ld(&bar[XB_TOPGEN]) == tg, bar);
            __builtin_amdgcn_fence(__ATOMIC_ACQUIRE, "agent");
            xb_add(&bar[XB_XGEN(b.x)], 1u);
            asm volatile("s_waitcnt vmcnt(0)" ::: "memory");
        } else {
            XB_SPIN(xb_ld(&bar[XB_XGEN(b.x)]) == gen, bar);
            __builtin_amdgcn_fence(__ATOMIC_ACQUIRE, "agent");
            asm volatile("s_waitcnt vmcnt(0)" ::: "memory");
        }
    }
    __syncthreads();
}

DEVI float bf2f(bf16_t v) { return __uint_as_float(((unsigned)v) << 16); }
typedef float f32x2_t __attribute__((ext_vector_type(2)));
typedef __bf16 bf16x2_t __attribute__((ext_vector_type(2)));
DEVI unsigned pk2(float lo, float hi) { f32x2_t v = {lo, hi}; bf16x2_t b = __builtin_convertvector(v, bf16x2_t); return __builtin_bit_cast(unsigned, b); }
#define dppf(v, ctrl) __int_as_float(__builtin_amdgcn_update_dpp(0, __float_as_int(v), (ctrl), 0xf, 0xf, false))
#define dppi(v, ctrl) __builtin_amdgcn_update_dpp(0, (v), (ctrl), 0xf, 0xf, false)
#define DPP_X1 0xB1
#define DPP_X2 0x4E
#define DPP_HM 0x141
#define DPP_RM 0x140
DEVI float x16f(float v, float& o) { auto r = __builtin_amdgcn_permlane16_swap(__float_as_uint(v), __float_as_uint(v), false, false); o = __uint_as_float(r[1]); return __uint_as_float(r[0]); }
DEVI float x32f(float v, float& o) { auto r = __builtin_amdgcn_permlane32_swap(__float_as_uint(v), __float_as_uint(v), false, false); o = __uint_as_float(r[1]); return __uint_as_float(r[0]); }
DEVI float sum32(float v) { float o; const float a = x32f(v, o); return a + o; }
DEVI float max32(float v) { float o; const float a = x32f(v, o); return fmaxf(a, o); }
DEVI float wave_sum(float v) {
    v += dppf(v, DPP_X1); v += dppf(v, DPP_X2); v += dppf(v, DPP_HM); v += dppf(v, DPP_RM);
    { float o; const float a = x16f(v, o); v = a + o; }
    { float o; const float a = x32f(v, o); v = a + o; }
    return v;
}
DEVI float ex2(float x) { return __builtin_amdgcn_exp2f(x); }
DEVI float siluf(float v) { return v / (1.0f + __expf(-v)); }

namespace g8 {
constexpr int BK = 64, HALF = 128, HT = HALF * BK;
DEVI int lds_byte(int r, int c) { int st = (r >> 4) * 2 + (c >> 5), rr = r & 15, cc = c & 31, ob = rr * 64 + cc * 2; return st * 1024 + (ob ^ (((ob >> 9) & 1) << 5)); }
DEVI void stage_rc(int b, int& R, int& C) { int st = b / 1024, sb = b % 1024, swz = sb ^ (((sb >> 9) & 1) << 5); R = (st >> 1) * 16 + swz / 64; C = (st & 1) * 32 + (swz % 64) / 2; }
}

DEVI void g8_rc(int tid, int& R0, int& C0) { g8::stage_rc(tid * 16, R0, C0); }
DEVI void g8_voff_lin(unsigned (&v)[4], int ld, int tid) { int R0, C0; g8_rc(tid, R0, C0);
    v[0] = (unsigned)(R0 * ld + C0) * 2u; v[1] = (unsigned)((R0 + 64) * ld + C0) * 2u; v[2] = (unsigned)((R0 + 128) * ld + C0) * 2u; v[3] = (unsigned)((R0 + 192) * ld + C0) * 2u; }
DEVI void g8_voff_tab(unsigned (&v)[4], const LAS unsigned* tab, int tid) { int R0, C0; g8_rc(tid, R0, C0);
    v[0] = (tab[R0] + C0) * 2u; v[1] = (tab[R0 + 64] + C0) * 2u; v[2] = (tab[R0 + 128] + C0) * 2u; v[3] = (tab[R0 + 192] + C0) * 2u; }

template <class Epi>
DEVI void gemm_tile(LAS unsigned char* lds, const int tid_in, const char* Ab, const unsigned (&voffA_)[4], const char* Bb, const int K, const Epi& epi) {
    using namespace g8;
    constexpr int HTB = HALF * BK * 2;
    int tz = tid_in; asm volatile("" : "+v"(tz));
    int wid = tz >> 6, lane = tz & 63, wr = wid >> 2, wc = wid & 3, fr = lane & 15, fq = lane >> 4;
    unsigned voffA[4] = {voffA_[0], voffA_[1], voffA_[2], voffA_[3]};
    asm volatile("" : "+v"(voffA[0]), "+v"(voffA[1]), "+v"(voffA[2]), "+v"(voffA[3]));
    unsigned voffB[2];
    { int R0, C0; stage_rc(tz * 16, R0, C0); voffB[0] = (unsigned)(R0 * K + C0) * 2u; voffB[1] = (unsigned)((R0 + 64) * K + C0) * 2u; }
    const size_t kstep = (size_t)(BK * 2);
    const size_t hstepB = (size_t)HALF * K * 2;
    const unsigned ldsw = (unsigned)wid * 1024u;
    const int aoff = lds_byte(wr * 64 + fr, fq * 8), boff = lds_byte(wc * 32 + fr, fq * 8);
#define G8_SA(b, h) (((b) * 2 + (h)) * HTB)
#define G8_SB(b, h) ((4 + (b) * 2 + (h)) * HTB)
#define G8_GL(gp, lofs) __builtin_amdgcn_global_load_lds((const unsigned*)(gp), (LAS unsigned*)(lds + (lofs)), 16, 0, 0)
#define STAGE_A(b, h, kt) do { const char* g_ = Ab + (size_t)(kt) * kstep; G8_GL(g_ + voffA[(h) * 2], G8_SA(b, h) + ldsw); G8_GL(g_ + voffA[(h) * 2 + 1], G8_SA(b, h) + ldsw + 8192); } while (0)
#define STAGE_B(b, h, kt) do { const char* g_ = Bb + (size_t)(kt) * kstep + ((h) ? hstepB : 0); G8_GL(g_ + voffB[0], G8_SB(b, h) + ldsw); G8_GL(g_ + voffB[1], G8_SB(b, h) + ldsw + 8192); } while (0)
#define LDA(dst, b, h) do { _Pragma("unroll") for (int m = 0; m < 4; ++m) _Pragma("unroll") for (int k = 0; k < 2; ++k) dst[m][k] = *(const LAS bf16x8*)(lds + G8_SA(b, h) + aoff + m * 2048 + k * 1024); } while (0)
#define LDB(dst, b, h) do { _Pragma("unroll") for (int n = 0; n < 2; ++n) _Pragma("unroll") for (int k = 0; k < 2; ++k) dst[n][k] = *(const LAS bf16x8*)(lds + G8_SB(b, h) + boff + n * 2048 + k * 1024); } while (0)
#define MMA(ai, bj, Af, Bf) do { __builtin_amdgcn_s_setprio(1); \
    _Pragma("unroll") for (int m = 0; m < 4; ++m) _Pragma("unroll") for (int n = 0; n < 2; ++n) _Pragma("unroll") for (int k = 0; k < 2; ++k) \
      acc[ai][bj][m][n] = __builtin_amdgcn_mfma_f32_16x16x32_bf16(Bf[n][k], Af[m][k], acc[ai][bj][m][n], 0, 0, 0); \
    __builtin_amdgcn_s_setprio(0); } while (0)
#define WAIT_V(n) asm volatile("s_waitcnt vmcnt(" #n ")" ::: "memory")
#define WAIT_L(n) asm volatile("s_waitcnt lgkmcnt(" #n ")" ::: "memory")
#define BAR __builtin_amdgcn_s_barrier()
#define SCHED __builtin_amdgcn_sched_barrier(0)
    f32x4 acc[2][2][4][2];
#pragma unroll
    for (int a = 0; a < 2; ++a)
#pragma unroll
        for (int b = 0; b < 2; ++b)
#pragma unroll
            for (int m = 0; m < 4; ++m)
#pragma unroll
                for (int n = 0; n < 2; ++n) acc[a][b][m][n] = (f32x4){0.f, 0.f, 0.f, 0.f};
    bf16x8 At[4][2], B0[2][2], B1[2][2];
    const int nt = K / BK;
    STAGE_B(0, 0, 0); STAGE_A(0, 0, 0); STAGE_B(0, 1, 0); STAGE_A(0, 1, 0);
    if (wr == 1) BAR;
    WAIT_V(4); BAR;
    STAGE_B(1, 0, 1); STAGE_A(1, 0, 1); STAGE_B(1, 1, 1);
    WAIT_V(6); BAR;
#pragma unroll 1
    for (int t = 0; t < nt; t += 2) {
        const int t2 = (t == nt - 2) ? 0 : t + 2;
        const int t3 = t2 + 1;
        LDB(B0, 0, 0); SCHED; LDA(At, 0, 0); STAGE_A(1, 1, t + 1);
        WAIT_L(8); BAR; WAIT_L(0); MMA(0, 0, At, B0); BAR; SCHED;
        LDB(B1, 0, 1); STAGE_B(0, 0, t2);
        BAR; WAIT_L(0); MMA(0, 1, At, B1); BAR;
        LDA(At, 0, 1); STAGE_A(0, 0, t2);
        BAR; WAIT_L(0); MMA(1, 0, At, B0); BAR; SCHED;
        STAGE_B(0, 1, t2);
        WAIT_V(6); BAR; MMA(1, 1, At, B1); BAR;
        LDB(B0, 1, 0); SCHED; LDA(At, 1, 0); STAGE_A(0, 1, t2);
        WAIT_L(8); BAR; WAIT_L(0); MMA(0, 0, At, B0); BAR; SCHED;
        LDB(B1, 1, 1); STAGE_B(1, 0, t3);
        BAR; WAIT_L(0); MMA(0, 1, At, B1); BAR;
        LDA(At, 1, 1); STAGE_A(1, 0, t3);
        BAR; WAIT_L(0); MMA(1, 0, At, B0); BAR; SCHED;
        STAGE_B(1, 1, t3);
        WAIT_V(6); BAR; MMA(1, 1, At, B1); BAR;
    }
    WAIT_V(0);
    if (wr == 0) BAR;
    BAR;
    asm volatile("" : "+v"(tz)); wid = tz >> 6; lane = tz & 63; wr = wid >> 2; wc = wid & 3; fr = lane & 15; fq = lane >> 4;
    epi(acc, wr, wc, fr, fq);
#undef G8_SA
#undef G8_SB
#undef G8_GL
#undef STAGE_A
#undef STAGE_B
#undef LDA
#undef LDB
#undef MMA
}
struct GDesc { const char* Ab; const char* Bb; unsigned va0, va1, va2, va3; int i0, i1; };
template <class Next, class Epi>
DEVI void gemm_stream(LAS unsigned char* lds, const int tid_in, const int K, Next& next, const Epi& epi) {
    using namespace g8;
    constexpr int HTB = HALF * BK * 2;
    int tz = tid_in; asm volatile("" : "+v"(tz));
    int wid = tz >> 6, lane = tz & 63, wr = wid >> 2, wc = wid & 3, fr = lane & 15, fq = lane >> 4;
    unsigned voffB[2];
    { int R0, C0; stage_rc(tz * 16, R0, C0); voffB[0] = (unsigned)(R0 * K + C0) * 2u; voffB[1] = (unsigned)((R0 + 64) * K + C0) * 2u; }
    const size_t kstep = (size_t)(BK * 2);
    const size_t hstepB = (size_t)HALF * K * 2;
    const unsigned ldsw = (unsigned)wid * 1024u;
    const int aoff = lds_byte(wr * 64 + fr, fq * 8), boff = lds_byte(wc * 32 + fr, fq * 8);
#define G8_SA(b, h) (((b) * 2 + (h)) * HTB)
#define G8_SB(b, h) ((4 + (b) * 2 + (h)) * HTB)
#define G8_GL(gp, lofs) __builtin_amdgcn_global_load_lds((const unsigned*)(gp), (LAS unsigned*)(lds + (lofs)), 16, 0, 0)
#define STG_A(b, h, gb, v0, v1) do { G8_GL((gb) + (v0), G8_SA(b, h) + ldsw); G8_GL((gb) + (v1), G8_SA(b, h) + ldsw + 8192); } while (0)
#define STG_B(b, h, gb) do { const char* g_ = (gb) + ((h) ? hstepB : 0); G8_GL(g_ + voffB[0], G8_SB(b, h) + ldsw); G8_GL(g_ + voffB[1], G8_SB(b, h) + ldsw + 8192); } while (0)
#define LDA(dst, b, h) do { _Pragma("unroll") for (int m = 0; m < 4; ++m) _Pragma("unroll") for (int k = 0; k < 2; ++k) dst[m][k] = *(const LAS bf16x8*)(lds + G8_SA(b, h) + aoff + m * 2048 + k * 1024); } while (0)
#define LDB(dst, b, h) do { _Pragma("unroll") for (int n = 0; n < 2; ++n) _Pragma("unroll") for (int k = 0; k < 2; ++k) dst[n][k] = *(const LAS bf16x8*)(lds + G8_SB(b, h) + boff + n * 2048 + k * 1024); } while (0)
#define MMA(ai, bj, Af, Bf) do { __builtin_amdgcn_s_setprio(1); \
    _Pragma("unroll") for (int m = 0; m < 4; ++m) _Pragma("unroll") for (int n = 0; n < 2; ++n) _Pragma("unroll") for (int k = 0; k < 2; ++k) \
      acc[ai][bj][m][n] = __builtin_amdgcn_mfma_f32_16x16x32_bf16(Bf[n][k], Af[m][k], acc[ai][bj][m][n], 0, 0, 0); \
    __builtin_amdgcn_s_setprio(0); } while (0)
#define ZACC() do { _Pragma("unroll") for (int a = 0; a < 2; ++a) _Pragma("unroll") for (int b = 0; b < 2; ++b) _Pragma("unroll") for (int m = 0; m < 4; ++m) _Pragma("unroll") for (int n = 0; n < 2; ++n) acc[a][b][m][n] = (f32x4){0.f, 0.f, 0.f, 0.f}; } while (0)
    GDesc cur, nxt;
    if (!next(0, cur)) return;
    nxt = cur;
    f32x4 acc[2][2][4][2];
    ZACC();
    bf16x8 At[4][2], B0[2][2], B1[2][2];
    const int nt = K / BK;
    STG_B(0, 0, cur.Bb); STG_A(0, 0, cur.Ab, cur.va0, cur.va1); STG_B(0, 1, cur.Bb); STG_A(0, 1, cur.Ab, cur.va2, cur.va3);
    if (wr == 1) BAR;
    WAIT_V(4); BAR;
    STG_B(1, 0, cur.Bb + kstep); STG_A(1, 0, cur.Ab + kstep, cur.va0, cur.va1); STG_B(1, 1, cur.Bb + kstep);
    WAIT_V(6); BAR;
    int ui = 0; bool has_next = false;
#pragma unroll 1
    for (;;) {
#pragma unroll 1
        for (int t = 0; t < nt; t += 2) {
            const bool last = (t == nt - 2);
            if (last) { has_next = next(ui + 1, nxt); if (!has_next) nxt = cur; }
            const char* a2 = last ? nxt.Ab : cur.Ab + (size_t)(t + 2) * kstep;
            const char* b2 = last ? nxt.Bb : cur.Bb + (size_t)(t + 2) * kstep;
            const unsigned s0 = last ? nxt.va0 : cur.va0, s1 = last ? nxt.va1 : cur.va1, s2 = last ? nxt.va2 : cur.va2, s3 = last ? nxt.va3 : cur.va3;
            LDB(B0, 0, 0); SCHED; LDA(At, 0, 0); STG_A(1, 1, cur.Ab + (size_t)(t + 1) * kstep, cur.va2, cur.va3);
            WAIT_L(8); BAR; WAIT_L(0); MMA(0, 0, At, B0); BAR; SCHED;
            LDB(B1, 0, 1); STG_B(0, 0, b2);
            BAR; WAIT_L(0); MMA(0, 1, At, B1); BAR;
            LDA(At, 0, 1); STG_A(0, 0, a2, s0, s1);
            BAR; WAIT_L(0); MMA(1, 0, At, B0); BAR; SCHED;
            STG_B(0, 1, b2);
            WAIT_V(6); BAR; MMA(1, 1, At, B1); BAR;
            LDB(B0, 1, 0); SCHED; LDA(At, 1, 0); STG_A(0, 1, a2, s2, s3);
            WAIT_L(8); BAR; WAIT_L(0); MMA(0, 0, At, B0); BAR; SCHED;
            LDB(B1, 1, 1); STG_B(1, 0, b2 + kstep);
            BAR; WAIT_L(0); MMA(0, 1, At, B1); BAR;
            LDA(At, 1, 1); STG_A(1, 0, a2 + kstep, s0, s1);
            BAR; WAIT_L(0); MMA(1, 0, At, B0); BAR; SCHED;
            STG_B(1, 1, b2 + kstep);
            WAIT_V(6); BAR; MMA(1, 1, At, B1); BAR;
        }
        {
            int tq = tz; asm volatile("" : "+v"(tq));
            const int wid_ = tq >> 6, lane_ = tq & 63;
            epi(acc, cur, wid_ >> 2, wid_ & 3, lane_ & 15, lane_ >> 4);
        }
        if (!has_next) break;
        ZACC();
        cur = nxt; ++ui;
    }
    WAIT_V(0);
    if (wr == 0) BAR;
    BAR;
#undef G8_SA
#undef G8_SB
#undef G8_GL
#undef STG_A
#undef STG_B
#undef LDA
#undef LDB
#undef MMA
#undef ZACC
}
#define EPI_FOREACH(acc, wr, wc, fr, fq, ROW, COL, V, ...) \
    _Pragma("unroll") for (int ai_ = 0; ai_ < 2; ++ai_) _Pragma("unroll") for (int m_ = 0; m_ < 4; ++m_) { const int ROW = ai_ * 128 + (wr) * 64 + m_ * 16 + (fr); \
    _Pragma("unroll") for (int bj_ = 0; bj_ < 2; ++bj_) _Pragma("unroll") for (int n_ = 0; n_ < 2; ++n_) { const int COL = bj_ * 128 + (wc) * 32 + n_ * 16 + (fq) * 4; const f32x4 V = acc[ai_][bj_][m_][n_]; __VA_ARGS__ } }

template <class SCol, class DRow, class KS, class NS>
DEVI void convert_T(bf16_t* __restrict__ dst, const float* __restrict__ src, int ld, int K, int NR, SCol scol, DRow drow, KS ks, NS ns, int wi, int nw) {
    const int k8n = K >> 3; const int items = NR * k8n;
    for (int it = wi; it < items; it += nw) {
        const int n = it % NR, k0 = (it / NR) << 3;
        const int sc = scol(n);
        float v[8];
#pragma unroll
        for (int j = 0; j < 8; ++j) v[j] = (sc >= 0) ? src[(size_t)(k0 + j) * ld + sc] * ks(k0 + j) : 0.f;
        const float s = ns(n);
        u32x4 w; w.x = pk2(v[0] * s, v[1] * s); w.y = pk2(v[2] * s, v[3] * s); w.z = pk2(v[4] * s, v[5] * s); w.w = pk2(v[6] * s, v[7] * s);
        *(u32x4*)(dst + (size_t)drow(n) * K + k0) = w;
    }
}
struct IdCol { DEVI int operator()(int n) const { return n; } };
struct OneK { DEVI float operator()(int) const { return 1.f; } };
struct VecK { const float* g; DEVI float operator()(int k) const { return g[k]; } };

DEVI int perm_slot(int cl) { return 16 * ((cl >> 2) & 1) + 4 * (cl >> 3) + (cl & 3); }
template <int NB, bool PERM>
DEVI void convert_panel(bf16_t* __restrict__ dst, const float* __restrict__ src, const int ld, const int K, const int tid) {
    constexpr int N4 = NB / 4;
    const int items = (K >> 3) * N4;
#pragma unroll 1
    for (int it0 = tid; it0 < items; it0 += 1024) {
        f32x4 v[2][8];
#pragma unroll
        for (int u = 0; u < 2; ++u) {
            const int it = it0 + u * 512; const int n4 = it % N4, k8 = it / N4;
            const float* sp = src + (size_t)(k8 * 8) * ld + n4 * 4;
#pragma unroll
            for (int j = 0; j < 8; ++j) v[u][j] = *(const f32x4*)(sp + (size_t)j * ld);
        }
#pragma unroll
        for (int u = 0; u < 2; ++u) {
            const int it = it0 + u * 512; const int n4 = it % N4, k8 = it / N4;
#pragma unroll
            for (int c = 0; c < 4; ++c) {
                u32x4 w; w.x = pk2(v[u][0][c], v[u][1][c]); w.y = pk2(v[u][2][c], v[u][3][c]); w.z = pk2(v[u][4][c], v[u][5][c]); w.w = pk2(v[u][6][c], v[u][7][c]);
                const int n = n4 * 4 + c; const int dr = PERM ? ((n & ~31) + perm_slot(n & 31)) : n;
                *(u32x4*)(dst + (size_t)dr * K + k8 * 8) = w;
            }
        }
    }
}

struct Params {
    const float* in[24];
    float* out;
    unsigned char* ws;
    int ph_lo, ph_hi;
    int flags, pad;
};
enum { I_X = 0, I_C, I_WADA, I_BADA, I_N1G, I_WIN, I_QNG, I_WUQ, I_KVNG, I_WUKV, I_REL, I_AOG, I_BOG, I_WO, I_N2G, I_WR, I_EB, I_W1, I_W3, I_W2, I_WS1, I_WS3, I_WS2, I_FG };
constexpr int NPHASE = 15;

#define W_x (P.in[I_X])
#define W_mod ((float*)(ws + OFF_MOD))
#define W_ropecs ((float*)(ws + OFF_ROPE))
#define W_biasT ((float*)(ws + OFF_BIAS))
#define W_WinT ((bf16_t*)(ws + OFF_WIN))
#define W_WuqT ((bf16_t*)(ws + OFF_WUQ))
#define W_WukvT ((bf16_t*)(ws + OFF_WUKV))
#define W_WoT ((bf16_t*)(ws + OFF_WO))
#define W_WrT ((bf16_t*)(ws + OFF_WR))
#define W_Ws13T ((bf16_t*)(ws + OFF_WS13))
#define W_Ws2T ((bf16_t*)(ws + OFF_WS2))
#define W_hbuf ((bf16_t*)(ws + OFF_H))
#define W_logits ((float*)(ws + OFF_LOGITS))
#define W_eidx ((int*)(ws + OFF_EIDX))
#define W_gate ((float*)(ws + OFF_GATE))
#define W_rnk ((int*)(ws + OFF_RNK))
#define W_pos ((int*)(ws + OFF_POS))
#define W_toks ((int*)(ws + OFF_TOKS))
#define W_wts ((float*)(ws + OFF_WTS))
#define W_ssq ((float*)(ws + OFF_SSQ))
#define W_scr ((bf16_t*)(ws + OFF_SCR + (size_t)blk * 512 * 1024))
#define W_hdn ((bf16_t*)(ws + OFF_HDN))
#define W_ybuf ((bf16_t*)(ws + OFF_Y))
#define W_y8 ((unsigned char*)(ws + OFF_Y))
#define W_proj ((bf16_t*)(ws + OFF_PROJ))
#define W_qb ((bf16_t*)(ws + OFF_QB))
#define W_kvb ((bf16_t*)(ws + OFF_KVB))
#define W_bout ((bf16_t*)(ws + OFF_BOUT))
#define W_aparts ((bf16_t*)(ws + OFF_APARTS))
#define W_lsebuf ((float*)(ws + OFF_LSE))
#define W_mixb ((bf16_t*)(ws + OFF_MIX))

__global__ void __launch_bounds__(512, 2) fwd_kernel(Params P) {
    extern __shared__ __attribute__((aligned(16))) unsigned char lds[];
    const int blk = blockIdx.x, G = gridDim.x;
    const int wave_s = __builtin_amdgcn_readfirstlane((int)threadIdx.x >> 6);
#define TIDS0 int tid; asm volatile("v_mbcnt_lo_u32_b32 %0, -1, 0\n\tv_mbcnt_hi_u32_b32 %0, -1, %0" : "=v"(tid)); tid += wave_s * 64;
    const int vblk = (G % 8 == 0) ? (blk % 8) * (G / 8) + blk / 8 : blk;
    unsigned char* ws = P.ws;
    unsigned* ctl = (unsigned*)(ws + OFF_CTL);
    { TIDS0 if (tid < 64) ((LAS unsigned*)(lds + LDS_MISC))[tid] = 0u; }
    __syncthreads();
    XcdBarrier bar; bar.bar = ctl; bar.x = 0; bar.st = nullptr;
    if (MK_N_LAUNCHES == 1) { TIDS0 bar = xcd_barrier_post(ctl, (volatile LAS unsigned*)(lds + LDS_MISC), tid == 0); }
#ifndef PH_MASK
#define PH_MASK 0xffffffffu
#endif
#define TIDS int tid; asm volatile("v_mbcnt_lo_u32_b32 %0, -1, 0\n\tv_mbcnt_hi_u32_b32 %0, -1, %0" : "=v"(tid)); tid += wave_s * 64; const int lane = tid & 63; const int wave = wave_s; (void)lane; (void)wave;
#define IN(k) ((((PH_MASK) >> (k)) & 1u) && P.ph_lo <= (k) && (k) < P.ph_hi)
#define SEAM(k) do { if (MK_N_LAUNCHES == 1 && IN(k) && IN((k) + 1)) { TIDS0 xcd_barrier(bar, tid == 0); } } while (0)

    unsigned* cntg = ctl + CNT_WORD0;
    LAS unsigned* rowoff = (LAS unsigned*)(lds + LDS_ROWOFF);
    LAS float* rowsc = (LAS float*)(lds + LDS_ROWSC);
    LAS int* startL = (LAS int*)(lds + LDS_START);
    LAS int* cntL = (LAS int*)(lds + LDS_CNT);
    char* stage = (char*)lds + LDS_STAGE;
    LAS unsigned char* ldsL = (LAS unsigned char*)lds;

    if (IN(0)) {
        TIDS
        {
            float* sc = (float*)(lds);
            float* red = (float*)(lds + 32768);
            const float* c = P.in[I_C];
            for (int i = tid; i < 8192; i += 512) sc[i] = siluf(c[i]);
            __syncthreads();
            for (int cb = blk; cb < 256; cb += G) {
                const int cj = tid & 31, kg = tid >> 5;
                float a0 = 0, a1 = 0, a2 = 0, a3 = 0, a4 = 0, a5 = 0, a6 = 0, a7 = 0;
                if (cj < 24) {
                    const float* w = P.in[I_WADA] + cb * 24 + cj;
                    for (int k = kg * 64; k < kg * 64 + 64; ++k) {
                        const float wv = w[(size_t)k * 6144];
                        a0 += sc[k] * wv; a1 += sc[1024 + k] * wv; a2 += sc[2048 + k] * wv; a3 += sc[3072 + k] * wv;
                        a4 += sc[4096 + k] * wv; a5 += sc[5120 + k] * wv; a6 += sc[6144 + k] * wv; a7 += sc[7168 + k] * wv;
                    }
                }
                float* rp = red + (kg * 8) * 32 + cj;
                rp[0] = a0; rp[32] = a1; rp[64] = a2; rp[96] = a3; rp[128] = a4; rp[160] = a5; rp[192] = a6; rp[224] = a7;
                __syncthreads();
                if (tid < 256) {
                    const int b = tid >> 5, j = tid & 31;
                    if (j < 24) {
                        float s = 0.f;
                        for (int g = 0; g < 16; ++g) s += red[(g * 8 + b) * 32 + j];
                        const int col = cb * 24 + j;
                        W_mod[b * 6144 + col] = s + P.in[I_BADA][col];
                    }
                }
                __syncthreads();
            }
        }
        {
            for (int idx = blk * 512 + tid; idx < 4096 * 16; idx += G * 512) {
                const int s = idx >> 4, i = idx & 15;
                double inv = 1.0; for (int j = 0; j < i; ++j) inv *= 0.5623413251903491;
                const float invf = (float)inv;
                const float angf = (float)s * invf;
                const double xa = (double)angf;
                const double nrev = __builtin_rint(xa * 0.15915494309189535);
                const double r = xa - nrev * 6.283185307179586;
                const double r2 = r * r;
                double ts = r, ss = r, tc = 1.0, cc = 1.0;
#pragma unroll
                for (int n = 1; n <= 14; ++n) {
                    ts *= -r2 / (double)((2 * n) * (2 * n + 1)); ss += ts;
                    tc *= -r2 / (double)((2 * n - 1) * (2 * n)); cc += tc;
                }
                W_ropecs[idx * 2] = (float)cc; W_ropecs[idx * 2 + 1] = (float)ss;
            }
        }
        {
            for (int idx = blk * 512 + tid; idx < 3 * 8 * 129; idx += G * 512) {
                const int j = idx % 129, hh = (idx / 129) % 8, p = idx / (129 * 8);
                const int dil = (p == 0) ? 1 : (p == 1 ? 4 : 16);
                const int rel = (j - 64) * dil;
                const int n = rel < 0 ? -rel : rel;
                const float nf = (float)(n > 1 ? n : 1);
                int large = 8 + (int)(__logf(nf * 0.125f) / 4.852030263919617f * 8.0f);
                large = large < 15 ? large : 15;
                const int bucket = (rel > 0 ? 16 : 0) + (n < 8 ? n : large);
                W_biasT[idx] = P.in[I_REL][bucket * 8 + hh] * LOG2E;
            }
        }
        {
            const int wi = blk * 512 + tid, nw = G * 512;
            convert_T(W_WinT, P.in[I_WIN], INC, 1024, INCP,
                      [](int n) { if (n >= INC) return -1; if (n < 2176) return n; const int i = n - 2176; return 2176 + ((i & 1) ? 16 : 0) + (i >> 1); },
                      IdCol{}, OneK{}, [](int n) { return n < 512 ? 0.125f * LOG2E : 1.0f; }, wi, nw);
            convert_T(W_WuqT, P.in[I_WUQ], 768, 384, 768,
                      [](int n) { if (n < 512) return (n >> 6) * 96 + (n & 63); const int hh = (n - 512) >> 5, i = n & 31; return hh * 96 + 64 + ((i & 1) ? 16 : 0) + (i >> 1); },
                      IdCol{}, VecK{P.in[I_QNG]}, [](int) { return 0.10206207261596577f * LOG2E; }, wi, nw);
            convert_T(W_WukvT, P.in[I_WUKV], 1024, 256, 1024, IdCol{}, IdCol{}, VecK{P.in[I_KVNG]}, [](int) { return 1.f; }, wi, nw);
            {
                const float* ag = P.in[I_AOG]; const float* bg = P.in[I_BOG];
                convert_T(W_WoT, P.in[I_WO], 1024, 1024, 1024, IdCol{}, IdCol{}, [=](int k) { return k < 512 ? ag[k] : bg[k - 512]; }, [](int) { return 1.f; }, wi, nw);
            }
            convert_T(W_WrT, P.in[I_WR], 256, 1024, 256, IdCol{}, IdCol{}, OneK{}, [](int) { return 1.f; }, wi, nw);
            convert_T(W_Ws13T, P.in[I_WS1], 256, 1024, 256, IdCol{}, [](int n) { return (n >> 7) * 256 + (n & 127); }, OneK{}, [](int) { return 1.f; }, wi, nw);
            convert_T(W_Ws13T, P.in[I_WS3], 256, 1024, 256, IdCol{}, [](int n) { return (n >> 7) * 256 + 128 + (n & 127); }, OneK{}, [](int) { return 1.f; }, wi, nw);
            convert_T(W_Ws2T, P.in[I_WS2], 1024, 256, 1024, IdCol{}, [](int n) { return (n & ~31) + perm_slot(n & 31); }, OneK{}, [](int) { return 1.f; }, wi, nw);
        }
    }
    SEAM(0);

    if (IN(1)) {
        TIDS
        const float* g = P.in[I_N1G];
        for (int row = blk * 8 + wave; row < NTOK; row += G * 8) {
            const int b = row >> 12;
            const float* xr = W_x + (size_t)row * DM;
            f32x4 v[4]; float ss = 0.f;
#pragma unroll
            for (int i = 0; i < 4; ++i) { v[i] = *(const f32x4*)(xr + i * 256 + lane * 4); ss += v[i][0] * v[i][0] + v[i][1] * v[i][1] + v[i][2] * v[i][2] + v[i][3] * v[i][3]; }
            ss = wave_sum(ss);
            const float rinv = rsqrtf(ss * (1.0f / 1024.0f) + EPS);
            const float* mb = W_mod + b * 6144;
#pragma unroll
            for (int i = 0; i < 4; ++i) {
                const int c = i * 256 + lane * 4;
                const f32x4 gg = *(const f32x4*)(g + c), sh = *(const f32x4*)(mb + c), sc = *(const f32x4*)(mb + 1024 + c);
                float o[4];
#pragma unroll
                for (int j = 0; j < 4; ++j) o[j] = v[i][j] * rinv * gg[j] * (1.0f + sc[j]) + sh[j];
                u32x2 w; w.x = pk2(o[0], o[1]); w.y = pk2(o[2], o[3]);
                *(u32x2*)(W_hbuf + (size_t)row * DM + c) = w;
            }
        }
    }
    SEAM(1);

    if (IN(2)) {
        TIDS
        unsigned vl_[4]; g8_voff_lin(vl_, DM, tid);
        auto nextf = [&](int i, GDesc& d) {
            const int ul = i * 32 + (vblk & 31); if (ul >= 144 || vblk >= 256) return false;
            const int pm = (vblk >> 5) * 16 + ul / 9, pn = ul % 9;
            d.Ab = (const char*)(W_hbuf + (size_t)pm * 256 * DM); d.Bb = (const char*)(W_WinT + (size_t)pn * 256 * DM);
            d.va0 = vl_[0]; d.va1 = vl_[1]; d.va2 = vl_[2]; d.va3 = vl_[3]; d.i0 = pm; d.i1 = pn; return true;
        };
        auto epi = [&](const f32x4 (&acc)[2][2][4][2], const GDesc& d, int wr, int wc, int fr, int fq) {
            const int pm = d.i0, pn = d.i1;
            if (pn < 8) {
                EPI_FOREACH(acc, wr, wc, fr, fq, r, c, v, {
                    u32x2 w; w.x = pk2(v[0], v[1]); w.y = pk2(v[2], v[3]);
                    *(u32x2*)(W_proj + (size_t)(pm * 256 + r) * INCP + pn * 256 + c) = w;
                })
            } else {
                EPI_FOREACH(acc, wr, wc, fr, fq, r, c, v, {
                    const int row = pm * 256 + r;
                    if (c < 160) {
                        float o0 = v[0], o1 = v[1], o2 = v[2], o3 = v[3];
                        if (c >= 128) {
                            const int i = (c - 128) >> 1; const int s = row & 4095;
                            const f32x4 cs = *(const f32x4*)(W_ropecs + (s * 16 + i) * 2);
                            o0 = v[0] * cs[0] - v[1] * cs[1]; o1 = v[1] * cs[0] + v[0] * cs[1];
                            o2 = v[2] * cs[2] - v[3] * cs[3]; o3 = v[3] * cs[2] + v[2] * cs[3];
                        }
                        u32x2 w; w.x = pk2(o0, o1); w.y = pk2(o2, o3);
                        *(u32x2*)(W_proj + (size_t)row * INCP + 2048 + c) = w;
                    }
                })
            }
            if (pn >= 6) {
#pragma unroll
                for (int ai = 0; ai < 2; ++ai)
#pragma unroll
                    for (int m = 0; m < 4; ++m)
#pragma unroll
                        for (int bj = 0; bj < 2; ++bj) {
                            const f32x4 a = acc[ai][bj][m][0], b = acc[ai][bj][m][1];
                            float ss = a[0] * a[0] + a[1] * a[1] + a[2] * a[2] + a[3] * a[3] + b[0] * b[0] + b[1] * b[1] + b[2] * b[2] + b[3] * b[3];
                            { float o; const float t = x16f(ss, o); ss = t + o; }
                            { float o; const float t = x32f(ss, o); ss = t + o; }
                            if (fq == 0) W_ssq[(size_t)(pm * 256 + ai * 128 + wr * 64 + m * 16 + fr) * 24 + (pn - 6) * 8 + bj * 4 + wc] = ss;
                        }
            }
        };
        gemm_stream(ldsL, tid, DM, nextf, epi);
    }
    SEAM(2);

    if (IN(3)) {
        TIDS
        for (int u = blk; u < 128 * 3; u += G) {
            TIDS
            const int pm = u / 3, pn = u % 3;
            __syncthreads();
            if (tid < 256) {
                const float* sp = W_ssq + (size_t)(pm * 256 + tid) * 24;
                const f32x4 s0 = *(const f32x4*)sp, s1 = *(const f32x4*)(sp + 4), s2 = *(const f32x4*)(sp + 8);
                const float ss = ((s0[0] + s0[1]) + (s0[2] + s0[3])) + ((s1[0] + s1[1]) + (s1[2] + s1[3])) + ((s2[0] + s2[1]) + (s2[2] + s2[3]));
                rowsc[tid] = rsqrtf(ss * (1.0f / 384.0f) + EPS);
            }
            __syncthreads();
            const char* aB_ = (const char*)(W_proj + (size_t)pm * 256 * INCP + 1536); unsigned va_[4]; g8_voff_lin(va_, INCP, tid);
            auto epi = [&](const f32x4 (&acc)[2][2][4][2], int wr, int wc, int fr, int fq) {
                if (pn < 2) {
                    EPI_FOREACH(acc, wr, wc, fr, fq, r, c, v, {
                        const float rs = rowsc[r];
                        u32x2 w; w.x = pk2(v[0] * rs, v[1] * rs); w.y = pk2(v[2] * rs, v[3] * rs);
                        *(u32x2*)(W_qb + (size_t)(pm * 256 + r) * 768 + pn * 256 + c) = w;
                    })
                } else {
                    EPI_FOREACH(acc, wr, wc, fr, fq, r, c, v, {
                        const int row = pm * 256 + r;
                        const float rs = rowsc[r];
                        const int i = (c & 31) >> 1; const int s = row & 4095;
                        const f32x4 cs = *(const f32x4*)(W_ropecs + (s * 16 + i) * 2);
                        const float t0 = v[0] * rs, t1 = v[1] * rs, t2 = v[2] * rs, t3 = v[3] * rs;
                        u32x2 w; w.x = pk2(t0 * cs[0] - t1 * cs[1], t1 * cs[0] + t0 * cs[1]); w.y = pk2(t2 * cs[2] - t3 * cs[3], t3 * cs[2] + t2 * cs[3]);
                        *(u32x2*)(W_qb + (size_t)row * 768 + 512 + c) = w;
                    })
                }
            };
            gemm_tile(ldsL, tid, aB_, va_, (const char*)(W_WuqT + (size_t)pn * 256 * QLORA), QLORA, epi);
        }
        for (int u = (blk + 128) % G; u < 128 * 4; u += G) {
            TIDS
            const int pm = u / 4, pn = u % 4;
            __syncthreads();
            if (tid < 256) {
                const float* sp = W_ssq + (size_t)(pm * 256 + tid) * 24 + 12;
                const f32x4 s0 = *(const f32x4*)sp, s1 = *(const f32x4*)(sp + 4);
                const float ss = ((s0[0] + s0[1]) + (s0[2] + s0[3])) + ((s1[0] + s1[1]) + (s1[2] + s1[3]));
                rowsc[tid] = rsqrtf(ss * (1.0f / 256.0f) + EPS);
            }
            __syncthreads();
            const char* aB_ = (const char*)(W_proj + (size_t)pm * 256 * INCP + 1920); unsigned va_[4]; g8_voff_lin(va_, INCP, tid);
            auto epi = [&](const f32x4 (&acc)[2][2][4][2], int wr, int wc, int fr, int fq) {
                EPI_FOREACH(acc, wr, wc, fr, fq, r, c, v, {
                    const int col = pn * 256 + c; const int row = pm * 256 + r;
                    const float rs = rowsc[r];
                    u32x2 w; w.x = pk2(v[0] * rs, v[1] * rs); w.y = pk2(v[2] * rs, v[3] * rs);
                    *(u32x2*)(W_kvb + (size_t)row * 1024 + col) = w;
                })
            };
            gemm_tile(ldsL, tid, aB_, va_, (const char*)(W_WukvT + (size_t)pn * 256 * KVLORA), KVLORA, epi);
        }
    }
    SEAM(3);

    if (IN(4)) {
        for (int ui = 0; ui < ((P.flags & 4) ? 0 : 4); ++ui) {
            TIDS
            const int r32 = lane & 31, hh = lane >> 5;
            if (vblk >= 256) break;
            const int qblk = vblk & 15, bh = (vblk >> 5) * 8 + ui * 2 + ((vblk >> 4) & 1), h = bh & 7, b = bh >> 3;
            const size_t tok0 = (size_t)b * SEQ;
            bf16x8 qf[6];
            {
                const size_t tq = tok0 + qblk * 256 + wave * 32 + r32;
#pragma unroll
                for (int d0 = 0; d0 < 6; ++d0) qf[d0] = *(const bf16x8*)(W_qb + tq * 768 + (d0 < 4 ? h * 64 + d0 * 16 : 512 + h * 32 + (d0 - 4) * 16) + hh * 8);
            }
            f32x16 o0 = {}, o1 = {};
            f32x16 mneg = {};
            float m_run = 0.f, l_run = 0.f;
            const int skey = tid >> 3, sch = tid & 7;
            const bf16_t* kn_src = W_kvb + (tok0 + skey) * 1024 + h * 128 + sch * 8;
            const int pkey = tid >> 2, pch = tid & 3;
            const bf16_t* kp_src = W_proj + (tok0 + pkey) * INCP + 2176 + pch * 8;
            constexpr int KBUF = 12 * 2048, VBUF = 2 * 8192, BUFB = KBUF + VBUF;
            const int k_dst = sch * 2048 + ((skey ^ sch) * 16);
            const int kp_dst = (8 + pch) * 2048 + ((pkey ^ pch) * 16);
            const int v_dst = KBUF + (sch >> 2) * 8192 + skey * 64 + (sch & 3) * 16;
            const int kfo = hh * 2048;
            const int vfo = KBUF + (4 * hh + ((lane & 15) >> 2)) * 64 + ((lane >> 4) & 1) * 32 + (lane & 3) * 8;
            __syncthreads();
            {
                const u32x4 k0 = *(const u32x4*)kn_src, v0 = *(const u32x4*)(kn_src + 64);
                const u32x4 k1 = *(const u32x4*)(kn_src + 64 * 1024), v1 = *(const u32x4*)(kn_src + 64 * 1024 + 64);
                const u32x4 pr = *(const u32x4*)kp_src;
                *(LAS u32x4*)(ldsL + k_dst) = k0; *(LAS u32x4*)(ldsL + k_dst + 1024) = k1;
                *(LAS u32x4*)(ldsL + v_dst) = v0; *(LAS u32x4*)(ldsL + v_dst + 4096) = v1;
                *(LAS u32x4*)(ldsL + kp_dst) = pr;
            }
            __syncthreads();
#pragma unroll 1
            for (int t = 0; t < 32; ++t) {
                const int cur = t & 1;
                const int tn = (t + 1 < 32) ? t + 1 : t;
                const bf16_t* ks = kn_src + (size_t)tn * 128 * 1024;
                const u32x4 nk0 = *(const u32x4*)ks, nv0 = *(const u32x4*)(ks + 64);
                const u32x4 nk1 = *(const u32x4*)(ks + 64 * 1024), nv1 = *(const u32x4*)(ks + 64 * 1024 + 64);
                const u32x4 npr = *(const u32x4*)(kp_src + (size_t)tn * 128 * INCP);
#pragma unroll
                for (int sub = 0; sub < 2; ++sub) {
                    const int kb = cur * BUFB + kfo + sub * 1024, vb = cur * BUFB + vfo + sub * 4096;
                    f32x16 s0, s1;
#pragma unroll
                    for (int d0 = 0; d0 < 6; ++d0) {
                        const int sw = (2 * d0 + hh) & 7;
                        const bf16x8 k0 = *(const LAS bf16x8*)(ldsL + kb + d0 * 4096 + ((r32 ^ sw) * 16));
                        const bf16x8 k1 = *(const LAS bf16x8*)(ldsL + kb + d0 * 4096 + (((32 + r32) ^ sw) * 16));
                        if (d0 == 0) { s0 = __builtin_amdgcn_mfma_f32_32x32x16_bf16(k0, qf[0], mneg, 0, 0, 0); s1 = __builtin_amdgcn_mfma_f32_32x32x16_bf16(k1, qf[0], mneg, 0, 0, 0); }
                        else { s0 = __builtin_amdgcn_mfma_f32_32x32x16_bf16(k0, qf[d0], s0, 0, 0, 0); s1 = __builtin_amdgcn_mfma_f32_32x32x16_bf16(k1, qf[d0], s1, 0, 0, 0); }
                    }
                    float mx = fmaxf(s0[0], s1[0]);
#pragma unroll
                    for (int i = 1; i < 16; ++i) mx = fmaxf(mx, fmaxf(s0[i], s1[i]));
                    mx = max32(mx);
                    const bool first = (t == 0 && sub == 0);
                    if (first || __builtin_amdgcn_ballot_w64(mx > 8.0f) != 0ull) {
                        const float d = first ? mx : fmaxf(mx, 0.f);
                        const float alpha = first ? 0.f : ex2(-d);
                        m_run += d; l_run *= alpha;
#pragma unroll
                        for (int i = 0; i < 16; ++i) { o0[i] *= alpha; o1[i] *= alpha; s0[i] -= d; s1[i] -= d; mneg[i] = -m_run; }
                    }
                    float ps = 0.f;
#pragma unroll
                    for (int i = 0; i < 16; ++i) { s0[i] = ex2(s0[i]); s1[i] = ex2(s1[i]); ps += s0[i] + s1[i]; }
                    l_run += ps;
                    bf16x8 pf[2][2];
#pragma unroll
                    for (int s = 0; s < 2; ++s) {
                        u32x4 w0, w1;
                        w0.x = pk2(s0[8 * s + 0], s0[8 * s + 1]); w0.y = pk2(s0[8 * s + 2], s0[8 * s + 3]); w0.z = pk2(s0[8 * s + 4], s0[8 * s + 5]); w0.w = pk2(s0[8 * s + 6], s0[8 * s + 7]);
                        w1.x = pk2(s1[8 * s + 0], s1[8 * s + 1]); w1.y = pk2(s1[8 * s + 2], s1[8 * s + 3]); w1.z = pk2(s1[8 * s + 4], s1[8 * s + 5]); w1.w = pk2(s1[8 * s + 6], s1[8 * s + 7]);
                        pf[0][s] = __builtin_bit_cast(bf16x8, w0); pf[1][s] = __builtin_bit_cast(bf16x8, w1);
                    }
#pragma unroll
                    for (int n = 0; n < 2; ++n)
#pragma unroll
                        for (int s = 0; s < 2; ++s) {
                            const int ko = (32 * n + 16 * s) * 64;
#pragma unroll
                            for (int db = 0; db < 2; ++db) {
                                const s16x4 lo = __builtin_bit_cast(s16x4, __builtin_amdgcn_ds_read_tr16_b64_v4i16((LAS s16x4*)(ldsL + vb + db * 8192 + ko)));
                                const s16x4 hi = __builtin_bit_cast(s16x4, __builtin_amdgcn_ds_read_tr16_b64_v4i16((LAS s16x4*)(ldsL + vb + db * 8192 + ko + 512)));
                                const bf16x8 vf = {lo[0], lo[1], lo[2], lo[3], hi[0], hi[1], hi[2], hi[3]};
                                if (db == 0) o0 = __builtin_amdgcn_mfma_f32_32x32x16_bf16(vf, pf[n][s], o0, 0, 0, 0);
                                else o1 = __builtin_amdgcn_mfma_f32_32x32x16_bf16(vf, pf[n][s], o1, 0, 0, 0);
                            }
                        }
                }
                {
                    const int nb = (cur ^ 1) * BUFB;
                    *(LAS u32x4*)(ldsL + nb + k_dst) = nk0; *(LAS u32x4*)(ldsL + nb + k_dst + 1024) = nk1;
                    *(LAS u32x4*)(ldsL + nb + v_dst) = nv0; *(LAS u32x4*)(ldsL + nb + v_dst + 4096) = nv1;
                    *(LAS u32x4*)(ldsL + nb + kp_dst) = npr;
                }
                __syncthreads();
            }
            {
                const float lt = sum32(l_run);
                const float inv = 1.0f / lt;
                const int sc = 81920 + wave * 4352;
#pragma unroll
                for (int g = 0; g < 4; ++g) {
                    u32x2 w;
                    w.x = pk2(o0[4 * g] * inv, o0[4 * g + 1] * inv); w.y = pk2(o0[4 * g + 2] * inv, o0[4 * g + 3] * inv);
                    *(LAS u32x2*)(ldsL + sc + r32 * 136 + (8 * g + 4 * hh) * 2) = w;
                    w.x = pk2(o1[4 * g] * inv, o1[4 * g + 1] * inv); w.y = pk2(o1[4 * g + 2] * inv, o1[4 * g + 3] * inv);
                    *(LAS u32x2*)(ldsL + sc + r32 * 136 + (32 + 8 * g + 4 * hh) * 2) = w;
                }
                __syncthreads();
#pragma unroll
                for (int it = 0; it < 8; ++it) {
                    const int row = it * 4 + (lane >> 4), pc = lane & 15;
                    const u32x2 w = *(const LAS u32x2*)(ldsL + sc + row * 136 + pc * 8);
                    *(u32x2*)(W_bout + (tok0 + qblk * 256 + wave * 32 + row) * 512 + h * 64 + pc * 4) = w;
                }
            }
        }
        for (int ui = 0; ui < ((P.flags & 8) ? 0 : 12); ++ui) {
            TIDS
            const int r32 = lane & 31, hh = lane >> 5;
            const int u = vblk * 12 + ui;
            if (u >= 3072) break;
            const int bh = u / 48, w48 = u % 48, h = bh & 7, b = bh >> 3;
            const int p = w48 >> 4, j16 = w48 & 15;
            const int dil = (p == 0) ? 1 : (p == 1 ? 4 : 16);
            const int res = (p == 0) ? 0 : (p == 1 ? (j16 >> 2) : j16);
            const int m0 = (p == 0) ? j16 * 256 : (p == 1 ? (j16 & 3) * 256 : 0);
            const int L = SEQ / dil;
            const size_t tok0 = (size_t)b * SEQ;
            __syncthreads();
            if (tid < 129) *(LAS float*)(ldsL + 98304 + tid * 4) = W_biasT[(p * 8 + h) * 129 + tid];
#pragma unroll 2
            for (int it = 0; it < 6; ++it) {
                const int idx = it * 512 + tid, row = idx >> 3, ch = idx & 7;
                const int mk = m0 - 64 + row;
                u32x4 kr = {0, 0, 0, 0}, vr = {0, 0, 0, 0};
                if (mk >= 0 && mk < L) {
                    const bf16_t* src = W_proj + (tok0 + (size_t)mk * dil + res) * INCP + 512 + h * 64 + ch * 8;
                    kr = *(const u32x4*)src; vr = *(const u32x4*)(src + 512);
                }
                *(LAS u32x4*)(ldsL + ch * 6144 + ((row ^ ch) * 16)) = kr;
                *(LAS u32x4*)(ldsL + 49152 + (ch >> 2) * 24576 + row * 64 + (ch & 3) * 16) = vr;
            }
            const int qrel = wave * 32 + r32;
            const size_t tq = tok0 + (size_t)(m0 + qrel) * dil + res;
            bf16x8 qf[4];
#pragma unroll
            for (int d0 = 0; d0 < 4; ++d0) qf[d0] = *(const bf16x8*)(W_proj + tq * INCP + h * 64 + d0 * 16 + hh * 8);
            __syncthreads();
            f32x16 o0 = {}, o1 = {};
            float m_run = -1e30f, l_run = 0.f;
            const int vfo = 49152 + (4 * hh + ((lane & 15) >> 2)) * 64 + ((lane >> 4) & 1) * 32 + (lane & 3) * 8;
#pragma unroll 1
            for (int jj = 0; jj < 3; ++jj) {
                const int jt = (wave >> 1) + jj;
                f32x16 s0 = {}, s1 = {};
#pragma unroll
                for (int d0 = 0; d0 < 4; ++d0) {
                    const int ch = 2 * d0 + hh;
                    const bf16x8 k0 = *(const LAS bf16x8*)(ldsL + ch * 6144 + (((64 * jt + r32) ^ ch) * 16));
                    const bf16x8 k1 = *(const LAS bf16x8*)(ldsL + ch * 6144 + (((64 * jt + 32 + r32) ^ ch) * 16));
                    s0 = __builtin_amdgcn_mfma_f32_32x32x16_bf16(k0, qf[d0], s0, 0, 0, 0);
                    s1 = __builtin_amdgcn_mfma_f32_32x32x16_bf16(k1, qf[d0], s1, 0, 0, 0);
                }
                float mx = -1e30f;
#pragma unroll
                for (int i = 0; i < 16; ++i) {
                    const int cr = (i & 3) + 8 * (i >> 2) + 4 * hh;
                    const int i0 = 64 * jt + cr, i1 = i0 + 32;
                    const int oi0 = i0 - qrel, oi1 = i1 - qrel;
                    const int mk0 = m0 - 64 + i0, mk1 = mk0 + 32;
                    const bool v0 = (oi0 >= 0) && (oi0 <= 128) && (mk0 >= 0) && (mk0 < L);
                    const bool v1 = (oi1 >= 0) && (oi1 <= 128) && (mk1 >= 0) && (mk1 < L);
                    const float b0 = *(const LAS float*)(ldsL + 98304 + (v0 ? oi0 : 0) * 4);
                    const float b1 = *(const LAS float*)(ldsL + 98304 + (v1 ? oi1 : 0) * 4);
                    s0[i] = v0 ? s0[i] + b0 : -1e30f;
                    s1[i] = v1 ? s1[i] + b1 : -1e30f;
                    mx = fmaxf(mx, fmaxf(s0[i], s1[i]));
                }
                mx = max32(mx);
                const float m_new = fmaxf(m_run, mx);
                const float alpha = ex2(m_run - m_new);
                m_run = m_new;
                float ps = 0.f;
#pragma unroll
                for (int i = 0; i < 16; ++i) {
                    s0[i] = (s0[i] > -1e29f) ? ex2(s0[i] - m_new) : 0.f;
                    s1[i] = (s1[i] > -1e29f) ? ex2(s1[i] - m_new) : 0.f;
                    ps += s0[i] + s1[i];
                }
                l_run = l_run * alpha + ps;
#pragma unroll
                for (int i = 0; i < 16; ++i) { o0[i] *= alpha; o1[i] *= alpha; }
                bf16x8 pf[2][2];
#pragma unroll
                for (int s = 0; s < 2; ++s) {
                    u32x4 w0, w1;
                    w0.x = pk2(s0[8 * s + 0], s0[8 * s + 1]); w0.y = pk2(s0[8 * s + 2], s0[8 * s + 3]); w0.z = pk2(s0[8 * s + 4], s0[8 * s + 5]); w0.w = pk2(s0[8 * s + 6], s0[8 * s + 7]);
                    w1.x = pk2(s1[8 * s + 0], s1[8 * s + 1]); w1.y = pk2(s1[8 * s + 2], s1[8 * s + 3]); w1.z = pk2(s1[8 * s + 4], s1[8 * s + 5]); w1.w = pk2(s1[8 * s + 6], s1[8 * s + 7]);
                    pf[0][s] = __builtin_bit_cast(bf16x8, w0); pf[1][s] = __builtin_bit_cast(bf16x8, w1);
                }
#pragma unroll
                for (int n = 0; n < 2; ++n)
#pragma unroll
                    for (int s = 0; s < 2; ++s) {
                        const int ko = (64 * jt + 32 * n + 16 * s) * 64;
#pragma unroll
                        for (int db = 0; db < 2; ++db) {
                            const s16x4 lo = __builtin_bit_cast(s16x4, __builtin_amdgcn_ds_read_tr16_b64_v4i16((LAS s16x4*)(ldsL + vfo + db * 24576 + ko)));
                            const s16x4 hi = __builtin_bit_cast(s16x4, __builtin_amdgcn_ds_read_tr16_b64_v4i16((LAS s16x4*)(ldsL + vfo + db * 24576 + ko + 512)));
                            const bf16x8 vf = {lo[0], lo[1], lo[2], lo[3], hi[0], hi[1], hi[2], hi[3]};
                            if (db == 0) o0 = __builtin_amdgcn_mfma_f32_32x32x16_bf16(vf, pf[n][s], o0, 0, 0, 0);
                            else o1 = __builtin_amdgcn_mfma_f32_32x32x16_bf16(vf, pf[n][s], o1, 0, 0, 0);
                        }
                    }
            }
            __syncthreads();
            {
                const float lt = sum32(l_run);
                const float inv = 1.0f / lt;
                if (hh == 0) W_lsebuf[((size_t)p * NTOK + tq) * 8 + h] = m_run + __log2f(lt);
                const int sc = wave * 4352;
#pragma unroll
                for (int g = 0; g < 4; ++g) {
                    u32x2 w;
                    w.x = pk2(o0[4 * g] * inv, o0[4 * g + 1] * inv); w.y = pk2(o0[4 * g + 2] * inv, o0[4 * g + 3] * inv);
                    *(LAS u32x2*)(ldsL + sc + r32 * 136 + (8 * g + 4 * hh) * 2) = w;
                    w.x = pk2(o1[4 * g] * inv, o1[4 * g + 1] * inv); w.y = pk2(o1[4 * g + 2] * inv, o1[4 * g + 3] * inv);
                    *(LAS u32x2*)(ldsL + sc + r32 * 136 + (32 + 8 * g + 4 * hh) * 2) = w;
                }
                __syncthreads();
#pragma unroll
                for (int it = 0; it < 8; ++it) {
                    const int row = it * 4 + (lane >> 4), pc = lane & 15;
                    const u32x2 w = *(const LAS u32x2*)(ldsL + sc + row * 136 + pc * 8);
                    const size_t tr = tok0 + (size_t)(m0 + wave * 32 + row) * dil + res;
                    *(u32x2*)(W_aparts + ((size_t)p * NTOK + tr) * 512 + h * 64 + pc * 4) = w;
                }
            }
        }
    }
    SEAM(4);

    if (IN(5)) {
        TIDS
        for (int row = blk * 8 + wave; row < NTOK; row += G * 8) {
            const int hd = lane >> 3;
            float ls0 = W_lsebuf[((size_t)0 * NTOK + row) * 8 + hd], ls1 = W_lsebuf[((size_t)1 * NTOK + row) * 8 + hd], ls2 = W_lsebuf[((size_t)2 * NTOK + row) * 8 + hd];
            const float M = fmaxf(ls0, fmaxf(ls1, ls2));
            float w0 = ex2(ls0 - M), w1 = ex2(ls1 - M), w2 = ex2(ls2 - M);
            const float wsn = 1.0f / (w0 + w1 + w2); w0 *= wsn; w1 *= wsn; w2 *= wsn;
            const u32x4 a0 = *(const u32x4*)(W_aparts + ((size_t)0 * NTOK + row) * 512 + lane * 8);
            const u32x4 a1 = *(const u32x4*)(W_aparts + ((size_t)1 * NTOK + row) * 512 + lane * 8);
            const u32x4 a2 = *(const u32x4*)(W_aparts + ((size_t)2 * NTOK + row) * 512 + lane * 8);
            const u32x4 bb = *(const u32x4*)(W_bout + (size_t)row * 512 + lane * 8);
            float av[8], bv[8]; float sa = 0.f, sb = 0.f;
#pragma unroll
            for (int j = 0; j < 4; ++j) {
                av[2 * j] = w0 * __uint_as_float(a0[j] << 16) + w1 * __uint_as_float(a1[j] << 16) + w2 * __uint_as_float(a2[j] << 16);
                av[2 * j + 1] = w0 * __uint_as_float(a0[j] & 0xffff0000u) + w1 * __uint_as_float(a1[j] & 0xffff0000u) + w2 * __uint_as_float(a2[j] & 0xffff0000u);
                bv[2 * j] = __uint_as_float(bb[j] << 16); bv[2 * j + 1] = __uint_as_float(bb[j] & 0xffff0000u);
                sa += av[2 * j] * av[2 * j] + av[2 * j + 1] * av[2 * j + 1];
                sb += bv[2 * j] * bv[2 * j] + bv[2 * j + 1] * bv[2 * j + 1];
            }
            sa = wave_sum(sa); sb = wave_sum(sb);
            const float ra = rsqrtf(sa * (1.0f / 512.0f) + EPS), rb = rsqrtf(sb * (1.0f / 512.0f) + EPS);
            u32x4 wa, wb;
            wa.x = pk2(av[0] * ra, av[1] * ra); wa.y = pk2(av[2] * ra, av[3] * ra); wa.z = pk2(av[4] * ra, av[5] * ra); wa.w = pk2(av[6] * ra, av[7] * ra);
            wb.x = pk2(bv[0] * rb, bv[1] * rb); wb.y = pk2(bv[2] * rb, bv[3] * rb); wb.z = pk2(bv[4] * rb, bv[5] * rb); wb.w = pk2(bv[6] * rb, bv[7] * rb);
            *(u32x4*)(W_mixb + (size_t)row * DM + lane * 8) = wa;
            *(u32x4*)(W_mixb + (size_t)row * DM + 512 + lane * 8) = wb;
        }
    }
    SEAM(5);

    if (IN(6)) {
        TIDS
        for (int u = blk; u < 128 * 4; u += G) {
            const int pm = u >> 2, pn = u & 3;
            const char* aB_ = (const char*)(W_mixb + (size_t)pm * 256 * DM); unsigned va_[4]; g8_voff_lin(va_, DM, tid);
            auto epi = [&](const f32x4 (&acc)[2][2][4][2], int wr, int wc, int fr, int fq) {
                EPI_FOREACH(acc, wr, wc, fr, fq, r, c, v, {
                    const int col = pn * 256 + c; const int row = pm * 256 + r;
                    const f32x4 xv = *(const f32x4*)(W_x + (size_t)row * DM + col);
                    const f32x4 g1 = *(const f32x4*)(W_mod + (row >> 12) * 6144 + 2048 + col);
                    f32x4 o; o[0] = xv[0] + g1[0] * v[0]; o[1] = xv[1] + g1[1] * v[1]; o[2] = xv[2] + g1[2] * v[2]; o[3] = xv[3] + g1[3] * v[3];
                    *(f32x4*)(P.out + (size_t)row * DM + col) = o;
                })
            };
            gemm_tile(ldsL, tid, aB_, va_, (const char*)(W_WoT + (size_t)pn * 256 * DM), DM, epi);
        }
    }
    SEAM(6);

    if (IN(7)) {
        TIDS
        const float* g = P.in[I_N2G];
        for (int row = blk * 8 + wave; row < NTOK; row += G * 8) {
            const int b = row >> 12;
            const float* xr = P.out + (size_t)row * DM;
            f32x4 v[4]; float ss = 0.f;
#pragma unroll
            for (int i = 0; i < 4; ++i) { v[i] = *(const f32x4*)(xr + i * 256 + lane * 4); ss += v[i][0] * v[i][0] + v[i][1] * v[i][1] + v[i][2] * v[i][2] + v[i][3] * v[i][3]; }
            ss = wave_sum(ss);
            const float rinv = rsqrtf(ss * (1.0f / 1024.0f) + EPS);
            const float* mb = W_mod + b * 6144 + 3072;
#pragma unroll
            for (int i = 0; i < 4; ++i) {
                const int c = i * 256 + lane * 4;
                const f32x4 gg = *(const f32x4*)(g + c), sh = *(const f32x4*)(mb + c), sc = *(const f32x4*)(mb + 1024 + c);
                float o[4];
#pragma unroll
                for (int j = 0; j < 4; ++j) o[j] = v[i][j] * rinv * gg[j] * (1.0f + sc[j]) + sh[j];
                u32x2 w; w.x = pk2(o[0], o[1]); w.y = pk2(o[2], o[3]);
                *(u32x2*)(W_hbuf + (size_t)row * DM + c) = w;
            }
        }
    }
    SEAM(7);

    if (IN(8)) {
        TIDS
        for (int u = blk; u < 256; u += G) {
            const int pm = u >> 1, pn = u & 1;
            const char* aB_ = (const char*)(W_hbuf + (size_t)pm * 256 * DM); unsigned va_[4]; g8_voff_lin(va_, DM, tid);
            auto epi = [&](const f32x4 (&acc)[2][2][4][2], int wr, int wc, int fr, int fq) {
#pragma unroll
                for (int ai = 0; ai < 2; ++ai)
#pragma unroll
                    for (int m = 0; m < 4; ++m) {
                        const int r = ai * 128 + wr * 64 + m * 16 + fr;
#pragma unroll
                        for (int n = 0; n < 2; ++n) {
                            const f32x4 a = acc[ai][0][m][n], bq = acc[ai][1][m][n];
                            const int c = wc * 32 + n * 16 + fq * 4;
                            u32x2 w; w.x = pk2(siluf(a[0]) * bq[0], siluf(a[1]) * bq[1]); w.y = pk2(siluf(a[2]) * bq[2], siluf(a[3]) * bq[3]);
                            *(u32x2*)(W_hdn + (size_t)(NASG + pm * 256 + r) * EFF + pn * 128 + c) = w;
                        }
                        __builtin_amdgcn_sched_barrier(0);
                    }
            };
            gemm_tile(ldsL, tid, aB_, va_, (const char*)(W_Ws13T + (size_t)pn * 256 * DM), DM, epi);
        }
        for (int u = (blk + 128) % G; u < 128; u += G) {
            const int pm = u;
            const char* aB_ = (const char*)(W_hbuf + (size_t)pm * 256 * DM); unsigned va_[4]; g8_voff_lin(va_, DM, tid);
            auto epi = [&](const f32x4 (&acc)[2][2][4][2], int wr, int wc, int fr, int fq) {
                EPI_FOREACH(acc, wr, wc, fr, fq, r, c, v, {
                    *(f32x4*)(W_logits + (size_t)(pm * 256 + r) * 256 + c) = v;
                })
            };
            gemm_tile(ldsL, tid, aB_, va_, (const char*)(W_WrT), DM, epi);
        }
    }
    SEAM(8);

    if (IN(9)) {
        TIDS
        const float* ebias = P.in[I_EB];
        const f32x4 eb = *(const f32x4*)(ebias + lane * 4);
        for (int t = blk * 8 + wave; t < NTOK; t += G * 8) {
            const f32x4 lg = *(const f32x4*)(W_logits + (size_t)t * 256 + lane * 4);
            float sc[4], sel[4];
#pragma unroll
            for (int i = 0; i < 4; ++i) { sc[i] = 1.0f / (1.0f + expf(-lg[i])); sel[i] = sc[i] + eb[i]; }
            float a1 = fmaxf(sel[0], sel[1]), a2 = fminf(sel[0], sel[1]);
#pragma unroll
            for (int i = 2; i < 4; ++i) { const float v = sel[i]; a2 = fmaxf(a2, fminf(a1, v)); a1 = fmaxf(a1, v); }
            {
                float b1, b2, n1, n2;
                b1 = dppf(a1, DPP_X1); b2 = dppf(a2, DPP_X1); n1 = fmaxf(a1, b1); n2 = fmaxf(fminf(a1, b1), fmaxf(a2, b2)); a1 = n1; a2 = n2;
                b1 = dppf(a1, DPP_X2); b2 = dppf(a2, DPP_X2); n1 = fmaxf(a1, b1); n2 = fmaxf(fminf(a1, b1), fmaxf(a2, b2)); a1 = n1; a2 = n2;
                b1 = dppf(a1, DPP_HM); b2 = dppf(a2, DPP_HM); n1 = fmaxf(a1, b1); n2 = fmaxf(fminf(a1, b1), fmaxf(a2, b2)); a1 = n1; a2 = n2;
            }
            const float gs = a1 + a2; const int myg = lane >> 3;
            int rank = 0;
#pragma unroll
            for (int g = 0; g < 8; ++g) { const float v = __int_as_float(__builtin_amdgcn_readlane(__float_as_int(gs), g * 8)); rank += (v > gs || (v == gs && g < myg)) ? 1 : 0; }
            const bool gsel = rank < 4;
            float cand[4];
#pragma unroll
            for (int i = 0; i < 4; ++i) cand[i] = gsel ? sel[i] : -INFINITY;
            int my_e = 0; float my_g = 0.f; float gsum = 0.f;
#pragma unroll
            for (int k = 0; k < 8; ++k) {
                float bv = cand[0]; int bi = 0;
#pragma unroll
                for (int i = 1; i < 4; ++i) if (cand[i] > bv) { bv = cand[i]; bi = i; }
                float v = bv; int ix = lane * 4 + bi;
#define AMX(ov, oi) do { const float ov_ = (ov); const int oi_ = (oi); if (ov_ > v || (ov_ == v && oi_ < ix)) { v = ov_; ix = oi_; } } while (0)
                AMX(dppf(v, DPP_X1), dppi(ix, DPP_X1)); AMX(dppf(v, DPP_X2), dppi(ix, DPP_X2)); AMX(dppf(v, DPP_HM), dppi(ix, DPP_HM)); AMX(dppf(v, DPP_RM), dppi(ix, DPP_RM));
                { auto rv = __builtin_amdgcn_permlane16_swap(__float_as_uint(v), __float_as_uint(v), false, false); auto ri = __builtin_amdgcn_permlane16_swap((unsigned)ix, (unsigned)ix, false, false);
                  v = __uint_as_float(rv[0]); ix = (int)ri[0]; AMX(__uint_as_float(rv[1]), (int)ri[1]); }
                { auto rv = __builtin_amdgcn_permlane32_swap(__float_as_uint(v), __float_as_uint(v), false, false); auto ri = __builtin_amdgcn_permlane32_swap((unsigned)ix, (unsigned)ix, false, false);
                  v = __uint_as_float(rv[0]); ix = (int)ri[0]; AMX(__uint_as_float(rv[1]), (int)ri[1]); }
#undef AMX
                ix = __builtin_amdgcn_readfirstlane(ix);
                float myscore = 0.f;
#pragma unroll
                for (int i = 0; i < 4; ++i) if (lane * 4 + i == ix) { cand[i] = -INFINITY; myscore = sc[i]; }
                const float gw = __int_as_float(__builtin_amdgcn_readlane(__float_as_int(myscore), ix >> 2));
                gsum += gw;
                if (lane == k) { my_e = ix; my_g = gw; }
            }
            if (lane < 8) {
                const unsigned rk = atomicAdd(&cntg[my_e * CNT_STRIDE], 1u);
                W_eidx[t * 8 + lane] = my_e; W_gate[t * 8 + lane] = my_g / gsum * 2.5f; W_rnk[t * 8 + lane] = (int)rk;
            }
        }
    }
    SEAM(9);

    if (IN(10)) {
        TIDS
        if (tid < 256) cntL[tid] = (int)__hip_atomic_load(&cntg[tid * CNT_STRIDE], __ATOMIC_RELAXED, __HIP_MEMORY_SCOPE_AGENT);
        __syncthreads();
        if (tid < 256) { int s = 0; for (int j = 0; j < tid; ++j) s += cntL[j]; startL[tid] = s; }
        __syncthreads();
        for (int t = blk * 8 + wave; t < NTOK; t += G * 8) {
            if (lane < 8) {
                const int e = W_eidx[t * 8 + lane];
                const int d = startL[e] + W_rnk[t * 8 + lane];
                W_toks[d] = t; W_wts[d] = W_gate[t * 8 + lane]; W_pos[t * 8 + lane] = d;
            }
        }
    }
    SEAM(10);

    if (IN(11)) {
        TIDS
        __syncthreads();
        if (tid < 256) cntL[tid] = (int)__hip_atomic_load(&cntg[tid * CNT_STRIDE], __ATOMIC_RELAXED, __HIP_MEMORY_SCOPE_AGENT);
        __syncthreads();
        if (tid < 256) { int s = 0; for (int j = 0; j < tid; ++j) s += cntL[j]; startL[tid] = s; }
        __syncthreads();
        for (int ui = blk; ui < 512; ui += G) {
            TIDS
            const int e = (G == 256) ? ((vblk & ~1) + (ui >> 8)) : (ui >> 1), pn = (G == 256) ? (vblk & 1) : (ui & 1);
            const int cnt = cntL[e], st = startL[e];
            if (cnt == 0) continue;
            __syncthreads();
            if (!(P.flags & 1)) {
            convert_panel<128, false>(W_scr, P.in[I_W1] + (size_t)e * 1024 * 256 + pn * 128, 256, 1024, tid);
            convert_panel<128, false>(W_scr + 128 * 1024, P.in[I_W3] + (size_t)e * 1024 * 256 + pn * 128, 256, 1024, tid);
            }
            asm volatile("s_waitcnt vmcnt(0)" ::: "memory");
            const int ntile = (P.flags & 2) ? 0 : ((cnt + 255) >> 8);
            for (int c0 = 0; c0 < ntile; c0 += 8) {
                TIDS
                const int nch = (ntile - c0) < 8 ? (ntile - c0) : 8;
                __syncthreads();
                for (int idx = tid; idx < nch * 256; idx += 512) { const int rr = c0 * 256 + idx; const int sr = st + (rr < cnt ? rr : 0); rowoff[idx] = (unsigned)W_toks[sr] * DM; }
                __syncthreads();
                int R0, C0; g8_rc(tid, R0, C0);
                auto nextf = [&](int i, GDesc& d) {
                    if (i >= nch) return false;
                    d.Ab = (const char*)W_hbuf; d.Bb = (const char*)W_scr;
                    d.va0 = (rowoff[i * 256 + R0] + C0) * 2u; d.va1 = (rowoff[i * 256 + R0 + 64] + C0) * 2u; d.va2 = (rowoff[i * 256 + R0 + 128] + C0) * 2u; d.va3 = (rowoff[i * 256 + R0 + 192] + C0) * 2u;
                    d.i0 = c0 + i; d.i1 = 0; return true;
                };
                auto epi = [&](const f32x4 (&acc)[2][2][4][2], const GDesc& d, int wr, int wc, int fr, int fq) {
                    const int ti = d.i0;
#pragma unroll
                    for (int ai = 0; ai < 2; ++ai)
#pragma unroll
                        for (int m = 0; m < 4; ++m) {
                            const int r = ai * 128 + wr * 64 + m * 16 + fr;
                            const int rr = ti * 256 + r;
                            if (rr < cnt) {
#pragma unroll
                                for (int n = 0; n < 2; ++n) {
                                    const f32x4 a = acc[ai][0][m][n], bq = acc[ai][1][m][n];
                                    const int c = wc * 32 + n * 16 + fq * 4;
                                    u32x2 w; w.x = pk2(siluf(a[0]) * bq[0], siluf(a[1]) * bq[1]); w.y = pk2(siluf(a[2]) * bq[2], siluf(a[3]) * bq[3]);
                                    *(u32x2*)(W_hdn + (size_t)(st + rr) * EFF + pn * 128 + c) = w;
                                }
                            }
                        }
                };
                gemm_stream(ldsL, tid, DM, nextf, epi);
            }
        }
    }
    SEAM(11);

    if (IN(12)) {
        TIDS
        __syncthreads();
        if (tid < 256) cntL[tid] = (int)__hip_atomic_load(&cntg[tid * CNT_STRIDE], __ATOMIC_RELAXED, __HIP_MEMORY_SCOPE_AGENT);
        __syncthreads();
        if (tid < 256) { int s = 0; for (int j = 0; j < tid; ++j) s += cntL[j]; startL[tid] = s; }
        __syncthreads();
#define Y_STORE(ROWG, COL0, G_) do { _Pragma("unroll") for (int bj = 0; bj < 2; ++bj) { const f32x4 a_ = acc[ai][bj][m][0], b_ = acc[ai][bj][m][1]; int w0_ = 0, w1_ = 0; \
            w0_ = __builtin_amdgcn_cvt_pk_fp8_f32(a_[0] * (G_), a_[1] * (G_), w0_, false); w0_ = __builtin_amdgcn_cvt_pk_fp8_f32(a_[2] * (G_), a_[3] * (G_), w0_, true); \
            w1_ = __builtin_amdgcn_cvt_pk_fp8_f32(b_[0] * (G_), b_[1] * (G_), w1_, false); w1_ = __builtin_amdgcn_cvt_pk_fp8_f32(b_[2] * (G_), b_[3] * (G_), w1_, true); \
            u32x2 w_; w_.x = (unsigned)w0_; w_.y = (unsigned)w1_; *(u32x2*)(W_y8 + (size_t)(ROWG) * DM + (COL0) + bj * 128 + wc * 32 + fq * 8) = w_; } } while (0)
        for (int ui = blk; ui < 1024; ui += G) {
            TIDS
            const int e = (G == 256) ? ((vblk & ~3) + (ui >> 8)) : (ui >> 2), pn = (G == 256) ? (vblk & 3) : (ui & 3);
            const int cnt = cntL[e], st = startL[e];
            if (cnt == 0) continue;
            __syncthreads();
            if (!(P.flags & 1)) convert_panel<256, true>(W_scr, P.in[I_W2] + (size_t)e * 256 * 1024 + pn * 256, 1024, 256, tid);
            asm volatile("s_waitcnt vmcnt(0)" ::: "memory");
            const int ntile = (P.flags & 2) ? 0 : ((cnt + 255) >> 8);
            for (int c0 = 0; c0 < ntile; c0 += 8) {
                TIDS
                const int nch = (ntile - c0) < 8 ? (ntile - c0) : 8;
                __syncthreads();
                for (int idx = tid; idx < nch * 256; idx += 512) { const int rr = c0 * 256 + idx; const int sr = st + (rr < cnt ? rr : 0); rowoff[idx] = (unsigned)sr * EFF; rowsc[idx] = W_wts[sr]; }
                __syncthreads();
                int R0, C0; g8_rc(tid, R0, C0);
                auto nextf = [&](int i, GDesc& d) {
                    if (i >= nch) return false;
                    d.Ab = (const char*)W_hdn; d.Bb = (const char*)W_scr;
                    d.va0 = (rowoff[i * 256 + R0] + C0) * 2u; d.va1 = (rowoff[i * 256 + R0 + 64] + C0) * 2u; d.va2 = (rowoff[i * 256 + R0 + 128] + C0) * 2u; d.va3 = (rowoff[i * 256 + R0 + 192] + C0) * 2u;
                    d.i0 = c0 + i; d.i1 = i; return true;
                };
                auto epi = [&](const f32x4 (&acc)[2][2][4][2], const GDesc& d, int wr, int wc, int fr, int fq) {
                    const int ti = d.i0, tl = d.i1;
#pragma unroll
                    for (int ai = 0; ai < 2; ++ai)
#pragma unroll
                        for (int m = 0; m < 4; ++m) {
                            const int r = ai * 128 + wr * 64 + m * 16 + fr;
                            const int rr = ti * 256 + r;
                            if (rr < cnt) { const float g = rowsc[tl * 256 + r]; Y_STORE(st + rr, pn * 256, g); }
                        }
                };
                gemm_stream(ldsL, tid, EFF, nextf, epi);
            }
        }
        {
            TIDS
            unsigned vl_[4]; g8_voff_lin(vl_, EFF, tid);
            auto nextf = [&](int i, GDesc& d) {
                const int u = blk + i * G; if (u >= 512) return false;
                const int pm = u >> 2, pn = u & 3;
                d.Ab = (const char*)(W_hdn + (size_t)(NASG + pm * 256) * EFF); d.Bb = (const char*)(W_Ws2T + (size_t)pn * 256 * EFF);
                d.va0 = vl_[0]; d.va1 = vl_[1]; d.va2 = vl_[2]; d.va3 = vl_[3]; d.i0 = pm; d.i1 = pn; return true;
            };
            auto epi = [&](const f32x4 (&acc)[2][2][4][2], const GDesc& d, int wr, int wc, int fr, int fq) {
                const int pm = d.i0, pn = d.i1;
#pragma unroll
                for (int ai = 0; ai < 2; ++ai)
#pragma unroll
                    for (int m = 0; m < 4; ++m) {
                        const int r = ai * 128 + wr * 64 + m * 16 + fr;
                        Y_STORE(NASG + pm * 256 + r, pn * 256, 1.0f);
                    }
            };
            gemm_stream(ldsL, tid, EFF, nextf, epi);
        }
#undef Y_STORE
    }
    SEAM(12);

    if (IN(13)) {
        TIDS
        const float* fg = P.in[I_FG];
        for (int row = blk * 8 + wave; row < NTOK; row += G * 8) {
            const int b = row >> 12;
            float a[16];
#pragma unroll
            for (int j = 0; j < 16; ++j) a[j] = 0.f;
#pragma unroll
            for (int k = 0; k < 9; ++k) {
                const int pr = (k < 8) ? W_pos[row * 8 + k] : (NASG + row);
                const u32x4 w = *(const u32x4*)(W_y8 + (size_t)pr * DM + lane * 16);
#pragma unroll
                for (int q = 0; q < 4; ++q) {
                    a[4 * q + 0] += __builtin_amdgcn_cvt_f32_fp8((int)w[q], 0); a[4 * q + 1] += __builtin_amdgcn_cvt_f32_fp8((int)w[q], 1);
                    a[4 * q + 2] += __builtin_amdgcn_cvt_f32_fp8((int)w[q], 2); a[4 * q + 3] += __builtin_amdgcn_cvt_f32_fp8((int)w[q], 3);
                }
            }
            float* xr = P.out + (size_t)row * DM + lane * 16;
            const float* g2 = W_mod + b * 6144 + 5120 + lane * 16;
            float v[16]; float ss = 0.f;
#pragma unroll
            for (int q = 0; q < 4; ++q) {
                const f32x4 xa = *(const f32x4*)(xr + q * 4), ga = *(const f32x4*)(g2 + q * 4);
#pragma unroll
                for (int j = 0; j < 4; ++j) { v[q * 4 + j] = xa[j] + ga[j] * a[q * 4 + j]; ss += v[q * 4 + j] * v[q * 4 + j]; }
            }
            ss = wave_sum(ss);
            const float rinv = rsqrtf(ss * (1.0f / 1024.0f) + EPS);
#pragma unroll
            for (int q = 0; q < 4; ++q) {
                const f32x4 fa = *(const f32x4*)(fg + lane * 16 + q * 4);
                f32x4 oa;
#pragma unroll
                for (int j = 0; j < 4; ++j) oa[j] = v[q * 4 + j] * rinv * fa[j];
                *(f32x4*)(xr + q * 4) = oa;
            }
        }
    }
#ifdef DBG_STOP
    if (IN(14)) {
        TIDS
        const size_t NO = (size_t)NTOK * DM;
        for (size_t i = (size_t)blk * 512 + tid; i < NO; i += (size_t)G * 512) {
            unsigned hsh = 0u;
            const size_t row = i >> 10, c = i & 1023;
#define RB(p, idx) ((unsigned)(p)[(idx)])
#define RF(p, idx) (__float_as_uint((p)[(idx)]))
#if DBG_STOP == 0
            hsh = RB(W_WinT, i % (2304 * 1024)) ^ RB(W_WoT, i % (1024 * 1024)) ^ RB(W_WuqT, i % (768 * 384)) ^ RB(W_WukvT, i % (1024 * 256)) ^ RB(W_Ws13T, i % (512 * 1024)) ^ RB(W_Ws2T, i % (1024 * 256)) ^ RB(W_WrT, i % (256 * 1024))
                ^ RF(W_mod, i % (8 * 6144)) ^ RF(W_ropecs, i % (4096 * 32)) ^ RF(W_biasT, i % (3 * 8 * 129));
#elif DBG_STOP == 1 || DBG_STOP == 7
            hsh = RB(W_hbuf, i);
#elif DBG_STOP == 2
            hsh = RB(W_proj, row * INCP + c) ^ (RB(W_proj, row * INCP + 1024 + c) << 1) ^ (c < 160 ? (RB(W_proj, row * INCP + 2048 + c) << 2) : 0u);
#elif DBG_STOP == 3
            hsh = RB(W_kvb, i) ^ (c < 768 ? (RB(W_qb, row * 768 + c) << 1) : 0u);
#elif DBG_STOP == 4
            if (c < 512) hsh = RB(W_bout, row * 512 + c); else if (DBG_SUB) { const size_t cc = c - 512; hsh = RB(W_aparts, row * 512 + cc) ^ (RB(W_aparts, ((size_t)NTOK + row) * 512 + cc) << 1) ^ (RB(W_aparts, ((size_t)2 * NTOK + row) * 512 + cc) << 2) ^ RF(W_lsebuf, row * 8 + (cc >> 6)) ^ (RF(W_lsebuf, ((size_t)NTOK + row) * 8 + (cc >> 6)) << 1) ^ (RF(W_lsebuf, ((size_t)2 * NTOK + row) * 8 + (cc >> 6)) << 2); }
#elif DBG_STOP == 5
            hsh = RB(W_mixb, i);
#elif DBG_STOP == 6
            hsh = RF(P.out, i);
#elif DBG_STOP == 8
            if (c < 256) hsh = RF(W_logits, row * 256 + c); else if (c < 512) hsh = RB(W_hdn, ((size_t)NASG + row) * EFF + (c - 256));
#elif DBG_STOP == 9
            if (c < 8) hsh = (unsigned)W_eidx[row * 8 + c]; else if (c < 16) hsh = RF(W_gate, row * 8 + (c - 8));
#elif DBG_STOP == 11
            { const int k = (int)(c >> 8); hsh = RB(W_hdn, (size_t)W_pos[row * 8 + k] * EFF + (c & 255)) ^ (RB(W_hdn, (size_t)W_pos[row * 8 + 4 + k] * EFF + (c & 255)) << 1); }
#elif DBG_STOP == 12
            { for (int k = 0; k < 8; ++k) hsh ^= RB(W_ybuf, (size_t)W_pos[row * 8 + k] * DM + c) << (k & 3); hsh ^= RB(W_ybuf, ((size_t)NASG + row) * DM + c); }
#endif
            P.out[i] = (float)(hsh & 0xFu);
        }
    }
#endif
#undef IN
#undef SEAM
}

extern "C" void kernel_launch(void* const* d_in, const int* in_sizes, int n_in, void* d_out, int out_size, void* d_ws, size_t ws_size, hipStream_t stream) {
    static int grid = 0;
    if (grid == 0) {
        if (n_in != 24 || ws_size < WS_END) { fprintf(stderr, "kernel_launch: need 24 inputs and %zu bytes of workspace (got %d, %zu)\n", (size_t)WS_END, n_in, ws_size); grid = -1; return; }
        int dev = 0, cus = 0, per_cu = 0;
        if (hipGetDevice(&dev) != hipSuccess || hipDeviceGetAttribute(&cus, hipDeviceAttributeMultiprocessorCount, dev) != hipSuccess) { grid = -1; return; }
        if (hipFuncSetAttribute((const void*)fwd_kernel, hipFuncAttributeMaxDynamicSharedMemorySize, LDS_BYTES) != hipSuccess) { fprintf(stderr, "kernel_launch: hipFuncSetAttribute failed\n"); grid = -1; return; }
        if (hipOccupancyMaxActiveBlocksPerMultiprocessor(&per_cu, (const void*)fwd_kernel, 512, LDS_BYTES) != hipSuccess || per_cu < 1) { fprintf(stderr, "kernel_launch: occupancy query says %d\n", per_cu); }
        (void)hipGetLastError();
        grid = cus;
    }
    if (grid < 0) return;
    (void)hipMemsetAsync((char*)d_ws + OFF_CTL, 0, CTL_BYTES, stream);
    Params p{};
    for (int i = 0; i < 24; ++i) p.in[i] = (const float*)d_in[i];
    p.out = (float*)d_out; p.ws = (unsigned char*)d_ws;
#if MK_N_LAUNCHES == 1
    p.ph_lo = 0; p.ph_hi = NPHASE;
    hipLaunchKernelGGL(fwd_kernel, dim3(grid), dim3(512), LDS_BYTES, stream, p);
#else
#ifdef DBG_STOP
    for (int k = 0; k <= DBG_STOP; ++k) { p.ph_lo = k; p.ph_hi = k + 1; hipLaunchKernelGGL(fwd_kernel, dim3(grid), dim3(512), LDS_BYTES, stream, p); }
    p.ph_lo = 14; p.ph_hi = 15; hipLaunchKernelGGL(fwd_kernel, dim3(grid), dim3(512), LDS_BYTES, stream, p);
#else
#ifndef DBL_MASK
#define DBL_MASK 0u
#endif
#ifndef DBL_FLAGS
#define DBL_FLAGS 0
#endif
    for (int k = 0; k < 14; ++k) { p.ph_lo = k; p.ph_hi = k + 1; hipLaunchKernelGGL(fwd_kernel, dim3(grid), dim3(512), LDS_BYTES, stream, p);
        if ((DBL_MASK >> k) & 1u) { p.flags = DBL_FLAGS; hipLaunchKernelGGL(fwd_kernel, dim3(grid), dim3(512), LDS_BYTES, stream, p); p.flags = 0; } }
#endif
#endif
}
```

```cpp
#include <hip/hip_runtime.h>
#include <stdint.h>
#include <stdio.h>

#ifndef MK_N_LAUNCHES
#define MK_N_LAUNCHES 1
#endif

#define DEVI __device__ __forceinline__
typedef unsigned short bf16_t;
typedef short bf16x8 __attribute__((ext_vector_type(8)));
typedef short s16x4 __attribute__((ext_vector_type(4)));
typedef float f32x4 __attribute__((ext_vector_type(4)));
typedef float f32x16 __attribute__((ext_vector_type(16)));
typedef unsigned u32x4 __attribute__((ext_vector_type(4)));
typedef unsigned u32x2 __attribute__((ext_vector_type(2)));

constexpr int NTOK = 32768, SEQ = 4096, DM = 1024;
constexpr int INC = 2208, INCP = 2304;
constexpr int QLORA = 384, KVLORA = 256;
constexpr int NEXP = 256, EFF = 256;
constexpr int NASG = NTOK * 8;
constexpr int NROWS = NASG + NTOK;
constexpr float EPS = 1e-6f;
constexpr float LOG2E = 1.4426950408889634f;

constexpr size_t MiB = 1u << 20;
constexpr size_t OFF_CTL = 0, CTL_BYTES = 1 * MiB;
constexpr size_t OFF_MOD = 1 * MiB;
constexpr size_t OFF_ROPE = OFF_MOD + 256 * 1024;
constexpr size_t OFF_BIAS = OFF_ROPE + 512 * 1024;
constexpr size_t OFF_WIN = 2 * MiB;
constexpr size_t OFF_WUQ = OFF_WIN + 4608 * 1024;
constexpr size_t OFF_WUKV = OFF_WUQ + 1 * MiB;
constexpr size_t OFF_WO = OFF_WUKV + 512 * 1024;
constexpr size_t OFF_WR = OFF_WO + 2 * MiB;
constexpr size_t OFF_WS13 = OFF_WR + 512 * 1024;
constexpr size_t OFF_WS2 = OFF_WS13 + 1 * MiB;
constexpr size_t OFF_H = 12 * MiB;
constexpr size_t OFF_LOGITS = OFF_H + 64 * MiB;
constexpr size_t OFF_EIDX = OFF_LOGITS + 32 * MiB;
constexpr size_t OFF_GATE = OFF_EIDX + 1 * MiB;
constexpr size_t OFF_RNK = OFF_GATE + 1 * MiB;
constexpr size_t OFF_POS = OFF_RNK + 1 * MiB;
constexpr size_t OFF_TOKS = OFF_POS + 1 * MiB;
constexpr size_t OFF_WTS = OFF_TOKS + 1 * MiB;
constexpr size_t OFF_SSQ = OFF_WTS + 1 * MiB;
constexpr size_t OFF_SCR = OFF_SSQ + 4 * MiB;
constexpr size_t SCR_PER_BLK = 1536 * 1024;
constexpr size_t OFF_R = OFF_SCR + 384 * MiB;
constexpr size_t WS_END = OFF_R + 452 * MiB;
constexpr size_t OFF_PROJ = OFF_R;
constexpr size_t OFF_QB = OFF_PROJ + 144 * MiB;
constexpr size_t OFF_KVB = OFF_QB + 48 * MiB;
constexpr size_t OFF_BOUT = OFF_KVB + 64 * MiB;
constexpr size_t OFF_APARTS = OFF_BOUT + 32 * MiB;
constexpr size_t OFF_LSE = OFF_APARTS + 96 * MiB;
constexpr size_t OFF_MIX = OFF_LSE + 4 * MiB;
constexpr size_t OFF_Y = OFF_R;
constexpr size_t OFF_HDN = OFF_R + 288 * MiB;
static_assert(OFF_MIX + 64 * MiB <= WS_END, "alias map");
constexpr int CNT_WORD0 = 8192, CNT_STRIDE = 16;

constexpr int LDS_STAGE = 0;
constexpr int LDS_ROWOFF = 131072;
constexpr int LDS_ROWSC = LDS_ROWOFF + 8192;
constexpr int LDS_MISC = LDS_ROWSC + 8192;
constexpr int LDS_START = LDS_MISC + 256;
constexpr int LDS_CNT = LDS_START + 1280;
constexpr int LDS_BYTES = 155648;
static_assert(LDS_CNT + 1024 <= LDS_BYTES, "lds map");

#define XB_TMO      128
#define XB_XCNT(j)  (256  + 64 * (j))
#define XB_XSUB(j)  (1280 + 64 * (j))
#define XB_XGEN(j)  (2304 + 64 * (j))
#define XB_TOP      3328
#define XB_TOPGEN   3392
#define XCD_BAR_WORDS 3456
#define XB_SPIN_CAP (1u << 22)
#define LAS __attribute__((address_space(3)))

__device__ __forceinline__ unsigned xb_ld(unsigned* p)              { return __hip_atomic_load(p, __ATOMIC_RELAXED, __HIP_MEMORY_SCOPE_AGENT); }
__device__ __forceinline__ unsigned xb_add(unsigned* p, unsigned v) { return __hip_atomic_fetch_add(p, v, __ATOMIC_RELAXED, __HIP_MEMORY_SCOPE_AGENT); }
__device__ __forceinline__ unsigned xb_xcc_id() { return (unsigned)__builtin_amdgcn_s_getreg((3 << 11) | 20) & 0xFu; }
#define XB_SPIN(cond, bar) do { unsigned _sp = 0; while (cond) { __builtin_amdgcn_s_sleep(1); \
    if ((++_sp & 255u) == 0u) { if (xb_ld(&(bar)[XB_TMO])) break; if (_sp > XB_SPIN_CAP) { atomicAdd(&(bar)[XB_TMO], 1u); break; } } } } while (0)

struct XcdBarrier { unsigned* bar; unsigned x; volatile LAS unsigned* st; };

__device__ __forceinline__ XcdBarrier xcd_barrier_post(unsigned* bar, volatile LAS unsigned* st, const bool leader) {
    XcdBarrier b; b.bar = bar; b.x = xb_xcc_id(); b.st = st;
    if (leader) (void)xb_add(&bar[XB_XCNT(b.x)], 1u);
    return b;
}
__device__ __forceinline__ void xcd_barrier_complete(unsigned* bar, unsigned x, unsigned& nloc, unsigned& nx) {
    const unsigned G = gridDim.x * gridDim.y * gridDim.z;
    unsigned sum, cnt, mine, sp = 0u;
    for (;;) {
        sum = 0u; cnt = 0u; mine = 0u;
#pragma unroll
        for (unsigned j = 0; j < 16; ++j) { const unsigned c = xb_ld(&bar[XB_XCNT(j)]); sum += c; cnt += (c > 0u) ? 1u : 0u; mine = (j == x) ? c : mine; }
        if (sum == G) break;
        __builtin_amdgcn_s_sleep(1);
        if ((++sp & 255u) == 0u) { if (xb_ld(&bar[XB_TMO])) break; if (sp > XB_SPIN_CAP) { atomicAdd(&bar[XB_TMO], 1u); break; } }
    }
    nloc = mine > 0u ? mine : 1u; nx = cnt > 0u ? cnt : 1u;
}
__device__ __forceinline__ void xcd_barrier(const XcdBarrier& b, const bool leader) {
    asm volatile("s_waitcnt vmcnt(0)" ::: "memory");
    __syncthreads();
    if (leader) {
        unsigned* bar = b.bar;
        __builtin_amdgcn_s_waitcnt(0);
        unsigned nloc = b.st[0], nx = b.st[1];
        if (nloc == 0u) { xcd_barrier_complete(bar, b.x, nloc, nx); b.st[0] = nloc; b.st[1] = nx; }
        const unsigned old = xb_add(&bar[XB_XSUB(b.x)], 1u);
        const unsigned gen = old / nloc;
        if (old + 1u == (gen + 1u) * nloc) {
            __builtin_amdgcn_fence(__ATOMIC_RELEASE, "agent");
            asm volatile("s_waitcnt vmcnt(0)" ::: "memory");
            const unsigned og = xb_add(&bar[XB_TOP], 1u);
            const unsigned tg = og / nx;
            if (og + 1u == (tg + 1u) * nx) xb_add(&bar[XB_TOPGEN], 1u);
            else XB_SPIN(xb_ld(&bar[XB_TOPGEN]) == tg, bar);
            __builtin_amdgcn_fence(__ATOMIC_ACQUIRE, "agent");
            xb_add(&bar[XB_XGEN(b.x)], 1u);
            asm volatile("s_waitcnt vmcnt(0)" ::: "memory");
        } else {
            XB_SPIN(xb_ld(&bar[XB_XGEN(b.x)]) == gen, bar);
            __builtin_amdgcn_fence(__ATOMIC_ACQUIRE, "agent");
            asm volatile("s_waitcnt vmcnt(0)" ::: "memory");
        }
    }
    __syncthreads();
}

DEVI float bf2f(bf16_t v) { return __uint_as_float(((unsigned)v) << 16); }
typedef float f32x2_t __attribute__((ext_vector_type(2)));
typedef __bf16 bf16x2_t __attribute__((ext_vector_type(2)));
DEVI unsigned pk2(float lo, float hi) { f32x2_t v = {lo, hi}; bf16x2_t b = __builtin_convertvector(v, bf16x2_t); return __builtin_bit_cast(unsigned, b); }
#define dppf(v, ctrl) __int_as_float(__builtin_amdgcn_update_dpp(0, __float_as_int(v), (ctrl), 0xf, 0xf, false))
#define dppi(v, ctrl) __builtin_amdgcn_update_dpp(0, (v), (ctrl), 0xf, 0xf, false)
#define DPP_X1 0xB1
#define DPP_X2 0x4E
#define DPP_HM 0x141
#define DPP_RM 0x140
DEVI float x16f(float v, float& o) { auto r = __builtin_amdgcn_permlane16_swap(__float_as_uint(v), __float_as_uint(v), false, false); o = __uint_as_float(r[1]); return __uint_as_float(r[0]); }
DEVI float x32f(float v, float& o) { auto r = __builtin_amdgcn_permlane32_swap(__float_as_uint(v), __float_as_uint(v), false, false); o = __uint_as_float(r[1]); return __uint_as_float(r[0]); }
DEVI float sum32(float v) { float o; const float a = x32f(v, o); return a + o; }
DEVI float max32(float v) { float o; const float a = x32f(v, o); return fmaxf(a, o); }
DEVI float wave_sum(float v) {
    v += dppf(v, DPP_X1); v += dppf(v, DPP_X2); v += dppf(v, DPP_HM); v += dppf(v, DPP_RM);
    { float o; const float a = x16f(v, o); v = a + o; }
    { float o; const float a = x32f(v, o); v = a + o; }
    return v;
}
DEVI int perm_slot(int cl) { return 16 * ((cl >> 2) & 1) + 4 * (cl >> 3) + (cl & 3); }
DEVI int perm_row(int n) { return (n & ~31) + perm_slot(n & 31); }
DEVI float ex2(float x) { return __builtin_amdgcn_exp2f(x); }
DEVI float siluf(float v) { return v / (1.0f + __expf(-v)); }

namespace g8 {
constexpr int BK = 64, HALF = 128, HT = HALF * BK;
DEVI int lds_byte(int r, int c) { int st = (r >> 4) * 2 + (c >> 5), rr = r & 15, cc = c & 31, ob = rr * 64 + cc * 2; return st * 1024 + (ob ^ (((ob >> 9) & 1) << 5)); }
DEVI void stage_rc(int b, int& R, int& C) { int st = b / 1024, sb = b % 1024, swz = sb ^ (((sb >> 9) & 1) << 5); R = (st >> 1) * 16 + swz / 64; C = (st & 1) * 32 + (swz % 64) / 2; }
}

DEVI void g8_rc(int tid, int& R0, int& C0) { g8::stage_rc(tid * 16, R0, C0); }
DEVI void g8_voff_lin(unsigned (&v)[4], int ld, int tid) { int R0, C0; g8_rc(tid, R0, C0);
    v[0] = (unsigned)(R0 * ld + C0) * 2u; v[1] = (unsigned)((R0 + 64) * ld + C0) * 2u; v[2] = (unsigned)((R0 + 128) * ld + C0) * 2u; v[3] = (unsigned)((R0 + 192) * ld + C0) * 2u; }
DEVI void g8_voff_tab(unsigned (&v)[4], const LAS unsigned* tab, int tid) { int R0, C0; g8_rc(tid, R0, C0);
    v[0] = (tab[R0] + C0) * 2u; v[1] = (tab[R0 + 64] + C0) * 2u; v[2] = (tab[R0 + 128] + C0) * 2u; v[3] = (tab[R0 + 192] + C0) * 2u; }

template <class Epi>
DEVI void gemm_tile(LAS unsigned char* lds, const int tid_in, const char* Ab, const unsigned (&voffA_)[4], const char* Bb, const int K, const Epi& epi) {
    using namespace g8;
    constexpr int HTB = HALF * BK * 2;
    int tz = tid_in; asm volatile("" : "+v"(tz));
    int wid = tz >> 6, lane = tz & 63, wr = wid >> 2, wc = wid & 3, fr = lane & 15, fq = lane >> 4;
    unsigned voffA[4] = {voffA_[0], voffA_[1], voffA_[2], voffA_[3]};
    asm volatile("" : "+v"(voffA[0]), "+v"(voffA[1]), "+v"(voffA[2]), "+v"(voffA[3]));
    unsigned voffB[2];
    { int R0, C0; stage_rc(tz * 16, R0, C0); voffB[0] = (unsigned)(R0 * K + C0) * 2u; voffB[1] = (unsigned)((R0 + 64) * K + C0) * 2u; }
    const size_t kstep = (size_t)(BK * 2);
    const size_t hstepB = (size_t)HALF * K * 2;
    const unsigned ldsw = (unsigned)wid * 1024u;
    const int aoff = lds_byte(wr * 64 + fr, fq * 8), boff = lds_byte(wc * 32 + fr, fq * 8);
#define G8_SA(b, h) (((b) * 2 + (h)) * HTB)
#define G8_SB(b, h) ((4 + (b) * 2 + (h)) * HTB)
#define G8_GL(gp, lofs) __builtin_amdgcn_global_load_lds((const unsigned*)(gp), (LAS unsigned*)(lds + (lofs)), 16, 0, 0)
#define STAGE_A(b, h, kt) do { const char* g_ = Ab + (size_t)(kt) * kstep; G8_GL(g_ + voffA[(h) * 2], G8_SA(b, h) + ldsw); G8_GL(g_ + voffA[(h) * 2 + 1], G8_SA(b, h) + ldsw + 8192); } while (0)
#define STAGE_B(b, h, kt) do { const char* g_ = Bb + (size_t)(kt) * kstep + ((h) ? hstepB : 0); G8_GL(g_ + voffB[0], G8_SB(b, h) + ldsw); G8_GL(g_ + voffB[1], G8_SB(b, h) + ldsw + 8192); } while (0)
#define LDA(dst, b, h) do { _Pragma("unroll") for (int m = 0; m < 4; ++m) _Pragma("unroll") for (int k = 0; k < 2; ++k) dst[m][k] = *(const LAS bf16x8*)(lds + G8_SA(b, h) + aoff + m * 2048 + k * 1024); } while (0)
#define LDB(dst, b, h) do { _Pragma("unroll") for (int n = 0; n < 2; ++n) _Pragma("unroll") for (int k = 0; k < 2; ++k) dst[n][k] = *(const LAS bf16x8*)(lds + G8_SB(b, h) + boff + n * 2048 + k * 1024); } while (0)
#define MMA(ai, bj, Af, Bf) do { __builtin_amdgcn_s_setprio(1); \
    _Pragma("unroll") for (int m = 0; m < 4; ++m) _Pragma("unroll") for (int n = 0; n < 2; ++n) _Pragma("unroll") for (int k = 0; k < 2; ++k) \
      acc[ai][bj][m][n] = __builtin_amdgcn_mfma_f32_16x16x32_bf16(Bf[n][k], Af[m][k], acc[ai][bj][m][n], 0, 0, 0); \
    __builtin_amdgcn_s_setprio(0); } while (0)
#define WAIT_V(n) asm volatile("s_waitcnt vmcnt(" #n ")" ::: "memory")
#define WAIT_L(n) asm volatile("s_waitcnt lgkmcnt(" #n ")" ::: "memory")
#define BAR __builtin_amdgcn_s_barrier()
#define SCHED __builtin_amdgcn_sched_barrier(0)
    f32x4 acc[2][2][4][2];
#pragma unroll
    for (int a = 0; a < 2; ++a)
#pragma unroll
        for (int b = 0; b < 2; ++b)
#pragma unroll
            for (int m = 0; m < 4; ++m)
#pragma unroll
                for (int n = 0; n < 2; ++n) acc[a][b][m][n] = (f32x4){0.f, 0.f, 0.f, 0.f};
    bf16x8 At[4][2], B0[2][2], B1[2][2];
    const int nt = K / BK;
    STAGE_B(0, 0, 0); STAGE_A(0, 0, 0); STAGE_B(0, 1, 0); STAGE_A(0, 1, 0);
    if (wr == 1) BAR;
    WAIT_V(4); BAR;
    STAGE_B(1, 0, 1); STAGE_A(1, 0, 1); STAGE_B(1, 1, 1);
    WAIT_V(6); BAR;
#pragma unroll 1
    for (int t = 0; t < nt; t += 2) {
        const int t2 = (t == nt - 2) ? 0 : t + 2;
        const int t3 = t2 + 1;
        LDB(B0, 0, 0); SCHED; LDA(At, 0, 0); STAGE_A(1, 1, t + 1);
        WAIT_L(8); BAR; WAIT_L(0); MMA(0, 0, At, B0); BAR; SCHED;
        LDB(B1, 0, 1); STAGE_B(0, 0, t2);
        BAR; WAIT_L(0); MMA(0, 1, At, B1); BAR;
        LDA(At, 0, 1); STAGE_A(0, 0, t2);
        BAR; WAIT_L(0); MMA(1, 0, At, B0); BAR; SCHED;
        STAGE_B(0, 1, t2);
        WAIT_V(6); BAR; MMA(1, 1, At, B1); BAR;
        LDB(B0, 1, 0); SCHED; LDA(At, 1, 0); STAGE_A(0, 1, t2);
        WAIT_L(8); BAR; WAIT_L(0); MMA(0, 0, At, B0); BAR; SCHED;
        LDB(B1, 1, 1); STAGE_B(1, 0, t3);
        BAR; WAIT_L(0); MMA(0, 1, At, B1); BAR;
        LDA(At, 1, 1); STAGE_A(1, 0, t3);
        BAR; WAIT_L(0); MMA(1, 0, At, B0); BAR; SCHED;
        STAGE_B(1, 1, t3);
        WAIT_V(6); BAR; MMA(1, 1, At, B1); BAR;
    }
    WAIT_V(0);
    if (wr == 0) BAR;
    BAR;
    asm volatile("" : "+v"(tz)); wid = tz >> 6; lane = tz & 63; wr = wid >> 2; wc = wid & 3; fr = lane & 15; fq = lane >> 4;
    epi(acc, wr, wc, fr, fq);
#undef G8_SA
#undef G8_SB
#undef G8_GL
#undef STAGE_A
#undef STAGE_B
#undef LDA
#undef LDB
#undef MMA
}
struct GDesc { const char* Ab; const char* Bb; unsigned va0, va1, va2, va3; int i0, i1; };
template <class Next, class Epi>
DEVI void gemm_stream(LAS unsigned char* lds, const int tid_in, const int K, Next& next, const Epi& epi) {
    using namespace g8;
    constexpr int HTB = HALF * BK * 2;
    int tz = tid_in; asm volatile("" : "+v"(tz));
    int wid = tz >> 6, lane = tz & 63, wr = wid >> 2, wc = wid & 3, fr = lane & 15, fq = lane >> 4;
    unsigned voffB[2];
    { int R0, C0; stage_rc(tz * 16, R0, C0); voffB[0] = (unsigned)(R0 * K + C0) * 2u; voffB[1] = (unsigned)((R0 + 64) * K + C0) * 2u; }
    const size_t kstep = (size_t)(BK * 2);
    const size_t hstepB = (size_t)HALF * K * 2;
    const unsigned ldsw = (unsigned)wid * 1024u;
    const int aoff = lds_byte(wr * 64 + fr, fq * 8), boff = lds_byte(wc * 32 + fr, fq * 8);
#define G8_SA(b, h) (((b) * 2 + (h)) * HTB)
#define G8_SB(b, h) ((4 + (b) * 2 + (h)) * HTB)
#define G8_GL(gp, lofs) __builtin_amdgcn_global_load_lds((const unsigned*)(gp), (LAS unsigned*)(lds + (lofs)), 16, 0, 0)
#define STG_A(b, h, gb, v0, v1) do { G8_GL((gb) + (v0), G8_SA(b, h) + ldsw); G8_GL((gb) + (v1), G8_SA(b, h) + ldsw + 8192); } while (0)
#define STG_B(b, h, gb) do { const char* g_ = (gb) + ((h) ? hstepB : 0); G8_GL(g_ + voffB[0], G8_SB(b, h) + ldsw); G8_GL(g_ + voffB[1], G8_SB(b, h) + ldsw + 8192); } while (0)
#define LDA(dst, b, h) do { _Pragma("unroll") for (int m = 0; m < 4; ++m) _Pragma("unroll") for (int k = 0; k < 2; ++k) dst[m][k] = *(const LAS bf16x8*)(lds + G8_SA(b, h) + aoff + m * 2048 + k * 1024); } while (0)
#define LDB(dst, b, h) do { _Pragma("unroll") for (int n = 0; n < 2; ++n) _Pragma("unroll") for (int k = 0; k < 2; ++k) dst[n][k] = *(const LAS bf16x8*)(lds + G8_SB(b, h) + boff + n * 2048 + k * 1024); } while (0)
#define MMA(ai, bj, Af, Bf) do { __builtin_amdgcn_s_setprio(1); \
    _Pragma("unroll") for (int m = 0; m < 4; ++m) _Pragma("unroll") for (int n = 0; n < 2; ++n) _Pragma("unroll") for (int k = 0; k < 2; ++k) \
      acc[ai][bj][m][n] = __builtin_amdgcn_mfma_f32_16x16x32_bf16(Bf[n][k], Af[m][k], acc[ai][bj][m][n], 0, 0, 0); \
    __builtin_amdgcn_s_setprio(0); } while (0)
#define ZACC() do { _Pragma("unroll") for (int a = 0; a < 2; ++a) _Pragma("unroll") for (int b = 0; b < 2; ++b) _Pragma("unroll") for (int m = 0; m < 4; ++m) _Pragma("unroll") for (int n = 0; n < 2; ++n) acc[a][b][m][n] = (f32x4){0.f, 0.f, 0.f, 0.f}; } while (0)
    GDesc cur, nxt;
    if (!next(0, cur)) return;
    nxt = cur;
    f32x4 acc[2][2][4][2];
    ZACC();
    bf16x8 At[4][2], B0[2][2], B1[2][2];
    const int nt = K / BK;
    STG_B(0, 0, cur.Bb); STG_A(0, 0, cur.Ab, cur.va0, cur.va1); STG_B(0, 1, cur.Bb); STG_A(0, 1, cur.Ab, cur.va2, cur.va3);
    if (wr == 1) BAR;
    WAIT_V(4); BAR;
    STG_B(1, 0, cur.Bb + kstep); STG_A(1, 0, cur.Ab + kstep, cur.va0, cur.va1); STG_B(1, 1, cur.Bb + kstep);
    WAIT_V(6); BAR;
    int ui = 0; bool has_next = false;
#pragma unroll 1
    for (;;) {
#pragma unroll 1
        for (int t = 0; t < nt; t += 2) {
            const bool last = (t == nt - 2);
            if (last) { has_next = next(ui + 1, nxt); if (!has_next) nxt = cur; }
            const char* a2 = last ? nxt.Ab : cur.Ab + (size_t)(t + 2) * kstep;
            const char* b2 = last ? nxt.Bb : cur.Bb + (size_t)(t + 2) * kstep;
            const unsigned s0 = last ? nxt.va0 : cur.va0, s1 = last ? nxt.va1 : cur.va1, s2 = last ? nxt.va2 : cur.va2, s3 = last ? nxt.va3 : cur.va3;
            LDB(B0, 0, 0); SCHED; LDA(At, 0, 0); STG_A(1, 1, cur.Ab + (size_t)(t + 1) * kstep, cur.va2, cur.va3);
            WAIT_L(8); BAR; WAIT_L(0); MMA(0, 0, At, B0); BAR; SCHED;
            LDB(B1, 0, 1); STG_B(0, 0, b2);
            BAR; WAIT_L(0); MMA(0, 1, At, B1); BAR;
            LDA(At, 0, 1); STG_A(0, 0, a2, s0, s1);
            BAR; WAIT_L(0); MMA(1, 0, At, B0); BAR; SCHED;
            STG_B(0, 1, b2);
            WAIT_V(6); BAR; MMA(1, 1, At, B1); BAR;
            LDB(B0, 1, 0); SCHED; LDA(At, 1, 0); STG_A(0, 1, a2, s2, s3);
            WAIT_L(8); BAR; WAIT_L(0); MMA(0, 0, At, B0); BAR; SCHED;
            LDB(B1, 1, 1); STG_B(1, 0, b2 + kstep);
            BAR; WAIT_L(0); MMA(0, 1, At, B1); BAR;
            LDA(At, 1, 1); STG_A(1, 0, a2 + kstep, s0, s1);
            BAR; WAIT_L(0); MMA(1, 0, At, B0); BAR; SCHED;
            STG_B(1, 1, b2 + kstep);
            WAIT_V(6); BAR; MMA(1, 1, At, B1); BAR;
        }
        {
            int tq = tz; asm volatile("" : "+v"(tq));
            const int wid_ = tq >> 6, lane_ = tq & 63;
            epi(acc, cur, wid_ >> 2, wid_ & 3, lane_ & 15, lane_ >> 4);
        }
        if (!has_next) break;
        ZACC();
        cur = nxt; ++ui;
    }
    WAIT_V(0);
    if (wr == 0) BAR;
    BAR;
#undef G8_SA
#undef G8_SB
#undef G8_GL
#undef STG_A
#undef STG_B
#undef LDA
#undef LDB
#undef MMA
#undef ZACC
}
#define EPI_FOREACH8(acc, wr, wc, fr, fq, ROW, COL8, V0, V1, ...) \
    _Pragma("unroll") for (int ai_ = 0; ai_ < 2; ++ai_) _Pragma("unroll") for (int m_ = 0; m_ < 4; ++m_) { const int ROW = ai_ * 128 + (wr) * 64 + m_ * 16 + (fr); \
    _Pragma("unroll") for (int bj_ = 0; bj_ < 2; ++bj_) { const int COL8 = bj_ * 128 + (wc) * 32 + (fq) * 8; const f32x4 V0 = acc[ai_][bj_][m_][0]; const f32x4 V1 = acc[ai_][bj_][m_][1]; __VA_ARGS__ } }
#define PK8(w, a, b) do { w.x = pk2(a[0], a[1]); w.y = pk2(a[2], a[3]); w.z = pk2(b[0], b[1]); w.w = pk2(b[2], b[3]); } while (0)

template <class SCol, class DRow, class KS, class NS>
DEVI void convert_T(bf16_t* __restrict__ dst, const float* __restrict__ src, int ld, int K, int NR, SCol scol, DRow drow, KS ks, NS ns, int wi, int nw) {
    const int k8n = K >> 3; const int items = NR * k8n;
    for (int it = wi; it < items; it += nw) {
        const int n = it % NR, k0 = (it / NR) << 3;
        const int sc = scol(n);
        float v[8];
#pragma unroll
        for (int j = 0; j < 8; ++j) v[j] = (sc >= 0) ? src[(size_t)(k0 + j) * ld + sc] * ks(k0 + j) : 0.f;
        const float s = ns(n);
        u32x4 w; w.x = pk2(v[0] * s, v[1] * s); w.y = pk2(v[2] * s, v[3] * s); w.z = pk2(v[4] * s, v[5] * s); w.w = pk2(v[6] * s, v[7] * s);
        *(u32x4*)(dst + (size_t)drow(n) * K + k0) = w;
    }
}
struct IdCol { DEVI int operator()(int n) const { return n; } };
struct OneK { DEVI float operator()(int) const { return 1.f; } };
struct VecK { const float* g; DEVI float operator()(int k) const { return g[k]; } };

template <int NB, bool PERM>
DEVI void convert_panel(bf16_t* __restrict__ dst, const float* __restrict__ src, const int ld, const int K, const int tid) {
    constexpr int N4 = NB / 4;
    const int items = (K >> 3) * N4;
#pragma unroll 1
    for (int it0 = tid; it0 < items; it0 += 1024) {
        f32x4 v[2][8];
#pragma unroll
        for (int u = 0; u < 2; ++u) {
            const int it = it0 + u * 512; const int n4 = it % N4, k8 = it / N4;
            const float* sp = src + (size_t)(k8 * 8) * ld + n4 * 4;
#pragma unroll
            for (int j = 0; j < 8; ++j) v[u][j] = *(const f32x4*)(sp + (size_t)j * ld);
        }
#pragma unroll
        for (int u = 0; u < 2; ++u) {
            const int it = it0 + u * 512; const int n4 = it % N4, k8 = it / N4;
#pragma unroll
            for (int c = 0; c < 4; ++c) {
                u32x4 w; w.x = pk2(v[u][0][c], v[u][1][c]); w.y = pk2(v[u][2][c], v[u][3][c]); w.z = pk2(v[u][4][c], v[u][5][c]); w.w = pk2(v[u][6][c], v[u][7][c]);
                const int n = n4 * 4 + c; const int dr = PERM ? ((n & ~31) + perm_slot(n & 31)) : n;
                *(u32x4*)(dst + (size_t)dr * K + k8 * 8) = w;
            }
        }
    }
}

template <int NB, bool PERM>
DEVI void convert_panel_lds(bf16_t* __restrict__ dst, const float* __restrict__ src, const int ld, const int K, const int tid, LAS unsigned char* lds) {
    constexpr int N4 = NB / 4;
    constexpr int K8C = 512 / N4;
    constexpr int KC = K8C * 8;
    constexpr int PITCH = KC * 2 + 8;
    constexpr int PPR = KC / 8;
    const int n4 = tid % N4, k8 = tid / N4;
    const float* sp = src + (size_t)(k8 * 8) * ld + n4 * 4;
    const int nchunk = K / KC;
    f32x4 va[8], vb[8], vc[8];
#define CPL_LOAD(V, c) do { const float* q_ = sp + (size_t)(c) * KC * ld; _Pragma("unroll") for (int j = 0; j < 8; ++j) V[j] = *(const f32x4*)(q_ + (size_t)j * ld); } while (0)
#define CPL_PROC(V, c) do { \
        _Pragma("unroll") for (int cc = 0; cc < 4; ++cc) { \
            u32x2 lo, hi; lo.x = pk2(V[0][cc], V[1][cc]); lo.y = pk2(V[2][cc], V[3][cc]); hi.x = pk2(V[4][cc], V[5][cc]); hi.y = pk2(V[6][cc], V[7][cc]); \
            LAS unsigned char* wp = lds + (n4 * 4 + cc) * PITCH + k8 * 16; \
            *(LAS u32x2*)wp = lo; *(LAS u32x2*)(wp + 8) = hi; } \
        __syncthreads(); \
        _Pragma("unroll") for (int q = 0; q < 4; ++q) { \
            const int p = tid + 512 * q; const int row = p / PPR, pc = p % PPR; \
            const LAS unsigned char* rp = lds + row * PITCH + pc * 16; \
            const u32x2 a = *(const LAS u32x2*)rp, b = *(const LAS u32x2*)(rp + 8); \
            const int dr = PERM ? ((row & ~31) + perm_slot(row & 31)) : row; \
            u32x4 w; w.x = a.x; w.y = a.y; w.z = b.x; w.w = b.y; \
            *(u32x4*)(dst + (size_t)dr * K + (c) * KC + pc * 8) = w; } \
        __syncthreads(); } while (0)
    CPL_LOAD(va, 0); if (nchunk > 1) CPL_LOAD(vb, 1); if (nchunk > 2) CPL_LOAD(vc, 2);
#pragma unroll 1
    for (int c = 0; c < nchunk; c += 3) {
        CPL_PROC(va, c); if (c + 3 < nchunk) CPL_LOAD(va, c + 3);
        if (c + 1 < nchunk) { CPL_PROC(vb, c + 1); if (c + 4 < nchunk) CPL_LOAD(vb, c + 4); }
        if (c + 2 < nchunk) { CPL_PROC(vc, c + 2); if (c + 5 < nchunk) CPL_LOAD(vc, c + 5); }
    }
#undef CPL_LOAD
#undef CPL_PROC
}

struct Params {
    const float* in[24];
    float* out;
    unsigned char* ws;
    int ph_lo, ph_hi;
    int flags, pad;
};
enum { I_X = 0, I_C, I_WADA, I_BADA, I_N1G, I_WIN, I_QNG, I_WUQ, I_KVNG, I_WUKV, I_REL, I_AOG, I_BOG, I_WO, I_N2G, I_WR, I_EB, I_W1, I_W3, I_W2, I_WS1, I_WS3, I_WS2, I_FG };
constexpr int NPHASE = 15;

#define W_x (P.in[I_X])
#define W_mod ((float*)(ws + OFF_MOD))
#define W_ropecs ((float*)(ws + OFF_ROPE))
#define W_biasT ((float*)(ws + OFF_BIAS))
#define W_WinT ((bf16_t*)(ws + OFF_WIN))
#define W_WuqT ((bf16_t*)(ws + OFF_WUQ))
#define W_WukvT ((bf16_t*)(ws + OFF_WUKV))
#define W_WoT ((bf16_t*)(ws + OFF_WO))
#define W_WrT ((bf16_t*)(ws + OFF_WR))
#define W_Ws13T ((bf16_t*)(ws + OFF_WS13))
#define W_Ws2T ((bf16_t*)(ws + OFF_WS2))
#define W_hbuf ((bf16_t*)(ws + OFF_H))
#define W_logits ((float*)(ws + OFF_LOGITS))
#define W_eidx ((int*)(ws + OFF_EIDX))
#define W_gate ((float*)(ws + OFF_GATE))
#define W_rnk ((int*)(ws + OFF_RNK))
#define W_pos ((int*)(ws + OFF_POS))
#define W_toks ((int*)(ws + OFF_TOKS))
#define W_wts ((float*)(ws + OFF_WTS))
#define W_ssq ((float*)(ws + OFF_SSQ))
#define W_scr ((bf16_t*)(ws + OFF_SCR + (size_t)blk * SCR_PER_BLK))
#define W_hdn ((bf16_t*)(ws + OFF_HDN))
#define W_ybuf ((bf16_t*)(ws + OFF_Y))
#define W_y8 ((unsigned char*)(ws + OFF_Y))
#define W_proj ((bf16_t*)(ws + OFF_PROJ))
#define W_qb ((bf16_t*)(ws + OFF_QB))
#define W_kvb ((bf16_t*)(ws + OFF_KVB))
#define W_bout ((bf16_t*)(ws + OFF_BOUT))
#define W_aparts ((bf16_t*)(ws + OFF_APARTS))
#define W_lsebuf ((float*)(ws + OFF_LSE))
#define W_mixb ((bf16_t*)(ws + OFF_MIX))

__global__ void __launch_bounds__(512, 2) fwd_kernel(Params P) {
    extern __shared__ __attribute__((aligned(16))) unsigned char lds[];
    const int blk = blockIdx.x, G = gridDim.x;
    const int wave_s = __builtin_amdgcn_readfirstlane((int)threadIdx.x >> 6);
#define TIDS0 int tid; asm volatile("v_mbcnt_lo_u32_b32 %0, -1, 0\n\tv_mbcnt_hi_u32_b32 %0, -1, %0" : "=v"(tid)); tid += wave_s * 64;
    const int vblk = (G % 8 == 0) ? (blk % 8) * (G / 8) + blk / 8 : blk;
    unsigned char* ws = P.ws;
    unsigned* ctl = (unsigned*)(ws + OFF_CTL);
    { TIDS0 if (tid < 64) ((LAS unsigned*)(lds + LDS_MISC))[tid] = 0u; }
    __syncthreads();
    XcdBarrier bar; bar.bar = ctl; bar.x = 0; bar.st = nullptr;
    if (MK_N_LAUNCHES == 1) { TIDS0 bar = xcd_barrier_post(ctl, (volatile LAS unsigned*)(lds + LDS_MISC), tid == 0); }
#ifndef PH_MASK
#define PH_MASK 0xffffffffu
#endif
#define TIDS int tid; asm volatile("v_mbcnt_lo_u32_b32 %0, -1, 0\n\tv_mbcnt_hi_u32_b32 %0, -1, %0" : "=v"(tid)); tid += wave_s * 64; const int lane = tid & 63; const int wave = wave_s; (void)lane; (void)wave;
#define IN(k) ((((PH_MASK) >> (k)) & 1u) && P.ph_lo <= (k) && (k) < P.ph_hi)
#define SEAM(k) do { if (MK_N_LAUNCHES == 1 && IN(k) && IN((k) + 1)) { TIDS0 xcd_barrier(bar, tid == 0); } } while (0)

    unsigned* cntg = ctl + CNT_WORD0;
    LAS unsigned* rowoff = (LAS unsigned*)(lds + LDS_ROWOFF);
    LAS float* rowsc = (LAS float*)(lds + LDS_ROWSC);
    LAS int* startL = (LAS int*)(lds + LDS_START);
    LAS int* cntL = (LAS int*)(lds + LDS_CNT);
    char* stage = (char*)lds + LDS_STAGE;
    LAS unsigned char* ldsL = (LAS unsigned char*)lds;

    if (IN(0)) {
        TIDS
        {
            float* sc = (float*)(lds);
            float* red = (float*)(lds + 32768);
            const float* c = P.in[I_C];
            for (int i = tid; i < 8192; i += 512) sc[i] = siluf(c[i]);
            __syncthreads();
            for (int cb = blk; cb < 256; cb += G) {
                const int cj = tid & 31, kg = tid >> 5;
                float a0 = 0, a1 = 0, a2 = 0, a3 = 0, a4 = 0, a5 = 0, a6 = 0, a7 = 0;
                if (cj < 24) {
                    const float* w = P.in[I_WADA] + cb * 24 + cj;
                    for (int k = kg * 64; k < kg * 64 + 64; ++k) {
                        const float wv = w[(size_t)k * 6144];
                        a0 += sc[k] * wv; a1 += sc[1024 + k] * wv; a2 += sc[2048 + k] * wv; a3 += sc[3072 + k] * wv;
                        a4 += sc[4096 + k] * wv; a5 += sc[5120 + k] * wv; a6 += sc[6144 + k] * wv; a7 += sc[7168 + k] * wv;
                    }
                }
                float* rp = red + (kg * 8) * 32 + cj;
                rp[0] = a0; rp[32] = a1; rp[64] = a2; rp[96] = a3; rp[128] = a4; rp[160] = a5; rp[192] = a6; rp[224] = a7;
                __syncthreads();
                if (tid < 256) {
                    const int b = tid >> 5, j = tid & 31;
                    if (j < 24) {
                        float s = 0.f;
                        for (int g = 0; g < 16; ++g) s += red[(g * 8 + b) * 32 + j];
                        const int col = cb * 24 + j;
                        W_mod[b * 6144 + col] = s + P.in[I_BADA][col];
                    }
                }
                __syncthreads();
            }
        }
        {
            for (int idx = blk * 512 + tid; idx < 4096 * 16; idx += G * 512) {
                const int s = idx >> 4, i = idx & 15;
                double inv = 1.0; for (int j = 0; j < i; ++j) inv *= 0.5623413251903491;
                const float invf = (float)inv;
                const float angf = (float)s * invf;
                const double xa = (double)angf;
                const double nrev = __builtin_rint(xa * 0.15915494309189535);
                const double r = xa - nrev * 6.283185307179586;
                const double r2 = r * r;
                double ts = r, ss = r, tc = 1.0, cc = 1.0;
#pragma unroll
                for (int n = 1; n <= 14; ++n) {
                    ts *= -r2 / (double)((2 * n) * (2 * n + 1)); ss += ts;
                    tc *= -r2 / (double)((2 * n - 1) * (2 * n)); cc += tc;
                }
                W_ropecs[idx * 2] = (float)cc; W_ropecs[idx * 2 + 1] = (float)ss;
            }
        }
        {
            for (int idx = blk * 512 + tid; idx < 3 * 8 * 129; idx += G * 512) {
                const int j = idx % 129, hh = (idx / 129) % 8, p = idx / (129 * 8);
                const int dil = (p == 0) ? 1 : (p == 1 ? 4 : 16);
                const int rel = (j - 64) * dil;
                const int n = rel < 0 ? -rel : rel;
                const float nf = (float)(n > 1 ? n : 1);
                int large = 8 + (int)(__logf(nf * 0.125f) / 4.852030263919617f * 8.0f);
                large = large < 15 ? large : 15;
                const int bucket = (rel > 0 ? 16 : 0) + (n < 8 ? n : large);
                W_biasT[idx] = P.in[I_REL][bucket * 8 + hh] * LOG2E;
            }
        }
        {
            const int wi = blk * 512 + tid, nw = G * 512;
            convert_T(W_WinT, P.in[I_WIN], INC, 1024, INCP,
                      [](int n) { if (n >= INC) return -1; if (n < 2176) return n; const int i = n - 2176; return 2176 + ((i & 1) ? 16 : 0) + (i >> 1); },
                      [](int n) { return perm_row(n); }, OneK{}, [](int n) { return n < 512 ? 0.125f * LOG2E : 1.0f; }, wi, nw);
            convert_T(W_WuqT, P.in[I_WUQ], 768, 384, 768,
                      [](int n) { if (n < 512) return (n >> 6) * 96 + (n & 63); const int hh = (n - 512) >> 5, i = n & 31; return hh * 96 + 64 + ((i & 1) ? 16 : 0) + (i >> 1); },
                      [](int n) { return perm_row(n); }, VecK{P.in[I_QNG]}, [](int) { return 0.10206207261596577f * LOG2E; }, wi, nw);
            convert_T(W_WukvT, P.in[I_WUKV], 1024, 256, 1024, IdCol{}, [](int n) { return perm_row(n); }, VecK{P.in[I_KVNG]}, [](int) { return 1.f; }, wi, nw);
            {
                const float* ag = P.in[I_AOG]; const float* bg = P.in[I_BOG];
                convert_T(W_WoT, P.in[I_WO], 1024, 1024, 1024, IdCol{}, [](int n) { return perm_row(n); }, [=](int k) { return k < 512 ? ag[k] : bg[k - 512]; }, [](int) { return 1.f; }, wi, nw);
            }
            convert_T(W_WrT, P.in[I_WR], 256, 1024, 256, IdCol{}, [](int n) { return perm_row(n); }, OneK{}, [](int) { return 1.f; }, wi, nw);
            convert_T(W_Ws13T, P.in[I_WS1], 256, 1024, 256, IdCol{}, [](int n) { return perm_row((n >> 7) * 256 + (n & 127)); }, OneK{}, [](int) { return 1.f; }, wi, nw);
            convert_T(W_Ws13T, P.in[I_WS3], 256, 1024, 256, IdCol{}, [](int n) { return perm_row((n >> 7) * 256 + 128 + (n & 127)); }, OneK{}, [](int) { return 1.f; }, wi, nw);
            convert_T(W_Ws2T, P.in[I_WS2], 1024, 256, 1024, IdCol{}, [](int n) { return perm_row(n); }, OneK{}, [](int) { return 1.f; }, wi, nw);
        }
    }
    SEAM(0);

    if (IN(1)) {
        TIDS
        const float* g = P.in[I_N1G];
        for (int row = blk * 8 + wave; row < NTOK; row += G * 8) {
            const int b = row >> 12;
            const float* xr = W_x + (size_t)row * DM;
            f32x4 v[4]; float ss = 0.f;
#pragma unroll
            for (int i = 0; i < 4; ++i) { v[i] = *(const f32x4*)(xr + i * 256 + lane * 4); ss += v[i][0] * v[i][0] + v[i][1] * v[i][1] + v[i][2] * v[i][2] + v[i][3] * v[i][3]; }
            ss = wave_sum(ss);
            const float rinv = rsqrtf(ss * (1.0f / 1024.0f) + EPS);
            const float* mb = W_mod + b * 6144;
#pragma unroll
            for (int i = 0; i < 4; ++i) {
                const int c = i * 256 + lane * 4;
                const f32x4 gg = *(const f32x4*)(g + c), sh = *(const f32x4*)(mb + c), sc = *(const f32x4*)(mb + 1024 + c);
                float o[4];
#pragma unroll
                for (int j = 0; j < 4; ++j) o[j] = v[i][j] * rinv * gg[j] * (1.0f + sc[j]) + sh[j];
                u32x2 w; w.x = pk2(o[0], o[1]); w.y = pk2(o[2], o[3]);
                *(u32x2*)(W_hbuf + (size_t)row * DM + c) = w;
            }
        }
    }
    SEAM(1);

    if (IN(2)) {
        TIDS
        unsigned vl_[4]; g8_voff_lin(vl_, DM, tid);
        auto nextf = [&](int i, GDesc& d) {
            const int ul = i * 32 + (vblk & 31); if (ul >= 144 || vblk >= 256) return false;
            const int pm = (vblk >> 5) * 16 + ul / 9, pn = ul % 9;
            d.Ab = (const char*)(W_hbuf + (size_t)pm * 256 * DM); d.Bb = (const char*)(W_WinT + (size_t)pn * 256 * DM);
            d.va0 = vl_[0]; d.va1 = vl_[1]; d.va2 = vl_[2]; d.va3 = vl_[3]; d.i0 = pm; d.i1 = pn; return true;
        };
        auto epi = [&](const f32x4 (&acc)[2][2][4][2], const GDesc& d, int wr, int wc, int fr, int fq) {
            const int pm = d.i0, pn = d.i1;
            if (pn < 8) {
                EPI_FOREACH8(acc, wr, wc, fr, fq, r, c8, v0, v1, {
                    u32x4 w; PK8(w, v0, v1);
                    *(u32x4*)(W_proj + (size_t)(pm * 256 + r) * INCP + pn * 256 + c8) = w;
                })
            } else {
                EPI_FOREACH8(acc, wr, wc, fr, fq, r, c8, v0, v1, {
                    const int row = pm * 256 + r;
                    if (c8 < 160) {
                        f32x4 o0 = v0, o1 = v1;
                        if (c8 >= 128) {
                            const int i = (c8 - 128) >> 1; const int s = row & 4095;
                            const f32x4 ca = *(const f32x4*)(W_ropecs + (s * 16 + i) * 2), cb = *(const f32x4*)(W_ropecs + (s * 16 + i) * 2 + 4);
                            o0[0] = v0[0] * ca[0] - v0[1] * ca[1]; o0[1] = v0[1] * ca[0] + v0[0] * ca[1];
                            o0[2] = v0[2] * ca[2] - v0[3] * ca[3]; o0[3] = v0[3] * ca[2] + v0[2] * ca[3];
                            o1[0] = v1[0] * cb[0] - v1[1] * cb[1]; o1[1] = v1[1] * cb[0] + v1[0] * cb[1];
                            o1[2] = v1[2] * cb[2] - v1[3] * cb[3]; o1[3] = v1[3] * cb[2] + v1[2] * cb[3];
                        }
                        u32x4 w; PK8(w, o0, o1);
                        *(u32x4*)(W_proj + (size_t)row * INCP + 2048 + c8) = w;
                    }
                })
            }
            if (pn >= 6) {
#pragma unroll
                for (int ai = 0; ai < 2; ++ai)
#pragma unroll
                    for (int m = 0; m < 4; ++m)
#pragma unroll
                        for (int bj = 0; bj < 2; ++bj) {
                            const f32x4 a = acc[ai][bj][m][0], b = acc[ai][bj][m][1];
                            float ss = a[0] * a[0] + a[1] * a[1] + a[2] * a[2] + a[3] * a[3] + b[0] * b[0] + b[1] * b[1] + b[2] * b[2] + b[3] * b[3];
                            { float o; const float t = x16f(ss, o); ss = t + o; }
                            { float o; const float t = x32f(ss, o); ss = t + o; }
                            if (fq == 0) W_ssq[(size_t)(pm * 256 + ai * 128 + wr * 64 + m * 16 + fr) * 24 + (pn - 6) * 8 + bj * 4 + wc] = ss;
                        }
            }
        };
        gemm_stream(ldsL, tid, DM, nextf, epi);
    }
    SEAM(2);

    if (IN(3)) {
        {
            TIDS
            const int xb = (vblk >> 5) * 16, lb = vblk & 31;
            __syncthreads();
            for (int j = 0; j < 2; ++j) { const int ul = j * 32 + lb; if (ul < 48 && tid < 256) {
                const float* sp = W_ssq + (size_t)((xb + ul / 3) * 256 + tid) * 24;
                const f32x4 s0 = *(const f32x4*)sp, s1 = *(const f32x4*)(sp + 4), s2 = *(const f32x4*)(sp + 8);
                const float ss = ((s0[0] + s0[1]) + (s0[2] + s0[3])) + ((s1[0] + s1[1]) + (s1[2] + s1[3])) + ((s2[0] + s2[1]) + (s2[2] + s2[3]));
                rowsc[j * 256 + tid] = rsqrtf(ss * (1.0f / 384.0f) + EPS); } }
            __syncthreads();
            unsigned vl_[4]; g8_voff_lin(vl_, INCP, tid);
            auto nextf = [&](int i, GDesc& d) {
                const int ul = i * 32 + lb; if (ul >= 48 || vblk >= 256) return false;
                const int pm = xb + ul / 3, pn = ul % 3;
                d.Ab = (const char*)(W_proj + (size_t)pm * 256 * INCP + 1536); d.Bb = (const char*)(W_WuqT + (size_t)pn * 256 * QLORA);
                d.va0 = vl_[0]; d.va1 = vl_[1]; d.va2 = vl_[2]; d.va3 = vl_[3]; d.i0 = pm * 4 + pn; d.i1 = i; return true;
            };
            auto epi = [&](const f32x4 (&acc)[2][2][4][2], const GDesc& d, int wr, int wc, int fr, int fq) {
                const int pm = d.i0 >> 2, pn = d.i0 & 3, sl = d.i1 * 256;
                if (pn < 2) {
                    EPI_FOREACH8(acc, wr, wc, fr, fq, r, c8, v0, v1, {
                        const float rs = rowsc[sl + r];
                        const f32x4 a = v0 * rs, b = v1 * rs;
                        u32x4 w; PK8(w, a, b);
                        *(u32x4*)(W_qb + (size_t)(pm * 256 + r) * 768 + pn * 256 + c8) = w;
                    })
                } else {
                    EPI_FOREACH8(acc, wr, wc, fr, fq, r, c8, v0, v1, {
                        const int row = pm * 256 + r;
                        const float rs = rowsc[sl + r];
                        const int i = (c8 & 31) >> 1; const int s = row & 4095;
                        const f32x4 ca = *(const f32x4*)(W_ropecs + (s * 16 + i) * 2), cb = *(const f32x4*)(W_ropecs + (s * 16 + i) * 2 + 4);
                        const f32x4 t0 = v0 * rs, t1 = v1 * rs;
                        f32x4 o0, o1;
                        o0[0] = t0[0] * ca[0] - t0[1] * ca[1]; o0[1] = t0[1] * ca[0] + t0[0] * ca[1];
                        o0[2] = t0[2] * ca[2] - t0[3] * ca[3]; o0[3] = t0[3] * ca[2] + t0[2] * ca[3];
                        o1[0] = t1[0] * cb[0] - t1[1] * cb[1]; o1[1] = t1[1] * cb[0] + t1[0] * cb[1];
                        o1[2] = t1[2] * cb[2] - t1[3] * cb[3]; o1[3] = t1[3] * cb[2] + t1[2] * cb[3];
                        u32x4 w; PK8(w, o0, o1);
                        *(u32x4*)(W_qb + (size_t)row * 768 + 512 + c8) = w;
                    })
                }
            };
            gemm_stream(ldsL, tid, QLORA, nextf, epi);
        }
        {
            TIDS
            const int xb = (vblk >> 5) * 16, lb = vblk & 31;
            __syncthreads();
            for (int j = 0; j < 2; ++j) { const int ul = j * 32 + lb; if (tid < 256) {
                const float* sp = W_ssq + (size_t)((xb + ul / 4) * 256 + tid) * 24 + 12;
                const f32x4 s0 = *(const f32x4*)sp, s1 = *(const f32x4*)(sp + 4);
                const float ss = ((s0[0] + s0[1]) + (s0[2] + s0[3])) + ((s1[0] + s1[1]) + (s1[2] + s1[3]));
                rowsc[j * 256 + tid] = rsqrtf(ss * (1.0f / 256.0f) + EPS); } }
            __syncthreads();
            unsigned vl_[4]; g8_voff_lin(vl_, INCP, tid);
            auto nextf = [&](int i, GDesc& d) {
                const int ul = i * 32 + lb; if (ul >= 64 || vblk >= 256) return false;
                const int pm = xb + ul / 4, pn = ul % 4;
                d.Ab = (const char*)(W_proj + (size_t)pm * 256 * INCP + 1920); d.Bb = (const char*)(W_WukvT + (size_t)pn * 256 * KVLORA);
                d.va0 = vl_[0]; d.va1 = vl_[1]; d.va2 = vl_[2]; d.va3 = vl_[3]; d.i0 = pm * 4 + pn; d.i1 = i; return true;
            };
            auto epi = [&](const f32x4 (&acc)[2][2][4][2], const GDesc& d, int wr, int wc, int fr, int fq) {
                const int pm = d.i0 >> 2, pn = d.i0 & 3, sl = d.i1 * 256;
                EPI_FOREACH8(acc, wr, wc, fr, fq, r, c8, v0, v1, {
                    const float rs = rowsc[sl + r];
                    const f32x4 a = v0 * rs, b = v1 * rs;
                    u32x4 w; PK8(w, a, b);
                    *(u32x4*)(W_kvb + (size_t)(pm * 256 + r) * 1024 + pn * 256 + c8) = w;
                })
            };
            gemm_stream(ldsL, tid, KVLORA, nextf, epi);
        }
    }
    SEAM(3);

    if (IN(4)) {
        for (int ui = 0; ui < ((P.flags & 4) ? 0 : 4); ++ui) {
            TIDS
            const int r32 = lane & 31, hh = lane >> 5;
            if (vblk >= 256) break;
            const int qblk = vblk & 15, bh = (vblk >> 5) * 8 + ui * 2 + ((vblk >> 4) & 1), h = bh & 7, b = bh >> 3;
            const size_t tok0 = (size_t)b * SEQ;
            bf16x8 qf[6];
            {
                const size_t tq = tok0 + qblk * 256 + wave * 32 + r32;
#pragma unroll
                for (int d0 = 0; d0 < 6; ++d0) qf[d0] = *(const bf16x8*)(W_qb + tq * 768 + (d0 < 4 ? h * 64 + d0 * 16 : 512 + h * 32 + (d0 - 4) * 16) + hh * 8);
            }
            f32x16 o0 = {}, o1 = {};
            f32x16 mneg = {};
            float m_run = 0.f, l_run = 0.f;
            const int skey = tid >> 3, sch = tid & 7;
            const bf16_t* kn_src = W_kvb + (tok0 + skey) * 1024 + h * 128 + sch * 8;
            const int pkey = tid >> 2, pch = tid & 3;
            const bf16_t* kp_src = W_proj + (tok0 + pkey) * INCP + 2176 + pch * 8;
            constexpr int KBUF = 12 * 2048, VBUF = 2 * 8192, BUFB = KBUF + VBUF;
            const int k_dst = sch * 2048 + ((skey ^ sch) * 16);
            const int kp_dst = (8 + pch) * 2048 + ((pkey ^ pch) * 16);
            const int v_dst = KBUF + (sch >> 2) * 8192 + skey * 64 + (sch & 3) * 16;
            const int kfo = hh * 2048;
            const int vfo = KBUF + (4 * hh + ((lane & 15) >> 2)) * 64 + ((lane >> 4) & 1) * 32 + (lane & 3) * 8;
            __syncthreads();
            {
                const u32x4 k0 = *(const u32x4*)kn_src, v0 = *(const u32x4*)(kn_src + 64);
                const u32x4 k1 = *(const u32x4*)(kn_src + 64 * 1024), v1 = *(const u32x4*)(kn_src + 64 * 1024 + 64);
                const u32x4 pr = *(const u32x4*)kp_src;
                *(LAS u32x4*)(ldsL + k_dst) = k0; *(LAS u32x4*)(ldsL + k_dst + 1024) = k1;
                *(LAS u32x4*)(ldsL + v_dst) = v0; *(LAS u32x4*)(ldsL + v_dst + 4096) = v1;
                *(LAS u32x4*)(ldsL + kp_dst) = pr;
            }
            __syncthreads();
#pragma unroll 1
            for (int t = 0; t < 32; ++t) {
                const int cur = t & 1;
                const int tn = (t + 1 < 32) ? t + 1 : t;
                const bf16_t* ks = kn_src + (size_t)tn * 128 * 1024;
                const u32x4 nk0 = *(const u32x4*)ks, nv0 = *(const u32x4*)(ks + 64);
                const u32x4 nk1 = *(const u32x4*)(ks + 64 * 1024), nv1 = *(const u32x4*)(ks + 64 * 1024 + 64);
                const u32x4 npr = *(const u32x4*)(kp_src + (size_t)tn * 128 * INCP);
#pragma unroll
                for (int sub = 0; sub < 2; ++sub) {
                    const int kb = cur * BUFB + kfo + sub * 1024, vb = cur * BUFB + vfo + sub * 4096;
                    f32x16 s0, s1;
#pragma unroll
                    for (int d0 = 0; d0 < 6; ++d0) {
                        const int sw = (2 * d0 + hh) & 7;
                        const bf16x8 k0 = *(const LAS bf16x8*)(ldsL + kb + d0 * 4096 + ((r32 ^ sw) * 16));
                        const bf16x8 k1 = *(const LAS bf16x8*)(ldsL + kb + d0 * 4096 + (((32 + r32) ^ sw) * 16));
                        if (d0 == 0) { s0 = __builtin_amdgcn_mfma_f32_32x32x16_bf16(k0, qf[0], mneg, 0, 0, 0); s1 = __builtin_amdgcn_mfma_f32_32x32x16_bf16(k1, qf[0], mneg, 0, 0, 0); }
                        else { s0 = __builtin_amdgcn_mfma_f32_32x32x16_bf16(k0, qf[d0], s0, 0, 0, 0); s1 = __builtin_amdgcn_mfma_f32_32x32x16_bf16(k1, qf[d0], s1, 0, 0, 0); }
                    }
                    float mx = fmaxf(s0[0], s1[0]);
#pragma unroll
                    for (int i = 1; i < 16; ++i) mx = fmaxf(mx, fmaxf(s0[i], s1[i]));
                    mx = max32(mx);
                    const bool first = (t == 0 && sub == 0);
                    if (first || __builtin_amdgcn_ballot_w64(mx > 8.0f) != 0ull) {
                        const float d = first ? mx : fmaxf(mx, 0.f);
                        const float alpha = first ? 0.f : ex2(-d);
                        m_run += d; l_run *= alpha;
#pragma unroll
                        for (int i = 0; i < 16; ++i) { o0[i] *= alpha; o1[i] *= alpha; s0[i] -= d; s1[i] -= d; mneg[i] = -m_run; }
                    }
                    float ps = 0.f;
#pragma unroll
                    for (int i = 0; i < 16; ++i) { s0[i] = ex2(s0[i]); s1[i] = ex2(s1[i]); ps += s0[i] + s1[i]; }
                    l_run += ps;
                    bf16x8 pf[2][2];
#pragma unroll
                    for (int s = 0; s < 2; ++s) {
                        u32x4 w0, w1;
                        w0.x = pk2(s0[8 * s + 0], s0[8 * s + 1]); w0.y = pk2(s0[8 * s + 2], s0[8 * s + 3]); w0.z = pk2(s0[8 * s + 4], s0[8 * s + 5]); w0.w = pk2(s0[8 * s + 6], s0[8 * s + 7]);
                        w1.x = pk2(s1[8 * s + 0], s1[8 * s + 1]); w1.y = pk2(s1[8 * s + 2], s1[8 * s + 3]); w1.z = pk2(s1[8 * s + 4], s1[8 * s + 5]); w1.w = pk2(s1[8 * s + 6], s1[8 * s + 7]);
                        pf[0][s] = __builtin_bit_cast(bf16x8, w0); pf[1][s] = __builtin_bit_cast(bf16x8, w1);
                    }
#pragma unroll
                    for (int n = 0; n < 2; ++n)
#pragma unroll
                        for (int s = 0; s < 2; ++s) {
                            const int ko = (32 * n + 16 * s) * 64;
#pragma unroll
                            for (int db = 0; db < 2; ++db) {
                                const s16x4 lo = __builtin_bit_cast(s16x4, __builtin_amdgcn_ds_read_tr16_b64_v4i16((LAS s16x4*)(ldsL + vb + db * 8192 + ko)));
                                const s16x4 hi = __builtin_bit_cast(s16x4, __builtin_amdgcn_ds_read_tr16_b64_v4i16((LAS s16x4*)(ldsL + vb + db * 8192 + ko + 512)));
                                const bf16x8 vf = {lo[0], lo[1], lo[2], lo[3], hi[0], hi[1], hi[2], hi[3]};
                                if (db == 0) o0 = __builtin_amdgcn_mfma_f32_32x32x16_bf16(vf, pf[n][s], o0, 0, 0, 0);
                                else o1 = __builtin_amdgcn_mfma_f32_32x32x16_bf16(vf, pf[n][s], o1, 0, 0, 0);
                            }
                        }
                }
                {
                    const int nb = (cur ^ 1) * BUFB;
                    *(LAS u32x4*)(ldsL + nb + k_dst) = nk0; *(LAS u32x4*)(ldsL + nb + k_dst + 1024) = nk1;
                    *(LAS u32x4*)(ldsL + nb + v_dst) = nv0; *(LAS u32x4*)(ldsL + nb + v_dst + 4096) = nv1;
                    *(LAS u32x4*)(ldsL + nb + kp_dst) = npr;
                }
                __syncthreads();
            }
            {
                const float lt = sum32(l_run);
                const float inv = 1.0f / lt;
                const int sc = 81920 + wave * 4352;
#pragma unroll
                for (int g = 0; g < 4; ++g) {
                    u32x2 w;
                    w.x = pk2(o0[4 * g] * inv, o0[4 * g + 1] * inv); w.y = pk2(o0[4 * g + 2] * inv, o0[4 * g + 3] * inv);
                    *(LAS u32x2*)(ldsL + sc + r32 * 136 + (8 * g + 4 * hh) * 2) = w;
                    w.x = pk2(o1[4 * g] * inv, o1[4 * g + 1] * inv); w.y = pk2(o1[4 * g + 2] * inv, o1[4 * g + 3] * inv);
                    *(LAS u32x2*)(ldsL + sc + r32 * 136 + (32 + 8 * g + 4 * hh) * 2) = w;
                }
                __syncthreads();
#pragma unroll
                for (int it = 0; it < 8; ++it) {
                    const int row = it * 4 + (lane >> 4), pc = lane & 15;
                    const u32x2 w = *(const LAS u32x2*)(ldsL + sc + row * 136 + pc * 8);
                    *(u32x2*)(W_bout + (tok0 + qblk * 256 + wave * 32 + row) * 512 + h * 64 + pc * 4) = w;
                }
            }
            {
                const int j = ui >> 1; const int uu = blk + j * G;
                const int e = (G == 256) ? ((vblk & ~1) + j) : (uu >> 1), pn = (G == 256) ? (vblk & 1) : (uu & 1);
                __syncthreads();
                if (uu < 512) convert_panel_lds<128, true>(W_scr + (size_t)j * 256 * 1024 + (ui & 1) * 128 * 1024, P.in[(ui & 1) ? I_W3 : I_W1] + (size_t)e * 1024 * 256 + pn * 128, 256, 1024, tid, ldsL);
            }
        }
        for (int ui = 0; ui < ((P.flags & 8) ? 0 : 12); ++ui) {
            TIDS
            const int r32 = lane & 31, hh = lane >> 5;
            const int u = vblk * 12 + ui;
            if (u >= 3072) break;
            const int bh = u / 48, w48 = u % 48, h = bh & 7, b = bh >> 3;
            const int p = w48 >> 4, j16 = w48 & 15;
            const int dil = (p == 0) ? 1 : (p == 1 ? 4 : 16);
            const int res = (p == 0) ? 0 : (p == 1 ? (j16 >> 2) : j16);
            const int m0 = (p == 0) ? j16 * 256 : (p == 1 ? (j16 & 3) * 256 : 0);
            const int L = SEQ / dil;
            const size_t tok0 = (size_t)b * SEQ;
            __syncthreads();
            for (int idx = tid; idx < 672; idx += 512) { const int oi = idx - 255; *(LAS float*)(ldsL + 98304 + idx * 4) = (oi >= 0 && oi <= 128) ? W_biasT[(p * 8 + h) * 129 + oi] : -1e30f; }
            {
                u32x4 kr[6], vr[6];
#pragma unroll
                for (int it = 0; it < 6; ++it) {
                    const int idx = it * 512 + tid, row = idx >> 3, ch = idx & 7;
                    const int mk = m0 - 64 + row;
                    kr[it] = (u32x4){0, 0, 0, 0}; vr[it] = (u32x4){0, 0, 0, 0};
                    if (mk >= 0 && mk < L) {
                        const bf16_t* src = W_proj + (tok0 + (size_t)mk * dil + res) * INCP + 512 + h * 64 + ch * 8;
                        kr[it] = *(const u32x4*)src; vr[it] = *(const u32x4*)(src + 512);
                    }
                }
#pragma unroll
                for (int it = 0; it < 6; ++it) {
                    const int idx = it * 512 + tid, row = idx >> 3, ch = idx & 7;
                    *(LAS u32x4*)(ldsL + ch * 6144 + ((row ^ ch) * 16)) = kr[it];
                    *(LAS u32x4*)(ldsL + 49152 + (ch >> 2) * 24576 + row * 64 + (ch & 3) * 16) = vr[it];
                }
            }
            const int qrel = wave * 32 + r32;
            const size_t tq = tok0 + (size_t)(m0 + qrel) * dil + res;
            bf16x8 qf[4];
#pragma unroll
            for (int d0 = 0; d0 < 4; ++d0) qf[d0] = *(const bf16x8*)(W_proj + tq * INCP + h * 64 + d0 * 16 + hh * 8);
            __syncthreads();
            f32x16 o0 = {}, o1 = {};
            float m_run = -1e20f, l_run = 0.f;
            const int vfo = 49152 + (4 * hh + ((lane & 15) >> 2)) * 64 + ((lane >> 4) & 1) * 32 + (lane & 3) * 8;
#pragma unroll 1
            for (int jj = 0; jj < 3; ++jj) {
                const int jt = (wave >> 1) + jj;
                f32x16 s0 = {}, s1 = {};
#pragma unroll
                for (int d0 = 0; d0 < 4; ++d0) {
                    const int ch = 2 * d0 + hh;
                    const bf16x8 k0 = *(const LAS bf16x8*)(ldsL + ch * 6144 + (((64 * jt + r32) ^ ch) * 16));
                    const bf16x8 k1 = *(const LAS bf16x8*)(ldsL + ch * 6144 + (((64 * jt + 32 + r32) ^ ch) * 16));
                    s0 = __builtin_amdgcn_mfma_f32_32x32x16_bf16(k0, qf[d0], s0, 0, 0, 0);
                    s1 = __builtin_amdgcn_mfma_f32_32x32x16_bf16(k1, qf[d0], s1, 0, 0, 0);
                }
                const LAS float* bl = (const LAS float*)(ldsL + 98304) + (64 * jt - qrel + 4 * hh + 255);
                const int mkb = m0 - 64 + 64 * jt;
                const bool edge = (mkb < 0) || (mkb + 64 > L);
                float mx = -1e30f;
#pragma unroll
                for (int i = 0; i < 16; ++i) {
                    const int cr = (i & 3) + 8 * (i >> 2);
                    s0[i] += bl[cr]; s1[i] += bl[cr + 32];
                    if (edge) {
                        const int mk0 = mkb + cr + 4 * hh;
                        if (mk0 < 0 || mk0 >= L) s0[i] = -1e30f;
                        if (mk0 + 32 < 0 || mk0 + 32 >= L) s1[i] = -1e30f;
                    }
                    mx = fmaxf(mx, fmaxf(s0[i], s1[i]));
                }
                mx = max32(mx);
                const float m_new = fmaxf(m_run, mx);
                const float alpha = ex2(m_run - m_new);
                m_run = m_new;
                float ps = 0.f;
#pragma unroll
                for (int i = 0; i < 16; ++i) { s0[i] = ex2(s0[i] - m_new); s1[i] = ex2(s1[i] - m_new); ps += s0[i] + s1[i]; }
                l_run = l_run * alpha + ps;
#pragma unroll
                for (int i = 0; i < 16; ++i) { o0[i] *= alpha; o1[i] *= alpha; }
                bf16x8 pf[2][2];
#pragma unroll
                for (int s = 0; s < 2; ++s) {
                    u32x4 w0, w1;
                    w0.x = pk2(s0[8 * s + 0], s0[8 * s + 1]); w0.y = pk2(s0[8 * s + 2], s0[8 * s + 3]); w0.z = pk2(s0[8 * s + 4], s0[8 * s + 5]); w0.w = pk2(s0[8 * s + 6], s0[8 * s + 7]);
                    w1.x = pk2(s1[8 * s + 0], s1[8 * s + 1]); w1.y = pk2(s1[8 * s + 2], s1[8 * s + 3]); w1.z = pk2(s1[8 * s + 4], s1[8 * s + 5]); w1.w = pk2(s1[8 * s + 6], s1[8 * s + 7]);
                    pf[0][s] = __builtin_bit_cast(bf16x8, w0); pf[1][s] = __builtin_bit_cast(bf16x8, w1);
                }
#pragma unroll
                for (int n = 0; n < 2; ++n)
#pragma unroll
                    for (int s = 0; s < 2; ++s) {
                        const int ko = (64 * jt + 32 * n + 16 * s) * 64;
#pragma unroll
                        for (int db = 0; db < 2; ++db) {
                            const s16x4 lo = __builtin_bit_cast(s16x4, __builtin_amdgcn_ds_read_tr16_b64_v4i16((LAS s16x4*)(ldsL + vfo + db * 24576 + ko)));
                            const s16x4 hi = __builtin_bit_cast(s16x4, __builtin_amdgcn_ds_read_tr16_b64_v4i16((LAS s16x4*)(ldsL + vfo + db * 24576 + ko + 512)));
                            const bf16x8 vf = {lo[0], lo[1], lo[2], lo[3], hi[0], hi[1], hi[2], hi[3]};
                            if (db == 0) o0 = __builtin_amdgcn_mfma_f32_32x32x16_bf16(vf, pf[n][s], o0, 0, 0, 0);
                            else o1 = __builtin_amdgcn_mfma_f32_32x32x16_bf16(vf, pf[n][s], o1, 0, 0, 0);
                        }
                    }
            }
            __syncthreads();
            {
                const float lt = sum32(l_run);
                const float inv = 1.0f / lt;
                if (hh == 0) W_lsebuf[((size_t)p * NTOK + tq) * 8 + h] = m_run + __log2f(lt);
                const int sc = wave * 4352;
#pragma unroll
                for (int g = 0; g < 4; ++g) {
                    u32x2 w;
                    w.x = pk2(o0[4 * g] * inv, o0[4 * g + 1] * inv); w.y = pk2(o0[4 * g + 2] * inv, o0[4 * g + 3] * inv);
                    *(LAS u32x2*)(ldsL + sc + r32 * 136 + (8 * g + 4 * hh) * 2) = w;
                    w.x = pk2(o1[4 * g] * inv, o1[4 * g + 1] * inv); w.y = pk2(o1[4 * g + 2] * inv, o1[4 * g + 3] * inv);
                    *(LAS u32x2*)(ldsL + sc + r32 * 136 + (32 + 8 * g + 4 * hh) * 2) = w;
                }
                __syncthreads();
#pragma unroll
                for (int it = 0; it < 8; ++it) {
                    const int row = it * 4 + (lane >> 4), pc = lane & 15;
                    const u32x2 w = *(const LAS u32x2*)(ldsL + sc + row * 136 + pc * 8);
                    const size_t tr = tok0 + (size_t)(m0 + wave * 32 + row) * dil + res;
                    *(u32x2*)(W_aparts + ((size_t)p * NTOK + tr) * 512 + h * 64 + pc * 4) = w;
                }
            }
            if (ui % 3 == 0) {
                const int q = ui / 3; const int uu = blk + q * G;
                const int e = (G == 256) ? ((vblk & ~3) + q) : (uu >> 2), pn = (G == 256) ? (vblk & 3) : (uu & 3);
                __syncthreads();
                if (uu < 1024) convert_panel_lds<256, true>(W_scr + (size_t)2 * 256 * 1024 + (size_t)q * 256 * 256, P.in[I_W2] + (size_t)e * 256 * 1024 + pn * 256, 1024, 256, tid, ldsL);
            }
        }
    }
    SEAM(4);

    if (IN(5)) {
        TIDS
        for (int row = blk * 8 + wave; row < NTOK; row += G * 8) {
            const int hd = lane >> 3;
            float ls0 = W_lsebuf[((size_t)0 * NTOK + row) * 8 + hd], ls1 = W_lsebuf[((size_t)1 * NTOK + row) * 8 + hd], ls2 = W_lsebuf[((size_t)2 * NTOK + row) * 8 + hd];
            const float M = fmaxf(ls0, fmaxf(ls1, ls2));
            float w0 = ex2(ls0 - M), w1 = ex2(ls1 - M), w2 = ex2(ls2 - M);
            const float wsn = 1.0f / (w0 + w1 + w2); w0 *= wsn; w1 *= wsn; w2 *= wsn;
            const u32x4 a0 = *(const u32x4*)(W_aparts + ((size_t)0 * NTOK + row) * 512 + lane * 8);
            const u32x4 a1 = *(const u32x4*)(W_aparts + ((size_t)1 * NTOK + row) * 512 + lane * 8);
            const u32x4 a2 = *(const u32x4*)(W_aparts + ((size_t)2 * NTOK + row) * 512 + lane * 8);
            const u32x4 bb = *(const u32x4*)(W_bout + (size_t)row * 512 + lane * 8);
            float av[8], bv[8]; float sa = 0.f, sb = 0.f;
#pragma unroll
            for (int j = 0; j < 4; ++j) {
                av[2 * j] = w0 * __uint_as_float(a0[j] << 16) + w1 * __uint_as_float(a1[j] << 16) + w2 * __uint_as_float(a2[j] << 16);
                av[2 * j + 1] = w0 * __uint_as_float(a0[j] & 0xffff0000u) + w1 * __uint_as_float(a1[j] & 0xffff0000u) + w2 * __uint_as_float(a2[j] & 0xffff0000u);
                bv[2 * j] = __uint_as_float(bb[j] << 16); bv[2 * j + 1] = __uint_as_float(bb[j] & 0xffff0000u);
                sa += av[2 * j] * av[2 * j] + av[2 * j + 1] * av[2 * j + 1];
                sb += bv[2 * j] * bv[2 * j] + bv[2 * j + 1] * bv[2 * j + 1];
            }
            sa = wave_sum(sa); sb = wave_sum(sb);
            const float ra = rsqrtf(sa * (1.0f / 512.0f) + EPS), rb = rsqrtf(sb * (1.0f / 512.0f) + EPS);
            u32x4 wa, wb;
            wa.x = pk2(av[0] * ra, av[1] * ra); wa.y = pk2(av[2] * ra, av[3] * ra); wa.z = pk2(av[4] * ra, av[5] * ra); wa.w = pk2(av[6] * ra, av[7] * ra);
            wb.x = pk2(bv[0] * rb, bv[1] * rb); wb.y = pk2(bv[2] * rb, bv[3] * rb); wb.z = pk2(bv[4] * rb, bv[5] * rb); wb.w = pk2(bv[6] * rb, bv[7] * rb);
            *(u32x4*)(W_mixb + (size_t)row * DM + lane * 8) = wa;
            *(u32x4*)(W_mixb + (size_t)row * DM + 512 + lane * 8) = wb;
        }
    }
    SEAM(5);

    if (IN(6)) {
        TIDS
        unsigned vl_[4]; g8_voff_lin(vl_, DM, tid);
        auto nextf = [&](int i, GDesc& d) {
            const int ul = i * 32 + (vblk & 31); if (ul >= 64 || vblk >= 256) return false;
            const int pm = (vblk >> 5) * 16 + (ul >> 2), pn = ul & 3;
            d.Ab = (const char*)(W_mixb + (size_t)pm * 256 * DM); d.Bb = (const char*)(W_WoT + (size_t)pn * 256 * DM);
            d.va0 = vl_[0]; d.va1 = vl_[1]; d.va2 = vl_[2]; d.va3 = vl_[3]; d.i0 = pm; d.i1 = pn; return true;
        };
        auto epi = [&](const f32x4 (&acc)[2][2][4][2], const GDesc& d, int wr, int wc, int fr, int fq) {
            const int pm = d.i0, pn = d.i1;
            EPI_FOREACH8(acc, wr, wc, fr, fq, r, c8, v0, v1, {
                const int col = pn * 256 + c8; const int row = pm * 256 + r;
                const float* gp = W_mod + (row >> 12) * 6144 + 2048 + col;
                const f32x4 ga = *(const f32x4*)gp, gb = *(const f32x4*)(gp + 4);
                *(f32x4*)(P.out + (size_t)row * DM + col) = ga * v0;
                *(f32x4*)(P.out + (size_t)row * DM + col + 4) = gb * v1;
            })
        };
        gemm_stream(ldsL, tid, DM, nextf, epi);
    }
    SEAM(6);

    if (IN(7)) {
        TIDS
        const float* g = P.in[I_N2G];
        for (int row = blk * 8 + wave; row < NTOK; row += G * 8) {
            const int b = row >> 12;
            float* xr = P.out + (size_t)row * DM;
            const float* x0 = W_x + (size_t)row * DM;
            f32x4 v[4]; float ss = 0.f;
#pragma unroll
            for (int i = 0; i < 4; ++i) { v[i] = *(const f32x4*)(xr + i * 256 + lane * 4) + *(const f32x4*)(x0 + i * 256 + lane * 4); *(f32x4*)(xr + i * 256 + lane * 4) = v[i];
                ss += v[i][0] * v[i][0] + v[i][1] * v[i][1] + v[i][2] * v[i][2] + v[i][3] * v[i][3]; }
            ss = wave_sum(ss);
            const float rinv = rsqrtf(ss * (1.0f / 1024.0f) + EPS);
            const float* mb = W_mod + b * 6144 + 3072;
#pragma unroll
            for (int i = 0; i < 4; ++i) {
                const int c = i * 256 + lane * 4;
                const f32x4 gg = *(const f32x4*)(g + c), sh = *(const f32x4*)(mb + c), sc = *(const f32x4*)(mb + 1024 + c);
                float o[4];
#pragma unroll
                for (int j = 0; j < 4; ++j) o[j] = v[i][j] * rinv * gg[j] * (1.0f + sc[j]) + sh[j];
                u32x2 w; w.x = pk2(o[0], o[1]); w.y = pk2(o[2], o[3]);
                *(u32x2*)(W_hbuf + (size_t)row * DM + c) = w;
            }
        }
    }
    SEAM(7);

    if (IN(8)) {
        {
            TIDS
            unsigned vl_[4]; g8_voff_lin(vl_, DM, tid);
            auto nextf = [&](int i, GDesc& d) {
                const int ul = vblk & 31; if (i > 0 || vblk >= 256) return false;
                const int pm = (vblk >> 5) * 16 + (ul >> 1), pn = ul & 1;
                d.Ab = (const char*)(W_hbuf + (size_t)pm * 256 * DM); d.Bb = (const char*)(W_Ws13T + (size_t)pn * 256 * DM);
                d.va0 = vl_[0]; d.va1 = vl_[1]; d.va2 = vl_[2]; d.va3 = vl_[3]; d.i0 = pm; d.i1 = pn; return true;
            };
            auto epi = [&](const f32x4 (&acc)[2][2][4][2], const GDesc& d, int wr, int wc, int fr, int fq) {
                const int pm = d.i0, pn = d.i1;
#pragma unroll
                for (int ai = 0; ai < 2; ++ai)
#pragma unroll
                    for (int m = 0; m < 4; ++m) {
                        const int r = ai * 128 + wr * 64 + m * 16 + fr;
                        const f32x4 a0 = acc[ai][0][m][0], a1 = acc[ai][0][m][1], b0 = acc[ai][1][m][0], b1 = acc[ai][1][m][1];
                        f32x4 h0, h1;
#pragma unroll
                        for (int j = 0; j < 4; ++j) { h0[j] = siluf(a0[j]) * b0[j]; h1[j] = siluf(a1[j]) * b1[j]; }
                        u32x4 w; PK8(w, h0, h1);
                        *(u32x4*)(W_hdn + (size_t)(NASG + pm * 256 + r) * EFF + pn * 128 + wc * 32 + fq * 8) = w;
                    }
            };
            gemm_stream(ldsL, tid, DM, nextf, epi);
        }
        {
            TIDS
            unsigned vl_[4]; g8_voff_lin(vl_, DM, tid);
            auto nextf = [&](int i, GDesc& d) {
                const int ul = vblk & 31; if (i > 0 || ul < 16 || vblk >= 256) return false;
                const int pm = (vblk >> 5) * 16 + (ul - 16);
                d.Ab = (const char*)(W_hbuf + (size_t)pm * 256 * DM); d.Bb = (const char*)(W_WrT);
                d.va0 = vl_[0]; d.va1 = vl_[1]; d.va2 = vl_[2]; d.va3 = vl_[3]; d.i0 = pm; d.i1 = 0; return true;
            };
            auto epi = [&](const f32x4 (&acc)[2][2][4][2], const GDesc& d, int wr, int wc, int fr, int fq) {
                const int pm = d.i0;
                EPI_FOREACH8(acc, wr, wc, fr, fq, r, c8, v0, v1, {
                    *(f32x4*)(W_logits + (size_t)(pm * 256 + r) * 256 + c8) = v0;
                    *(f32x4*)(W_logits + (size_t)(pm * 256 + r) * 256 + c8 + 4) = v1;
                })
            };
            gemm_stream(ldsL, tid, DM, nextf, epi);
        }
    }
    SEAM(8);

    if (IN(9)) {
        TIDS
        const float* ebias = P.in[I_EB];
        const f32x4 eb = *(const f32x4*)(ebias + lane * 4);
        for (int t = blk * 8 + wave; t < NTOK; t += G * 8) {
            const f32x4 lg = *(const f32x4*)(W_logits + (size_t)t * 256 + lane * 4);
            float sc[4], sel[4];
#pragma unroll
            for (int i = 0; i < 4; ++i) { sc[i] = 1.0f / (1.0f + expf(-lg[i])); sel[i] = sc[i] + eb[i]; }
            float a1 = fmaxf(sel[0], sel[1]), a2 = fminf(sel[0], sel[1]);
#pragma unroll
            for (int i = 2; i < 4; ++i) { const float v = sel[i]; a2 = fmaxf(a2, fminf(a1, v)); a1 = fmaxf(a1, v); }
            {
                float b1, b2, n1, n2;
                b1 = dppf(a1, DPP_X1); b2 = dppf(a2, DPP_X1); n1 = fmaxf(a1, b1); n2 = fmaxf(fminf(a1, b1), fmaxf(a2, b2)); a1 = n1; a2 = n2;
                b1 = dppf(a1, DPP_X2); b2 = dppf(a2, DPP_X2); n1 = fmaxf(a1, b1); n2 = fmaxf(fminf(a1, b1), fmaxf(a2, b2)); a1 = n1; a2 = n2;
                b1 = dppf(a1, DPP_HM); b2 = dppf(a2, DPP_HM); n1 = fmaxf(a1, b1); n2 = fmaxf(fminf(a1, b1), fmaxf(a2, b2)); a1 = n1; a2 = n2;
            }
            const float gs = a1 + a2; const int myg = lane >> 3;
            int rank = 0;
#pragma unroll
            for (int g = 0; g < 8; ++g) { const float v = __int_as_float(__builtin_amdgcn_readlane(__float_as_int(gs), g * 8)); rank += (v > gs || (v == gs && g < myg)) ? 1 : 0; }
            const bool gsel = rank < 4;
            float cand[4];
#pragma unroll
            for (int i = 0; i < 4; ++i) cand[i] = gsel ? sel[i] : -INFINITY;
            int my_e = 0; float my_g = 0.f; float gsum = 0.f;
#pragma unroll
            for (int k = 0; k < 8; ++k) {
                float bv = cand[0]; int bi = 0;
#pragma unroll
                for (int i = 1; i < 4; ++i) if (cand[i] > bv) { bv = cand[i]; bi = i; }
                float v = bv; int ix = lane * 4 + bi;
#define AMX(ov, oi) do { const float ov_ = (ov); const int oi_ = (oi); if (ov_ > v || (ov_ == v && oi_ < ix)) { v = ov_; ix = oi_; } } while (0)
                AMX(dppf(v, DPP_X1), dppi(ix, DPP_X1)); AMX(dppf(v, DPP_X2), dppi(ix, DPP_X2)); AMX(dppf(v, DPP_HM), dppi(ix, DPP_HM)); AMX(dppf(v, DPP_RM), dppi(ix, DPP_RM));
                { auto rv = __builtin_amdgcn_permlane16_swap(__float_as_uint(v), __float_as_uint(v), false, false); auto ri = __builtin_amdgcn_permlane16_swap((unsigned)ix, (unsigned)ix, false, false);
                  v = __uint_as_float(rv[0]); ix = (int)ri[0]; AMX(__uint_as_float(rv[1]), (int)ri[1]); }
                { auto rv = __builtin_amdgcn_permlane32_swap(__float_as_uint(v), __float_as_uint(v), false, false); auto ri = __builtin_amdgcn_permlane32_swap((unsigned)ix, (unsigned)ix, false, false);
                  v = __uint_as_float(rv[0]); ix = (int)ri[0]; AMX(__uint_as_float(rv[1]), (int)ri[1]); }
#undef AMX
                ix = __builtin_amdgcn_readfirstlane(ix);
                float myscore = 0.f;
#pragma unroll
                for (int i = 0; i < 4; ++i) if (lane * 4 + i == ix) { cand[i] = -INFINITY; myscore = sc[i]; }
                const float gw = __int_as_float(__builtin_amdgcn_readlane(__float_as_int(myscore), ix >> 2));
                gsum += gw;
                if (lane == k) { my_e = ix; my_g = gw; }
            }
            if (lane < 8) {
                const unsigned rk = atomicAdd(&cntg[my_e * CNT_STRIDE], 1u);
                W_eidx[t * 8 + lane] = my_e; W_gate[t * 8 + lane] = my_g / gsum * 2.5f; W_rnk[t * 8 + lane] = (int)rk;
            }
        }
    }
    SEAM(9);

    if (IN(10)) {
        TIDS
        if (tid < 256) cntL[tid] = (int)__hip_atomic_load(&cntg[tid * CNT_STRIDE], __ATOMIC_RELAXED, __HIP_MEMORY_SCOPE_AGENT);
        __syncthreads();
        if (tid < 256) { int s = 0; for (int j = 0; j < tid; ++j) s += cntL[j]; startL[tid] = s; }
        __syncthreads();
        for (int t = blk * 8 + wave; t < NTOK; t += G * 8) {
            if (lane < 8) {
                const int e = W_eidx[t * 8 + lane];
                const int d = startL[e] + W_rnk[t * 8 + lane];
                W_toks[d] = t; W_wts[d] = W_gate[t * 8 + lane]; W_pos[t * 8 + lane] = d;
            }
        }
    }
    SEAM(10);

    if (IN(11)) {
        TIDS
        __syncthreads();
        if (tid < 256) cntL[tid] = (int)__hip_atomic_load(&cntg[tid * CNT_STRIDE], __ATOMIC_RELAXED, __HIP_MEMORY_SCOPE_AGENT);
        __syncthreads();
        if (tid < 256) { int s = 0; for (int j = 0; j < tid; ++j) s += cntL[j]; startL[tid] = s; }
        __syncthreads();
        for (int ui = blk; ui < 512; ui += G) {
            TIDS
            const int e = (G == 256) ? ((vblk & ~1) + (ui >> 8)) : (ui >> 1), pn = (G == 256) ? (vblk & 1) : (ui & 1);
            const int cnt = cntL[e], st = startL[e];
            if (cnt == 0) continue;
            const bf16_t* panel = W_scr + (size_t)(ui / G) * 256 * 1024;
            const int ntile = (cnt + 255) >> 8;
            for (int c0 = 0; c0 < ntile; c0 += 8) {
                TIDS
                const int nch = (ntile - c0) < 8 ? (ntile - c0) : 8;
                __syncthreads();
                for (int idx = tid; idx < nch * 256; idx += 512) { const int rr = c0 * 256 + idx; const int sr = st + (rr < cnt ? rr : 0); rowoff[idx] = (unsigned)W_toks[sr] * DM; }
                __syncthreads();
                int R0, C0; g8_rc(tid, R0, C0);
                auto nextf = [&](int i, GDesc& d) {
                    if (i >= nch) return false;
                    d.Ab = (const char*)W_hbuf; d.Bb = (const char*)panel;
                    d.va0 = (rowoff[i * 256 + R0] + C0) * 2u; d.va1 = (rowoff[i * 256 + R0 + 64] + C0) * 2u; d.va2 = (rowoff[i * 256 + R0 + 128] + C0) * 2u; d.va3 = (rowoff[i * 256 + R0 + 192] + C0) * 2u;
                    d.i0 = c0 + i; d.i1 = 0; return true;
                };
                auto epi = [&](const f32x4 (&acc)[2][2][4][2], const GDesc& d, int wr, int wc, int fr, int fq) {
                    const int ti = d.i0;
#pragma unroll
                    for (int ai = 0; ai < 2; ++ai)
#pragma unroll
                        for (int m = 0; m < 4; ++m) {
                            const int r = ai * 128 + wr * 64 + m * 16 + fr;
                            const int rr = ti * 256 + r;
                            if (rr < cnt) {
                                const f32x4 a0 = acc[ai][0][m][0], a1 = acc[ai][0][m][1], b0 = acc[ai][1][m][0], b1 = acc[ai][1][m][1];
                                f32x4 h0, h1;
#pragma unroll
                                for (int j = 0; j < 4; ++j) { h0[j] = siluf(a0[j]) * b0[j]; h1[j] = siluf(a1[j]) * b1[j]; }
                                u32x4 w; PK8(w, h0, h1);
                                *(u32x4*)(W_hdn + (size_t)(st + rr) * EFF + pn * 128 + wc * 32 + fq * 8) = w;
                            }
                        }
                };
                gemm_stream(ldsL, tid, DM, nextf, epi);
            }
        }
    }
    SEAM(11);

    if (IN(12)) {
        TIDS
        __syncthreads();
        if (tid < 256) cntL[tid] = (int)__hip_atomic_load(&cntg[tid * CNT_STRIDE], __ATOMIC_RELAXED, __HIP_MEMORY_SCOPE_AGENT);
        __syncthreads();
        if (tid < 256) { int s = 0; for (int j = 0; j < tid; ++j) s += cntL[j]; startL[tid] = s; }
        __syncthreads();
#define Y_STORE(ROWG, COL0, G_) do { _Pragma("unroll") for (int bj = 0; bj < 2; ++bj) { const f32x4 a_ = acc[ai][bj][m][0], b_ = acc[ai][bj][m][1]; int w0_ = 0, w1_ = 0; \
            w0_ = __builtin_amdgcn_cvt_pk_fp8_f32(a_[0] * (G_), a_[1] * (G_), w0_, false); w0_ = __builtin_amdgcn_cvt_pk_fp8_f32(a_[2] * (G_), a_[3] * (G_), w0_, true); \
            w1_ = __builtin_amdgcn_cvt_pk_fp8_f32(b_[0] * (G_), b_[1] * (G_), w1_, false); w1_ = __builtin_amdgcn_cvt_pk_fp8_f32(b_[2] * (G_), b_[3] * (G_), w1_, true); \
            u32x2 w_; w_.x = (unsigned)w0_; w_.y = (unsigned)w1_; *(u32x2*)(W_y8 + (size_t)(ROWG) * DM + (COL0) + bj * 128 + wc * 32 + fq * 8) = w_; } } while (0)
        for (int ui = blk; ui < 1024; ui += G) {
            TIDS
            const int e = (G == 256) ? ((vblk & ~3) + (ui >> 8)) : (ui >> 2), pn = (G == 256) ? (vblk & 3) : (ui & 3);
            const int cnt = cntL[e], st = startL[e];
            if (cnt == 0) continue;
            const bf16_t* panel = W_scr + (size_t)2 * 256 * 1024 + (size_t)(ui / G) * 256 * 256;
            const int ntile = (cnt + 255) >> 8;
            for (int c0 = 0; c0 < ntile; c0 += 8) {
                TIDS
                const int nch = (ntile - c0) < 8 ? (ntile - c0) : 8;
                __syncthreads();
                for (int idx = tid; idx < nch * 256; idx += 512) { const int rr = c0 * 256 + idx; const int sr = st + (rr < cnt ? rr : 0); rowoff[idx] = (unsigned)sr * EFF; rowsc[idx] = W_wts[sr]; }
                __syncthreads();
                int R0, C0; g8_rc(tid, R0, C0);
                auto nextf = [&](int i, GDesc& d) {
                    if (i >= nch) return false;
                    d.Ab = (const char*)W_hdn; d.Bb = (const char*)panel;
                    d.va0 = (rowoff[i * 256 + R0] + C0) * 2u; d.va1 = (rowoff[i * 256 + R0 + 64] + C0) * 2u; d.va2 = (rowoff[i * 256 + R0 + 128] + C0) * 2u; d.va3 = (rowoff[i * 256 + R0 + 192] + C0) * 2u;
                    d.i0 = c0 + i; d.i1 = i; return true;
                };
                auto epi = [&](const f32x4 (&acc)[2][2][4][2], const GDesc& d, int wr, int wc, int fr, int fq) {
                    const int ti = d.i0, tl = d.i1;
#pragma unroll
                    for (int ai = 0; ai < 2; ++ai)
#pragma unroll
                        for (int m = 0; m < 4; ++m) {
                            const int r = ai * 128 + wr * 64 + m * 16 + fr;
                            const int rr = ti * 256 + r;
                            if (rr < cnt) { const float g = rowsc[tl * 256 + r]; Y_STORE(st + rr, pn * 256, g); }
                        }
                };
                gemm_stream(ldsL, tid, EFF, nextf, epi);
            }
        }
        {
            TIDS
            unsigned vl_[4]; g8_voff_lin(vl_, EFF, tid);
            auto nextf = [&](int i, GDesc& d) {
                const int u = blk + i * G; if (u >= 512) return false;
                const int pm = u >> 2, pn = u & 3;
                d.Ab = (const char*)(W_hdn + (size_t)(NASG + pm * 256) * EFF); d.Bb = (const char*)(W_Ws2T + (size_t)pn * 256 * EFF);
                d.va0 = vl_[0]; d.va1 = vl_[1]; d.va2 = vl_[2]; d.va3 = vl_[3]; d.i0 = pm; d.i1 = pn; return true;
            };
            auto epi = [&](const f32x4 (&acc)[2][2][4][2], const GDesc& d, int wr, int wc, int fr, int fq) {
                const int pm = d.i0, pn = d.i1;
#pragma unroll
                for (int ai = 0; ai < 2; ++ai)
#pragma unroll
                    for (int m = 0; m < 4; ++m) {
                        const int r = ai * 128 + wr * 64 + m * 16 + fr;
                        Y_STORE(NASG + pm * 256 + r, pn * 256, 1.0f);
                    }
            };
            gemm_stream(ldsL, tid, EFF, nextf, epi);
        }
#undef Y_STORE
    }
    SEAM(12);

    if (IN(13)) {
        TIDS
        const float* fg = P.in[I_FG];
        for (int row = blk * 8 + wave; row < NTOK; row += G * 8) {
            const int b = row >> 12;
            float a[16];
#pragma unroll
            for (int j = 0; j < 16; ++j) a[j] = 0.f;
#pragma unroll
            for (int k = 0; k < 9; ++k) {
                const int pr = (k < 8) ? W_pos[row * 8 + k] : (NASG + row);
                const u32x4 w = *(const u32x4*)(W_y8 + (size_t)pr * DM + lane * 16);
#pragma unroll
                for (int q = 0; q < 4; ++q) {
                    a[4 * q + 0] += __builtin_amdgcn_cvt_f32_fp8((int)w[q], 0); a[4 * q + 1] += __builtin_amdgcn_cvt_f32_fp8((int)w[q], 1);
                    a[4 * q + 2] += __builtin_amdgcn_cvt_f32_fp8((int)w[q], 2); a[4 * q + 3] += __builtin_amdgcn_cvt_f32_fp8((int)w[q], 3);
                }
            }
            float* xr = P.out + (size_t)row * DM + lane * 16;
            const float* g2 = W_mod + b * 6144 + 5120 + lane * 16;
            float v[16]; float ss = 0.f;
#pragma unroll
            for (int q = 0; q < 4; ++q) {
                const f32x4 xa = *(const f32x4*)(xr + q * 4), ga = *(const f32x4*)(g2 + q * 4);
#pragma unroll
                for (int j = 0; j < 4; ++j) { v[q * 4 + j] = xa[j] + ga[j] * a[q * 4 + j]; ss += v[q * 4 + j] * v[q * 4 + j]; }
            }
            ss = wave_sum(ss);
            const float rinv = rsqrtf(ss * (1.0f / 1024.0f) + EPS);
#pragma unroll
            for (int q = 0; q < 4; ++q) {
                const f32x4 fa = *(const f32x4*)(fg + lane * 16 + q * 4);
                f32x4 oa;
#pragma unroll
                for (int j = 0; j < 4; ++j) oa[j] = v[q * 4 + j] * rinv * fa[j];
                *(f32x4*)(xr + q * 4) = oa;
            }
        }
    }
#ifdef DBG_STOP
    if (IN(14)) {
        TIDS
        const size_t NO = (size_t)NTOK * DM;
        for (size_t i = (size_t)blk * 512 + tid; i < NO; i += (size_t)G * 512) {
            unsigned hsh = 0u;
            const size_t row = i >> 10, c = i & 1023;
#define RB(p, idx) ((unsigned)(p)[(idx)])
#define RF(p, idx) (__float_as_uint((p)[(idx)]))
#if DBG_STOP == 0
            hsh = RB(W_WinT, i % (2304 * 1024)) ^ RB(W_WoT, i % (1024 * 1024)) ^ RB(W_WuqT, i % (768 * 384)) ^ RB(W_WukvT, i % (1024 * 256)) ^ RB(W_Ws13T, i % (512 * 1024)) ^ RB(W_Ws2T, i % (1024 * 256)) ^ RB(W_WrT, i % (256 * 1024))
                ^ RF(W_mod, i % (8 * 6144)) ^ RF(W_ropecs, i % (4096 * 32)) ^ RF(W_biasT, i % (3 * 8 * 129));
#elif DBG_STOP == 1 || DBG_STOP == 7
            hsh = RB(W_hbuf, i);
#elif DBG_STOP == 2
            hsh = RB(W_proj, row * INCP + c) ^ (RB(W_proj, row * INCP + 1024 + c) << 1) ^ (c < 160 ? (RB(W_proj, row * INCP + 2048 + c) << 2) : 0u);
#elif DBG_STOP == 3
            hsh = RB(W_kvb, i) ^ (c < 768 ? (RB(W_qb, row * 768 + c) << 1) : 0u);
#elif DBG_STOP == 4
            if (c < 512) hsh = RB(W_bout, row * 512 + c); else if (DBG_SUB) { const size_t cc = c - 512; hsh = RB(W_aparts, row * 512 + cc) ^ (RB(W_aparts, ((size_t)NTOK + row) * 512 + cc) << 1) ^ (RB(W_aparts, ((size_t)2 * NTOK + row) * 512 + cc) << 2) ^ RF(W_lsebuf, row * 8 + (cc >> 6)) ^ (RF(W_lsebuf, ((size_t)NTOK + row) * 8 + (cc >> 6)) << 1) ^ (RF(W_lsebuf, ((size_t)2 * NTOK + row) * 8 + (cc >> 6)) << 2); }
#elif DBG_STOP == 5
            hsh = RB(W_mixb, i);
#elif DBG_STOP == 6
            hsh = RF(P.out, i);
#elif DBG_STOP == 8
            if (c < 256) hsh = RF(W_logits, row * 256 + c); else if (c < 512) hsh = RB(W_hdn, ((size_t)NASG + row) * EFF + (c - 256));
#elif DBG_STOP == 9
            if (c < 8) hsh = (unsigned)W_eidx[row * 8 + c]; else if (c < 16) hsh = RF(W_gate, row * 8 + (c - 8));
#elif DBG_STOP == 11
            { const int k = (int)(c >> 8); hsh = RB(W_hdn, (size_t)W_pos[row * 8 + k] * EFF + (c & 255)) ^ (RB(W_hdn, (size_t)W_pos[row * 8 + 4 + k] * EFF + (c & 255)) << 1); }
#elif DBG_STOP == 12
            { for (int k = 0; k < 8; ++k) hsh ^= RB(W_ybuf, (size_t)W_pos[row * 8 + k] * DM + c) << (k & 3); hsh ^= RB(W_ybuf, ((size_t)NASG + row) * DM + c); }
#endif
            P.out[i] = (float)(hsh & 0xFu);
        }
    }
#endif
#undef IN
#undef SEAM
}

extern "C" void kernel_launch(void* const* d_in, const int* in_sizes, int n_in, void* d_out, int out_size, void* d_ws, size_t ws_size, hipStream_t stream) {
    static int grid = 0;
    if (grid == 0) {
        if (n_in != 24 || ws_size < WS_END) { fprintf(stderr, "kernel_launch: need 24 inputs and %zu bytes of workspace (got %d, %zu)\n", (size_t)WS_END, n_in, ws_size); grid = -1; return; }
        int dev = 0, cus = 0, per_cu = 0;
        if (hipGetDevice(&dev) != hipSuccess || hipDeviceGetAttribute(&cus, hipDeviceAttributeMultiprocessorCount, dev) != hipSuccess) { grid = -1; return; }
        if (hipFuncSetAttribute((const void*)fwd_kernel, hipFuncAttributeMaxDynamicSharedMemorySize, LDS_BYTES) != hipSuccess) { fprintf(stderr, "kernel_launch: hipFuncSetAttribute failed\n"); grid = -1; return; }
        if (hipOccupancyMaxActiveBlocksPerMultiprocessor(&per_cu, (const void*)fwd_kernel, 512, LDS_BYTES) != hipSuccess || per_cu < 1) { fprintf(stderr, "kernel_launch: occupancy query says %d\n", per_cu); }
        (void)hipGetLastError();
        grid = cus;
    }
    if (grid < 0) return;
    (void)hipMemsetAsync((char*)d_ws + OFF_CTL, 0, CTL_BYTES, stream);
    Params p{};
    for (int i = 0; i < 24; ++i) p.in[i] = (const float*)d_in[i];
    p.out = (float*)d_out; p.ws = (unsigned char*)d_ws;
#if MK_N_LAUNCHES == 1
    p.ph_lo = 0; p.ph_hi = NPHASE;
    hipLaunchKernelGGL(fwd_kernel, dim3(grid), dim3(512), LDS_BYTES, stream, p);
#else
#ifdef DBG_STOP
    for (int k = 0; k <= DBG_STOP; ++k) { p.ph_lo = k; p.ph_hi = k + 1; hipLaunchKernelGGL(fwd_kernel, dim3(grid), dim3(512), LDS_BYTES, stream, p); }
    p.ph_lo = 14; p.ph_hi = 15; hipLaunchKernelGGL(fwd_kernel, dim3(grid), dim3(512), LDS_BYTES, stream, p);
#else
#ifndef DBL_MASK
#define DBL_MASK 0u
#endif
#ifndef DBL_FLAGS
#define DBL_FLAGS 0
#endif
    for (int k = 0; k < 14; ++k) { p.ph_lo = k; p.ph_hi = k + 1; hipLaunchKernelGGL(fwd_kernel, dim3(grid), dim3(512), LDS_BYTES, stream, p);
        if ((DBL_MASK >> k) & 1u) { p.flags = DBL_FLAGS; hipLaunchKernelGGL(fwd_kernel, dim3(grid), dim3(512), LDS_BYTES, stream, p); p.flags = 0; } }
#endif
#endif
}
```

```cpp
#include <hip/hip_runtime.h>
#include <stdint.h>
#include <stdio.h>

#ifndef MK_N_LAUNCHES
#define MK_N_LAUNCHES 1
#endif

#define DEVI __device__ __forceinline__
typedef unsigned short bf16_t;
typedef short bf16x8 __attribute__((ext_vector_type(8)));
typedef short s16x4 __attribute__((ext_vector_type(4)));
typedef float f32x4 __attribute__((ext_vector_type(4)));
typedef float f32x16 __attribute__((ext_vector_type(16)));
typedef unsigned u32x4 __attribute__((ext_vector_type(4)));
typedef unsigned u32x2 __attribute__((ext_vector_type(2)));

constexpr int NTOK = 32768, SEQ = 4096, DM = 1024;
constexpr int INC = 2208, INCP = 2304;
constexpr int QLORA = 384, KVLORA = 256;
constexpr int NEXP = 256, EFF = 256;
constexpr int NASG = NTOK * 8;
constexpr int NROWS = NASG + NTOK;
constexpr float EPS = 1e-6f;
constexpr float LOG2E = 1.4426950408889634f;

constexpr size_t MiB = 1u << 20;
constexpr size_t OFF_CTL = 0, CTL_BYTES = 1 * MiB;
constexpr size_t OFF_MOD = 1 * MiB;
constexpr size_t OFF_ROPE = OFF_MOD + 256 * 1024;
constexpr size_t OFF_BIAS = OFF_ROPE + 512 * 1024;
constexpr size_t OFF_WIN = 2 * MiB;
constexpr size_t OFF_WUQ = OFF_WIN + 4608 * 1024;
constexpr size_t OFF_WUKV = OFF_WUQ + 1 * MiB;
constexpr size_t OFF_WO = OFF_WUKV + 512 * 1024;
constexpr size_t OFF_WR = OFF_WO + 2 * MiB;
constexpr size_t OFF_WS13 = OFF_WR + 512 * 1024;
constexpr size_t OFF_WS2 = OFF_WS13 + 1 * MiB;
constexpr size_t OFF_H = 12 * MiB;
constexpr size_t OFF_LOGITS = OFF_H + 64 * MiB;
constexpr size_t OFF_EIDX = OFF_LOGITS + 32 * MiB;
constexpr size_t OFF_GATE = OFF_EIDX + 1 * MiB;
constexpr size_t OFF_RNK = OFF_GATE + 1 * MiB;
constexpr size_t OFF_POS = OFF_RNK + 1 * MiB;
constexpr size_t OFF_TOKS = OFF_POS + 1 * MiB;
constexpr size_t OFF_WTS = OFF_TOKS + 1 * MiB;
constexpr size_t OFF_SSQ = OFF_WTS + 1 * MiB;
constexpr size_t OFF_SCR = OFF_SSQ + 4 * MiB;
constexpr size_t SCR_PER_BLK = 1536 * 1024;
constexpr size_t OFF_R = OFF_SCR + 384 * MiB;
constexpr size_t WS_END = OFF_R + 452 * MiB;
constexpr size_t OFF_PROJ = OFF_R;
constexpr size_t OFF_QB = OFF_PROJ + 144 * MiB;
constexpr size_t OFF_KVB = OFF_QB + 48 * MiB;
constexpr size_t OFF_BOUT = OFF_KVB + 64 * MiB;
constexpr size_t OFF_APARTS = OFF_BOUT + 32 * MiB;
constexpr size_t OFF_LSE = OFF_APARTS + 96 * MiB;
constexpr size_t OFF_MIX = OFF_LSE + 4 * MiB;
constexpr size_t OFF_Y = OFF_R;
constexpr size_t OFF_HDN = OFF_R + 288 * MiB;
static_assert(OFF_MIX + 64 * MiB <= WS_END, "alias map");
constexpr int CNT_WORD0 = 8192, CNT_STRIDE = 16;

constexpr int LDS_STAGE = 0;
constexpr int LDS_ROWOFF = 131072;
constexpr int LDS_ROWSC = LDS_ROWOFF + 8192;
constexpr int LDS_MISC = LDS_ROWSC + 8192;
constexpr int LDS_START = LDS_MISC + 256;
constexpr int LDS_CNT = LDS_START + 1280;
constexpr int LDS_BYTES = 155648;
static_assert(LDS_CNT + 1024 <= LDS_BYTES, "lds map");

#define XB_TMO      128
#define XB_XCNT(j)  (256  + 64 * (j))
#define XB_XSUB(j)  (1280 + 64 * (j))
#define XB_XGEN(j)  (2304 + 64 * (j))
#define XB_TOP      3328
#define XB_TOPGEN   3392
#define XCD_BAR_WORDS 3456
#define XB_SPIN_CAP (1u << 22)
#define LAS __attribute__((address_space(3)))

__device__ __forceinline__ unsigned xb_ld(unsigned* p)              { return __hip_atomic_load(p, __ATOMIC_RELAXED, __HIP_MEMORY_SCOPE_AGENT); }
__device__ __forceinline__ unsigned xb_add(unsigned* p, unsigned v) { return __hip_atomic_fetch_add(p, v, __ATOMIC_RELAXED, __HIP_MEMORY_SCOPE_AGENT); }
__device__ __forceinline__ unsigned xb_xcc_id() { return (unsigned)__builtin_amdgcn_s_getreg((3 << 11) | 20) & 0xFu; }
#define XB_SPIN(cond, bar) do { unsigned _sp = 0; while (cond) { __builtin_amdgcn_s_sleep(1); \
    if ((++_sp & 255u) == 0u) { if (xb_ld(&(bar)[XB_TMO])) break; if (_sp > XB_SPIN_CAP) { atomicAdd(&(bar)[XB_TMO], 1u); break; } } } } while (0)

struct XcdBarrier { unsigned* bar; unsigned x; volatile LAS unsigned* st; };

__device__ __forceinline__ XcdBarrier xcd_barrier_post(unsigned* bar, volatile LAS unsigned* st, const bool leader) {
    XcdBarrier b; b.bar = bar; b.x = xb_xcc_id(); b.st = st;
    if (leader) (void)xb_add(&bar[XB_XCNT(b.x)], 1u);
    return b;
}
__device__ __forceinline__ void xcd_barrier_complete(unsigned* bar, unsigned x, unsigned& nloc, unsigned& nx) {
    const unsigned G = gridDim.x * gridDim.y * gridDim.z;
    unsigned sum, cnt, mine, sp = 0u;
    for (;;) {
        sum = 0u; cnt = 0u; mine = 0u;
#pragma unroll
        for (unsigned j = 0; j < 16; ++j) { const unsigned c = xb_ld(&bar[XB_XCNT(j)]); sum += c; cnt += (c > 0u) ? 1u : 0u; mine = (j == x) ? c : mine; }
        if (sum == G) break;
        __builtin_amdgcn_s_sleep(1);
        if ((++sp & 255u) == 0u) { if (xb_ld(&bar[XB_TMO])) break; if (sp > XB_SPIN_CAP) { atomicAdd(&bar[XB_TMO], 1u); break; } }
    }
    nloc = mine > 0u ? mine : 1u; nx = cnt > 0u ? cnt : 1u;
}
__device__ __forceinline__ void xcd_barrier(const XcdBarrier& b, const bool leader) {
    asm volatile("s_waitcnt vmcnt(0)" ::: "memory");
    __syncthreads();
    if (leader) {
        unsigned* bar = b.bar;
        __builtin_amdgcn_s_waitcnt(0);
        unsigned nloc = b.st[0], nx = b.st[1];
        if (nloc == 0u) { xcd_barrier_complete(bar, b.x, nloc, nx); b.st[0] = nloc; b.st[1] = nx; }
        const unsigned old = xb_add(&bar[XB_XSUB(b.x)], 1u);
        const unsigned gen = old / nloc;
        if (old + 1u == (gen + 1u) * nloc) {
            __builtin_amdgcn_fence(__ATOMIC_RELEASE, "agent");
            asm volatile("s_waitcnt vmcnt(0)" ::: "memory");
            const unsigned og = xb_add(&bar[XB_TOP], 1u);
            const unsigned tg = og / nx;
            if (og + 1u == (tg + 1u) * nx) xb_add(&bar[XB_TOPGEN], 1u);
            else XB_SPIN(xb_ld(&bar[XB_TOPGEN]) == tg, bar);
            __builtin_amdgcn_fence(__ATOMIC_ACQUIRE, "agent");
            xb_add(&bar[XB_XGEN(b.x)], 1u);
            asm volatile("s_waitcnt vmcnt(0)" ::: "memory");
        } else {
            XB_SPIN(xb_ld(&bar[XB_XGEN(b.x)]) == gen, bar);
            __builtin_amdgcn_fence(__ATOMIC_ACQUIRE, "agent");
            asm volatile("s_waitcnt vmcnt(0)" ::: "memory");
        }
    }
    __syncthreads();
}

DEVI float bf2f(bf16_t v) { return __uint_as_float(((unsigned)v) << 16); }
typedef float f32x2_t __attribute__((ext_vector_type(2)));
typedef __bf16 bf16x2_t __attribute__((ext_vector_type(2)));
DEVI unsigned pk2(float lo, float hi) { f32x2_t v = {lo, hi}; bf16x2_t b = __builtin_convertvector(v, bf16x2_t); return __builtin_bit_cast(unsigned, b); }
#define dppf(v, ctrl) __int_as_float(__builtin_amdgcn_update_dpp(0, __float_as_int(v), (ctrl), 0xf, 0xf, false))
#define dppi(v, ctrl) __builtin_amdgcn_update_dpp(0, (v), (ctrl), 0xf, 0xf, false)
#define DPP_X1 0xB1
#define DPP_X2 0x4E
#define DPP_HM 0x141
#define DPP_RM 0x140
DEVI float x16f(float v, float& o) { auto r = __builtin_amdgcn_permlane16_swap(__float_as_uint(v), __float_as_uint(v), false, false); o = __uint_as_float(r[1]); return __uint_as_float(r[0]); }
DEVI float x32f(float v, float& o) { auto r = __builtin_amdgcn_permlane32_swap(__float_as_uint(v), __float_as_uint(v), false, false); o = __uint_as_float(r[1]); return __uint_as_float(r[0]); }
DEVI float sum32(float v) { float o; const float a = x32f(v, o); return a + o; }
DEVI float max32(float v) { float o; const float a = x32f(v, o); return fmaxf(a, o); }
DEVI float wave_sum(float v) {
    v += dppf(v, DPP_X1); v += dppf(v, DPP_X2); v += dppf(v, DPP_HM); v += dppf(v, DPP_RM);
    { float o; const float a = x16f(v, o); v = a + o; }
    { float o; const float a = x32f(v, o); v = a + o; }
    return v;
}
DEVI int perm_slot(int cl) { return 16 * ((cl >> 2) & 1) + 4 * (cl >> 3) + (cl & 3); }
DEVI int perm_row(int n) { return (n & ~31) + perm_slot(n & 31); }
DEVI float ex2(float x) { return __builtin_amdgcn_exp2f(x); }
DEVI float siluf(float v) { return v / (1.0f + __expf(-v)); }

namespace g8 {
constexpr int BK = 64, HALF = 128, HT = HALF * BK;
DEVI int lds_byte(int r, int c) { int st = (r >> 4) * 2 + (c >> 5), rr = r & 15, cc = c & 31, ob = rr * 64 + cc * 2; return st * 1024 + (ob ^ (((ob >> 9) & 1) << 5)); }
DEVI void stage_rc(int b, int& R, int& C) { int st = b / 1024, sb = b % 1024, swz = sb ^ (((sb >> 9) & 1) << 5); R = (st >> 1) * 16 + swz / 64; C = (st & 1) * 32 + (swz % 64) / 2; }
}

DEVI void g8_rc(int tid, int& R0, int& C0) { g8::stage_rc(tid * 16, R0, C0); }
DEVI void g8_voff_lin(unsigned (&v)[4], int ld, int tid) { int R0, C0; g8_rc(tid, R0, C0);
    v[0] = (unsigned)(R0 * ld + C0) * 2u; v[1] = (unsigned)((R0 + 64) * ld + C0) * 2u; v[2] = (unsigned)((R0 + 128) * ld + C0) * 2u; v[3] = (unsigned)((R0 + 192) * ld + C0) * 2u; }
DEVI void g8_voff_tab(unsigned (&v)[4], const LAS unsigned* tab, int tid) { int R0, C0; g8_rc(tid, R0, C0);
    v[0] = (tab[R0] + C0) * 2u; v[1] = (tab[R0 + 64] + C0) * 2u; v[2] = (tab[R0 + 128] + C0) * 2u; v[3] = (tab[R0 + 192] + C0) * 2u; }

template <class Epi>
DEVI void gemm_tile(LAS unsigned char* lds, const int tid_in, const char* Ab, const unsigned (&voffA_)[4], const char* Bb, const int K, const Epi& epi) {
    using namespace g8;
    constexpr int HTB = HALF * BK * 2;
    int tz = tid_in; asm volatile("" : "+v"(tz));
    int wid = tz >> 6, lane = tz & 63, wr = wid >> 2, wc = wid & 3, fr = lane & 15, fq = lane >> 4;
    unsigned voffA[4] = {voffA_[0], voffA_[1], voffA_[2], voffA_[3]};
    asm volatile("" : "+v"(voffA[0]), "+v"(voffA[1]), "+v"(voffA[2]), "+v"(voffA[3]));
    unsigned voffB[2];
    { int R0, C0; stage_rc(tz * 16, R0, C0); voffB[0] = (unsigned)(R0 * K + C0) * 2u; voffB[1] = (unsigned)((R0 + 64) * K + C0) * 2u; }
    const size_t kstep = (size_t)(BK * 2);
    const size_t hstepB = (size_t)HALF * K * 2;
    const unsigned ldsw = (unsigned)wid * 1024u;
    const int aoff = lds_byte(wr * 64 + fr, fq * 8), boff = lds_byte(wc * 32 + fr, fq * 8);
#define G8_SA(b, h) (((b) * 2 + (h)) * HTB)
#define G8_SB(b, h) ((4 + (b) * 2 + (h)) * HTB)
#define G8_GL(gp, lofs) __builtin_amdgcn_global_load_lds((const unsigned*)(gp), (LAS unsigned*)(lds + (lofs)), 16, 0, 0)
#define STAGE_A(b, h, kt) do { const char* g_ = Ab + (size_t)(kt) * kstep; G8_GL(g_ + voffA[(h) * 2], G8_SA(b, h) + ldsw); G8_GL(g_ + voffA[(h) * 2 + 1], G8_SA(b, h) + ldsw + 8192); } while (0)
#define STAGE_B(b, h, kt) do { const char* g_ = Bb + (size_t)(kt) * kstep + ((h) ? hstepB : 0); G8_GL(g_ + voffB[0], G8_SB(b, h) + ldsw); G8_GL(g_ + voffB[1], G8_SB(b, h) + ldsw + 8192); } while (0)
#define LDA(dst, b, h) do { _Pragma("unroll") for (int m = 0; m < 4; ++m) _Pragma("unroll") for (int k = 0; k < 2; ++k) dst[m][k] = *(const LAS bf16x8*)(lds + G8_SA(b, h) + aoff + m * 2048 + k * 1024); } while (0)
#define LDB(dst, b, h) do { _Pragma("unroll") for (int n = 0; n < 2; ++n) _Pragma("unroll") for (int k = 0; k < 2; ++k) dst[n][k] = *(const LAS bf16x8*)(lds + G8_SB(b, h) + boff + n * 2048 + k * 1024); } while (0)
#define MMA(ai, bj, Af, Bf) do { __builtin_amdgcn_s_setprio(1); \
    _Pragma("unroll") for (int m = 0; m < 4; ++m) _Pragma("unroll") for (int n = 0; n < 2; ++n) _Pragma("unroll") for (int k = 0; k < 2; ++k) \
      acc[ai][bj][m][n] = __builtin_amdgcn_mfma_f32_16x16x32_bf16(Bf[n][k], Af[m][k], acc[ai][bj][m][n], 0, 0, 0); \
    __builtin_amdgcn_s_setprio(0); } while (0)
#define WAIT_V(n) asm volatile("s_waitcnt vmcnt(" #n ")" ::: "memory")
#define WAIT_L(n) asm volatile("s_waitcnt lgkmcnt(" #n ")" ::: "memory")
#define BAR __builtin_amdgcn_s_barrier()
#define SCHED __builtin_amdgcn_sched_barrier(0)
    f32x4 acc[2][2][4][2];
#pragma unroll
    for (int a = 0; a < 2; ++a)
#pragma unroll
        for (int b = 0; b < 2; ++b)
#pragma unroll
            for (int m = 0; m < 4; ++m)
#pragma unroll
                for (int n = 0; n < 2; ++n) acc[a][b][m][n] = (f32x4){0.f, 0.f, 0.f, 0.f};
    bf16x8 At[4][2], B0[2][2], B1[2][2];
    const int nt = K / BK;
    STAGE_B(0, 0, 0); STAGE_A(0, 0, 0); STAGE_B(0, 1, 0); STAGE_A(0, 1, 0);
    if (wr == 1) BAR;
    WAIT_V(4); BAR;
    STAGE_B(1, 0, 1); STAGE_A(1, 0, 1); STAGE_B(1, 1, 1);
    WAIT_V(6); BAR;
#pragma unroll 1
    for (int t = 0; t < nt; t += 2) {
        const int t2 = (t == nt - 2) ? 0 : t + 2;
        const int t3 = t2 + 1;
        LDB(B0, 0, 0); SCHED; LDA(At, 0, 0); STAGE_A(1, 1, t + 1);
        WAIT_L(8); BAR; WAIT_L(0); MMA(0, 0, At, B0); BAR; SCHED;
        LDB(B1, 0, 1); STAGE_B(0, 0, t2);
        BAR; WAIT_L(0); MMA(0, 1, At, B1); BAR;
        LDA(At, 0, 1); STAGE_A(0, 0, t2);
        BAR; WAIT_L(0); MMA(1, 0, At, B0); BAR; SCHED;
        STAGE_B(0, 1, t2);
        WAIT_V(6); BAR; MMA(1, 1, At, B1); BAR;
        LDB(B0, 1, 0); SCHED; LDA(At, 1, 0); STAGE_A(0, 1, t2);
        WAIT_L(8); BAR; WAIT_L(0); MMA(0, 0, At, B0); BAR; SCHED;
        LDB(B1, 1, 1); STAGE_B(1, 0, t3);
        BAR; WAIT_L(0); MMA(0, 1, At, B1); BAR;
        LDA(At, 1, 1); STAGE_A(1, 0, t3);
        BAR; WAIT_L(0); MMA(1, 0, At, B0); BAR; SCHED;
        STAGE_B(1, 1, t3);
        WAIT_V(6); BAR; MMA(1, 1, At, B1); BAR;
    }
    WAIT_V(0);
    if (wr == 0) BAR;
    BAR;
    asm volatile("" : "+v"(tz)); wid = tz >> 6; lane = tz & 63; wr = wid >> 2; wc = wid & 3; fr = lane & 15; fq = lane >> 4;
    epi(acc, wr, wc, fr, fq);
#undef G8_SA
#undef G8_SB
#undef G8_GL
#undef STAGE_A
#undef STAGE_B
#undef LDA
#undef LDB
#undef MMA
}
struct GDesc { const char* Ab; const char* Bb; unsigned va0, va1, va2, va3; int i0, i1; };
template <class Next, class Epi>
DEVI void gemm_stream(LAS unsigned char* lds, const int tid_in, const int K, Next& next, const Epi& epi) {
    using namespace g8;
    constexpr int HTB = HALF * BK * 2;
    int tz = tid_in; asm volatile("" : "+v"(tz));
    int wid = tz >> 6, lane = tz & 63, wr = wid >> 2, wc = wid & 3, fr = lane & 15, fq = lane >> 4;
    unsigned voffB[2];
    { int R0, C0; stage_rc(tz * 16, R0, C0); voffB[0] = (unsigned)(R0 * K + C0) * 2u; voffB[1] = (unsigned)((R0 + 64) * K + C0) * 2u; }
    const size_t kstep = (size_t)(BK * 2);
    const size_t hstepB = (size_t)HALF * K * 2;
    const unsigned ldsw = (unsigned)wid * 1024u;
    const int aoff = lds_byte(wr * 64 + fr, fq * 8), boff = lds_byte(wc * 32 + fr, fq * 8);
#define G8_SA(b, h) (((b) * 2 + (h)) * HTB)
#define G8_SB(b, h) ((4 + (b) * 2 + (h)) * HTB)
#define G8_GL(gp, lofs) __builtin_amdgcn_global_load_lds((const unsigned*)(gp), (LAS unsigned*)(lds + (lofs)), 16, 0, 0)
#define STG_A(b, h, gb, v0, v1) do { G8_GL((gb) + (v0), G8_SA(b, h) + ldsw); G8_GL((gb) + (v1), G8_SA(b, h) + ldsw + 8192); } while (0)
#define STG_B(b, h, gb) do { const char* g_ = (gb) + ((h) ? hstepB : 0); G8_GL(g_ + voffB[0], G8_SB(b, h) + ldsw); G8_GL(g_ + voffB[1], G8_SB(b, h) + ldsw + 8192); } while (0)
#define LDA(dst, b, h) do { _Pragma("unroll") for (int m = 0; m < 4; ++m) _Pragma("unroll") for (int k = 0; k < 2; ++k) dst[m][k] = *(const LAS bf16x8*)(lds + G8_SA(b, h) + aoff + m * 2048 + k * 1024); } while (0)
#define LDB(dst, b, h) do { _Pragma("unroll") for (int n = 0; n < 2; ++n) _Pragma("unroll") for (int k = 0; k < 2; ++k) dst[n][k] = *(const LAS bf16x8*)(lds + G8_SB(b, h) + boff + n * 2048 + k * 1024); } while (0)
#define MMA(ai, bj, Af, Bf) do { __builtin_amdgcn_s_setprio(1); \
    _Pragma("unroll") for (int m = 0; m < 4; ++m) _Pragma("unroll") for (int n = 0; n < 2; ++n) _Pragma("unroll") for (int k = 0; k < 2; ++k) \
      acc[ai][bj][m][n] = __builtin_amdgcn_mfma_f32_16x16x32_bf16(Bf[n][k], Af[m][k], acc[ai][bj][m][n], 0, 0, 0); \
    __builtin_amdgcn_s_setprio(0); } while (0)
#define ZACC() do { _Pragma("unroll") for (int a = 0; a < 2; ++a) _Pragma("unroll") for (int b = 0; b < 2; ++b) _Pragma("unroll") for (int m = 0; m < 4; ++m) _Pragma("unroll") for (int n = 0; n < 2; ++n) acc[a][b][m][n] = (f32x4){0.f, 0.f, 0.f, 0.f}; } while (0)
    GDesc cur, nxt;
    if (!next(0, cur)) return;
    nxt = cur;
    f32x4 acc[2][2][4][2];
    ZACC();
    bf16x8 At[4][2], B0[2][2], B1[2][2];
    const int nt = K / BK;
    STG_B(0, 0, cur.Bb); STG_A(0, 0, cur.Ab, cur.va0, cur.va1); STG_B(0, 1, cur.Bb); STG_A(0, 1, cur.Ab, cur.va2, cur.va3);
    if (wr == 1) BAR;
    WAIT_V(4); BAR;
    STG_B(1, 0, cur.Bb + kstep); STG_A(1, 0, cur.Ab + kstep, cur.va0, cur.va1); STG_B(1, 1, cur.Bb + kstep);
    WAIT_V(6); BAR;
    int ui = 0; bool has_next = false;
#pragma unroll 1
    for (;;) {
#pragma unroll 1
        for (int t = 0; t < nt; t += 2) {
            const bool last = (t == nt - 2);
            if (last) { has_next = next(ui + 1, nxt); if (!has_next) nxt = cur; }
            const char* a2 = last ? nxt.Ab : cur.Ab + (size_t)(t + 2) * kstep;
            const char* b2 = last ? nxt.Bb : cur.Bb + (size_t)(t + 2) * kstep;
            const unsigned s0 = last ? nxt.va0 : cur.va0, s1 = last ? nxt.va1 : cur.va1, s2 = last ? nxt.va2 : cur.va2, s3 = last ? nxt.va3 : cur.va3;
            LDB(B0, 0, 0); SCHED; LDA(At, 0, 0); STG_A(1, 1, cur.Ab + (size_t)(t + 1) * kstep, cur.va2, cur.va3);
            WAIT_L(8); BAR; WAIT_L(0); MMA(0, 0, At, B0); BAR; SCHED;
            LDB(B1, 0, 1); STG_B(0, 0, b2);
            BAR; WAIT_L(0); MMA(0, 1, At, B1); BAR;
            LDA(At, 0, 1); STG_A(0, 0, a2, s0, s1);
            BAR; WAIT_L(0); MMA(1, 0, At, B0); BAR; SCHED;
            STG_B(0, 1, b2);
            WAIT_V(6); BAR; MMA(1, 1, At, B1); BAR;
            LDB(B0, 1, 0); SCHED; LDA(At, 1, 0); STG_A(0, 1, a2, s2, s3);
            WAIT_L(8); BAR; WAIT_L(0); MMA(0, 0, At, B0); BAR; SCHED;
            LDB(B1, 1, 1); STG_B(1, 0, b2 + kstep);
            BAR; WAIT_L(0); MMA(0, 1, At, B1); BAR;
            LDA(At, 1, 1); STG_A(1, 0, a2 + kstep, s0, s1);
            BAR; WAIT_L(0); MMA(1, 0, At, B0); BAR; SCHED;
            STG_B(1, 1, b2 + kstep);
            WAIT_V(6); BAR; MMA(1, 1, At, B1); BAR;
        }
        {
            int tq = tz; asm volatile("" : "+v"(tq));
            const int wid_ = tq >> 6, lane_ = tq & 63;
            epi(acc, cur, wid_ >> 2, wid_ & 3, lane_ & 15, lane_ >> 4);
        }
        if (!has_next) break;
        ZACC();
        cur = nxt; ++ui;
    }
    WAIT_V(0);
    if (wr == 0) BAR;
    BAR;
#undef G8_SA
#undef G8_SB
#undef G8_GL
#undef STG_A
#undef STG_B
#undef LDA
#undef LDB
#undef MMA
#undef ZACC
}
#define EPI_FOREACH8(acc, wr, wc, fr, fq, ROW, COL8, V0, V1, ...) \
    _Pragma("unroll") for (int ai_ = 0; ai_ < 2; ++ai_) _Pragma("unroll") for (int m_ = 0; m_ < 4; ++m_) { const int ROW = ai_ * 128 + (wr) * 64 + m_ * 16 + (fr); \
    _Pragma("unroll") for (int bj_ = 0; bj_ < 2; ++bj_) { const int COL8 = bj_ * 128 + (wc) * 32 + (fq) * 8; const f32x4 V0 = acc[ai_][bj_][m_][0]; const f32x4 V1 = acc[ai_][bj_][m_][1]; __VA_ARGS__ } }
#define PK8(w, a, b) do { w.x = pk2(a[0], a[1]); w.y = pk2(a[2], a[3]); w.z = pk2(b[0], b[1]); w.w = pk2(b[2], b[3]); } while (0)

template <class SCol, class DRow, class KS, class NS>
DEVI void convert_T(bf16_t* __restrict__ dst, const float* __restrict__ src, int ld, int K, int NR, SCol scol, DRow drow, KS ks, NS ns, int wi, int nw) {
    const int k8n = K >> 3; const int items = NR * k8n;
    for (int it = wi; it < items; it += nw) {
        const int n = it % NR, k0 = (it / NR) << 3;
        const int sc = scol(n);
        float v[8];
#pragma unroll
        for (int j = 0; j < 8; ++j) v[j] = (sc >= 0) ? src[(size_t)(k0 + j) * ld + sc] * ks(k0 + j) : 0.f;
        const float s = ns(n);
        u32x4 w; w.x = pk2(v[0] * s, v[1] * s); w.y = pk2(v[2] * s, v[3] * s); w.z = pk2(v[4] * s, v[5] * s); w.w = pk2(v[6] * s, v[7] * s);
        *(u32x4*)(dst + (size_t)drow(n) * K + k0) = w;
    }
}
struct IdCol { DEVI int operator()(int n) const { return n; } };
struct OneK { DEVI float operator()(int) const { return 1.f; } };
struct VecK { const float* g; DEVI float operator()(int k) const { return g[k]; } };

template <int NB, bool PERM>
DEVI void convert_panel(bf16_t* __restrict__ dst, const float* __restrict__ src, const int ld, const int K, const int tid) {
    constexpr int N4 = NB / 4;
    const int items = (K >> 3) * N4;
#pragma unroll 1
    for (int it0 = tid; it0 < items; it0 += 1024) {
        f32x4 v[2][8];
#pragma unroll
        for (int u = 0; u < 2; ++u) {
            const int it = it0 + u * 512; const int n4 = it % N4, k8 = it / N4;
            const float* sp = src + (size_t)(k8 * 8) * ld + n4 * 4;
#pragma unroll
            for (int j = 0; j < 8; ++j) v[u][j] = *(const f32x4*)(sp + (size_t)j * ld);
        }
#pragma unroll
        for (int u = 0; u < 2; ++u) {
            const int it = it0 + u * 512; const int n4 = it % N4, k8 = it / N4;
#pragma unroll
            for (int c = 0; c < 4; ++c) {
                u32x4 w; w.x = pk2(v[u][0][c], v[u][1][c]); w.y = pk2(v[u][2][c], v[u][3][c]); w.z = pk2(v[u][4][c], v[u][5][c]); w.w = pk2(v[u][6][c], v[u][7][c]);
                const int n = n4 * 4 + c; const int dr = PERM ? ((n & ~31) + perm_slot(n & 31)) : n;
                *(u32x4*)(dst + (size_t)dr * K + k8 * 8) = w;
            }
        }
    }
}

template <int NB, bool PERM>
DEVI void convert_panel_lds(bf16_t* __restrict__ dst, const float* __restrict__ src, const int ld, const int K, const int tid, LAS unsigned char* lds) {
    constexpr int N4 = NB / 4;
    constexpr int K8C = 512 / N4;
    constexpr int KC = K8C * 8;
    constexpr int PITCH = KC * 2 + 8;
    constexpr int PPR = KC / 8;
    const int n4 = tid % N4, k8 = tid / N4;
    const float* sp = src + (size_t)(k8 * 8) * ld + n4 * 4;
    const int nchunk = K / KC;
    f32x4 va[8], vb[8], vc[8];
#define CPL_LOAD(V, c) do { const float* q_ = sp + (size_t)(c) * KC * ld; _Pragma("unroll") for (int j = 0; j < 8; ++j) V[j] = *(const f32x4*)(q_ + (size_t)j * ld); } while (0)
#define CPL_PROC(V, c) do { \
        _Pragma("unroll") for (int cc = 0; cc < 4; ++cc) { \
            u32x2 lo, hi; lo.x = pk2(V[0][cc], V[1][cc]); lo.y = pk2(V[2][cc], V[3][cc]); hi.x = pk2(V[4][cc], V[5][cc]); hi.y = pk2(V[6][cc], V[7][cc]); \
            LAS unsigned char* wp = lds + (n4 * 4 + cc) * PITCH + k8 * 16; \
            *(LAS u32x2*)wp = lo; *(LAS u32x2*)(wp + 8) = hi; } \
        __syncthreads(); \
        _Pragma("unroll") for (int q = 0; q < 4; ++q) { \
            const int p = tid + 512 * q; const int row = p / PPR, pc = p % PPR; \
            const LAS unsigned char* rp = lds + row * PITCH + pc * 16; \
            const u32x2 a = *(const LAS u32x2*)rp, b = *(const LAS u32x2*)(rp + 8); \
            const int dr = PERM ? ((row & ~31) + perm_slot(row & 31)) : row; \
            u32x4 w; w.x = a.x; w.y = a.y; w.z = b.x; w.w = b.y; \
            *(u32x4*)(dst + (size_t)dr * K + (c) * KC + pc * 8) = w; } \
        __syncthreads(); } while (0)
    CPL_LOAD(va, 0); if (nchunk > 1) CPL_LOAD(vb, 1); if (nchunk > 2) CPL_LOAD(vc, 2);
#pragma unroll 1
    for (int c = 0; c < nchunk; c += 3) {
        CPL_PROC(va, c); if (c + 3 < nchunk) CPL_LOAD(va, c + 3);
        if (c + 1 < nchunk) { CPL_PROC(vb, c + 1); if (c + 4 < nchunk) CPL_LOAD(vb, c + 4); }
        if (c + 2 < nchunk) { CPL_PROC(vc, c + 2); if (c + 5 < nchunk) CPL_LOAD(vc, c + 5); }
    }
#undef CPL_LOAD
#undef CPL_PROC
}

struct Params {
    const float* in[24];
    float* out;
    unsigned char* ws;
    int ph_lo, ph_hi;
    int flags, pad;
};
enum { I_X = 0, I_C, I_WADA, I_BADA, I_N1G, I_WIN, I_QNG, I_WUQ, I_KVNG, I_WUKV, I_REL, I_AOG, I_BOG, I_WO, I_N2G, I_WR, I_EB, I_W1, I_W3, I_W2, I_WS1, I_WS3, I_WS2, I_FG };
constexpr int NPHASE = 15;

#define W_x (P.in[I_X])
#define W_mod ((float*)(ws + OFF_MOD))
#define W_ropecs ((float*)(ws + OFF_ROPE))
#define W_biasT ((float*)(ws + OFF_BIAS))
#define W_WinT ((bf16_t*)(ws + OFF_WIN))
#define W_WuqT ((bf16_t*)(ws + OFF_WUQ))
#define W_WukvT ((bf16_t*)(ws + OFF_WUKV))
#define W_WoT ((bf16_t*)(ws + OFF_WO))
#define W_WrT ((bf16_t*)(ws + OFF_WR))
#define W_Ws13T ((bf16_t*)(ws + OFF_WS13))
#define W_Ws2T ((bf16_t*)(ws + OFF_WS2))
#define W_hbuf ((bf16_t*)(ws + OFF_H))
#define W_logits ((float*)(ws + OFF_LOGITS))
#define W_eidx ((int*)(ws + OFF_EIDX))
#define W_gate ((float*)(ws + OFF_GATE))
#define W_rnk ((int*)(ws + OFF_RNK))
#define W_pos ((int*)(ws + OFF_POS))
#define W_toks ((int*)(ws + OFF_TOKS))
#define W_wts ((float*)(ws + OFF_WTS))
#define W_ssq ((float*)(ws + OFF_SSQ))
#define W_scr ((bf16_t*)(ws + OFF_SCR + (size_t)blk * SCR_PER_BLK))
#define W_hdn ((bf16_t*)(ws + OFF_HDN))
#define W_ybuf ((bf16_t*)(ws + OFF_Y))
#define W_y8 ((unsigned char*)(ws + OFF_Y))
#define W_proj ((bf16_t*)(ws + OFF_PROJ))
#define W_qb ((bf16_t*)(ws + OFF_QB))
#define W_kvb ((bf16_t*)(ws + OFF_KVB))
#define W_bout ((bf16_t*)(ws + OFF_BOUT))
#define W_aparts ((bf16_t*)(ws + OFF_APARTS))
#define W_lsebuf ((float*)(ws + OFF_LSE))
#define W_mixb ((bf16_t*)(ws + OFF_MIX))

__global__ void __launch_bounds__(512, 2) fwd_kernel(Params P) {
    extern __shared__ __attribute__((aligned(16))) unsigned char lds[];
    const int blk = blockIdx.x, G = gridDim.x;
    const int wave_s = __builtin_amdgcn_readfirstlane((int)threadIdx.x >> 6);
#define TIDS0 int tid; asm volatile("v_mbcnt_lo_u32_b32 %0, -1, 0\n\tv_mbcnt_hi_u32_b32 %0, -1, %0" : "=v"(tid)); tid += wave_s * 64;
    const int vblk = (G % 8 == 0) ? (blk % 8) * (G / 8) + blk / 8 : blk;
    unsigned char* ws = P.ws;
    unsigned* ctl = (unsigned*)(ws + OFF_CTL);
    { TIDS0 if (tid < 64) ((LAS unsigned*)(lds + LDS_MISC))[tid] = 0u; }
    __syncthreads();
    XcdBarrier bar; bar.bar = ctl; bar.x = 0; bar.st = nullptr;
    if (MK_N_LAUNCHES == 1) { TIDS0 bar = xcd_barrier_post(ctl, (volatile LAS unsigned*)(lds + LDS_MISC), tid == 0); }
#ifndef PH_MASK
#define PH_MASK 0xffffffffu
#endif
#define TIDS int tid; asm volatile("v_mbcnt_lo_u32_b32 %0, -1, 0\n\tv_mbcnt_hi_u32_b32 %0, -1, %0" : "=v"(tid)); tid += wave_s * 64; const int lane = tid & 63; const int wave = wave_s; (void)lane; (void)wave;
#define IN(k) ((((PH_MASK) >> (k)) & 1u) && P.ph_lo <= (k) && (k) < P.ph_hi)
#define SEAM(k) do { if (MK_N_LAUNCHES == 1 && IN(k) && IN((k) + 1)) { TIDS0 xcd_barrier(bar, tid == 0); } } while (0)

    unsigned* cntg = ctl + CNT_WORD0;
    LAS unsigned* rowoff = (LAS unsigned*)(lds + LDS_ROWOFF);
    LAS float* rowsc = (LAS float*)(lds + LDS_ROWSC);
    LAS int* startL = (LAS int*)(lds + LDS_START);
    LAS int* cntL = (LAS int*)(lds + LDS_CNT);
    char* stage = (char*)lds + LDS_STAGE;
    LAS unsigned char* ldsL = (LAS unsigned char*)lds;

    if (IN(0)) {
        TIDS
        {
            float* sc = (float*)(lds);
            float* red = (float*)(lds + 32768);
            const float* c = P.in[I_C];
            for (int i = tid; i < 8192; i += 512) sc[i] = siluf(c[i]);
            __syncthreads();
            for (int cb = blk; cb < 256; cb += G) {
                const int cj = tid & 31, kg = tid >> 5;
                float a0 = 0, a1 = 0, a2 = 0, a3 = 0, a4 = 0, a5 = 0, a6 = 0, a7 = 0;
                if (cj < 24) {
                    const float* w = P.in[I_WADA] + cb * 24 + cj;
                    for (int k = kg * 64; k < kg * 64 + 64; ++k) {
                        const float wv = w[(size_t)k * 6144];
                        a0 += sc[k] * wv; a1 += sc[1024 + k] * wv; a2 += sc[2048 + k] * wv; a3 += sc[3072 + k] * wv;
                        a4 += sc[4096 + k] * wv; a5 += sc[5120 + k] * wv; a6 += sc[6144 + k] * wv; a7 += sc[7168 + k] * wv;
                    }
                }
                float* rp = red + (kg * 8) * 32 + cj;
                rp[0] = a0; rp[32] = a1; rp[64] = a2; rp[96] = a3; rp[128] = a4; rp[160] = a5; rp[192] = a6; rp[224] = a7;
                __syncthreads();
                if (tid < 256) {
                    const int b = tid >> 5, j = tid & 31;
                    if (j < 24) {
                        float s = 0.f;
                        for (int g = 0; g < 16; ++g) s += red[(g * 8 + b) * 32 + j];
                        const int col = cb * 24 + j;
                        W_mod[b * 6144 + col] = s + P.in[I_BADA][col];
                    }
                }
                __syncthreads();
            }
        }
        {
            for (int idx = blk * 512 + tid; idx < 4096 * 16; idx += G * 512) {
                const int s = idx >> 4, i = idx & 15;
                double inv = 1.0; for (int j = 0; j < i; ++j) inv *= 0.5623413251903491;
                const float invf = (float)inv;
                const float angf = (float)s * invf;
                const double xa = (double)angf;
                const double nrev = __builtin_rint(xa * 0.15915494309189535);
                const double r = xa - nrev * 6.283185307179586;
                const double r2 = r * r;
                double ts = r, ss = r, tc = 1.0, cc = 1.0;
#pragma unroll
                for (int n = 1; n <= 14; ++n) {
                    ts *= -r2 / (double)((2 * n) * (2 * n + 1)); ss += ts;
                    tc *= -r2 / (double)((2 * n - 1) * (2 * n)); cc += tc;
                }
                W_ropecs[idx * 2] = (float)cc; W_ropecs[idx * 2 + 1] = (float)ss;
            }
        }
        {
            for (int idx = blk * 512 + tid; idx < 3 * 8 * 129; idx += G * 512) {
                const int j = idx % 129, hh = (idx / 129) % 8, p = idx / (129 * 8);
                const int dil = (p == 0) ? 1 : (p == 1 ? 4 : 16);
                const int rel = (j - 64) * dil;
                const int n = rel < 0 ? -rel : rel;
                const float nf = (float)(n > 1 ? n : 1);
                int large = 8 + (int)(__logf(nf * 0.125f) / 4.852030263919617f * 8.0f);
                large = large < 15 ? large : 15;
                const int bucket = (rel > 0 ? 16 : 0) + (n < 8 ? n : large);
                W_biasT[idx] = P.in[I_REL][bucket * 8 + hh] * LOG2E;
            }
        }
        {
            const int wi = blk * 512 + tid, nw = G * 512;
            convert_T(W_WinT, P.in[I_WIN], INC, 1024, INCP,
                      [](int n) { if (n >= INC) return -1; if (n < 2176) return n; const int i = n - 2176; return 2176 + ((i & 1) ? 16 : 0) + (i >> 1); },
                      [](int n) { return perm_row(n); }, OneK{}, [](int n) { return n < 512 ? 0.125f * LOG2E : 1.0f; }, wi, nw);
            convert_T(W_WuqT, P.in[I_WUQ], 768, 384, 768,
                      [](int n) { if (n < 512) return (n >> 6) * 96 + (n & 63); const int hh = (n - 512) >> 5, i = n & 31; return hh * 96 + 64 + ((i & 1) ? 16 : 0) + (i >> 1); },
                      [](int n) { return perm_row(n); }, VecK{P.in[I_QNG]}, [](int) { return 0.10206207261596577f * LOG2E; }, wi, nw);
            convert_T(W_WukvT, P.in[I_WUKV], 1024, 256, 1024, IdCol{}, [](int n) { return perm_row(n); }, VecK{P.in[I_KVNG]}, [](int) { return 1.f; }, wi, nw);
            {
                const float* ag = P.in[I_AOG]; const float* bg = P.in[I_BOG];
                convert_T(W_WoT, P.in[I_WO], 1024, 1024, 1024, IdCol{}, [](int n) { return perm_row(n); }, [=](int k) { return k < 512 ? ag[k] : bg[k - 512]; }, [](int) { return 1.f; }, wi, nw);
            }
            convert_T(W_WrT, P.in[I_WR], 256, 1024, 256, IdCol{}, [](int n) { return perm_row(n); }, OneK{}, [](int) { return 1.f; }, wi, nw);
            convert_T(W_Ws13T, P.in[I_WS1], 256, 1024, 256, IdCol{}, [](int n) { return perm_row((n >> 7) * 256 + (n & 127)); }, OneK{}, [](int) { return 1.f; }, wi, nw);
            convert_T(W_Ws13T, P.in[I_WS3], 256, 1024, 256, IdCol{}, [](int n) { return perm_row((n >> 7) * 256 + 128 + (n & 127)); }, OneK{}, [](int) { return 1.f; }, wi, nw);
            convert_T(W_Ws2T, P.in[I_WS2], 1024, 256, 1024, IdCol{}, [](int n) { return perm_row(n); }, OneK{}, [](int) { return 1.f; }, wi, nw);
        }
    }
    SEAM(0);

    if (IN(1)) {
        TIDS
        const float* g = P.in[I_N1G];
        for (int row = blk * 8 + wave; row < NTOK; row += G * 8) {
            const int b = row >> 12;
            const float* xr = W_x + (size_t)row * DM;
            f32x4 v[4]; float ss = 0.f;
#pragma unroll
            for (int i = 0; i < 4; ++i) { v[i] = *(const f32x4*)(xr + i * 256 + lane * 4); ss += v[i][0] * v[i][0] + v[i][1] * v[i][1] + v[i][2] * v[i][2] + v[i][3] * v[i][3]; }
            ss = wave_sum(ss);
            const float rinv = rsqrtf(ss * (1.0f / 1024.0f) + EPS);
            const float* mb = W_mod + b * 6144;
#pragma unroll
            for (int i = 0; i < 4; ++i) {
                const int c = i * 256 + lane * 4;
                const f32x4 gg = *(const f32x4*)(g + c), sh = *(const f32x4*)(mb + c), sc = *(const f32x4*)(mb + 1024 + c);
                float o[4];
#pragma unroll
                for (int j = 0; j < 4; ++j) o[j] = v[i][j] * rinv * gg[j] * (1.0f + sc[j]) + sh[j];
                u32x2 w; w.x = pk2(o[0], o[1]); w.y = pk2(o[2], o[3]);
                *(u32x2*)(W_hbuf + (size_t)row * DM + c) = w;
            }
        }
    }
    SEAM(1);

    if (IN(2)) {
        TIDS
        unsigned vl_[4]; g8_voff_lin(vl_, DM, tid);
        auto nextf = [&](int i, GDesc& d) {
            const int ul = i * 32 + (vblk & 31); if (ul >= 144 || vblk >= 256) return false;
            const int pm = (vblk >> 5) * 16 + ul / 9, pn = ul % 9;
            d.Ab = (const char*)(W_hbuf + (size_t)pm * 256 * DM); d.Bb = (const char*)(W_WinT + (size_t)pn * 256 * DM);
            d.va0 = vl_[0]; d.va1 = vl_[1]; d.va2 = vl_[2]; d.va3 = vl_[3]; d.i0 = pm; d.i1 = pn; return true;
        };
        auto epi = [&](const f32x4 (&acc)[2][2][4][2], const GDesc& d, int wr, int wc, int fr, int fq) {
            const int pm = d.i0, pn = d.i1;
            if (pn < 8) {
                EPI_FOREACH8(acc, wr, wc, fr, fq, r, c8, v0, v1, {
                    u32x4 w; PK8(w, v0, v1);
                    *(u32x4*)(W_proj + (size_t)(pm * 256 + r) * INCP + pn * 256 + c8) = w;
                })
            } else {
                EPI_FOREACH8(acc, wr, wc, fr, fq, r, c8, v0, v1, {
                    const int row = pm * 256 + r;
                    if (c8 < 160) {
                        f32x4 o0 = v0, o1 = v1;
                        if (c8 >= 128) {
                            const int i = (c8 - 128) >> 1; const int s = row & 4095;
                            const f32x4 ca = *(const f32x4*)(W_ropecs + (s * 16 + i) * 2), cb = *(const f32x4*)(W_ropecs + (s * 16 + i) * 2 + 4);
                            o0[0] = v0[0] * ca[0] - v0[1] * ca[1]; o0[1] = v0[1] * ca[0] + v0[0] * ca[1];
                            o0[2] = v0[2] * ca[2] - v0[3] * ca[3]; o0[3] = v0[3] * ca[2] + v0[2] * ca[3];
                            o1[0] = v1[0] * cb[0] - v1[1] * cb[1]; o1[1] = v1[1] * cb[0] + v1[0] * cb[1];
                            o1[2] = v1[2] * cb[2] - v1[3] * cb[3]; o1[3] = v1[3] * cb[2] + v1[2] * cb[3];
                        }
                        u32x4 w; PK8(w, o0, o1);
                        *(u32x4*)(W_proj + (size_t)row * INCP + 2048 + c8) = w;
                    }
                })
            }
            if (pn >= 6) {
#pragma unroll
                for (int ai = 0; ai < 2; ++ai)
#pragma unroll
                    for (int m = 0; m < 4; ++m)
#pragma unroll
                        for (int bj = 0; bj < 2; ++bj) {
                            const f32x4 a = acc[ai][bj][m][0], b = acc[ai][bj][m][1];
                            float ss = a[0] * a[0] + a[1] * a[1] + a[2] * a[2] + a[3] * a[3] + b[0] * b[0] + b[1] * b[1] + b[2] * b[2] + b[3] * b[3];
                            { float o; const float t = x16f(ss, o); ss = t + o; }
                            { float o; const float t = x32f(ss, o); ss = t + o; }
                            if (fq == 0) W_ssq[(size_t)(pm * 256 + ai * 128 + wr * 64 + m * 16 + fr) * 24 + (pn - 6) * 8 + bj * 4 + wc] = ss;
                        }
            }
        };
        gemm_stream(ldsL, tid, DM, nextf, epi);
        if ((vblk & 31) >= 16) {
            TIDS
#pragma unroll 1
            for (int q = 0; q < 2; ++q) {
                const int uu = blk + q * G;
                const int e = (G == 256) ? ((vblk & ~3) + q) : (uu >> 2), pn = (G == 256) ? (vblk & 3) : (uu & 3);
                __syncthreads();
                if (uu < 1024) convert_panel_lds<256, true>(W_scr + (size_t)2 * 256 * 1024 + (size_t)q * 256 * 256, P.in[I_W2] + (size_t)e * 256 * 1024 + pn * 256, 1024, 256, tid, ldsL);
            }
        }
    }
    SEAM(2);

    if (IN(3)) {
        {
            TIDS
            const int xb = (vblk >> 5) * 16, lb = vblk & 31;
            __syncthreads();
            for (int j = 0; j < 2; ++j) { const int ul = j * 32 + lb; if (ul < 48 && tid < 256) {
                const float* sp = W_ssq + (size_t)((xb + ul / 3) * 256 + tid) * 24;
                const f32x4 s0 = *(const f32x4*)sp, s1 = *(const f32x4*)(sp + 4), s2 = *(const f32x4*)(sp + 8);
                const float ss = ((s0[0] + s0[1]) + (s0[2] + s0[3])) + ((s1[0] + s1[1]) + (s1[2] + s1[3])) + ((s2[0] + s2[1]) + (s2[2] + s2[3]));
                rowsc[j * 256 + tid] = rsqrtf(ss * (1.0f / 384.0f) + EPS); } }
            __syncthreads();
            unsigned vl_[4]; g8_voff_lin(vl_, INCP, tid);
            auto nextf = [&](int i, GDesc& d) {
                const int ul = i * 32 + lb; if (ul >= 48 || vblk >= 256) return false;
                const int pm = xb + ul / 3, pn = ul % 3;
                d.Ab = (const char*)(W_proj + (size_t)pm * 256 * INCP + 1536); d.Bb = (const char*)(W_WuqT + (size_t)pn * 256 * QLORA);
                d.va0 = vl_[0]; d.va1 = vl_[1]; d.va2 = vl_[2]; d.va3 = vl_[3]; d.i0 = pm * 4 + pn; d.i1 = i; return true;
            };
            auto epi = [&](const f32x4 (&acc)[2][2][4][2], const GDesc& d, int wr, int wc, int fr, int fq) {
                const int pm = d.i0 >> 2, pn = d.i0 & 3, sl = d.i1 * 256;
                if (pn < 2) {
                    EPI_FOREACH8(acc, wr, wc, fr, fq, r, c8, v0, v1, {
                        const float rs = rowsc[sl + r];
                        const f32x4 a = v0 * rs, b = v1 * rs;
                        u32x4 w; PK8(w, a, b);
                        *(u32x4*)(W_qb + (size_t)(pm * 256 + r) * 768 + pn * 256 + c8) = w;
                    })
                } else {
                    EPI_FOREACH8(acc, wr, wc, fr, fq, r, c8, v0, v1, {
                        const int row = pm * 256 + r;
                        const float rs = rowsc[sl + r];
                        const int i = (c8 & 31) >> 1; const int s = row & 4095;
                        const f32x4 ca = *(const f32x4*)(W_ropecs + (s * 16 + i) * 2), cb = *(const f32x4*)(W_ropecs + (s * 16 + i) * 2 + 4);
                        const f32x4 t0 = v0 * rs, t1 = v1 * rs;
                        f32x4 o0, o1;
                        o0[0] = t0[0] * ca[0] - t0[1] * ca[1]; o0[1] = t0[1] * ca[0] + t0[0] * ca[1];
                        o0[2] = t0[2] * ca[2] - t0[3] * ca[3]; o0[3] = t0[3] * ca[2] + t0[2] * ca[3];
                        o1[0] = t1[0] * cb[0] - t1[1] * cb[1]; o1[1] = t1[1] * cb[0] + t1[0] * cb[1];
                        o1[2] = t1[2] * cb[2] - t1[3] * cb[3]; o1[3] = t1[3] * cb[2] + t1[2] * cb[3];
                        u32x4 w; PK8(w, o0, o1);
                        *(u32x4*)(W_qb + (size_t)row * 768 + 512 + c8) = w;
                    })
                }
            };
            gemm_stream(ldsL, tid, QLORA, nextf, epi);
        }
        {
            TIDS
            const int xb = (vblk >> 5) * 16, lb = vblk & 31;
            __syncthreads();
            for (int j = 0; j < 2; ++j) { const int ul = j * 32 + lb; if (tid < 256) {
                const float* sp = W_ssq + (size_t)((xb + ul / 4) * 256 + tid) * 24 + 12;
                const f32x4 s0 = *(const f32x4*)sp, s1 = *(const f32x4*)(sp + 4);
                const float ss = ((s0[0] + s0[1]) + (s0[2] + s0[3])) + ((s1[0] + s1[1]) + (s1[2] + s1[3]));
                rowsc[j * 256 + tid] = rsqrtf(ss * (1.0f / 256.0f) + EPS); } }
            __syncthreads();
            unsigned vl_[4]; g8_voff_lin(vl_, INCP, tid);
            auto nextf = [&](int i, GDesc& d) {
                const int ul = i * 32 + lb; if (ul >= 64 || vblk >= 256) return false;
                const int pm = xb + ul / 4, pn = ul % 4;
                d.Ab = (const char*)(W_proj + (size_t)pm * 256 * INCP + 1920); d.Bb = (const char*)(W_WukvT + (size_t)pn * 256 * KVLORA);
                d.va0 = vl_[0]; d.va1 = vl_[1]; d.va2 = vl_[2]; d.va3 = vl_[3]; d.i0 = pm * 4 + pn; d.i1 = i; return true;
            };
            auto epi = [&](const f32x4 (&acc)[2][2][4][2], const GDesc& d, int wr, int wc, int fr, int fq) {
                const int pm = d.i0 >> 2, pn = d.i0 & 3, sl = d.i1 * 256;
                EPI_FOREACH8(acc, wr, wc, fr, fq, r, c8, v0, v1, {
                    const float rs = rowsc[sl + r];
                    const f32x4 a = v0 * rs, b = v1 * rs;
                    u32x4 w; PK8(w, a, b);
                    *(u32x4*)(W_kvb + (size_t)(pm * 256 + r) * 1024 + pn * 256 + c8) = w;
                })
            };
            gemm_stream(ldsL, tid, KVLORA, nextf, epi);
        }
    }
    SEAM(3);

    if (IN(4)) {
        for (int ui = 0; ui < ((P.flags & 4) ? 0 : 4); ++ui) {
            TIDS
            const int r32 = lane & 31, hh = lane >> 5;
            if (vblk >= 256) break;
            const int qblk = vblk & 15, bh = (vblk >> 5) * 8 + ui * 2 + ((vblk >> 4) & 1), h = bh & 7, b = bh >> 3;
            const size_t tok0 = (size_t)b * SEQ;
            bf16x8 qf[6];
            {
                const size_t tq = tok0 + qblk * 256 + wave * 32 + r32;
#pragma unroll
                for (int d0 = 0; d0 < 6; ++d0) qf[d0] = *(const bf16x8*)(W_qb + tq * 768 + (d0 < 4 ? h * 64 + d0 * 16 : 512 + h * 32 + (d0 - 4) * 16) + hh * 8);
            }
            f32x16 o0 = {}, o1 = {};
            f32x16 mneg = {};
            float m_run = 0.f, l_run = 0.f;
            const int skey = tid >> 3, sch = tid & 7;
            const bf16_t* kn_src = W_kvb + (tok0 + skey) * 1024 + h * 128 + sch * 8;
            const int pkey = tid >> 2, pch = tid & 3;
            const bf16_t* kp_src = W_proj + (tok0 + pkey) * INCP + 2176 + pch * 8;
            constexpr int KBUF = 12 * 2048, VBUF = 2 * 8192, BUFB = KBUF + VBUF;
            const int k_dst = sch * 2048 + ((skey ^ sch) * 16);
            const int kp_dst = (8 + pch) * 2048 + ((pkey ^ pch) * 16);
            const int v_dst = KBUF + (sch >> 2) * 8192 + skey * 64 + (sch & 3) * 16;
            const int kfo = hh * 2048;
            const int vfo = KBUF + (4 * hh + ((lane & 15) >> 2)) * 64 + ((lane >> 4) & 1) * 32 + (lane & 3) * 8;
            __syncthreads();
            {
                const u32x4 k0 = *(const u32x4*)kn_src, v0 = *(const u32x4*)(kn_src + 64);
                const u32x4 k1 = *(const u32x4*)(kn_src + 64 * 1024), v1 = *(const u32x4*)(kn_src + 64 * 1024 + 64);
                const u32x4 pr = *(const u32x4*)kp_src;
                *(LAS u32x4*)(ldsL + k_dst) = k0; *(LAS u32x4*)(ldsL + k_dst + 1024) = k1;
                *(LAS u32x4*)(ldsL + v_dst) = v0; *(LAS u32x4*)(ldsL + v_dst + 4096) = v1;
                *(LAS u32x4*)(ldsL + kp_dst) = pr;
            }
            __syncthreads();
#pragma unroll 1
            for (int t = 0; t < 32; ++t) {
                const int cur = t & 1;
                const int tn = (t + 1 < 32) ? t + 1 : t;
                const bf16_t* ks = kn_src + (size_t)tn * 128 * 1024;
                const u32x4 nk0 = *(const u32x4*)ks, nv0 = *(const u32x4*)(ks + 64);
                const u32x4 nk1 = *(const u32x4*)(ks + 64 * 1024), nv1 = *(const u32x4*)(ks + 64 * 1024 + 64);
                const u32x4 npr = *(const u32x4*)(kp_src + (size_t)tn * 128 * INCP);
                f32x16 sc[2][2];
#pragma unroll
                for (int sub = 0; sub < 2; ++sub) {
                    const int kb = cur * BUFB + kfo + sub * 1024;
#pragma unroll
                    for (int d0 = 0; d0 < 6; ++d0) {
                        const int sw = (2 * d0 + hh) & 7;
                        const bf16x8 k0 = *(const LAS bf16x8*)(ldsL + kb + d0 * 4096 + ((r32 ^ sw) * 16));
                        const bf16x8 k1 = *(const LAS bf16x8*)(ldsL + kb + d0 * 4096 + (((32 + r32) ^ sw) * 16));
                        if (d0 == 0) { sc[sub][0] = __builtin_amdgcn_mfma_f32_32x32x16_bf16(k0, qf[0], mneg, 0, 0, 0); sc[sub][1] = __builtin_amdgcn_mfma_f32_32x32x16_bf16(k1, qf[0], mneg, 0, 0, 0); }
                        else { sc[sub][0] = __builtin_amdgcn_mfma_f32_32x32x16_bf16(k0, qf[d0], sc[sub][0], 0, 0, 0); sc[sub][1] = __builtin_amdgcn_mfma_f32_32x32x16_bf16(k1, qf[d0], sc[sub][1], 0, 0, 0); }
                    }
                }
#pragma unroll
                for (int sub = 0; sub < 2; ++sub) {
                    const int vb = cur * BUFB + vfo + sub * 4096;
                    f32x16& s0 = sc[sub][0]; f32x16& s1 = sc[sub][1];
                    float mx = fmaxf(s0[0], s1[0]);
#pragma unroll
                    for (int i = 1; i < 16; ++i) mx = fmaxf(mx, fmaxf(s0[i], s1[i]));
                    mx = max32(mx);
                    const bool first = (t == 0 && sub == 0);
                    if (first || __builtin_amdgcn_ballot_w64(mx > 8.0f) != 0ull) {
                        const float d = first ? mx : fmaxf(mx, 0.f);
                        const float alpha = first ? 0.f : ex2(-d);
                        m_run += d; l_run *= alpha;
#pragma unroll
                        for (int i = 0; i < 16; ++i) { o0[i] *= alpha; o1[i] *= alpha; s0[i] -= d; s1[i] -= d; mneg[i] = -m_run; }
                        if (sub == 0) {
#pragma unroll
                            for (int i = 0; i < 16; ++i) { sc[1][0][i] -= d; sc[1][1][i] -= d; }
                        }
                    }
                    float ps = 0.f;
#pragma unroll
                    for (int i = 0; i < 16; ++i) { s0[i] = ex2(s0[i]); s1[i] = ex2(s1[i]); ps += s0[i] + s1[i]; }
                    l_run += ps;
                    bf16x8 pf[2][2];
#pragma unroll
                    for (int s = 0; s < 2; ++s) {
                        u32x4 w0, w1;
                        w0.x = pk2(s0[8 * s + 0], s0[8 * s + 1]); w0.y = pk2(s0[8 * s + 2], s0[8 * s + 3]); w0.z = pk2(s0[8 * s + 4], s0[8 * s + 5]); w0.w = pk2(s0[8 * s + 6], s0[8 * s + 7]);
                        w1.x = pk2(s1[8 * s + 0], s1[8 * s + 1]); w1.y = pk2(s1[8 * s + 2], s1[8 * s + 3]); w1.z = pk2(s1[8 * s + 4], s1[8 * s + 5]); w1.w = pk2(s1[8 * s + 6], s1[8 * s + 7]);
                        pf[0][s] = __builtin_bit_cast(bf16x8, w0); pf[1][s] = __builtin_bit_cast(bf16x8, w1);
                    }
#pragma unroll
                    for (int n = 0; n < 2; ++n)
#pragma unroll
                        for (int s = 0; s < 2; ++s) {
                            const int ko = (32 * n + 16 * s) * 64;
#pragma unroll
                            for (int db = 0; db < 2; ++db) {
                                const s16x4 lo = __builtin_bit_cast(s16x4, __builtin_amdgcn_ds_read_tr16_b64_v4i16((LAS s16x4*)(ldsL + vb + db * 8192 + ko)));
                                const s16x4 hi = __builtin_bit_cast(s16x4, __builtin_amdgcn_ds_read_tr16_b64_v4i16((LAS s16x4*)(ldsL + vb + db * 8192 + ko + 512)));
                                const bf16x8 vf = {lo[0], lo[1], lo[2], lo[3], hi[0], hi[1], hi[2], hi[3]};
                                if (db == 0) o0 = __builtin_amdgcn_mfma_f32_32x32x16_bf16(vf, pf[n][s], o0, 0, 0, 0);
                                else o1 = __builtin_amdgcn_mfma_f32_32x32x16_bf16(vf, pf[n][s], o1, 0, 0, 0);
                            }
                        }
                }
                {
                    const int nb = (cur ^ 1) * BUFB;
                    *(LAS u32x4*)(ldsL + nb + k_dst) = nk0; *(LAS u32x4*)(ldsL + nb + k_dst + 1024) = nk1;
                    *(LAS u32x4*)(ldsL + nb + v_dst) = nv0; *(LAS u32x4*)(ldsL + nb + v_dst + 4096) = nv1;
                    *(LAS u32x4*)(ldsL + nb + kp_dst) = npr;
                }
                __syncthreads();
            }
            {
                const float lt = sum32(l_run);
                const float inv = 1.0f / lt;
                const int sc = 81920 + wave * 4352;
#pragma unroll
                for (int g = 0; g < 4; ++g) {
                    u32x2 w;
                    w.x = pk2(o0[4 * g] * inv, o0[4 * g + 1] * inv); w.y = pk2(o0[4 * g + 2] * inv, o0[4 * g + 3] * inv);
                    *(LAS u32x2*)(ldsL + sc + r32 * 136 + (8 * g + 4 * hh) * 2) = w;
                    w.x = pk2(o1[4 * g] * inv, o1[4 * g + 1] * inv); w.y = pk2(o1[4 * g + 2] * inv, o1[4 * g + 3] * inv);
                    *(LAS u32x2*)(ldsL + sc + r32 * 136 + (32 + 8 * g + 4 * hh) * 2) = w;
                }
                __syncthreads();
#pragma unroll
                for (int it = 0; it < 8; ++it) {
                    const int row = it * 4 + (lane >> 4), pc = lane & 15;
                    const u32x2 w = *(const LAS u32x2*)(ldsL + sc + row * 136 + pc * 8);
                    *(u32x2*)(W_bout + (tok0 + qblk * 256 + wave * 32 + row) * 512 + h * 64 + pc * 4) = w;
                }
            }
            if ((vblk & 3) == ui) {
#pragma unroll 1
                for (int sl = 0; sl < 4; ++sl) {
                    const int j = sl >> 1; const int uu = blk + j * G;
                    const int e = (G == 256) ? ((vblk & ~1) + j) : (uu >> 1), pn = (G == 256) ? (vblk & 1) : (uu & 1);
                    __syncthreads();
                    if (uu < 512) convert_panel_lds<128, true>(W_scr + (size_t)j * 256 * 1024 + (sl & 1) * 128 * 1024, P.in[(sl & 1) ? I_W3 : I_W1] + (size_t)e * 1024 * 256 + pn * 128, 256, 1024, tid, ldsL);
                }
            }
        }
        for (int ui = 0; ui < ((P.flags & 8) ? 0 : 12); ++ui) {
            TIDS
            const int r32 = lane & 31, hh = lane >> 5;
            const int u = vblk * 12 + ui;
            if (u >= 3072) break;
            const int bh = u / 48, w48 = u % 48, h = bh & 7, b = bh >> 3;
            const int p = w48 >> 4, j16 = w48 & 15;
            const int dil = (p == 0) ? 1 : (p == 1 ? 4 : 16);
            const int res = (p == 0) ? 0 : (p == 1 ? (j16 >> 2) : j16);
            const int m0 = (p == 0) ? j16 * 256 : (p == 1 ? (j16 & 3) * 256 : 0);
            const int L = SEQ / dil;
            const size_t tok0 = (size_t)b * SEQ;
            __syncthreads();
            for (int idx = tid; idx < 672; idx += 512) { const int oi = idx - 255; *(LAS float*)(ldsL + 98304 + idx * 4) = (oi >= 0 && oi <= 128) ? W_biasT[(p * 8 + h) * 129 + oi] : -1e30f; }
            {
                u32x4 kr[6], vr[6];
#pragma unroll
                for (int it = 0; it < 6; ++it) {
                    const int idx = it * 512 + tid, row = idx >> 3, ch = idx & 7;
                    const int mk = m0 - 64 + row;
                    kr[it] = (u32x4){0, 0, 0, 0}; vr[it] = (u32x4){0, 0, 0, 0};
                    if (mk >= 0 && mk < L) {
                        const bf16_t* src = W_proj + (tok0 + (size_t)mk * dil + res) * INCP + 512 + h * 64 + ch * 8;
                        kr[it] = *(const u32x4*)src; vr[it] = *(const u32x4*)(src + 512);
                    }
                }
#pragma unroll
                for (int it = 0; it < 6; ++it) {
                    const int idx = it * 512 + tid, row = idx >> 3, ch = idx & 7;
                    *(LAS u32x4*)(ldsL + ch * 6144 + ((row ^ ch) * 16)) = kr[it];
                    *(LAS u32x4*)(ldsL + 49152 + (ch >> 2) * 24576 + row * 64 + (ch & 3) * 16) = vr[it];
                }
            }
            const int qrel = wave * 32 + r32;
            const size_t tq = tok0 + (size_t)(m0 + qrel) * dil + res;
            bf16x8 qf[4];
#pragma unroll
            for (int d0 = 0; d0 < 4; ++d0) qf[d0] = *(const bf16x8*)(W_proj + tq * INCP + h * 64 + d0 * 16 + hh * 8);
            __syncthreads();
            f32x16 o0 = {}, o1 = {};
            float m_run = -1e20f, l_run = 0.f;
            const int vfo = 49152 + (4 * hh + ((lane & 15) >> 2)) * 64 + ((lane >> 4) & 1) * 32 + (lane & 3) * 8;
#pragma unroll 1
            for (int jj = 0; jj < 3; ++jj) {
                const int jt = (wave >> 1) + jj;
                f32x16 s0 = {}, s1 = {};
#pragma unroll
                for (int d0 = 0; d0 < 4; ++d0) {
                    const int ch = 2 * d0 + hh;
                    const bf16x8 k0 = *(const LAS bf16x8*)(ldsL + ch * 6144 + (((64 * jt + r32) ^ ch) * 16));
                    const bf16x8 k1 = *(const LAS bf16x8*)(ldsL + ch * 6144 + (((64 * jt + 32 + r32) ^ ch) * 16));
                    s0 = __builtin_amdgcn_mfma_f32_32x32x16_bf16(k0, qf[d0], s0, 0, 0, 0);
                    s1 = __builtin_amdgcn_mfma_f32_32x32x16_bf16(k1, qf[d0], s1, 0, 0, 0);
                }
                const LAS float* bl = (const LAS float*)(ldsL + 98304) + (64 * jt - qrel + 4 * hh + 255);
                const int mkb = m0 - 64 + 64 * jt;
                const bool edge = (mkb < 0) || (mkb + 64 > L);
                float mx = -1e30f;
#pragma unroll
                for (int i = 0; i < 16; ++i) {
                    const int cr = (i & 3) + 8 * (i >> 2);
                    s0[i] += bl[cr]; s1[i] += bl[cr + 32];
                    if (edge) {
                        const int mk0 = mkb + cr + 4 * hh;
                        if (mk0 < 0 || mk0 >= L) s0[i] = -1e30f;
                        if (mk0 + 32 < 0 || mk0 + 32 >= L) s1[i] = -1e30f;
                    }
                    mx = fmaxf(mx, fmaxf(s0[i], s1[i]));
                }
                mx = max32(mx);
                const float m_new = fmaxf(m_run, mx);
                const float alpha = ex2(m_run - m_new);
                m_run = m_new;
                float ps = 0.f;
#pragma unroll
                for (int i = 0; i < 16; ++i) { s0[i] = ex2(s0[i] - m_new); s1[i] = ex2(s1[i] - m_new); ps += s0[i] + s1[i]; }
                l_run = l_run * alpha + ps;
#pragma unroll
                for (int i = 0; i < 16; ++i) { o0[i] *= alpha; o1[i] *= alpha; }
                bf16x8 pf[2][2];
#pragma unroll
                for (int s = 0; s < 2; ++s) {
                    u32x4 w0, w1;
                    w0.x = pk2(s0[8 * s + 0], s0[8 * s + 1]); w0.y = pk2(s0[8 * s + 2], s0[8 * s + 3]); w0.z = pk2(s0[8 * s + 4], s0[8 * s + 5]); w0.w = pk2(s0[8 * s + 6], s0[8 * s + 7]);
                    w1.x = pk2(s1[8 * s + 0], s1[8 * s + 1]); w1.y = pk2(s1[8 * s + 2], s1[8 * s + 3]); w1.z = pk2(s1[8 * s + 4], s1[8 * s + 5]); w1.w = pk2(s1[8 * s + 6], s1[8 * s + 7]);
                    pf[0][s] = __builtin_bit_cast(bf16x8, w0); pf[1][s] = __builtin_bit_cast(bf16x8, w1);
                }
#pragma unroll
                for (int n = 0; n < 2; ++n)
#pragma unroll
                    for (int s = 0; s < 2; ++s) {
                        const int ko = (64 * jt + 32 * n + 16 * s) * 64;
#pragma unroll
                        for (int db = 0; db < 2; ++db) {
                            const s16x4 lo = __builtin_bit_cast(s16x4, __builtin_amdgcn_ds_read_tr16_b64_v4i16((LAS s16x4*)(ldsL + vfo + db * 24576 + ko)));
                            const s16x4 hi = __builtin_bit_cast(s16x4, __builtin_amdgcn_ds_read_tr16_b64_v4i16((LAS s16x4*)(ldsL + vfo + db * 24576 + ko + 512)));
                            const bf16x8 vf = {lo[0], lo[1], lo[2], lo[3], hi[0], hi[1], hi[2], hi[3]};
                            if (db == 0) o0 = __builtin_amdgcn_mfma_f32_32x32x16_bf16(vf, pf[n][s], o0, 0, 0, 0);
                            else o1 = __builtin_amdgcn_mfma_f32_32x32x16_bf16(vf, pf[n][s], o1, 0, 0, 0);
                        }
                    }
            }
            __syncthreads();
            {
                const float lt = sum32(l_run);
                const float inv = 1.0f / lt;
                if (hh == 0) W_lsebuf[((size_t)p * NTOK + tq) * 8 + h] = m_run + __log2f(lt);
                const int sc = wave * 4352;
#pragma unroll
                for (int g = 0; g < 4; ++g) {
                    u32x2 w;
                    w.x = pk2(o0[4 * g] * inv, o0[4 * g + 1] * inv); w.y = pk2(o0[4 * g + 2] * inv, o0[4 * g + 3] * inv);
                    *(LAS u32x2*)(ldsL + sc + r32 * 136 + (8 * g + 4 * hh) * 2) = w;
                    w.x = pk2(o1[4 * g] * inv, o1[4 * g + 1] * inv); w.y = pk2(o1[4 * g + 2] * inv, o1[4 * g + 3] * inv);
                    *(LAS u32x2*)(ldsL + sc + r32 * 136 + (32 + 8 * g + 4 * hh) * 2) = w;
                }
                __syncthreads();
#pragma unroll
                for (int it = 0; it < 8; ++it) {
                    const int row = it * 4 + (lane >> 4), pc = lane & 15;
                    const u32x2 w = *(const LAS u32x2*)(ldsL + sc + row * 136 + pc * 8);
                    const size_t tr = tok0 + (size_t)(m0 + wave * 32 + row) * dil + res;
                    *(u32x2*)(W_aparts + ((size_t)p * NTOK + tr) * 512 + h * 64 + pc * 4) = w;
                }
            }
            if ((vblk % 12) == ui) {
#pragma unroll 1
                for (int q = 2; q < 4; ++q) {
                    const int uu = blk + q * G;
                    const int e = (G == 256) ? ((vblk & ~3) + q) : (uu >> 2), pn = (G == 256) ? (vblk & 3) : (uu & 3);
                    __syncthreads();
                    if (uu < 1024) convert_panel_lds<256, true>(W_scr + (size_t)2 * 256 * 1024 + (size_t)q * 256 * 256, P.in[I_W2] + (size_t)e * 256 * 1024 + pn * 256, 1024, 256, tid, ldsL);
                }
            }
        }
    }
    SEAM(4);

    if (IN(5)) {
        TIDS
        for (int row = blk * 8 + wave; row < NTOK; row += G * 8) {
            const int hd = lane >> 3;
            float ls0 = W_lsebuf[((size_t)0 * NTOK + row) * 8 + hd], ls1 = W_lsebuf[((size_t)1 * NTOK + row) * 8 + hd], ls2 = W_lsebuf[((size_t)2 * NTOK + row) * 8 + hd];
            const float M = fmaxf(ls0, fmaxf(ls1, ls2));
            float w0 = ex2(ls0 - M), w1 = ex2(ls1 - M), w2 = ex2(ls2 - M);
            const float wsn = 1.0f / (w0 + w1 + w2); w0 *= wsn; w1 *= wsn; w2 *= wsn;
            const u32x4 a0 = *(const u32x4*)(W_aparts + ((size_t)0 * NTOK + row) * 512 + lane * 8);
            const u32x4 a1 = *(const u32x4*)(W_aparts + ((size_t)1 * NTOK + row) * 512 + lane * 8);
            const u32x4 a2 = *(const u32x4*)(W_aparts + ((size_t)2 * NTOK + row) * 512 + lane * 8);
            const u32x4 bb = *(const u32x4*)(W_bout + (size_t)row * 512 + lane * 8);
            float av[8], bv[8]; float sa = 0.f, sb = 0.f;
#pragma unroll
            for (int j = 0; j < 4; ++j) {
                av[2 * j] = w0 * __uint_as_float(a0[j] << 16) + w1 * __uint_as_float(a1[j] << 16) + w2 * __uint_as_float(a2[j] << 16);
                av[2 * j + 1] = w0 * __uint_as_float(a0[j] & 0xffff0000u) + w1 * __uint_as_float(a1[j] & 0xffff0000u) + w2 * __uint_as_float(a2[j] & 0xffff0000u);
                bv[2 * j] = __uint_as_float(bb[j] << 16); bv[2 * j + 1] = __uint_as_float(bb[j] & 0xffff0000u);
                sa += av[2 * j] * av[2 * j] + av[2 * j + 1] * av[2 * j + 1];
                sb += bv[2 * j] * bv[2 * j] + bv[2 * j + 1] * bv[2 * j + 1];
            }
            sa = wave_sum(sa); sb = wave_sum(sb);
            const float ra = rsqrtf(sa * (1.0f / 512.0f) + EPS), rb = rsqrtf(sb * (1.0f / 512.0f) + EPS);
            u32x4 wa, wb;
            wa.x = pk2(av[0] * ra, av[1] * ra); wa.y = pk2(av[2] * ra, av[3] * ra); wa.z = pk2(av[4] * ra, av[5] * ra); wa.w = pk2(av[6] * ra, av[7] * ra);
            wb.x = pk2(bv[0] * rb, bv[1] * rb); wb.y = pk2(bv[2] * rb, bv[3] * rb); wb.z = pk2(bv[4] * rb, bv[5] * rb); wb.w = pk2(bv[6] * rb, bv[7] * rb);
            *(u32x4*)(W_mixb + (size_t)row * DM + lane * 8) = wa;
            *(u32x4*)(W_mixb + (size_t)row * DM + 512 + lane * 8) = wb;
        }
    }
    SEAM(5);

    if (IN(6)) {
        TIDS
        unsigned vl_[4]; g8_voff_lin(vl_, DM, tid);
        auto nextf = [&](int i, GDesc& d) {
            const int ul = i * 32 + (vblk & 31); if (ul >= 64 || vblk >= 256) return false;
            const int pm = (vblk >> 5) * 16 + (ul >> 2), pn = ul & 3;
            d.Ab = (const char*)(W_mixb + (size_t)pm * 256 * DM); d.Bb = (const char*)(W_WoT + (size_t)pn * 256 * DM);
            d.va0 = vl_[0]; d.va1 = vl_[1]; d.va2 = vl_[2]; d.va3 = vl_[3]; d.i0 = pm; d.i1 = pn; return true;
        };
        auto epi = [&](const f32x4 (&acc)[2][2][4][2], const GDesc& d, int wr, int wc, int fr, int fq) {
            const int pm = d.i0, pn = d.i1;
            EPI_FOREACH8(acc, wr, wc, fr, fq, r, c8, v0, v1, {
                const int col = pn * 256 + c8; const int row = pm * 256 + r;
                const float* gp = W_mod + (row >> 12) * 6144 + 2048 + col;
                const f32x4 ga = *(const f32x4*)gp, gb = *(const f32x4*)(gp + 4);
                *(f32x4*)(P.out + (size_t)row * DM + col) = ga * v0;
                *(f32x4*)(P.out + (size_t)row * DM + col + 4) = gb * v1;
            })
        };
        gemm_stream(ldsL, tid, DM, nextf, epi);
    }
    SEAM(6);

    if (IN(7)) {
        TIDS
        const float* g = P.in[I_N2G];
        for (int row = blk * 8 + wave; row < NTOK; row += G * 8) {
            const int b = row >> 12;
            float* xr = P.out + (size_t)row * DM;
            const float* x0 = W_x + (size_t)row * DM;
            f32x4 v[4]; float ss = 0.f;
#pragma unroll
            for (int i = 0; i < 4; ++i) { v[i] = *(const f32x4*)(xr + i * 256 + lane * 4) + *(const f32x4*)(x0 + i * 256 + lane * 4); *(f32x4*)(xr + i * 256 + lane * 4) = v[i];
                ss += v[i][0] * v[i][0] + v[i][1] * v[i][1] + v[i][2] * v[i][2] + v[i][3] * v[i][3]; }
            ss = wave_sum(ss);
            const float rinv = rsqrtf(ss * (1.0f / 1024.0f) + EPS);
            const float* mb = W_mod + b * 6144 + 3072;
#pragma unroll
            for (int i = 0; i < 4; ++i) {
                const int c = i * 256 + lane * 4;
                const f32x4 gg = *(const f32x4*)(g + c), sh = *(const f32x4*)(mb + c), sc = *(const f32x4*)(mb + 1024 + c);
                float o[4];
#pragma unroll
                for (int j = 0; j < 4; ++j) o[j] = v[i][j] * rinv * gg[j] * (1.0f + sc[j]) + sh[j];
                u32x2 w; w.x = pk2(o[0], o[1]); w.y = pk2(o[2], o[3]);
                *(u32x2*)(W_hbuf + (size_t)row * DM + c) = w;
            }
        }
    }
    SEAM(7);

    if (IN(8)) {
        {
            TIDS
            unsigned vl_[4]; g8_voff_lin(vl_, DM, tid);
            auto nextf = [&](int i, GDesc& d) {
                const int ul = vblk & 31; if (i > 0 || vblk >= 256) return false;
                const int pm = (vblk >> 5) * 16 + (ul >> 1), pn = ul & 1;
                d.Ab = (const char*)(W_hbuf + (size_t)pm * 256 * DM); d.Bb = (const char*)(W_Ws13T + (size_t)pn * 256 * DM);
                d.va0 = vl_[0]; d.va1 = vl_[1]; d.va2 = vl_[2]; d.va3 = vl_[3]; d.i0 = pm; d.i1 = pn; return true;
            };
            auto epi = [&](const f32x4 (&acc)[2][2][4][2], const GDesc& d, int wr, int wc, int fr, int fq) {
                const int pm = d.i0, pn = d.i1;
#pragma unroll
                for (int ai = 0; ai < 2; ++ai)
#pragma unroll
                    for (int m = 0; m < 4; ++m) {
                        const int r = ai * 128 + wr * 64 + m * 16 + fr;
                        const f32x4 a0 = acc[ai][0][m][0], a1 = acc[ai][0][m][1], b0 = acc[ai][1][m][0], b1 = acc[ai][1][m][1];
                        f32x4 h0, h1;
#pragma unroll
                        for (int j = 0; j < 4; ++j) { h0[j] = siluf(a0[j]) * b0[j]; h1[j] = siluf(a1[j]) * b1[j]; }
                        u32x4 w; PK8(w, h0, h1);
                        *(u32x4*)(W_hdn + (size_t)(NASG + pm * 256 + r) * EFF + pn * 128 + wc * 32 + fq * 8) = w;
                    }
            };
            gemm_stream(ldsL, tid, DM, nextf, epi);
        }
        {
            TIDS
            unsigned vl_[4]; g8_voff_lin(vl_, DM, tid);
            auto nextf = [&](int i, GDesc& d) {
                const int ul = vblk & 31; if (i > 0 || ul < 16 || vblk >= 256) return false;
                const int pm = (vblk >> 5) * 16 + (ul - 16);
                d.Ab = (const char*)(W_hbuf + (size_t)pm * 256 * DM); d.Bb = (const char*)(W_WrT);
                d.va0 = vl_[0]; d.va1 = vl_[1]; d.va2 = vl_[2]; d.va3 = vl_[3]; d.i0 = pm; d.i1 = 0; return true;
            };
            auto epi = [&](const f32x4 (&acc)[2][2][4][2], const GDesc& d, int wr, int wc, int fr, int fq) {
                const int pm = d.i0;
                EPI_FOREACH8(acc, wr, wc, fr, fq, r, c8, v0, v1, {
                    *(f32x4*)(W_logits + (size_t)(pm * 256 + r) * 256 + c8) = v0;
                    *(f32x4*)(W_logits + (size_t)(pm * 256 + r) * 256 + c8 + 4) = v1;
                })
            };
            gemm_stream(ldsL, tid, DM, nextf, epi);
        }
        if ((vblk & 31) < 16) {
            TIDS
#pragma unroll 1
            for (int q = 0; q < 2; ++q) {
                const int uu = blk + q * G;
                const int e = (G == 256) ? ((vblk & ~3) + q) : (uu >> 2), pn = (G == 256) ? (vblk & 3) : (uu & 3);
                __syncthreads();
                if (uu < 1024) convert_panel_lds<256, true>(W_scr + (size_t)2 * 256 * 1024 + (size_t)q * 256 * 256, P.in[I_W2] + (size_t)e * 256 * 1024 + pn * 256, 1024, 256, tid, ldsL);
            }
        }
    }
    SEAM(8);

    if (IN(9)) {
        TIDS
        const float* ebias = P.in[I_EB];
        const f32x4 eb = *(const f32x4*)(ebias + lane * 4);
        for (int t = blk * 8 + wave; t < NTOK; t += G * 8) {
            const f32x4 lg = *(const f32x4*)(W_logits + (size_t)t * 256 + lane * 4);
            float sc[4], sel[4];
#pragma unroll
            for (int i = 0; i < 4; ++i) { sc[i] = 1.0f / (1.0f + expf(-lg[i])); sel[i] = sc[i] + eb[i]; }
            float a1 = fmaxf(sel[0], sel[1]), a2 = fminf(sel[0], sel[1]);
#pragma unroll
            for (int i = 2; i < 4; ++i) { const float v = sel[i]; a2 = fmaxf(a2, fminf(a1, v)); a1 = fmaxf(a1, v); }
            {
                float b1, b2, n1, n2;
                b1 = dppf(a1, DPP_X1); b2 = dppf(a2, DPP_X1); n1 = fmaxf(a1, b1); n2 = fmaxf(fminf(a1, b1), fmaxf(a2, b2)); a1 = n1; a2 = n2;
                b1 = dppf(a1, DPP_X2); b2 = dppf(a2, DPP_X2); n1 = fmaxf(a1, b1); n2 = fmaxf(fminf(a1, b1), fmaxf(a2, b2)); a1 = n1; a2 = n2;
                b1 = dppf(a1, DPP_HM); b2 = dppf(a2, DPP_HM); n1 = fmaxf(a1, b1); n2 = fmaxf(fminf(a1, b1), fmaxf(a2, b2)); a1 = n1; a2 = n2;
            }
            const float gs = a1 + a2; const int myg = lane >> 3;
            int rank = 0;
#pragma unroll
            for (int g = 0; g < 8; ++g) { const float v = __int_as_float(__builtin_amdgcn_readlane(__float_as_int(gs), g * 8)); rank += (v > gs || (v == gs && g < myg)) ? 1 : 0; }
            const bool gsel = rank < 4;
            float cand[4];
#pragma unroll
            for (int i = 0; i < 4; ++i) cand[i] = gsel ? sel[i] : -INFINITY;
            int my_e = 0; float my_g = 0.f; float gsum = 0.f;
#pragma unroll
            for (int k = 0; k < 8; ++k) {
                float bv = cand[0]; int bi = 0;
#pragma unroll
                for (int i = 1; i < 4; ++i) if (cand[i] > bv) { bv = cand[i]; bi = i; }
                float v = bv; int ix = lane * 4 + bi;
#define AMX(ov, oi) do { const float ov_ = (ov); const int oi_ = (oi); if (ov_ > v || (ov_ == v && oi_ < ix)) { v = ov_; ix = oi_; } } while (0)
                AMX(dppf(v, DPP_X1), dppi(ix, DPP_X1)); AMX(dppf(v, DPP_X2), dppi(ix, DPP_X2)); AMX(dppf(v, DPP_HM), dppi(ix, DPP_HM)); AMX(dppf(v, DPP_RM), dppi(ix, DPP_RM));
                { auto rv = __builtin_amdgcn_permlane16_swap(__float_as_uint(v), __float_as_uint(v), false, false); auto ri = __builtin_amdgcn_permlane16_swap((unsigned)ix, (unsigned)ix, false, false);
                  v = __uint_as_float(rv[0]); ix = (int)ri[0]; AMX(__uint_as_float(rv[1]), (int)ri[1]); }
                { auto rv = __builtin_amdgcn_permlane32_swap(__float_as_uint(v), __float_as_uint(v), false, false); auto ri = __builtin_amdgcn_permlane32_swap((unsigned)ix, (unsigned)ix, false, false);
                  v = __uint_as_float(rv[0]); ix = (int)ri[0]; AMX(__uint_as_float(rv[1]), (int)ri[1]); }
#undef AMX
                ix = __builtin_amdgcn_readfirstlane(ix);
                float myscore = 0.f;
#pragma unroll
                for (int i = 0; i < 4; ++i) if (lane * 4 + i == ix) { cand[i] = -INFINITY; myscore = sc[i]; }
                const float gw = __int_as_float(__builtin_amdgcn_readlane(__float_as_int(myscore), ix >> 2));
                gsum += gw;
                if (lane == k) { my_e = ix; my_g = gw; }
            }
            if (lane < 8) {
                const unsigned rk = atomicAdd(&cntg[my_e * CNT_STRIDE], 1u);
                W_eidx[t * 8 + lane] = my_e; W_gate[t * 8 + lane] = my_g / gsum * 2.5f; W_rnk[t * 8 + lane] = (int)rk;
            }
        }
    }
    SEAM(9);

    if (IN(10)) {
        TIDS
        if (tid < 256) cntL[tid] = (int)__hip_atomic_load(&cntg[tid * CNT_STRIDE], __ATOMIC_RELAXED, __HIP_MEMORY_SCOPE_AGENT);
        __syncthreads();
        if (tid < 256) { int s = 0; for (int j = 0; j < tid; ++j) s += cntL[j]; startL[tid] = s; }
        __syncthreads();
        for (int t = blk * 8 + wave; t < NTOK; t += G * 8) {
            if (lane < 8) {
                const int e = W_eidx[t * 8 + lane];
                const int d = startL[e] + W_rnk[t * 8 + lane];
                W_toks[d] = t; W_wts[d] = W_gate[t * 8 + lane]; W_pos[t * 8 + lane] = d;
            }
        }
    }
    SEAM(10);

    if (IN(11)) {
        TIDS
        __syncthreads();
        if (tid < 256) cntL[tid] = (int)__hip_atomic_load(&cntg[tid * CNT_STRIDE], __ATOMIC_RELAXED, __HIP_MEMORY_SCOPE_AGENT);
        __syncthreads();
        if (tid < 256) { int s = 0; for (int j = 0; j < tid; ++j) s += cntL[j]; startL[tid] = s; }
        __syncthreads();
        for (int ui = blk; ui < 512; ui += G) {
            TIDS
            const int e = (G == 256) ? ((vblk & ~1) + (ui >> 8)) : (ui >> 1), pn = (G == 256) ? (vblk & 1) : (ui & 1);
            const int cnt = cntL[e], st = startL[e];
            if (cnt == 0) continue;
            const bf16_t* panel = W_scr + (size_t)(ui / G) * 256 * 1024;
            const int ntile = (cnt + 255) >> 8;
            for (int c0 = 0; c0 < ntile; c0 += 8) {
                TIDS
                const int nch = (ntile - c0) < 8 ? (ntile - c0) : 8;
                __syncthreads();
                for (int idx = tid; idx < nch * 256; idx += 512) { const int rr = c0 * 256 + idx; const int sr = st + (rr < cnt ? rr : 0); rowoff[idx] = (unsigned)W_toks[sr] * DM; }
                __syncthreads();
                int R0, C0; g8_rc(tid, R0, C0);
                auto nextf = [&](int i, GDesc& d) {
                    if (i >= nch) return false;
                    d.Ab = (const char*)W_hbuf; d.Bb = (const char*)panel;
                    d.va0 = (rowoff[i * 256 + R0] + C0) * 2u; d.va1 = (rowoff[i * 256 + R0 + 64] + C0) * 2u; d.va2 = (rowoff[i * 256 + R0 + 128] + C0) * 2u; d.va3 = (rowoff[i * 256 + R0 + 192] + C0) * 2u;
                    d.i0 = c0 + i; d.i1 = 0; return true;
                };
                auto epi = [&](const f32x4 (&acc)[2][2][4][2], const GDesc& d, int wr, int wc, int fr, int fq) {
                    const int ti = d.i0;
#pragma unroll
                    for (int ai = 0; ai < 2; ++ai)
#pragma unroll
                        for (int m = 0; m < 4; ++m) {
                            const int r = ai * 128 + wr * 64 + m * 16 + fr;
                            const int rr = ti * 256 + r;
                            if (rr < cnt) {
                                const f32x4 a0 = acc[ai][0][m][0], a1 = acc[ai][0][m][1], b0 = acc[ai][1][m][0], b1 = acc[ai][1][m][1];
                                f32x4 h0, h1;
#pragma unroll
                                for (int j = 0; j < 4; ++j) { h0[j] = siluf(a0[j]) * b0[j]; h1[j] = siluf(a1[j]) * b1[j]; }
                                u32x4 w; PK8(w, h0, h1);
                                *(u32x4*)(W_hdn + (size_t)(st + rr) * EFF + pn * 128 + wc * 32 + fq * 8) = w;
                            }
                        }
                };
                gemm_stream(ldsL, tid, DM, nextf, epi);
            }
        }
    }
    SEAM(11);

    if (IN(12)) {
        TIDS
        __syncthreads();
        if (tid < 256) cntL[tid] = (int)__hip_atomic_load(&cntg[tid * CNT_STRIDE], __ATOMIC_RELAXED, __HIP_MEMORY_SCOPE_AGENT);
        __syncthreads();
        if (tid < 256) { int s = 0; for (int j = 0; j < tid; ++j) s += cntL[j]; startL[tid] = s; }
        __syncthreads();
#define Y_STORE(ROWG, COL0, G_) do { _Pragma("unroll") for (int bj = 0; bj < 2; ++bj) { const f32x4 a_ = acc[ai][bj][m][0], b_ = acc[ai][bj][m][1]; int w0_ = 0, w1_ = 0; \
            w0_ = __builtin_amdgcn_cvt_pk_fp8_f32(a_[0] * (G_), a_[1] * (G_), w0_, false); w0_ = __builtin_amdgcn_cvt_pk_fp8_f32(a_[2] * (G_), a_[3] * (G_), w0_, true); \
            w1_ = __builtin_amdgcn_cvt_pk_fp8_f32(b_[0] * (G_), b_[1] * (G_), w1_, false); w1_ = __builtin_amdgcn_cvt_pk_fp8_f32(b_[2] * (G_), b_[3] * (G_), w1_, true); \
            u32x2 w_; w_.x = (unsigned)w0_; w_.y = (unsigned)w1_; *(u32x2*)(W_y8 + (size_t)(ROWG) * DM + (COL0) + bj * 128 + wc * 32 + fq * 8) = w_; } } while (0)
        for (int ui = blk; ui < 1024; ui += G) {
            TIDS
            const int e = (G == 256) ? ((vblk & ~3) + (ui >> 8)) : (ui >> 2), pn = (G == 256) ? (vblk & 3) : (ui & 3);
            const int cnt = cntL[e], st = startL[e];
            if (cnt == 0) continue;
            const bf16_t* panel = W_scr + (size_t)2 * 256 * 1024 + (size_t)(ui / G) * 256 * 256;
            const int ntile = (cnt + 255) >> 8;
            for (int c0 = 0; c0 < ntile; c0 += 8) {
                TIDS
                const int nch = (ntile - c0) < 8 ? (ntile - c0) : 8;
                __syncthreads();
                for (int idx = tid; idx < nch * 256; idx += 512) { const int rr = c0 * 256 + idx; const int sr = st + (rr < cnt ? rr : 0); rowoff[idx] = (unsigned)sr * EFF; rowsc[idx] = W_wts[sr]; }
                __syncthreads();
                int R0, C0; g8_rc(tid, R0, C0);
                auto nextf = [&](int i, GDesc& d) {
                    if (i >= nch) return false;
                    d.Ab = (const char*)W_hdn; d.Bb = (const char*)panel;
                    d.va0 = (rowoff[i * 256 + R0] + C0) * 2u; d.va1 = (rowoff[i * 256 + R0 + 64] + C0) * 2u; d.va2 = (rowoff[i * 256 + R0 + 128] + C0) * 2u; d.va3 = (rowoff[i * 256 + R0 + 192] + C0) * 2u;
                    d.i0 = c0 + i; d.i1 = i; return true;
                };
                auto epi = [&](const f32x4 (&acc)[2][2][4][2], const GDesc& d, int wr, int wc, int fr, int fq) {
                    const int ti = d.i0, tl = d.i1;
#pragma unroll
                    for (int ai = 0; ai < 2; ++ai)
#pragma unroll
                        for (int m = 0; m < 4; ++m) {
                            const int r = ai * 128 + wr * 64 + m * 16 + fr;
                            const int rr = ti * 256 + r;
                            if (rr < cnt) { const float g = rowsc[tl * 256 + r]; Y_STORE(st + rr, pn * 256, g); }
                        }
                };
                gemm_stream(ldsL, tid, EFF, nextf, epi);
            }
        }
        {
            TIDS
            unsigned vl_[4]; g8_voff_lin(vl_, EFF, tid);
            auto nextf = [&](int i, GDesc& d) {
                const int u = blk + i * G; if (u >= 512) return false;
                const int pm = u >> 2, pn = u & 3;
                d.Ab = (const char*)(W_hdn + (size_t)(NASG + pm * 256) * EFF); d.Bb = (const char*)(W_Ws2T + (size_t)pn * 256 * EFF);
                d.va0 = vl_[0]; d.va1 = vl_[1]; d.va2 = vl_[2]; d.va3 = vl_[3]; d.i0 = pm; d.i1 = pn; return true;
            };
            auto epi = [&](const f32x4 (&acc)[2][2][4][2], const GDesc& d, int wr, int wc, int fr, int fq) {
                const int pm = d.i0, pn = d.i1;
#pragma unroll
                for (int ai = 0; ai < 2; ++ai)
#pragma unroll
                    for (int m = 0; m < 4; ++m) {
                        const int r = ai * 128 + wr * 64 + m * 16 + fr;
                        Y_STORE(NASG + pm * 256 + r, pn * 256, 1.0f);
                    }
            };
            gemm_stream(ldsL, tid, EFF, nextf, epi);
        }
#undef Y_STORE
    }
    SEAM(12);

    if (IN(13)) {
        TIDS
        const float* fg = P.in[I_FG];
        for (int row = blk * 8 + wave; row < NTOK; row += G * 8) {
            const int b = row >> 12;
            float a[16];
#pragma unroll
            for (int j = 0; j < 16; ++j) a[j] = 0.f;
#pragma unroll
            for (int k = 0; k < 9; ++k) {
                const int pr = (k < 8) ? W_pos[row * 8 + k] : (NASG + row);
                const u32x4 w = *(const u32x4*)(W_y8 + (size_t)pr * DM + lane * 16);
#pragma unroll
                for (int q = 0; q < 4; ++q) {
                    a[4 * q + 0] += __builtin_amdgcn_cvt_f32_fp8((int)w[q], 0); a[4 * q + 1] += __builtin_amdgcn_cvt_f32_fp8((int)w[q], 1);
                    a[4 * q + 2] += __builtin_amdgcn_cvt_f32_fp8((int)w[q], 2); a[4 * q + 3] += __builtin_amdgcn_cvt_f32_fp8((int)w[q], 3);
                }
            }
            float* xr = P.out + (size_t)row * DM + lane * 16;
            const float* g2 = W_mod + b * 6144 + 5120 + lane * 16;
            float v[16]; float ss = 0.f;
#pragma unroll
            for (int q = 0; q < 4; ++q) {
                const f32x4 xa = *(const f32x4*)(xr + q * 4), ga = *(const f32x4*)(g2 + q * 4);
#pragma unroll
                for (int j = 0; j < 4; ++j) { v[q * 4 + j] = xa[j] + ga[j] * a[q * 4 + j]; ss += v[q * 4 + j] * v[q * 4 + j]; }
            }
            ss = wave_sum(ss);
            const float rinv = rsqrtf(ss * (1.0f / 1024.0f) + EPS);
#pragma unroll
            for (int q = 0; q < 4; ++q) {
                const f32x4 fa = *(const f32x4*)(fg + lane * 16 + q * 4);
                f32x4 oa;
#pragma unroll
                for (int j = 0; j < 4; ++j) oa[j] = v[q * 4 + j] * rinv * fa[j];
                *(f32x4*)(xr + q * 4) = oa;
            }
        }
    }
#ifdef DBG_STOP
    if (IN(14)) {
        TIDS
        const size_t NO = (size_t)NTOK * DM;
        for (size_t i = (size_t)blk * 512 + tid; i < NO; i += (size_t)G * 512) {
            unsigned hsh = 0u;
            const size_t row = i >> 10, c = i & 1023;
#define RB(p, idx) ((unsigned)(p)[(idx)])
#define RF(p, idx) (__float_as_uint((p)[(idx)]))
#if DBG_STOP == 0
            hsh = RB(W_WinT, i % (2304 * 1024)) ^ RB(W_WoT, i % (1024 * 1024)) ^ RB(W_WuqT, i % (768 * 384)) ^ RB(W_WukvT, i % (1024 * 256)) ^ RB(W_Ws13T, i % (512 * 1024)) ^ RB(W_Ws2T, i % (1024 * 256)) ^ RB(W_WrT, i % (256 * 1024))
                ^ RF(W_mod, i % (8 * 6144)) ^ RF(W_ropecs, i % (4096 * 32)) ^ RF(W_biasT, i % (3 * 8 * 129));
#elif DBG_STOP == 1 || DBG_STOP == 7
            hsh = RB(W_hbuf, i);
#elif DBG_STOP == 2
            hsh = RB(W_proj, row * INCP + c) ^ (RB(W_proj, row * INCP + 1024 + c) << 1) ^ (c < 160 ? (RB(W_proj, row * INCP + 2048 + c) << 2) : 0u);
#elif DBG_STOP == 3
            hsh = RB(W_kvb, i) ^ (c < 768 ? (RB(W_qb, row * 768 + c) << 1) : 0u);
#elif DBG_STOP == 4
            if (c < 512) hsh = RB(W_bout, row * 512 + c); else if (DBG_SUB) { const size_t cc = c - 512; hsh = RB(W_aparts, row * 512 + cc) ^ (RB(W_aparts, ((size_t)NTOK + row) * 512 + cc) << 1) ^ (RB(W_aparts, ((size_t)2 * NTOK + row) * 512 + cc) << 2) ^ RF(W_lsebuf, row * 8 + (cc >> 6)) ^ (RF(W_lsebuf, ((size_t)NTOK + row) * 8 + (cc >> 6)) << 1) ^ (RF(W_lsebuf, ((size_t)2 * NTOK + row) * 8 + (cc >> 6)) << 2); }
#elif DBG_STOP == 5
            hsh = RB(W_mixb, i);
#elif DBG_STOP == 6
            hsh = RF(P.out, i);
#elif DBG_STOP == 8
            if (c < 256) hsh = RF(W_logits, row * 256 + c); else if (c < 512) hsh = RB(W_hdn, ((size_t)NASG + row) * EFF + (c - 256));
#elif DBG_STOP == 9
            if (c < 8) hsh = (unsigned)W_eidx[row * 8 + c]; else if (c < 16) hsh = RF(W_gate, row * 8 + (c - 8));
#elif DBG_STOP == 11
            { const int k = (int)(c >> 8); hsh = RB(W_hdn, (size_t)W_pos[row * 8 + k] * EFF + (c & 255)) ^ (RB(W_hdn, (size_t)W_pos[row * 8 + 4 + k] * EFF + (c & 255)) << 1); }
#elif DBG_STOP == 12
            { for (int k = 0; k < 8; ++k) hsh ^= RB(W_ybuf, (size_t)W_pos[row * 8 + k] * DM + c) << (k & 3); hsh ^= RB(W_ybuf, ((size_t)NASG + row) * DM + c); }
#endif
            P.out[i] = (float)(hsh & 0xFu);
        }
    }
#endif
#undef IN
#undef SEAM
}

extern "C" void kernel_launch(void* const* d_in, const int* in_sizes, int n_in, void* d_out, int out_size, void* d_ws, size_t ws_size, hipStream_t stream) {
    static int grid = 0;
    if (grid == 0) {
        if (n_in != 24 || ws_size < WS_END) { fprintf(stderr, "kernel_launch: need 24 inputs and %zu bytes of workspace (got %d, %zu)\n", (size_t)WS_END, n_in, ws_size); grid = -1; return; }
        int dev = 0, cus = 0, per_cu = 0;
        if (hipGetDevice(&dev) != hipSuccess || hipDeviceGetAttribute(&cus, hipDeviceAttributeMultiprocessorCount, dev) != hipSuccess) { grid = -1; return; }
        if (hipFuncSetAttribute((const void*)fwd_kernel, hipFuncAttributeMaxDynamicSharedMemorySize, LDS_BYTES) != hipSuccess) { fprintf(stderr, "kernel_launch: hipFuncSetAttribute failed\n"); grid = -1; return; }
        if (hipOccupancyMaxActiveBlocksPerMultiprocessor(&per_cu, (const void*)fwd_kernel, 512, LDS_BYTES) != hipSuccess || per_cu < 1) { fprintf(stderr, "kernel_launch: occupancy query says %d\n", per_cu); }
        (void)hipGetLastError();
        grid = cus;
    }
    if (grid < 0) return;
    (void)hipMemsetAsync((char*)d_ws + OFF_CTL, 0, CTL_BYTES, stream);
    Params p{};
    for (int i = 0; i < 24; ++i) p.in[i] = (const float*)d_in[i];
    p.out = (float*)d_out; p.ws = (unsigned char*)d_ws;
#if MK_N_LAUNCHES == 1
    p.ph_lo = 0; p.ph_hi = NPHASE;
    hipLaunchKernelGGL(fwd_kernel, dim3(grid), dim3(512), LDS_BYTES, stream, p);
#else
#ifdef DBG_STOP
    for (int k = 0; k <= DBG_STOP; ++k) { p.ph_lo = k; p.ph_hi = k + 1; hipLaunchKernelGGL(fwd_kernel, dim3(grid), dim3(512), LDS_BYTES, stream, p); }
    p.ph_lo = 14; p.ph_hi = 15; hipLaunchKernelGGL(fwd_kernel, dim3(grid), dim3(512), LDS_BYTES, stream, p);
#else
#ifndef DBL_MASK
#define DBL_MASK 0u
#endif
#ifndef DBL_FLAGS
#define DBL_FLAGS 0
#endif
    for (int k = 0; k < 14; ++k) { p.ph_lo = k; p.ph_hi = k + 1; hipLaunchKernelGGL(fwd_kernel, dim3(grid), dim3(512), LDS_BYTES, stream, p);
        if ((DBL_MASK >> k) & 1u) { p.flags = DBL_FLAGS; hipLaunchKernelGGL(fwd_kernel, dim3(grid), dim3(512), LDS_BYTES, stream, p); p.flags = 0; } }
#endif
#endif
}
```

```cpp
#include <hip/hip_runtime.h>
#include <stdint.h>
#include <stdio.h>

#ifndef MK_N_LAUNCHES
#define MK_N_LAUNCHES 1
#endif

#define DEVI __device__ __forceinline__
typedef unsigned short bf16_t;
typedef short bf16x8 __attribute__((ext_vector_type(8)));
typedef short s16x4 __attribute__((ext_vector_type(4)));
typedef float f32x4 __attribute__((ext_vector_type(4)));
typedef float f32x16 __attribute__((ext_vector_type(16)));
typedef unsigned u32x4 __attribute__((ext_vector_type(4)));
typedef unsigned u32x2 __attribute__((ext_vector_type(2)));

constexpr int NTOK = 32768, SEQ = 4096, DM = 1024;
constexpr int INC = 2208, INCP = 2304;
constexpr int QLORA = 384, KVLORA = 256;
constexpr int NEXP = 256, EFF = 256;
constexpr int NASG = NTOK * 8;
constexpr int NROWS = NASG + NTOK;
constexpr float EPS = 1e-6f;
constexpr float LOG2E = 1.4426950408889634f;

constexpr size_t MiB = 1u << 20;
constexpr size_t OFF_CTL = 0, CTL_BYTES = 1 * MiB;
constexpr size_t OFF_MOD = 1 * MiB;
constexpr size_t OFF_ROPE = OFF_MOD + 256 * 1024;
constexpr size_t OFF_BIAS = OFF_ROPE + 512 * 1024;
constexpr size_t OFF_WIN = 2 * MiB;
constexpr size_t OFF_WUQ = OFF_WIN + 4608 * 1024;
constexpr size_t OFF_WUKV = OFF_WUQ + 1 * MiB;
constexpr size_t OFF_WO = OFF_WUKV + 512 * 1024;
constexpr size_t OFF_WR = OFF_WO + 2 * MiB;
constexpr size_t OFF_WS13 = OFF_WR + 512 * 1024;
constexpr size_t OFF_WS2 = OFF_WS13 + 1 * MiB;
constexpr size_t OFF_H = 12 * MiB;
constexpr size_t OFF_LOGITS = OFF_H + 64 * MiB;
constexpr size_t OFF_EIDX = OFF_LOGITS + 32 * MiB;
constexpr size_t OFF_GATE = OFF_EIDX + 1 * MiB;
constexpr size_t OFF_RNK = OFF_GATE + 1 * MiB;
constexpr size_t OFF_POS = OFF_RNK + 1 * MiB;
constexpr size_t OFF_TOKS = OFF_POS + 1 * MiB;
constexpr size_t OFF_WTS = OFF_TOKS + 1 * MiB;
constexpr size_t OFF_SSQ = OFF_WTS + 1 * MiB;
constexpr size_t OFF_SCR = OFF_SSQ + 4 * MiB;
constexpr size_t SCR_PER_BLK = 1536 * 1024;
constexpr size_t OFF_R = OFF_SCR + 384 * MiB;
constexpr size_t OFF_XT = OFF_R + 452 * MiB;
constexpr size_t WS_END = OFF_XT + 64 * MiB;
constexpr size_t OFF_PROJ = OFF_R;
constexpr size_t OFF_QB = OFF_PROJ + 144 * MiB;
constexpr size_t OFF_KVB = OFF_QB + 48 * MiB;
constexpr size_t OFF_BOUT = OFF_KVB + 64 * MiB;
constexpr size_t OFF_APARTS = OFF_BOUT + 32 * MiB;
constexpr size_t OFF_LSE = OFF_APARTS + 96 * MiB;
constexpr size_t OFF_MIX = OFF_LSE + 4 * MiB;
constexpr size_t OFF_Y = OFF_R;
constexpr size_t OFF_HDN = OFF_R + 288 * MiB;
static_assert(OFF_MIX + 64 * MiB <= WS_END, "alias map");
constexpr int CNT_WORD0 = 8192, CNT_STRIDE = 16;

constexpr int LDS_STAGE = 0;
constexpr int LDS_ROWOFF = 131072;
constexpr int LDS_ROWSC = LDS_ROWOFF + 8192;
constexpr int LDS_MISC = LDS_ROWSC + 8192;
constexpr int LDS_START = LDS_MISC + 256;
constexpr int LDS_CNT = LDS_START + 1280;
constexpr int LDS_BYTES = 155648;
static_assert(LDS_CNT + 1024 <= LDS_BYTES, "lds map");

#define XB_TMO      128
#define XB_XCNT(j)  (256  + 64 * (j))
#define XB_XSUB(j)  (1280 + 64 * (j))
#define XB_XGEN(j)  (2304 + 64 * (j))
#define XB_TOP      3328
#define XB_TOPGEN   3392
#define XCD_BAR_WORDS 3456
#define XB_SPIN_CAP (1u << 22)
#define LAS __attribute__((address_space(3)))

__device__ __forceinline__ unsigned xb_ld(unsigned* p)              { return __hip_atomic_load(p, __ATOMIC_RELAXED, __HIP_MEMORY_SCOPE_AGENT); }
__device__ __forceinline__ unsigned xb_add(unsigned* p, unsigned v) { return __hip_atomic_fetch_add(p, v, __ATOMIC_RELAXED, __HIP_MEMORY_SCOPE_AGENT); }
__device__ __forceinline__ unsigned xb_xcc_id() { return (unsigned)__builtin_amdgcn_s_getreg((3 << 11) | 20) & 0xFu; }
#define XB_SPIN(cond, bar) do { unsigned _sp = 0; while (cond) { __builtin_amdgcn_s_sleep(1); \
    if ((++_sp & 255u) == 0u) { if (xb_ld(&(bar)[XB_TMO])) break; if (_sp > XB_SPIN_CAP) { atomicAdd(&(bar)[XB_TMO], 1u); break; } } } } while (0)

struct XcdBarrier { unsigned* bar; unsigned x; volatile LAS unsigned* st; };

__device__ __forceinline__ XcdBarrier xcd_barrier_post(unsigned* bar, volatile LAS unsigned* st, const bool leader) {
    XcdBarrier b; b.bar = bar; b.x = xb_xcc_id(); b.st = st;
    if (leader) (void)xb_add(&bar[XB_XCNT(b.x)], 1u);
    return b;
}
__device__ __forceinline__ void xcd_barrier_complete(unsigned* bar, unsigned x, unsigned& nloc, unsigned& nx) {
    const unsigned G = gridDim.x * gridDim.y * gridDim.z;
    unsigned sum, cnt, mine, sp = 0u;
    for (;;) {
        sum = 0u; cnt = 0u; mine = 0u;
#pragma unroll
        for (unsigned j = 0; j < 16; ++j) { const unsigned c = xb_ld(&bar[XB_XCNT(j)]); sum += c; cnt += (c > 0u) ? 1u : 0u; mine = (j == x) ? c : mine; }
        if (sum == G) break;
        __builtin_amdgcn_s_sleep(1);
        if ((++sp & 255u) == 0u) { if (xb_ld(&bar[XB_TMO])) break; if (sp > XB_SPIN_CAP) { atomicAdd(&bar[XB_TMO], 1u); break; } }
    }
    nloc = mine > 0u ? mine : 1u; nx = cnt > 0u ? cnt : 1u;
}
__device__ __forceinline__ void xcd_barrier(const XcdBarrier& b, const bool leader) {
    asm volatile("s_waitcnt vmcnt(0)" ::: "memory");
    __syncthreads();
    if (leader) {
        unsigned* bar = b.bar;
        __builtin_amdgcn_s_waitcnt(0);
        unsigned nloc = b.st[0], nx = b.st[1];
        if (nloc == 0u) { xcd_barrier_complete(bar, b.x, nloc, nx); b.st[0] = nloc; b.st[1] = nx; }
        const unsigned old = xb_add(&bar[XB_XSUB(b.x)], 1u);
        const unsigned gen = old / nloc;
        if (old + 1u == (gen + 1u) * nloc) {
            __builtin_amdgcn_fence(__ATOMIC_RELEASE, "agent");
            asm volatile("s_waitcnt vmcnt(0)" ::: "memory");
            const unsigned og = xb_add(&bar[XB_TOP], 1u);
            const unsigned tg = og / nx;
            if (og + 1u == (tg + 1u) * nx) xb_add(&bar[XB_TOPGEN], 1u);
            else XB_SPIN(xb_ld(&bar[XB_TOPGEN]) == tg, bar);
            __builtin_amdgcn_fence(__ATOMIC_ACQUIRE, "agent");
            xb_add(&bar[XB_XGEN(b.x)], 1u);
            asm volatile("s_waitcnt vmcnt(0)" ::: "memory");
        } else {
            XB_SPIN(xb_ld(&bar[XB_XGEN(b.x)]) == gen, bar);
            __builtin_amdgcn_fence(__ATOMIC_ACQUIRE, "agent");
            asm volatile("s_waitcnt vmcnt(0)" ::: "memory");
        }
    }
    __syncthreads();
}

DEVI float bf2f(bf16_t v) { return __uint_as_float(((unsigned)v) << 16); }
typedef float f32x2_t __attribute__((ext_vector_type(2)));
typedef __bf16 bf16x2_t __attribute__((ext_vector_type(2)));
DEVI unsigned pk2(float lo, float hi) { f32x2_t v = {lo, hi}; bf16x2_t b = __builtin_convertvector(v, bf16x2_t); return __builtin_bit_cast(unsigned, b); }
#define dppf(v, ctrl) __int_as_float(__builtin_amdgcn_update_dpp(0, __float_as_int(v), (ctrl), 0xf, 0xf, false))
#define dppi(v, ctrl) __builtin_amdgcn_update_dpp(0, (v), (ctrl), 0xf, 0xf, false)
#define DPP_X1 0xB1
#define DPP_X2 0x4E
#define DPP_HM 0x141
#define DPP_RM 0x140
DEVI float x16f(float v, float& o) { auto r = __builtin_amdgcn_permlane16_swap(__float_as_uint(v), __float_as_uint(v), false, false); o = __uint_as_float(r[1]); return __uint_as_float(r[0]); }
DEVI float x32f(float v, float& o) { auto r = __builtin_amdgcn_permlane32_swap(__float_as_uint(v), __float_as_uint(v), false, false); o = __uint_as_float(r[1]); return __uint_as_float(r[0]); }
DEVI float sum32(float v) { float o; const float a = x32f(v, o); return a + o; }
DEVI float max32(float v) { float o; const float a = x32f(v, o); return fmaxf(a, o); }
DEVI float wave_sum(float v) {
    v += dppf(v, DPP_X1); v += dppf(v, DPP_X2); v += dppf(v, DPP_HM); v += dppf(v, DPP_RM);
    { float o; const float a = x16f(v, o); v = a + o; }
    { float o; const float a = x32f(v, o); v = a + o; }
    return v;
}
DEVI int perm_slot(int cl) { return 16 * ((cl >> 2) & 1) + 4 * (cl >> 3) + (cl & 3); }
DEVI int perm_row(int n) { return (n & ~31) + perm_slot(n & 31); }
DEVI float ex2(float x) { return __builtin_amdgcn_exp2f(x); }
DEVI float siluf(float v) { return v / (1.0f + __expf(-v)); }

namespace g8 {
constexpr int BK = 64, HALF = 128, HT = HALF * BK;
DEVI int lds_byte(int r, int c) { int st = (r >> 4) * 2 + (c >> 5), rr = r & 15, cc = c & 31, ob = rr * 64 + cc * 2; return st * 1024 + (ob ^ (((ob >> 9) & 1) << 5)); }
DEVI void stage_rc(int b, int& R, int& C) { int st = b / 1024, sb = b % 1024, swz = sb ^ (((sb >> 9) & 1) << 5); R = (st >> 1) * 16 + swz / 64; C = (st & 1) * 32 + (swz % 64) / 2; }
}

DEVI void g8_rc(int tid, int& R0, int& C0) { g8::stage_rc(tid * 16, R0, C0); }
DEVI void g8_voff_lin(unsigned (&v)[4], int ld, int tid) { int R0, C0; g8_rc(tid, R0, C0);
    v[0] = (unsigned)(R0 * ld + C0) * 2u; v[1] = (unsigned)((R0 + 64) * ld + C0) * 2u; v[2] = (unsigned)((R0 + 128) * ld + C0) * 2u; v[3] = (unsigned)((R0 + 192) * ld + C0) * 2u; }
DEVI void g8_voff_tab(unsigned (&v)[4], const LAS unsigned* tab, int tid) { int R0, C0; g8_rc(tid, R0, C0);
    v[0] = (tab[R0] + C0) * 2u; v[1] = (tab[R0 + 64] + C0) * 2u; v[2] = (tab[R0 + 128] + C0) * 2u; v[3] = (tab[R0 + 192] + C0) * 2u; }

template <class Epi>
DEVI void gemm_tile(LAS unsigned char* lds, const int tid_in, const char* Ab, const unsigned (&voffA_)[4], const char* Bb, const int K, const Epi& epi) {
    using namespace g8;
    constexpr int HTB = HALF * BK * 2;
    int tz = tid_in; asm volatile("" : "+v"(tz));
    int wid = tz >> 6, lane = tz & 63, wr = wid >> 2, wc = wid & 3, fr = lane & 15, fq = lane >> 4;
    unsigned voffA[4] = {voffA_[0], voffA_[1], voffA_[2], voffA_[3]};
    asm volatile("" : "+v"(voffA[0]), "+v"(voffA[1]), "+v"(voffA[2]), "+v"(voffA[3]));
    unsigned voffB[2];
    { int R0, C0; stage_rc(tz * 16, R0, C0); voffB[0] = (unsigned)(R0 * K + C0) * 2u; voffB[1] = (unsigned)((R0 + 64) * K + C0) * 2u; }
    const size_t kstep = (size_t)(BK * 2);
    const size_t hstepB = (size_t)HALF * K * 2;
    const unsigned ldsw = (unsigned)wid * 1024u;
    const int aoff = lds_byte(wr * 64 + fr, fq * 8), boff = lds_byte(wc * 32 + fr, fq * 8);
#define G8_SA(b, h) (((b) * 2 + (h)) * HTB)
#define G8_SB(b, h) ((4 + (b) * 2 + (h)) * HTB)
#define G8_GL(gp, lofs) __builtin_amdgcn_global_load_lds((const unsigned*)(gp), (LAS unsigned*)(lds + (lofs)), 16, 0, 0)
#define STAGE_A(b, h, kt) do { const char* g_ = Ab + (size_t)(kt) * kstep; G8_GL(g_ + voffA[(h) * 2], G8_SA(b, h) + ldsw); G8_GL(g_ + voffA[(h) * 2 + 1], G8_SA(b, h) + ldsw + 8192); } while (0)
#define STAGE_B(b, h, kt) do { const char* g_ = Bb + (size_t)(kt) * kstep + ((h) ? hstepB : 0); G8_GL(g_ + voffB[0], G8_SB(b, h) + ldsw); G8_GL(g_ + voffB[1], G8_SB(b, h) + ldsw + 8192); } while (0)
#define LDA(dst, b, h) do { _Pragma("unroll") for (int m = 0; m < 4; ++m) _Pragma("unroll") for (int k = 0; k < 2; ++k) dst[m][k] = *(const LAS bf16x8*)(lds + G8_SA(b, h) + aoff + m * 2048 + k * 1024); } while (0)
#define LDB(dst, b, h) do { _Pragma("unroll") for (int n = 0; n < 2; ++n) _Pragma("unroll") for (int k = 0; k < 2; ++k) dst[n][k] = *(const LAS bf16x8*)(lds + G8_SB(b, h) + boff + n * 2048 + k * 1024); } while (0)
#define MMA(ai, bj, Af, Bf) do { __builtin_amdgcn_s_setprio(1); \
    _Pragma("unroll") for (int m = 0; m < 4; ++m) _Pragma("unroll") for (int n = 0; n < 2; ++n) _Pragma("unroll") for (int k = 0; k < 2; ++k) \
      acc[ai][bj][m][n] = __builtin_amdgcn_mfma_f32_16x16x32_bf16(Bf[n][k], Af[m][k], acc[ai][bj][m][n], 0, 0, 0); \
    __builtin_amdgcn_s_setprio(0); } while (0)
#define WAIT_V(n) asm volatile("s_waitcnt vmcnt(" #n ")" ::: "memory")
#define WAIT_L(n) asm volatile("s_waitcnt lgkmcnt(" #n ")" ::: "memory")
#define BAR __builtin_amdgcn_s_barrier()
#define SCHED __builtin_amdgcn_sched_barrier(0)
    f32x4 acc[2][2][4][2];
#pragma unroll
    for (int a = 0; a < 2; ++a)
#pragma unroll
        for (int b = 0; b < 2; ++b)
#pragma unroll
            for (int m = 0; m < 4; ++m)
#pragma unroll
                for (int n = 0; n < 2; ++n) acc[a][b][m][n] = (f32x4){0.f, 0.f, 0.f, 0.f};
    bf16x8 At[4][2], B0[2][2], B1[2][2];
    const int nt = K / BK;
    STAGE_B(0, 0, 0); STAGE_A(0, 0, 0); STAGE_B(0, 1, 0); STAGE_A(0, 1, 0);
    if (wr == 1) BAR;
    WAIT_V(4); BAR;
    STAGE_B(1, 0, 1); STAGE_A(1, 0, 1); STAGE_B(1, 1, 1);
    WAIT_V(6); BAR;
#pragma unroll 1
    for (int t = 0; t < nt; t += 2) {
        const int t2 = (t == nt - 2) ? 0 : t + 2;
        const int t3 = t2 + 1;
        LDB(B0, 0, 0); SCHED; LDA(At, 0, 0); STAGE_A(1, 1, t + 1);
        WAIT_L(8); BAR; WAIT_L(0); MMA(0, 0, At, B0); BAR; SCHED;
        LDB(B1, 0, 1); STAGE_B(0, 0, t2);
        BAR; WAIT_L(0); MMA(0, 1, At, B1); BAR;
        LDA(At, 0, 1); STAGE_A(0, 0, t2);
        BAR; WAIT_L(0); MMA(1, 0, At, B0); BAR; SCHED;
        STAGE_B(0, 1, t2);
        WAIT_V(6); BAR; MMA(1, 1, At, B1); BAR;
        LDB(B0, 1, 0); SCHED; LDA(At, 1, 0); STAGE_A(0, 1, t2);
        WAIT_L(8); BAR; WAIT_L(0); MMA(0, 0, At, B0); BAR; SCHED;
        LDB(B1, 1, 1); STAGE_B(1, 0, t3);
        BAR; WAIT_L(0); MMA(0, 1, At, B1); BAR;
        LDA(At, 1, 1); STAGE_A(1, 0, t3);
        BAR; WAIT_L(0); MMA(1, 0, At, B0); BAR; SCHED;
        STAGE_B(1, 1, t3);
        WAIT_V(6); BAR; MMA(1, 1, At, B1); BAR;
    }
    WAIT_V(0);
    if (wr == 0) BAR;
    BAR;
    asm volatile("" : "+v"(tz)); wid = tz >> 6; lane = tz & 63; wr = wid >> 2; wc = wid & 3; fr = lane & 15; fq = lane >> 4;
    epi(acc, wr, wc, fr, fq);
#undef G8_SA
#undef G8_SB
#undef G8_GL
#undef STAGE_A
#undef STAGE_B
#undef LDA
#undef LDB
#undef MMA
}
struct GDesc { const char* Ab; const char* Bb; unsigned va0, va1, va2, va3; int i0, i1; };
template <class Next, class Epi>
DEVI void gemm_stream(LAS unsigned char* lds, const int tid_in, const int K, Next& next, const Epi& epi) {
    using namespace g8;
    constexpr int HTB = HALF * BK * 2;
    int tz = tid_in; asm volatile("" : "+v"(tz));
    int wid = tz >> 6, lane = tz & 63, wr = wid >> 2, wc = wid & 3, fr = lane & 15, fq = lane >> 4;
    unsigned voffB[2];
    { int R0, C0; stage_rc(tz * 16, R0, C0); voffB[0] = (unsigned)(R0 * K + C0) * 2u; voffB[1] = (unsigned)((R0 + 64) * K + C0) * 2u; }
    const size_t kstep = (size_t)(BK * 2);
    const size_t hstepB = (size_t)HALF * K * 2;
    const unsigned ldsw = (unsigned)wid * 1024u;
    const int aoff = lds_byte(wr * 64 + fr, fq * 8), boff = lds_byte(wc * 32 + fr, fq * 8);
#define G8_SA(b, h) (((b) * 2 + (h)) * HTB)
#define G8_SB(b, h) ((4 + (b) * 2 + (h)) * HTB)
#define G8_GL(gp, lofs) __builtin_amdgcn_global_load_lds((const unsigned*)(gp), (LAS unsigned*)(lds + (lofs)), 16, 0, 0)
#define STG_A(b, h, gb, v0, v1) do { G8_GL((gb) + (v0), G8_SA(b, h) + ldsw); G8_GL((gb) + (v1), G8_SA(b, h) + ldsw + 8192); } while (0)
#define STG_B(b, h, gb) do { const char* g_ = (gb) + ((h) ? hstepB : 0); G8_GL(g_ + voffB[0], G8_SB(b, h) + ldsw); G8_GL(g_ + voffB[1], G8_SB(b, h) + ldsw + 8192); } while (0)
#define LDA(dst, b, h) do { _Pragma("unroll") for (int m = 0; m < 4; ++m) _Pragma("unroll") for (int k = 0; k < 2; ++k) dst[m][k] = *(const LAS bf16x8*)(lds + G8_SA(b, h) + aoff + m * 2048 + k * 1024); } while (0)
#define LDB(dst, b, h) do { _Pragma("unroll") for (int n = 0; n < 2; ++n) _Pragma("unroll") for (int k = 0; k < 2; ++k) dst[n][k] = *(const LAS bf16x8*)(lds + G8_SB(b, h) + boff + n * 2048 + k * 1024); } while (0)
#define MMA(ai, bj, Af, Bf) do { __builtin_amdgcn_s_setprio(1); \
    _Pragma("unroll") for (int m = 0; m < 4; ++m) _Pragma("unroll") for (int n = 0; n < 2; ++n) _Pragma("unroll") for (int k = 0; k < 2; ++k) \
      acc[ai][bj][m][n] = __builtin_amdgcn_mfma_f32_16x16x32_bf16(Bf[n][k], Af[m][k], acc[ai][bj][m][n], 0, 0, 0); \
    __builtin_amdgcn_s_setprio(0); } while (0)
#define ZACC() do { _Pragma("unroll") for (int a = 0; a < 2; ++a) _Pragma("unroll") for (int b = 0; b < 2; ++b) _Pragma("unroll") for (int m = 0; m < 4; ++m) _Pragma("unroll") for (int n = 0; n < 2; ++n) acc[a][b][m][n] = (f32x4){0.f, 0.f, 0.f, 0.f}; } while (0)
    GDesc cur, nxt;
    if (!next(0, cur)) return;
    nxt = cur;
    f32x4 acc[2][2][4][2];
    ZACC();
    bf16x8 At[4][2], B0[2][2], B1[2][2];
    const int nt = K / BK;
    STG_B(0, 0, cur.Bb); STG_A(0, 0, cur.Ab, cur.va0, cur.va1); STG_B(0, 1, cur.Bb); STG_A(0, 1, cur.Ab, cur.va2, cur.va3);
    if (wr == 1) BAR;
    WAIT_V(4); BAR;
    STG_B(1, 0, cur.Bb + kstep); STG_A(1, 0, cur.Ab + kstep, cur.va0, cur.va1); STG_B(1, 1, cur.Bb + kstep);
    WAIT_V(6); BAR;
    int ui = 0; bool has_next = false;
#pragma unroll 1
    for (;;) {
#pragma unroll 1
        for (int t = 0; t < nt; t += 2) {
            const bool last = (t == nt - 2);
            if (last) { has_next = next(ui + 1, nxt); if (!has_next) nxt = cur; }
            const char* a2 = last ? nxt.Ab : cur.Ab + (size_t)(t + 2) * kstep;
            const char* b2 = last ? nxt.Bb : cur.Bb + (size_t)(t + 2) * kstep;
            const unsigned s0 = last ? nxt.va0 : cur.va0, s1 = last ? nxt.va1 : cur.va1, s2 = last ? nxt.va2 : cur.va2, s3 = last ? nxt.va3 : cur.va3;
            LDB(B0, 0, 0); SCHED; LDA(At, 0, 0); STG_A(1, 1, cur.Ab + (size_t)(t + 1) * kstep, cur.va2, cur.va3);
            WAIT_L(8); BAR; WAIT_L(0); MMA(0, 0, At, B0); BAR; SCHED;
            LDB(B1, 0, 1); STG_B(0, 0, b2);
            BAR; WAIT_L(0); MMA(0, 1, At, B1); BAR;
            LDA(At, 0, 1); STG_A(0, 0, a2, s0, s1);
            BAR; WAIT_L(0); MMA(1, 0, At, B0); BAR; SCHED;
            STG_B(0, 1, b2);
            WAIT_V(6); BAR; MMA(1, 1, At, B1); BAR;
            LDB(B0, 1, 0); SCHED; LDA(At, 1, 0); STG_A(0, 1, a2, s2, s3);
            WAIT_L(8); BAR; WAIT_L(0); MMA(0, 0, At, B0); BAR; SCHED;
            LDB(B1, 1, 1); STG_B(1, 0, b2 + kstep);
            BAR; WAIT_L(0); MMA(0, 1, At, B1); BAR;
            LDA(At, 1, 1); STG_A(1, 0, a2 + kstep, s0, s1);
            BAR; WAIT_L(0); MMA(1, 0, At, B0); BAR; SCHED;
            STG_B(1, 1, b2 + kstep);
            WAIT_V(6); BAR; MMA(1, 1, At, B1); BAR;
        }
        {
            int tq = tz; asm volatile("" : "+v"(tq));
            const int wid_ = tq >> 6, lane_ = tq & 63;
            epi(acc, cur, wid_ >> 2, wid_ & 3, lane_ & 15, lane_ >> 4);
        }
        if (!has_next) break;
        ZACC();
        cur = nxt; ++ui;
    }
    WAIT_V(0);
    if (wr == 0) BAR;
    BAR;
#undef G8_SA
#undef G8_SB
#undef G8_GL
#undef STG_A
#undef STG_B
#undef LDA
#undef LDB
#undef MMA
#undef ZACC
}
#define EPI_FOREACH8(acc, wr, wc, fr, fq, ROW, COL8, V0, V1, ...) \
    _Pragma("unroll") for (int ai_ = 0; ai_ < 2; ++ai_) _Pragma("unroll") for (int m_ = 0; m_ < 4; ++m_) { const int ROW = ai_ * 128 + (wr) * 64 + m_ * 16 + (fr); \
    _Pragma("unroll") for (int bj_ = 0; bj_ < 2; ++bj_) { const int COL8 = bj_ * 128 + (wc) * 32 + (fq) * 8; const f32x4 V0 = acc[ai_][bj_][m_][0]; const f32x4 V1 = acc[ai_][bj_][m_][1]; __VA_ARGS__ } }
#define PK8(w, a, b) do { w.x = pk2(a[0], a[1]); w.y = pk2(a[2], a[3]); w.z = pk2(b[0], b[1]); w.w = pk2(b[2], b[3]); } while (0)

template <class SCol, class DRow, class KS, class NS>
DEVI void convert_T(bf16_t* __restrict__ dst, const float* __restrict__ src, int ld, int K, int NR, SCol scol, DRow drow, KS ks, NS ns, int wi, int nw) {
    const int k8n = K >> 3; const int items = NR * k8n;
    for (int it = wi; it < items; it += nw) {
        const int n = it % NR, k0 = (it / NR) << 3;
        const int sc = scol(n);
        float v[8];
#pragma unroll
        for (int j = 0; j < 8; ++j) v[j] = (sc >= 0) ? src[(size_t)(k0 + j) * ld + sc] * ks(k0 + j) : 0.f;
        const float s = ns(n);
        u32x4 w; w.x = pk2(v[0] * s, v[1] * s); w.y = pk2(v[2] * s, v[3] * s); w.z = pk2(v[4] * s, v[5] * s); w.w = pk2(v[6] * s, v[7] * s);
        *(u32x4*)(dst + (size_t)drow(n) * K + k0) = w;
    }
}
struct IdCol { DEVI int operator()(int n) const { return n; } };
struct OneK { DEVI float operator()(int) const { return 1.f; } };
struct VecK { const float* g; DEVI float operator()(int k) const { return g[k]; } };

template <int NB, bool PERM>
DEVI void convert_panel(bf16_t* __restrict__ dst, const float* __restrict__ src, const int ld, const int K, const int tid) {
    constexpr int N4 = NB / 4;
    const int items = (K >> 3) * N4;
#pragma unroll 1
    for (int it0 = tid; it0 < items; it0 += 1024) {
        f32x4 v[2][8];
#pragma unroll
        for (int u = 0; u < 2; ++u) {
            const int it = it0 + u * 512; const int n4 = it % N4, k8 = it / N4;
            const float* sp = src + (size_t)(k8 * 8) * ld + n4 * 4;
#pragma unroll
            for (int j = 0; j < 8; ++j) v[u][j] = *(const f32x4*)(sp + (size_t)j * ld);
        }
#pragma unroll
        for (int u = 0; u < 2; ++u) {
            const int it = it0 + u * 512; const int n4 = it % N4, k8 = it / N4;
#pragma unroll
            for (int c = 0; c < 4; ++c) {
                u32x4 w; w.x = pk2(v[u][0][c], v[u][1][c]); w.y = pk2(v[u][2][c], v[u][3][c]); w.z = pk2(v[u][4][c], v[u][5][c]); w.w = pk2(v[u][6][c], v[u][7][c]);
                const int n = n4 * 4 + c; const int dr = PERM ? ((n & ~31) + perm_slot(n & 31)) : n;
                *(u32x4*)(dst + (size_t)dr * K + k8 * 8) = w;
            }
        }
    }
}

template <int NB, bool PERM>
DEVI void convert_panel_lds(bf16_t* __restrict__ dst, const float* __restrict__ src, const int ld, const int K, const int tid, LAS unsigned char* lds) {
    constexpr int N4 = NB / 4;
    constexpr int K8C = 512 / N4;
    constexpr int KC = K8C * 8;
    constexpr int PITCH = KC * 2 + 8;
    constexpr int PPR = KC / 8;
    const int n4 = tid % N4, k8 = tid / N4;
    const float* sp = src + (size_t)(k8 * 8) * ld + n4 * 4;
    const int nchunk = K / KC;
    f32x4 va[8], vb[8], vc[8];
#define CPL_LOAD(V, c) do { const float* q_ = sp + (size_t)(c) * KC * ld; _Pragma("unroll") for (int j = 0; j < 8; ++j) V[j] = *(const f32x4*)(q_ + (size_t)j * ld); } while (0)
#define CPL_PROC(V, c) do { \
        _Pragma("unroll") for (int cc = 0; cc < 4; ++cc) { \
            u32x2 lo, hi; lo.x = pk2(V[0][cc], V[1][cc]); lo.y = pk2(V[2][cc], V[3][cc]); hi.x = pk2(V[4][cc], V[5][cc]); hi.y = pk2(V[6][cc], V[7][cc]); \
            LAS unsigned char* wp = lds + (n4 * 4 + cc) * PITCH + k8 * 16; \
            *(LAS u32x2*)wp = lo; *(LAS u32x2*)(wp + 8) = hi; } \
        __syncthreads(); \
        _Pragma("unroll") for (int q = 0; q < 4; ++q) { \
            const int p = tid + 512 * q; const int row = p / PPR, pc = p % PPR; \
            const LAS unsigned char* rp = lds + row * PITCH + pc * 16; \
            const u32x2 a = *(const LAS u32x2*)rp, b = *(const LAS u32x2*)(rp + 8); \
            const int dr = PERM ? ((row & ~31) + perm_slot(row & 31)) : row; \
            u32x4 w; w.x = a.x; w.y = a.y; w.z = b.x; w.w = b.y; \
            *(u32x4*)(dst + (size_t)dr * K + (c) * KC + pc * 8) = w; } \
        __syncthreads(); } while (0)
    CPL_LOAD(va, 0); if (nchunk > 1) CPL_LOAD(vb, 1); if (nchunk > 2) CPL_LOAD(vc, 2);
#pragma unroll 1
    for (int c = 0; c < nchunk; c += 3) {
        CPL_PROC(va, c); if (c + 3 < nchunk) CPL_LOAD(va, c + 3);
        if (c + 1 < nchunk) { CPL_PROC(vb, c + 1); if (c + 4 < nchunk) CPL_LOAD(vb, c + 4); }
        if (c + 2 < nchunk) { CPL_PROC(vc, c + 2); if (c + 5 < nchunk) CPL_LOAD(vc, c + 5); }
    }
#undef CPL_LOAD
#undef CPL_PROC
}

struct Params {
    const float* in[24];
    float* out;
    unsigned char* ws;
    int ph_lo, ph_hi;
    int flags, pad;
};
enum { I_X = 0, I_C, I_WADA, I_BADA, I_N1G, I_WIN, I_QNG, I_WUQ, I_KVNG, I_WUKV, I_REL, I_AOG, I_BOG, I_WO, I_N2G, I_WR, I_EB, I_W1, I_W3, I_W2, I_WS1, I_WS3, I_WS2, I_FG };
constexpr int NPHASE = 15;

#define W_x (P.in[I_X])
#define W_mod ((float*)(ws + OFF_MOD))
#define W_ropecs ((float*)(ws + OFF_ROPE))
#define W_biasT ((float*)(ws + OFF_BIAS))
#define W_WinT ((bf16_t*)(ws + OFF_WIN))
#define W_WuqT ((bf16_t*)(ws + OFF_WUQ))
#define W_WukvT ((bf16_t*)(ws + OFF_WUKV))
#define W_WoT ((bf16_t*)(ws + OFF_WO))
#define W_WrT ((bf16_t*)(ws + OFF_WR))
#define W_Ws13T ((bf16_t*)(ws + OFF_WS13))
#define W_Ws2T ((bf16_t*)(ws + OFF_WS2))
#define W_hbuf ((bf16_t*)(ws + OFF_H))
#define W_logits ((float*)(ws + OFF_LOGITS))
#define W_eidx ((int*)(ws + OFF_EIDX))
#define W_gate ((float*)(ws + OFF_GATE))
#define W_rnk ((int*)(ws + OFF_RNK))
#define W_pos ((int*)(ws + OFF_POS))
#define W_toks ((int*)(ws + OFF_TOKS))
#define W_wts ((float*)(ws + OFF_WTS))
#define W_ssq ((float*)(ws + OFF_SSQ))
#define W_scr ((bf16_t*)(ws + OFF_SCR + (size_t)blk * SCR_PER_BLK))
#define W_hdn ((bf16_t*)(ws + OFF_HDN))
#define W_ybuf ((bf16_t*)(ws + OFF_Y))
#define W_y8 ((unsigned char*)(ws + OFF_Y))
#define W_proj ((bf16_t*)(ws + OFF_PROJ))
#define W_qb ((bf16_t*)(ws + OFF_QB))
#define W_kvb ((bf16_t*)(ws + OFF_KVB))
#define W_bout ((bf16_t*)(ws + OFF_BOUT))
#define W_aparts ((bf16_t*)(ws + OFF_APARTS))
#define W_lsebuf ((float*)(ws + OFF_LSE))
#define W_mixb ((bf16_t*)(ws + OFF_MIX))
#define W_xt ((bf16_t*)(ws + OFF_XT))

__global__ void __launch_bounds__(512, 2) fwd_kernel(Params P) {
    extern __shared__ __attribute__((aligned(16))) unsigned char lds[];
    const int blk = blockIdx.x, G = gridDim.x;
    const int wave_s = __builtin_amdgcn_readfirstlane((int)threadIdx.x >> 6);
#define TIDS0 int tid; asm volatile("v_mbcnt_lo_u32_b32 %0, -1, 0\n\tv_mbcnt_hi_u32_b32 %0, -1, %0" : "=v"(tid)); tid += wave_s * 64;
    const int vblk = (G % 8 == 0) ? (blk % 8) * (G / 8) + blk / 8 : blk;
    unsigned char* ws = P.ws;
    unsigned* ctl = (unsigned*)(ws + OFF_CTL);
    { TIDS0 if (tid < 64) ((LAS unsigned*)(lds + LDS_MISC))[tid] = 0u; }
    __syncthreads();
    XcdBarrier bar; bar.bar = ctl; bar.x = 0; bar.st = nullptr;
    if (MK_N_LAUNCHES == 1) { TIDS0 bar = xcd_barrier_post(ctl, (volatile LAS unsigned*)(lds + LDS_MISC), tid == 0); }
#ifndef PH_MASK
#define PH_MASK 0xffffffffu
#endif
#define TIDS int tid; asm volatile("v_mbcnt_lo_u32_b32 %0, -1, 0\n\tv_mbcnt_hi_u32_b32 %0, -1, %0" : "=v"(tid)); tid += wave_s * 64; const int lane = tid & 63; const int wave = wave_s; (void)lane; (void)wave;
#define IN(k) ((((PH_MASK) >> (k)) & 1u) && P.ph_lo <= (k) && (k) < P.ph_hi)
#define SEAM(k) do { if (MK_N_LAUNCHES == 1 && IN(k) && IN((k) + 1)) { TIDS0 xcd_barrier(bar, tid == 0); } } while (0)

    unsigned* cntg = ctl + CNT_WORD0;
    LAS unsigned* rowoff = (LAS unsigned*)(lds + LDS_ROWOFF);
    LAS float* rowsc = (LAS float*)(lds + LDS_ROWSC);
    LAS int* startL = (LAS int*)(lds + LDS_START);
    LAS int* cntL = (LAS int*)(lds + LDS_CNT);
    char* stage = (char*)lds + LDS_STAGE;
    LAS unsigned char* ldsL = (LAS unsigned char*)lds;

    if (IN(0)) {
        TIDS
        {
            float* sc = (float*)(lds);
            float* red = (float*)(lds + 32768);
            const float* c = P.in[I_C];
            for (int i = tid; i < 8192; i += 512) sc[i] = siluf(c[i]);
            __syncthreads();
            for (int cb = blk; cb < 256; cb += G) {
                const int cj = tid & 31, kg = tid >> 5;
                float a0 = 0, a1 = 0, a2 = 0, a3 = 0, a4 = 0, a5 = 0, a6 = 0, a7 = 0;
                if (cj < 24) {
                    const float* w = P.in[I_WADA] + cb * 24 + cj;
                    for (int k = kg * 64; k < kg * 64 + 64; ++k) {
                        const float wv = w[(size_t)k * 6144];
                        a0 += sc[k] * wv; a1 += sc[1024 + k] * wv; a2 += sc[2048 + k] * wv; a3 += sc[3072 + k] * wv;
                        a4 += sc[4096 + k] * wv; a5 += sc[5120 + k] * wv; a6 += sc[6144 + k] * wv; a7 += sc[7168 + k] * wv;
                    }
                }
                float* rp = red + (kg * 8) * 32 + cj;
                rp[0] = a0; rp[32] = a1; rp[64] = a2; rp[96] = a3; rp[128] = a4; rp[160] = a5; rp[192] = a6; rp[224] = a7;
                __syncthreads();
                if (tid < 256) {
                    const int b = tid >> 5, j = tid & 31;
                    if (j < 24) {
                        float s = 0.f;
                        for (int g = 0; g < 16; ++g) s += red[(g * 8 + b) * 32 + j];
                        const int col = cb * 24 + j;
                        W_mod[b * 6144 + col] = s + P.in[I_BADA][col];
                    }
                }
                __syncthreads();
            }
        }
        {
            for (int idx = blk * 512 + tid; idx < 4096 * 16; idx += G * 512) {
                const int s = idx >> 4, i = idx & 15;
                double inv = 1.0; for (int j = 0; j < i; ++j) inv *= 0.5623413251903491;
                const float invf = (float)inv;
                const float angf = (float)s * invf;
                const double xa = (double)angf;
                const double nrev = __builtin_rint(xa * 0.15915494309189535);
                const double r = xa - nrev * 6.283185307179586;
                const double r2 = r * r;
                double ts = r, ss = r, tc = 1.0, cc = 1.0;
#pragma unroll
                for (int n = 1; n <= 14; ++n) {
                    ts *= -r2 / (double)((2 * n) * (2 * n + 1)); ss += ts;
                    tc *= -r2 / (double)((2 * n - 1) * (2 * n)); cc += tc;
                }
                W_ropecs[idx * 2] = (float)cc; W_ropecs[idx * 2 + 1] = (float)ss;
            }
        }
        {
            for (int idx = blk * 512 + tid; idx < 3 * 8 * 129; idx += G * 512) {
                const int j = idx % 129, hh = (idx / 129) % 8, p = idx / (129 * 8);
                const int dil = (p == 0) ? 1 : (p == 1 ? 4 : 16);
                const int rel = (j - 64) * dil;
                const int n = rel < 0 ? -rel : rel;
                const float nf = (float)(n > 1 ? n : 1);
                int large = 8 + (int)(__logf(nf * 0.125f) / 4.852030263919617f * 8.0f);
                large = large < 15 ? large : 15;
                const int bucket = (rel > 0 ? 16 : 0) + (n < 8 ? n : large);
                W_biasT[idx] = P.in[I_REL][bucket * 8 + hh] * LOG2E;
            }
        }
        {
            const int wi = blk * 512 + tid, nw = G * 512;
            convert_T(W_WinT, P.in[I_WIN], INC, 1024, INCP,
                      [](int n) { if (n >= INC) return -1; if (n < 2176) return n; const int i = n - 2176; return 2176 + ((i & 1) ? 16 : 0) + (i >> 1); },
                      [](int n) { return perm_row(n); }, OneK{}, [](int n) { return n < 512 ? 0.125f * LOG2E : 1.0f; }, wi, nw);
            convert_T(W_WuqT, P.in[I_WUQ], 768, 384, 768,
                      [](int n) { if (n < 512) return (n >> 6) * 96 + (n & 63); const int hh = (n - 512) >> 5, i = n & 31; return hh * 96 + 64 + ((i & 1) ? 16 : 0) + (i >> 1); },
                      [](int n) { return perm_row(n); }, VecK{P.in[I_QNG]}, [](int) { return 0.10206207261596577f * LOG2E; }, wi, nw);
            convert_T(W_WukvT, P.in[I_WUKV], 1024, 256, 1024, IdCol{}, [](int n) { return perm_row(n); }, VecK{P.in[I_KVNG]}, [](int) { return 1.f; }, wi, nw);
            {
                const float* ag = P.in[I_AOG]; const float* bg = P.in[I_BOG];
                convert_T(W_WoT, P.in[I_WO], 1024, 1024, 1024, IdCol{}, [](int n) { return perm_row(n); }, [=](int k) { return k < 512 ? ag[k] : bg[k - 512]; }, [](int) { return 1.f; }, wi, nw);
            }
            convert_T(W_WrT, P.in[I_WR], 256, 1024, 256, IdCol{}, [](int n) { return perm_row(n); }, OneK{}, [](int) { return 1.f; }, wi, nw);
            convert_T(W_Ws13T, P.in[I_WS1], 256, 1024, 256, IdCol{}, [](int n) { return perm_row((n >> 7) * 256 + (n & 127)); }, OneK{}, [](int) { return 1.f; }, wi, nw);
            convert_T(W_Ws13T, P.in[I_WS3], 256, 1024, 256, IdCol{}, [](int n) { return perm_row((n >> 7) * 256 + 128 + (n & 127)); }, OneK{}, [](int) { return 1.f; }, wi, nw);
            convert_T(W_Ws2T, P.in[I_WS2], 1024, 256, 1024, IdCol{}, [](int n) { return perm_row(n); }, OneK{}, [](int) { return 1.f; }, wi, nw);
        }
    }
    SEAM(0);

    if (IN(1)) {
        TIDS
        const float* g = P.in[I_N1G];
        for (int row = blk * 8 + wave; row < NTOK; row += G * 8) {
            const int b = row >> 12;
            const float* xr = W_x + (size_t)row * DM;
            f32x4 v[4]; float ss = 0.f;
#pragma unroll
            for (int i = 0; i < 4; ++i) { v[i] = *(const f32x4*)(xr + i * 256 + lane * 4); ss += v[i][0] * v[i][0] + v[i][1] * v[i][1] + v[i][2] * v[i][2] + v[i][3] * v[i][3]; }
            ss = wave_sum(ss);
            const float rinv = rsqrtf(ss * (1.0f / 1024.0f) + EPS);
            const float* mb = W_mod + b * 6144;
#pragma unroll
            for (int i = 0; i < 4; ++i) {
                const int c = i * 256 + lane * 4;
                const f32x4 gg = *(const f32x4*)(g + c), sh = *(const f32x4*)(mb + c), sc = *(const f32x4*)(mb + 1024 + c);
                float o[4];
#pragma unroll
                for (int j = 0; j < 4; ++j) o[j] = v[i][j] * rinv * gg[j] * (1.0f + sc[j]) + sh[j];
                u32x2 w; w.x = pk2(o[0], o[1]); w.y = pk2(o[2], o[3]);
                *(u32x2*)(W_hbuf + (size_t)row * DM + c) = w;
            }
        }
    }
    SEAM(1);

    if (IN(2)) {
        TIDS
        unsigned vl_[4]; g8_voff_lin(vl_, DM, tid);
        auto nextf = [&](int i, GDesc& d) {
            const int ul = i * 32 + (vblk & 31); if (ul >= 144 || vblk >= 256) return false;
            const int pm = (vblk >> 5) * 16 + ul / 9, pn = ul % 9;
            d.Ab = (const char*)(W_hbuf + (size_t)pm * 256 * DM); d.Bb = (const char*)(W_WinT + (size_t)pn * 256 * DM);
            d.va0 = vl_[0]; d.va1 = vl_[1]; d.va2 = vl_[2]; d.va3 = vl_[3]; d.i0 = pm; d.i1 = pn; return true;
        };
        auto epi = [&](const f32x4 (&acc)[2][2][4][2], const GDesc& d, int wr, int wc, int fr, int fq) {
            const int pm = d.i0, pn = d.i1;
            if (pn < 8) {
                EPI_FOREACH8(acc, wr, wc, fr, fq, r, c8, v0, v1, {
                    u32x4 w; PK8(w, v0, v1);
                    *(u32x4*)(W_proj + (size_t)(pm * 256 + r) * INCP + pn * 256 + c8) = w;
                })
            } else {
                EPI_FOREACH8(acc, wr, wc, fr, fq, r, c8, v0, v1, {
                    const int row = pm * 256 + r;
                    if (c8 < 160) {
                        f32x4 o0 = v0, o1 = v1;
                        if (c8 >= 128) {
                            const int i = (c8 - 128) >> 1; const int s = row & 4095;
                            const f32x4 ca = *(const f32x4*)(W_ropecs + (s * 16 + i) * 2), cb = *(const f32x4*)(W_ropecs + (s * 16 + i) * 2 + 4);
                            o0[0] = v0[0] * ca[0] - v0[1] * ca[1]; o0[1] = v0[1] * ca[0] + v0[0] * ca[1];
                            o0[2] = v0[2] * ca[2] - v0[3] * ca[3]; o0[3] = v0[3] * ca[2] + v0[2] * ca[3];
                            o1[0] = v1[0] * cb[0] - v1[1] * cb[1]; o1[1] = v1[1] * cb[0] + v1[0] * cb[1];
                            o1[2] = v1[2] * cb[2] - v1[3] * cb[3]; o1[3] = v1[3] * cb[2] + v1[2] * cb[3];
                        }
                        u32x4 w; PK8(w, o0, o1);
                        *(u32x4*)(W_proj + (size_t)row * INCP + 2048 + c8) = w;
                    }
                })
            }
            if (pn >= 6) {
#pragma unroll
                for (int ai = 0; ai < 2; ++ai)
#pragma unroll
                    for (int m = 0; m < 4; ++m)
#pragma unroll
                        for (int bj = 0; bj < 2; ++bj) {
                            const f32x4 a = acc[ai][bj][m][0], b = acc[ai][bj][m][1];
                            float ss = a[0] * a[0] + a[1] * a[1] + a[2] * a[2] + a[3] * a[3] + b[0] * b[0] + b[1] * b[1] + b[2] * b[2] + b[3] * b[3];
                            { float o; const float t = x16f(ss, o); ss = t + o; }
                            { float o; const float t = x32f(ss, o); ss = t + o; }
                            if (fq == 0) W_ssq[(size_t)(pm * 256 + ai * 128 + wr * 64 + m * 16 + fr) * 24 + (pn - 6) * 8 + bj * 4 + wc] = ss;
                        }
            }
        };
        gemm_stream(ldsL, tid, DM, nextf, epi);
        if ((vblk & 31) >= 16) {
            TIDS
#pragma unroll 1
            for (int q = 0; q < 2; ++q) {
                const int uu = blk + q * G;
                const int e = (G == 256) ? ((vblk & ~3) + q) : (uu >> 2), pn = (G == 256) ? (vblk & 3) : (uu & 3);
                __syncthreads();
                if (uu < 1024) convert_panel_lds<256, true>(W_scr + (size_t)2 * 256 * 1024 + (size_t)q * 256 * 256, P.in[I_W2] + (size_t)e * 256 * 1024 + pn * 256, 1024, 256, tid, ldsL);
            }
        }
    }
    SEAM(2);

    if (IN(3)) {
        {
            TIDS
            const int xb = (vblk >> 5) * 16, lb = vblk & 31;
            __syncthreads();
            for (int j = 0; j < 2; ++j) { const int ul = j * 32 + lb; if (ul < 48 && tid < 256) {
                const float* sp = W_ssq + (size_t)((xb + ul / 3) * 256 + tid) * 24;
                const f32x4 s0 = *(const f32x4*)sp, s1 = *(const f32x4*)(sp + 4), s2 = *(const f32x4*)(sp + 8);
                const float ss = ((s0[0] + s0[1]) + (s0[2] + s0[3])) + ((s1[0] + s1[1]) + (s1[2] + s1[3])) + ((s2[0] + s2[1]) + (s2[2] + s2[3]));
                rowsc[j * 256 + tid] = rsqrtf(ss * (1.0f / 384.0f) + EPS); } }
            __syncthreads();
            unsigned vl_[4]; g8_voff_lin(vl_, INCP, tid);
            auto nextf = [&](int i, GDesc& d) {
                const int ul = i * 32 + lb; if (ul >= 48 || vblk >= 256) return false;
                const int pm = xb + ul / 3, pn = ul % 3;
                d.Ab = (const char*)(W_proj + (size_t)pm * 256 * INCP + 1536); d.Bb = (const char*)(W_WuqT + (size_t)pn * 256 * QLORA);
                d.va0 = vl_[0]; d.va1 = vl_[1]; d.va2 = vl_[2]; d.va3 = vl_[3]; d.i0 = pm * 4 + pn; d.i1 = i; return true;
            };
            auto epi = [&](const f32x4 (&acc)[2][2][4][2], const GDesc& d, int wr, int wc, int fr, int fq) {
                const int pm = d.i0 >> 2, pn = d.i0 & 3, sl = d.i1 * 256;
                if (pn < 2) {
                    EPI_FOREACH8(acc, wr, wc, fr, fq, r, c8, v0, v1, {
                        const float rs = rowsc[sl + r];
                        const f32x4 a = v0 * rs, b = v1 * rs;
                        u32x4 w; PK8(w, a, b);
                        *(u32x4*)(W_qb + (size_t)(pm * 256 + r) * 768 + pn * 256 + c8) = w;
                    })
                } else {
                    EPI_FOREACH8(acc, wr, wc, fr, fq, r, c8, v0, v1, {
                        const int row = pm * 256 + r;
                        const float rs = rowsc[sl + r];
                        const int i = (c8 & 31) >> 1; const int s = row & 4095;
                        const f32x4 ca = *(const f32x4*)(W_ropecs + (s * 16 + i) * 2), cb = *(const f32x4*)(W_ropecs + (s * 16 + i) * 2 + 4);
                        const f32x4 t0 = v0 * rs, t1 = v1 * rs;
                        f32x4 o0, o1;
                        o0[0] = t0[0] * ca[0] - t0[1] * ca[1]; o0[1] = t0[1] * ca[0] + t0[0] * ca[1];
                        o0[2] = t0[2] * ca[2] - t0[3] * ca[3]; o0[3] = t0[3] * ca[2] + t0[2] * ca[3];
                        o1[0] = t1[0] * cb[0] - t1[1] * cb[1]; o1[1] = t1[1] * cb[0] + t1[0] * cb[1];
                        o1[2] = t1[2] * cb[2] - t1[3] * cb[3]; o1[3] = t1[3] * cb[2] + t1[2] * cb[3];
                        u32x4 w; PK8(w, o0, o1);
                        *(u32x4*)(W_qb + (size_t)row * 768 + 512 + c8) = w;
                    })
                }
            };
            gemm_stream(ldsL, tid, QLORA, nextf, epi);
        }
        {
            TIDS
            const int xb = (vblk >> 5) * 16, lb = vblk & 31;
            __syncthreads();
            for (int j = 0; j < 2; ++j) { const int ul = j * 32 + lb; if (tid < 256) {
                const float* sp = W_ssq + (size_t)((xb + ul / 4) * 256 + tid) * 24 + 12;
                const f32x4 s0 = *(const f32x4*)sp, s1 = *(const f32x4*)(sp + 4);
                const float ss = ((s0[0] + s0[1]) + (s0[2] + s0[3])) + ((s1[0] + s1[1]) + (s1[2] + s1[3]));
                rowsc[j * 256 + tid] = rsqrtf(ss * (1.0f / 256.0f) + EPS); } }
            __syncthreads();
            unsigned vl_[4]; g8_voff_lin(vl_, INCP, tid);
            auto nextf = [&](int i, GDesc& d) {
                const int ul = i * 32 + lb; if (ul >= 64 || vblk >= 256) return false;
                const int pm = xb + ul / 4, pn = ul % 4;
                d.Ab = (const char*)(W_proj + (size_t)pm * 256 * INCP + 1920); d.Bb = (const char*)(W_WukvT + (size_t)pn * 256 * KVLORA);
                d.va0 = vl_[0]; d.va1 = vl_[1]; d.va2 = vl_[2]; d.va3 = vl_[3]; d.i0 = pm * 4 + pn; d.i1 = i; return true;
            };
            auto epi = [&](const f32x4 (&acc)[2][2][4][2], const GDesc& d, int wr, int wc, int fr, int fq) {
                const int pm = d.i0 >> 2, pn = d.i0 & 3, sl = d.i1 * 256;
                EPI_FOREACH8(acc, wr, wc, fr, fq, r, c8, v0, v1, {
                    const float rs = rowsc[sl + r];
                    const f32x4 a = v0 * rs, b = v1 * rs;
                    u32x4 w; PK8(w, a, b);
                    *(u32x4*)(W_kvb + (size_t)(pm * 256 + r) * 1024 + pn * 256 + c8) = w;
                })
            };
            gemm_stream(ldsL, tid, KVLORA, nextf, epi);
        }
    }
    SEAM(3);

    if (IN(4)) {
        for (int ui = 0; ui < ((P.flags & 4) ? 0 : 4); ++ui) {
            TIDS
            const int r32 = lane & 31, hh = lane >> 5;
            if (vblk >= 256) break;
            const int qblk = vblk & 15, bh = (vblk >> 5) * 8 + ui * 2 + ((vblk >> 4) & 1), h = bh & 7, b = bh >> 3;
            const size_t tok0 = (size_t)b * SEQ;
            bf16x8 qf[6];
            {
                const size_t tq = tok0 + qblk * 256 + wave * 32 + r32;
#pragma unroll
                for (int d0 = 0; d0 < 6; ++d0) qf[d0] = *(const bf16x8*)(W_qb + tq * 768 + (d0 < 4 ? h * 64 + d0 * 16 : 512 + h * 32 + (d0 - 4) * 16) + hh * 8);
            }
            f32x16 o0 = {}, o1 = {};
            f32x16 mneg = {};
            float m_run = 0.f, l_run = 0.f;
            const int skey = tid >> 3, sch = tid & 7;
            const bf16_t* kn_src = W_kvb + (tok0 + skey) * 1024 + h * 128 + sch * 8;
            const int pkey = tid >> 2, pch = tid & 3;
            const bf16_t* kp_src = W_proj + (tok0 + pkey) * INCP + 2176 + pch * 8;
            constexpr int KBUF = 12 * 2048, VBUF = 2 * 8192, BUFB = KBUF + VBUF;
            const int k_dst = sch * 2048 + ((skey ^ sch) * 16);
            const int kp_dst = (8 + pch) * 2048 + ((pkey ^ pch) * 16);
            const int v_dst = KBUF + (sch >> 2) * 8192 + skey * 64 + (sch & 3) * 16;
            const int kfo = hh * 2048;
            const int vfo = KBUF + (4 * hh + ((lane & 15) >> 2)) * 64 + ((lane >> 4) & 1) * 32 + (lane & 3) * 8;
            __syncthreads();
            {
                const u32x4 k0 = *(const u32x4*)kn_src, v0 = *(const u32x4*)(kn_src + 64);
                const u32x4 k1 = *(const u32x4*)(kn_src + 64 * 1024), v1 = *(const u32x4*)(kn_src + 64 * 1024 + 64);
                const u32x4 pr = *(const u32x4*)kp_src;
                *(LAS u32x4*)(ldsL + k_dst) = k0; *(LAS u32x4*)(ldsL + k_dst + 1024) = k1;
                *(LAS u32x4*)(ldsL + v_dst) = v0; *(LAS u32x4*)(ldsL + v_dst + 4096) = v1;
                *(LAS u32x4*)(ldsL + kp_dst) = pr;
            }
            __syncthreads();
#pragma unroll 1
            for (int t = 0; t < 32; ++t) {
                const int cur = t & 1;
                const int tn = (t + 1 < 32) ? t + 1 : t;
                const bf16_t* ks = kn_src + (size_t)tn * 128 * 1024;
                const u32x4 nk0 = *(const u32x4*)ks, nv0 = *(const u32x4*)(ks + 64);
                const u32x4 nk1 = *(const u32x4*)(ks + 64 * 1024), nv1 = *(const u32x4*)(ks + 64 * 1024 + 64);
                const u32x4 npr = *(const u32x4*)(kp_src + (size_t)tn * 128 * INCP);
                f32x16 sc[2][2];
#pragma unroll
                for (int sub = 0; sub < 2; ++sub) {
                    const int kb = cur * BUFB + kfo + sub * 1024;
#pragma unroll
                    for (int d0 = 0; d0 < 6; ++d0) {
                        const int sw = (2 * d0 + hh) & 7;
                        const bf16x8 k0 = *(const LAS bf16x8*)(ldsL + kb + d0 * 4096 + ((r32 ^ sw) * 16));
                        const bf16x8 k1 = *(const LAS bf16x8*)(ldsL + kb + d0 * 4096 + (((32 + r32) ^ sw) * 16));
                        if (d0 == 0) { sc[sub][0] = __builtin_amdgcn_mfma_f32_32x32x16_bf16(k0, qf[0], mneg, 0, 0, 0); sc[sub][1] = __builtin_amdgcn_mfma_f32_32x32x16_bf16(k1, qf[0], mneg, 0, 0, 0); }
                        else { sc[sub][0] = __builtin_amdgcn_mfma_f32_32x32x16_bf16(k0, qf[d0], sc[sub][0], 0, 0, 0); sc[sub][1] = __builtin_amdgcn_mfma_f32_32x32x16_bf16(k1, qf[d0], sc[sub][1], 0, 0, 0); }
                    }
                }
#pragma unroll
                for (int sub = 0; sub < 2; ++sub) {
                    const int vb = cur * BUFB + vfo + sub * 4096;
                    f32x16& s0 = sc[sub][0]; f32x16& s1 = sc[sub][1];
                    float mx = fmaxf(s0[0], s1[0]);
#pragma unroll
                    for (int i = 1; i < 16; ++i) mx = fmaxf(mx, fmaxf(s0[i], s1[i]));
                    mx = max32(mx);
                    const bool first = (t == 0 && sub == 0);
                    if (first || __builtin_amdgcn_ballot_w64(mx > 8.0f) != 0ull) {
                        const float d = first ? mx : fmaxf(mx, 0.f);
                        const float alpha = first ? 0.f : ex2(-d);
                        m_run += d; l_run *= alpha;
#pragma unroll
                        for (int i = 0; i < 16; ++i) { o0[i] *= alpha; o1[i] *= alpha; s0[i] -= d; s1[i] -= d; mneg[i] = -m_run; }
                        if (sub == 0) {
#pragma unroll
                            for (int i = 0; i < 16; ++i) { sc[1][0][i] -= d; sc[1][1][i] -= d; }
                        }
                    }
                    float ps = 0.f;
#pragma unroll
                    for (int i = 0; i < 16; ++i) { s0[i] = ex2(s0[i]); s1[i] = ex2(s1[i]); ps += s0[i] + s1[i]; }
                    l_run += ps;
                    bf16x8 pf[2][2];
#pragma unroll
                    for (int s = 0; s < 2; ++s) {
                        u32x4 w0, w1;
                        w0.x = pk2(s0[8 * s + 0], s0[8 * s + 1]); w0.y = pk2(s0[8 * s + 2], s0[8 * s + 3]); w0.z = pk2(s0[8 * s + 4], s0[8 * s + 5]); w0.w = pk2(s0[8 * s + 6], s0[8 * s + 7]);
                        w1.x = pk2(s1[8 * s + 0], s1[8 * s + 1]); w1.y = pk2(s1[8 * s + 2], s1[8 * s + 3]); w1.z = pk2(s1[8 * s + 4], s1[8 * s + 5]); w1.w = pk2(s1[8 * s + 6], s1[8 * s + 7]);
                        pf[0][s] = __builtin_bit_cast(bf16x8, w0); pf[1][s] = __builtin_bit_cast(bf16x8, w1);
                    }
#pragma unroll
                    for (int n = 0; n < 2; ++n)
#pragma unroll
                        for (int s = 0; s < 2; ++s) {
                            const int ko = (32 * n + 16 * s) * 64;
#pragma unroll
                            for (int db = 0; db < 2; ++db) {
                                const s16x4 lo = __builtin_bit_cast(s16x4, __builtin_amdgcn_ds_read_tr16_b64_v4i16((LAS s16x4*)(ldsL + vb + db * 8192 + ko)));
                                const s16x4 hi = __builtin_bit_cast(s16x4, __builtin_amdgcn_ds_read_tr16_b64_v4i16((LAS s16x4*)(ldsL + vb + db * 8192 + ko + 512)));
                                const bf16x8 vf = {lo[0], lo[1], lo[2], lo[3], hi[0], hi[1], hi[2], hi[3]};
                                if (db == 0) o0 = __builtin_amdgcn_mfma_f32_32x32x16_bf16(vf, pf[n][s], o0, 0, 0, 0);
                                else o1 = __builtin_amdgcn_mfma_f32_32x32x16_bf16(vf, pf[n][s], o1, 0, 0, 0);
                            }
                        }
                }
                {
                    const int nb = (cur ^ 1) * BUFB;
                    *(LAS u32x4*)(ldsL + nb + k_dst) = nk0; *(LAS u32x4*)(ldsL + nb + k_dst + 1024) = nk1;
                    *(LAS u32x4*)(ldsL + nb + v_dst) = nv0; *(LAS u32x4*)(ldsL + nb + v_dst + 4096) = nv1;
                    *(LAS u32x4*)(ldsL + nb + kp_dst) = npr;
                }
                __syncthreads();
            }
            {
                const float lt = sum32(l_run);
                const float inv = 1.0f / lt;
                const int sc = 81920 + wave * 4352;
#pragma unroll
                for (int g = 0; g < 4; ++g) {
                    u32x2 w;
                    w.x = pk2(o0[4 * g] * inv, o0[4 * g + 1] * inv); w.y = pk2(o0[4 * g + 2] * inv, o0[4 * g + 3] * inv);
                    *(LAS u32x2*)(ldsL + sc + r32 * 136 + (8 * g + 4 * hh) * 2) = w;
                    w.x = pk2(o1[4 * g] * inv, o1[4 * g + 1] * inv); w.y = pk2(o1[4 * g + 2] * inv, o1[4 * g + 3] * inv);
                    *(LAS u32x2*)(ldsL + sc + r32 * 136 + (32 + 8 * g + 4 * hh) * 2) = w;
                }
                __syncthreads();
#pragma unroll
                for (int it = 0; it < 8; ++it) {
                    const int row = it * 4 + (lane >> 4), pc = lane & 15;
                    const u32x2 w = *(const LAS u32x2*)(ldsL + sc + row * 136 + pc * 8);
                    *(u32x2*)(W_bout + (tok0 + qblk * 256 + wave * 32 + row) * 512 + h * 64 + pc * 4) = w;
                }
            }
            if ((vblk & 3) == ui) {
#pragma unroll 1
                for (int sl = 0; sl < 4; ++sl) {
                    const int j = sl >> 1; const int uu = blk + j * G;
                    const int e = (G == 256) ? ((vblk & ~1) + j) : (uu >> 1), pn = (G == 256) ? (vblk & 1) : (uu & 1);
                    __syncthreads();
                    if (uu < 512) convert_panel_lds<128, true>(W_scr + (size_t)j * 256 * 1024 + (sl & 1) * 128 * 1024, P.in[(sl & 1) ? I_W3 : I_W1] + (size_t)e * 1024 * 256 + pn * 128, 256, 1024, tid, ldsL);
                }
            }
        }
        for (int ui = 0; ui < ((P.flags & 8) ? 0 : 12); ++ui) {
            TIDS
            const int r32 = lane & 31, hh = lane >> 5;
            const int u = vblk * 12 + ui;
            if (u >= 3072) break;
            const int bh = u / 48, w48 = u % 48, h = bh & 7, b = bh >> 3;
            const int p = w48 >> 4, j16 = w48 & 15;
            const int dil = (p == 0) ? 1 : (p == 1 ? 4 : 16);
            const int res = (p == 0) ? 0 : (p == 1 ? (j16 >> 2) : j16);
            const int m0 = (p == 0) ? j16 * 256 : (p == 1 ? (j16 & 3) * 256 : 0);
            const int L = SEQ / dil;
            const size_t tok0 = (size_t)b * SEQ;
            __syncthreads();
            for (int idx = tid; idx < 672; idx += 512) { const int oi = idx - 255; *(LAS float*)(ldsL + 98304 + idx * 4) = (oi >= 0 && oi <= 128) ? W_biasT[(p * 8 + h) * 129 + oi] : -1e30f; }
            {
                u32x4 kr[6], vr[6];
#pragma unroll
                for (int it = 0; it < 6; ++it) {
                    const int idx = it * 512 + tid, row = idx >> 3, ch = idx & 7;
                    const int mk = m0 - 64 + row;
                    kr[it] = (u32x4){0, 0, 0, 0}; vr[it] = (u32x4){0, 0, 0, 0};
                    if (mk >= 0 && mk < L) {
                        const bf16_t* src = W_proj + (tok0 + (size_t)mk * dil + res) * INCP + 512 + h * 64 + ch * 8;
                        kr[it] = *(const u32x4*)src; vr[it] = *(const u32x4*)(src + 512);
                    }
                }
#pragma unroll
                for (int it = 0; it < 6; ++it) {
                    const int idx = it * 512 + tid, row = idx >> 3, ch = idx & 7;
                    *(LAS u32x4*)(ldsL + ch * 6144 + ((row ^ ch) * 16)) = kr[it];
                    *(LAS u32x4*)(ldsL + 49152 + (ch >> 2) * 24576 + row * 64 + (ch & 3) * 16) = vr[it];
                }
            }
            const int qrel = wave * 32 + r32;
            const size_t tq = tok0 + (size_t)(m0 + qrel) * dil + res;
            bf16x8 qf[4];
#pragma unroll
            for (int d0 = 0; d0 < 4; ++d0) qf[d0] = *(const bf16x8*)(W_proj + tq * INCP + h * 64 + d0 * 16 + hh * 8);
            __syncthreads();
            f32x16 o0 = {}, o1 = {};
            float m_run = -1e20f, l_run = 0.f;
            const int vfo = 49152 + (4 * hh + ((lane & 15) >> 2)) * 64 + ((lane >> 4) & 1) * 32 + (lane & 3) * 8;
#pragma unroll 1
            for (int jj = 0; jj < 3; ++jj) {
                const int jt = (wave >> 1) + jj;
                f32x16 s0 = {}, s1 = {};
#pragma unroll
                for (int d0 = 0; d0 < 4; ++d0) {
                    const int ch = 2 * d0 + hh;
                    const bf16x8 k0 = *(const LAS bf16x8*)(ldsL + ch * 6144 + (((64 * jt + r32) ^ ch) * 16));
                    const bf16x8 k1 = *(const LAS bf16x8*)(ldsL + ch * 6144 + (((64 * jt + 32 + r32) ^ ch) * 16));
                    s0 = __builtin_amdgcn_mfma_f32_32x32x16_bf16(k0, qf[d0], s0, 0, 0, 0);
                    s1 = __builtin_amdgcn_mfma_f32_32x32x16_bf16(k1, qf[d0], s1, 0, 0, 0);
                }
                const LAS float* bl = (const LAS float*)(ldsL + 98304) + (64 * jt - qrel + 4 * hh + 255);
                const int mkb = m0 - 64 + 64 * jt;
                const bool edge = (mkb < 0) || (mkb + 64 > L);
                float mx = -1e30f;
#pragma unroll
                for (int i = 0; i < 16; ++i) {
                    const int cr = (i & 3) + 8 * (i >> 2);
                    s0[i] += bl[cr]; s1[i] += bl[cr + 32];
                    if (edge) {
                        const int mk0 = mkb + cr + 4 * hh;
                        if (mk0 < 0 || mk0 >= L) s0[i] = -1e30f;
                        if (mk0 + 32 < 0 || mk0 + 32 >= L) s1[i] = -1e30f;
                    }
                    mx = fmaxf(mx, fmaxf(s0[i], s1[i]));
                }
                mx = max32(mx);
                const float m_new = fmaxf(m_run, mx);
                const float alpha = ex2(m_run - m_new);
                m_run = m_new;
                float ps = 0.f;
#pragma unroll
                for (int i = 0; i < 16; ++i) { s0[i] = ex2(s0[i] - m_new); s1[i] = ex2(s1[i] - m_new); ps += s0[i] + s1[i]; }
                l_run = l_run * alpha + ps;
#pragma unroll
                for (int i = 0; i < 16; ++i) { o0[i] *= alpha; o1[i] *= alpha; }
                bf16x8 pf[2][2];
#pragma unroll
                for (int s = 0; s < 2; ++s) {
                    u32x4 w0, w1;
                    w0.x = pk2(s0[8 * s + 0], s0[8 * s + 1]); w0.y = pk2(s0[8 * s + 2], s0[8 * s + 3]); w0.z = pk2(s0[8 * s + 4], s0[8 * s + 5]); w0.w = pk2(s0[8 * s + 6], s0[8 * s + 7]);
                    w1.x = pk2(s1[8 * s + 0], s1[8 * s + 1]); w1.y = pk2(s1[8 * s + 2], s1[8 * s + 3]); w1.z = pk2(s1[8 * s + 4], s1[8 * s + 5]); w1.w = pk2(s1[8 * s + 6], s1[8 * s + 7]);
                    pf[0][s] = __builtin_bit_cast(bf16x8, w0); pf[1][s] = __builtin_bit_cast(bf16x8, w1);
                }
#pragma unroll
                for (int n = 0; n < 2; ++n)
#pragma unroll
                    for (int s = 0; s < 2; ++s) {
                        const int ko = (64 * jt + 32 * n + 16 * s) * 64;
#pragma unroll
                        for (int db = 0; db < 2; ++db) {
                            const s16x4 lo = __builtin_bit_cast(s16x4, __builtin_amdgcn_ds_read_tr16_b64_v4i16((LAS s16x4*)(ldsL + vfo + db * 24576 + ko)));
                            const s16x4 hi = __builtin_bit_cast(s16x4, __builtin_amdgcn_ds_read_tr16_b64_v4i16((LAS s16x4*)(ldsL + vfo + db * 24576 + ko + 512)));
                            const bf16x8 vf = {lo[0], lo[1], lo[2], lo[3], hi[0], hi[1], hi[2], hi[3]};
                            if (db == 0) o0 = __builtin_amdgcn_mfma_f32_32x32x16_bf16(vf, pf[n][s], o0, 0, 0, 0);
                            else o1 = __builtin_amdgcn_mfma_f32_32x32x16_bf16(vf, pf[n][s], o1, 0, 0, 0);
                        }
                    }
            }
            __syncthreads();
            {
                const float lt = sum32(l_run);
                const float inv = 1.0f / lt;
                if (hh == 0) W_lsebuf[((size_t)p * NTOK + tq) * 8 + h] = m_run + __log2f(lt);
                const int sc = wave * 4352;
#pragma unroll
                for (int g = 0; g < 4; ++g) {
                    u32x2 w;
                    w.x = pk2(o0[4 * g] * inv, o0[4 * g + 1] * inv); w.y = pk2(o0[4 * g + 2] * inv, o0[4 * g + 3] * inv);
                    *(LAS u32x2*)(ldsL + sc + r32 * 136 + (8 * g + 4 * hh) * 2) = w;
                    w.x = pk2(o1[4 * g] * inv, o1[4 * g + 1] * inv); w.y = pk2(o1[4 * g + 2] * inv, o1[4 * g + 3] * inv);
                    *(LAS u32x2*)(ldsL + sc + r32 * 136 + (32 + 8 * g + 4 * hh) * 2) = w;
                }
                __syncthreads();
#pragma unroll
                for (int it = 0; it < 8; ++it) {
                    const int row = it * 4 + (lane >> 4), pc = lane & 15;
                    const u32x2 w = *(const LAS u32x2*)(ldsL + sc + row * 136 + pc * 8);
                    const size_t tr = tok0 + (size_t)(m0 + wave * 32 + row) * dil + res;
                    *(u32x2*)(W_aparts + ((size_t)p * NTOK + tr) * 512 + h * 64 + pc * 4) = w;
                }
            }
            if ((vblk % 12) == ui) {
#pragma unroll 1
                for (int q = 2; q < 4; ++q) {
                    const int uu = blk + q * G;
                    const int e = (G == 256) ? ((vblk & ~3) + q) : (uu >> 2), pn = (G == 256) ? (vblk & 3) : (uu & 3);
                    __syncthreads();
                    if (uu < 1024) convert_panel_lds<256, true>(W_scr + (size_t)2 * 256 * 1024 + (size_t)q * 256 * 256, P.in[I_W2] + (size_t)e * 256 * 1024 + pn * 256, 1024, 256, tid, ldsL);
                }
            }
        }
    }
    SEAM(4);

    if (IN(5)) {
        TIDS
        for (int row = blk * 8 + wave; row < NTOK; row += G * 8) {
            const int hd = lane >> 3;
            float ls0 = W_lsebuf[((size_t)0 * NTOK + row) * 8 + hd], ls1 = W_lsebuf[((size_t)1 * NTOK + row) * 8 + hd], ls2 = W_lsebuf[((size_t)2 * NTOK + row) * 8 + hd];
            const float M = fmaxf(ls0, fmaxf(ls1, ls2));
            float w0 = ex2(ls0 - M), w1 = ex2(ls1 - M), w2 = ex2(ls2 - M);
            const float wsn = 1.0f / (w0 + w1 + w2); w0 *= wsn; w1 *= wsn; w2 *= wsn;
            const u32x4 a0 = *(const u32x4*)(W_aparts + ((size_t)0 * NTOK + row) * 512 + lane * 8);
            const u32x4 a1 = *(const u32x4*)(W_aparts + ((size_t)1 * NTOK + row) * 512 + lane * 8);
            const u32x4 a2 = *(const u32x4*)(W_aparts + ((size_t)2 * NTOK + row) * 512 + lane * 8);
            const u32x4 bb = *(const u32x4*)(W_bout + (size_t)row * 512 + lane * 8);
            float av[8], bv[8]; float sa = 0.f, sb = 0.f;
#pragma unroll
            for (int j = 0; j < 4; ++j) {
                av[2 * j] = w0 * __uint_as_float(a0[j] << 16) + w1 * __uint_as_float(a1[j] << 16) + w2 * __uint_as_float(a2[j] << 16);
                av[2 * j + 1] = w0 * __uint_as_float(a0[j] & 0xffff0000u) + w1 * __uint_as_float(a1[j] & 0xffff0000u) + w2 * __uint_as_float(a2[j] & 0xffff0000u);
                bv[2 * j] = __uint_as_float(bb[j] << 16); bv[2 * j + 1] = __uint_as_float(bb[j] & 0xffff0000u);
                sa += av[2 * j] * av[2 * j] + av[2 * j + 1] * av[2 * j + 1];
                sb += bv[2 * j] * bv[2 * j] + bv[2 * j + 1] * bv[2 * j + 1];
            }
            sa = wave_sum(sa); sb = wave_sum(sb);
            const float ra = rsqrtf(sa * (1.0f / 512.0f) + EPS), rb = rsqrtf(sb * (1.0f / 512.0f) + EPS);
            u32x4 wa, wb;
            wa.x = pk2(av[0] * ra, av[1] * ra); wa.y = pk2(av[2] * ra, av[3] * ra); wa.z = pk2(av[4] * ra, av[5] * ra); wa.w = pk2(av[6] * ra, av[7] * ra);
            wb.x = pk2(bv[0] * rb, bv[1] * rb); wb.y = pk2(bv[2] * rb, bv[3] * rb); wb.z = pk2(bv[4] * rb, bv[5] * rb); wb.w = pk2(bv[6] * rb, bv[7] * rb);
            *(u32x4*)(W_mixb + (size_t)row * DM + lane * 8) = wa;
            *(u32x4*)(W_mixb + (size_t)row * DM + 512 + lane * 8) = wb;
        }
    }
    SEAM(5);

    if (IN(6)) {
        TIDS
        unsigned vl_[4]; g8_voff_lin(vl_, DM, tid);
        auto nextf = [&](int i, GDesc& d) {
            const int ul = i * 32 + (vblk & 31); if (ul >= 64 || vblk >= 256) return false;
            const int pm = (vblk >> 5) * 16 + (ul >> 2), pn = ul & 3;
            d.Ab = (const char*)(W_mixb + (size_t)pm * 256 * DM); d.Bb = (const char*)(W_WoT + (size_t)pn * 256 * DM);
            d.va0 = vl_[0]; d.va1 = vl_[1]; d.va2 = vl_[2]; d.va3 = vl_[3]; d.i0 = pm; d.i1 = pn; return true;
        };
        auto epi = [&](const f32x4 (&acc)[2][2][4][2], const GDesc& d, int wr, int wc, int fr, int fq) {
            const int pm = d.i0, pn = d.i1;
            EPI_FOREACH8(acc, wr, wc, fr, fq, r, c8, v0, v1, {
                const int col = pn * 256 + c8; const int row = pm * 256 + r;
                const float* gp = W_mod + (row >> 12) * 6144 + 2048 + col;
                const f32x4 ga = *(const f32x4*)gp * v0, gb = *(const f32x4*)(gp + 4) * v1;
                u32x4 w; PK8(w, ga, gb);
                *(u32x4*)(W_xt + (size_t)row * DM + col) = w;
            })
        };
        gemm_stream(ldsL, tid, DM, nextf, epi);
    }
    SEAM(6);

    if (IN(7)) {
        TIDS
        const float* g = P.in[I_N2G];
        for (int row = blk * 8 + wave; row < NTOK; row += G * 8) {
            const int b = row >> 12;
            bf16_t* xr = W_xt + (size_t)row * DM;
            const float* x0 = W_x + (size_t)row * DM;
            f32x4 v[4]; float ss = 0.f;
#pragma unroll
            for (int i = 0; i < 4; ++i) {
                const u32x2 tw = *(const u32x2*)(xr + i * 256 + lane * 4);
                const f32x4 tv = {__uint_as_float(tw.x << 16), __uint_as_float(tw.x & 0xffff0000u), __uint_as_float(tw.y << 16), __uint_as_float(tw.y & 0xffff0000u)};
                v[i] = tv + *(const f32x4*)(x0 + i * 256 + lane * 4);
                u32x2 xw; xw.x = pk2(v[i][0], v[i][1]); xw.y = pk2(v[i][2], v[i][3]);
                *(u32x2*)(xr + i * 256 + lane * 4) = xw;
                ss += v[i][0] * v[i][0] + v[i][1] * v[i][1] + v[i][2] * v[i][2] + v[i][3] * v[i][3]; }
            ss = wave_sum(ss);
            const float rinv = rsqrtf(ss * (1.0f / 1024.0f) + EPS);
            const float* mb = W_mod + b * 6144 + 3072;
#pragma unroll
            for (int i = 0; i < 4; ++i) {
                const int c = i * 256 + lane * 4;
                const f32x4 gg = *(const f32x4*)(g + c), sh = *(const f32x4*)(mb + c), sc = *(const f32x4*)(mb + 1024 + c);
                float o[4];
#pragma unroll
                for (int j = 0; j < 4; ++j) o[j] = v[i][j] * rinv * gg[j] * (1.0f + sc[j]) + sh[j];
                u32x2 w; w.x = pk2(o[0], o[1]); w.y = pk2(o[2], o[3]);
                *(u32x2*)(W_hbuf + (size_t)row * DM + c) = w;
            }
        }
    }
    SEAM(7);

    if (IN(8)) {
        {
            TIDS
            unsigned vl_[4]; g8_voff_lin(vl_, DM, tid);
            auto nextf = [&](int i, GDesc& d) {
                const int ul = vblk & 31; if (i > 0 || vblk >= 256) return false;
                const int pm = (vblk >> 5) * 16 + (ul >> 1), pn = ul & 1;
                d.Ab = (const char*)(W_hbuf + (size_t)pm * 256 * DM); d.Bb = (const char*)(W_Ws13T + (size_t)pn * 256 * DM);
                d.va0 = vl_[0]; d.va1 = vl_[1]; d.va2 = vl_[2]; d.va3 = vl_[3]; d.i0 = pm; d.i1 = pn; return true;
            };
            auto epi = [&](const f32x4 (&acc)[2][2][4][2], const GDesc& d, int wr, int wc, int fr, int fq) {
                const int pm = d.i0, pn = d.i1;
#pragma unroll
                for (int ai = 0; ai < 2; ++ai)
#pragma unroll
                    for (int m = 0; m < 4; ++m) {
                        const int r = ai * 128 + wr * 64 + m * 16 + fr;
                        const f32x4 a0 = acc[ai][0][m][0], a1 = acc[ai][0][m][1], b0 = acc[ai][1][m][0], b1 = acc[ai][1][m][1];
                        f32x4 h0, h1;
#pragma unroll
                        for (int j = 0; j < 4; ++j) { h0[j] = siluf(a0[j]) * b0[j]; h1[j] = siluf(a1[j]) * b1[j]; }
                        u32x4 w; PK8(w, h0, h1);
                        *(u32x4*)(W_hdn + (size_t)(NASG + pm * 256 + r) * EFF + pn * 128 + wc * 32 + fq * 8) = w;
                    }
            };
            gemm_stream(ldsL, tid, DM, nextf, epi);
        }
        {
            TIDS
            unsigned vl_[4]; g8_voff_lin(vl_, DM, tid);
            auto nextf = [&](int i, GDesc& d) {
                const int ul = vblk & 31; if (i > 0 || ul < 16 || vblk >= 256) return false;
                const int pm = (vblk >> 5) * 16 + (ul - 16);
                d.Ab = (const char*)(W_hbuf + (size_t)pm * 256 * DM); d.Bb = (const char*)(W_WrT);
                d.va0 = vl_[0]; d.va1 = vl_[1]; d.va2 = vl_[2]; d.va3 = vl_[3]; d.i0 = pm; d.i1 = 0; return true;
            };
            auto epi = [&](const f32x4 (&acc)[2][2][4][2], const GDesc& d, int wr, int wc, int fr, int fq) {
                const int pm = d.i0;
                EPI_FOREACH8(acc, wr, wc, fr, fq, r, c8, v0, v1, {
                    *(f32x4*)(W_logits + (size_t)(pm * 256 + r) * 256 + c8) = v0;
                    *(f32x4*)(W_logits + (size_t)(pm * 256 + r) * 256 + c8 + 4) = v1;
                })
            };
            gemm_stream(ldsL, tid, DM, nextf, epi);
        }
        if ((vblk & 31) < 16) {
            TIDS
#pragma unroll 1
            for (int q = 0; q < 2; ++q) {
                const int uu = blk + q * G;
                const int e = (G == 256) ? ((vblk & ~3) + q) : (uu >> 2), pn = (G == 256) ? (vblk & 3) : (uu & 3);
                __syncthreads();
                if (uu < 1024) convert_panel_lds<256, true>(W_scr + (size_t)2 * 256 * 1024 + (size_t)q * 256 * 256, P.in[I_W2] + (size_t)e * 256 * 1024 + pn * 256, 1024, 256, tid, ldsL);
            }
        }
    }
    SEAM(8);

    if (IN(9)) {
        TIDS
        const float* ebias = P.in[I_EB];
        const f32x4 eb = *(const f32x4*)(ebias + lane * 4);
        for (int t = blk * 8 + wave; t < NTOK; t += G * 8) {
            const f32x4 lg = *(const f32x4*)(W_logits + (size_t)t * 256 + lane * 4);
            float sc[4], sel[4];
#pragma unroll
            for (int i = 0; i < 4; ++i) { sc[i] = 1.0f / (1.0f + expf(-lg[i])); sel[i] = sc[i] + eb[i]; }
            float a1 = fmaxf(sel[0], sel[1]), a2 = fminf(sel[0], sel[1]);
#pragma unroll
            for (int i = 2; i < 4; ++i) { const float v = sel[i]; a2 = fmaxf(a2, fminf(a1, v)); a1 = fmaxf(a1, v); }
            {
                float b1, b2, n1, n2;
                b1 = dppf(a1, DPP_X1); b2 = dppf(a2, DPP_X1); n1 = fmaxf(a1, b1); n2 = fmaxf(fminf(a1, b1), fmaxf(a2, b2)); a1 = n1; a2 = n2;
                b1 = dppf(a1, DPP_X2); b2 = dppf(a2, DPP_X2); n1 = fmaxf(a1, b1); n2 = fmaxf(fminf(a1, b1), fmaxf(a2, b2)); a1 = n1; a2 = n2;
                b1 = dppf(a1, DPP_HM); b2 = dppf(a2, DPP_HM); n1 = fmaxf(a1, b1); n2 = fmaxf(fminf(a1, b1), fmaxf(a2, b2)); a1 = n1; a2 = n2;
            }
            const float gs = a1 + a2; const int myg = lane >> 3;
            int rank = 0;
#pragma unroll
            for (int g = 0; g < 8; ++g) { const float v = __int_as_float(__builtin_amdgcn_readlane(__float_as_int(gs), g * 8)); rank += (v > gs || (v == gs && g < myg)) ? 1 : 0; }
            const bool gsel = rank < 4;
            float cand[4];
#pragma unroll
            for (int i = 0; i < 4; ++i) cand[i] = gsel ? sel[i] : -INFINITY;
            int my_e = 0; float my_g = 0.f; float gsum = 0.f;
#pragma unroll
            for (int k = 0; k < 8; ++k) {
                float bv = cand[0]; int bi = 0;
#pragma unroll
                for (int i = 1; i < 4; ++i) if (cand[i] > bv) { bv = cand[i]; bi = i; }
                float v = bv; int ix = lane * 4 + bi;
#define AMX(ov, oi) do { const float ov_ = (ov); const int oi_ = (oi); if (ov_ > v || (ov_ == v && oi_ < ix)) { v = ov_; ix = oi_; } } while (0)
                AMX(dppf(v, DPP_X1), dppi(ix, DPP_X1)); AMX(dppf(v, DPP_X2), dppi(ix, DPP_X2)); AMX(dppf(v, DPP_HM), dppi(ix, DPP_HM)); AMX(dppf(v, DPP_RM), dppi(ix, DPP_RM));
                { auto rv = __builtin_amdgcn_permlane16_swap(__float_as_uint(v), __float_as_uint(v), false, false); auto ri = __builtin_amdgcn_permlane16_swap((unsigned)ix, (unsigned)ix, false, false);
                  v = __uint_as_float(rv[0]); ix = (int)ri[0]; AMX(__uint_as_float(rv[1]), (int)ri[1]); }
                { auto rv = __builtin_amdgcn_permlane32_swap(__float_as_uint(v), __float_as_uint(v), false, false); auto ri = __builtin_amdgcn_permlane32_swap((unsigned)ix, (unsigned)ix, false, false);
                  v = __uint_as_float(rv[0]); ix = (int)ri[0]; AMX(__uint_as_float(rv[1]), (int)ri[1]); }
#undef AMX
                ix = __builtin_amdgcn_readfirstlane(ix);
                float myscore = 0.f;
#pragma unroll
                for (int i = 0; i < 4; ++i) if (lane * 4 + i == ix) { cand[i] = -INFINITY; myscore = sc[i]; }
                const float gw = __int_as_float(__builtin_amdgcn_readlane(__float_as_int(myscore), ix >> 2));
                gsum += gw;
                if (lane == k) { my_e = ix; my_g = gw; }
            }
            if (lane < 8) {
                const unsigned rk = atomicAdd(&cntg[my_e * CNT_STRIDE], 1u);
                W_eidx[t * 8 + lane] = my_e; W_gate[t * 8 + lane] = my_g / gsum * 2.5f; W_rnk[t * 8 + lane] = (int)rk;
            }
        }
    }
    SEAM(9);

    if (IN(10)) {
        TIDS
        if (tid < 256) cntL[tid] = (int)__hip_atomic_load(&cntg[tid * CNT_STRIDE], __ATOMIC_RELAXED, __HIP_MEMORY_SCOPE_AGENT);
        __syncthreads();
        if (tid < 256) { int s = 0; for (int j = 0; j < tid; ++j) s += cntL[j]; startL[tid] = s; }
        __syncthreads();
        for (int t = blk * 8 + wave; t < NTOK; t += G * 8) {
            if (lane < 8) {
                const int e = W_eidx[t * 8 + lane];
                const int d = startL[e] + W_rnk[t * 8 + lane];
                W_toks[d] = t; W_wts[d] = W_gate[t * 8 + lane]; W_pos[t * 8 + lane] = d;
            }
        }
    }
    SEAM(10);

    if (IN(11)) {
        TIDS
        __syncthreads();
        if (tid < 256) cntL[tid] = (int)__hip_atomic_load(&cntg[tid * CNT_STRIDE], __ATOMIC_RELAXED, __HIP_MEMORY_SCOPE_AGENT);
        __syncthreads();
        if (tid < 256) { int s = 0; for (int j = 0; j < tid; ++j) s += cntL[j]; startL[tid] = s; }
        __syncthreads();
        for (int ui = blk; ui < 512; ui += G) {
            TIDS
            const int e = (G == 256) ? ((vblk & ~1) + (ui >> 8)) : (ui >> 1), pn = (G == 256) ? (vblk & 1) : (ui & 1);
            const int cnt = cntL[e], st = startL[e];
            if (cnt == 0) continue;
            const bf16_t* panel = W_scr + (size_t)(ui / G) * 256 * 1024;
            const int ntile = (cnt + 255) >> 8;
            for (int c0 = 0; c0 < ntile; c0 += 8) {
                TIDS
                const int nch = (ntile - c0) < 8 ? (ntile - c0) : 8;
                __syncthreads();
                for (int idx = tid; idx < nch * 256; idx += 512) { const int rr = c0 * 256 + idx; const int sr = st + (rr < cnt ? rr : 0); rowoff[idx] = (unsigned)W_toks[sr] * DM; }
                __syncthreads();
                int R0, C0; g8_rc(tid, R0, C0);
                auto nextf = [&](int i, GDesc& d) {
                    if (i >= nch) return false;
                    d.Ab = (const char*)W_hbuf; d.Bb = (const char*)panel;
                    d.va0 = (rowoff[i * 256 + R0] + C0) * 2u; d.va1 = (rowoff[i * 256 + R0 + 64] + C0) * 2u; d.va2 = (rowoff[i * 256 + R0 + 128] + C0) * 2u; d.va3 = (rowoff[i * 256 + R0 + 192] + C0) * 2u;
                    d.i0 = c0 + i; d.i1 = 0; return true;
                };
                auto epi = [&](const f32x4 (&acc)[2][2][4][2], const GDesc& d, int wr, int wc, int fr, int fq) {
                    const int ti = d.i0;
#pragma unroll
                    for (int ai = 0; ai < 2; ++ai)
#pragma unroll
                        for (int m = 0; m < 4; ++m) {
                            const int r = ai * 128 + wr * 64 + m * 16 + fr;
                            const int rr = ti * 256 + r;
                            if (rr < cnt) {
                                const f32x4 a0 = acc[ai][0][m][0], a1 = acc[ai][0][m][1], b0 = acc[ai][1][m][0], b1 = acc[ai][1][m][1];
                                f32x4 h0, h1;
#pragma unroll
                                for (int j = 0; j < 4; ++j) { h0[j] = siluf(a0[j]) * b0[j]; h1[j] = siluf(a1[j]) * b1[j]; }
                                u32x4 w; PK8(w, h0, h1);
                                *(u32x4*)(W_hdn + (size_t)(st + rr) * EFF + pn * 128 + wc * 32 + fq * 8) = w;
                            }
                        }
                };
                gemm_stream(ldsL, tid, DM, nextf, epi);
            }
        }
    }
    SEAM(11);

    if (IN(12)) {
        TIDS
        __syncthreads();
        if (tid < 256) cntL[tid] = (int)__hip_atomic_load(&cntg[tid * CNT_STRIDE], __ATOMIC_RELAXED, __HIP_MEMORY_SCOPE_AGENT);
        __syncthreads();
        if (tid < 256) { int s = 0; for (int j = 0; j < tid; ++j) s += cntL[j]; startL[tid] = s; }
        __syncthreads();
#define Y_STORE(ROWG, COL0, G_) do { _Pragma("unroll") for (int bj = 0; bj < 2; ++bj) { const f32x4 a_ = acc[ai][bj][m][0], b_ = acc[ai][bj][m][1]; int w0_ = 0, w1_ = 0; \
            w0_ = __builtin_amdgcn_cvt_pk_fp8_f32(a_[0] * (G_), a_[1] * (G_), w0_, false); w0_ = __builtin_amdgcn_cvt_pk_fp8_f32(a_[2] * (G_), a_[3] * (G_), w0_, true); \
            w1_ = __builtin_amdgcn_cvt_pk_fp8_f32(b_[0] * (G_), b_[1] * (G_), w1_, false); w1_ = __builtin_amdgcn_cvt_pk_fp8_f32(b_[2] * (G_), b_[3] * (G_), w1_, true); \
            u32x2 w_; w_.x = (unsigned)w0_; w_.y = (unsigned)w1_; *(u32x2*)(W_y8 + (size_t)(ROWG) * DM + (COL0) + bj * 128 + wc * 32 + fq * 8) = w_; } } while (0)
        for (int ui = blk; ui < 1024; ui += G) {
            TIDS
            const int e = (G == 256) ? ((vblk & ~3) + (ui >> 8)) : (ui >> 2), pn = (G == 256) ? (vblk & 3) : (ui & 3);
            const int cnt = cntL[e], st = startL[e];
            if (cnt == 0) continue;
            const bf16_t* panel = W_scr + (size_t)2 * 256 * 1024 + (size_t)(ui / G) * 256 * 256;
            const int ntile = (cnt + 255) >> 8;
            for (int c0 = 0; c0 < ntile; c0 += 8) {
                TIDS
                const int nch = (ntile - c0) < 8 ? (ntile - c0) : 8;
                __syncthreads();
                for (int idx = tid; idx < nch * 256; idx += 512) { const int rr = c0 * 256 + idx; const int sr = st + (rr < cnt ? rr : 0); rowoff[idx] = (unsigned)sr * EFF; rowsc[idx] = W_wts[sr]; }
                __syncthreads();
                int R0, C0; g8_rc(tid, R0, C0);
                auto nextf = [&](int i, GDesc& d) {
                    if (i >= nch) return false;
                    d.Ab = (const char*)W_hdn; d.Bb = (const char*)panel;
                    d.va0 = (rowoff[i * 256 + R0] + C0) * 2u; d.va1 = (rowoff[i * 256 + R0 + 64] + C0) * 2u; d.va2 = (rowoff[i * 256 + R0 + 128] + C0) * 2u; d.va3 = (rowoff[i * 256 + R0 + 192] + C0) * 2u;
                    d.i0 = c0 + i; d.i1 = i; return true;
                };
                auto epi = [&](const f32x4 (&acc)[2][2][4][2], const GDesc& d, int wr, int wc, int fr, int fq) {
                    const int ti = d.i0, tl = d.i1;
#pragma unroll
                    for (int ai = 0; ai < 2; ++ai)
#pragma unroll
                        for (int m = 0; m < 4; ++m) {
                            const int r = ai * 128 + wr * 64 + m * 16 + fr;
                            const int rr = ti * 256 + r;
                            if (rr < cnt) { const float g = rowsc[tl * 256 + r]; Y_STORE(st + rr, pn * 256, g); }
                        }
                };
                gemm_stream(ldsL, tid, EFF, nextf, epi);
            }
        }
        {
            TIDS
            unsigned vl_[4]; g8_voff_lin(vl_, EFF, tid);
            auto nextf = [&](int i, GDesc& d) {
                const int u = blk + i * G; if (u >= 512) return false;
                const int pm = u >> 2, pn = u & 3;
                d.Ab = (const char*)(W_hdn + (size_t)(NASG + pm * 256) * EFF); d.Bb = (const char*)(W_Ws2T + (size_t)pn * 256 * EFF);
                d.va0 = vl_[0]; d.va1 = vl_[1]; d.va2 = vl_[2]; d.va3 = vl_[3]; d.i0 = pm; d.i1 = pn; return true;
            };
            auto epi = [&](const f32x4 (&acc)[2][2][4][2], const GDesc& d, int wr, int wc, int fr, int fq) {
                const int pm = d.i0, pn = d.i1;
#pragma unroll
                for (int ai = 0; ai < 2; ++ai)
#pragma unroll
                    for (int m = 0; m < 4; ++m) {
                        const int r = ai * 128 + wr * 64 + m * 16 + fr;
                        Y_STORE(NASG + pm * 256 + r, pn * 256, 1.0f);
                    }
            };
            gemm_stream(ldsL, tid, EFF, nextf, epi);
        }
#undef Y_STORE
    }
    SEAM(12);

    if (IN(13)) {
        TIDS
        const float* fg = P.in[I_FG];
        for (int row = blk * 8 + wave; row < NTOK; row += G * 8) {
            const int b = row >> 12;
            float a[16];
#pragma unroll
            for (int j = 0; j < 16; ++j) a[j] = 0.f;
#pragma unroll
            for (int k = 0; k < 9; ++k) {
                const int pr = (k < 8) ? W_pos[row * 8 + k] : (NASG + row);
                const u32x4 w = *(const u32x4*)(W_y8 + (size_t)pr * DM + lane * 16);
#pragma unroll
                for (int q = 0; q < 4; ++q) {
                    a[4 * q + 0] += __builtin_amdgcn_cvt_f32_fp8((int)w[q], 0); a[4 * q + 1] += __builtin_amdgcn_cvt_f32_fp8((int)w[q], 1);
                    a[4 * q + 2] += __builtin_amdgcn_cvt_f32_fp8((int)w[q], 2); a[4 * q + 3] += __builtin_amdgcn_cvt_f32_fp8((int)w[q], 3);
                }
            }
            float* xr = P.out + (size_t)row * DM + lane * 16;
            const bf16_t* x1r = W_xt + (size_t)row * DM + lane * 16;
            const u32x4 xw0 = *(const u32x4*)x1r, xw1 = *(const u32x4*)(x1r + 8);
            const float* g2 = W_mod + b * 6144 + 5120 + lane * 16;
            float v[16]; float ss = 0.f;
#pragma unroll
            for (int q = 0; q < 4; ++q) {
                const unsigned wa = (q < 2) ? xw0[2 * q] : xw1[2 * (q - 2)], wb = (q < 2) ? xw0[2 * q + 1] : xw1[2 * (q - 2) + 1];
                const f32x4 xa = {__uint_as_float(wa << 16), __uint_as_float(wa & 0xffff0000u), __uint_as_float(wb << 16), __uint_as_float(wb & 0xffff0000u)};
                const f32x4 ga = *(const f32x4*)(g2 + q * 4);
#pragma unroll
                for (int j = 0; j < 4; ++j) { v[q * 4 + j] = xa[j] + ga[j] * a[q * 4 + j]; ss += v[q * 4 + j] * v[q * 4 + j]; }
            }
            ss = wave_sum(ss);
            const float rinv = rsqrtf(ss * (1.0f / 1024.0f) + EPS);
#pragma unroll
            for (int q = 0; q < 4; ++q) {
                const f32x4 fa = *(const f32x4*)(fg + lane * 16 + q * 4);
                f32x4 oa;
#pragma unroll
                for (int j = 0; j < 4; ++j) oa[j] = v[q * 4 + j] * rinv * fa[j];
                *(f32x4*)(xr + q * 4) = oa;
            }
        }
    }
#ifdef DBG_STOP
    if (IN(14)) {
        TIDS
        const size_t NO = (size_t)NTOK * DM;
        for (size_t i = (size_t)blk * 512 + tid; i < NO; i += (size_t)G * 512) {
            unsigned hsh = 0u;
            const size_t row = i >> 10, c = i & 1023;
#define RB(p, idx) ((unsigned)(p)[(idx)])
#define RF(p, idx) (__float_as_uint((p)[(idx)]))
#if DBG_STOP == 0
            hsh = RB(W_WinT, i % (2304 * 1024)) ^ RB(W_WoT, i % (1024 * 1024)) ^ RB(W_WuqT, i % (768 * 384)) ^ RB(W_WukvT, i % (1024 * 256)) ^ RB(W_Ws13T, i % (512 * 1024)) ^ RB(W_Ws2T, i % (1024 * 256)) ^ RB(W_WrT, i % (256 * 1024))
                ^ RF(W_mod, i % (8 * 6144)) ^ RF(W_ropecs, i % (4096 * 32)) ^ RF(W_biasT, i % (3 * 8 * 129));
#elif DBG_STOP == 1 || DBG_STOP == 7
            hsh = RB(W_hbuf, i);
#elif DBG_STOP == 2
            hsh = RB(W_proj, row * INCP + c) ^ (RB(W_proj, row * INCP + 1024 + c) << 1) ^ (c < 160 ? (RB(W_proj, row * INCP + 2048 + c) << 2) : 0u);
#elif DBG_STOP == 3
            hsh = RB(W_kvb, i) ^ (c < 768 ? (RB(W_qb, row * 768 + c) << 1) : 0u);
#elif DBG_STOP == 4
            if (c < 512) hsh = RB(W_bout, row * 512 + c); else if (DBG_SUB) { const size_t cc = c - 512; hsh = RB(W_aparts, row * 512 + cc) ^ (RB(W_aparts, ((size_t)NTOK + row) * 512 + cc) << 1) ^ (RB(W_aparts, ((size_t)2 * NTOK + row) * 512 + cc) << 2) ^ RF(W_lsebuf, row * 8 + (cc >> 6)) ^ (RF(W_lsebuf, ((size_t)NTOK + row) * 8 + (cc >> 6)) << 1) ^ (RF(W_lsebuf, ((size_t)2 * NTOK + row) * 8 + (cc >> 6)) << 2); }
#elif DBG_STOP == 5
            hsh = RB(W_mixb, i);
#elif DBG_STOP == 6
            hsh = RF(P.out, i);
#elif DBG_STOP == 8
            if (c < 256) hsh = RF(W_logits, row * 256 + c); else if (c < 512) hsh = RB(W_hdn, ((size_t)NASG + row) * EFF + (c - 256));
#elif DBG_STOP == 9
            if (c < 8) hsh = (unsigned)W_eidx[row * 8 + c]; else if (c < 16) hsh = RF(W_gate, row * 8 + (c - 8));
#elif DBG_STOP == 11
            { const int k = (int)(c >> 8); hsh = RB(W_hdn, (size_t)W_pos[row * 8 + k] * EFF + (c & 255)) ^ (RB(W_hdn, (size_t)W_pos[row * 8 + 4 + k] * EFF + (c & 255)) << 1); }
#elif DBG_STOP == 12
            { for (int k = 0; k < 8; ++k) hsh ^= RB(W_ybuf, (size_t)W_pos[row * 8 + k] * DM + c) << (k & 3); hsh ^= RB(W_ybuf, ((size_t)NASG + row) * DM + c); }
#endif
            P.out[i] = (float)(hsh & 0xFu);
        }
    }
#endif
#undef IN
#undef SEAM
}

extern "C" void kernel_launch(void* const* d_in, const int* in_sizes, int n_in, void* d_out, int out_size, void* d_ws, size_t ws_size, hipStream_t stream) {
    static int grid = 0;
    if (grid == 0) {
        if (n_in != 24 || ws_size < WS_END) { fprintf(stderr, "kernel_launch: need 24 inputs and %zu bytes of workspace (got %d, %zu)\n", (size_t)WS_END, n_in, ws_size); grid = -1; return; }
        int dev = 0, cus = 0, per_cu = 0;
        if (hipGetDevice(&dev) != hipSuccess || hipDeviceGetAttribute(&cus, hipDeviceAttributeMultiprocessorCount, dev) != hipSuccess) { grid = -1; return; }
        if (hipFuncSetAttribute((const void*)fwd_kernel, hipFuncAttributeMaxDynamicSharedMemorySize, LDS_BYTES) != hipSuccess) { fprintf(stderr, "kernel_launch: hipFuncSetAttribute failed\n"); grid = -1; return; }
        if (hipOccupancyMaxActiveBlocksPerMultiprocessor(&per_cu, (const void*)fwd_kernel, 512, LDS_BYTES) != hipSuccess || per_cu < 1) { fprintf(stderr, "kernel_launch: occupancy query says %d\n", per_cu); }
        (void)hipGetLastError();
        if (cus < 256) { fprintf(stderr, "kernel_launch: this kernel needs 256 CUs (device reports %d)\n", cus); grid = -1; return; }
        grid = 256;
    }
    if (grid < 0) return;
    (void)hipMemsetAsync((char*)d_ws + OFF_CTL, 0, CTL_BYTES, stream);
    Params p{};
    for (int i = 0; i < 24; ++i) p.in[i] = (const float*)d_in[i];
    p.out = (float*)d_out; p.ws = (unsigned char*)d_ws;
#if MK_N_LAUNCHES == 1
    p.ph_lo = 0; p.ph_hi = NPHASE;
    hipLaunchKernelGGL(fwd_kernel, dim3(grid), dim3(512), LDS_BYTES, stream, p);
#else
#ifdef DBG_STOP
    for (int k = 0; k <= DBG_STOP; ++k) { p.ph_lo = k; p.ph_hi = k + 1; hipLaunchKernelGGL(fwd_kernel, dim3(grid), dim3(512), LDS_BYTES, stream, p); }
    p.ph_lo = 14; p.ph_hi = 15; hipLaunchKernelGGL(fwd_kernel, dim3(grid), dim3(512), LDS_BYTES, stream, p);
#else
#ifndef DBL_MASK
#define DBL_MASK 0u
#endif
#ifndef DBL_FLAGS
#define DBL_FLAGS 0
#endif
    for (int k = 0; k < 14; ++k) { p.ph_lo = k; p.ph_hi = k + 1; hipLaunchKernelGGL(fwd_kernel, dim3(grid), dim3(512), LDS_BYTES, stream, p);
        if ((DBL_MASK >> k) & 1u) { p.flags = DBL_FLAGS; hipLaunchKernelGGL(fwd_kernel, dim3(grid), dim3(512), LDS_BYTES, stream, p); p.flags = 0; } }
#endif
#endif
}
```

```cpp
#include <hip/hip_runtime.h>
#include <stdint.h>
#include <stdio.h>

#ifndef MK_N_LAUNCHES
#define MK_N_LAUNCHES 1
#endif

#define DEVI __device__ __forceinline__
typedef unsigned short bf16_t;
typedef short bf16x8 __attribute__((ext_vector_type(8)));
typedef short s16x4 __attribute__((ext_vector_type(4)));
typedef float f32x4 __attribute__((ext_vector_type(4)));
typedef float f32x16 __attribute__((ext_vector_type(16)));
typedef unsigned u32x4 __attribute__((ext_vector_type(4)));
typedef unsigned u32x2 __attribute__((ext_vector_type(2)));

constexpr int NTOK = 32768, SEQ = 4096, DM = 1024;
constexpr int INC = 2208, INCP = 2304;
constexpr int QLORA = 384, KVLORA = 256;
constexpr int NEXP = 256, EFF = 256;
constexpr int NASG = NTOK * 8;
constexpr int NROWS = NASG + NTOK;
constexpr float EPS = 1e-6f;
constexpr float LOG2E = 1.4426950408889634f;

constexpr size_t MiB = 1u << 20;
constexpr size_t OFF_CTL = 0, CTL_BYTES = 1 * MiB;
constexpr size_t OFF_MOD = 1 * MiB;
constexpr size_t OFF_ROPE = OFF_MOD + 256 * 1024;
constexpr size_t OFF_BIAS = OFF_ROPE + 512 * 1024;
constexpr size_t OFF_WIN = 2 * MiB;
constexpr size_t OFF_WUQ = OFF_WIN + 4608 * 1024;
constexpr size_t OFF_WUKV = OFF_WUQ + 1 * MiB;
constexpr size_t OFF_WO = OFF_WUKV + 512 * 1024;
constexpr size_t OFF_WR = OFF_WO + 2 * MiB;
constexpr size_t OFF_WS13 = OFF_WR + 512 * 1024;
constexpr size_t OFF_WS2 = OFF_WS13 + 1 * MiB;
constexpr size_t OFF_H = 12 * MiB;
constexpr size_t OFF_LOGITS = OFF_H + 64 * MiB;
constexpr size_t OFF_EIDX = OFF_LOGITS + 32 * MiB;
constexpr size_t OFF_GATE = OFF_EIDX + 1 * MiB;
constexpr size_t OFF_RNK = OFF_GATE + 1 * MiB;
constexpr size_t OFF_POS = OFF_RNK + 1 * MiB;
constexpr size_t OFF_TOKS = OFF_POS + 1 * MiB;
constexpr size_t OFF_WTS = OFF_TOKS + 1 * MiB;
constexpr size_t OFF_SSQ = OFF_WTS + 1 * MiB;
constexpr size_t OFF_SCR = OFF_SSQ + 4 * MiB;
constexpr size_t SCR_PER_BLK = 1536 * 1024;
constexpr size_t OFF_R = OFF_SCR + 384 * MiB;
constexpr size_t OFF_XT = OFF_R + 452 * MiB;
constexpr size_t WS_END = OFF_XT + 64 * MiB;
constexpr size_t OFF_PROJ = OFF_R;
constexpr size_t OFF_QB = OFF_PROJ + 144 * MiB;
constexpr size_t OFF_KVB = OFF_QB + 48 * MiB;
constexpr size_t OFF_BOUT = OFF_KVB + 64 * MiB;
constexpr size_t OFF_APARTS = OFF_BOUT + 32 * MiB;
constexpr size_t OFF_LSE = OFF_APARTS + 96 * MiB;
constexpr size_t OFF_MIX = OFF_LSE + 4 * MiB;
constexpr size_t OFF_Y = OFF_R;
constexpr size_t OFF_HDN = OFF_R + 288 * MiB;
static_assert(OFF_MIX + 64 * MiB <= WS_END, "alias map");
constexpr int CNT_WORD0 = 8192, CNT_STRIDE = 16;

constexpr int LDS_STAGE = 0;
constexpr int LDS_ROWOFF = 131072;
constexpr int LDS_ROWSC = LDS_ROWOFF + 8192;
constexpr int LDS_MISC = LDS_ROWSC + 8192;
constexpr int LDS_START = LDS_MISC + 256;
constexpr int LDS_CNT = LDS_START + 1280;
constexpr int LDS_TB = LDS_CNT + 1280;
constexpr int LDS_BYTES = 155648;
static_assert(LDS_TB + 1280 <= LDS_BYTES, "lds map");

#define XB_TMO      128
#define XB_XCNT(j)  (256  + 64 * (j))
#define XB_XSUB(j)  (1280 + 64 * (j))
#define XB_XGEN(j)  (2304 + 64 * (j))
#define XB_TOP      3328
#define XB_TOPGEN   3392
#define XCD_BAR_WORDS 3456
#define XB_SPIN_CAP (1u << 22)
#define LAS __attribute__((address_space(3)))

__device__ __forceinline__ unsigned xb_ld(unsigned* p)              { return __hip_atomic_load(p, __ATOMIC_RELAXED, __HIP_MEMORY_SCOPE_AGENT); }
__device__ __forceinline__ unsigned xb_add(unsigned* p, unsigned v) { return __hip_atomic_fetch_add(p, v, __ATOMIC_RELAXED, __HIP_MEMORY_SCOPE_AGENT); }
__device__ __forceinline__ unsigned xb_xcc_id() { return (unsigned)__builtin_amdgcn_s_getreg((3 << 11) | 20) & 0xFu; }
#define XB_SPIN(cond, bar) do { unsigned _sp = 0; while (cond) { __builtin_amdgcn_s_sleep(1); \
    if ((++_sp & 255u) == 0u) { if (xb_ld(&(bar)[XB_TMO])) break; if (_sp > XB_SPIN_CAP) { atomicAdd(&(bar)[XB_TMO], 1u); break; } } } } while (0)

struct XcdBarrier { unsigned* bar; unsigned x; volatile LAS unsigned* st; };

__device__ __forceinline__ XcdBarrier xcd_barrier_post(unsigned* bar, volatile LAS unsigned* st, const bool leader) {
    XcdBarrier b; b.bar = bar; b.x = xb_xcc_id(); b.st = st;
    if (leader) (void)xb_add(&bar[XB_XCNT(b.x)], 1u);
    return b;
}
__device__ __forceinline__ void xcd_barrier_complete(unsigned* bar, unsigned x, unsigned& nloc, unsigned& nx) {
    const unsigned G = gridDim.x * gridDim.y * gridDim.z;
    unsigned sum, cnt, mine, sp = 0u;
    for (;;) {
        sum = 0u; cnt = 0u; mine = 0u;
#pragma unroll
        for (unsigned j = 0; j < 16; ++j) { const unsigned c = xb_ld(&bar[XB_XCNT(j)]); sum += c; cnt += (c > 0u) ? 1u : 0u; mine = (j == x) ? c : mine; }
        if (sum == G) break;
        __builtin_amdgcn_s_sleep(1);
        if ((++sp & 255u) == 0u) { if (xb_ld(&bar[XB_TMO])) break; if (sp > XB_SPIN_CAP) { atomicAdd(&bar[XB_TMO], 1u); break; } }
    }
    nloc = mine > 0u ? mine : 1u; nx = cnt > 0u ? cnt : 1u;
}
__device__ __forceinline__ void xcd_barrier(const XcdBarrier& b, const bool leader) {
    asm volatile("s_waitcnt vmcnt(0)" ::: "memory");
    __syncthreads();
    if (leader) {
        unsigned* bar = b.bar;
        __builtin_amdgcn_s_waitcnt(0);
        unsigned nloc = b.st[0], nx = b.st[1];
        if (nloc == 0u) { xcd_barrier_complete(bar, b.x, nloc, nx); b.st[0] = nloc; b.st[1] = nx; }
        const unsigned old = xb_add(&bar[XB_XSUB(b.x)], 1u);
        const unsigned gen = old / nloc;
        if (old + 1u == (gen + 1u) * nloc) {
            __builtin_amdgcn_fence(__ATOMIC_RELEASE, "agent");
            asm volatile("s_waitcnt vmcnt(0)" ::: "memory");
            const unsigned og = xb_add(&bar[XB_TOP], 1u);
            const unsigned tg = og / nx;
            if (og + 1u == (tg + 1u) * nx) xb_add(&bar[XB_TOPGEN], 1u);
            else XB_SPIN(xb_ld(&bar[XB_TOPGEN]) == tg, bar);
            __builtin_amdgcn_fence(__ATOMIC_ACQUIRE, "agent");
            xb_add(&bar[XB_XGEN(b.x)], 1u);
            asm volatile("s_waitcnt vmcnt(0)" ::: "memory");
        } else {
            XB_SPIN(xb_ld(&bar[XB_XGEN(b.x)]) == gen, bar);
            __builtin_amdgcn_fence(__ATOMIC_ACQUIRE, "agent");
            asm volatile("s_waitcnt vmcnt(0)" ::: "memory");
        }
    }
    __syncthreads();
}

DEVI float bf2f(bf16_t v) { return __uint_as_float(((unsigned)v) << 16); }
typedef float f32x2_t __attribute__((ext_vector_type(2)));
typedef __bf16 bf16x2_t __attribute__((ext_vector_type(2)));
DEVI unsigned pk2(float lo, float hi) { f32x2_t v = {lo, hi}; bf16x2_t b = __builtin_convertvector(v, bf16x2_t); return __builtin_bit_cast(unsigned, b); }
#define dppf(v, ctrl) __int_as_float(__builtin_amdgcn_update_dpp(0, __float_as_int(v), (ctrl), 0xf, 0xf, false))
#define dppi(v, ctrl) __builtin_amdgcn_update_dpp(0, (v), (ctrl), 0xf, 0xf, false)
#define DPP_X1 0xB1
#define DPP_X2 0x4E
#define DPP_HM 0x141
#define DPP_RM 0x140
DEVI float x16f(float v, float& o) { auto r = __builtin_amdgcn_permlane16_swap(__float_as_uint(v), __float_as_uint(v), false, false); o = __uint_as_float(r[1]); return __uint_as_float(r[0]); }
DEVI float x32f(float v, float& o) { auto r = __builtin_amdgcn_permlane32_swap(__float_as_uint(v), __float_as_uint(v), false, false); o = __uint_as_float(r[1]); return __uint_as_float(r[0]); }
DEVI float sum32(float v) { float o; const float a = x32f(v, o); return a + o; }
DEVI float max32(float v) { float o; const float a = x32f(v, o); return fmaxf(a, o); }
DEVI float wave_sum(float v) {
    v += dppf(v, DPP_X1); v += dppf(v, DPP_X2); v += dppf(v, DPP_HM); v += dppf(v, DPP_RM);
    { float o; const float a = x16f(v, o); v = a + o; }
    { float o; const float a = x32f(v, o); v = a + o; }
    return v;
}
DEVI int perm_slot(int cl) { return 16 * ((cl >> 2) & 1) + 4 * (cl >> 3) + (cl & 3); }
DEVI int perm_row(int n) { return (n & ~31) + perm_slot(n & 31); }
DEVI float ex2(float x) { return __builtin_amdgcn_exp2f(x); }
DEVI float siluf(float v) { return v * __builtin_amdgcn_rcpf(1.0f + __expf(-v)); }

namespace g8 {
constexpr int BK = 64, HALF = 128, HT = HALF * BK;
DEVI int lds_byte(int r, int c) { int st = (r >> 4) * 2 + (c >> 5), rr = r & 15, cc = c & 31, ob = rr * 64 + cc * 2; return st * 1024 + (ob ^ (((ob >> 9) & 1) << 5)); }
DEVI void stage_rc(int b, int& R, int& C) { int st = b / 1024, sb = b % 1024, swz = sb ^ (((sb >> 9) & 1) << 5); R = (st >> 1) * 16 + swz / 64; C = (st & 1) * 32 + (swz % 64) / 2; }
}

DEVI void g8_rc(int tid, int& R0, int& C0) { g8::stage_rc(tid * 16, R0, C0); }
DEVI void g8_voff_lin(unsigned (&v)[4], int ld, int tid) { int R0, C0; g8_rc(tid, R0, C0);
    v[0] = (unsigned)(R0 * ld + C0) * 2u; v[1] = (unsigned)((R0 + 64) * ld + C0) * 2u; v[2] = (unsigned)((R0 + 128) * ld + C0) * 2u; v[3] = (unsigned)((R0 + 192) * ld + C0) * 2u; }
DEVI void g8_voff_tab(unsigned (&v)[4], const LAS unsigned* tab, int tid) { int R0, C0; g8_rc(tid, R0, C0);
    v[0] = (tab[R0] + C0) * 2u; v[1] = (tab[R0 + 64] + C0) * 2u; v[2] = (tab[R0 + 128] + C0) * 2u; v[3] = (tab[R0 + 192] + C0) * 2u; }

template <class Epi>
DEVI void gemm_tile(LAS unsigned char* lds, const int tid_in, const char* Ab, const unsigned (&voffA_)[4], const char* Bb, const int K, const Epi& epi) {
    using namespace g8;
    constexpr int HTB = HALF * BK * 2;
    int tz = tid_in; asm volatile("" : "+v"(tz));
    int wid = tz >> 6, lane = tz & 63, wr = wid >> 2, wc = wid & 3, fr = lane & 15, fq = lane >> 4;
    unsigned voffA[4] = {voffA_[0], voffA_[1], voffA_[2], voffA_[3]};
    asm volatile("" : "+v"(voffA[0]), "+v"(voffA[1]), "+v"(voffA[2]), "+v"(voffA[3]));
    unsigned voffB[2];
    { int R0, C0; stage_rc(tz * 16, R0, C0); voffB[0] = (unsigned)(R0 * K + C0) * 2u; voffB[1] = (unsigned)((R0 + 64) * K + C0) * 2u; }
    const size_t kstep = (size_t)(BK * 2);
    const size_t hstepB = (size_t)HALF * K * 2;
    const unsigned ldsw = (unsigned)wid * 1024u;
    const int aoff = lds_byte(wr * 64 + fr, fq * 8), boff = lds_byte(wc * 32 + fr, fq * 8);
#define G8_SA(b, h) (((b) * 2 + (h)) * HTB)
#define G8_SB(b, h) ((4 + (b) * 2 + (h)) * HTB)
#define G8_GL(gp, lofs) __builtin_amdgcn_global_load_lds((const unsigned*)(gp), (LAS unsigned*)(lds + (lofs)), 16, 0, 0)
#define STAGE_A(b, h, kt) do { const char* g_ = Ab + (size_t)(kt) * kstep; G8_GL(g_ + voffA[(h) * 2], G8_SA(b, h) + ldsw); G8_GL(g_ + voffA[(h) * 2 + 1], G8_SA(b, h) + ldsw + 8192); } while (0)
#define STAGE_B(b, h, kt) do { const char* g_ = Bb + (size_t)(kt) * kstep + ((h) ? hstepB : 0); G8_GL(g_ + voffB[0], G8_SB(b, h) + ldsw); G8_GL(g_ + voffB[1], G8_SB(b, h) + ldsw + 8192); } while (0)
#define LDA(dst, b, h) do { _Pragma("unroll") for (int m = 0; m < 4; ++m) _Pragma("unroll") for (int k = 0; k < 2; ++k) dst[m][k] = *(const LAS bf16x8*)(lds + G8_SA(b, h) + aoff + m * 2048 + k * 1024); } while (0)
#define LDB(dst, b, h) do { _Pragma("unroll") for (int n = 0; n < 2; ++n) _Pragma("unroll") for (int k = 0; k < 2; ++k) dst[n][k] = *(const LAS bf16x8*)(lds + G8_SB(b, h) + boff + n * 2048 + k * 1024); } while (0)
#define MMA(ai, bj, Af, Bf) do { __builtin_amdgcn_s_setprio(1); \
    _Pragma("unroll") for (int m = 0; m < 4; ++m) _Pragma("unroll") for (int n = 0; n < 2; ++n) _Pragma("unroll") for (int k = 0; k < 2; ++k) \
      acc[ai][bj][m][n] = __builtin_amdgcn_mfma_f32_16x16x32_bf16(Bf[n][k], Af[m][k], acc[ai][bj][m][n], 0, 0, 0); \
    __builtin_amdgcn_s_setprio(0); } while (0)
#define WAIT_V(n) asm volatile("s_waitcnt vmcnt(" #n ")" ::: "memory")
#define WAIT_L(n) asm volatile("s_waitcnt lgkmcnt(" #n ")" ::: "memory")
#define BAR __builtin_amdgcn_s_barrier()
#define SCHED __builtin_amdgcn_sched_barrier(0)
    f32x4 acc[2][2][4][2];
#pragma unroll
    for (int a = 0; a < 2; ++a)
#pragma unroll
        for (int b = 0; b < 2; ++b)
#pragma unroll
            for (int m = 0; m < 4; ++m)
#pragma unroll
                for (int n = 0; n < 2; ++n) acc[a][b][m][n] = (f32x4){0.f, 0.f, 0.f, 0.f};
    bf16x8 At[4][2], B0[2][2], B1[2][2];
    const int nt = K / BK;
    STAGE_B(0, 0, 0); STAGE_A(0, 0, 0); STAGE_B(0, 1, 0); STAGE_A(0, 1, 0);
    if (wr == 1) BAR;
    WAIT_V(4); BAR;
    STAGE_B(1, 0, 1); STAGE_A(1, 0, 1); STAGE_B(1, 1, 1);
    WAIT_V(6); BAR;
#pragma unroll 1
    for (int t = 0; t < nt; t += 2) {
        const int t2 = (t == nt - 2) ? 0 : t + 2;
        const int t3 = t2 + 1;
        LDB(B0, 0, 0); SCHED; LDA(At, 0, 0); STAGE_A(1, 1, t + 1);
        WAIT_L(8); BAR; WAIT_L(0); MMA(0, 0, At, B0); BAR; SCHED;
        LDB(B1, 0, 1); STAGE_B(0, 0, t2);
        BAR; WAIT_L(0); MMA(0, 1, At, B1); BAR;
        LDA(At, 0, 1); STAGE_A(0, 0, t2);
        BAR; WAIT_L(0); MMA(1, 0, At, B0); BAR; SCHED;
        STAGE_B(0, 1, t2);
        WAIT_V(6); BAR; MMA(1, 1, At, B1); BAR;
        LDB(B0, 1, 0); SCHED; LDA(At, 1, 0); STAGE_A(0, 1, t2);
        WAIT_L(8); BAR; WAIT_L(0); MMA(0, 0, At, B0); BAR; SCHED;
        LDB(B1, 1, 1); STAGE_B(1, 0, t3);
        BAR; WAIT_L(0); MMA(0, 1, At, B1); BAR;
        LDA(At, 1, 1); STAGE_A(1, 0, t3);
        BAR; WAIT_L(0); MMA(1, 0, At, B0); BAR; SCHED;
        STAGE_B(1, 1, t3);
        WAIT_V(6); BAR; MMA(1, 1, At, B1); BAR;
    }
    WAIT_V(0);
    if (wr == 0) BAR;
    BAR;
    asm volatile("" : "+v"(tz)); wid = tz >> 6; lane = tz & 63; wr = wid >> 2; wc = wid & 3; fr = lane & 15; fq = lane >> 4;
    epi(acc, wr, wc, fr, fq);
#undef G8_SA
#undef G8_SB
#undef G8_GL
#undef STAGE_A
#undef STAGE_B
#undef LDA
#undef LDB
#undef MMA
}
struct GDesc { const char* Ab; const char* Bb; unsigned va0, va1, va2, va3; int i0, i1, i2; };
template <class Next, class Epi>
DEVI void gemm_stream(LAS unsigned char* lds, const int tid_in, const int K, Next& next, const Epi& epi) {
    using namespace g8;
    constexpr int HTB = HALF * BK * 2;
    int tz = tid_in; asm volatile("" : "+v"(tz));
    int wid = tz >> 6, lane = tz & 63, wr = wid >> 2, wc = wid & 3, fr = lane & 15, fq = lane >> 4;
    unsigned voffB[2];
    { int R0, C0; stage_rc(tz * 16, R0, C0); voffB[0] = (unsigned)(R0 * K + C0) * 2u; voffB[1] = (unsigned)((R0 + 64) * K + C0) * 2u; }
    const size_t kstep = (size_t)(BK * 2);
    const size_t hstepB = (size_t)HALF * K * 2;
    const unsigned ldsw = (unsigned)wid * 1024u;
    const int aoff = lds_byte(wr * 64 + fr, fq * 8), boff = lds_byte(wc * 32 + fr, fq * 8);
#define G8_SA(b, h) (((b) * 2 + (h)) * HTB)
#define G8_SB(b, h) ((4 + (b) * 2 + (h)) * HTB)
#define G8_GL(gp, lofs) __builtin_amdgcn_global_load_lds((const unsigned*)(gp), (LAS unsigned*)(lds + (lofs)), 16, 0, 0)
#define STG_A(b, h, gb, v0, v1) do { G8_GL((gb) + (v0), G8_SA(b, h) + ldsw); G8_GL((gb) + (v1), G8_SA(b, h) + ldsw + 8192); } while (0)
#define STG_B(b, h, gb) do { const char* g_ = (gb) + ((h) ? hstepB : 0); G8_GL(g_ + voffB[0], G8_SB(b, h) + ldsw); G8_GL(g_ + voffB[1], G8_SB(b, h) + ldsw + 8192); } while (0)
#define LDA(dst, b, h) do { _Pragma("unroll") for (int m = 0; m < 4; ++m) _Pragma("unroll") for (int k = 0; k < 2; ++k) dst[m][k] = *(const LAS bf16x8*)(lds + G8_SA(b, h) + aoff + m * 2048 + k * 1024); } while (0)
#define LDB(dst, b, h) do { _Pragma("unroll") for (int n = 0; n < 2; ++n) _Pragma("unroll") for (int k = 0; k < 2; ++k) dst[n][k] = *(const LAS bf16x8*)(lds + G8_SB(b, h) + boff + n * 2048 + k * 1024); } while (0)
#define MMA(ai, bj, Af, Bf) do { __builtin_amdgcn_s_setprio(1); \
    _Pragma("unroll") for (int m = 0; m < 4; ++m) _Pragma("unroll") for (int n = 0; n < 2; ++n) _Pragma("unroll") for (int k = 0; k < 2; ++k) \
      acc[ai][bj][m][n] = __builtin_amdgcn_mfma_f32_16x16x32_bf16(Bf[n][k], Af[m][k], acc[ai][bj][m][n], 0, 0, 0); \
    __builtin_amdgcn_s_setprio(0); } while (0)
#define ZACC() do { _Pragma("unroll") for (int a = 0; a < 2; ++a) _Pragma("unroll") for (int b = 0; b < 2; ++b) _Pragma("unroll") for (int m = 0; m < 4; ++m) _Pragma("unroll") for (int n = 0; n < 2; ++n) acc[a][b][m][n] = (f32x4){0.f, 0.f, 0.f, 0.f}; } while (0)
    GDesc cur, nxt;
    if (!next(0, cur)) return;
    nxt = cur;
    f32x4 acc[2][2][4][2];
    ZACC();
    bf16x8 At[4][2], B0[2][2], B1[2][2];
    const int nt = K / BK;
    STG_B(0, 0, cur.Bb); STG_A(0, 0, cur.Ab, cur.va0, cur.va1); STG_B(0, 1, cur.Bb); STG_A(0, 1, cur.Ab, cur.va2, cur.va3);
    if (wr == 1) BAR;
    WAIT_V(4); BAR;
    STG_B(1, 0, cur.Bb + kstep); STG_A(1, 0, cur.Ab + kstep, cur.va0, cur.va1); STG_B(1, 1, cur.Bb + kstep);
    WAIT_V(6); BAR;
    int ui = 0; bool has_next = false;
#pragma unroll 1
    for (;;) {
#pragma unroll 1
        for (int t = 0; t < nt; t += 2) {
            const bool last = (t == nt - 2);
            if (last) { has_next = next(ui + 1, nxt); if (!has_next) nxt = cur; }
            const char* a2 = last ? nxt.Ab : cur.Ab + (size_t)(t + 2) * kstep;
            const char* b2 = last ? nxt.Bb : cur.Bb + (size_t)(t + 2) * kstep;
            const unsigned s0 = last ? nxt.va0 : cur.va0, s1 = last ? nxt.va1 : cur.va1, s2 = last ? nxt.va2 : cur.va2, s3 = last ? nxt.va3 : cur.va3;
            LDB(B0, 0, 0); SCHED; LDA(At, 0, 0); STG_A(1, 1, cur.Ab + (size_t)(t + 1) * kstep, cur.va2, cur.va3);
            WAIT_L(8); BAR; WAIT_L(0); MMA(0, 0, At, B0); BAR; SCHED;
            LDB(B1, 0, 1); STG_B(0, 0, b2);
            BAR; WAIT_L(0); MMA(0, 1, At, B1); BAR;
            LDA(At, 0, 1); STG_A(0, 0, a2, s0, s1);
            BAR; WAIT_L(0); MMA(1, 0, At, B0); BAR; SCHED;
            STG_B(0, 1, b2);
            WAIT_V(6); BAR; MMA(1, 1, At, B1); BAR;
            LDB(B0, 1, 0); SCHED; LDA(At, 1, 0); STG_A(0, 1, a2, s2, s3);
            WAIT_L(8); BAR; WAIT_L(0); MMA(0, 0, At, B0); BAR; SCHED;
            LDB(B1, 1, 1); STG_B(1, 0, b2 + kstep);
            BAR; WAIT_L(0); MMA(0, 1, At, B1); BAR;
            LDA(At, 1, 1); STG_A(1, 0, a2 + kstep, s0, s1);
            BAR; WAIT_L(0); MMA(1, 0, At, B0); BAR; SCHED;
            STG_B(1, 1, b2 + kstep);
            WAIT_V(6); BAR; MMA(1, 1, At, B1); BAR;
        }
        {
            int tq = tz; asm volatile("" : "+v"(tq));
            const int wid_ = tq >> 6, lane_ = tq & 63;
            epi(acc, cur, wid_ >> 2, wid_ & 3, lane_ & 15, lane_ >> 4);
        }
        if (!has_next) break;
        ZACC();
        cur = nxt; ++ui;
    }
    WAIT_V(0);
    if (wr == 0) BAR;
    BAR;
#undef G8_SA
#undef G8_SB
#undef G8_GL
#undef STG_A
#undef STG_B
#undef LDA
#undef LDB
#undef MMA
#undef ZACC
}
#define EPI_FOREACH8(acc, wr, wc, fr, fq, ROW, COL8, V0, V1, ...) \
    _Pragma("unroll") for (int ai_ = 0; ai_ < 2; ++ai_) _Pragma("unroll") for (int m_ = 0; m_ < 4; ++m_) { const int ROW = ai_ * 128 + (wr) * 64 + m_ * 16 + (fr); \
    _Pragma("unroll") for (int bj_ = 0; bj_ < 2; ++bj_) { const int COL8 = bj_ * 128 + (wc) * 32 + (fq) * 8; const f32x4 V0 = acc[ai_][bj_][m_][0]; const f32x4 V1 = acc[ai_][bj_][m_][1]; __VA_ARGS__ } }
#define PK8(w, a, b) do { w.x = pk2(a[0], a[1]); w.y = pk2(a[2], a[3]); w.z = pk2(b[0], b[1]); w.w = pk2(b[2], b[3]); } while (0)

template <class SCol, class DRow, class KS, class NS>
DEVI void convert_T(bf16_t* __restrict__ dst, const float* __restrict__ src, int ld, int K, int NR, SCol scol, DRow drow, KS ks, NS ns, int wi, int nw) {
    const int k8n = K >> 3; const int items = NR * k8n;
    for (int it = wi; it < items; it += nw) {
        const int n = it % NR, k0 = (it / NR) << 3;
        const int sc = scol(n);
        float v[8];
#pragma unroll
        for (int j = 0; j < 8; ++j) v[j] = (sc >= 0) ? src[(size_t)(k0 + j) * ld + sc] * ks(k0 + j) : 0.f;
        const float s = ns(n);
        u32x4 w; w.x = pk2(v[0] * s, v[1] * s); w.y = pk2(v[2] * s, v[3] * s); w.z = pk2(v[4] * s, v[5] * s); w.w = pk2(v[6] * s, v[7] * s);
        *(u32x4*)(dst + (size_t)drow(n) * K + k0) = w;
    }
}
struct IdCol { DEVI int operator()(int n) const { return n; } };
struct OneK { DEVI float operator()(int) const { return 1.f; } };
struct VecK { const float* g; DEVI float operator()(int k) const { return g[k]; } };

template <int NB, bool PERM>
DEVI void convert_panel(bf16_t* __restrict__ dst, const float* __restrict__ src, const int ld, const int K, const int tid) {
    constexpr int N4 = NB / 4;
    const int items = (K >> 3) * N4;
#pragma unroll 1
    for (int it0 = tid; it0 < items; it0 += 1024) {
        f32x4 v[2][8];
#pragma unroll
        for (int u = 0; u < 2; ++u) {
            const int it = it0 + u * 512; const int n4 = it % N4, k8 = it / N4;
            const float* sp = src + (size_t)(k8 * 8) * ld + n4 * 4;
#pragma unroll
            for (int j = 0; j < 8; ++j) v[u][j] = *(const f32x4*)(sp + (size_t)j * ld);
        }
#pragma unroll
        for (int u = 0; u < 2; ++u) {
            const int it = it0 + u * 512; const int n4 = it % N4, k8 = it / N4;
#pragma unroll
            for (int c = 0; c < 4; ++c) {
                u32x4 w; w.x = pk2(v[u][0][c], v[u][1][c]); w.y = pk2(v[u][2][c], v[u][3][c]); w.z = pk2(v[u][4][c], v[u][5][c]); w.w = pk2(v[u][6][c], v[u][7][c]);
                const int n = n4 * 4 + c; const int dr = PERM ? ((n & ~31) + perm_slot(n & 31)) : n;
                *(u32x4*)(dst + (size_t)dr * K + k8 * 8) = w;
            }
        }
    }
}

template <int NB, bool PERM>
DEVI void convert_panel_lds(bf16_t* __restrict__ dst, const float* __restrict__ src, const int ld, const int K, const int tid, LAS unsigned char* lds) {
    constexpr int N4 = NB / 4;
    constexpr int K8C = 512 / N4;
    constexpr int KC = K8C * 8;
    constexpr int PITCH = KC * 2 + 8;
    constexpr int PPR = KC / 8;
    const int n4 = tid % N4, k8 = tid / N4;
    const float* sp = src + (size_t)(k8 * 8) * ld + n4 * 4;
    const int nchunk = K / KC;
    f32x4 va[8], vb[8], vc[8];
#define CPL_LOAD(V, c) do { const float* q_ = sp + (size_t)(c) * KC * ld; _Pragma("unroll") for (int j = 0; j < 8; ++j) V[j] = *(const f32x4*)(q_ + (size_t)j * ld); } while (0)
#define CPL_PROC(V, c) do { \
        _Pragma("unroll") for (int cc = 0; cc < 4; ++cc) { \
            u32x2 lo, hi; lo.x = pk2(V[0][cc], V[1][cc]); lo.y = pk2(V[2][cc], V[3][cc]); hi.x = pk2(V[4][cc], V[5][cc]); hi.y = pk2(V[6][cc], V[7][cc]); \
            LAS unsigned char* wp = lds + (n4 * 4 + cc) * PITCH + k8 * 16; \
            *(LAS u32x2*)wp = lo; *(LAS u32x2*)(wp + 8) = hi; } \
        __syncthreads(); \
        _Pragma("unroll") for (int q = 0; q < 4; ++q) { \
            const int p = tid + 512 * q; const int row = p / PPR, pc = p % PPR; \
            const LAS unsigned char* rp = lds + row * PITCH + pc * 16; \
            const u32x2 a = *(const LAS u32x2*)rp, b = *(const LAS u32x2*)(rp + 8); \
            const int dr = PERM ? ((row & ~31) + perm_slot(row & 31)) : row; \
            u32x4 w; w.x = a.x; w.y = a.y; w.z = b.x; w.w = b.y; \
            *(u32x4*)(dst + (size_t)dr * K + (c) * KC + pc * 8) = w; } \
        __syncthreads(); } while (0)
    CPL_LOAD(va, 0); if (nchunk > 1) CPL_LOAD(vb, 1); if (nchunk > 2) CPL_LOAD(vc, 2);
#pragma unroll 1
    for (int c = 0; c < nchunk; c += 3) {
        CPL_PROC(va, c); if (c + 3 < nchunk) CPL_LOAD(va, c + 3);
        if (c + 1 < nchunk) { CPL_PROC(vb, c + 1); if (c + 4 < nchunk) CPL_LOAD(vb, c + 4); }
        if (c + 2 < nchunk) { CPL_PROC(vc, c + 2); if (c + 5 < nchunk) CPL_LOAD(vc, c + 5); }
    }
#undef CPL_LOAD
#undef CPL_PROC
}

struct Params {
    const float* in[24];
    float* out;
    unsigned char* ws;
    int ph_lo, ph_hi;
    int flags, pad;
};
enum { I_X = 0, I_C, I_WADA, I_BADA, I_N1G, I_WIN, I_QNG, I_WUQ, I_KVNG, I_WUKV, I_REL, I_AOG, I_BOG, I_WO, I_N2G, I_WR, I_EB, I_W1, I_W3, I_W2, I_WS1, I_WS3, I_WS2, I_FG };
constexpr int NPHASE = 15;

#define W_x (P.in[I_X])
#define W_mod ((float*)(ws + OFF_MOD))
#define W_ropecs ((float*)(ws + OFF_ROPE))
#define W_biasT ((float*)(ws + OFF_BIAS))
#define W_WinT ((bf16_t*)(ws + OFF_WIN))
#define W_WuqT ((bf16_t*)(ws + OFF_WUQ))
#define W_WukvT ((bf16_t*)(ws + OFF_WUKV))
#define W_WoT ((bf16_t*)(ws + OFF_WO))
#define W_WrT ((bf16_t*)(ws + OFF_WR))
#define W_Ws13T ((bf16_t*)(ws + OFF_WS13))
#define W_Ws2T ((bf16_t*)(ws + OFF_WS2))
#define W_hbuf ((bf16_t*)(ws + OFF_H))
#define W_logits ((float*)(ws + OFF_LOGITS))
#define W_eidx ((int*)(ws + OFF_EIDX))
#define W_gate ((float*)(ws + OFF_GATE))
#define W_rnk ((int*)(ws + OFF_RNK))
#define W_pos ((int*)(ws + OFF_POS))
#define W_toks ((int*)(ws + OFF_TOKS))
#define W_wts ((float*)(ws + OFF_WTS))
#define W_ssq ((float*)(ws + OFF_SSQ))
#define W_scr ((bf16_t*)(ws + OFF_SCR + (size_t)blk * SCR_PER_BLK))
#define W_hdn ((bf16_t*)(ws + OFF_HDN))
#define W_ybuf ((bf16_t*)(ws + OFF_Y))
#define W_y8 ((unsigned char*)(ws + OFF_Y))
#define W_proj ((bf16_t*)(ws + OFF_PROJ))
#define W_qb ((bf16_t*)(ws + OFF_QB))
#define W_kvb ((bf16_t*)(ws + OFF_KVB))
#define W_bout ((bf16_t*)(ws + OFF_BOUT))
#define W_aparts ((bf16_t*)(ws + OFF_APARTS))
#define W_lsebuf ((float*)(ws + OFF_LSE))
#define W_mixb ((bf16_t*)(ws + OFF_MIX))
#define W_xt ((bf16_t*)(ws + OFF_XT))

__global__ void __launch_bounds__(512, 2) fwd_kernel(Params P) {
    extern __shared__ __attribute__((aligned(16))) unsigned char lds[];
    const int blk = blockIdx.x, G = gridDim.x;
    const int wave_s = __builtin_amdgcn_readfirstlane((int)threadIdx.x >> 6);
#define TIDS0 int tid; asm volatile("v_mbcnt_lo_u32_b32 %0, -1, 0\n\tv_mbcnt_hi_u32_b32 %0, -1, %0" : "=v"(tid)); tid += wave_s * 64;
    const int vblk = (G % 8 == 0) ? (blk % 8) * (G / 8) + blk / 8 : blk;
    unsigned char* ws = P.ws;
    unsigned* ctl = (unsigned*)(ws + OFF_CTL);
    { TIDS0 if (tid < 64) ((LAS unsigned*)(lds + LDS_MISC))[tid] = 0u; }
    __syncthreads();
    XcdBarrier bar; bar.bar = ctl; bar.x = 0; bar.st = nullptr;
    if (MK_N_LAUNCHES == 1) { TIDS0 bar = xcd_barrier_post(ctl, (volatile LAS unsigned*)(lds + LDS_MISC), tid == 0); }
#ifndef PH_MASK
#define PH_MASK 0xffffffffu
#endif
#define TIDS int tid; asm volatile("v_mbcnt_lo_u32_b32 %0, -1, 0\n\tv_mbcnt_hi_u32_b32 %0, -1, %0" : "=v"(tid)); tid += wave_s * 64; const int lane = tid & 63; const int wave = wave_s; (void)lane; (void)wave;
#define IN(k) ((((PH_MASK) >> (k)) & 1u) && P.ph_lo <= (k) && (k) < P.ph_hi)
#define SEAM(k) do { if (MK_N_LAUNCHES == 1 && IN(k) && IN((k) + 1)) { TIDS0 xcd_barrier(bar, tid == 0); } } while (0)

    unsigned* cntg = ctl + CNT_WORD0;
    LAS unsigned* rowoff = (LAS unsigned*)(lds + LDS_ROWOFF);
    LAS float* rowsc = (LAS float*)(lds + LDS_ROWSC);
    LAS int* startL = (LAS int*)(lds + LDS_START);
    LAS int* cntL = (LAS int*)(lds + LDS_CNT);
    LAS int* tbL = (LAS int*)(lds + LDS_TB);
    LAS int* itemD = (LAS int*)(lds + LDS_MISC + 64);
    char* stage = (char*)lds + LDS_STAGE;
    LAS unsigned char* ldsL = (LAS unsigned char*)lds;

    if (IN(0)) {
        TIDS
        {
            float* sc = (float*)(lds);
            float* red = (float*)(lds + 32768);
            const float* c = P.in[I_C];
            for (int i = tid; i < 8192; i += 512) sc[i] = siluf(c[i]);
            __syncthreads();
            for (int cb = blk; cb < 256; cb += G) {
                const int cj = tid & 31, kg = tid >> 5;
                float a0 = 0, a1 = 0, a2 = 0, a3 = 0, a4 = 0, a5 = 0, a6 = 0, a7 = 0;
                if (cj < 24) {
                    const float* w = P.in[I_WADA] + cb * 24 + cj;
                    for (int k = kg * 64; k < kg * 64 + 64; ++k) {
                        const float wv = w[(size_t)k * 6144];
                        a0 += sc[k] * wv; a1 += sc[1024 + k] * wv; a2 += sc[2048 + k] * wv; a3 += sc[3072 + k] * wv;
                        a4 += sc[4096 + k] * wv; a5 += sc[5120 + k] * wv; a6 += sc[6144 + k] * wv; a7 += sc[7168 + k] * wv;
                    }
                }
                float* rp = red + (kg * 8) * 32 + cj;
                rp[0] = a0; rp[32] = a1; rp[64] = a2; rp[96] = a3; rp[128] = a4; rp[160] = a5; rp[192] = a6; rp[224] = a7;
                __syncthreads();
                if (tid < 256) {
                    const int b = tid >> 5, j = tid & 31;
                    if (j < 24) {
                        float s = 0.f;
                        for (int g = 0; g < 16; ++g) s += red[(g * 8 + b) * 32 + j];
                        const int col = cb * 24 + j;
                        W_mod[b * 6144 + col] = s + P.in[I_BADA][col];
                    }
                }
                __syncthreads();
            }
        }
        {
            for (int idx = blk * 512 + tid; idx < 4096 * 16; idx += G * 512) {
                const int s = idx >> 4, i = idx & 15;
                double inv = 1.0; for (int j = 0; j < i; ++j) inv *= 0.5623413251903491;
                const float invf = (float)inv;
                const float angf = (float)s * invf;
                const double xa = (double)angf;
                const double nrev = __builtin_rint(xa * 0.15915494309189535);
                const double r = xa - nrev * 6.283185307179586;
                const double r2 = r * r;
                double ts = r, ss = r, tc = 1.0, cc = 1.0;
#pragma unroll
                for (int n = 1; n <= 14; ++n) {
                    ts *= -r2 / (double)((2 * n) * (2 * n + 1)); ss += ts;
                    tc *= -r2 / (double)((2 * n - 1) * (2 * n)); cc += tc;
                }
                W_ropecs[idx * 2] = (float)cc; W_ropecs[idx * 2 + 1] = (float)ss;
            }
        }
        {
            for (int idx = blk * 512 + tid; idx < 3 * 8 * 129; idx += G * 512) {
                const int j = idx % 129, hh = (idx / 129) % 8, p = idx / (129 * 8);
                const int dil = (p == 0) ? 1 : (p == 1 ? 4 : 16);
                const int rel = (j - 64) * dil;
                const int n = rel < 0 ? -rel : rel;
                const float nf = (float)(n > 1 ? n : 1);
                int large = 8 + (int)(__logf(nf * 0.125f) / 4.852030263919617f * 8.0f);
                large = large < 15 ? large : 15;
                const int bucket = (rel > 0 ? 16 : 0) + (n < 8 ? n : large);
                W_biasT[idx] = P.in[I_REL][bucket * 8 + hh] * LOG2E;
            }
        }
        {
            const int wi = blk * 512 + tid, nw = G * 512;
            convert_T(W_WinT, P.in[I_WIN], INC, 1024, INCP,
                      [](int n) { if (n >= INC) return -1; if (n < 2176) return n; const int i = n - 2176; return 2176 + ((i & 1) ? 16 : 0) + (i >> 1); },
                      [](int n) { return perm_row(n); }, OneK{}, [](int n) { return n < 512 ? 0.125f * LOG2E : 1.0f; }, wi, nw);
            convert_T(W_WuqT, P.in[I_WUQ], 768, 384, 768,
                      [](int n) { if (n < 512) return (n >> 6) * 96 + (n & 63); const int hh = (n - 512) >> 5, i = n & 31; return hh * 96 + 64 + ((i & 1) ? 16 : 0) + (i >> 1); },
                      [](int n) { return perm_row(n); }, VecK{P.in[I_QNG]}, [](int) { return 0.10206207261596577f * LOG2E; }, wi, nw);
            convert_T(W_WukvT, P.in[I_WUKV], 1024, 256, 1024, IdCol{}, [](int n) { return perm_row(n); }, VecK{P.in[I_KVNG]}, [](int) { return 1.f; }, wi, nw);
            {
                const float* ag = P.in[I_AOG]; const float* bg = P.in[I_BOG];
                convert_T(W_WoT, P.in[I_WO], 1024, 1024, 1024, IdCol{}, [](int n) { return perm_row(n); }, [=](int k) { return k < 512 ? ag[k] : bg[k - 512]; }, [](int) { return 1.f; }, wi, nw);
            }
            convert_T(W_WrT, P.in[I_WR], 256, 1024, 256, IdCol{}, [](int n) { return perm_row(n); }, OneK{}, [](int) { return 1.f; }, wi, nw);
            convert_T(W_Ws13T, P.in[I_WS1], 256, 1024, 256, IdCol{}, [](int n) { return perm_row((n >> 7) * 256 + (n & 127)); }, OneK{}, [](int) { return 1.f; }, wi, nw);
            convert_T(W_Ws13T, P.in[I_WS3], 256, 1024, 256, IdCol{}, [](int n) { return perm_row((n >> 7) * 256 + 128 + (n & 127)); }, OneK{}, [](int) { return 1.f; }, wi, nw);
            convert_T(W_Ws2T, P.in[I_WS2], 1024, 256, 1024, IdCol{}, [](int n) { return perm_row(n); }, OneK{}, [](int) { return 1.f; }, wi, nw);
        }
    }
    SEAM(0);

    if (IN(1)) {
        TIDS
        const float* g = P.in[I_N1G];
        for (int row = blk * 8 + wave; row < NTOK; row += G * 8) {
            const int b = row >> 12;
            const float* xr = W_x + (size_t)row * DM;
            f32x4 v[4]; float ss = 0.f;
#pragma unroll
            for (int i = 0; i < 4; ++i) { v[i] = *(const f32x4*)(xr + i * 256 + lane * 4); ss += v[i][0] * v[i][0] + v[i][1] * v[i][1] + v[i][2] * v[i][2] + v[i][3] * v[i][3]; }
            ss = wave_sum(ss);
            const float rinv = rsqrtf(ss * (1.0f / 1024.0f) + EPS);
            const float* mb = W_mod + b * 6144;
#pragma unroll
            for (int i = 0; i < 4; ++i) {
                const int c = i * 256 + lane * 4;
                const f32x4 gg = *(const f32x4*)(g + c), sh = *(const f32x4*)(mb + c), sc = *(const f32x4*)(mb + 1024 + c);
                float o[4];
#pragma unroll
                for (int j = 0; j < 4; ++j) o[j] = v[i][j] * rinv * gg[j] * (1.0f + sc[j]) + sh[j];
                u32x2 w; w.x = pk2(o[0], o[1]); w.y = pk2(o[2], o[3]);
                *(u32x2*)(W_hbuf + (size_t)row * DM + c) = w;
            }
        }
    }
    SEAM(1);

    if (IN(2)) {
        TIDS
        unsigned vl_[4]; g8_voff_lin(vl_, DM, tid);
        auto nextf = [&](int i, GDesc& d) {
            const int ul = i * 32 + (vblk & 31); if (ul >= 144 || vblk >= 256) return false;
            const int pm = (vblk >> 5) * 16 + ul / 9, pn = ul % 9;
            d.Ab = (const char*)(W_hbuf + (size_t)pm * 256 * DM); d.Bb = (const char*)(W_WinT + (size_t)pn * 256 * DM);
            d.va0 = vl_[0]; d.va1 = vl_[1]; d.va2 = vl_[2]; d.va3 = vl_[3]; d.i0 = pm; d.i1 = pn; d.i2 = 0; return true;
        };
        auto epi = [&](const f32x4 (&acc)[2][2][4][2], const GDesc& d, int wr, int wc, int fr, int fq) {
            const int pm = d.i0, pn = d.i1;
            if (pn < 8) {
                EPI_FOREACH8(acc, wr, wc, fr, fq, r, c8, v0, v1, {
                    u32x4 w; PK8(w, v0, v1);
                    *(u32x4*)(W_proj + (size_t)(pm * 256 + r) * INCP + pn * 256 + c8) = w;
                })
            } else {
                EPI_FOREACH8(acc, wr, wc, fr, fq, r, c8, v0, v1, {
                    const int row = pm * 256 + r;
                    if (c8 < 160) {
                        f32x4 o0 = v0, o1 = v1;
                        if (c8 >= 128) {
                            const int i = (c8 - 128) >> 1; const int s = row & 4095;
                            const f32x4 ca = *(const f32x4*)(W_ropecs + (s * 16 + i) * 2), cb = *(const f32x4*)(W_ropecs + (s * 16 + i) * 2 + 4);
                            o0[0] = v0[0] * ca[0] - v0[1] * ca[1]; o0[1] = v0[1] * ca[0] + v0[0] * ca[1];
                            o0[2] = v0[2] * ca[2] - v0[3] * ca[3]; o0[3] = v0[3] * ca[2] + v0[2] * ca[3];
                            o1[0] = v1[0] * cb[0] - v1[1] * cb[1]; o1[1] = v1[1] * cb[0] + v1[0] * cb[1];
                            o1[2] = v1[2] * cb[2] - v1[3] * cb[3]; o1[3] = v1[3] * cb[2] + v1[2] * cb[3];
                        }
                        u32x4 w; PK8(w, o0, o1);
                        *(u32x4*)(W_proj + (size_t)row * INCP + 2048 + c8) = w;
                    }
                })
            }
            if (pn >= 6) {
#pragma unroll
                for (int ai = 0; ai < 2; ++ai)
#pragma unroll
                    for (int m = 0; m < 4; ++m)
#pragma unroll
                        for (int bj = 0; bj < 2; ++bj) {
                            const f32x4 a = acc[ai][bj][m][0], b = acc[ai][bj][m][1];
                            float ss = a[0] * a[0] + a[1] * a[1] + a[2] * a[2] + a[3] * a[3] + b[0] * b[0] + b[1] * b[1] + b[2] * b[2] + b[3] * b[3];
                            { float o; const float t = x16f(ss, o); ss = t + o; }
                            { float o; const float t = x32f(ss, o); ss = t + o; }
                            if (fq == 0) W_ssq[(size_t)(pm * 256 + ai * 128 + wr * 64 + m * 16 + fr) * 24 + (pn - 6) * 8 + bj * 4 + wc] = ss;
                        }
            }
        };
        gemm_stream(ldsL, tid, DM, nextf, epi);
        if ((vblk & 31) >= 16) {
            TIDS
#pragma unroll 1
            for (int q = 0; q < 2; ++q) {
                const int uu = blk + q * G;
                const int e = (G == 256) ? ((vblk & ~3) + q) : (uu >> 2), pn = (G == 256) ? (vblk & 3) : (uu & 3);
                __syncthreads();
                if (uu < 1024) convert_panel_lds<256, true>(W_scr + (size_t)2 * 256 * 1024 + (size_t)q * 256 * 256, P.in[I_W2] + (size_t)e * 256 * 1024 + pn * 256, 1024, 256, tid, ldsL);
            }
        }
    }
    SEAM(2);

    if (IN(3)) {
        {
            TIDS
            const int xb = (vblk >> 5) * 16, lb = vblk & 31;
            __syncthreads();
            for (int j = 0; j < 2; ++j) { const int ul = j * 32 + lb; if (ul < 48 && tid < 256) {
                const float* sp = W_ssq + (size_t)((xb + ul / 3) * 256 + tid) * 24;
                const f32x4 s0 = *(const f32x4*)sp, s1 = *(const f32x4*)(sp + 4), s2 = *(const f32x4*)(sp + 8);
                const float ss = ((s0[0] + s0[1]) + (s0[2] + s0[3])) + ((s1[0] + s1[1]) + (s1[2] + s1[3])) + ((s2[0] + s2[1]) + (s2[2] + s2[3]));
                rowsc[j * 256 + tid] = rsqrtf(ss * (1.0f / 384.0f) + EPS); } }
            __syncthreads();
            unsigned vl_[4]; g8_voff_lin(vl_, INCP, tid);
            auto nextf = [&](int i, GDesc& d) {
                const int ul = i * 32 + lb; if (ul >= 48 || vblk >= 256) return false;
                const int pm = xb + ul / 3, pn = ul % 3;
                d.Ab = (const char*)(W_proj + (size_t)pm * 256 * INCP + 1536); d.Bb = (const char*)(W_WuqT + (size_t)pn * 256 * QLORA);
                d.va0 = vl_[0]; d.va1 = vl_[1]; d.va2 = vl_[2]; d.va3 = vl_[3]; d.i0 = pm * 4 + pn; d.i1 = i; d.i2 = 0; return true;
            };
            auto epi = [&](const f32x4 (&acc)[2][2][4][2], const GDesc& d, int wr, int wc, int fr, int fq) {
                const int pm = d.i0 >> 2, pn = d.i0 & 3, sl = d.i1 * 256;
                if (pn < 2) {
                    EPI_FOREACH8(acc, wr, wc, fr, fq, r, c8, v0, v1, {
                        const float rs = rowsc[sl + r];
                        const f32x4 a = v0 * rs, b = v1 * rs;
                        u32x4 w; PK8(w, a, b);
                        *(u32x4*)(W_qb + (size_t)(pm * 256 + r) * 768 + pn * 256 + c8) = w;
                    })
                } else {
                    EPI_FOREACH8(acc, wr, wc, fr, fq, r, c8, v0, v1, {
                        const int row = pm * 256 + r;
                        const float rs = rowsc[sl + r];
                        const int i = (c8 & 31) >> 1; const int s = row & 4095;
                        const f32x4 ca = *(const f32x4*)(W_ropecs + (s * 16 + i) * 2), cb = *(const f32x4*)(W_ropecs + (s * 16 + i) * 2 + 4);
                        const f32x4 t0 = v0 * rs, t1 = v1 * rs;
                        f32x4 o0, o1;
                        o0[0] = t0[0] * ca[0] - t0[1] * ca[1]; o0[1] = t0[1] * ca[0] + t0[0] * ca[1];
                        o0[2] = t0[2] * ca[2] - t0[3] * ca[3]; o0[3] = t0[3] * ca[2] + t0[2] * ca[3];
                        o1[0] = t1[0] * cb[0] - t1[1] * cb[1]; o1[1] = t1[1] * cb[0] + t1[0] * cb[1];
                        o1[2] = t1[2] * cb[2] - t1[3] * cb[3]; o1[3] = t1[3] * cb[2] + t1[2] * cb[3];
                        u32x4 w; PK8(w, o0, o1);
                        *(u32x4*)(W_qb + (size_t)row * 768 + 512 + c8) = w;
                    })
                }
            };
            gemm_stream(ldsL, tid, QLORA, nextf, epi);
        }
        {
            TIDS
            const int xb = (vblk >> 5) * 16, lb = vblk & 31;
            __syncthreads();
            for (int j = 0; j < 2; ++j) { const int ul = j * 32 + lb; if (tid < 256) {
                const float* sp = W_ssq + (size_t)((xb + ul / 4) * 256 + tid) * 24 + 12;
                const f32x4 s0 = *(const f32x4*)sp, s1 = *(const f32x4*)(sp + 4);
                const float ss = ((s0[0] + s0[1]) + (s0[2] + s0[3])) + ((s1[0] + s1[1]) + (s1[2] + s1[3]));
                rowsc[j * 256 + tid] = rsqrtf(ss * (1.0f / 256.0f) + EPS); } }
            __syncthreads();
            unsigned vl_[4]; g8_voff_lin(vl_, INCP, tid);
            auto nextf = [&](int i, GDesc& d) {
                const int ul = i * 32 + lb; if (ul >= 64 || vblk >= 256) return false;
                const int pm = xb + ul / 4, pn = ul % 4;
                d.Ab = (const char*)(W_proj + (size_t)pm * 256 * INCP + 1920); d.Bb = (const char*)(W_WukvT + (size_t)pn * 256 * KVLORA);
                d.va0 = vl_[0]; d.va1 = vl_[1]; d.va2 = vl_[2]; d.va3 = vl_[3]; d.i0 = pm * 4 + pn; d.i1 = i; d.i2 = 0; return true;
            };
            auto epi = [&](const f32x4 (&acc)[2][2][4][2], const GDesc& d, int wr, int wc, int fr, int fq) {
                const int pm = d.i0 >> 2, pn = d.i0 & 3, sl = d.i1 * 256;
                EPI_FOREACH8(acc, wr, wc, fr, fq, r, c8, v0, v1, {
                    const float rs = rowsc[sl + r];
                    const f32x4 a = v0 * rs, b = v1 * rs;
                    u32x4 w; PK8(w, a, b);
                    *(u32x4*)(W_kvb + (size_t)(pm * 256 + r) * 1024 + pn * 256 + c8) = w;
                })
            };
            gemm_stream(ldsL, tid, KVLORA, nextf, epi);
        }
    }
    SEAM(3);

    if (IN(4)) {
        for (int ui = 0; ui < ((P.flags & 4) ? 0 : 4); ++ui) {
            TIDS
            const int r32 = lane & 31, hh = lane >> 5;
            if (vblk >= 256) break;
            const int qblk = vblk & 15, bh = (vblk >> 5) * 8 + ui * 2 + ((vblk >> 4) & 1), h = bh & 7, b = bh >> 3;
            const size_t tok0 = (size_t)b * SEQ;
            bf16x8 qf[6];
            {
                const size_t tq = tok0 + qblk * 256 + wave * 32 + r32;
#pragma unroll
                for (int d0 = 0; d0 < 6; ++d0) qf[d0] = *(const bf16x8*)(W_qb + tq * 768 + (d0 < 4 ? h * 64 + d0 * 16 : 512 + h * 32 + (d0 - 4) * 16) + hh * 8);
            }
            f32x16 o0 = {}, o1 = {};
            f32x16 mneg = {};
            float m_run = 0.f, l_run = 0.f;
            const int skey = tid >> 3, sch = tid & 7;
            const bf16_t* kn_src = W_kvb + (tok0 + skey) * 1024 + h * 128 + sch * 8;
            const int pkey = tid >> 2, pch = tid & 3;
            const bf16_t* kp_src = W_proj + (tok0 + pkey) * INCP + 2176 + pch * 8;
            constexpr int KBUF = 12 * 2048, VBUF = 2 * 8192, BUFB = KBUF + VBUF;
            const int k_dst = sch * 2048 + ((skey ^ sch) * 16);
            const int kp_dst = (8 + pch) * 2048 + ((pkey ^ pch) * 16);
            const int v_dst = KBUF + (sch >> 2) * 8192 + skey * 64 + (sch & 3) * 16;
            const int kfo = hh * 2048;
            const int vfo = KBUF + (4 * hh + ((lane & 15) >> 2)) * 64 + ((lane >> 4) & 1) * 32 + (lane & 3) * 8;
            __syncthreads();
            {
                const u32x4 k0 = *(const u32x4*)kn_src, v0 = *(const u32x4*)(kn_src + 64);
                const u32x4 k1 = *(const u32x4*)(kn_src + 64 * 1024), v1 = *(const u32x4*)(kn_src + 64 * 1024 + 64);
                const u32x4 pr = *(const u32x4*)kp_src;
                *(LAS u32x4*)(ldsL + k_dst) = k0; *(LAS u32x4*)(ldsL + k_dst + 1024) = k1;
                *(LAS u32x4*)(ldsL + v_dst) = v0; *(LAS u32x4*)(ldsL + v_dst + 4096) = v1;
                *(LAS u32x4*)(ldsL + kp_dst) = pr;
            }
            __syncthreads();
#pragma unroll 1
            for (int t = 0; t < 32; ++t) {
                const int cur = t & 1;
                const int tn = (t + 1 < 32) ? t + 1 : t;
                const bf16_t* ks = kn_src + (size_t)tn * 128 * 1024;
                const u32x4 nk0 = *(const u32x4*)ks, nv0 = *(const u32x4*)(ks + 64);
                const u32x4 nk1 = *(const u32x4*)(ks + 64 * 1024), nv1 = *(const u32x4*)(ks + 64 * 1024 + 64);
                const u32x4 npr = *(const u32x4*)(kp_src + (size_t)tn * 128 * INCP);
                f32x16 sc[2][2];
#pragma unroll
                for (int sub = 0; sub < 2; ++sub) {
                    const int kb = cur * BUFB + kfo + sub * 1024;
#pragma unroll
                    for (int d0 = 0; d0 < 6; ++d0) {
                        const int sw = (2 * d0 + hh) & 7;
                        const bf16x8 k0 = *(const LAS bf16x8*)(ldsL + kb + d0 * 4096 + ((r32 ^ sw) * 16));
                        const bf16x8 k1 = *(const LAS bf16x8*)(ldsL + kb + d0 * 4096 + (((32 + r32) ^ sw) * 16));
                        if (d0 == 0) { sc[sub][0] = __builtin_amdgcn_mfma_f32_32x32x16_bf16(k0, qf[0], mneg, 0, 0, 0); sc[sub][1] = __builtin_amdgcn_mfma_f32_32x32x16_bf16(k1, qf[0], mneg, 0, 0, 0); }
                        else { sc[sub][0] = __builtin_amdgcn_mfma_f32_32x32x16_bf16(k0, qf[d0], sc[sub][0], 0, 0, 0); sc[sub][1] = __builtin_amdgcn_mfma_f32_32x32x16_bf16(k1, qf[d0], sc[sub][1], 0, 0, 0); }
                    }
                }
#pragma unroll
                for (int sub = 0; sub < 2; ++sub) {
                    const int vb = cur * BUFB + vfo + sub * 4096;
                    f32x16& s0 = sc[sub][0]; f32x16& s1 = sc[sub][1];
                    float mx = fmaxf(s0[0], s1[0]);
#pragma unroll
                    for (int i = 1; i < 16; ++i) mx = fmaxf(mx, fmaxf(s0[i], s1[i]));
                    mx = max32(mx);
                    const bool first = (t == 0 && sub == 0);
                    if (first || __builtin_amdgcn_ballot_w64(mx > 8.0f) != 0ull) {
                        const float d = first ? mx : fmaxf(mx, 0.f);
                        const float alpha = first ? 0.f : ex2(-d);
                        m_run += d; l_run *= alpha;
#pragma unroll
                        for (int i = 0; i < 16; ++i) { o0[i] *= alpha; o1[i] *= alpha; s0[i] -= d; s1[i] -= d; mneg[i] = -m_run; }
                        if (sub == 0) {
#pragma unroll
                            for (int i = 0; i < 16; ++i) { sc[1][0][i] -= d; sc[1][1][i] -= d; }
                        }
                    }
                    float ps = 0.f;
#pragma unroll
                    for (int i = 0; i < 16; ++i) { s0[i] = ex2(s0[i]); s1[i] = ex2(s1[i]); ps += s0[i] + s1[i]; }
                    l_run += ps;
                    bf16x8 pf[2][2];
#pragma unroll
                    for (int s = 0; s < 2; ++s) {
                        u32x4 w0, w1;
                        w0.x = pk2(s0[8 * s + 0], s0[8 * s + 1]); w0.y = pk2(s0[8 * s + 2], s0[8 * s + 3]); w0.z = pk2(s0[8 * s + 4], s0[8 * s + 5]); w0.w = pk2(s0[8 * s + 6], s0[8 * s + 7]);
                        w1.x = pk2(s1[8 * s + 0], s1[8 * s + 1]); w1.y = pk2(s1[8 * s + 2], s1[8 * s + 3]); w1.z = pk2(s1[8 * s + 4], s1[8 * s + 5]); w1.w = pk2(s1[8 * s + 6], s1[8 * s + 7]);
                        pf[0][s] = __builtin_bit_cast(bf16x8, w0); pf[1][s] = __builtin_bit_cast(bf16x8, w1);
                    }
#pragma unroll
                    for (int n = 0; n < 2; ++n)
#pragma unroll
                        for (int s = 0; s < 2; ++s) {
                            const int ko = (32 * n + 16 * s) * 64;
#pragma unroll
                            for (int db = 0; db < 2; ++db) {
                                const s16x4 lo = __builtin_bit_cast(s16x4, __builtin_amdgcn_ds_read_tr16_b64_v4i16((LAS s16x4*)(ldsL + vb + db * 8192 + ko)));
                                const s16x4 hi = __builtin_bit_cast(s16x4, __builtin_amdgcn_ds_read_tr16_b64_v4i16((LAS s16x4*)(ldsL + vb + db * 8192 + ko + 512)));
                                const bf16x8 vf = {lo[0], lo[1], lo[2], lo[3], hi[0], hi[1], hi[2], hi[3]};
                                if (db == 0) o0 = __builtin_amdgcn_mfma_f32_32x32x16_bf16(vf, pf[n][s], o0, 0, 0, 0);
                                else o1 = __builtin_amdgcn_mfma_f32_32x32x16_bf16(vf, pf[n][s], o1, 0, 0, 0);
                            }
                        }
                }
                {
                    const int nb = (cur ^ 1) * BUFB;
                    *(LAS u32x4*)(ldsL + nb + k_dst) = nk0; *(LAS u32x4*)(ldsL + nb + k_dst + 1024) = nk1;
                    *(LAS u32x4*)(ldsL + nb + v_dst) = nv0; *(LAS u32x4*)(ldsL + nb + v_dst + 4096) = nv1;
                    *(LAS u32x4*)(ldsL + nb + kp_dst) = npr;
                }
                __syncthreads();
            }
            {
                const float lt = sum32(l_run);
                const float inv = 1.0f / lt;
                const int sc = 81920 + wave * 4352;
#pragma unroll
                for (int g = 0; g < 4; ++g) {
                    u32x2 w;
                    w.x = pk2(o0[4 * g] * inv, o0[4 * g + 1] * inv); w.y = pk2(o0[4 * g + 2] * inv, o0[4 * g + 3] * inv);
                    *(LAS u32x2*)(ldsL + sc + r32 * 136 + (8 * g + 4 * hh) * 2) = w;
                    w.x = pk2(o1[4 * g] * inv, o1[4 * g + 1] * inv); w.y = pk2(o1[4 * g + 2] * inv, o1[4 * g + 3] * inv);
                    *(LAS u32x2*)(ldsL + sc + r32 * 136 + (32 + 8 * g + 4 * hh) * 2) = w;
                }
                __syncthreads();
#pragma unroll
                for (int it = 0; it < 8; ++it) {
                    const int row = it * 4 + (lane >> 4), pc = lane & 15;
                    const u32x2 w = *(const LAS u32x2*)(ldsL + sc + row * 136 + pc * 8);
                    *(u32x2*)(W_bout + (tok0 + qblk * 256 + wave * 32 + row) * 512 + h * 64 + pc * 4) = w;
                }
            }
            if ((vblk & 3) == ui) {
#pragma unroll 1
                for (int sl = 0; sl < 4; ++sl) {
                    const int j = sl >> 1; const int uu = blk + j * G;
                    const int e = (G == 256) ? ((vblk & ~1) + j) : (uu >> 1), pn = (G == 256) ? (vblk & 1) : (uu & 1);
                    __syncthreads();
                    if (uu < 512) convert_panel_lds<128, true>(W_scr + (size_t)j * 256 * 1024 + (sl & 1) * 128 * 1024, P.in[(sl & 1) ? I_W3 : I_W1] + (size_t)e * 1024 * 256 + pn * 128, 256, 1024, tid, ldsL);
                }
            }
        }
        for (int ui = 0; ui < ((P.flags & 8) ? 0 : 12); ++ui) {
            TIDS
            const int r32 = lane & 31, hh = lane >> 5;
            const int u = vblk * 12 + ui;
            if (u >= 3072) break;
            const int bh = u / 48, w48 = u % 48, h = bh & 7, b = bh >> 3;
            const int p = w48 >> 4, j16 = w48 & 15;
            const int dil = (p == 0) ? 1 : (p == 1 ? 4 : 16);
            const int res = (p == 0) ? 0 : (p == 1 ? (j16 >> 2) : j16);
            const int m0 = (p == 0) ? j16 * 256 : (p == 1 ? (j16 & 3) * 256 : 0);
            const int L = SEQ / dil;
            const size_t tok0 = (size_t)b * SEQ;
            __syncthreads();
            for (int idx = tid; idx < 672; idx += 512) { const int oi = idx - 255; *(LAS float*)(ldsL + 98304 + idx * 4) = (oi >= 0 && oi <= 128) ? W_biasT[(p * 8 + h) * 129 + oi] : -1e30f; }
            {
                u32x4 kr[6], vr[6];
#pragma unroll
                for (int it = 0; it < 6; ++it) {
                    const int idx = it * 512 + tid, row = idx >> 3, ch = idx & 7;
                    const int mk = m0 - 64 + row;
                    kr[it] = (u32x4){0, 0, 0, 0}; vr[it] = (u32x4){0, 0, 0, 0};
                    if (mk >= 0 && mk < L) {
                        const bf16_t* src = W_proj + (tok0 + (size_t)mk * dil + res) * INCP + 512 + h * 64 + ch * 8;
                        kr[it] = *(const u32x4*)src; vr[it] = *(const u32x4*)(src + 512);
                    }
                }
#pragma unroll
                for (int it = 0; it < 6; ++it) {
                    const int idx = it * 512 + tid, row = idx >> 3, ch = idx & 7;
                    *(LAS u32x4*)(ldsL + ch * 6144 + ((row ^ ch) * 16)) = kr[it];
                    *(LAS u32x4*)(ldsL + 49152 + (ch >> 2) * 24576 + row * 64 + (ch & 3) * 16) = vr[it];
                }
            }
            const int qrel = wave * 32 + r32;
            const size_t tq = tok0 + (size_t)(m0 + qrel) * dil + res;
            bf16x8 qf[4];
#pragma unroll
            for (int d0 = 0; d0 < 4; ++d0) qf[d0] = *(const bf16x8*)(W_proj + tq * INCP + h * 64 + d0 * 16 + hh * 8);
            __syncthreads();
            f32x16 o0 = {}, o1 = {};
            float m_run = -1e20f, l_run = 0.f;
            const int vfo = 49152 + (4 * hh + ((lane & 15) >> 2)) * 64 + ((lane >> 4) & 1) * 32 + (lane & 3) * 8;
#pragma unroll 1
            for (int jj = 0; jj < 3; ++jj) {
                const int jt = (wave >> 1) + jj;
                f32x16 s0 = {}, s1 = {};
#pragma unroll
                for (int d0 = 0; d0 < 4; ++d0) {
                    const int ch = 2 * d0 + hh;
                    const bf16x8 k0 = *(const LAS bf16x8*)(ldsL + ch * 6144 + (((64 * jt + r32) ^ ch) * 16));
                    const bf16x8 k1 = *(const LAS bf16x8*)(ldsL + ch * 6144 + (((64 * jt + 32 + r32) ^ ch) * 16));
                    s0 = __builtin_amdgcn_mfma_f32_32x32x16_bf16(k0, qf[d0], s0, 0, 0, 0);
                    s1 = __builtin_amdgcn_mfma_f32_32x32x16_bf16(k1, qf[d0], s1, 0, 0, 0);
                }
                const LAS float* bl = (const LAS float*)(ldsL + 98304) + (64 * jt - qrel + 4 * hh + 255);
                const int mkb = m0 - 64 + 64 * jt;
                const bool edge = (mkb < 0) || (mkb + 64 > L);
                float mx = -1e30f;
#pragma unroll
                for (int i = 0; i < 16; ++i) {
                    const int cr = (i & 3) + 8 * (i >> 2);
                    s0[i] += bl[cr]; s1[i] += bl[cr + 32];
                    if (edge) {
                        const int mk0 = mkb + cr + 4 * hh;
                        if (mk0 < 0 || mk0 >= L) s0[i] = -1e30f;
                        if (mk0 + 32 < 0 || mk0 + 32 >= L) s1[i] = -1e30f;
                    }
                    mx = fmaxf(mx, fmaxf(s0[i], s1[i]));
                }
                mx = max32(mx);
                const float m_new = fmaxf(m_run, mx);
                const float alpha = ex2(m_run - m_new);
                m_run = m_new;
                float ps = 0.f;
#pragma unroll
                for (int i = 0; i < 16; ++i) { s0[i] = ex2(s0[i] - m_new); s1[i] = ex2(s1[i] - m_new); ps += s0[i] + s1[i]; }
                l_run = l_run * alpha + ps;
#pragma unroll
                for (int i = 0; i < 16; ++i) { o0[i] *= alpha; o1[i] *= alpha; }
                bf16x8 pf[2][2];
#pragma unroll
                for (int s = 0; s < 2; ++s) {
                    u32x4 w0, w1;
                    w0.x = pk2(s0[8 * s + 0], s0[8 * s + 1]); w0.y = pk2(s0[8 * s + 2], s0[8 * s + 3]); w0.z = pk2(s0[8 * s + 4], s0[8 * s + 5]); w0.w = pk2(s0[8 * s + 6], s0[8 * s + 7]);
                    w1.x = pk2(s1[8 * s + 0], s1[8 * s + 1]); w1.y = pk2(s1[8 * s + 2], s1[8 * s + 3]); w1.z = pk2(s1[8 * s + 4], s1[8 * s + 5]); w1.w = pk2(s1[8 * s + 6], s1[8 * s + 7]);
                    pf[0][s] = __builtin_bit_cast(bf16x8, w0); pf[1][s] = __builtin_bit_cast(bf16x8, w1);
                }
#pragma unroll
                for (int n = 0; n < 2; ++n)
#pragma unroll
                    for (int s = 0; s < 2; ++s) {
                        const int ko = (64 * jt + 32 * n + 16 * s) * 64;
#pragma unroll
                        for (int db = 0; db < 2; ++db) {
                            const s16x4 lo = __builtin_bit_cast(s16x4, __builtin_amdgcn_ds_read_tr16_b64_v4i16((LAS s16x4*)(ldsL + vfo + db * 24576 + ko)));
                            const s16x4 hi = __builtin_bit_cast(s16x4, __builtin_amdgcn_ds_read_tr16_b64_v4i16((LAS s16x4*)(ldsL + vfo + db * 24576 + ko + 512)));
                            const bf16x8 vf = {lo[0], lo[1], lo[2], lo[3], hi[0], hi[1], hi[2], hi[3]};
                            if (db == 0) o0 = __builtin_amdgcn_mfma_f32_32x32x16_bf16(vf, pf[n][s], o0, 0, 0, 0);
                            else o1 = __builtin_amdgcn_mfma_f32_32x32x16_bf16(vf, pf[n][s], o1, 0, 0, 0);
                        }
                    }
            }
            __syncthreads();
            {
                const float lt = sum32(l_run);
                const float inv = 1.0f / lt;
                if (hh == 0) W_lsebuf[((size_t)p * NTOK + tq) * 8 + h] = m_run + __log2f(lt);
                const int sc = wave * 4352;
#pragma unroll
                for (int g = 0; g < 4; ++g) {
                    u32x2 w;
                    w.x = pk2(o0[4 * g] * inv, o0[4 * g + 1] * inv); w.y = pk2(o0[4 * g + 2] * inv, o0[4 * g + 3] * inv);
                    *(LAS u32x2*)(ldsL + sc + r32 * 136 + (8 * g + 4 * hh) * 2) = w;
                    w.x = pk2(o1[4 * g] * inv, o1[4 * g + 1] * inv); w.y = pk2(o1[4 * g + 2] * inv, o1[4 * g + 3] * inv);
                    *(LAS u32x2*)(ldsL + sc + r32 * 136 + (32 + 8 * g + 4 * hh) * 2) = w;
                }
                __syncthreads();
#pragma unroll
                for (int it = 0; it < 8; ++it) {
                    const int row = it * 4 + (lane >> 4), pc = lane & 15;
                    const u32x2 w = *(const LAS u32x2*)(ldsL + sc + row * 136 + pc * 8);
                    const size_t tr = tok0 + (size_t)(m0 + wave * 32 + row) * dil + res;
                    *(u32x2*)(W_aparts + ((size_t)p * NTOK + tr) * 512 + h * 64 + pc * 4) = w;
                }
            }
            if ((vblk % 12) == ui) {
#pragma unroll 1
                for (int q = 2; q < 4; ++q) {
                    const int uu = blk + q * G;
                    const int e = (G == 256) ? ((vblk & ~3) + q) : (uu >> 2), pn = (G == 256) ? (vblk & 3) : (uu & 3);
                    __syncthreads();
                    if (uu < 1024) convert_panel_lds<256, true>(W_scr + (size_t)2 * 256 * 1024 + (size_t)q * 256 * 256, P.in[I_W2] + (size_t)e * 256 * 1024 + pn * 256, 1024, 256, tid, ldsL);
                }
            }
        }
    }
    SEAM(4);

    if (IN(5)) {
        TIDS
        for (int row = blk * 8 + wave; row < NTOK; row += G * 8) {
            const int hd = lane >> 3;
            float ls0 = W_lsebuf[((size_t)0 * NTOK + row) * 8 + hd], ls1 = W_lsebuf[((size_t)1 * NTOK + row) * 8 + hd], ls2 = W_lsebuf[((size_t)2 * NTOK + row) * 8 + hd];
            const float M = fmaxf(ls0, fmaxf(ls1, ls2));
            float w0 = ex2(ls0 - M), w1 = ex2(ls1 - M), w2 = ex2(ls2 - M);
            const float wsn = 1.0f / (w0 + w1 + w2); w0 *= wsn; w1 *= wsn; w2 *= wsn;
            const u32x4 a0 = *(const u32x4*)(W_aparts + ((size_t)0 * NTOK + row) * 512 + lane * 8);
            const u32x4 a1 = *(const u32x4*)(W_aparts + ((size_t)1 * NTOK + row) * 512 + lane * 8);
            const u32x4 a2 = *(const u32x4*)(W_aparts + ((size_t)2 * NTOK + row) * 512 + lane * 8);
            const u32x4 bb = *(const u32x4*)(W_bout + (size_t)row * 512 + lane * 8);
            float av[8], bv[8]; float sa = 0.f, sb = 0.f;
#pragma unroll
            for (int j = 0; j < 4; ++j) {
                av[2 * j] = w0 * __uint_as_float(a0[j] << 16) + w1 * __uint_as_float(a1[j] << 16) + w2 * __uint_as_float(a2[j] << 16);
                av[2 * j + 1] = w0 * __uint_as_float(a0[j] & 0xffff0000u) + w1 * __uint_as_float(a1[j] & 0xffff0000u) + w2 * __uint_as_float(a2[j] & 0xffff0000u);
                bv[2 * j] = __uint_as_float(bb[j] << 16); bv[2 * j + 1] = __uint_as_float(bb[j] & 0xffff0000u);
                sa += av[2 * j] * av[2 * j] + av[2 * j + 1] * av[2 * j + 1];
                sb += bv[2 * j] * bv[2 * j] + bv[2 * j + 1] * bv[2 * j + 1];
            }
            sa = wave_sum(sa); sb = wave_sum(sb);
            const float ra = rsqrtf(sa * (1.0f / 512.0f) + EPS), rb = rsqrtf(sb * (1.0f / 512.0f) + EPS);
            u32x4 wa, wb;
            wa.x = pk2(av[0] * ra, av[1] * ra); wa.y = pk2(av[2] * ra, av[3] * ra); wa.z = pk2(av[4] * ra, av[5] * ra); wa.w = pk2(av[6] * ra, av[7] * ra);
            wb.x = pk2(bv[0] * rb, bv[1] * rb); wb.y = pk2(bv[2] * rb, bv[3] * rb); wb.z = pk2(bv[4] * rb, bv[5] * rb); wb.w = pk2(bv[6] * rb, bv[7] * rb);
            *(u32x4*)(W_mixb + (size_t)row * DM + lane * 8) = wa;
            *(u32x4*)(W_mixb + (size_t)row * DM + 512 + lane * 8) = wb;
        }
    }
    SEAM(5);

    if (IN(6)) {
        TIDS
        unsigned vl_[4]; g8_voff_lin(vl_, DM, tid);
        auto nextf = [&](int i, GDesc& d) {
            const int ul = i * 32 + (vblk & 31); if (ul >= 64 || vblk >= 256) return false;
            const int pm = (vblk >> 5) * 16 + (ul >> 2), pn = ul & 3;
            d.Ab = (const char*)(W_mixb + (size_t)pm * 256 * DM); d.Bb = (const char*)(W_WoT + (size_t)pn * 256 * DM);
            d.va0 = vl_[0]; d.va1 = vl_[1]; d.va2 = vl_[2]; d.va3 = vl_[3]; d.i0 = pm; d.i1 = pn; d.i2 = 0; return true;
        };
        auto epi = [&](const f32x4 (&acc)[2][2][4][2], const GDesc& d, int wr, int wc, int fr, int fq) {
            const int pm = d.i0, pn = d.i1;
            EPI_FOREACH8(acc, wr, wc, fr, fq, r, c8, v0, v1, {
                const int col = pn * 256 + c8; const int row = pm * 256 + r;
                const float* gp = W_mod + (row >> 12) * 6144 + 2048 + col;
                const f32x4 ga = *(const f32x4*)gp * v0, gb = *(const f32x4*)(gp + 4) * v1;
                u32x4 w; PK8(w, ga, gb);
                *(u32x4*)(W_xt + (size_t)row * DM + col) = w;
            })
        };
        gemm_stream(ldsL, tid, DM, nextf, epi);
    }
    SEAM(6);

    if (IN(7)) {
        TIDS
        const float* g = P.in[I_N2G];
        for (int row = blk * 8 + wave; row < NTOK; row += G * 8) {
            const int b = row >> 12;
            bf16_t* xr = W_xt + (size_t)row * DM;
            const float* x0 = W_x + (size_t)row * DM;
            f32x4 v[4]; float ss = 0.f;
#pragma unroll
            for (int i = 0; i < 4; ++i) {
                const u32x2 tw = *(const u32x2*)(xr + i * 256 + lane * 4);
                const f32x4 tv = {__uint_as_float(tw.x << 16), __uint_as_float(tw.x & 0xffff0000u), __uint_as_float(tw.y << 16), __uint_as_float(tw.y & 0xffff0000u)};
                v[i] = tv + *(const f32x4*)(x0 + i * 256 + lane * 4);
                u32x2 xw; xw.x = pk2(v[i][0], v[i][1]); xw.y = pk2(v[i][2], v[i][3]);
                *(u32x2*)(xr + i * 256 + lane * 4) = xw;
                ss += v[i][0] * v[i][0] + v[i][1] * v[i][1] + v[i][2] * v[i][2] + v[i][3] * v[i][3]; }
            ss = wave_sum(ss);
            const float rinv = rsqrtf(ss * (1.0f / 1024.0f) + EPS);
            const float* mb = W_mod + b * 6144 + 3072;
#pragma unroll
            for (int i = 0; i < 4; ++i) {
                const int c = i * 256 + lane * 4;
                const f32x4 gg = *(const f32x4*)(g + c), sh = *(const f32x4*)(mb + c), sc = *(const f32x4*)(mb + 1024 + c);
                float o[4];
#pragma unroll
                for (int j = 0; j < 4; ++j) o[j] = v[i][j] * rinv * gg[j] * (1.0f + sc[j]) + sh[j];
                u32x2 w; w.x = pk2(o[0], o[1]); w.y = pk2(o[2], o[3]);
                *(u32x2*)(W_hbuf + (size_t)row * DM + c) = w;
            }
        }
    }
    SEAM(7);

    if (IN(8)) {
        {
            TIDS
            unsigned vl_[4]; g8_voff_lin(vl_, DM, tid);
            auto nextf = [&](int i, GDesc& d) {
                const int ul = vblk & 31; if (i > 0 || vblk >= 256) return false;
                const int pm = (vblk >> 5) * 16 + (ul >> 1), pn = ul & 1;
                d.Ab = (const char*)(W_hbuf + (size_t)pm * 256 * DM); d.Bb = (const char*)(W_Ws13T + (size_t)pn * 256 * DM);
                d.va0 = vl_[0]; d.va1 = vl_[1]; d.va2 = vl_[2]; d.va3 = vl_[3]; d.i0 = pm; d.i1 = pn; d.i2 = 0; return true;
            };
            auto epi = [&](const f32x4 (&acc)[2][2][4][2], const GDesc& d, int wr, int wc, int fr, int fq) {
                const int pm = d.i0, pn = d.i1;
#pragma unroll
                for (int ai = 0; ai < 2; ++ai)
#pragma unroll
                    for (int m = 0; m < 4; ++m) {
                        const int r = ai * 128 + wr * 64 + m * 16 + fr;
                        const f32x4 a0 = acc[ai][0][m][0], a1 = acc[ai][0][m][1], b0 = acc[ai][1][m][0], b1 = acc[ai][1][m][1];
                        f32x4 h0, h1;
#pragma unroll
                        for (int j = 0; j < 4; ++j) { h0[j] = siluf(a0[j]) * b0[j]; h1[j] = siluf(a1[j]) * b1[j]; }
                        u32x4 w; PK8(w, h0, h1);
                        *(u32x4*)(W_hdn + (size_t)(NASG + pm * 256 + r) * EFF + pn * 128 + wc * 32 + fq * 8) = w;
                    }
            };
            gemm_stream(ldsL, tid, DM, nextf, epi);
        }
        {
            TIDS
            unsigned vl_[4]; g8_voff_lin(vl_, DM, tid);
            auto nextf = [&](int i, GDesc& d) {
                const int ul = vblk & 31; if (i > 0 || ul < 16 || vblk >= 256) return false;
                const int pm = (vblk >> 5) * 16 + (ul - 16);
                d.Ab = (const char*)(W_hbuf + (size_t)pm * 256 * DM); d.Bb = (const char*)(W_WrT);
                d.va0 = vl_[0]; d.va1 = vl_[1]; d.va2 = vl_[2]; d.va3 = vl_[3]; d.i0 = pm; d.i1 = 0; d.i2 = 0; return true;
            };
            auto epi = [&](const f32x4 (&acc)[2][2][4][2], const GDesc& d, int wr, int wc, int fr, int fq) {
                const int pm = d.i0;
                EPI_FOREACH8(acc, wr, wc, fr, fq, r, c8, v0, v1, {
                    *(f32x4*)(W_logits + (size_t)(pm * 256 + r) * 256 + c8) = v0;
                    *(f32x4*)(W_logits + (size_t)(pm * 256 + r) * 256 + c8 + 4) = v1;
                })
            };
            gemm_stream(ldsL, tid, DM, nextf, epi);
        }
        if ((vblk & 31) < 16) {
            TIDS
#pragma unroll 1
            for (int q = 0; q < 2; ++q) {
                const int uu = blk + q * G;
                const int e = (G == 256) ? ((vblk & ~3) + q) : (uu >> 2), pn = (G == 256) ? (vblk & 3) : (uu & 3);
                __syncthreads();
                if (uu < 1024) convert_panel_lds<256, true>(W_scr + (size_t)2 * 256 * 1024 + (size_t)q * 256 * 256, P.in[I_W2] + (size_t)e * 256 * 1024 + pn * 256, 1024, 256, tid, ldsL);
            }
        }
    }
    SEAM(8);

    if (IN(9)) {
        TIDS
        const float* ebias = P.in[I_EB];
        const f32x4 eb = *(const f32x4*)(ebias + lane * 4);
        for (int t = blk * 8 + wave; t < NTOK; t += G * 8) {
            const f32x4 lg = *(const f32x4*)(W_logits + (size_t)t * 256 + lane * 4);
            float sc[4], sel[4];
#pragma unroll
            for (int i = 0; i < 4; ++i) { sc[i] = 1.0f / (1.0f + expf(-lg[i])); sel[i] = sc[i] + eb[i]; }
            float a1 = fmaxf(sel[0], sel[1]), a2 = fminf(sel[0], sel[1]);
#pragma unroll
            for (int i = 2; i < 4; ++i) { const float v = sel[i]; a2 = fmaxf(a2, fminf(a1, v)); a1 = fmaxf(a1, v); }
            {
                float b1, b2, n1, n2;
                b1 = dppf(a1, DPP_X1); b2 = dppf(a2, DPP_X1); n1 = fmaxf(a1, b1); n2 = fmaxf(fminf(a1, b1), fmaxf(a2, b2)); a1 = n1; a2 = n2;
                b1 = dppf(a1, DPP_X2); b2 = dppf(a2, DPP_X2); n1 = fmaxf(a1, b1); n2 = fmaxf(fminf(a1, b1), fmaxf(a2, b2)); a1 = n1; a2 = n2;
                b1 = dppf(a1, DPP_HM); b2 = dppf(a2, DPP_HM); n1 = fmaxf(a1, b1); n2 = fmaxf(fminf(a1, b1), fmaxf(a2, b2)); a1 = n1; a2 = n2;
            }
            const float gs = a1 + a2; const int myg = lane >> 3;
            int rank = 0;
#pragma unroll
            for (int g = 0; g < 8; ++g) { const float v = __int_as_float(__builtin_amdgcn_readlane(__float_as_int(gs), g * 8)); rank += (v > gs || (v == gs && g < myg)) ? 1 : 0; }
            const bool gsel = rank < 4;
            float cand[4];
#pragma unroll
            for (int i = 0; i < 4; ++i) cand[i] = gsel ? sel[i] : -INFINITY;
            int my_e = 0; float my_g = 0.f; float gsum = 0.f;
#pragma unroll
            for (int k = 0; k < 8; ++k) {
                float bv = cand[0]; int bi = 0;
#pragma unroll
                for (int i = 1; i < 4; ++i) if (cand[i] > bv) { bv = cand[i]; bi = i; }
                float v = bv; int ix = lane * 4 + bi;
#define AMX(ov, oi) do { const float ov_ = (ov); const int oi_ = (oi); if (ov_ > v || (ov_ == v && oi_ < ix)) { v = ov_; ix = oi_; } } while (0)
                AMX(dppf(v, DPP_X1), dppi(ix, DPP_X1)); AMX(dppf(v, DPP_X2), dppi(ix, DPP_X2)); AMX(dppf(v, DPP_HM), dppi(ix, DPP_HM)); AMX(dppf(v, DPP_RM), dppi(ix, DPP_RM));
                { auto rv = __builtin_amdgcn_permlane16_swap(__float_as_uint(v), __float_as_uint(v), false, false); auto ri = __builtin_amdgcn_permlane16_swap((unsigned)ix, (unsigned)ix, false, false);
                  v = __uint_as_float(rv[0]); ix = (int)ri[0]; AMX(__uint_as_float(rv[1]), (int)ri[1]); }
                { auto rv = __builtin_amdgcn_permlane32_swap(__float_as_uint(v), __float_as_uint(v), false, false); auto ri = __builtin_amdgcn_permlane32_swap((unsigned)ix, (unsigned)ix, false, false);
                  v = __uint_as_float(rv[0]); ix = (int)ri[0]; AMX(__uint_as_float(rv[1]), (int)ri[1]); }
#undef AMX
                ix = __builtin_amdgcn_readfirstlane(ix);
                float myscore = 0.f;
#pragma unroll
                for (int i = 0; i < 4; ++i) if (lane * 4 + i == ix) { cand[i] = -INFINITY; myscore = sc[i]; }
                const float gw = __int_as_float(__builtin_amdgcn_readlane(__float_as_int(myscore), ix >> 2));
                gsum += gw;
                if (lane == k) { my_e = ix; my_g = gw; }
            }
            if (lane < 8) {
                const unsigned rk = atomicAdd(&cntg[my_e * CNT_STRIDE], 1u);
                W_eidx[t * 8 + lane] = my_e; W_gate[t * 8 + lane] = my_g / gsum * 2.5f; W_rnk[t * 8 + lane] = (int)rk;
            }
        }
    }
    SEAM(9);

    if (IN(10)) {
        TIDS
        if (tid < 256) cntL[tid] = (int)__hip_atomic_load(&cntg[tid * CNT_STRIDE], __ATOMIC_RELAXED, __HIP_MEMORY_SCOPE_AGENT);
        __syncthreads();
        if (tid < 256) { int s = 0; for (int j = 0; j < tid; ++j) s += cntL[j]; startL[tid] = s; }
        __syncthreads();
        for (int t = blk * 8 + wave; t < NTOK; t += G * 8) {
            if (lane < 8) {
                const int e = W_eidx[t * 8 + lane];
                const int d = startL[e] + W_rnk[t * 8 + lane];
                W_toks[d] = t; W_wts[d] = W_gate[t * 8 + lane]; W_pos[t * 8 + lane] = d;
            }
        }
    }
    SEAM(10);

    if (IN(11)) {
        TIDS
        __syncthreads();
        if (tid < 256) cntL[tid] = (int)__hip_atomic_load(&cntg[tid * CNT_STRIDE], __ATOMIC_RELAXED, __HIP_MEMORY_SCOPE_AGENT);
        __syncthreads();
        if (tid <= 256) { int sa = 0, tb = 0; for (int j = 0; j < tid; ++j) { sa += cntL[j]; tb += (cntL[j] + 255) >> 8; } startL[tid] = sa; tbL[tid] = tb; }
        __syncthreads();
        const int T1 = 2 * tbL[256];
        const int g0 = (int)(((long)vblk * T1) / G), g1 = (int)(((long)(vblk + 1) * T1) / G);
        for (int c0 = g0; c0 < g1; c0 += 8) {
            TIDS
            const int nch = (g1 - c0) < 8 ? (g1 - c0) : 8;
            __syncthreads();
            if (tid < nch) {
                const int g = c0 + tid; int e = 0;
                for (int j = 1; j < 256; ++j) if (2 * tbL[j] <= g) e = j;
                const int r = g - 2 * tbL[e], nt = tbL[e + 1] - tbL[e];
                itemD[tid * 4 + 0] = e; itemD[tid * 4 + 1] = r / nt; itemD[tid * 4 + 2] = r % nt;
            }
            __syncthreads();
            for (int idx = tid; idx < nch * 256; idx += 512) {
                const int it = idx >> 8, e = itemD[it * 4], ti = itemD[it * 4 + 2];
                const int rr = ti * 256 + (idx & 255); const int sr = startL[e] + (rr < cntL[e] ? rr : 0);
                rowoff[idx] = (unsigned)W_toks[sr] * DM;
            }
            __syncthreads();
            int R0, C0; g8_rc(tid, R0, C0);
            auto nextf = [&](int i, GDesc& d) {
                if (i >= nch) return false;
                const int e = itemD[i * 4], pn = itemD[i * 4 + 1], ti = itemD[i * 4 + 2];
                const int vo = (e & ~1) | pn; const int bo = (G == 256) ? ((vo & 31) * 8 + (vo >> 5)) : vo;
                d.Ab = (const char*)W_hbuf; d.Bb = (const char*)(ws + OFF_SCR + (size_t)bo * SCR_PER_BLK) + (size_t)(e & 1) * 512 * 1024;
                d.va0 = (rowoff[i * 256 + R0] + C0) * 2u; d.va1 = (rowoff[i * 256 + R0 + 64] + C0) * 2u; d.va2 = (rowoff[i * 256 + R0 + 128] + C0) * 2u; d.va3 = (rowoff[i * 256 + R0 + 192] + C0) * 2u;
                const int left = cntL[e] - ti * 256;
                d.i0 = startL[e] + ti * 256; d.i1 = left < 256 ? left : 256; d.i2 = pn; return true;
            };
            auto epi = [&](const f32x4 (&acc)[2][2][4][2], const GDesc& d, int wr, int wc, int fr, int fq) {
                const int rowbase = d.i0, nvalid = d.i1, pn = d.i2;
#pragma unroll
                for (int ai = 0; ai < 2; ++ai)
#pragma unroll
                    for (int m = 0; m < 4; ++m) {
                        const int r = ai * 128 + wr * 64 + m * 16 + fr;
                        if (r < nvalid) {
                            const f32x4 a0 = acc[ai][0][m][0], a1 = acc[ai][0][m][1], b0 = acc[ai][1][m][0], b1 = acc[ai][1][m][1];
                            f32x4 h0, h1;
#pragma unroll
                            for (int j = 0; j < 4; ++j) { h0[j] = siluf(a0[j]) * b0[j]; h1[j] = siluf(a1[j]) * b1[j]; }
                            u32x4 w; PK8(w, h0, h1);
                            *(u32x4*)(W_hdn + (size_t)(rowbase + r) * EFF + pn * 128 + wc * 32 + fq * 8) = w;
                        }
                    }
            };
            gemm_stream(ldsL, tid, DM, nextf, epi);
        }
    }
    SEAM(11);

    if (IN(12)) {
        TIDS
        __syncthreads();
        if (tid < 256) cntL[tid] = (int)__hip_atomic_load(&cntg[tid * CNT_STRIDE], __ATOMIC_RELAXED, __HIP_MEMORY_SCOPE_AGENT);
        if (tid == 256) cntL[256] = NTOK;
        __syncthreads();
        if (tid <= 257) { int sa = 0, tb = 0; for (int j = 0; j < tid; ++j) { sa += cntL[j]; tb += (cntL[j] + 255) >> 8; } if (tid <= 256) startL[tid] = sa; tbL[tid] = tb; }
        __syncthreads();
        const int T2 = 4 * tbL[257];
        const int g0 = (int)(((long)vblk * T2) / G), g1 = (int)(((long)(vblk + 1) * T2) / G);
#define Y_STORE(ROWG, COL0, G_) do { _Pragma("unroll") for (int bj = 0; bj < 2; ++bj) { const f32x4 a_ = acc[ai][bj][m][0], b_ = acc[ai][bj][m][1]; int w0_ = 0, w1_ = 0; \
            w0_ = __builtin_amdgcn_cvt_pk_fp8_f32(a_[0] * (G_), a_[1] * (G_), w0_, false); w0_ = __builtin_amdgcn_cvt_pk_fp8_f32(a_[2] * (G_), a_[3] * (G_), w0_, true); \
            w1_ = __builtin_amdgcn_cvt_pk_fp8_f32(b_[0] * (G_), b_[1] * (G_), w1_, false); w1_ = __builtin_amdgcn_cvt_pk_fp8_f32(b_[2] * (G_), b_[3] * (G_), w1_, true); \
            u32x2 w_; w_.x = (unsigned)w0_; w_.y = (unsigned)w1_; *(u32x2*)(W_y8 + (size_t)(ROWG) * DM + (COL0) + bj * 128 + wc * 32 + fq * 8) = w_; } } while (0)
        for (int c0 = g0; c0 < g1; c0 += 8) {
            TIDS
            const int nch = (g1 - c0) < 8 ? (g1 - c0) : 8;
            __syncthreads();
            if (tid < nch) {
                const int g = c0 + tid; int e = 0;
                for (int j = 1; j < 257; ++j) if (4 * tbL[j] <= g) e = j;
                const int r = g - 4 * tbL[e], nt = tbL[e + 1] - tbL[e];
                itemD[tid * 4 + 0] = e; itemD[tid * 4 + 1] = r / nt; itemD[tid * 4 + 2] = r % nt;
            }
            __syncthreads();
            for (int idx = tid; idx < nch * 256; idx += 512) {
                const int it = idx >> 8, e = itemD[it * 4], ti = itemD[it * 4 + 2];
                const int rr = ti * 256 + (idx & 255); const int sr = startL[e] + (rr < cntL[e] ? rr : 0);
                rowoff[idx] = (unsigned)sr * EFF; rowsc[idx] = (e < 256) ? W_wts[sr] : 1.0f;
            }
            __syncthreads();
            int R0, C0; g8_rc(tid, R0, C0);
            auto nextf = [&](int i, GDesc& d) {
                if (i >= nch) return false;
                const int e = itemD[i * 4], pn = itemD[i * 4 + 1], ti = itemD[i * 4 + 2];
                const int vo = (e & ~3) | pn; const int bo = (G == 256) ? ((vo & 31) * 8 + (vo >> 5)) : vo;
                d.Ab = (const char*)W_hdn;
                d.Bb = (e < 256) ? (const char*)(ws + OFF_SCR + (size_t)bo * SCR_PER_BLK) + (size_t)2 * 512 * 1024 + (size_t)(e & 3) * 128 * 1024 : (const char*)(W_Ws2T + (size_t)pn * 256 * EFF);
                d.va0 = (rowoff[i * 256 + R0] + C0) * 2u; d.va1 = (rowoff[i * 256 + R0 + 64] + C0) * 2u; d.va2 = (rowoff[i * 256 + R0 + 128] + C0) * 2u; d.va3 = (rowoff[i * 256 + R0 + 192] + C0) * 2u;
                const int left = cntL[e] - ti * 256;
                d.i0 = startL[e] + ti * 256; d.i1 = (left < 256 ? left : 256) | (i << 16); d.i2 = pn; return true;
            };
            auto epi = [&](const f32x4 (&acc)[2][2][4][2], const GDesc& d, int wr, int wc, int fr, int fq) {
                const int rowbase = d.i0, nvalid = d.i1 & 0xffff, tl = d.i1 >> 16, pn = d.i2;
#pragma unroll
                for (int ai = 0; ai < 2; ++ai)
#pragma unroll
                    for (int m = 0; m < 4; ++m) {
                        const int r = ai * 128 + wr * 64 + m * 16 + fr;
                        if (r < nvalid) { const float g = rowsc[tl * 256 + r]; Y_STORE(rowbase + r, pn * 256, g); }
                    }
            };
            gemm_stream(ldsL, tid, EFF, nextf, epi);
        }
#undef Y_STORE
    }
    SEAM(12);

    if (IN(13)) {
        TIDS
        const float* fg = P.in[I_FG];
        for (int row = blk * 8 + wave; row < NTOK; row += G * 8) {
            const int b = row >> 12;
            float a[16];
#pragma unroll
            for (int j = 0; j < 16; ++j) a[j] = 0.f;
#pragma unroll
            for (int k = 0; k < 9; ++k) {
                const int pr = (k < 8) ? W_pos[row * 8 + k] : (NASG + row);
                const u32x4 w = *(const u32x4*)(W_y8 + (size_t)pr * DM + lane * 16);
#pragma unroll
                for (int q = 0; q < 4; ++q) {
                    a[4 * q + 0] += __builtin_amdgcn_cvt_f32_fp8((int)w[q], 0); a[4 * q + 1] += __builtin_amdgcn_cvt_f32_fp8((int)w[q], 1);
                    a[4 * q + 2] += __builtin_amdgcn_cvt_f32_fp8((int)w[q], 2); a[4 * q + 3] += __builtin_amdgcn_cvt_f32_fp8((int)w[q], 3);
                }
            }
            float* xr = P.out + (size_t)row * DM + lane * 16;
            const bf16_t* x1r = W_xt + (size_t)row * DM + lane * 16;
            const u32x4 xw0 = *(const u32x4*)x1r, xw1 = *(const u32x4*)(x1r + 8);
            const float* g2 = W_mod + b * 6144 + 5120 + lane * 16;
            float v[16]; float ss = 0.f;
#pragma unroll
            for (int q = 0; q < 4; ++q) {
                const unsigned wa = (q < 2) ? xw0[2 * q] : xw1[2 * (q - 2)], wb = (q < 2) ? xw0[2 * q + 1] : xw1[2 * (q - 2) + 1];
                const f32x4 xa = {__uint_as_float(wa << 16), __uint_as_float(wa & 0xffff0000u), __uint_as_float(wb << 16), __uint_as_float(wb & 0xffff0000u)};
                const f32x4 ga = *(const f32x4*)(g2 + q * 4);
#pragma unroll
                for (int j = 0; j < 4; ++j) { v[q * 4 + j] = xa[j] + ga[j] * a[q * 4 + j]; ss += v[q * 4 + j] * v[q * 4 + j]; }
            }
            ss = wave_sum(ss);
            const float rinv = rsqrtf(ss * (1.0f / 1024.0f) + EPS);
#pragma unroll
            for (int q = 0; q < 4; ++q) {
                const f32x4 fa = *(const f32x4*)(fg + lane * 16 + q * 4);
                f32x4 oa;
#pragma unroll
                for (int j = 0; j < 4; ++j) oa[j] = v[q * 4 + j] * rinv * fa[j];
                *(f32x4*)(xr + q * 4) = oa;
            }
        }
    }
#ifdef DBG_STOP
    if (IN(14)) {
        TIDS
        const size_t NO = (size_t)NTOK * DM;
        for (size_t i = (size_t)blk * 512 + tid; i < NO; i += (size_t)G * 512) {
            unsigned hsh = 0u;
            const size_t row = i >> 10, c = i & 1023;
#define RB(p, idx) ((unsigned)(p)[(idx)])
#define RF(p, idx) (__float_as_uint((p)[(idx)]))
#if DBG_STOP == 0
            hsh = RB(W_WinT, i % (2304 * 1024)) ^ RB(W_WoT, i % (1024 * 1024)) ^ RB(W_WuqT, i % (768 * 384)) ^ RB(W_WukvT, i % (1024 * 256)) ^ RB(W_Ws13T, i % (512 * 1024)) ^ RB(W_Ws2T, i % (1024 * 256)) ^ RB(W_WrT, i % (256 * 1024))
                ^ RF(W_mod, i % (8 * 6144)) ^ RF(W_ropecs, i % (4096 * 32)) ^ RF(W_biasT, i % (3 * 8 * 129));
#elif DBG_STOP == 1 || DBG_STOP == 7
            hsh = RB(W_hbuf, i);
#elif DBG_STOP == 2
            hsh = RB(W_proj, row * INCP + c) ^ (RB(W_proj, row * INCP + 1024 + c) << 1) ^ (c < 160 ? (RB(W_proj, row * INCP + 2048 + c) << 2) : 0u);
#elif DBG_STOP == 3
            hsh = RB(W_kvb, i) ^ (c < 768 ? (RB(W_qb, row * 768 + c) << 1) : 0u);
#elif DBG_STOP == 4
            if (c < 512) hsh = RB(W_bout, row * 512 + c); else if (DBG_SUB) { const size_t cc = c - 512; hsh = RB(W_aparts, row * 512 + cc) ^ (RB(W_aparts, ((size_t)NTOK + row) * 512 + cc) << 1) ^ (RB(W_aparts, ((size_t)2 * NTOK + row) * 512 + cc) << 2) ^ RF(W_lsebuf, row * 8 + (cc >> 6)) ^ (RF(W_lsebuf, ((size_t)NTOK + row) * 8 + (cc >> 6)) << 1) ^ (RF(W_lsebuf, ((size_t)2 * NTOK + row) * 8 + (cc >> 6)) << 2); }
#elif DBG_STOP == 5
            hsh = RB(W_mixb, i);
#elif DBG_STOP == 6
            hsh = RF(P.out, i);
#elif DBG_STOP == 8
            if (c < 256) hsh = RF(W_logits, row * 256 + c); else if (c < 512) hsh = RB(W_hdn, ((size_t)NASG + row) * EFF + (c - 256));
#elif DBG_STOP == 9
            if (c < 8) hsh = (unsigned)W_eidx[row * 8 + c]; else if (c < 16) hsh = RF(W_gate, row * 8 + (c - 8));
#elif DBG_STOP == 11
            { const int k = (int)(c >> 8); hsh = RB(W_hdn, (size_t)W_pos[row * 8 + k] * EFF + (c & 255)) ^ (RB(W_hdn, (size_t)W_pos[row * 8 + 4 + k] * EFF + (c & 255)) << 1); }
#elif DBG_STOP == 12
            { for (int k = 0; k < 8; ++k) hsh ^= RB(W_ybuf, (size_t)W_pos[row * 8 + k] * DM + c) << (k & 3); hsh ^= RB(W_ybuf, ((size_t)NASG + row) * DM + c); }
#endif
            P.out[i] = (float)(hsh & 0xFu);
        }
    }
#endif
#undef IN
#undef SEAM
}

extern "C" void kernel_launch(void* const* d_in, const int* in_sizes, int n_in, void* d_out, int out_size, void* d_ws, size_t ws_size, hipStream_t stream) {
    static int grid = 0;
    if (grid == 0) {
        if (n_in != 24 || ws_size < WS_END) { fprintf(stderr, "kernel_launch: need 24 inputs and %zu bytes of workspace (got %d, %zu)\n", (size_t)WS_END, n_in, ws_size); grid = -1; return; }
        int dev = 0, cus = 0, per_cu = 0;
        if (hipGetDevice(&dev) != hipSuccess || hipDeviceGetAttribute(&cus, hipDeviceAttributeMultiprocessorCount, dev) != hipSuccess) { grid = -1; return; }
        if (hipFuncSetAttribute((const void*)fwd_kernel, hipFuncAttributeMaxDynamicSharedMemorySize, LDS_BYTES) != hipSuccess) { fprintf(stderr, "kernel_launch: hipFuncSetAttribute failed\n"); grid = -1; return; }
        if (hipOccupancyMaxActiveBlocksPerMultiprocessor(&per_cu, (const void*)fwd_kernel, 512, LDS_BYTES) != hipSuccess || per_cu < 1) { fprintf(stderr, "kernel_launch: occupancy query says %d\n", per_cu); }
        (void)hipGetLastError();
        if (cus < 256) { fprintf(stderr, "kernel_launch: this kernel needs 256 CUs (device reports %d)\n", cus); grid = -1; return; }
        grid = 256;
    }
    if (grid < 0) return;
    (void)hipMemsetAsync((char*)d_ws + OFF_CTL, 0, CTL_BYTES, stream);
    Params p{};
    for (int i = 0; i < 24; ++i) p.in[i] = (const float*)d_in[i];
    p.out = (float*)d_out; p.ws = (unsigned char*)d_ws;
#if MK_N_LAUNCHES == 1
    p.ph_lo = 0; p.ph_hi = NPHASE;
    hipLaunchKernelGGL(fwd_kernel, dim3(grid), dim3(512), LDS_BYTES, stream, p);
#else
#ifdef DBG_STOP
    for (int k = 0; k <= DBG_STOP; ++k) { p.ph_lo = k; p.ph_hi = k + 1; hipLaunchKernelGGL(fwd_kernel, dim3(grid), dim3(512), LDS_BYTES, stream, p); }
    p.ph_lo = 14; p.ph_hi = 15; hipLaunchKernelGGL(fwd_kernel, dim3(grid), dim3(512), LDS_BYTES, stream, p);
#else
#ifndef DBL_MASK
#define DBL_MASK 0u
#endif
#ifndef DBL_FLAGS
#define DBL_FLAGS 0
#endif
    for (int k = 0; k < 14; ++k) { p.ph_lo = k; p.ph_hi = k + 1; hipLaunchKernelGGL(fwd_kernel, dim3(grid), dim3(512), LDS_BYTES, stream, p);
        if ((DBL_MASK >> k) & 1u) { p.flags = DBL_FLAGS; hipLaunchKernelGGL(fwd_kernel, dim3(grid), dim3(512), LDS_BYTES, stream, p); p.flags = 0; } }
#endif
#endif
}
```

```cpp
#include <hip/hip_runtime.h>
#include <stdint.h>
#include <stdio.h>

#ifndef MK_N_LAUNCHES
#define MK_N_LAUNCHES 1
#endif

#define DEVI __device__ __forceinline__
typedef unsigned short bf16_t;
typedef short bf16x8 __attribute__((ext_vector_type(8)));
typedef short s16x4 __attribute__((ext_vector_type(4)));
typedef float f32x4 __attribute__((ext_vector_type(4)));
typedef float f32x16 __attribute__((ext_vector_type(16)));
typedef unsigned u32x4 __attribute__((ext_vector_type(4)));
typedef unsigned u32x2 __attribute__((ext_vector_type(2)));

constexpr int NTOK = 32768, SEQ = 4096, DM = 1024;
constexpr int INC = 2208, INCP = 2304;
constexpr int QLORA = 384, KVLORA = 256;
constexpr int NEXP = 256, EFF = 256;
constexpr int NASG = NTOK * 8;
constexpr int NROWS = NASG + NTOK;
constexpr float EPS = 1e-6f;
constexpr float LOG2E = 1.4426950408889634f;

constexpr size_t MiB = 1u << 20;
constexpr size_t OFF_CTL = 0, CTL_BYTES = 1 * MiB;
constexpr size_t OFF_MOD = 1 * MiB;
constexpr size_t OFF_ROPE = OFF_MOD + 256 * 1024;
constexpr size_t OFF_BIAS = OFF_ROPE + 512 * 1024;
constexpr size_t OFF_WIN = 2 * MiB;
constexpr size_t OFF_WUQ = OFF_WIN + 4608 * 1024;
constexpr size_t OFF_WUKV = OFF_WUQ + 1 * MiB;
constexpr size_t OFF_WO = OFF_WUKV + 512 * 1024;
constexpr size_t OFF_WR = OFF_WO + 2 * MiB;
constexpr size_t OFF_WS13 = OFF_WR + 512 * 1024;
constexpr size_t OFF_WS2 = OFF_WS13 + 1 * MiB;
constexpr size_t OFF_H = 12 * MiB;
constexpr size_t OFF_LOGITS = OFF_H + 64 * MiB;
constexpr size_t OFF_EIDX = OFF_LOGITS + 32 * MiB;
constexpr size_t OFF_GATE = OFF_EIDX + 1 * MiB;
constexpr size_t OFF_RNK = OFF_GATE + 1 * MiB;
constexpr size_t OFF_POS = OFF_RNK + 1 * MiB;
constexpr size_t OFF_TOKS = OFF_POS + 1 * MiB;
constexpr size_t OFF_WTS = OFF_TOKS + 1 * MiB;
constexpr size_t OFF_SSQ = OFF_WTS + 1 * MiB;
constexpr size_t OFF_SCR = OFF_SSQ + 4 * MiB;
constexpr size_t SCR_PER_BLK = 1536 * 1024;
constexpr size_t OFF_R = OFF_SCR + 384 * MiB;
constexpr size_t OFF_XT = OFF_R + 452 * MiB;
constexpr size_t WS_END = OFF_XT + 64 * MiB;
constexpr size_t OFF_PROJ = OFF_R;
constexpr size_t OFF_QB = OFF_PROJ + 144 * MiB;
constexpr size_t OFF_KVB = OFF_QB + 48 * MiB;
constexpr size_t OFF_BOUT = OFF_KVB + 64 * MiB;
constexpr size_t OFF_APARTS = OFF_BOUT + 32 * MiB;
constexpr size_t OFF_LSE = OFF_APARTS + 96 * MiB;
constexpr size_t OFF_MIX = OFF_LSE + 4 * MiB;
constexpr size_t OFF_Y = OFF_R;
constexpr size_t OFF_HDN = OFF_R + 288 * MiB;
static_assert(OFF_MIX + 64 * MiB <= WS_END, "alias map");
constexpr int CNT_WORD0 = 8192, CNT_STRIDE = 16;

constexpr int LDS_STAGE = 0;
constexpr int LDS_ROWOFF = 131072;
constexpr int LDS_ROWSC = LDS_ROWOFF + 8192;
constexpr int LDS_MISC = LDS_ROWSC + 8192;
constexpr int LDS_START = LDS_MISC + 256;
constexpr int LDS_CNT = LDS_START + 1280;
constexpr int LDS_TB = LDS_CNT + 1280;
constexpr int LDS_BYTES = 155648;
static_assert(LDS_TB + 1280 <= LDS_BYTES, "lds map");

#define XB_TMO      128
#define XB_XCNT(j)  (256  + 64 * (j))
#define XB_XSUB(j)  (1280 + 64 * (j))
#define XB_XGEN(j)  (2304 + 64 * (j))
#define XB_TOP      3328
#define XB_TOPGEN   3392
#define XCD_BAR_WORDS 3456
#define XB_SPIN_CAP (1u << 22)
#define LAS __attribute__((address_space(3)))

__device__ __forceinline__ unsigned xb_ld(unsigned* p)              { return __hip_atomic_load(p, __ATOMIC_RELAXED, __HIP_MEMORY_SCOPE_AGENT); }
__device__ __forceinline__ unsigned xb_add(unsigned* p, unsigned v) { return __hip_atomic_fetch_add(p, v, __ATOMIC_RELAXED, __HIP_MEMORY_SCOPE_AGENT); }
__device__ __forceinline__ unsigned xb_xcc_id() { return (unsigned)__builtin_amdgcn_s_getreg((3 << 11) | 20) & 0xFu; }
#define XB_SPIN(cond, bar) do { unsigned _sp = 0; while (cond) { __builtin_amdgcn_s_sleep(1); \
    if ((++_sp & 255u) == 0u) { if (xb_ld(&(bar)[XB_TMO])) break; if (_sp > XB_SPIN_CAP) { atomicAdd(&(bar)[XB_TMO], 1u); break; } } } } while (0)

struct XcdBarrier { unsigned* bar; unsigned x; volatile LAS unsigned* st; };

__device__ __forceinline__ XcdBarrier xcd_barrier_post(unsigned* bar, volatile LAS unsigned* st, const bool leader) {
    XcdBarrier b; b.bar = bar; b.x = xb_xcc_id(); b.st = st;
    if (leader) (void)xb_add(&bar[XB_XCNT(b.x)], 1u);
    return b;
}
__device__ __forceinline__ void xcd_barrier_complete(unsigned* bar, unsigned x, unsigned& nloc, unsigned& nx) {
    const unsigned G = gridDim.x * gridDim.y * gridDim.z;
    unsigned sum, cnt, mine, sp = 0u;
    for (;;) {
        sum = 0u; cnt = 0u; mine = 0u;
#pragma unroll
        for (unsigned j = 0; j < 16; ++j) { const unsigned c = xb_ld(&bar[XB_XCNT(j)]); sum += c; cnt += (c > 0u) ? 1u : 0u; mine = (j == x) ? c : mine; }
        if (sum == G) break;
        __builtin_amdgcn_s_sleep(1);
        if ((++sp & 255u) == 0u) { if (xb_ld(&bar[XB_TMO])) break; if (sp > XB_SPIN_CAP) { atomicAdd(&bar[XB_TMO], 1u); break; } }
    }
    nloc = mine > 0u ? mine : 1u; nx = cnt > 0u ? cnt : 1u;
}
__device__ __forceinline__ void xcd_barrier(const XcdBarrier& b, const bool leader) {
    asm volatile("s_waitcnt vmcnt(0)" ::: "memory");
    __syncthreads();
    if (leader) {
        unsigned* bar = b.bar;
        __builtin_amdgcn_s_waitcnt(0);
        unsigned nloc = b.st[0], nx = b.st[1];
        if (nloc == 0u) { xcd_barrier_complete(bar, b.x, nloc, nx); b.st[0] = nloc; b.st[1] = nx; }
        const unsigned old = xb_add(&bar[XB_XSUB(b.x)], 1u);
        const unsigned gen = old / nloc;
        if (old + 1u == (gen + 1u) * nloc) {
            __builtin_amdgcn_fence(__ATOMIC_RELEASE, "agent");
            asm volatile("s_waitcnt vmcnt(0)" ::: "memory");
            const unsigned og = xb_add(&bar[XB_TOP], 1u);
            const unsigned tg = og / nx;
            if (og + 1u == (tg + 1u) * nx) xb_add(&bar[XB_TOPGEN], 1u);
            else XB_SPIN(xb_ld(&bar[XB_TOPGEN]) == tg, bar);
            __builtin_amdgcn_fence(__ATOMIC_ACQUIRE, "agent");
            xb_add(&bar[XB_XGEN(b.x)], 1u);
            asm volatile("s_waitcnt vmcnt(0)" ::: "memory");
        } else {
            XB_SPIN(xb_ld(&bar[XB_XGEN(b.x)]) == gen, bar);
            __builtin_amdgcn_fence(__ATOMIC_ACQUIRE, "agent");
            asm volatile("s_waitcnt vmcnt(0)" ::: "memory");
        }
    }
    __syncthreads();
}

DEVI float bf2f(bf16_t v) { return __uint_as_float(((unsigned)v) << 16); }
typedef float f32x2_t __attribute__((ext_vector_type(2)));
typedef __bf16 bf16x2_t __attribute__((ext_vector_type(2)));
DEVI unsigned pk2(float lo, float hi) { f32x2_t v = {lo, hi}; bf16x2_t b = __builtin_convertvector(v, bf16x2_t); return __builtin_bit_cast(unsigned, b); }
#define dppf(v, ctrl) __int_as_float(__builtin_amdgcn_update_dpp(0, __float_as_int(v), (ctrl), 0xf, 0xf, false))
#define dppi(v, ctrl) __builtin_amdgcn_update_dpp(0, (v), (ctrl), 0xf, 0xf, false)
#define DPP_X1 0xB1
#define DPP_X2 0x4E
#define DPP_HM 0x141
#define DPP_RM 0x140
DEVI float x16f(float v, float& o) { auto r = __builtin_amdgcn_permlane16_swap(__float_as_uint(v), __float_as_uint(v), false, false); o = __uint_as_float(r[1]); return __uint_as_float(r[0]); }
DEVI float x32f(float v, float& o) { auto r = __builtin_amdgcn_permlane32_swap(__float_as_uint(v), __float_as_uint(v), false, false); o = __uint_as_float(r[1]); return __uint_as_float(r[0]); }
DEVI float sum32(float v) { float o; const float a = x32f(v, o); return a + o; }
DEVI float max32(float v) { float o; const float a = x32f(v, o); return fmaxf(a, o); }
DEVI float wave_sum(float v) {
    v += dppf(v, DPP_X1); v += dppf(v, DPP_X2); v += dppf(v, DPP_HM); v += dppf(v, DPP_RM);
    { float o; const float a = x16f(v, o); v = a + o; }
    { float o; const float a = x32f(v, o); v = a + o; }
    return v;
}
DEVI int perm_slot(int cl) { return 16 * ((cl >> 2) & 1) + 4 * (cl >> 3) + (cl & 3); }
DEVI int perm_row(int n) { return (n & ~31) + perm_slot(n & 31); }
DEVI float ex2(float x) { return __builtin_amdgcn_exp2f(x); }
DEVI float siluf(float v) { return v * __builtin_amdgcn_rcpf(1.0f + __expf(-v)); }

namespace g8 {
constexpr int BK = 64, HALF = 128, HT = HALF * BK;
DEVI int lds_byte(int r, int c) { int st = (r >> 4) * 2 + (c >> 5), rr = r & 15, cc = c & 31, ob = rr * 64 + cc * 2; return st * 1024 + (ob ^ (((ob >> 9) & 1) << 5)); }
DEVI void stage_rc(int b, int& R, int& C) { int st = b / 1024, sb = b % 1024, swz = sb ^ (((sb >> 9) & 1) << 5); R = (st >> 1) * 16 + swz / 64; C = (st & 1) * 32 + (swz % 64) / 2; }
}

DEVI void g8_rc(int tid, int& R0, int& C0) { g8::stage_rc(tid * 16, R0, C0); }
DEVI void g8_voff_lin(unsigned (&v)[4], int ld, int tid) { int R0, C0; g8_rc(tid, R0, C0);
    v[0] = (unsigned)(R0 * ld + C0) * 2u; v[1] = (unsigned)((R0 + 64) * ld + C0) * 2u; v[2] = (unsigned)((R0 + 128) * ld + C0) * 2u; v[3] = (unsigned)((R0 + 192) * ld + C0) * 2u; }
DEVI void g8_voff_tab(unsigned (&v)[4], const LAS unsigned* tab, int tid) { int R0, C0; g8_rc(tid, R0, C0);
    v[0] = (tab[R0] + C0) * 2u; v[1] = (tab[R0 + 64] + C0) * 2u; v[2] = (tab[R0 + 128] + C0) * 2u; v[3] = (tab[R0 + 192] + C0) * 2u; }

template <class Epi>
DEVI void gemm_tile(LAS unsigned char* lds, const int tid_in, const char* Ab, const unsigned (&voffA_)[4], const char* Bb, const int K, const Epi& epi) {
    using namespace g8;
    constexpr int HTB = HALF * BK * 2;
    int tz = tid_in; asm volatile("" : "+v"(tz));
    int wid = tz >> 6, lane = tz & 63, wr = wid >> 2, wc = wid & 3, fr = lane & 15, fq = lane >> 4;
    unsigned voffA[4] = {voffA_[0], voffA_[1], voffA_[2], voffA_[3]};
    asm volatile("" : "+v"(voffA[0]), "+v"(voffA[1]), "+v"(voffA[2]), "+v"(voffA[3]));
    unsigned voffB[2];
    { int R0, C0; stage_rc(tz * 16, R0, C0); voffB[0] = (unsigned)(R0 * K + C0) * 2u; voffB[1] = (unsigned)((R0 + 64) * K + C0) * 2u; }
    const size_t kstep = (size_t)(BK * 2);
    const size_t hstepB = (size_t)HALF * K * 2;
    const unsigned ldsw = (unsigned)wid * 1024u;
    const int aoff = lds_byte(wr * 64 + fr, fq * 8), boff = lds_byte(wc * 32 + fr, fq * 8);
#define G8_SA(b, h) (((b) * 2 + (h)) * HTB)
#define G8_SB(b, h) ((4 + (b) * 2 + (h)) * HTB)
#define G8_GL(gp, lofs) __builtin_amdgcn_global_load_lds((const unsigned*)(gp), (LAS unsigned*)(lds + (lofs)), 16, 0, 0)
#define STAGE_A(b, h, kt) do { const char* g_ = Ab + (size_t)(kt) * kstep; G8_GL(g_ + voffA[(h) * 2], G8_SA(b, h) + ldsw); G8_GL(g_ + voffA[(h) * 2 + 1], G8_SA(b, h) + ldsw + 8192); } while (0)
#define STAGE_B(b, h, kt) do { const char* g_ = Bb + (size_t)(kt) * kstep + ((h) ? hstepB : 0); G8_GL(g_ + voffB[0], G8_SB(b, h) + ldsw); G8_GL(g_ + voffB[1], G8_SB(b, h) + ldsw + 8192); } while (0)
#define LDA(dst, b, h) do { _Pragma("unroll") for (int m = 0; m < 4; ++m) _Pragma("unroll") for (int k = 0; k < 2; ++k) dst[m][k] = *(const LAS bf16x8*)(lds + G8_SA(b, h) + aoff + m * 2048 + k * 1024); } while (0)
#define LDB(dst, b, h) do { _Pragma("unroll") for (int n = 0; n < 2; ++n) _Pragma("unroll") for (int k = 0; k < 2; ++k) dst[n][k] = *(const LAS bf16x8*)(lds + G8_SB(b, h) + boff + n * 2048 + k * 1024); } while (0)
#define MMA(ai, bj, Af, Bf) do { __builtin_amdgcn_s_setprio(1); \
    _Pragma("unroll") for (int m = 0; m < 4; ++m) _Pragma("unroll") for (int n = 0; n < 2; ++n) _Pragma("unroll") for (int k = 0; k < 2; ++k) \
      acc[ai][bj][m][n] = __builtin_amdgcn_mfma_f32_16x16x32_bf16(Bf[n][k], Af[m][k], acc[ai][bj][m][n], 0, 0, 0); \
    __builtin_amdgcn_s_setprio(0); } while (0)
#define WAIT_V(n) asm volatile("s_waitcnt vmcnt(" #n ")" ::: "memory")
#define WAIT_L(n) asm volatile("s_waitcnt lgkmcnt(" #n ")" ::: "memory")
#define BAR __builtin_amdgcn_s_barrier()
#define SCHED __builtin_amdgcn_sched_barrier(0)
    f32x4 acc[2][2][4][2];
#pragma unroll
    for (int a = 0; a < 2; ++a)
#pragma unroll
        for (int b = 0; b < 2; ++b)
#pragma unroll
            for (int m = 0; m < 4; ++m)
#pragma unroll
                for (int n = 0; n < 2; ++n) acc[a][b][m][n] = (f32x4){0.f, 0.f, 0.f, 0.f};
    bf16x8 At[4][2], B0[2][2], B1[2][2];
    const int nt = K / BK;
    STAGE_B(0, 0, 0); STAGE_A(0, 0, 0); STAGE_B(0, 1, 0); STAGE_A(0, 1, 0);
    if (wr == 1) BAR;
    WAIT_V(4); BAR;
    STAGE_B(1, 0, 1); STAGE_A(1, 0, 1); STAGE_B(1, 1, 1);
    WAIT_V(6); BAR;
#pragma unroll 1
    for (int t = 0; t < nt; t += 2) {
        const int t2 = (t == nt - 2) ? 0 : t + 2;
        const int t3 = t2 + 1;
        LDB(B0, 0, 0); SCHED; LDA(At, 0, 0); STAGE_A(1, 1, t + 1);
        WAIT_L(8); BAR; WAIT_L(0); MMA(0, 0, At, B0); BAR; SCHED;
        LDB(B1, 0, 1); STAGE_B(0, 0, t2);
        BAR; WAIT_L(0); MMA(0, 1, At, B1); BAR;
        LDA(At, 0, 1); STAGE_A(0, 0, t2);
        BAR; WAIT_L(0); MMA(1, 0, At, B0); BAR; SCHED;
        STAGE_B(0, 1, t2);
        WAIT_V(6); BAR; MMA(1, 1, At, B1); BAR;
        LDB(B0, 1, 0); SCHED; LDA(At, 1, 0); STAGE_A(0, 1, t2);
        WAIT_L(8); BAR; WAIT_L(0); MMA(0, 0, At, B0); BAR; SCHED;
        LDB(B1, 1, 1); STAGE_B(1, 0, t3);
        BAR; WAIT_L(0); MMA(0, 1, At, B1); BAR;
        LDA(At, 1, 1); STAGE_A(1, 0, t3);
        BAR; WAIT_L(0); MMA(1, 0, At, B0); BAR; SCHED;
        STAGE_B(1, 1, t3);
        WAIT_V(6); BAR; MMA(1, 1, At, B1); BAR;
    }
    WAIT_V(0);
    if (wr == 0) BAR;
    BAR;
    asm volatile("" : "+v"(tz)); wid = tz >> 6; lane = tz & 63; wr = wid >> 2; wc = wid & 3; fr = lane & 15; fq = lane >> 4;
    epi(acc, wr, wc, fr, fq);
#undef G8_SA
#undef G8_SB
#undef G8_GL
#undef STAGE_A
#undef STAGE_B
#undef LDA
#undef LDB
#undef MMA
}
struct GDesc { const char* Ab; const char* Bb; unsigned va0, va1, va2, va3; int i0, i1, i2; };
template <class Next, class Epi>
DEVI void gemm_stream(LAS unsigned char* lds, const int tid_in, const int K, Next& next, const Epi& epi) {
    using namespace g8;
    constexpr int HTB = HALF * BK * 2;
    int tz = tid_in; asm volatile("" : "+v"(tz));
    int wid = tz >> 6, lane = tz & 63, wr = wid >> 2, wc = wid & 3, fr = lane & 15, fq = lane >> 4;
    unsigned voffB[2];
    { int R0, C0; stage_rc(tz * 16, R0, C0); voffB[0] = (unsigned)(R0 * K + C0) * 2u; voffB[1] = (unsigned)((R0 + 64) * K + C0) * 2u; }
    const size_t kstep = (size_t)(BK * 2);
    const size_t hstepB = (size_t)HALF * K * 2;
    const unsigned ldsw = (unsigned)wid * 1024u;
    const int aoff = lds_byte(wr * 64 + fr, fq * 8), boff = lds_byte(wc * 32 + fr, fq * 8);
#define G8_SA(b, h) (((b) * 2 + (h)) * HTB)
#define G8_SB(b, h) ((4 + (b) * 2 + (h)) * HTB)
#define G8_GL(gp, lofs) __builtin_amdgcn_global_load_lds((const unsigned*)(gp), (LAS unsigned*)(lds + (lofs)), 16, 0, 0)
#define STG_A(b, h, gb, v0, v1) do { G8_GL((gb) + (v0), G8_SA(b, h) + ldsw); G8_GL((gb) + (v1), G8_SA(b, h) + ldsw + 8192); } while (0)
#define STG_B(b, h, gb) do { const char* g_ = (gb) + ((h) ? hstepB : 0); G8_GL(g_ + voffB[0], G8_SB(b, h) + ldsw); G8_GL(g_ + voffB[1], G8_SB(b, h) + ldsw + 8192); } while (0)
#define LDA(dst, b, h) do { _Pragma("unroll") for (int m = 0; m < 4; ++m) _Pragma("unroll") for (int k = 0; k < 2; ++k) dst[m][k] = *(const LAS bf16x8*)(lds + G8_SA(b, h) + aoff + m * 2048 + k * 1024); } while (0)
#define LDB(dst, b, h) do { _Pragma("unroll") for (int n = 0; n < 2; ++n) _Pragma("unroll") for (int k = 0; k < 2; ++k) dst[n][k] = *(const LAS bf16x8*)(lds + G8_SB(b, h) + boff + n * 2048 + k * 1024); } while (0)
#define MMA(ai, bj, Af, Bf) do { __builtin_amdgcn_s_setprio(1); \
    _Pragma("unroll") for (int m = 0; m < 4; ++m) _Pragma("unroll") for (int n = 0; n < 2; ++n) _Pragma("unroll") for (int k = 0; k < 2; ++k) \
      acc[ai][bj][m][n] = __builtin_amdgcn_mfma_f32_16x16x32_bf16(Bf[n][k], Af[m][k], acc[ai][bj][m][n], 0, 0, 0); \
    __builtin_amdgcn_s_setprio(0); } while (0)
#define ZACC() do { _Pragma("unroll") for (int a = 0; a < 2; ++a) _Pragma("unroll") for (int b = 0; b < 2; ++b) _Pragma("unroll") for (int m = 0; m < 4; ++m) _Pragma("unroll") for (int n = 0; n < 2; ++n) acc[a][b][m][n] = (f32x4){0.f, 0.f, 0.f, 0.f}; } while (0)
    GDesc cur, nxt;
    if (!next(0, cur)) return;
    nxt = cur;
    f32x4 acc[2][2][4][2];
    ZACC();
    bf16x8 At[4][2], B0[2][2], B1[2][2];
    const int nt = K / BK;
    STG_B(0, 0, cur.Bb); STG_A(0, 0, cur.Ab, cur.va0, cur.va1); STG_B(0, 1, cur.Bb); STG_A(0, 1, cur.Ab, cur.va2, cur.va3);
    if (wr == 1) BAR;
    WAIT_V(4); BAR;
    STG_B(1, 0, cur.Bb + kstep); STG_A(1, 0, cur.Ab + kstep, cur.va0, cur.va1); STG_B(1, 1, cur.Bb + kstep);
    WAIT_V(6); BAR;
    int ui = 0; bool has_next = false;
#pragma unroll 1
    for (;;) {
#pragma unroll 1
        for (int t = 0; t < nt; t += 2) {
            const bool last = (t == nt - 2);
            if (last) { has_next = next(ui + 1, nxt); if (!has_next) nxt = cur; }
            const char* a2 = last ? nxt.Ab : cur.Ab + (size_t)(t + 2) * kstep;
            const char* b2 = last ? nxt.Bb : cur.Bb + (size_t)(t + 2) * kstep;
            const unsigned s0 = last ? nxt.va0 : cur.va0, s1 = last ? nxt.va1 : cur.va1, s2 = last ? nxt.va2 : cur.va2, s3 = last ? nxt.va3 : cur.va3;
            LDB(B0, 0, 0); SCHED; LDA(At, 0, 0); STG_A(1, 1, cur.Ab + (size_t)(t + 1) * kstep, cur.va2, cur.va3);
            WAIT_L(8); BAR; WAIT_L(0); MMA(0, 0, At, B0); BAR; SCHED;
            LDB(B1, 0, 1); STG_B(0, 0, b2);
            BAR; WAIT_L(0); MMA(0, 1, At, B1); BAR;
            LDA(At, 0, 1); STG_A(0, 0, a2, s0, s1);
            BAR; WAIT_L(0); MMA(1, 0, At, B0); BAR; SCHED;
            STG_B(0, 1, b2);
            WAIT_V(6); BAR; MMA(1, 1, At, B1); BAR;
            LDB(B0, 1, 0); SCHED; LDA(At, 1, 0); STG_A(0, 1, a2, s2, s3);
            WAIT_L(8); BAR; WAIT_L(0); MMA(0, 0, At, B0); BAR; SCHED;
            LDB(B1, 1, 1); STG_B(1, 0, b2 + kstep);
            BAR; WAIT_L(0); MMA(0, 1, At, B1); BAR;
            LDA(At, 1, 1); STG_A(1, 0, a2 + kstep, s0, s1);
            BAR; WAIT_L(0); MMA(1, 0, At, B0); BAR; SCHED;
            STG_B(1, 1, b2 + kstep);
            WAIT_V(6); BAR; MMA(1, 1, At, B1); BAR;
        }
        {
            int tq = tz; asm volatile("" : "+v"(tq));
            const int wid_ = tq >> 6, lane_ = tq & 63;
            epi(acc, cur, wid_ >> 2, wid_ & 3, lane_ & 15, lane_ >> 4);
        }
        if (!has_next) break;
        ZACC();
        cur = nxt; ++ui;
    }
    WAIT_V(0);
    if (wr == 0) BAR;
    BAR;
#undef G8_SA
#undef G8_SB
#undef G8_GL
#undef STG_A
#undef STG_B
#undef LDA
#undef LDB
#undef MMA
#undef ZACC
}
#define EPI_FOREACH8(acc, wr, wc, fr, fq, ROW, COL8, V0, V1, ...) \
    _Pragma("unroll") for (int ai_ = 0; ai_ < 2; ++ai_) _Pragma("unroll") for (int m_ = 0; m_ < 4; ++m_) { const int ROW = ai_ * 128 + (wr) * 64 + m_ * 16 + (fr); \
    _Pragma("unroll") for (int bj_ = 0; bj_ < 2; ++bj_) { const int COL8 = bj_ * 128 + (wc) * 32 + (fq) * 8; const f32x4 V0 = acc[ai_][bj_][m_][0]; const f32x4 V1 = acc[ai_][bj_][m_][1]; __VA_ARGS__ } }
#define PK8(w, a, b) do { w.x = pk2(a[0], a[1]); w.y = pk2(a[2], a[3]); w.z = pk2(b[0], b[1]); w.w = pk2(b[2], b[3]); } while (0)

template <class SCol, class DRow, class KS, class NS>
DEVI void convert_T(bf16_t* __restrict__ dst, const float* __restrict__ src, int ld, int K, int NR, SCol scol, DRow drow, KS ks, NS ns, int wi, int nw) {
    const int k8n = K >> 3; const int items = NR * k8n;
    for (int it = wi; it < items; it += nw) {
        const int n = it % NR, k0 = (it / NR) << 3;
        const int sc = scol(n);
        float v[8];
#pragma unroll
        for (int j = 0; j < 8; ++j) v[j] = (sc >= 0) ? src[(size_t)(k0 + j) * ld + sc] * ks(k0 + j) : 0.f;
        const float s = ns(n);
        u32x4 w; w.x = pk2(v[0] * s, v[1] * s); w.y = pk2(v[2] * s, v[3] * s); w.z = pk2(v[4] * s, v[5] * s); w.w = pk2(v[6] * s, v[7] * s);
        *(u32x4*)(dst + (size_t)drow(n) * K + k0) = w;
    }
}
struct IdCol { DEVI int operator()(int n) const { return n; } };
struct OneK { DEVI float operator()(int) const { return 1.f; } };
struct VecK { const float* g; DEVI float operator()(int k) const { return g[k]; } };

template <int NB, bool PERM>
DEVI void convert_panel(bf16_t* __restrict__ dst, const float* __restrict__ src, const int ld, const int K, const int tid) {
    constexpr int N4 = NB / 4;
    const int items = (K >> 3) * N4;
#pragma unroll 1
    for (int it0 = tid; it0 < items; it0 += 1024) {
        f32x4 v[2][8];
#pragma unroll
        for (int u = 0; u < 2; ++u) {
            const int it = it0 + u * 512; const int n4 = it % N4, k8 = it / N4;
            const float* sp = src + (size_t)(k8 * 8) * ld + n4 * 4;
#pragma unroll
            for (int j = 0; j < 8; ++j) v[u][j] = *(const f32x4*)(sp + (size_t)j * ld);
        }
#pragma unroll
        for (int u = 0; u < 2; ++u) {
            const int it = it0 + u * 512; const int n4 = it % N4, k8 = it / N4;
#pragma unroll
            for (int c = 0; c < 4; ++c) {
                u32x4 w; w.x = pk2(v[u][0][c], v[u][1][c]); w.y = pk2(v[u][2][c], v[u][3][c]); w.z = pk2(v[u][4][c], v[u][5][c]); w.w = pk2(v[u][6][c], v[u][7][c]);
                const int n = n4 * 4 + c; const int dr = PERM ? ((n & ~31) + perm_slot(n & 31)) : n;
                *(u32x4*)(dst + (size_t)dr * K + k8 * 8) = w;
            }
        }
    }
}

template <int NB, bool PERM>
DEVI void convert_panel_lds(bf16_t* __restrict__ dst, const float* __restrict__ src, const int ld, const int K, const int tid, LAS unsigned char* lds) {
    constexpr int N4 = NB / 4;
    constexpr int K8C = 512 / N4;
    constexpr int KC = K8C * 8;
    constexpr int PITCH = KC * 2 + 8;
    constexpr int PPR = KC / 8;
    const int n4 = tid % N4, k8 = tid / N4;
    const float* sp = src + (size_t)(k8 * 8) * ld + n4 * 4;
    const int nchunk = K / KC;
    f32x4 va[8], vb[8], vc[8];
#define CPL_LOAD(V, c) do { const float* q_ = sp + (size_t)(c) * KC * ld; _Pragma("unroll") for (int j = 0; j < 8; ++j) V[j] = *(const f32x4*)(q_ + (size_t)j * ld); } while (0)
#define CPL_PROC(V, c) do { \
        _Pragma("unroll") for (int cc = 0; cc < 4; ++cc) { \
            u32x2 lo, hi; lo.x = pk2(V[0][cc], V[1][cc]); lo.y = pk2(V[2][cc], V[3][cc]); hi.x = pk2(V[4][cc], V[5][cc]); hi.y = pk2(V[6][cc], V[7][cc]); \
            LAS unsigned char* wp = lds + (n4 * 4 + cc) * PITCH + k8 * 16; \
            *(LAS u32x2*)wp = lo; *(LAS u32x2*)(wp + 8) = hi; } \
        __syncthreads(); \
        _Pragma("unroll") for (int q = 0; q < 4; ++q) { \
            const int p = tid + 512 * q; const int row = p / PPR, pc = p % PPR; \
            const LAS unsigned char* rp = lds + row * PITCH + pc * 16; \
            const u32x2 a = *(const LAS u32x2*)rp, b = *(const LAS u32x2*)(rp + 8); \
            const int dr = PERM ? ((row & ~31) + perm_slot(row & 31)) : row; \
            u32x4 w; w.x = a.x; w.y = a.y; w.z = b.x; w.w = b.y; \
            *(u32x4*)(dst + (size_t)dr * K + (c) * KC + pc * 8) = w; } \
        __syncthreads(); } while (0)
    CPL_LOAD(va, 0); if (nchunk > 1) CPL_LOAD(vb, 1); if (nchunk > 2) CPL_LOAD(vc, 2);
#pragma unroll 1
    for (int c = 0; c < nchunk; c += 3) {
        CPL_PROC(va, c); if (c + 3 < nchunk) CPL_LOAD(va, c + 3);
        if (c + 1 < nchunk) { CPL_PROC(vb, c + 1); if (c + 4 < nchunk) CPL_LOAD(vb, c + 4); }
        if (c + 2 < nchunk) { CPL_PROC(vc, c + 2); if (c + 5 < nchunk) CPL_LOAD(vc, c + 5); }
    }
#undef CPL_LOAD
#undef CPL_PROC
}

struct Params {
    const float* in[24];
    float* out;
    unsigned char* ws;
    int ph_lo, ph_hi;
    int flags, pad;
};
enum { I_X = 0, I_C, I_WADA, I_BADA, I_N1G, I_WIN, I_QNG, I_WUQ, I_KVNG, I_WUKV, I_REL, I_AOG, I_BOG, I_WO, I_N2G, I_WR, I_EB, I_W1, I_W3, I_W2, I_WS1, I_WS3, I_WS2, I_FG };
constexpr int NPHASE = 15;

#define W_x (P.in[I_X])
#define W_mod ((float*)(ws + OFF_MOD))
#define W_ropecs ((float*)(ws + OFF_ROPE))
#define W_biasT ((float*)(ws + OFF_BIAS))
#define W_WinT ((bf16_t*)(ws + OFF_WIN))
#define W_WuqT ((bf16_t*)(ws + OFF_WUQ))
#define W_WukvT ((bf16_t*)(ws + OFF_WUKV))
#define W_WoT ((bf16_t*)(ws + OFF_WO))
#define W_WrT ((bf16_t*)(ws + OFF_WR))
#define W_Ws13T ((bf16_t*)(ws + OFF_WS13))
#define W_Ws2T ((bf16_t*)(ws + OFF_WS2))
#define W_hbuf ((bf16_t*)(ws + OFF_H))
#define W_logits ((float*)(ws + OFF_LOGITS))
#define W_eidx ((int*)(ws + OFF_EIDX))
#define W_gate ((float*)(ws + OFF_GATE))
#define W_rnk ((int*)(ws + OFF_RNK))
#define W_pos ((int*)(ws + OFF_POS))
#define W_toks ((int*)(ws + OFF_TOKS))
#define W_wts ((float*)(ws + OFF_WTS))
#define W_ssq ((float*)(ws + OFF_SSQ))
#define W_scr ((bf16_t*)(ws + OFF_SCR + (size_t)blk * SCR_PER_BLK))
#define W_hdn ((bf16_t*)(ws + OFF_HDN))
#define W_ybuf ((bf16_t*)(ws + OFF_Y))
#define W_y8 ((unsigned char*)(ws + OFF_Y))
#define W_proj ((bf16_t*)(ws + OFF_PROJ))
#define W_qb ((bf16_t*)(ws + OFF_QB))
#define W_kvb ((bf16_t*)(ws + OFF_KVB))
#define W_bout ((bf16_t*)(ws + OFF_BOUT))
#define W_aparts ((bf16_t*)(ws + OFF_APARTS))
#define W_lsebuf ((float*)(ws + OFF_LSE))
#define W_mixb ((bf16_t*)(ws + OFF_MIX))
#define W_xt ((bf16_t*)(ws + OFF_XT))

__global__ void __launch_bounds__(512, 2) fwd_kernel(Params P) {
    extern __shared__ __attribute__((aligned(16))) unsigned char lds[];
    const int blk = blockIdx.x, G = gridDim.x;
    const int wave_s = __builtin_amdgcn_readfirstlane((int)threadIdx.x >> 6);
#define TIDS0 int tid; asm volatile("v_mbcnt_lo_u32_b32 %0, -1, 0\n\tv_mbcnt_hi_u32_b32 %0, -1, %0" : "=v"(tid)); tid += wave_s * 64;
    const int vblk = (G % 8 == 0) ? (blk % 8) * (G / 8) + blk / 8 : blk;
    unsigned char* ws = P.ws;
    unsigned* ctl = (unsigned*)(ws + OFF_CTL);
    { TIDS0 if (tid < 64) ((LAS unsigned*)(lds + LDS_MISC))[tid] = 0u; }
    __syncthreads();
    XcdBarrier bar; bar.bar = ctl; bar.x = 0; bar.st = nullptr;
    if (MK_N_LAUNCHES == 1) { TIDS0 bar = xcd_barrier_post(ctl, (volatile LAS unsigned*)(lds + LDS_MISC), tid == 0); }
#ifndef PH_MASK
#define PH_MASK 0xffffffffu
#endif
#define TIDS int tid; asm volatile("v_mbcnt_lo_u32_b32 %0, -1, 0\n\tv_mbcnt_hi_u32_b32 %0, -1, %0" : "=v"(tid)); tid += wave_s * 64; const int lane = tid & 63; const int wave = wave_s; (void)lane; (void)wave;
#define IN(k) ((((PH_MASK) >> (k)) & 1u) && P.ph_lo <= (k) && (k) < P.ph_hi)
#define SEAM(k) do { if (MK_N_LAUNCHES == 1 && IN(k) && IN((k) + 1)) { TIDS0 xcd_barrier(bar, tid == 0); } } while (0)

    unsigned* cntg = ctl + CNT_WORD0;
    LAS unsigned* rowoff = (LAS unsigned*)(lds + LDS_ROWOFF);
    LAS float* rowsc = (LAS float*)(lds + LDS_ROWSC);
    LAS int* startL = (LAS int*)(lds + LDS_START);
    LAS int* cntL = (LAS int*)(lds + LDS_CNT);
    LAS int* tbL = (LAS int*)(lds + LDS_TB);
    LAS int* itemD = (LAS int*)(lds + LDS_MISC + 64);
    char* stage = (char*)lds + LDS_STAGE;
    LAS unsigned char* ldsL = (LAS unsigned char*)lds;

    if (IN(0)) {
        TIDS
        {
            float* sc = (float*)(lds);
            float* red = (float*)(lds + 32768);
            const float* c = P.in[I_C];
            for (int i = tid; i < 8192; i += 512) sc[i] = siluf(c[i]);
            __syncthreads();
            for (int cb = blk; cb < 256; cb += G) {
                const int cj = tid & 31, kg = tid >> 5;
                float a0 = 0, a1 = 0, a2 = 0, a3 = 0, a4 = 0, a5 = 0, a6 = 0, a7 = 0;
                if (cj < 24) {
                    const float* w = P.in[I_WADA] + cb * 24 + cj;
                    for (int k = kg * 64; k < kg * 64 + 64; ++k) {
                        const float wv = w[(size_t)k * 6144];
                        a0 += sc[k] * wv; a1 += sc[1024 + k] * wv; a2 += sc[2048 + k] * wv; a3 += sc[3072 + k] * wv;
                        a4 += sc[4096 + k] * wv; a5 += sc[5120 + k] * wv; a6 += sc[6144 + k] * wv; a7 += sc[7168 + k] * wv;
                    }
                }
                float* rp = red + (kg * 8) * 32 + cj;
                rp[0] = a0; rp[32] = a1; rp[64] = a2; rp[96] = a3; rp[128] = a4; rp[160] = a5; rp[192] = a6; rp[224] = a7;
                __syncthreads();
                if (tid < 256) {
                    const int b = tid >> 5, j = tid & 31;
                    if (j < 24) {
                        float s = 0.f;
                        for (int g = 0; g < 16; ++g) s += red[(g * 8 + b) * 32 + j];
                        const int col = cb * 24 + j;
                        W_mod[b * 6144 + col] = s + P.in[I_BADA][col];
                    }
                }
                __syncthreads();
            }
        }
        {
            for (int idx = blk * 512 + tid; idx < 4096 * 16; idx += G * 512) {
                const int s = idx >> 4, i = idx & 15;
                double inv = 1.0; for (int j = 0; j < i; ++j) inv *= 0.5623413251903491;
                const float invf = (float)inv;
                const float angf = (float)s * invf;
                const double xa = (double)angf;
                const double nrev = __builtin_rint(xa * 0.15915494309189535);
                const double r = xa - nrev * 6.283185307179586;
                const double r2 = r * r;
                double ts = r, ss = r, tc = 1.0, cc = 1.0;
#pragma unroll
                for (int n = 1; n <= 14; ++n) {
                    ts *= -r2 / (double)((2 * n) * (2 * n + 1)); ss += ts;
                    tc *= -r2 / (double)((2 * n - 1) * (2 * n)); cc += tc;
                }
                W_ropecs[idx * 2] = (float)cc; W_ropecs[idx * 2 + 1] = (float)ss;
            }
        }
        {
            for (int idx = blk * 512 + tid; idx < 3 * 8 * 129; idx += G * 512) {
                const int j = idx % 129, hh = (idx / 129) % 8, p = idx / (129 * 8);
                const int dil = (p == 0) ? 1 : (p == 1 ? 4 : 16);
                const int rel = (j - 64) * dil;
                const int n = rel < 0 ? -rel : rel;
                const float nf = (float)(n > 1 ? n : 1);
                int large = 8 + (int)(__logf(nf * 0.125f) / 4.852030263919617f * 8.0f);
                large = large < 15 ? large : 15;
                const int bucket = (rel > 0 ? 16 : 0) + (n < 8 ? n : large);
                W_biasT[idx] = P.in[I_REL][bucket * 8 + hh] * LOG2E;
            }
        }
        {
            const int wi = blk * 512 + tid, nw = G * 512;
            convert_T(W_WinT, P.in[I_WIN], INC, 1024, INCP,
                      [](int n) { if (n >= INC) return -1; if (n < 2176) return n; const int i = n - 2176; return 2176 + ((i & 1) ? 16 : 0) + (i >> 1); },
                      [](int n) { return perm_row(n); }, OneK{}, [](int n) { return n < 512 ? 0.125f * LOG2E : 1.0f; }, wi, nw);
            convert_T(W_WuqT, P.in[I_WUQ], 768, 384, 768,
                      [](int n) { if (n < 512) return (n >> 6) * 96 + (n & 63); const int hh = (n - 512) >> 5, i = n & 31; return hh * 96 + 64 + ((i & 1) ? 16 : 0) + (i >> 1); },
                      [](int n) { return perm_row(n); }, VecK{P.in[I_QNG]}, [](int) { return 0.10206207261596577f * LOG2E; }, wi, nw);
            convert_T(W_WukvT, P.in[I_WUKV], 1024, 256, 1024, IdCol{}, [](int n) { return perm_row(n); }, VecK{P.in[I_KVNG]}, [](int) { return 1.f; }, wi, nw);
            {
                const float* ag = P.in[I_AOG]; const float* bg = P.in[I_BOG];
                convert_T(W_WoT, P.in[I_WO], 1024, 1024, 1024, IdCol{}, [](int n) { return perm_row(n); }, [=](int k) { return k < 512 ? ag[k] : bg[k - 512]; }, [](int) { return 1.f; }, wi, nw);
            }
            convert_T(W_WrT, P.in[I_WR], 256, 1024, 256, IdCol{}, [](int n) { return perm_row(n); }, OneK{}, [](int) { return 1.f; }, wi, nw);
            convert_T(W_Ws13T, P.in[I_WS1], 256, 1024, 256, IdCol{}, [](int n) { return perm_row((n >> 7) * 256 + (n & 127)); }, OneK{}, [](int) { return 1.f; }, wi, nw);
            convert_T(W_Ws13T, P.in[I_WS3], 256, 1024, 256, IdCol{}, [](int n) { return perm_row((n >> 7) * 256 + 128 + (n & 127)); }, OneK{}, [](int) { return 1.f; }, wi, nw);
            convert_T(W_Ws2T, P.in[I_WS2], 1024, 256, 1024, IdCol{}, [](int n) { return perm_row(n); }, OneK{}, [](int) { return 1.f; }, wi, nw);
        }
    }
    SEAM(0);

    if (IN(1)) {
        TIDS
        const float* g = P.in[I_N1G];
        for (int row = blk * 8 + wave; row < NTOK; row += G * 8) {
            const int b = row >> 12;
            const float* xr = W_x + (size_t)row * DM;
            f32x4 v[4]; float ss = 0.f;
#pragma unroll
            for (int i = 0; i < 4; ++i) { v[i] = *(const f32x4*)(xr + i * 256 + lane * 4); ss += v[i][0] * v[i][0] + v[i][1] * v[i][1] + v[i][2] * v[i][2] + v[i][3] * v[i][3]; }
            ss = wave_sum(ss);
            const float rinv = rsqrtf(ss * (1.0f / 1024.0f) + EPS);
            const float* mb = W_mod + b * 6144;
#pragma unroll
            for (int i = 0; i < 4; ++i) {
                const int c = i * 256 + lane * 4;
                const f32x4 gg = *(const f32x4*)(g + c), sh = *(const f32x4*)(mb + c), sc = *(const f32x4*)(mb + 1024 + c);
                float o[4];
#pragma unroll
                for (int j = 0; j < 4; ++j) o[j] = v[i][j] * rinv * gg[j] * (1.0f + sc[j]) + sh[j];
                u32x2 w; w.x = pk2(o[0], o[1]); w.y = pk2(o[2], o[3]);
                *(u32x2*)(W_hbuf + (size_t)row * DM + c) = w;
            }
        }
    }
    SEAM(1);

    if (IN(2)) {
        TIDS
        unsigned vl_[4]; g8_voff_lin(vl_, DM, tid);
        auto nextf = [&](int i, GDesc& d) {
            const int ul = i * 32 + (vblk & 31); if (ul >= 144 || vblk >= 256) return false;
            const int pm = (vblk >> 5) * 16 + ul / 9, pn = ul % 9;
            d.Ab = (const char*)(W_hbuf + (size_t)pm * 256 * DM); d.Bb = (const char*)(W_WinT + (size_t)pn * 256 * DM);
            d.va0 = vl_[0]; d.va1 = vl_[1]; d.va2 = vl_[2]; d.va3 = vl_[3]; d.i0 = pm; d.i1 = pn; d.i2 = 0; return true;
        };
        auto epi = [&](const f32x4 (&acc)[2][2][4][2], const GDesc& d, int wr, int wc, int fr, int fq) {
            const int pm = d.i0, pn = d.i1;
            if (pn < 8) {
                EPI_FOREACH8(acc, wr, wc, fr, fq, r, c8, v0, v1, {
                    u32x4 w; PK8(w, v0, v1);
                    *(u32x4*)(W_proj + (size_t)(pm * 256 + r) * INCP + pn * 256 + c8) = w;
                })
            } else {
                EPI_FOREACH8(acc, wr, wc, fr, fq, r, c8, v0, v1, {
                    const int row = pm * 256 + r;
                    if (c8 < 160) {
                        f32x4 o0 = v0, o1 = v1;
                        if (c8 >= 128) {
                            const int i = (c8 - 128) >> 1; const int s = row & 4095;
                            const f32x4 ca = *(const f32x4*)(W_ropecs + (s * 16 + i) * 2), cb = *(const f32x4*)(W_ropecs + (s * 16 + i) * 2 + 4);
                            o0[0] = v0[0] * ca[0] - v0[1] * ca[1]; o0[1] = v0[1] * ca[0] + v0[0] * ca[1];
                            o0[2] = v0[2] * ca[2] - v0[3] * ca[3]; o0[3] = v0[3] * ca[2] + v0[2] * ca[3];
                            o1[0] = v1[0] * cb[0] - v1[1] * cb[1]; o1[1] = v1[1] * cb[0] + v1[0] * cb[1];
                            o1[2] = v1[2] * cb[2] - v1[3] * cb[3]; o1[3] = v1[3] * cb[2] + v1[2] * cb[3];
                        }
                        u32x4 w; PK8(w, o0, o1);
                        *(u32x4*)(W_proj + (size_t)row * INCP + 2048 + c8) = w;
                    }
                })
            }
            if (pn >= 6) {
#pragma unroll
                for (int ai = 0; ai < 2; ++ai)
#pragma unroll
                    for (int m = 0; m < 4; ++m)
#pragma unroll
                        for (int bj = 0; bj < 2; ++bj) {
                            const f32x4 a = acc[ai][bj][m][0], b = acc[ai][bj][m][1];
                            float ss = a[0] * a[0] + a[1] * a[1] + a[2] * a[2] + a[3] * a[3] + b[0] * b[0] + b[1] * b[1] + b[2] * b[2] + b[3] * b[3];
                            { float o; const float t = x16f(ss, o); ss = t + o; }
                            { float o; const float t = x32f(ss, o); ss = t + o; }
                            if (fq == 0) W_ssq[(size_t)(pm * 256 + ai * 128 + wr * 64 + m * 16 + fr) * 24 + (pn - 6) * 8 + bj * 4 + wc] = ss;
                        }
            }
        };
        gemm_stream(ldsL, tid, DM, nextf, epi);
        if ((vblk & 31) >= 16) {
            TIDS
#pragma unroll 1
            for (int q = 0; q < 2; ++q) {
                const int uu = blk + q * G;
                const int e = (G == 256) ? ((vblk & ~3) + q) : (uu >> 2), pn = (G == 256) ? (vblk & 3) : (uu & 3);
                __syncthreads();
                if (uu < 1024) convert_panel_lds<256, true>(W_scr + (size_t)2 * 256 * 1024 + (size_t)q * 256 * 256, P.in[I_W2] + (size_t)e * 256 * 1024 + pn * 256, 1024, 256, tid, ldsL);
            }
        }
    }
    SEAM(2);

    if (IN(3)) {
        {
            TIDS
            const int xb = (vblk >> 5) * 16, lb = vblk & 31;
            __syncthreads();
            for (int j = 0; j < 2; ++j) { const int ul = j * 32 + lb; if (ul < 48 && tid < 256) {
                const float* sp = W_ssq + (size_t)((xb + ul / 3) * 256 + tid) * 24;
                const f32x4 s0 = *(const f32x4*)sp, s1 = *(const f32x4*)(sp + 4), s2 = *(const f32x4*)(sp + 8);
                const float ss = ((s0[0] + s0[1]) + (s0[2] + s0[3])) + ((s1[0] + s1[1]) + (s1[2] + s1[3])) + ((s2[0] + s2[1]) + (s2[2] + s2[3]));
                rowsc[j * 256 + tid] = rsqrtf(ss * (1.0f / 384.0f) + EPS); } }
            __syncthreads();
            unsigned vl_[4]; g8_voff_lin(vl_, INCP, tid);
            auto nextf = [&](int i, GDesc& d) {
                const int ul = i * 32 + lb; if (ul >= 48 || vblk >= 256) return false;
                const int pm = xb + ul / 3, pn = ul % 3;
                d.Ab = (const char*)(W_proj + (size_t)pm * 256 * INCP + 1536); d.Bb = (const char*)(W_WuqT + (size_t)pn * 256 * QLORA);
                d.va0 = vl_[0]; d.va1 = vl_[1]; d.va2 = vl_[2]; d.va3 = vl_[3]; d.i0 = pm * 4 + pn; d.i1 = i; d.i2 = 0; return true;
            };
            auto epi = [&](const f32x4 (&acc)[2][2][4][2], const GDesc& d, int wr, int wc, int fr, int fq) {
                const int pm = d.i0 >> 2, pn = d.i0 & 3, sl = d.i1 * 256;
                if (pn < 2) {
                    EPI_FOREACH8(acc, wr, wc, fr, fq, r, c8, v0, v1, {
                        const float rs = rowsc[sl + r];
                        const f32x4 a = v0 * rs, b = v1 * rs;
                        u32x4 w; PK8(w, a, b);
                        *(u32x4*)(W_qb + (size_t)(pm * 256 + r) * 768 + pn * 256 + c8) = w;
                    })
                } else {
                    EPI_FOREACH8(acc, wr, wc, fr, fq, r, c8, v0, v1, {
                        const int row = pm * 256 + r;
                        const float rs = rowsc[sl + r];
                        const int i = (c8 & 31) >> 1; const int s = row & 4095;
                        const f32x4 ca = *(const f32x4*)(W_ropecs + (s * 16 + i) * 2), cb = *(const f32x4*)(W_ropecs + (s * 16 + i) * 2 + 4);
                        const f32x4 t0 = v0 * rs, t1 = v1 * rs;
                        f32x4 o0, o1;
                        o0[0] = t0[0] * ca[0] - t0[1] * ca[1]; o0[1] = t0[1] * ca[0] + t0[0] * ca[1];
                        o0[2] = t0[2] * ca[2] - t0[3] * ca[3]; o0[3] = t0[3] * ca[2] + t0[2] * ca[3];
                        o1[0] = t1[0] * cb[0] - t1[1] * cb[1]; o1[1] = t1[1] * cb[0] + t1[0] * cb[1];
                        o1[2] = t1[2] * cb[2] - t1[3] * cb[3]; o1[3] = t1[3] * cb[2] + t1[2] * cb[3];
                        u32x4 w; PK8(w, o0, o1);
                        *(u32x4*)(W_qb + (size_t)row * 768 + 512 + c8) = w;
                    })
                }
            };
            gemm_stream(ldsL, tid, QLORA, nextf, epi);
        }
        {
            TIDS
            const int xb = (vblk >> 5) * 16, lb = vblk & 31;
            __syncthreads();
            for (int j = 0; j < 2; ++j) { const int ul = j * 32 + lb; if (tid < 256) {
                const float* sp = W_ssq + (size_t)((xb + ul / 4) * 256 + tid) * 24 + 12;
                const f32x4 s0 = *(const f32x4*)sp, s1 = *(const f32x4*)(sp + 4);
                const float ss = ((s0[0] + s0[1]) + (s0[2] + s0[3])) + ((s1[0] + s1[1]) + (s1[2] + s1[3]));
                rowsc[j * 256 + tid] = rsqrtf(ss * (1.0f / 256.0f) + EPS); } }
            __syncthreads();
            unsigned vl_[4]; g8_voff_lin(vl_, INCP, tid);
            auto nextf = [&](int i, GDesc& d) {
                const int ul = i * 32 + lb; if (ul >= 64 || vblk >= 256) return false;
                const int pm = xb + ul / 4, pn = ul % 4;
                d.Ab = (const char*)(W_proj + (size_t)pm * 256 * INCP + 1920); d.Bb = (const char*)(W_WukvT + (size_t)pn * 256 * KVLORA);
                d.va0 = vl_[0]; d.va1 = vl_[1]; d.va2 = vl_[2]; d.va3 = vl_[3]; d.i0 = pm * 4 + pn; d.i1 = i; d.i2 = 0; return true;
            };
            auto epi = [&](const f32x4 (&acc)[2][2][4][2], const GDesc& d, int wr, int wc, int fr, int fq) {
                const int pm = d.i0 >> 2, pn = d.i0 & 3, sl = d.i1 * 256;
                EPI_FOREACH8(acc, wr, wc, fr, fq, r, c8, v0, v1, {
                    const float rs = rowsc[sl + r];
                    const f32x4 a = v0 * rs, b = v1 * rs;
                    u32x4 w; PK8(w, a, b);
                    *(u32x4*)(W_kvb + (size_t)(pm * 256 + r) * 1024 + pn * 256 + c8) = w;
                })
            };
            gemm_stream(ldsL, tid, KVLORA, nextf, epi);
        }
    }
    SEAM(3);

    if (IN(4)) {
        for (int ui = 0; ui < ((P.flags & 4) ? 0 : 4); ++ui) {
            TIDS
            const int r32 = lane & 31, hh = lane >> 5;
            if (vblk >= 256) break;
            const int qblk = vblk & 15, bh = (vblk >> 5) * 8 + ui * 2 + ((vblk >> 4) & 1), h = bh & 7, b = bh >> 3;
            const size_t tok0 = (size_t)b * SEQ;
            bf16x8 qf[6];
            {
                const size_t tq = tok0 + qblk * 256 + wave * 32 + r32;
#pragma unroll
                for (int d0 = 0; d0 < 6; ++d0) qf[d0] = *(const bf16x8*)(W_qb + tq * 768 + (d0 < 4 ? h * 64 + d0 * 16 : 512 + h * 32 + (d0 - 4) * 16) + hh * 8);
            }
            f32x16 o0 = {}, o1 = {};
            f32x16 mneg = {};
            float m_run = 0.f, l_run = 0.f;
            const int skey = tid >> 3, sch = tid & 7;
            const bf16_t* kn_src = W_kvb + (tok0 + skey) * 1024 + h * 128 + sch * 8;
            const int pkey = tid >> 2, pch = tid & 3;
            const bf16_t* kp_src = W_proj + (tok0 + pkey) * INCP + 2176 + pch * 8;
            constexpr int KBUF = 12 * 2048, VBUF = 2 * 8192, BUFB = KBUF + VBUF;
            const int k_dst = sch * 2048 + ((skey ^ sch) * 16);
            const int kp_dst = (8 + pch) * 2048 + ((pkey ^ pch) * 16);
            const int v_dst = KBUF + (sch >> 2) * 8192 + skey * 64 + (sch & 3) * 16;
            const int kfo = hh * 2048;
            const int vfo = KBUF + (4 * hh + ((lane & 15) >> 2)) * 64 + ((lane >> 4) & 1) * 32 + (lane & 3) * 8;
            __syncthreads();
            {
                const u32x4 k0 = *(const u32x4*)kn_src, v0 = *(const u32x4*)(kn_src + 64);
                const u32x4 k1 = *(const u32x4*)(kn_src + 64 * 1024), v1 = *(const u32x4*)(kn_src + 64 * 1024 + 64);
                const u32x4 pr = *(const u32x4*)kp_src;
                *(LAS u32x4*)(ldsL + k_dst) = k0; *(LAS u32x4*)(ldsL + k_dst + 1024) = k1;
                *(LAS u32x4*)(ldsL + v_dst) = v0; *(LAS u32x4*)(ldsL + v_dst + 4096) = v1;
                *(LAS u32x4*)(ldsL + kp_dst) = pr;
            }
            __syncthreads();
#pragma unroll 1
            for (int t = 0; t < 32; ++t) {
                const int cur = t & 1;
                const int tn = (t + 1 < 32) ? t + 1 : t;
                const bf16_t* ks = kn_src + (size_t)tn * 128 * 1024;
                const u32x4 nk0 = *(const u32x4*)ks, nv0 = *(const u32x4*)(ks + 64);
                const u32x4 nk1 = *(const u32x4*)(ks + 64 * 1024), nv1 = *(const u32x4*)(ks + 64 * 1024 + 64);
                const u32x4 npr = *(const u32x4*)(kp_src + (size_t)tn * 128 * INCP);
                f32x16 sc[2][2];
#pragma unroll
                for (int sub = 0; sub < 2; ++sub) {
                    const int kb = cur * BUFB + kfo + sub * 1024;
#pragma unroll
                    for (int d0 = 0; d0 < 6; ++d0) {
                        const int sw = (2 * d0 + hh) & 7;
                        const bf16x8 k0 = *(const LAS bf16x8*)(ldsL + kb + d0 * 4096 + ((r32 ^ sw) * 16));
                        const bf16x8 k1 = *(const LAS bf16x8*)(ldsL + kb + d0 * 4096 + (((32 + r32) ^ sw) * 16));
                        if (d0 == 0) { sc[sub][0] = __builtin_amdgcn_mfma_f32_32x32x16_bf16(k0, qf[0], mneg, 0, 0, 0); sc[sub][1] = __builtin_amdgcn_mfma_f32_32x32x16_bf16(k1, qf[0], mneg, 0, 0, 0); }
                        else { sc[sub][0] = __builtin_amdgcn_mfma_f32_32x32x16_bf16(k0, qf[d0], sc[sub][0], 0, 0, 0); sc[sub][1] = __builtin_amdgcn_mfma_f32_32x32x16_bf16(k1, qf[d0], sc[sub][1], 0, 0, 0); }
                    }
                }
#pragma unroll
                for (int sub = 0; sub < 2; ++sub) {
                    const int vb = cur * BUFB + vfo + sub * 4096;
                    f32x16& s0 = sc[sub][0]; f32x16& s1 = sc[sub][1];
#define MX3(a, b, c) __builtin_fmaxf(__builtin_fmaxf((a), (b)), (c))
                    float mxa = MX3(s0[0], s0[1], s1[0]), mxb = MX3(s0[2], s0[3], s1[1]); mxa = MX3(mxa, s1[2], s1[3]);
#pragma unroll
                    for (int i = 4; i < 16; i += 4) { mxa = MX3(mxa, s0[i], s0[i + 1]); mxb = MX3(mxb, s0[i + 2], s0[i + 3]); mxa = MX3(mxa, s1[i], s1[i + 1]); mxb = MX3(mxb, s1[i + 2], s1[i + 3]); }
#undef MX3
                    float mx = max32(__builtin_fmaxf(mxa, mxb));
                    const bool first = (t == 0 && sub == 0);
                    if (first || __builtin_amdgcn_ballot_w64(mx > 8.0f) != 0ull) {
                        const float d = first ? mx : fmaxf(mx, 0.f);
                        const float alpha = first ? 0.f : ex2(-d);
                        m_run += d; l_run *= alpha;
#pragma unroll
                        for (int i = 0; i < 16; ++i) { o0[i] *= alpha; o1[i] *= alpha; s0[i] -= d; s1[i] -= d; mneg[i] = -m_run; }
                        if (sub == 0) {
#pragma unroll
                            for (int i = 0; i < 16; ++i) { sc[1][0][i] -= d; sc[1][1][i] -= d; }
                        }
                    }
                    f32x2_t psv = {0.f, 0.f};
#pragma unroll
                    for (int i = 0; i < 16; i += 2) { s0[i] = ex2(s0[i]); s0[i + 1] = ex2(s0[i + 1]); s1[i] = ex2(s1[i]); s1[i + 1] = ex2(s1[i + 1]);
                        psv += (f32x2_t){s0[i], s0[i + 1]}; psv += (f32x2_t){s1[i], s1[i + 1]}; }
                    l_run += psv[0] + psv[1];
                    bf16x8 pf[2][2];
#pragma unroll
                    for (int s = 0; s < 2; ++s) {
                        u32x4 w0, w1;
                        w0.x = pk2(s0[8 * s + 0], s0[8 * s + 1]); w0.y = pk2(s0[8 * s + 2], s0[8 * s + 3]); w0.z = pk2(s0[8 * s + 4], s0[8 * s + 5]); w0.w = pk2(s0[8 * s + 6], s0[8 * s + 7]);
                        w1.x = pk2(s1[8 * s + 0], s1[8 * s + 1]); w1.y = pk2(s1[8 * s + 2], s1[8 * s + 3]); w1.z = pk2(s1[8 * s + 4], s1[8 * s + 5]); w1.w = pk2(s1[8 * s + 6], s1[8 * s + 7]);
                        pf[0][s] = __builtin_bit_cast(bf16x8, w0); pf[1][s] = __builtin_bit_cast(bf16x8, w1);
                    }
#pragma unroll
                    for (int n = 0; n < 2; ++n)
#pragma unroll
                        for (int s = 0; s < 2; ++s) {
                            const int ko = (32 * n + 16 * s) * 64;
#pragma unroll
                            for (int db = 0; db < 2; ++db) {
                                const s16x4 lo = __builtin_bit_cast(s16x4, __builtin_amdgcn_ds_read_tr16_b64_v4i16((LAS s16x4*)(ldsL + vb + db * 8192 + ko)));
                                const s16x4 hi = __builtin_bit_cast(s16x4, __builtin_amdgcn_ds_read_tr16_b64_v4i16((LAS s16x4*)(ldsL + vb + db * 8192 + ko + 512)));
                                const bf16x8 vf = {lo[0], lo[1], lo[2], lo[3], hi[0], hi[1], hi[2], hi[3]};
                                if (db == 0) o0 = __builtin_amdgcn_mfma_f32_32x32x16_bf16(vf, pf[n][s], o0, 0, 0, 0);
                                else o1 = __builtin_amdgcn_mfma_f32_32x32x16_bf16(vf, pf[n][s], o1, 0, 0, 0);
                            }
                        }
                }
                {
                    const int nb = (cur ^ 1) * BUFB;
                    *(LAS u32x4*)(ldsL + nb + k_dst) = nk0; *(LAS u32x4*)(ldsL + nb + k_dst + 1024) = nk1;
                    *(LAS u32x4*)(ldsL + nb + v_dst) = nv0; *(LAS u32x4*)(ldsL + nb + v_dst + 4096) = nv1;
                    *(LAS u32x4*)(ldsL + nb + kp_dst) = npr;
                }
                __syncthreads();
            }
            {
                const float lt = sum32(l_run);
                const float inv = 1.0f / lt;
                const int sc = 81920 + wave * 4352;
#pragma unroll
                for (int g = 0; g < 4; ++g) {
                    u32x2 w;
                    w.x = pk2(o0[4 * g] * inv, o0[4 * g + 1] * inv); w.y = pk2(o0[4 * g + 2] * inv, o0[4 * g + 3] * inv);
                    *(LAS u32x2*)(ldsL + sc + r32 * 136 + (8 * g + 4 * hh) * 2) = w;
                    w.x = pk2(o1[4 * g] * inv, o1[4 * g + 1] * inv); w.y = pk2(o1[4 * g + 2] * inv, o1[4 * g + 3] * inv);
                    *(LAS u32x2*)(ldsL + sc + r32 * 136 + (32 + 8 * g + 4 * hh) * 2) = w;
                }
                __syncthreads();
#pragma unroll
                for (int it = 0; it < 8; ++it) {
                    const int row = it * 4 + (lane >> 4), pc = lane & 15;
                    const u32x2 w = *(const LAS u32x2*)(ldsL + sc + row * 136 + pc * 8);
                    *(u32x2*)(W_bout + (tok0 + qblk * 256 + wave * 32 + row) * 512 + h * 64 + pc * 4) = w;
                }
            }
            if ((vblk & 3) == ui) {
#pragma unroll 1
                for (int sl = 0; sl < 4; ++sl) {
                    const int j = sl >> 1; const int uu = blk + j * G;
                    const int e = (G == 256) ? ((vblk & ~1) + j) : (uu >> 1), pn = (G == 256) ? (vblk & 1) : (uu & 1);
                    __syncthreads();
                    if (uu < 512) convert_panel_lds<128, true>(W_scr + (size_t)j * 256 * 1024 + (sl & 1) * 128 * 1024, P.in[(sl & 1) ? I_W3 : I_W1] + (size_t)e * 1024 * 256 + pn * 128, 256, 1024, tid, ldsL);
                }
            }
        }
        for (int ui = 0; ui < ((P.flags & 8) ? 0 : 12); ++ui) {
            TIDS
            const int r32 = lane & 31, hh = lane >> 5;
            const int u = vblk * 12 + ui;
            if (u >= 3072) break;
            const int bh = u / 48, w48 = u % 48, h = bh & 7, b = bh >> 3;
            const int p = w48 >> 4, j16 = w48 & 15;
            const int dil = (p == 0) ? 1 : (p == 1 ? 4 : 16);
            const int res = (p == 0) ? 0 : (p == 1 ? (j16 >> 2) : j16);
            const int m0 = (p == 0) ? j16 * 256 : (p == 1 ? (j16 & 3) * 256 : 0);
            const int L = SEQ / dil;
            const size_t tok0 = (size_t)b * SEQ;
            __syncthreads();
            for (int idx = tid; idx < 672; idx += 512) { const int oi = idx - 255; *(LAS float*)(ldsL + 98304 + idx * 4) = (oi >= 0 && oi <= 128) ? W_biasT[(p * 8 + h) * 129 + oi] : -1e30f; }
            {
                u32x4 kr[6], vr[6];
#pragma unroll
                for (int it = 0; it < 6; ++it) {
                    const int idx = it * 512 + tid, row = idx >> 3, ch = idx & 7;
                    const int mk = m0 - 64 + row;
                    kr[it] = (u32x4){0, 0, 0, 0}; vr[it] = (u32x4){0, 0, 0, 0};
                    if (mk >= 0 && mk < L) {
                        const bf16_t* src = W_proj + (tok0 + (size_t)mk * dil + res) * INCP + 512 + h * 64 + ch * 8;
                        kr[it] = *(const u32x4*)src; vr[it] = *(const u32x4*)(src + 512);
                    }
                }
#pragma unroll
                for (int it = 0; it < 6; ++it) {
                    const int idx = it * 512 + tid, row = idx >> 3, ch = idx & 7;
                    *(LAS u32x4*)(ldsL + ch * 6144 + ((row ^ ch) * 16)) = kr[it];
                    *(LAS u32x4*)(ldsL + 49152 + (ch >> 2) * 24576 + row * 64 + (ch & 3) * 16) = vr[it];
                }
            }
            const int qrel = wave * 32 + r32;
            const size_t tq = tok0 + (size_t)(m0 + qrel) * dil + res;
            bf16x8 qf[4];
#pragma unroll
            for (int d0 = 0; d0 < 4; ++d0) qf[d0] = *(const bf16x8*)(W_proj + tq * INCP + h * 64 + d0 * 16 + hh * 8);
            __syncthreads();
            f32x16 o0 = {}, o1 = {};
            float m_run = -1e20f, l_run = 0.f;
            const int vfo = 49152 + (4 * hh + ((lane & 15) >> 2)) * 64 + ((lane >> 4) & 1) * 32 + (lane & 3) * 8;
#pragma unroll 1
            for (int jj = 0; jj < 3; ++jj) {
                const int jt = (wave >> 1) + jj;
                f32x16 s0 = {}, s1 = {};
#pragma unroll
                for (int d0 = 0; d0 < 4; ++d0) {
                    const int ch = 2 * d0 + hh;
                    const bf16x8 k0 = *(const LAS bf16x8*)(ldsL + ch * 6144 + (((64 * jt + r32) ^ ch) * 16));
                    const bf16x8 k1 = *(const LAS bf16x8*)(ldsL + ch * 6144 + (((64 * jt + 32 + r32) ^ ch) * 16));
                    s0 = __builtin_amdgcn_mfma_f32_32x32x16_bf16(k0, qf[d0], s0, 0, 0, 0);
                    s1 = __builtin_amdgcn_mfma_f32_32x32x16_bf16(k1, qf[d0], s1, 0, 0, 0);
                }
                const LAS float* bl = (const LAS float*)(ldsL + 98304) + (64 * jt - qrel + 4 * hh + 255);
                const int mkb = m0 - 64 + 64 * jt;
                const bool edge = (mkb < 0) || (mkb + 64 > L);
                float mx = -1e30f;
#pragma unroll
                for (int i = 0; i < 16; ++i) {
                    const int cr = (i & 3) + 8 * (i >> 2);
                    s0[i] += bl[cr]; s1[i] += bl[cr + 32];
                    if (edge) {
                        const int mk0 = mkb + cr + 4 * hh;
                        if (mk0 < 0 || mk0 >= L) s0[i] = -1e30f;
                        if (mk0 + 32 < 0 || mk0 + 32 >= L) s1[i] = -1e30f;
                    }
                    mx = fmaxf(mx, fmaxf(s0[i], s1[i]));
                }
                mx = max32(mx);
                const float m_new = fmaxf(m_run, mx);
                const float alpha = ex2(m_run - m_new);
                m_run = m_new;
                float ps = 0.f;
#pragma unroll
                for (int i = 0; i < 16; ++i) { s0[i] = ex2(s0[i] - m_new); s1[i] = ex2(s1[i] - m_new); ps += s0[i] + s1[i]; }
                l_run = l_run * alpha + ps;
#pragma unroll
                for (int i = 0; i < 16; ++i) { o0[i] *= alpha; o1[i] *= alpha; }
                bf16x8 pf[2][2];
#pragma unroll
                for (int s = 0; s < 2; ++s) {
                    u32x4 w0, w1;
                    w0.x = pk2(s0[8 * s + 0], s0[8 * s + 1]); w0.y = pk2(s0[8 * s + 2], s0[8 * s + 3]); w0.z = pk2(s0[8 * s + 4], s0[8 * s + 5]); w0.w = pk2(s0[8 * s + 6], s0[8 * s + 7]);
                    w1.x = pk2(s1[8 * s + 0], s1[8 * s + 1]); w1.y = pk2(s1[8 * s + 2], s1[8 * s + 3]); w1.z = pk2(s1[8 * s + 4], s1[8 * s + 5]); w1.w = pk2(s1[8 * s + 6], s1[8 * s + 7]);
                    pf[0][s] = __builtin_bit_cast(bf16x8, w0); pf[1][s] = __builtin_bit_cast(bf16x8, w1);
                }
#pragma unroll
                for (int n = 0; n < 2; ++n)
#pragma unroll
                    for (int s = 0; s < 2; ++s) {
                        const int ko = (64 * jt + 32 * n + 16 * s) * 64;
#pragma unroll
                        for (int db = 0; db < 2; ++db) {
                            const s16x4 lo = __builtin_bit_cast(s16x4, __builtin_amdgcn_ds_read_tr16_b64_v4i16((LAS s16x4*)(ldsL + vfo + db * 24576 + ko)));
                            const s16x4 hi = __builtin_bit_cast(s16x4, __builtin_amdgcn_ds_read_tr16_b64_v4i16((LAS s16x4*)(ldsL + vfo + db * 24576 + ko + 512)));
                            const bf16x8 vf = {lo[0], lo[1], lo[2], lo[3], hi[0], hi[1], hi[2], hi[3]};
                            if (db == 0) o0 = __builtin_amdgcn_mfma_f32_32x32x16_bf16(vf, pf[n][s], o0, 0, 0, 0);
                            else o1 = __builtin_amdgcn_mfma_f32_32x32x16_bf16(vf, pf[n][s], o1, 0, 0, 0);
                        }
                    }
            }
            __syncthreads();
            {
                const float lt = sum32(l_run);
                const float inv = 1.0f / lt;
                if (hh == 0) W_lsebuf[((size_t)p * NTOK + tq) * 8 + h] = m_run + __log2f(lt);
                const int sc = wave * 4352;
#pragma unroll
                for (int g = 0; g < 4; ++g) {
                    u32x2 w;
                    w.x = pk2(o0[4 * g] * inv, o0[4 * g + 1] * inv); w.y = pk2(o0[4 * g + 2] * inv, o0[4 * g + 3] * inv);
                    *(LAS u32x2*)(ldsL + sc + r32 * 136 + (8 * g + 4 * hh) * 2) = w;
                    w.x = pk2(o1[4 * g] * inv, o1[4 * g + 1] * inv); w.y = pk2(o1[4 * g + 2] * inv, o1[4 * g + 3] * inv);
                    *(LAS u32x2*)(ldsL + sc + r32 * 136 + (32 + 8 * g + 4 * hh) * 2) = w;
                }
                __syncthreads();
#pragma unroll
                for (int it = 0; it < 8; ++it) {
                    const int row = it * 4 + (lane >> 4), pc = lane & 15;
                    const u32x2 w = *(const LAS u32x2*)(ldsL + sc + row * 136 + pc * 8);
                    const size_t tr = tok0 + (size_t)(m0 + wave * 32 + row) * dil + res;
                    *(u32x2*)(W_aparts + ((size_t)p * NTOK + tr) * 512 + h * 64 + pc * 4) = w;
                }
            }
            if ((vblk % 12) == ui) {
#pragma unroll 1
                for (int q = 2; q < 4; ++q) {
                    const int uu = blk + q * G;
                    const int e = (G == 256) ? ((vblk & ~3) + q) : (uu >> 2), pn = (G == 256) ? (vblk & 3) : (uu & 3);
                    __syncthreads();
                    if (uu < 1024) convert_panel_lds<256, true>(W_scr + (size_t)2 * 256 * 1024 + (size_t)q * 256 * 256, P.in[I_W2] + (size_t)e * 256 * 1024 + pn * 256, 1024, 256, tid, ldsL);
                }
            }
        }
    }
    SEAM(4);

    if (IN(5)) {
        TIDS
        for (int row = blk * 8 + wave; row < NTOK; row += G * 8) {
            const int hd = lane >> 3;
            float ls0 = W_lsebuf[((size_t)0 * NTOK + row) * 8 + hd], ls1 = W_lsebuf[((size_t)1 * NTOK + row) * 8 + hd], ls2 = W_lsebuf[((size_t)2 * NTOK + row) * 8 + hd];
            const float M = fmaxf(ls0, fmaxf(ls1, ls2));
            float w0 = ex2(ls0 - M), w1 = ex2(ls1 - M), w2 = ex2(ls2 - M);
            const float wsn = 1.0f / (w0 + w1 + w2); w0 *= wsn; w1 *= wsn; w2 *= wsn;
            const u32x4 a0 = *(const u32x4*)(W_aparts + ((size_t)0 * NTOK + row) * 512 + lane * 8);
            const u32x4 a1 = *(const u32x4*)(W_aparts + ((size_t)1 * NTOK + row) * 512 + lane * 8);
            const u32x4 a2 = *(const u32x4*)(W_aparts + ((size_t)2 * NTOK + row) * 512 + lane * 8);
            const u32x4 bb = *(const u32x4*)(W_bout + (size_t)row * 512 + lane * 8);
            float av[8], bv[8]; float sa = 0.f, sb = 0.f;
#pragma unroll
            for (int j = 0; j < 4; ++j) {
                av[2 * j] = w0 * __uint_as_float(a0[j] << 16) + w1 * __uint_as_float(a1[j] << 16) + w2 * __uint_as_float(a2[j] << 16);
                av[2 * j + 1] = w0 * __uint_as_float(a0[j] & 0xffff0000u) + w1 * __uint_as_float(a1[j] & 0xffff0000u) + w2 * __uint_as_float(a2[j] & 0xffff0000u);
                bv[2 * j] = __uint_as_float(bb[j] << 16); bv[2 * j + 1] = __uint_as_float(bb[j] & 0xffff0000u);
                sa += av[2 * j] * av[2 * j] + av[2 * j + 1] * av[2 * j + 1];
                sb += bv[2 * j] * bv[2 * j] + bv[2 * j + 1] * bv[2 * j + 1];
            }
            sa = wave_sum(sa); sb = wave_sum(sb);
            const float ra = rsqrtf(sa * (1.0f / 512.0f) + EPS), rb = rsqrtf(sb * (1.0f / 512.0f) + EPS);
            u32x4 wa, wb;
            wa.x = pk2(av[0] * ra, av[1] * ra); wa.y = pk2(av[2] * ra, av[3] * ra); wa.z = pk2(av[4] * ra, av[5] * ra); wa.w = pk2(av[6] * ra, av[7] * ra);
            wb.x = pk2(bv[0] * rb, bv[1] * rb); wb.y = pk2(bv[2] * rb, bv[3] * rb); wb.z = pk2(bv[4] * rb, bv[5] * rb); wb.w = pk2(bv[6] * rb, bv[7] * rb);
            *(u32x4*)(W_mixb + (size_t)row * DM + lane * 8) = wa;
            *(u32x4*)(W_mixb + (size_t)row * DM + 512 + lane * 8) = wb;
        }
    }
    SEAM(5);

    if (IN(6)) {
        TIDS
        unsigned vl_[4]; g8_voff_lin(vl_, DM, tid);
        auto nextf = [&](int i, GDesc& d) {
            const int ul = i * 32 + (vblk & 31); if (ul >= 64 || vblk >= 256) return false;
            const int pm = (vblk >> 5) * 16 + (ul >> 2), pn = ul & 3;
            d.Ab = (const char*)(W_mixb + (size_t)pm * 256 * DM); d.Bb = (const char*)(W_WoT + (size_t)pn * 256 * DM);
            d.va0 = vl_[0]; d.va1 = vl_[1]; d.va2 = vl_[2]; d.va3 = vl_[3]; d.i0 = pm; d.i1 = pn; d.i2 = 0; return true;
        };
        auto epi = [&](const f32x4 (&acc)[2][2][4][2], const GDesc& d, int wr, int wc, int fr, int fq) {
            const int pm = d.i0, pn = d.i1;
            EPI_FOREACH8(acc, wr, wc, fr, fq, r, c8, v0, v1, {
                const int col = pn * 256 + c8; const int row = pm * 256 + r;
                const float* gp = W_mod + (row >> 12) * 6144 + 2048 + col;
                const f32x4 ga = *(const f32x4*)gp * v0, gb = *(const f32x4*)(gp + 4) * v1;
                u32x4 w; PK8(w, ga, gb);
                *(u32x4*)(W_xt + (size_t)row * DM + col) = w;
            })
        };
        gemm_stream(ldsL, tid, DM, nextf, epi);
    }
    SEAM(6);

    if (IN(7)) {
        TIDS
        const float* g = P.in[I_N2G];
        for (int row = blk * 8 + wave; row < NTOK; row += G * 8) {
            const int b = row >> 12;
            bf16_t* xr = W_xt + (size_t)row * DM;
            const float* x0 = W_x + (size_t)row * DM;
            f32x4 v[4]; float ss = 0.f;
#pragma unroll
            for (int i = 0; i < 4; ++i) {
                const u32x2 tw = *(const u32x2*)(xr + i * 256 + lane * 4);
                const f32x4 tv = {__uint_as_float(tw.x << 16), __uint_as_float(tw.x & 0xffff0000u), __uint_as_float(tw.y << 16), __uint_as_float(tw.y & 0xffff0000u)};
                v[i] = tv + *(const f32x4*)(x0 + i * 256 + lane * 4);
                u32x2 xw; xw.x = pk2(v[i][0], v[i][1]); xw.y = pk2(v[i][2], v[i][3]);
                *(u32x2*)(xr + i * 256 + lane * 4) = xw;
                ss += v[i][0] * v[i][0] + v[i][1] * v[i][1] + v[i][2] * v[i][2] + v[i][3] * v[i][3]; }
            ss = wave_sum(ss);
            const float rinv = rsqrtf(ss * (1.0f / 1024.0f) + EPS);
            const float* mb = W_mod + b * 6144 + 3072;
#pragma unroll
            for (int i = 0; i < 4; ++i) {
                const int c = i * 256 + lane * 4;
                const f32x4 gg = *(const f32x4*)(g + c), sh = *(const f32x4*)(mb + c), sc = *(const f32x4*)(mb + 1024 + c);
                float o[4];
#pragma unroll
                for (int j = 0; j < 4; ++j) o[j] = v[i][j] * rinv * gg[j] * (1.0f + sc[j]) + sh[j];
                u32x2 w; w.x = pk2(o[0], o[1]); w.y = pk2(o[2], o[3]);
                *(u32x2*)(W_hbuf + (size_t)row * DM + c) = w;
            }
        }
    }
    SEAM(7);

    if (IN(8)) {
        {
            TIDS
            unsigned vl_[4]; g8_voff_lin(vl_, DM, tid);
            auto nextf = [&](int i, GDesc& d) {
                const int ul = vblk & 31; if (i > 0 || vblk >= 256) return false;
                const int pm = (vblk >> 5) * 16 + (ul >> 1), pn = ul & 1;
                d.Ab = (const char*)(W_hbuf + (size_t)pm * 256 * DM); d.Bb = (const char*)(W_Ws13T + (size_t)pn * 256 * DM);
                d.va0 = vl_[0]; d.va1 = vl_[1]; d.va2 = vl_[2]; d.va3 = vl_[3]; d.i0 = pm; d.i1 = pn; d.i2 = 0; return true;
            };
            auto epi = [&](const f32x4 (&acc)[2][2][4][2], const GDesc& d, int wr, int wc, int fr, int fq) {
                const int pm = d.i0, pn = d.i1;
#pragma unroll
                for (int ai = 0; ai < 2; ++ai)
#pragma unroll
                    for (int m = 0; m < 4; ++m) {
                        const int r = ai * 128 + wr * 64 + m * 16 + fr;
                        const f32x4 a0 = acc[ai][0][m][0], a1 = acc[ai][0][m][1], b0 = acc[ai][1][m][0], b1 = acc[ai][1][m][1];
                        f32x4 h0, h1;
#pragma unroll
                        for (int j = 0; j < 4; ++j) { h0[j] = siluf(a0[j]) * b0[j]; h1[j] = siluf(a1[j]) * b1[j]; }
                        u32x4 w; PK8(w, h0, h1);
                        *(u32x4*)(W_hdn + (size_t)(NASG + pm * 256 + r) * EFF + pn * 128 + wc * 32 + fq * 8) = w;
                    }
            };
            gemm_stream(ldsL, tid, DM, nextf, epi);
        }
        {
            TIDS
            unsigned vl_[4]; g8_voff_lin(vl_, DM, tid);
            auto nextf = [&](int i, GDesc& d) {
                const int ul = vblk & 31; if (i > 0 || ul < 16 || vblk >= 256) return false;
                const int pm = (vblk >> 5) * 16 + (ul - 16);
                d.Ab = (const char*)(W_hbuf + (size_t)pm * 256 * DM); d.Bb = (const char*)(W_WrT);
                d.va0 = vl_[0]; d.va1 = vl_[1]; d.va2 = vl_[2]; d.va3 = vl_[3]; d.i0 = pm; d.i1 = 0; d.i2 = 0; return true;
            };
            auto epi = [&](const f32x4 (&acc)[2][2][4][2], const GDesc& d, int wr, int wc, int fr, int fq) {
                const int pm = d.i0;
                EPI_FOREACH8(acc, wr, wc, fr, fq, r, c8, v0, v1, {
                    *(f32x4*)(W_logits + (size_t)(pm * 256 + r) * 256 + c8) = v0;
                    *(f32x4*)(W_logits + (size_t)(pm * 256 + r) * 256 + c8 + 4) = v1;
                })
            };
            gemm_stream(ldsL, tid, DM, nextf, epi);
        }
        if ((vblk & 31) < 16) {
            TIDS
#pragma unroll 1
            for (int q = 0; q < 2; ++q) {
                const int uu = blk + q * G;
                const int e = (G == 256) ? ((vblk & ~3) + q) : (uu >> 2), pn = (G == 256) ? (vblk & 3) : (uu & 3);
                __syncthreads();
                if (uu < 1024) convert_panel_lds<256, true>(W_scr + (size_t)2 * 256 * 1024 + (size_t)q * 256 * 256, P.in[I_W2] + (size_t)e * 256 * 1024 + pn * 256, 1024, 256, tid, ldsL);
            }
        }
    }
    SEAM(8);

    if (IN(9)) {
        TIDS
        const float* ebias = P.in[I_EB];
        const f32x4 eb = *(const f32x4*)(ebias + lane * 4);
        for (int t = blk * 8 + wave; t < NTOK; t += G * 8) {
            const f32x4 lg = *(const f32x4*)(W_logits + (size_t)t * 256 + lane * 4);
            float sc[4], sel[4];
#pragma unroll
            for (int i = 0; i < 4; ++i) { sc[i] = 1.0f / (1.0f + expf(-lg[i])); sel[i] = sc[i] + eb[i]; }
            float a1 = fmaxf(sel[0], sel[1]), a2 = fminf(sel[0], sel[1]);
#pragma unroll
            for (int i = 2; i < 4; ++i) { const float v = sel[i]; a2 = fmaxf(a2, fminf(a1, v)); a1 = fmaxf(a1, v); }
            {
                float b1, b2, n1, n2;
                b1 = dppf(a1, DPP_X1); b2 = dppf(a2, DPP_X1); n1 = fmaxf(a1, b1); n2 = fmaxf(fminf(a1, b1), fmaxf(a2, b2)); a1 = n1; a2 = n2;
                b1 = dppf(a1, DPP_X2); b2 = dppf(a2, DPP_X2); n1 = fmaxf(a1, b1); n2 = fmaxf(fminf(a1, b1), fmaxf(a2, b2)); a1 = n1; a2 = n2;
                b1 = dppf(a1, DPP_HM); b2 = dppf(a2, DPP_HM); n1 = fmaxf(a1, b1); n2 = fmaxf(fminf(a1, b1), fmaxf(a2, b2)); a1 = n1; a2 = n2;
            }
            const float gs = a1 + a2; const int myg = lane >> 3;
            int rank = 0;
#pragma unroll
            for (int g = 0; g < 8; ++g) { const float v = __int_as_float(__builtin_amdgcn_readlane(__float_as_int(gs), g * 8)); rank += (v > gs || (v == gs && g < myg)) ? 1 : 0; }
            const bool gsel = rank < 4;
            unsigned key[4];
#pragma unroll
            for (int i = 0; i < 4; ++i) { const unsigned u = __float_as_uint(sel[i]); const unsigned mono = u ^ ((u >> 31) ? 0xFFFFFFFFu : 0x80000000u);
                key[i] = gsel ? ((mono & 0xFFFFFF00u) | (unsigned)(255 - (lane * 4 + i))) : 0u; }
            int my_e = 0; float my_g = 0.f; float gsum = 0.f;
#pragma unroll
            for (int k = 0; k < 8; ++k) {
                unsigned v = key[0] > key[1] ? key[0] : key[1]; { const unsigned w = key[2] > key[3] ? key[2] : key[3]; v = v > w ? v : w; }
#define UMX(o) do { const unsigned o_ = (unsigned)(o); v = v > o_ ? v : o_; } while (0)
                UMX(dppi((int)v, DPP_X1)); UMX(dppi((int)v, DPP_X2)); UMX(dppi((int)v, DPP_HM)); UMX(dppi((int)v, DPP_RM));
                { auto rv = __builtin_amdgcn_permlane16_swap(v, v, false, false); v = rv[0]; UMX(rv[1]); }
                { auto rv = __builtin_amdgcn_permlane32_swap(v, v, false, false); v = rv[0]; UMX(rv[1]); }
#undef UMX
                v = (unsigned)__builtin_amdgcn_readfirstlane((int)v);
                const int ix = 255 - (int)(v & 255u);
                float myscore = 0.f;
#pragma unroll
                for (int i = 0; i < 4; ++i) if (key[i] == v) { key[i] = 0u; myscore = sc[i]; }
                const float gw = __int_as_float(__builtin_amdgcn_readlane(__float_as_int(myscore), ix >> 2));
                gsum += gw;
                if (lane == k) { my_e = ix; my_g = gw; }
            }
            if (lane < 8) {
                const unsigned rk = atomicAdd(&cntg[my_e * CNT_STRIDE], 1u);
                W_eidx[t * 8 + lane] = my_e; W_gate[t * 8 + lane] = my_g / gsum * 2.5f; W_rnk[t * 8 + lane] = (int)rk;
            }
        }
    }
    SEAM(9);

    if (IN(10)) {
        TIDS
        if (tid < 256) cntL[tid] = (int)__hip_atomic_load(&cntg[tid * CNT_STRIDE], __ATOMIC_RELAXED, __HIP_MEMORY_SCOPE_AGENT);
        __syncthreads();
        if (tid < 256) { int s = 0; for (int j = 0; j < tid; ++j) s += cntL[j]; startL[tid] = s; }
        __syncthreads();
        for (int t = blk * 8 + wave; t < NTOK; t += G * 8) {
            if (lane < 8) {
                const int e = W_eidx[t * 8 + lane];
                const int d = startL[e] + W_rnk[t * 8 + lane];
                W_toks[d] = t; W_wts[d] = W_gate[t * 8 + lane]; W_pos[t * 8 + lane] = d;
            }
        }
    }
    SEAM(10);

    if (IN(11)) {
        TIDS
        __syncthreads();
        if (tid < 256) cntL[tid] = (int)__hip_atomic_load(&cntg[tid * CNT_STRIDE], __ATOMIC_RELAXED, __HIP_MEMORY_SCOPE_AGENT);
        __syncthreads();
        if (tid <= 256) { int sa = 0, tb = 0; for (int j = 0; j < tid; ++j) { sa += cntL[j]; tb += (cntL[j] + 255) >> 8; } startL[tid] = sa; tbL[tid] = tb; }
        __syncthreads();
        const int T1 = 2 * tbL[256];
        const int g0 = (int)(((long)vblk * T1) / G), g1 = (int)(((long)(vblk + 1) * T1) / G);
        for (int c0 = g0; c0 < g1; c0 += 8) {
            TIDS
            const int nch = (g1 - c0) < 8 ? (g1 - c0) : 8;
            __syncthreads();
            if (tid < nch) {
                const int g = c0 + tid; int e = 0;
                for (int j = 1; j < 256; ++j) if (2 * tbL[j] <= g) e = j;
                const int r = g - 2 * tbL[e], nt = tbL[e + 1] - tbL[e];
                itemD[tid * 4 + 0] = e; itemD[tid * 4 + 1] = r / nt; itemD[tid * 4 + 2] = r % nt;
            }
            __syncthreads();
            for (int idx = tid; idx < nch * 256; idx += 512) {
                const int it = idx >> 8, e = itemD[it * 4], ti = itemD[it * 4 + 2];
                const int rr = ti * 256 + (idx & 255); const int sr = startL[e] + (rr < cntL[e] ? rr : 0);
                rowoff[idx] = (unsigned)W_toks[sr] * DM;
            }
            __syncthreads();
            int R0, C0; g8_rc(tid, R0, C0);
            auto nextf = [&](int i, GDesc& d) {
                if (i >= nch) return false;
                const int e = itemD[i * 4], pn = itemD[i * 4 + 1], ti = itemD[i * 4 + 2];
                const int vo = (e & ~1) | pn; const int bo = (G == 256) ? ((vo & 31) * 8 + (vo >> 5)) : vo;
                d.Ab = (const char*)W_hbuf; d.Bb = (const char*)(ws + OFF_SCR + (size_t)bo * SCR_PER_BLK) + (size_t)(e & 1) * 512 * 1024;
                d.va0 = (rowoff[i * 256 + R0] + C0) * 2u; d.va1 = (rowoff[i * 256 + R0 + 64] + C0) * 2u; d.va2 = (rowoff[i * 256 + R0 + 128] + C0) * 2u; d.va3 = (rowoff[i * 256 + R0 + 192] + C0) * 2u;
                const int left = cntL[e] - ti * 256;
                d.i0 = startL[e] + ti * 256; d.i1 = left < 256 ? left : 256; d.i2 = pn; return true;
            };
            auto epi = [&](const f32x4 (&acc)[2][2][4][2], const GDesc& d, int wr, int wc, int fr, int fq) {
                const int rowbase = d.i0, nvalid = d.i1, pn = d.i2;
#pragma unroll
                for (int ai = 0; ai < 2; ++ai)
#pragma unroll
                    for (int m = 0; m < 4; ++m) {
                        const int r = ai * 128 + wr * 64 + m * 16 + fr;
                        if (r < nvalid) {
                            const f32x4 a0 = acc[ai][0][m][0], a1 = acc[ai][0][m][1], b0 = acc[ai][1][m][0], b1 = acc[ai][1][m][1];
                            f32x4 h0, h1;
#pragma unroll
                            for (int j = 0; j < 4; ++j) { h0[j] = siluf(a0[j]) * b0[j]; h1[j] = siluf(a1[j]) * b1[j]; }
                            u32x4 w; PK8(w, h0, h1);
                            *(u32x4*)(W_hdn + (size_t)(rowbase + r) * EFF + pn * 128 + wc * 32 + fq * 8) = w;
                        }
                    }
            };
            gemm_stream(ldsL, tid, DM, nextf, epi);
        }
    }
    SEAM(11);

    if (IN(12)) {
        TIDS
        __syncthreads();
        if (tid < 256) cntL[tid] = (int)__hip_atomic_load(&cntg[tid * CNT_STRIDE], __ATOMIC_RELAXED, __HIP_MEMORY_SCOPE_AGENT);
        if (tid == 256) cntL[256] = NTOK;
        __syncthreads();
        if (tid <= 257) { int sa = 0, tb = 0; for (int j = 0; j < tid; ++j) { sa += cntL[j]; tb += (cntL[j] + 255) >> 8; } if (tid <= 256) startL[tid] = sa; tbL[tid] = tb; }
        __syncthreads();
        const int T2 = 4 * tbL[257];
        const int g0 = (int)(((long)vblk * T2) / G), g1 = (int)(((long)(vblk + 1) * T2) / G);
#define Y_STORE(ROWG, COL0, G_) do { _Pragma("unroll") for (int bj = 0; bj < 2; ++bj) { const f32x4 a_ = acc[ai][bj][m][0], b_ = acc[ai][bj][m][1]; int w0_ = 0, w1_ = 0; \
            w0_ = __builtin_amdgcn_cvt_pk_fp8_f32(a_[0] * (G_), a_[1] * (G_), w0_, false); w0_ = __builtin_amdgcn_cvt_pk_fp8_f32(a_[2] * (G_), a_[3] * (G_), w0_, true); \
            w1_ = __builtin_amdgcn_cvt_pk_fp8_f32(b_[0] * (G_), b_[1] * (G_), w1_, false); w1_ = __builtin_amdgcn_cvt_pk_fp8_f32(b_[2] * (G_), b_[3] * (G_), w1_, true); \
            u32x2 w_; w_.x = (unsigned)w0_; w_.y = (unsigned)w1_; *(u32x2*)(W_y8 + (size_t)(ROWG) * DM + (COL0) + bj * 128 + wc * 32 + fq * 8) = w_; } } while (0)
        for (int c0 = g0; c0 < g1; c0 += 8) {
            TIDS
            const int nch = (g1 - c0) < 8 ? (g1 - c0) : 8;
            __syncthreads();
            if (tid < nch) {
                const int g = c0 + tid; int e = 0;
                for (int j = 1; j < 257; ++j) if (4 * tbL[j] <= g) e = j;
                const int r = g - 4 * tbL[e], nt = tbL[e + 1] - tbL[e];
                itemD[tid * 4 + 0] = e; itemD[tid * 4 + 1] = r / nt; itemD[tid * 4 + 2] = r % nt;
            }
            __syncthreads();
            for (int idx = tid; idx < nch * 256; idx += 512) {
                const int it = idx >> 8, e = itemD[it * 4], ti = itemD[it * 4 + 2];
                const int rr = ti * 256 + (idx & 255); const int sr = startL[e] + (rr < cntL[e] ? rr : 0);
                rowoff[idx] = (unsigned)sr * EFF; rowsc[idx] = (e < 256) ? W_wts[sr] : 1.0f;
            }
            __syncthreads();
            int R0, C0; g8_rc(tid, R0, C0);
            auto nextf = [&](int i, GDesc& d) {
                if (i >= nch) return false;
                const int e = itemD[i * 4], pn = itemD[i * 4 + 1], ti = itemD[i * 4 + 2];
                const int vo = (e & ~3) | pn; const int bo = (G == 256) ? ((vo & 31) * 8 + (vo >> 5)) : vo;
                d.Ab = (const char*)W_hdn;
                d.Bb = (e < 256) ? (const char*)(ws + OFF_SCR + (size_t)bo * SCR_PER_BLK) + (size_t)2 * 512 * 1024 + (size_t)(e & 3) * 128 * 1024 : (const char*)(W_Ws2T + (size_t)pn * 256 * EFF);
                d.va0 = (rowoff[i * 256 + R0] + C0) * 2u; d.va1 = (rowoff[i * 256 + R0 + 64] + C0) * 2u; d.va2 = (rowoff[i * 256 + R0 + 128] + C0) * 2u; d.va3 = (rowoff[i * 256 + R0 + 192] + C0) * 2u;
                const int left = cntL[e] - ti * 256;
                d.i0 = startL[e] + ti * 256; d.i1 = (left < 256 ? left : 256) | (i << 16); d.i2 = pn; return true;
            };
            auto epi = [&](const f32x4 (&acc)[2][2][4][2], const GDesc& d, int wr, int wc, int fr, int fq) {
                const int rowbase = d.i0, nvalid = d.i1 & 0xffff, tl = d.i1 >> 16, pn = d.i2;
#pragma unroll
                for (int ai = 0; ai < 2; ++ai)
#pragma unroll
                    for (int m = 0; m < 4; ++m) {
                        const int r = ai * 128 + wr * 64 + m * 16 + fr;
                        if (r < nvalid) { const float g = rowsc[tl * 256 + r]; Y_STORE(rowbase + r, pn * 256, g); }
                    }
            };
            gemm_stream(ldsL, tid, EFF, nextf, epi);
        }
#undef Y_STORE
    }
    SEAM(12);

    if (IN(13)) {
        TIDS
        const float* fg = P.in[I_FG];
        for (int row = blk * 8 + wave; row < NTOK; row += G * 8) {
            const int b = row >> 12;
            float a[16];
#pragma unroll
            for (int j = 0; j < 16; ++j) a[j] = 0.f;
#pragma unroll
            for (int k = 0; k < 9; ++k) {
                const int pr = (k < 8) ? W_pos[row * 8 + k] : (NASG + row);
                const u32x4 w = *(const u32x4*)(W_y8 + (size_t)pr * DM + lane * 16);
#pragma unroll
                for (int q = 0; q < 4; ++q) {
                    a[4 * q + 0] += __builtin_amdgcn_cvt_f32_fp8((int)w[q], 0); a[4 * q + 1] += __builtin_amdgcn_cvt_f32_fp8((int)w[q], 1);
                    a[4 * q + 2] += __builtin_amdgcn_cvt_f32_fp8((int)w[q], 2); a[4 * q + 3] += __builtin_amdgcn_cvt_f32_fp8((int)w[q], 3);
                }
            }
            float* xr = P.out + (size_t)row * DM + lane * 16;
            const bf16_t* x1r = W_xt + (size_t)row * DM + lane * 16;
            const u32x4 xw0 = *(const u32x4*)x1r, xw1 = *(const u32x4*)(x1r + 8);
            const float* g2 = W_mod + b * 6144 + 5120 + lane * 16;
            float v[16]; float ss = 0.f;
#pragma unroll
            for (int q = 0; q < 4; ++q) {
                const unsigned wa = (q < 2) ? xw0[2 * q] : xw1[2 * (q - 2)], wb = (q < 2) ? xw0[2 * q + 1] : xw1[2 * (q - 2) + 1];
                const f32x4 xa = {__uint_as_float(wa << 16), __uint_as_float(wa & 0xffff0000u), __uint_as_float(wb << 16), __uint_as_float(wb & 0xffff0000u)};
                const f32x4 ga = *(const f32x4*)(g2 + q * 4);
#pragma unroll
                for (int j = 0; j < 4; ++j) { v[q * 4 + j] = xa[j] + ga[j] * a[q * 4 + j]; ss += v[q * 4 + j] * v[q * 4 + j]; }
            }
            ss = wave_sum(ss);
            const float rinv = rsqrtf(ss * (1.0f / 1024.0f) + EPS);
#pragma unroll
            for (int q = 0; q < 4; ++q) {
                const f32x4 fa = *(const f32x4*)(fg + lane * 16 + q * 4);
                f32x4 oa;
#pragma unroll
                for (int j = 0; j < 4; ++j) oa[j] = v[q * 4 + j] * rinv * fa[j];
                *(f32x4*)(xr + q * 4) = oa;
            }
        }
    }
#ifdef DBG_STOP
    if (IN(14)) {
        TIDS
        const size_t NO = (size_t)NTOK * DM;
        for (size_t i = (size_t)blk * 512 + tid; i < NO; i += (size_t)G * 512) {
            unsigned hsh = 0u;
            const size_t row = i >> 10, c = i & 1023;
#define RB(p, idx) ((unsigned)(p)[(idx)])
#define RF(p, idx) (__float_as_uint((p)[(idx)]))
#if DBG_STOP == 0
            hsh = RB(W_WinT, i % (2304 * 1024)) ^ RB(W_WoT, i % (1024 * 1024)) ^ RB(W_WuqT, i % (768 * 384)) ^ RB(W_WukvT, i % (1024 * 256)) ^ RB(W_Ws13T, i % (512 * 1024)) ^ RB(W_Ws2T, i % (1024 * 256)) ^ RB(W_WrT, i % (256 * 1024))
                ^ RF(W_mod, i % (8 * 6144)) ^ RF(W_ropecs, i % (4096 * 32)) ^ RF(W_biasT, i % (3 * 8 * 129));
#elif DBG_STOP == 1 || DBG_STOP == 7
            hsh = RB(W_hbuf, i);
#elif DBG_STOP == 2
            hsh = RB(W_proj, row * INCP + c) ^ (RB(W_proj, row * INCP + 1024 + c) << 1) ^ (c < 160 ? (RB(W_proj, row * INCP + 2048 + c) << 2) : 0u);
#elif DBG_STOP == 3
            hsh = RB(W_kvb, i) ^ (c < 768 ? (RB(W_qb, row * 768 + c) << 1) : 0u);
#elif DBG_STOP == 4
            if (c < 512) hsh = RB(W_bout, row * 512 + c); else if (DBG_SUB) { const size_t cc = c - 512; hsh = RB(W_aparts, row * 512 + cc) ^ (RB(W_aparts, ((size_t)NTOK + row) * 512 + cc) << 1) ^ (RB(W_aparts, ((size_t)2 * NTOK + row) * 512 + cc) << 2) ^ RF(W_lsebuf, row * 8 + (cc >> 6)) ^ (RF(W_lsebuf, ((size_t)NTOK + row) * 8 + (cc >> 6)) << 1) ^ (RF(W_lsebuf, ((size_t)2 * NTOK + row) * 8 + (cc >> 6)) << 2); }
#elif DBG_STOP == 5
            hsh = RB(W_mixb, i);
#elif DBG_STOP == 6
            hsh = RF(P.out, i);
#elif DBG_STOP == 8
            if (c < 256) hsh = RF(W_logits, row * 256 + c); else if (c < 512) hsh = RB(W_hdn, ((size_t)NASG + row) * EFF + (c - 256));
#elif DBG_STOP == 9
            if (c < 8) hsh = (unsigned)W_eidx[row * 8 + c]; else if (c < 16) hsh = RF(W_gate, row * 8 + (c - 8));
#elif DBG_STOP == 11
            { const int k = (int)(c >> 8); hsh = RB(W_hdn, (size_t)W_pos[row * 8 + k] * EFF + (c & 255)) ^ (RB(W_hdn, (size_t)W_pos[row * 8 + 4 + k] * EFF + (c & 255)) << 1); }
#elif DBG_STOP == 12
            { for (int k = 0; k < 8; ++k) hsh ^= RB(W_ybuf, (size_t)W_pos[row * 8 + k] * DM + c) << (k & 3); hsh ^= RB(W_ybuf, ((size_t)NASG + row) * DM + c); }
#endif
            P.out[i] = (float)(hsh & 0xFu);
        }
    }
#endif
#undef IN
#undef SEAM
}

extern "C" void kernel_launch(void* const* d_in, const int* in_sizes, int n_in, void* d_out, int out_size, void* d_ws, size_t ws_size, hipStream_t stream) {
    static int grid = 0;
    if (grid == 0) {
        if (n_in != 24 || ws_size < WS_END) { fprintf(stderr, "kernel_launch: need 24 inputs and %zu bytes of workspace (got %d, %zu)\n", (size_t)WS_END, n_in, ws_size); grid = -1; return; }
        int dev = 0, cus = 0, per_cu = 0;
        if (hipGetDevice(&dev) != hipSuccess || hipDeviceGetAttribute(&cus, hipDeviceAttributeMultiprocessorCount, dev) != hipSuccess) { grid = -1; return; }
        if (hipFuncSetAttribute((const void*)fwd_kernel, hipFuncAttributeMaxDynamicSharedMemorySize, LDS_BYTES) != hipSuccess) { fprintf(stderr, "kernel_launch: hipFuncSetAttribute failed\n"); grid = -1; return; }
        if (hipOccupancyMaxActiveBlocksPerMultiprocessor(&per_cu, (const void*)fwd_kernel, 512, LDS_BYTES) != hipSuccess || per_cu < 1) { fprintf(stderr, "kernel_launch: occupancy query says %d\n", per_cu); }
        (void)hipGetLastError();
        if (cus < 256) { fprintf(stderr, "kernel_launch: this kernel needs 256 CUs (device reports %d)\n", cus); grid = -1; return; }
        grid = 256;
    }
    if (grid < 0) return;
    (void)hipMemsetAsync((char*)d_ws + OFF_CTL, 0, CTL_BYTES, stream);
    Params p{};
    for (int i = 0; i < 24; ++i) p.in[i] = (const float*)d_in[i];
    p.out = (float*)d_out; p.ws = (unsigned char*)d_ws;
#if MK_N_LAUNCHES == 1
    p.ph_lo = 0; p.ph_hi = NPHASE;
    hipLaunchKernelGGL(fwd_kernel, dim3(grid), dim3(512), LDS_BYTES, stream, p);
#else
#ifdef DBG_STOP
    for (int k = 0; k <= DBG_STOP; ++k) { p.ph_lo = k; p.ph_hi = k + 1; hipLaunchKernelGGL(fwd_kernel, dim3(grid), dim3(512), LDS_BYTES, stream, p); }
    p.ph_lo = 14; p.ph_hi = 15; hipLaunchKernelGGL(fwd_kernel, dim3(grid), dim3(512), LDS_BYTES, stream, p);
#else
#ifndef DBL_MASK
#define DBL_MASK 0u
#endif
#ifndef DBL_FLAGS
#define DBL_FLAGS 0
#endif
    for (int k = 0; k < 14; ++k) { p.ph_lo = k; p.ph_hi = k + 1; hipLaunchKernelGGL(fwd_kernel, dim3(grid), dim3(512), LDS_BYTES, stream, p);
        if ((DBL_MASK >> k) & 1u) { p.flags = DBL_FLAGS; hipLaunchKernelGGL(fwd_kernel, dim3(grid), dim3(512), LDS_BYTES, stream, p); p.flags = 0; } }
#endif
#endif
}
```

```cpp
#include <hip/hip_runtime.h>
#include <stdint.h>
#include <stdio.h>

#ifndef MK_N_LAUNCHES
#define MK_N_LAUNCHES 1
#endif

#define DEVI __device__ __forceinline__
typedef unsigned short bf16_t;
typedef short bf16x8 __attribute__((ext_vector_type(8)));
typedef short s16x4 __attribute__((ext_vector_type(4)));
typedef float f32x4 __attribute__((ext_vector_type(4)));
typedef float f32x16 __attribute__((ext_vector_type(16)));
typedef unsigned u32x4 __attribute__((ext_vector_type(4)));
typedef unsigned u32x2 __attribute__((ext_vector_type(2)));

constexpr int NTOK = 32768, SEQ = 4096, DM = 1024;
constexpr int INC = 2208, INCP = 2304;
constexpr int QLORA = 384, KVLORA = 256;
constexpr int NEXP = 256, EFF = 256;
constexpr int NASG = NTOK * 8;
constexpr int NROWS = NASG + NTOK;
constexpr float EPS = 1e-6f;
constexpr float LOG2E = 1.4426950408889634f;

constexpr size_t MiB = 1u << 20;
constexpr size_t OFF_CTL = 0, CTL_BYTES = 1 * MiB;
constexpr size_t OFF_MOD = 1 * MiB;
constexpr size_t OFF_ROPE = OFF_MOD + 256 * 1024;
constexpr size_t OFF_BIAS = OFF_ROPE + 512 * 1024;
constexpr size_t OFF_WIN = 2 * MiB;
constexpr size_t OFF_WUQ = OFF_WIN + 4608 * 1024;
constexpr size_t OFF_WUKV = OFF_WUQ + 1 * MiB;
constexpr size_t OFF_WO = OFF_WUKV + 512 * 1024;
constexpr size_t OFF_WR = OFF_WO + 2 * MiB;
constexpr size_t OFF_WS13 = OFF_WR + 512 * 1024;
constexpr size_t OFF_WS2 = OFF_WS13 + 1 * MiB;
constexpr size_t OFF_H = 12 * MiB;
constexpr size_t OFF_LOGITS = OFF_H + 64 * MiB;
constexpr size_t OFF_EIDX = OFF_LOGITS + 32 * MiB;
constexpr size_t OFF_GATE = OFF_EIDX + 1 * MiB;
constexpr size_t OFF_RNK = OFF_GATE + 1 * MiB;
constexpr size_t OFF_POS = OFF_RNK + 1 * MiB;
constexpr size_t OFF_TOKS = OFF_POS + 1 * MiB;
constexpr size_t OFF_WTS = OFF_TOKS + 1 * MiB;
constexpr size_t OFF_SSQ = OFF_WTS + 1 * MiB;
constexpr size_t OFF_SCR = OFF_SSQ + 4 * MiB;
constexpr size_t SCR_PER_BLK = 1536 * 1024;
constexpr size_t OFF_R = OFF_SCR + 384 * MiB;
constexpr size_t OFF_XT = OFF_R + 452 * MiB;
constexpr size_t WS_END = OFF_XT + 64 * MiB;
constexpr size_t OFF_PROJ = OFF_R;
constexpr size_t OFF_QB = OFF_PROJ + 144 * MiB;
constexpr size_t OFF_KVB = OFF_QB + 48 * MiB;
constexpr size_t OFF_BOUT = OFF_KVB + 64 * MiB;
constexpr size_t OFF_APARTS = OFF_BOUT + 32 * MiB;
constexpr size_t OFF_LSE = OFF_APARTS + 96 * MiB;
constexpr size_t OFF_MIX = OFF_LSE + 4 * MiB;
constexpr size_t OFF_Y = OFF_R;
constexpr size_t OFF_HDN = OFF_R + 288 * MiB;
static_assert(OFF_MIX + 64 * MiB <= WS_END, "alias map");
constexpr int CNT_WORD0 = 8192, CNT_STRIDE = 16;

constexpr int LDS_STAGE = 0;
constexpr int LDS_ROWOFF = 131072;
constexpr int LDS_ROWSC = LDS_ROWOFF + 8192;
constexpr int LDS_MISC = LDS_ROWSC + 8192;
constexpr int LDS_START = LDS_MISC + 256;
constexpr int LDS_CNT = LDS_START + 1280;
constexpr int LDS_TB = LDS_CNT + 1280;
constexpr int LDS_BYTES = 155648;
static_assert(LDS_TB + 1280 <= LDS_BYTES, "lds map");

#define XB_TMO      128
#define XB_XCNT(j)  (256  + 64 * (j))
#define XB_XSUB(j)  (1280 + 64 * (j))
#define XB_XGEN(j)  (2304 + 64 * (j))
#define XB_TOP      3328
#define XB_TOPGEN   3392
#define XCD_BAR_WORDS 3456
#define XB_SPIN_CAP (1u << 22)
#define LAS __attribute__((address_space(3)))

__device__ __forceinline__ unsigned xb_ld(unsigned* p)              { return __hip_atomic_load(p, __ATOMIC_RELAXED, __HIP_MEMORY_SCOPE_AGENT); }
__device__ __forceinline__ unsigned xb_add(unsigned* p, unsigned v) { return __hip_atomic_fetch_add(p, v, __ATOMIC_RELAXED, __HIP_MEMORY_SCOPE_AGENT); }
__device__ __forceinline__ unsigned xb_xcc_id() { return (unsigned)__builtin_amdgcn_s_getreg((3 << 11) | 20) & 0xFu; }
#define XB_SPIN(cond, bar) do { unsigned _sp = 0; while (cond) { __builtin_amdgcn_s_sleep(1); \
    if ((++_sp & 255u) == 0u) { if (xb_ld(&(bar)[XB_TMO])) break; if (_sp > XB_SPIN_CAP) { atomicAdd(&(bar)[XB_TMO], 1u); break; } } } } while (0)

struct XcdBarrier { unsigned* bar; unsigned x; volatile LAS unsigned* st; };

__device__ __forceinline__ XcdBarrier xcd_barrier_post(unsigned* bar, volatile LAS unsigned* st, const bool leader) {
    XcdBarrier b; b.bar = bar; b.x = xb_xcc_id(); b.st = st;
    if (leader) (void)xb_add(&bar[XB_XCNT(b.x)], 1u);
    return b;
}
__device__ __forceinline__ void xcd_barrier_complete(unsigned* bar, unsigned x, unsigned& nloc, unsigned& nx) {
    const unsigned G = gridDim.x * gridDim.y * gridDim.z;
    unsigned sum, cnt, mine, sp = 0u;
    for (;;) {
        sum = 0u; cnt = 0u; mine = 0u;
#pragma unroll
        for (unsigned j = 0; j < 16; ++j) { const unsigned c = xb_ld(&bar[XB_XCNT(j)]); sum += c; cnt += (c > 0u) ? 1u : 0u; mine = (j == x) ? c : mine; }
        if (sum == G) break;
        __builtin_amdgcn_s_sleep(1);
        if ((++sp & 255u) == 0u) { if (xb_ld(&bar[XB_TMO])) break; if (sp > XB_SPIN_CAP) { atomicAdd(&bar[XB_TMO], 1u); break; } }
    }
    nloc = mine > 0u ? mine : 1u; nx = cnt > 0u ? cnt : 1u;
}
__device__ __forceinline__ void xcd_barrier(const XcdBarrier& b, const bool leader) {
    asm volatile("s_waitcnt vmcnt(0)" ::: "memory");
    __syncthreads();
    if (leader) {
        unsigned* bar = b.bar;
        __builtin_amdgcn_s_waitcnt(0);
        unsigned nloc = b.st[0], nx = b.st[1];
        if (nloc == 0u) { xcd_barrier_complete(bar, b.x, nloc, nx); b.st[0] = nloc; b.st[1] = nx; }
        const unsigned old = xb_add(&bar[XB_XSUB(b.x)], 1u);
        const unsigned gen = old / nloc;
        if (old + 1u == (gen + 1u) * nloc) {
            __builtin_amdgcn_fence(__ATOMIC_RELEASE, "agent");
            asm volatile("s_waitcnt vmcnt(0)" ::: "memory");
            const unsigned og = xb_add(&bar[XB_TOP], 1u);
            const unsigned tg = og / nx;
            if (og + 1u == (tg + 1u) * nx) xb_add(&bar[XB_TOPGEN], 1u);
            else XB_SPIN(xb_ld(&bar[XB_TOPGEN]) == tg, bar);
            __builtin_amdgcn_fence(__ATOMIC_ACQUIRE, "agent");
            xb_add(&bar[XB_XGEN(b.x)], 1u);
            asm volatile("s_waitcnt vmcnt(0)" ::: "memory");
        } else {
            XB_SPIN(xb_ld(&bar[XB_XGEN(b.x)]) == gen, bar);
            __builtin_amdgcn_fence(__ATOMIC_ACQUIRE, "agent");
            asm volatile("s_waitcnt vmcnt(0)" ::: "memory");
        }
    }
    __syncthreads();
}

DEVI float bf2f(bf16_t v) { return __uint_as_float(((unsigned)v) << 16); }
typedef float f32x2_t __attribute__((ext_vector_type(2)));
typedef __bf16 bf16x2_t __attribute__((ext_vector_type(2)));
DEVI unsigned pk2(float lo, float hi) { f32x2_t v = {lo, hi}; bf16x2_t b = __builtin_convertvector(v, bf16x2_t); return __builtin_bit_cast(unsigned, b); }
#define dppf(v, ctrl) __int_as_float(__builtin_amdgcn_update_dpp(0, __float_as_int(v), (ctrl), 0xf, 0xf, false))
#define dppi(v, ctrl) __builtin_amdgcn_update_dpp(0, (v), (ctrl), 0xf, 0xf, false)
#define DPP_X1 0xB1
#define DPP_X2 0x4E
#define DPP_HM 0x141
#define DPP_RM 0x140
DEVI float x16f(float v, float& o) { auto r = __builtin_amdgcn_permlane16_swap(__float_as_uint(v), __float_as_uint(v), false, false); o = __uint_as_float(r[1]); return __uint_as_float(r[0]); }
DEVI float x32f(float v, float& o) { auto r = __builtin_amdgcn_permlane32_swap(__float_as_uint(v), __float_as_uint(v), false, false); o = __uint_as_float(r[1]); return __uint_as_float(r[0]); }
DEVI float sum32(float v) { float o; const float a = x32f(v, o); return a + o; }
DEVI float max32(float v) { float o; const float a = x32f(v, o); return fmaxf(a, o); }
DEVI float wave_sum(float v) {
    v += dppf(v, DPP_X1); v += dppf(v, DPP_X2); v += dppf(v, DPP_HM); v += dppf(v, DPP_RM);
    { float o; const float a = x16f(v, o); v = a + o; }
    { float o; const float a = x32f(v, o); v = a + o; }
    return v;
}
DEVI int perm_slot(int cl) { return 16 * ((cl >> 2) & 1) + 4 * (cl >> 3) + (cl & 3); }
DEVI int perm_row(int n) { return (n & ~31) + perm_slot(n & 31); }
DEVI float ex2(float x) { return __builtin_amdgcn_exp2f(x); }
DEVI float siluf(float v) { return v * __builtin_amdgcn_rcpf(1.0f + __expf(-v)); }

namespace g8 {
constexpr int BK = 64, HALF = 128, HT = HALF * BK;
DEVI int lds_byte(int r, int c) { int st = (r >> 4) * 2 + (c >> 5), rr = r & 15, cc = c & 31, ob = rr * 64 + cc * 2; return st * 1024 + (ob ^ (((ob >> 9) & 1) << 5)); }
DEVI void stage_rc(int b, int& R, int& C) { int st = b / 1024, sb = b % 1024, swz = sb ^ (((sb >> 9) & 1) << 5); R = (st >> 1) * 16 + swz / 64; C = (st & 1) * 32 + (swz % 64) / 2; }
}

DEVI void g8_rc(int tid, int& R0, int& C0) { g8::stage_rc(tid * 16, R0, C0); }
DEVI void g8_voff_lin(unsigned (&v)[4], int ld, int tid) { int R0, C0; g8_rc(tid, R0, C0);
    v[0] = (unsigned)(R0 * ld + C0) * 2u; v[1] = (unsigned)((R0 + 64) * ld + C0) * 2u; v[2] = (unsigned)((R0 + 128) * ld + C0) * 2u; v[3] = (unsigned)((R0 + 192) * ld + C0) * 2u; }
DEVI void g8_voff_tab(unsigned (&v)[4], const LAS unsigned* tab, int tid) { int R0, C0; g8_rc(tid, R0, C0);
    v[0] = (tab[R0] + C0) * 2u; v[1] = (tab[R0 + 64] + C0) * 2u; v[2] = (tab[R0 + 128] + C0) * 2u; v[3] = (tab[R0 + 192] + C0) * 2u; }

template <class Epi>
DEVI void gemm_tile(LAS unsigned char* lds, const int tid_in, const char* Ab, const unsigned (&voffA_)[4], const char* Bb, const int K, const Epi& epi) {
    using namespace g8;
    constexpr int HTB = HALF * BK * 2;
    int tz = tid_in; asm volatile("" : "+v"(tz));
    int wid = tz >> 6, lane = tz & 63, wr = wid >> 2, wc = wid & 3, fr = lane & 15, fq = lane >> 4;
    unsigned voffA[4] = {voffA_[0], voffA_[1], voffA_[2], voffA_[3]};
    asm volatile("" : "+v"(voffA[0]), "+v"(voffA[1]), "+v"(voffA[2]), "+v"(voffA[3]));
    unsigned voffB[2];
    { int R0, C0; stage_rc(tz * 16, R0, C0); voffB[0] = (unsigned)(R0 * K + C0) * 2u; voffB[1] = (unsigned)((R0 + 64) * K + C0) * 2u; }
    const size_t kstep = (size_t)(BK * 2);
    const size_t hstepB = (size_t)HALF * K * 2;
    const unsigned ldsw = (unsigned)wid * 1024u;
    const int aoff = lds_byte(wr * 64 + fr, fq * 8), boff = lds_byte(wc * 32 + fr, fq * 8);
#define G8_SA(b, h) (((b) * 2 + (h)) * HTB)
#define G8_SB(b, h) ((4 + (b) * 2 + (h)) * HTB)
#define G8_GL(gp, lofs) __builtin_amdgcn_global_load_lds((const unsigned*)(gp), (LAS unsigned*)(lds + (lofs)), 16, 0, 0)
#define STAGE_A(b, h, kt) do { const char* g_ = Ab + (size_t)(kt) * kstep; G8_GL(g_ + voffA[(h) * 2], G8_SA(b, h) + ldsw); G8_GL(g_ + voffA[(h) * 2 + 1], G8_SA(b, h) + ldsw + 8192); } while (0)
#define STAGE_B(b, h, kt) do { const char* g_ = Bb + (size_t)(kt) * kstep + ((h) ? hstepB : 0); G8_GL(g_ + voffB[0], G8_SB(b, h) + ldsw); G8_GL(g_ + voffB[1], G8_SB(b, h) + ldsw + 8192); } while (0)
#define LDA(dst, b, h) do { _Pragma("unroll") for (int m = 0; m < 4; ++m) _Pragma("unroll") for (int k = 0; k < 2; ++k) dst[m][k] = *(const LAS bf16x8*)(lds + G8_SA(b, h) + aoff + m * 2048 + k * 1024); } while (0)
#define LDB(dst, b, h) do { _Pragma("unroll") for (int n = 0; n < 2; ++n) _Pragma("unroll") for (int k = 0; k < 2; ++k) dst[n][k] = *(const LAS bf16x8*)(lds + G8_SB(b, h) + boff + n * 2048 + k * 1024); } while (0)
#define MMA(ai, bj, Af, Bf) do { __builtin_amdgcn_s_setprio(1); \
    _Pragma("unroll") for (int m = 0; m < 4; ++m) _Pragma("unroll") for (int n = 0; n < 2; ++n) _Pragma("unroll") for (int k = 0; k < 2; ++k) \
      acc[ai][bj][m][n] = __builtin_amdgcn_mfma_f32_16x16x32_bf16(Bf[n][k], Af[m][k], acc[ai][bj][m][n], 0, 0, 0); \
    __builtin_amdgcn_s_setprio(0); } while (0)
#define WAIT_V(n) asm volatile("s_waitcnt vmcnt(" #n ")" ::: "memory")
#define WAIT_L(n) asm volatile("s_waitcnt lgkmcnt(" #n ")" ::: "memory")
#define BAR __builtin_amdgcn_s_barrier()
#define SCHED __builtin_amdgcn_sched_barrier(0)
    f32x4 acc[2][2][4][2];
#pragma unroll
    for (int a = 0; a < 2; ++a)
#pragma unroll
        for (int b = 0; b < 2; ++b)
#pragma unroll
            for (int m = 0; m < 4; ++m)
#pragma unroll
                for (int n = 0; n < 2; ++n) acc[a][b][m][n] = (f32x4){0.f, 0.f, 0.f, 0.f};
    bf16x8 At[4][2], B0[2][2], B1[2][2];
    const int nt = K / BK;
    STAGE_B(0, 0, 0); STAGE_A(0, 0, 0); STAGE_B(0, 1, 0); STAGE_A(0, 1, 0);
    if (wr == 1) BAR;
    WAIT_V(4); BAR;
    STAGE_B(1, 0, 1); STAGE_A(1, 0, 1); STAGE_B(1, 1, 1);
    WAIT_V(6); BAR;
#pragma unroll 1
    for (int t = 0; t < nt; t += 2) {
        const int t2 = (t == nt - 2) ? 0 : t + 2;
        const int t3 = t2 + 1;
        LDB(B0, 0, 0); SCHED; LDA(At, 0, 0); STAGE_A(1, 1, t + 1);
        WAIT_L(8); BAR; WAIT_L(0); MMA(0, 0, At, B0); BAR; SCHED;
        LDB(B1, 0, 1); STAGE_B(0, 0, t2);
        BAR; WAIT_L(0); MMA(0, 1, At, B1); BAR;
        LDA(At, 0, 1); STAGE_A(0, 0, t2);
        BAR; WAIT_L(0); MMA(1, 0, At, B0); BAR; SCHED;
        STAGE_B(0, 1, t2);
        WAIT_V(6); BAR; MMA(1, 1, At, B1); BAR;
        LDB(B0, 1, 0); SCHED; LDA(At, 1, 0); STAGE_A(0, 1, t2);
        WAIT_L(8); BAR; WAIT_L(0); MMA(0, 0, At, B0); BAR; SCHED;
        LDB(B1, 1, 1); STAGE_B(1, 0, t3);
        BAR; WAIT_L(0); MMA(0, 1, At, B1); BAR;
        LDA(At, 1, 1); STAGE_A(1, 0, t3);
        BAR; WAIT_L(0); MMA(1, 0, At, B0); BAR; SCHED;
        STAGE_B(1, 1, t3);
        WAIT_V(6); BAR; MMA(1, 1, At, B1); BAR;
    }
    WAIT_V(0);
    if (wr == 0) BAR;
    BAR;
    asm volatile("" : "+v"(tz)); wid = tz >> 6; lane = tz & 63; wr = wid >> 2; wc = wid & 3; fr = lane & 15; fq = lane >> 4;
    epi(acc, wr, wc, fr, fq);
#undef G8_SA
#undef G8_SB
#undef G8_GL
#undef STAGE_A
#undef STAGE_B
#undef LDA
#undef LDB
#undef MMA
}
struct GDesc { const char* Ab; const char* Bb; unsigned va0, va1, va2, va3; int i0, i1, i2; };
template <class Next, class Epi>
DEVI void gemm_stream(LAS unsigned char* lds, const int tid_in, const int K, Next& next, const Epi& epi) {
    using namespace g8;
    constexpr int HTB = HALF * BK * 2;
    int tz = tid_in; asm volatile("" : "+v"(tz));
    int wid = tz >> 6, lane = tz & 63, wr = wid >> 2, wc = wid & 3, fr = lane & 15, fq = lane >> 4;
    unsigned voffB[2];
    { int R0, C0; stage_rc(tz * 16, R0, C0); voffB[0] = (unsigned)(R0 * K + C0) * 2u; voffB[1] = (unsigned)((R0 + 64) * K + C0) * 2u; }
    const size_t kstep = (size_t)(BK * 2);
    const size_t hstepB = (size_t)HALF * K * 2;
    const unsigned ldsw = (unsigned)wid * 1024u;
    const int aoff = lds_byte(wr * 64 + fr, fq * 8), boff = lds_byte(wc * 32 + fr, fq * 8);
#define G8_SA(b, h) (((b) * 2 + (h)) * HTB)
#define G8_SB(b, h) ((4 + (b) * 2 + (h)) * HTB)
#define G8_GL(gp, lofs) __builtin_amdgcn_global_load_lds((const unsigned*)(gp), (LAS unsigned*)(lds + (lofs)), 16, 0, 0)
#define STG_A(b, h, gb, v0, v1) do { G8_GL((gb) + (v0), G8_SA(b, h) + ldsw); G8_GL((gb) + (v1), G8_SA(b, h) + ldsw + 8192); } while (0)
#define STG_B(b, h, gb) do { const char* g_ = (gb) + ((h) ? hstepB : 0); G8_GL(g_ + voffB[0], G8_SB(b, h) + ldsw); G8_GL(g_ + voffB[1], G8_SB(b, h) + ldsw + 8192); } while (0)
#define LDA(dst, b, h) do { _Pragma("unroll") for (int m = 0; m < 4; ++m) _Pragma("unroll") for (int k = 0; k < 2; ++k) dst[m][k] = *(const LAS bf16x8*)(lds + G8_SA(b, h) + aoff + m * 2048 + k * 1024); } while (0)
#define LDB(dst, b, h) do { _Pragma("unroll") for (int n = 0; n < 2; ++n) _Pragma("unroll") for (int k = 0; k < 2; ++k) dst[n][k] = *(const LAS bf16x8*)(lds + G8_SB(b, h) + boff + n * 2048 + k * 1024); } while (0)
#define MMA(ai, bj, Af, Bf) do { __builtin_amdgcn_s_setprio(1); \
    _Pragma("unroll") for (int m = 0; m < 4; ++m) _Pragma("unroll") for (int n = 0; n < 2; ++n) _Pragma("unroll") for (int k = 0; k < 2; ++k) \
      acc[ai][bj][m][n] = __builtin_amdgcn_mfma_f32_16x16x32_bf16(Bf[n][k], Af[m][k], acc[ai][bj][m][n], 0, 0, 0); \
    __builtin_amdgcn_s_setprio(0); } while (0)
#define ZACC() do { _Pragma("unroll") for (int a = 0; a < 2; ++a) _Pragma("unroll") for (int b = 0; b < 2; ++b) _Pragma("unroll") for (int m = 0; m < 4; ++m) _Pragma("unroll") for (int n = 0; n < 2; ++n) acc[a][b][m][n] = (f32x4){0.f, 0.f, 0.f, 0.f}; } while (0)
    GDesc cur, nxt;
    if (!next(0, cur)) return;
    nxt = cur;
    f32x4 acc[2][2][4][2];
    ZACC();
    bf16x8 At[4][2], B0[2][2], B1[2][2];
    const int nt = K / BK;
    STG_B(0, 0, cur.Bb); STG_A(0, 0, cur.Ab, cur.va0, cur.va1); STG_B(0, 1, cur.Bb); STG_A(0, 1, cur.Ab, cur.va2, cur.va3);
    if (wr == 1) BAR;
    WAIT_V(4); BAR;
    STG_B(1, 0, cur.Bb + kstep); STG_A(1, 0, cur.Ab + kstep, cur.va0, cur.va1); STG_B(1, 1, cur.Bb + kstep);
    WAIT_V(6); BAR;
    int ui = 0; bool has_next = false;
#pragma unroll 1
    for (;;) {
#pragma unroll 1
        for (int t = 0; t < nt; t += 2) {
            const bool last = (t == nt - 2);
            if (last) { has_next = next(ui + 1, nxt); if (!has_next) nxt = cur; }
            const char* a2 = last ? nxt.Ab : cur.Ab + (size_t)(t + 2) * kstep;
            const char* b2 = last ? nxt.Bb : cur.Bb + (size_t)(t + 2) * kstep;
            const unsigned s0 = last ? nxt.va0 : cur.va0, s1 = last ? nxt.va1 : cur.va1, s2 = last ? nxt.va2 : cur.va2, s3 = last ? nxt.va3 : cur.va3;
            LDB(B0, 0, 0); SCHED; LDA(At, 0, 0); STG_A(1, 1, cur.Ab + (size_t)(t + 1) * kstep, cur.va2, cur.va3);
            WAIT_L(8); BAR; WAIT_L(0); MMA(0, 0, At, B0); BAR; SCHED;
            LDB(B1, 0, 1); STG_B(0, 0, b2);
            BAR; WAIT_L(0); MMA(0, 1, At, B1); BAR;
            LDA(At, 0, 1); STG_A(0, 0, a2, s0, s1);
            BAR; WAIT_L(0); MMA(1, 0, At, B0); BAR; SCHED;
            STG_B(0, 1, b2);
            WAIT_V(6); BAR; MMA(1, 1, At, B1); BAR;
            LDB(B0, 1, 0); SCHED; LDA(At, 1, 0); STG_A(0, 1, a2, s2, s3);
            WAIT_L(8); BAR; WAIT_L(0); MMA(0, 0, At, B0); BAR; SCHED;
            LDB(B1, 1, 1); STG_B(1, 0, b2 + kstep);
            BAR; WAIT_L(0); MMA(0, 1, At, B1); BAR;
            LDA(At, 1, 1); STG_A(1, 0, a2 + kstep, s0, s1);
            BAR; WAIT_L(0); MMA(1, 0, At, B0); BAR; SCHED;
            STG_B(1, 1, b2 + kstep);
            WAIT_V(6); BAR; MMA(1, 1, At, B1); BAR;
        }
        {
            int tq = tz; asm volatile("" : "+v"(tq));
            const int wid_ = tq >> 6, lane_ = tq & 63;
            epi(acc, cur, wid_ >> 2, wid_ & 3, lane_ & 15, lane_ >> 4);
        }
        if (!has_next) break;
        ZACC();
        cur = nxt; ++ui;
    }
    WAIT_V(0);
    if (wr == 0) BAR;
    BAR;
#undef G8_SA
#undef G8_SB
#undef G8_GL
#undef STG_A
#undef STG_B
#undef LDA
#undef LDB
#undef MMA
#undef ZACC
}
#define EPI_FOREACH8(acc, wr, wc, fr, fq, ROW, COL8, V0, V1, ...) \
    _Pragma("unroll") for (int ai_ = 0; ai_ < 2; ++ai_) _Pragma("unroll") for (int m_ = 0; m_ < 4; ++m_) { const int ROW = ai_ * 128 + (wr) * 64 + m_ * 16 + (fr); \
    _Pragma("unroll") for (int bj_ = 0; bj_ < 2; ++bj_) { const int COL8 = bj_ * 128 + (wc) * 32 + (fq) * 8; const f32x4 V0 = acc[ai_][bj_][m_][0]; const f32x4 V1 = acc[ai_][bj_][m_][1]; __VA_ARGS__ } }
#define PK8(w, a, b) do { w.x = pk2(a[0], a[1]); w.y = pk2(a[2], a[3]); w.z = pk2(b[0], b[1]); w.w = pk2(b[2], b[3]); } while (0)

template <class SCol, class DRow, class KS, class NS>
DEVI void convert_T(bf16_t* __restrict__ dst, const float* __restrict__ src, int ld, int K, int NR, SCol scol, DRow drow, KS ks, NS ns, int wi, int nw) {
    const int k8n = K >> 3; const int items = NR * k8n;
    for (int it = wi; it < items; it += nw) {
        const int n = it % NR, k0 = (it / NR) << 3;
        const int sc = scol(n);
        float v[8];
#pragma unroll
        for (int j = 0; j < 8; ++j) v[j] = (sc >= 0) ? src[(size_t)(k0 + j) * ld + sc] * ks(k0 + j) : 0.f;
        const float s = ns(n);
        u32x4 w; w.x = pk2(v[0] * s, v[1] * s); w.y = pk2(v[2] * s, v[3] * s); w.z = pk2(v[4] * s, v[5] * s); w.w = pk2(v[6] * s, v[7] * s);
        *(u32x4*)(dst + (size_t)drow(n) * K + k0) = w;
    }
}
struct IdCol { DEVI int operator()(int n) const { return n; } };
struct OneK { DEVI float operator()(int) const { return 1.f; } };
struct VecK { const float* g; DEVI float operator()(int k) const { return g[k]; } };

template <int NB, bool PERM>
DEVI void convert_panel(bf16_t* __restrict__ dst, const float* __restrict__ src, const int ld, const int K, const int tid) {
    constexpr int N4 = NB / 4;
    const int items = (K >> 3) * N4;
#pragma unroll 1
    for (int it0 = tid; it0 < items; it0 += 1024) {
        f32x4 v[2][8];
#pragma unroll
        for (int u = 0; u < 2; ++u) {
            const int it = it0 + u * 512; const int n4 = it % N4, k8 = it / N4;
            const float* sp = src + (size_t)(k8 * 8) * ld + n4 * 4;
#pragma unroll
            for (int j = 0; j < 8; ++j) v[u][j] = *(const f32x4*)(sp + (size_t)j * ld);
        }
#pragma unroll
        for (int u = 0; u < 2; ++u) {
            const int it = it0 + u * 512; const int n4 = it % N4, k8 = it / N4;
#pragma unroll
            for (int c = 0; c < 4; ++c) {
                u32x4 w; w.x = pk2(v[u][0][c], v[u][1][c]); w.y = pk2(v[u][2][c], v[u][3][c]); w.z = pk2(v[u][4][c], v[u][5][c]); w.w = pk2(v[u][6][c], v[u][7][c]);
                const int n = n4 * 4 + c; const int dr = PERM ? ((n & ~31) + perm_slot(n & 31)) : n;
                *(u32x4*)(dst + (size_t)dr * K + k8 * 8) = w;
            }
        }
    }
}

template <int NB, bool PERM>
DEVI void convert_panel_lds(bf16_t* __restrict__ dst, const float* __restrict__ src, const int ld, const int K, const int tid, LAS unsigned char* lds) {
    constexpr int N4 = NB / 4;
    constexpr int K8C = 512 / N4;
    constexpr int KC = K8C * 8;
    constexpr int PITCH = KC * 2 + 8;
    constexpr int PPR = KC / 8;
    const int n4 = tid % N4, k8 = tid / N4;
    const float* sp = src + (size_t)(k8 * 8) * ld + n4 * 4;
    const int nchunk = K / KC;
    f32x4 va[8], vb[8], vc[8];
#define CPL_LOAD(V, c) do { const float* q_ = sp + (size_t)(c) * KC * ld; _Pragma("unroll") for (int j = 0; j < 8; ++j) V[j] = *(const f32x4*)(q_ + (size_t)j * ld); } while (0)
#define CPL_PROC(V, c) do { \
        _Pragma("unroll") for (int cc = 0; cc < 4; ++cc) { \
            u32x2 lo, hi; lo.x = pk2(V[0][cc], V[1][cc]); lo.y = pk2(V[2][cc], V[3][cc]); hi.x = pk2(V[4][cc], V[5][cc]); hi.y = pk2(V[6][cc], V[7][cc]); \
            LAS unsigned char* wp = lds + (n4 * 4 + cc) * PITCH + k8 * 16; \
            *(LAS u32x2*)wp = lo; *(LAS u32x2*)(wp + 8) = hi; } \
        __syncthreads(); \
        _Pragma("unroll") for (int q = 0; q < 4; ++q) { \
            const int p = tid + 512 * q; const int row = p / PPR, pc = p % PPR; \
            const LAS unsigned char* rp = lds + row * PITCH + pc * 16; \
            const u32x2 a = *(const LAS u32x2*)rp, b = *(const LAS u32x2*)(rp + 8); \
            const int dr = PERM ? ((row & ~31) + perm_slot(row & 31)) : row; \
            u32x4 w; w.x = a.x; w.y = a.y; w.z = b.x; w.w = b.y; \
            *(u32x4*)(dst + (size_t)dr * K + (c) * KC + pc * 8) = w; } \
        __syncthreads(); } while (0)
    CPL_LOAD(va, 0); if (nchunk > 1) CPL_LOAD(vb, 1); if (nchunk > 2) CPL_LOAD(vc, 2);
#pragma unroll 1
    for (int c = 0; c < nchunk; c += 3) {
        CPL_PROC(va, c); if (c + 3 < nchunk) CPL_LOAD(va, c + 3);
        if (c + 1 < nchunk) { CPL_PROC(vb, c + 1); if (c + 4 < nchunk) CPL_LOAD(vb, c + 4); }
        if (c + 2 < nchunk) { CPL_PROC(vc, c + 2); if (c + 5 < nchunk) CPL_LOAD(vc, c + 5); }
    }
#undef CPL_LOAD
#undef CPL_PROC
}

struct Params {
    const float* in[24];
    float* out;
    unsigned char* ws;
    int ph_lo, ph_hi;
    int flags, pad;
};
enum { I_X = 0, I_C, I_WADA, I_BADA, I_N1G, I_WIN, I_QNG, I_WUQ, I_KVNG, I_WUKV, I_REL, I_AOG, I_BOG, I_WO, I_N2G, I_WR, I_EB, I_W1, I_W3, I_W2, I_WS1, I_WS3, I_WS2, I_FG };
constexpr int NPHASE = 15;

#define W_x (P.in[I_X])
#define W_mod ((float*)(ws + OFF_MOD))
#define W_ropecs ((float*)(ws + OFF_ROPE))
#define W_biasT ((float*)(ws + OFF_BIAS))
#define W_WinT ((bf16_t*)(ws + OFF_WIN))
#define W_WuqT ((bf16_t*)(ws + OFF_WUQ))
#define W_WukvT ((bf16_t*)(ws + OFF_WUKV))
#define W_WoT ((bf16_t*)(ws + OFF_WO))
#define W_WrT ((bf16_t*)(ws + OFF_WR))
#define W_Ws13T ((bf16_t*)(ws + OFF_WS13))
#define W_Ws2T ((bf16_t*)(ws + OFF_WS2))
#define W_hbuf ((bf16_t*)(ws + OFF_H))
#define W_logits ((float*)(ws + OFF_LOGITS))
#define W_eidx ((int*)(ws + OFF_EIDX))
#define W_gate ((float*)(ws + OFF_GATE))
#define W_rnk ((int*)(ws + OFF_RNK))
#define W_pos ((int*)(ws + OFF_POS))
#define W_toks ((int*)(ws + OFF_TOKS))
#define W_wts ((float*)(ws + OFF_WTS))
#define W_ssq ((float*)(ws + OFF_SSQ))
#define W_scr ((bf16_t*)(ws + OFF_SCR + (size_t)blk * SCR_PER_BLK))
#define W_hdn ((bf16_t*)(ws + OFF_HDN))
#define W_ybuf ((bf16_t*)(ws + OFF_Y))
#define W_y8 ((unsigned char*)(ws + OFF_Y))
#define W_proj ((bf16_t*)(ws + OFF_PROJ))
#define W_qb ((bf16_t*)(ws + OFF_QB))
#define W_kvb ((bf16_t*)(ws + OFF_KVB))
#define W_bout ((bf16_t*)(ws + OFF_BOUT))
#define W_aparts ((bf16_t*)(ws + OFF_APARTS))
#define W_lsebuf ((float*)(ws + OFF_LSE))
#define W_mixb ((bf16_t*)(ws + OFF_MIX))
#define W_xt ((bf16_t*)(ws + OFF_XT))

__global__ void __launch_bounds__(512, 2) fwd_kernel(Params P) {
    extern __shared__ __attribute__((aligned(16))) unsigned char lds[];
    const int blk = blockIdx.x, G = gridDim.x;
    const int wave_s = __builtin_amdgcn_readfirstlane((int)threadIdx.x >> 6);
#define TIDS0 int tid; asm volatile("v_mbcnt_lo_u32_b32 %0, -1, 0\n\tv_mbcnt_hi_u32_b32 %0, -1, %0" : "=v"(tid)); tid += wave_s * 64;
    const int vblk = (G % 8 == 0) ? (blk % 8) * (G / 8) + blk / 8 : blk;
    unsigned char* ws = P.ws;
    unsigned* ctl = (unsigned*)(ws + OFF_CTL);
    { TIDS0 if (tid < 64) ((LAS unsigned*)(lds + LDS_MISC))[tid] = 0u; }
    __syncthreads();
    XcdBarrier bar; bar.bar = ctl; bar.x = 0; bar.st = nullptr;
    if (MK_N_LAUNCHES == 1) { TIDS0 bar = xcd_barrier_post(ctl, (volatile LAS unsigned*)(lds + LDS_MISC), tid == 0); }
#ifndef PH_MASK
#define PH_MASK 0xffffffffu
#endif
#define TIDS int tid; asm volatile("v_mbcnt_lo_u32_b32 %0, -1, 0\n\tv_mbcnt_hi_u32_b32 %0, -1, %0" : "=v"(tid)); tid += wave_s * 64; const int lane = tid & 63; const int wave = wave_s; (void)lane; (void)wave;
#define IN(k) ((((PH_MASK) >> (k)) & 1u) && P.ph_lo <= (k) && (k) < P.ph_hi)
#define SEAM(k) do { if (MK_N_LAUNCHES == 1 && IN(k) && IN((k) + 1)) { TIDS0 xcd_barrier(bar, tid == 0); } } while (0)

    unsigned* cntg = ctl + CNT_WORD0;
    LAS unsigned* rowoff = (LAS unsigned*)(lds + LDS_ROWOFF);
    LAS float* rowsc = (LAS float*)(lds + LDS_ROWSC);
    LAS int* startL = (LAS int*)(lds + LDS_START);
    LAS int* cntL = (LAS int*)(lds + LDS_CNT);
    LAS int* tbL = (LAS int*)(lds + LDS_TB);
    LAS int* itemD = (LAS int*)(lds + LDS_MISC + 64);
    char* stage = (char*)lds + LDS_STAGE;
    LAS unsigned char* ldsL = (LAS unsigned char*)lds;

    if (IN(0)) {
        TIDS
        {
            float* sc = (float*)(lds);
            float* red = (float*)(lds + 32768);
            const float* c = P.in[I_C];
            for (int i = tid; i < 8192; i += 512) sc[i] = siluf(c[i]);
            __syncthreads();
            for (int cb = blk; cb < 256; cb += G) {
                const int cj = tid & 31, kg = tid >> 5;
                float a0 = 0, a1 = 0, a2 = 0, a3 = 0, a4 = 0, a5 = 0, a6 = 0, a7 = 0;
                if (cj < 24) {
                    const float* w = P.in[I_WADA] + cb * 24 + cj;
                    for (int k = kg * 64; k < kg * 64 + 64; ++k) {
                        const float wv = w[(size_t)k * 6144];
                        a0 += sc[k] * wv; a1 += sc[1024 + k] * wv; a2 += sc[2048 + k] * wv; a3 += sc[3072 + k] * wv;
                        a4 += sc[4096 + k] * wv; a5 += sc[5120 + k] * wv; a6 += sc[6144 + k] * wv; a7 += sc[7168 + k] * wv;
                    }
                }
                float* rp = red + (kg * 8) * 32 + cj;
                rp[0] = a0; rp[32] = a1; rp[64] = a2; rp[96] = a3; rp[128] = a4; rp[160] = a5; rp[192] = a6; rp[224] = a7;
                __syncthreads();
                if (tid < 256) {
                    const int b = tid >> 5, j = tid & 31;
                    if (j < 24) {
                        float s = 0.f;
                        for (int g = 0; g < 16; ++g) s += red[(g * 8 + b) * 32 + j];
                        const int col = cb * 24 + j;
                        W_mod[b * 6144 + col] = s + P.in[I_BADA][col];
                    }
                }
                __syncthreads();
            }
        }
        {
            for (int idx = blk * 512 + tid; idx < 4096 * 16; idx += G * 512) {
                const int s = idx >> 4, i = idx & 15;
                double inv = 1.0; for (int j = 0; j < i; ++j) inv *= 0.5623413251903491;
                const float invf = (float)inv;
                const float angf = (float)s * invf;
                const double xa = (double)angf;
                const double nrev = __builtin_rint(xa * 0.15915494309189535);
                const double r = xa - nrev * 6.283185307179586;
                const double r2 = r * r;
                double ts = r, ss = r, tc = 1.0, cc = 1.0;
#pragma unroll
                for (int n = 1; n <= 14; ++n) {
                    ts *= -r2 / (double)((2 * n) * (2 * n + 1)); ss += ts;
                    tc *= -r2 / (double)((2 * n - 1) * (2 * n)); cc += tc;
                }
                W_ropecs[idx * 2] = (float)cc; W_ropecs[idx * 2 + 1] = (float)ss;
            }
        }
        {
            for (int idx = blk * 512 + tid; idx < 3 * 8 * 129; idx += G * 512) {
                const int j = idx % 129, hh = (idx / 129) % 8, p = idx / (129 * 8);
                const int dil = (p == 0) ? 1 : (p == 1 ? 4 : 16);
                const int rel = (j - 64) * dil;
                const int n = rel < 0 ? -rel : rel;
                const float nf = (float)(n > 1 ? n : 1);
                int large = 8 + (int)(__logf(nf * 0.125f) / 4.852030263919617f * 8.0f);
                large = large < 15 ? large : 15;
                const int bucket = (rel > 0 ? 16 : 0) + (n < 8 ? n : large);
                W_biasT[idx] = P.in[I_REL][bucket * 8 + hh] * LOG2E;
            }
        }
        {
            const int wi = blk * 512 + tid, nw = G * 512;
            convert_T(W_WinT, P.in[I_WIN], INC, 1024, INCP,
                      [](int n) { if (n >= INC) return -1; if (n < 2176) return n; const int i = n - 2176; return 2176 + ((i & 1) ? 16 : 0) + (i >> 1); },
                      [](int n) { return perm_row(n); }, OneK{}, [](int n) { return n < 512 ? 0.125f * LOG2E : 1.0f; }, wi, nw);
            convert_T(W_WuqT, P.in[I_WUQ], 768, 384, 768,
                      [](int n) { if (n < 512) return (n >> 6) * 96 + (n & 63); const int hh = (n - 512) >> 5, i = n & 31; return hh * 96 + 64 + ((i & 1) ? 16 : 0) + (i >> 1); },
                      [](int n) { return perm_row(n); }, VecK{P.in[I_QNG]}, [](int) { return 0.10206207261596577f * LOG2E; }, wi, nw);
            convert_T(W_WukvT, P.in[I_WUKV], 1024, 256, 1024, IdCol{}, [](int n) { return perm_row(n); }, VecK{P.in[I_KVNG]}, [](int) { return 1.f; }, wi, nw);
            {
                const float* ag = P.in[I_AOG]; const float* bg = P.in[I_BOG];
                convert_T(W_WoT, P.in[I_WO], 1024, 1024, 1024, IdCol{}, [](int n) { return perm_row(n); }, [=](int k) { return k < 512 ? ag[k] : bg[k - 512]; }, [](int) { return 1.f; }, wi, nw);
            }
            convert_T(W_WrT, P.in[I_WR], 256, 1024, 256, IdCol{}, [](int n) { return perm_row(n); }, OneK{}, [](int) { return 1.f; }, wi, nw);
            convert_T(W_Ws13T, P.in[I_WS1], 256, 1024, 256, IdCol{}, [](int n) { return perm_row((n >> 7) * 256 + (n & 127)); }, OneK{}, [](int) { return 1.f; }, wi, nw);
            convert_T(W_Ws13T, P.in[I_WS3], 256, 1024, 256, IdCol{}, [](int n) { return perm_row((n >> 7) * 256 + 128 + (n & 127)); }, OneK{}, [](int) { return 1.f; }, wi, nw);
            convert_T(W_Ws2T, P.in[I_WS2], 1024, 256, 1024, IdCol{}, [](int n) { return perm_row(n); }, OneK{}, [](int) { return 1.f; }, wi, nw);
        }
    }
    SEAM(0);

    if (IN(1)) {
        TIDS
        const float* g = P.in[I_N1G];
        for (int row = blk * 8 + wave; row < NTOK; row += G * 8) {
            const int b = row >> 12;
            const float* xr = W_x + (size_t)row * DM;
            f32x4 v[4]; float ss = 0.f;
#pragma unroll
            for (int i = 0; i < 4; ++i) { v[i] = *(const f32x4*)(xr + i * 256 + lane * 4); ss += v[i][0] * v[i][0] + v[i][1] * v[i][1] + v[i][2] * v[i][2] + v[i][3] * v[i][3]; }
            ss = wave_sum(ss);
            const float rinv = rsqrtf(ss * (1.0f / 1024.0f) + EPS);
            const float* mb = W_mod + b * 6144;
#pragma unroll
            for (int i = 0; i < 4; ++i) {
                const int c = i * 256 + lane * 4;
                const f32x4 gg = *(const f32x4*)(g + c), sh = *(const f32x4*)(mb + c), sc = *(const f32x4*)(mb + 1024 + c);
                float o[4];
#pragma unroll
                for (int j = 0; j < 4; ++j) o[j] = v[i][j] * rinv * gg[j] * (1.0f + sc[j]) + sh[j];
                u32x2 w; w.x = pk2(o[0], o[1]); w.y = pk2(o[2], o[3]);
                *(u32x2*)(W_hbuf + (size_t)row * DM + c) = w;
            }
        }
    }
    SEAM(1);

    if (IN(2)) {
        TIDS
        unsigned vl_[4]; g8_voff_lin(vl_, DM, tid);
        auto nextf = [&](int i, GDesc& d) {
            const int ul = i * 32 + (vblk & 31); if (ul >= 144 || vblk >= 256) return false;
            const int pm = (vblk >> 5) * 16 + ul / 9, pn = ul % 9;
            d.Ab = (const char*)(W_hbuf + (size_t)pm * 256 * DM); d.Bb = (const char*)(W_WinT + (size_t)pn * 256 * DM);
            d.va0 = vl_[0]; d.va1 = vl_[1]; d.va2 = vl_[2]; d.va3 = vl_[3]; d.i0 = pm; d.i1 = pn; d.i2 = 0; return true;
        };
        auto epi = [&](const f32x4 (&acc)[2][2][4][2], const GDesc& d, int wr, int wc, int fr, int fq) {
            const int pm = d.i0, pn = d.i1;
            if (pn < 8) {
                EPI_FOREACH8(acc, wr, wc, fr, fq, r, c8, v0, v1, {
                    u32x4 w; PK8(w, v0, v1);
                    *(u32x4*)(W_proj + (size_t)(pm * 256 + r) * INCP + pn * 256 + c8) = w;
                })
            } else {
                EPI_FOREACH8(acc, wr, wc, fr, fq, r, c8, v0, v1, {
                    const int row = pm * 256 + r;
                    if (c8 < 160) {
                        f32x4 o0 = v0, o1 = v1;
                        if (c8 >= 128) {
                            const int i = (c8 - 128) >> 1; const int s = row & 4095;
                            const f32x4 ca = *(const f32x4*)(W_ropecs + (s * 16 + i) * 2), cb = *(const f32x4*)(W_ropecs + (s * 16 + i) * 2 + 4);
                            o0[0] = v0[0] * ca[0] - v0[1] * ca[1]; o0[1] = v0[1] * ca[0] + v0[0] * ca[1];
                            o0[2] = v0[2] * ca[2] - v0[3] * ca[3]; o0[3] = v0[3] * ca[2] + v0[2] * ca[3];
                            o1[0] = v1[0] * cb[0] - v1[1] * cb[1]; o1[1] = v1[1] * cb[0] + v1[0] * cb[1];
                            o1[2] = v1[2] * cb[2] - v1[3] * cb[3]; o1[3] = v1[3] * cb[2] + v1[2] * cb[3];
                        }
                        u32x4 w; PK8(w, o0, o1);
                        *(u32x4*)(W_proj + (size_t)row * INCP + 2048 + c8) = w;
                    }
                })
            }
            if (pn >= 6) {
#pragma unroll
                for (int ai = 0; ai < 2; ++ai)
#pragma unroll
                    for (int m = 0; m < 4; ++m)
#pragma unroll
                        for (int bj = 0; bj < 2; ++bj) {
                            const f32x4 a = acc[ai][bj][m][0], b = acc[ai][bj][m][1];
                            float ss = a[0] * a[0] + a[1] * a[1] + a[2] * a[2] + a[3] * a[3] + b[0] * b[0] + b[1] * b[1] + b[2] * b[2] + b[3] * b[3];
                            { float o; const float t = x16f(ss, o); ss = t + o; }
                            { float o; const float t = x32f(ss, o); ss = t + o; }
                            if (fq == 0) W_ssq[(size_t)(pm * 256 + ai * 128 + wr * 64 + m * 16 + fr) * 24 + (pn - 6) * 8 + bj * 4 + wc] = ss;
                        }
            }
        };
        gemm_stream(ldsL, tid, DM, nextf, epi);
        if ((vblk & 31) >= 16) {
            TIDS
#pragma unroll 1
            for (int q = 0; q < 2; ++q) {
                const int uu = blk + q * G;
                const int e = (G == 256) ? ((vblk & ~3) + q) : (uu >> 2), pn = (G == 256) ? (vblk & 3) : (uu & 3);
                __syncthreads();
                if (uu < 1024) convert_panel_lds<256, true>(W_scr + (size_t)2 * 256 * 1024 + (size_t)q * 256 * 256, P.in[I_W2] + (size_t)e * 256 * 1024 + pn * 256, 1024, 256, tid, ldsL);
            }
        }
    }
    SEAM(2);

    if (IN(3)) {
        {
            TIDS
            const int xb = (vblk >> 5) * 16, lb = vblk & 31;
            __syncthreads();
            for (int j = 0; j < 2; ++j) { const int ul = j * 32 + lb; if (ul < 48 && tid < 256) {
                const float* sp = W_ssq + (size_t)((xb + ul / 3) * 256 + tid) * 24;
                const f32x4 s0 = *(const f32x4*)sp, s1 = *(const f32x4*)(sp + 4), s2 = *(const f32x4*)(sp + 8);
                const float ss = ((s0[0] + s0[1]) + (s0[2] + s0[3])) + ((s1[0] + s1[1]) + (s1[2] + s1[3])) + ((s2[0] + s2[1]) + (s2[2] + s2[3]));
                rowsc[j * 256 + tid] = rsqrtf(ss * (1.0f / 384.0f) + EPS); } }
            __syncthreads();
            unsigned vl_[4]; g8_voff_lin(vl_, INCP, tid);
            auto nextf = [&](int i, GDesc& d) {
                const int ul = i * 32 + lb; if (ul >= 48 || vblk >= 256) return false;
                const int pm = xb + ul / 3, pn = ul % 3;
                d.Ab = (const char*)(W_proj + (size_t)pm * 256 * INCP + 1536); d.Bb = (const char*)(W_WuqT + (size_t)pn * 256 * QLORA);
                d.va0 = vl_[0]; d.va1 = vl_[1]; d.va2 = vl_[2]; d.va3 = vl_[3]; d.i0 = pm * 4 + pn; d.i1 = i; d.i2 = 0; return true;
            };
            auto epi = [&](const f32x4 (&acc)[2][2][4][2], const GDesc& d, int wr, int wc, int fr, int fq) {
                const int pm = d.i0 >> 2, pn = d.i0 & 3, sl = d.i1 * 256;
                if (pn < 2) {
                    EPI_FOREACH8(acc, wr, wc, fr, fq, r, c8, v0, v1, {
                        const float rs = rowsc[sl + r];
                        const f32x4 a = v0 * rs, b = v1 * rs;
                        u32x4 w; PK8(w, a, b);
                        *(u32x4*)(W_qb + (size_t)(pm * 256 + r) * 768 + pn * 256 + c8) = w;
                    })
                } else {
                    EPI_FOREACH8(acc, wr, wc, fr, fq, r, c8, v0, v1, {
                        const int row = pm * 256 + r;
                        const float rs = rowsc[sl + r];
                        const int i = (c8 & 31) >> 1; const int s = row & 4095;
                        const f32x4 ca = *(const f32x4*)(W_ropecs + (s * 16 + i) * 2), cb = *(const f32x4*)(W_ropecs + (s * 16 + i) * 2 + 4);
                        const f32x4 t0 = v0 * rs, t1 = v1 * rs;
                        f32x4 o0, o1;
                        o0[0] = t0[0] * ca[0] - t0[1] * ca[1]; o0[1] = t0[1] * ca[0] + t0[0] * ca[1];
                        o0[2] = t0[2] * ca[2] - t0[3] * ca[3]; o0[3] = t0[3] * ca[2] + t0[2] * ca[3];
                        o1[0] = t1[0] * cb[0] - t1[1] * cb[1]; o1[1] = t1[1] * cb[0] + t1[0] * cb[1];
                        o1[2] = t1[2] * cb[2] - t1[3] * cb[3]; o1[3] = t1[3] * cb[2] + t1[2] * cb[3];
                        u32x4 w; PK8(w, o0, o1);
                        *(u32x4*)(W_qb + (size_t)row * 768 + 512 + c8) = w;
                    })
                }
            };
            gemm_stream(ldsL, tid, QLORA, nextf, epi);
        }
        {
            TIDS
            const int xb = (vblk >> 5) * 16, lb = vblk & 31;
            __syncthreads();
            for (int j = 0; j < 2; ++j) { const int ul = j * 32 + lb; if (tid < 256) {
                const float* sp = W_ssq + (size_t)((xb + ul / 4) * 256 + tid) * 24 + 12;
                const f32x4 s0 = *(const f32x4*)sp, s1 = *(const f32x4*)(sp + 4);
                const float ss = ((s0[0] + s0[1]) + (s0[2] + s0[3])) + ((s1[0] + s1[1]) + (s1[2] + s1[3]));
                rowsc[j * 256 + tid] = rsqrtf(ss * (1.0f / 256.0f) + EPS); } }
            __syncthreads();
            unsigned vl_[4]; g8_voff_lin(vl_, INCP, tid);
            auto nextf = [&](int i, GDesc& d) {
                const int ul = i * 32 + lb; if (ul >= 64 || vblk >= 256) return false;
                const int pm = xb + ul / 4, pn = ul % 4;
                d.Ab = (const char*)(W_proj + (size_t)pm * 256 * INCP + 1920); d.Bb = (const char*)(W_WukvT + (size_t)pn * 256 * KVLORA);
                d.va0 = vl_[0]; d.va1 = vl_[1]; d.va2 = vl_[2]; d.va3 = vl_[3]; d.i0 = pm * 4 + pn; d.i1 = i; d.i2 = 0; return true;
            };
            auto epi = [&](const f32x4 (&acc)[2][2][4][2], const GDesc& d, int wr, int wc, int fr, int fq) {
                const int pm = d.i0 >> 2, pn = d.i0 & 3, sl = d.i1 * 256;
                EPI_FOREACH8(acc, wr, wc, fr, fq, r, c8, v0, v1, {
                    const float rs = rowsc[sl + r];
                    const f32x4 a = v0 * rs, b = v1 * rs;
                    u32x4 w; PK8(w, a, b);
                    *(u32x4*)(W_kvb + (size_t)(pm * 256 + r) * 1024 + pn * 256 + c8) = w;
                })
            };
            gemm_stream(ldsL, tid, KVLORA, nextf, epi);
        }
    }
    SEAM(3);

    if (IN(4)) {
        for (int ui = 0; ui < ((P.flags & 4) ? 0 : 4); ++ui) {
            TIDS
            const int r32 = lane & 31, hh = lane >> 5;
            if (vblk >= 256) break;
            const int qblk = vblk & 15, bh = (vblk >> 5) * 8 + ui * 2 + ((vblk >> 4) & 1), h = bh & 7, b = bh >> 3;
            const size_t tok0 = (size_t)b * SEQ;
            bf16x8 qf[6];
            {
                const size_t tq = tok0 + qblk * 256 + wave * 32 + r32;
#pragma unroll
                for (int d0 = 0; d0 < 6; ++d0) qf[d0] = *(const bf16x8*)(W_qb + tq * 768 + (d0 < 4 ? h * 64 + d0 * 16 : 512 + h * 32 + (d0 - 4) * 16) + hh * 8);
            }
            f32x16 o0 = {}, o1 = {};
            f32x16 mneg = {};
            float m_run = 0.f, l_run = 0.f;
            const int skey = tid >> 3, sch = tid & 7;
            const bf16_t* kn_src = W_kvb + (tok0 + skey) * 1024 + h * 128 + sch * 8;
            const int pkey = tid >> 2, pch = tid & 3;
            const bf16_t* kp_src = W_proj + (tok0 + pkey) * INCP + 2176 + pch * 8;
            constexpr int KBUF = 12 * 2048, VBUF = 2 * 8192, BUFB = KBUF + VBUF;
            const int k_dst = sch * 2048 + ((skey ^ sch) * 16);
            const int kp_dst = (8 + pch) * 2048 + ((pkey ^ pch) * 16);
            const int v_dst = KBUF + (sch >> 2) * 8192 + skey * 64 + (sch & 3) * 16;
            const int kfo = hh * 2048;
            const int vfo = KBUF + (4 * hh + ((lane & 15) >> 2)) * 64 + ((lane >> 4) & 1) * 32 + (lane & 3) * 8;
            __syncthreads();
            {
                const u32x4 k0 = *(const u32x4*)kn_src, v0 = *(const u32x4*)(kn_src + 64);
                const u32x4 k1 = *(const u32x4*)(kn_src + 64 * 1024), v1 = *(const u32x4*)(kn_src + 64 * 1024 + 64);
                const u32x4 pr = *(const u32x4*)kp_src;
                *(LAS u32x4*)(ldsL + k_dst) = k0; *(LAS u32x4*)(ldsL + k_dst + 1024) = k1;
                *(LAS u32x4*)(ldsL + v_dst) = v0; *(LAS u32x4*)(ldsL + v_dst + 4096) = v1;
                *(LAS u32x4*)(ldsL + kp_dst) = pr;
            }
            __syncthreads();
#pragma unroll 1
            for (int t = 0; t < 32; ++t) {
                const int cur = t & 1;
                const int tn = (t + 1 < 32) ? t + 1 : t;
                const bf16_t* ks = kn_src + (size_t)tn * 128 * 1024;
                const u32x4 nk0 = *(const u32x4*)ks, nv0 = *(const u32x4*)(ks + 64);
                const u32x4 nk1 = *(const u32x4*)(ks + 64 * 1024), nv1 = *(const u32x4*)(ks + 64 * 1024 + 64);
                const u32x4 npr = *(const u32x4*)(kp_src + (size_t)tn * 128 * INCP);
                f32x16 sc[2][2];
#pragma unroll
                for (int sub = 0; sub < 2; ++sub) {
                    const int kb = cur * BUFB + kfo + sub * 1024;
#pragma unroll
                    for (int d0 = 0; d0 < 6; ++d0) {
                        const int sw = (2 * d0 + hh) & 7;
                        const bf16x8 k0 = *(const LAS bf16x8*)(ldsL + kb + d0 * 4096 + ((r32 ^ sw) * 16));
                        const bf16x8 k1 = *(const LAS bf16x8*)(ldsL + kb + d0 * 4096 + (((32 + r32) ^ sw) * 16));
                        if (d0 == 0) { sc[sub][0] = __builtin_amdgcn_mfma_f32_32x32x16_bf16(k0, qf[0], mneg, 0, 0, 0); sc[sub][1] = __builtin_amdgcn_mfma_f32_32x32x16_bf16(k1, qf[0], mneg, 0, 0, 0); }
                        else { sc[sub][0] = __builtin_amdgcn_mfma_f32_32x32x16_bf16(k0, qf[d0], sc[sub][0], 0, 0, 0); sc[sub][1] = __builtin_amdgcn_mfma_f32_32x32x16_bf16(k1, qf[d0], sc[sub][1], 0, 0, 0); }
                    }
                }
#pragma unroll
                for (int sub = 0; sub < 2; ++sub) {
                    const int vb = cur * BUFB + vfo + sub * 4096;
                    f32x16& s0 = sc[sub][0]; f32x16& s1 = sc[sub][1];
#define MX3(a, b, c) __builtin_fmaxf(__builtin_fmaxf((a), (b)), (c))
                    float mxa = MX3(s0[0], s0[1], s1[0]), mxb = MX3(s0[2], s0[3], s1[1]); mxa = MX3(mxa, s1[2], s1[3]);
#pragma unroll
                    for (int i = 4; i < 16; i += 4) { mxa = MX3(mxa, s0[i], s0[i + 1]); mxb = MX3(mxb, s0[i + 2], s0[i + 3]); mxa = MX3(mxa, s1[i], s1[i + 1]); mxb = MX3(mxb, s1[i + 2], s1[i + 3]); }
#undef MX3
                    float mx = max32(__builtin_fmaxf(mxa, mxb));
                    const bool first = (t == 0 && sub == 0);
                    if (first || __builtin_amdgcn_ballot_w64(mx > 8.0f) != 0ull) {
                        const float d = first ? mx : fmaxf(mx, 0.f);
                        const float alpha = first ? 0.f : ex2(-d);
                        m_run += d; l_run *= alpha;
#pragma unroll
                        for (int i = 0; i < 16; ++i) { o0[i] *= alpha; o1[i] *= alpha; s0[i] -= d; s1[i] -= d; mneg[i] = -m_run; }
                        if (sub == 0) {
#pragma unroll
                            for (int i = 0; i < 16; ++i) { sc[1][0][i] -= d; sc[1][1][i] -= d; }
                        }
                    }
                    f32x2_t psv = {0.f, 0.f};
#pragma unroll
                    for (int i = 0; i < 16; i += 2) { s0[i] = ex2(s0[i]); s0[i + 1] = ex2(s0[i + 1]); s1[i] = ex2(s1[i]); s1[i + 1] = ex2(s1[i + 1]);
                        psv += (f32x2_t){s0[i], s0[i + 1]}; psv += (f32x2_t){s1[i], s1[i + 1]}; }
                    l_run += psv[0] + psv[1];
                    bf16x8 pf[2][2];
#pragma unroll
                    for (int s = 0; s < 2; ++s) {
                        u32x4 w0, w1;
                        w0.x = pk2(s0[8 * s + 0], s0[8 * s + 1]); w0.y = pk2(s0[8 * s + 2], s0[8 * s + 3]); w0.z = pk2(s0[8 * s + 4], s0[8 * s + 5]); w0.w = pk2(s0[8 * s + 6], s0[8 * s + 7]);
                        w1.x = pk2(s1[8 * s + 0], s1[8 * s + 1]); w1.y = pk2(s1[8 * s + 2], s1[8 * s + 3]); w1.z = pk2(s1[8 * s + 4], s1[8 * s + 5]); w1.w = pk2(s1[8 * s + 6], s1[8 * s + 7]);
                        pf[0][s] = __builtin_bit_cast(bf16x8, w0); pf[1][s] = __builtin_bit_cast(bf16x8, w1);
                    }
#pragma unroll
                    for (int n = 0; n < 2; ++n)
#pragma unroll
                        for (int s = 0; s < 2; ++s) {
                            const int ko = (32 * n + 16 * s) * 64;
#pragma unroll
                            for (int db = 0; db < 2; ++db) {
                                const s16x4 lo = __builtin_bit_cast(s16x4, __builtin_amdgcn_ds_read_tr16_b64_v4i16((LAS s16x4*)(ldsL + vb + db * 8192 + ko)));
                                const s16x4 hi = __builtin_bit_cast(s16x4, __builtin_amdgcn_ds_read_tr16_b64_v4i16((LAS s16x4*)(ldsL + vb + db * 8192 + ko + 512)));
                                const bf16x8 vf = {lo[0], lo[1], lo[2], lo[3], hi[0], hi[1], hi[2], hi[3]};
                                if (db == 0) o0 = __builtin_amdgcn_mfma_f32_32x32x16_bf16(vf, pf[n][s], o0, 0, 0, 0);
                                else o1 = __builtin_amdgcn_mfma_f32_32x32x16_bf16(vf, pf[n][s], o1, 0, 0, 0);
                            }
                        }
                }
                {
                    const int nb = (cur ^ 1) * BUFB;
                    *(LAS u32x4*)(ldsL + nb + k_dst) = nk0; *(LAS u32x4*)(ldsL + nb + k_dst + 1024) = nk1;
                    *(LAS u32x4*)(ldsL + nb + v_dst) = nv0; *(LAS u32x4*)(ldsL + nb + v_dst + 4096) = nv1;
                    *(LAS u32x4*)(ldsL + nb + kp_dst) = npr;
                }
                __syncthreads();
            }
            {
                const float lt = sum32(l_run);
                const float inv = 1.0f / lt;
                const int sc = 81920 + wave * 4352;
#pragma unroll
                for (int g = 0; g < 4; ++g) {
                    u32x2 w;
                    w.x = pk2(o0[4 * g] * inv, o0[4 * g + 1] * inv); w.y = pk2(o0[4 * g + 2] * inv, o0[4 * g + 3] * inv);
                    *(LAS u32x2*)(ldsL + sc + r32 * 136 + (8 * g + 4 * hh) * 2) = w;
                    w.x = pk2(o1[4 * g] * inv, o1[4 * g + 1] * inv); w.y = pk2(o1[4 * g + 2] * inv, o1[4 * g + 3] * inv);
                    *(LAS u32x2*)(ldsL + sc + r32 * 136 + (32 + 8 * g + 4 * hh) * 2) = w;
                }
                __syncthreads();
#pragma unroll
                for (int it = 0; it < 8; ++it) {
                    const int row = it * 4 + (lane >> 4), pc = lane & 15;
                    const u32x2 w = *(const LAS u32x2*)(ldsL + sc + row * 136 + pc * 8);
                    *(u32x2*)(W_bout + (tok0 + qblk * 256 + wave * 32 + row) * 512 + h * 64 + pc * 4) = w;
                }
            }
            if ((vblk & 3) == ui) {
#pragma unroll 1
                for (int sl = 0; sl < 4; ++sl) {
                    const int j = sl >> 1; const int uu = blk + j * G;
                    const int e = (G == 256) ? ((vblk & ~1) + j) : (uu >> 1), pn = (G == 256) ? (vblk & 1) : (uu & 1);
                    __syncthreads();
                    if (uu < 512) convert_panel_lds<128, true>(W_scr + (size_t)j * 256 * 1024 + (sl & 1) * 128 * 1024, P.in[(sl & 1) ? I_W3 : I_W1] + (size_t)e * 1024 * 256 + pn * 128, 256, 1024, tid, ldsL);
                }
            }
        }
        for (int ui = 0; ui < ((P.flags & 8) ? 0 : 12); ++ui) {
            TIDS
            const int r32 = lane & 31, hh = lane >> 5;
            const int u = vblk * 12 + ui;
            if (u >= 3072) break;
            const int bh = u / 48, w48 = u % 48, h = bh & 7, b = bh >> 3;
            const int p = w48 >> 4, j16 = w48 & 15;
            const int dil = (p == 0) ? 1 : (p == 1 ? 4 : 16);
            const int res = (p == 0) ? 0 : (p == 1 ? (j16 >> 2) : j16);
            const int m0 = (p == 0) ? j16 * 256 : (p == 1 ? (j16 & 3) * 256 : 0);
            const int L = SEQ / dil;
            const size_t tok0 = (size_t)b * SEQ;
            __syncthreads();
            for (int idx = tid; idx < 672; idx += 512) { const int oi = idx - 255; *(LAS float*)(ldsL + 98304 + idx * 4) = (oi >= 0 && oi <= 128) ? W_biasT[(p * 8 + h) * 129 + oi] : -1e30f; }
            {
                u32x4 kr[6], vr[6];
#pragma unroll
                for (int it = 0; it < 6; ++it) {
                    const int idx = it * 512 + tid, row = idx >> 3, ch = idx & 7;
                    const int mk = m0 - 64 + row;
                    kr[it] = (u32x4){0, 0, 0, 0}; vr[it] = (u32x4){0, 0, 0, 0};
                    if (mk >= 0 && mk < L) {
                        const bf16_t* src = W_proj + (tok0 + (size_t)mk * dil + res) * INCP + 512 + h * 64 + ch * 8;
                        kr[it] = *(const u32x4*)src; vr[it] = *(const u32x4*)(src + 512);
                    }
                }
#pragma unroll
                for (int it = 0; it < 6; ++it) {
                    const int idx = it * 512 + tid, row = idx >> 3, ch = idx & 7;
                    *(LAS u32x4*)(ldsL + ch * 6144 + ((row ^ ch) * 16)) = kr[it];
                    *(LAS u32x4*)(ldsL + 49152 + (ch >> 2) * 24576 + row * 64 + (ch & 3) * 16) = vr[it];
                }
            }
            const int qrel = wave * 32 + r32;
            const size_t tq = tok0 + (size_t)(m0 + qrel) * dil + res;
            bf16x8 qf[4];
#pragma unroll
            for (int d0 = 0; d0 < 4; ++d0) qf[d0] = *(const bf16x8*)(W_proj + tq * INCP + h * 64 + d0 * 16 + hh * 8);
            __syncthreads();
            f32x16 o0 = {}, o1 = {};
            float m_run = -1e20f, l_run = 0.f;
            const int vfo = 49152 + (4 * hh + ((lane & 15) >> 2)) * 64 + ((lane >> 4) & 1) * 32 + (lane & 3) * 8;
#pragma unroll 1
            for (int jj = 0; jj < 3; ++jj) {
                const int jt = (wave >> 1) + jj;
                f32x16 s0 = {}, s1 = {};
#pragma unroll
                for (int d0 = 0; d0 < 4; ++d0) {
                    const int ch = 2 * d0 + hh;
                    const bf16x8 k0 = *(const LAS bf16x8*)(ldsL + ch * 6144 + (((64 * jt + r32) ^ ch) * 16));
                    const bf16x8 k1 = *(const LAS bf16x8*)(ldsL + ch * 6144 + (((64 * jt + 32 + r32) ^ ch) * 16));
                    s0 = __builtin_amdgcn_mfma_f32_32x32x16_bf16(k0, qf[d0], s0, 0, 0, 0);
                    s1 = __builtin_amdgcn_mfma_f32_32x32x16_bf16(k1, qf[d0], s1, 0, 0, 0);
                }
                const LAS float* bl = (const LAS float*)(ldsL + 98304) + (64 * jt - qrel + 4 * hh + 255);
                const int mkb = m0 - 64 + 64 * jt;
                const bool edge = (mkb < 0) || (mkb + 64 > L);
                float mx = -1e30f;
#pragma unroll
                for (int i = 0; i < 16; ++i) {
                    const int cr = (i & 3) + 8 * (i >> 2);
                    s0[i] += bl[cr]; s1[i] += bl[cr + 32];
                    if (edge) {
                        const int mk0 = mkb + cr + 4 * hh;
                        if (mk0 < 0 || mk0 >= L) s0[i] = -1e30f;
                        if (mk0 + 32 < 0 || mk0 + 32 >= L) s1[i] = -1e30f;
                    }
                    mx = fmaxf(mx, fmaxf(s0[i], s1[i]));
                }
                mx = max32(mx);
                const float m_new = fmaxf(m_run, mx);
                const float alpha = ex2(m_run - m_new);
                m_run = m_new;
                float ps = 0.f;
#pragma unroll
                for (int i = 0; i < 16; ++i) { s0[i] = ex2(s0[i] - m_new); s1[i] = ex2(s1[i] - m_new); ps += s0[i] + s1[i]; }
                l_run = l_run * alpha + ps;
#pragma unroll
                for (int i = 0; i < 16; ++i) { o0[i] *= alpha; o1[i] *= alpha; }
                bf16x8 pf[2][2];
#pragma unroll
                for (int s = 0; s < 2; ++s) {
                    u32x4 w0, w1;
                    w0.x = pk2(s0[8 * s + 0], s0[8 * s + 1]); w0.y = pk2(s0[8 * s + 2], s0[8 * s + 3]); w0.z = pk2(s0[8 * s + 4], s0[8 * s + 5]); w0.w = pk2(s0[8 * s + 6], s0[8 * s + 7]);
                    w1.x = pk2(s1[8 * s + 0], s1[8 * s + 1]); w1.y = pk2(s1[8 * s + 2], s1[8 * s + 3]); w1.z = pk2(s1[8 * s + 4], s1[8 * s + 5]); w1.w = pk2(s1[8 * s + 6], s1[8 * s + 7]);
                    pf[0][s] = __builtin_bit_cast(bf16x8, w0); pf[1][s] = __builtin_bit_cast(bf16x8, w1);
                }
#pragma unroll
                for (int n = 0; n < 2; ++n)
#pragma unroll
                    for (int s = 0; s < 2; ++s) {
                        const int ko = (64 * jt + 32 * n + 16 * s) * 64;
#pragma unroll
                        for (int db = 0; db < 2; ++db) {
                            const s16x4 lo = __builtin_bit_cast(s16x4, __builtin_amdgcn_ds_read_tr16_b64_v4i16((LAS s16x4*)(ldsL + vfo + db * 24576 + ko)));
                            const s16x4 hi = __builtin_bit_cast(s16x4, __builtin_amdgcn_ds_read_tr16_b64_v4i16((LAS s16x4*)(ldsL + vfo + db * 24576 + ko + 512)));
                            const bf16x8 vf = {lo[0], lo[1], lo[2], lo[3], hi[0], hi[1], hi[2], hi[3]};
                            if (db == 0) o0 = __builtin_amdgcn_mfma_f32_32x32x16_bf16(vf, pf[n][s], o0, 0, 0, 0);
                            else o1 = __builtin_amdgcn_mfma_f32_32x32x16_bf16(vf, pf[n][s], o1, 0, 0, 0);
                        }
                    }
            }
            __syncthreads();
            {
                const float lt = sum32(l_run);
                const float inv = 1.0f / lt;
                if (hh == 0) W_lsebuf[((size_t)p * NTOK + tq) * 8 + h] = m_run + __log2f(lt);
                const int sc = wave * 4352;
#pragma unroll
                for (int g = 0; g < 4; ++g) {
                    u32x2 w;
                    w.x = pk2(o0[4 * g] * inv, o0[4 * g + 1] * inv); w.y = pk2(o0[4 * g + 2] * inv, o0[4 * g + 3] * inv);
                    *(LAS u32x2*)(ldsL + sc + r32 * 136 + (8 * g + 4 * hh) * 2) = w;
                    w.x = pk2(o1[4 * g] * inv, o1[4 * g + 1] * inv); w.y = pk2(o1[4 * g + 2] * inv, o1[4 * g + 3] * inv);
                    *(LAS u32x2*)(ldsL + sc + r32 * 136 + (32 + 8 * g + 4 * hh) * 2) = w;
                }
                __syncthreads();
#pragma unroll
                for (int it = 0; it < 8; ++it) {
                    const int row = it * 4 + (lane >> 4), pc = lane & 15;
                    const u32x2 w = *(const LAS u32x2*)(ldsL + sc + row * 136 + pc * 8);
                    const size_t tr = tok0 + (size_t)(m0 + wave * 32 + row) * dil + res;
                    *(u32x2*)(W_aparts + ((size_t)p * NTOK + tr) * 512 + h * 64 + pc * 4) = w;
                }
            }
            if ((vblk % 12) == ui) {
#pragma unroll 1
                for (int q = 2; q < 4; ++q) {
                    const int uu = blk + q * G;
                    const int e = (G == 256) ? ((vblk & ~3) + q) : (uu >> 2), pn = (G == 256) ? (vblk & 3) : (uu & 3);
                    __syncthreads();
                    if (uu < 1024) convert_panel_lds<256, true>(W_scr + (size_t)2 * 256 * 1024 + (size_t)q * 256 * 256, P.in[I_W2] + (size_t)e * 256 * 1024 + pn * 256, 1024, 256, tid, ldsL);
                }
            }
        }
    }
    SEAM(4);

    if (IN(5)) {
        TIDS
        for (int row = blk * 8 + wave; row < NTOK; row += G * 8) {
            const int hd = lane >> 3;
            float ls0 = W_lsebuf[((size_t)0 * NTOK + row) * 8 + hd], ls1 = W_lsebuf[((size_t)1 * NTOK + row) * 8 + hd], ls2 = W_lsebuf[((size_t)2 * NTOK + row) * 8 + hd];
            const float M = fmaxf(ls0, fmaxf(ls1, ls2));
            float w0 = ex2(ls0 - M), w1 = ex2(ls1 - M), w2 = ex2(ls2 - M);
            const float wsn = 1.0f / (w0 + w1 + w2); w0 *= wsn; w1 *= wsn; w2 *= wsn;
            const u32x4 a0 = *(const u32x4*)(W_aparts + ((size_t)0 * NTOK + row) * 512 + lane * 8);
            const u32x4 a1 = *(const u32x4*)(W_aparts + ((size_t)1 * NTOK + row) * 512 + lane * 8);
            const u32x4 a2 = *(const u32x4*)(W_aparts + ((size_t)2 * NTOK + row) * 512 + lane * 8);
            const u32x4 bb = *(const u32x4*)(W_bout + (size_t)row * 512 + lane * 8);
            float av[8], bv[8]; float sa = 0.f, sb = 0.f;
#pragma unroll
            for (int j = 0; j < 4; ++j) {
                av[2 * j] = w0 * __uint_as_float(a0[j] << 16) + w1 * __uint_as_float(a1[j] << 16) + w2 * __uint_as_float(a2[j] << 16);
                av[2 * j + 1] = w0 * __uint_as_float(a0[j] & 0xffff0000u) + w1 * __uint_as_float(a1[j] & 0xffff0000u) + w2 * __uint_as_float(a2[j] & 0xffff0000u);
                bv[2 * j] = __uint_as_float(bb[j] << 16); bv[2 * j + 1] = __uint_as_float(bb[j] & 0xffff0000u);
                sa += av[2 * j] * av[2 * j] + av[2 * j + 1] * av[2 * j + 1];
                sb += bv[2 * j] * bv[2 * j] + bv[2 * j + 1] * bv[2 * j + 1];
            }
            sa = wave_sum(sa); sb = wave_sum(sb);
            const float ra = rsqrtf(sa * (1.0f / 512.0f) + EPS), rb = rsqrtf(sb * (1.0f / 512.0f) + EPS);
            u32x4 wa, wb;
            wa.x = pk2(av[0] * ra, av[1] * ra); wa.y = pk2(av[2] * ra, av[3] * ra); wa.z = pk2(av[4] * ra, av[5] * ra); wa.w = pk2(av[6] * ra, av[7] * ra);
            wb.x = pk2(bv[0] * rb, bv[1] * rb); wb.y = pk2(bv[2] * rb, bv[3] * rb); wb.z = pk2(bv[4] * rb, bv[5] * rb); wb.w = pk2(bv[6] * rb, bv[7] * rb);
            *(u32x4*)(W_mixb + (size_t)row * DM + lane * 8) = wa;
            *(u32x4*)(W_mixb + (size_t)row * DM + 512 + lane * 8) = wb;
        }
    }
    SEAM(5);

    if (IN(6)) {
        TIDS
        unsigned vl_[4]; g8_voff_lin(vl_, DM, tid);
        auto nextf = [&](int i, GDesc& d) {
            const int ul = i * 32 + (vblk & 31); if (ul >= 64 || vblk >= 256) return false;
            const int pm = (vblk >> 5) * 16 + (ul >> 2), pn = ul & 3;
            d.Ab = (const char*)(W_mixb + (size_t)pm * 256 * DM); d.Bb = (const char*)(W_WoT + (size_t)pn * 256 * DM);
            d.va0 = vl_[0]; d.va1 = vl_[1]; d.va2 = vl_[2]; d.va3 = vl_[3]; d.i0 = pm; d.i1 = pn; d.i2 = 0; return true;
        };
        auto epi = [&](const f32x4 (&acc)[2][2][4][2], const GDesc& d, int wr, int wc, int fr, int fq) {
            const int pm = d.i0, pn = d.i1;
            const float* gbase = W_mod + ((pm * 256) >> 12) * 6144 + 2048 + pn * 256 + wc * 32 + fq * 8;
            const f32x4 g00 = *(const f32x4*)gbase, g01 = *(const f32x4*)(gbase + 4), g10 = *(const f32x4*)(gbase + 128), g11 = *(const f32x4*)(gbase + 132);
#pragma unroll
            for (int ai = 0; ai < 2; ++ai)
#pragma unroll
                for (int m = 0; m < 4; ++m) {
                    const int row = pm * 256 + ai * 128 + wr * 64 + m * 16 + fr;
                    bf16_t* op = W_xt + (size_t)row * DM + pn * 256 + wc * 32 + fq * 8;
                    { const f32x4 a = g00 * acc[ai][0][m][0], b = g01 * acc[ai][0][m][1]; u32x4 w; PK8(w, a, b); *(u32x4*)op = w; }
                    { const f32x4 a = g10 * acc[ai][1][m][0], b = g11 * acc[ai][1][m][1]; u32x4 w; PK8(w, a, b); *(u32x4*)(op + 128) = w; }
                }
        };
        gemm_stream(ldsL, tid, DM, nextf, epi);
    }
    SEAM(6);

    if (IN(7)) {
        TIDS
        const float* g = P.in[I_N2G];
        for (int row = blk * 8 + wave; row < NTOK; row += G * 8) {
            const int b = row >> 12;
            bf16_t* xr = W_xt + (size_t)row * DM;
            const float* x0 = W_x + (size_t)row * DM;
            f32x4 v[4]; float ss = 0.f;
#pragma unroll
            for (int i = 0; i < 4; ++i) {
                const u32x2 tw = *(const u32x2*)(xr + i * 256 + lane * 4);
                const f32x4 tv = {__uint_as_float(tw.x << 16), __uint_as_float(tw.x & 0xffff0000u), __uint_as_float(tw.y << 16), __uint_as_float(tw.y & 0xffff0000u)};
                v[i] = tv + *(const f32x4*)(x0 + i * 256 + lane * 4);
                u32x2 xw; xw.x = pk2(v[i][0], v[i][1]); xw.y = pk2(v[i][2], v[i][3]);
                *(u32x2*)(xr + i * 256 + lane * 4) = xw;
                ss += v[i][0] * v[i][0] + v[i][1] * v[i][1] + v[i][2] * v[i][2] + v[i][3] * v[i][3]; }
            ss = wave_sum(ss);
            const float rinv = rsqrtf(ss * (1.0f / 1024.0f) + EPS);
            const float* mb = W_mod + b * 6144 + 3072;
#pragma unroll
            for (int i = 0; i < 4; ++i) {
                const int c = i * 256 + lane * 4;
                const f32x4 gg = *(const f32x4*)(g + c), sh = *(const f32x4*)(mb + c), sc = *(const f32x4*)(mb + 1024 + c);
                float o[4];
#pragma unroll
                for (int j = 0; j < 4; ++j) o[j] = v[i][j] * rinv * gg[j] * (1.0f + sc[j]) + sh[j];
                u32x2 w; w.x = pk2(o[0], o[1]); w.y = pk2(o[2], o[3]);
                *(u32x2*)(W_hbuf + (size_t)row * DM + c) = w;
            }
        }
    }
    SEAM(7);

    if (IN(8)) {
        {
            TIDS
            unsigned vl_[4]; g8_voff_lin(vl_, DM, tid);
            auto nextf = [&](int i, GDesc& d) {
                const int ul = vblk & 31; if (i > 0 || vblk >= 256) return false;
                const int pm = (vblk >> 5) * 16 + (ul >> 1), pn = ul & 1;
                d.Ab = (const char*)(W_hbuf + (size_t)pm * 256 * DM); d.Bb = (const char*)(W_Ws13T + (size_t)pn * 256 * DM);
                d.va0 = vl_[0]; d.va1 = vl_[1]; d.va2 = vl_[2]; d.va3 = vl_[3]; d.i0 = pm; d.i1 = pn; d.i2 = 0; return true;
            };
            auto epi = [&](const f32x4 (&acc)[2][2][4][2], const GDesc& d, int wr, int wc, int fr, int fq) {
                const int pm = d.i0, pn = d.i1;
#pragma unroll
                for (int ai = 0; ai < 2; ++ai)
#pragma unroll
                    for (int m = 0; m < 4; ++m) {
                        const int r = ai * 128 + wr * 64 + m * 16 + fr;
                        const f32x4 a0 = acc[ai][0][m][0], a1 = acc[ai][0][m][1], b0 = acc[ai][1][m][0], b1 = acc[ai][1][m][1];
                        f32x4 h0, h1;
#pragma unroll
                        for (int j = 0; j < 4; ++j) { h0[j] = siluf(a0[j]) * b0[j]; h1[j] = siluf(a1[j]) * b1[j]; }
                        u32x4 w; PK8(w, h0, h1);
                        *(u32x4*)(W_hdn + (size_t)(NASG + pm * 256 + r) * EFF + pn * 128 + wc * 32 + fq * 8) = w;
                    }
            };
            gemm_stream(ldsL, tid, DM, nextf, epi);
        }
        {
            TIDS
            unsigned vl_[4]; g8_voff_lin(vl_, DM, tid);
            auto nextf = [&](int i, GDesc& d) {
                const int ul = vblk & 31; if (i > 0 || ul < 16 || vblk >= 256) return false;
                const int pm = (vblk >> 5) * 16 + (ul - 16);
                d.Ab = (const char*)(W_hbuf + (size_t)pm * 256 * DM); d.Bb = (const char*)(W_WrT);
                d.va0 = vl_[0]; d.va1 = vl_[1]; d.va2 = vl_[2]; d.va3 = vl_[3]; d.i0 = pm; d.i1 = 0; d.i2 = 0; return true;
            };
            auto epi = [&](const f32x4 (&acc)[2][2][4][2], const GDesc& d, int wr, int wc, int fr, int fq) {
                const int pm = d.i0;
                EPI_FOREACH8(acc, wr, wc, fr, fq, r, c8, v0, v1, {
                    *(f32x4*)(W_logits + (size_t)(pm * 256 + r) * 256 + c8) = v0;
                    *(f32x4*)(W_logits + (size_t)(pm * 256 + r) * 256 + c8 + 4) = v1;
                })
            };
            gemm_stream(ldsL, tid, DM, nextf, epi);
        }
        if ((vblk & 31) < 16) {
            TIDS
#pragma unroll 1
            for (int q = 0; q < 2; ++q) {
                const int uu = blk + q * G;
                const int e = (G == 256) ? ((vblk & ~3) + q) : (uu >> 2), pn = (G == 256) ? (vblk & 3) : (uu & 3);
                __syncthreads();
                if (uu < 1024) convert_panel_lds<256, true>(W_scr + (size_t)2 * 256 * 1024 + (size_t)q * 256 * 256, P.in[I_W2] + (size_t)e * 256 * 1024 + pn * 256, 1024, 256, tid, ldsL);
            }
        }
    }
    SEAM(8);

    if (IN(9)) {
        TIDS
        const float* ebias = P.in[I_EB];
        const f32x4 eb = *(const f32x4*)(ebias + lane * 4);
        for (int t = blk * 8 + wave; t < NTOK; t += G * 8) {
            const f32x4 lg = *(const f32x4*)(W_logits + (size_t)t * 256 + lane * 4);
            float sc[4], sel[4];
#pragma unroll
            for (int i = 0; i < 4; ++i) { sc[i] = 1.0f / (1.0f + expf(-lg[i])); sel[i] = sc[i] + eb[i]; }
            float a1 = fmaxf(sel[0], sel[1]), a2 = fminf(sel[0], sel[1]);
#pragma unroll
            for (int i = 2; i < 4; ++i) { const float v = sel[i]; a2 = fmaxf(a2, fminf(a1, v)); a1 = fmaxf(a1, v); }
            {
                float b1, b2, n1, n2;
                b1 = dppf(a1, DPP_X1); b2 = dppf(a2, DPP_X1); n1 = fmaxf(a1, b1); n2 = fmaxf(fminf(a1, b1), fmaxf(a2, b2)); a1 = n1; a2 = n2;
                b1 = dppf(a1, DPP_X2); b2 = dppf(a2, DPP_X2); n1 = fmaxf(a1, b1); n2 = fmaxf(fminf(a1, b1), fmaxf(a2, b2)); a1 = n1; a2 = n2;
                b1 = dppf(a1, DPP_HM); b2 = dppf(a2, DPP_HM); n1 = fmaxf(a1, b1); n2 = fmaxf(fminf(a1, b1), fmaxf(a2, b2)); a1 = n1; a2 = n2;
            }
            const float gs = a1 + a2; const int myg = lane >> 3;
            int rank = 0;
#pragma unroll
            for (int g = 0; g < 8; ++g) { const float v = __int_as_float(__builtin_amdgcn_readlane(__float_as_int(gs), g * 8)); rank += (v > gs || (v == gs && g < myg)) ? 1 : 0; }
            const bool gsel = rank < 4;
            unsigned key[4];
#pragma unroll
            for (int i = 0; i < 4; ++i) { const unsigned u = __float_as_uint(sel[i]); const unsigned mono = u ^ ((u >> 31) ? 0xFFFFFFFFu : 0x80000000u);
                key[i] = gsel ? ((mono & 0xFFFFFF00u) | (unsigned)(255 - (lane * 4 + i))) : 0u; }
            int my_e = 0; float my_g = 0.f; float gsum = 0.f;
#pragma unroll
            for (int k = 0; k < 8; ++k) {
                unsigned v = key[0] > key[1] ? key[0] : key[1]; { const unsigned w = key[2] > key[3] ? key[2] : key[3]; v = v > w ? v : w; }
#define UMX(o) do { const unsigned o_ = (unsigned)(o); v = v > o_ ? v : o_; } while (0)
                UMX(dppi((int)v, DPP_X1)); UMX(dppi((int)v, DPP_X2)); UMX(dppi((int)v, DPP_HM)); UMX(dppi((int)v, DPP_RM));
                { auto rv = __builtin_amdgcn_permlane16_swap(v, v, false, false); v = rv[0]; UMX(rv[1]); }
                { auto rv = __builtin_amdgcn_permlane32_swap(v, v, false, false); v = rv[0]; UMX(rv[1]); }
#undef UMX
                v = (unsigned)__builtin_amdgcn_readfirstlane((int)v);
                const int ix = 255 - (int)(v & 255u);
                float myscore = 0.f;
#pragma unroll
                for (int i = 0; i < 4; ++i) if (key[i] == v) { key[i] = 0u; myscore = sc[i]; }
                const float gw = __int_as_float(__builtin_amdgcn_readlane(__float_as_int(myscore), ix >> 2));
                gsum += gw;
                if (lane == k) { my_e = ix; my_g = gw; }
            }
            if (lane < 8) {
                const unsigned rk = atomicAdd(&cntg[my_e * CNT_STRIDE], 1u);
                W_eidx[t * 8 + lane] = my_e; W_gate[t * 8 + lane] = my_g / gsum * 2.5f; W_rnk[t * 8 + lane] = (int)rk;
            }
        }
    }
    SEAM(9);

    if (IN(10)) {
        TIDS
        if (tid < 256) cntL[tid] = (int)__hip_atomic_load(&cntg[tid * CNT_STRIDE], __ATOMIC_RELAXED, __HIP_MEMORY_SCOPE_AGENT);
        __syncthreads();
        if (tid < 256) { int s = 0; for (int j = 0; j < tid; ++j) s += cntL[j]; startL[tid] = s; }
        __syncthreads();
        for (int t = blk * 8 + wave; t < NTOK; t += G * 8) {
            if (lane < 8) {
                const int e = W_eidx[t * 8 + lane];
                const int d = startL[e] + W_rnk[t * 8 + lane];
                W_toks[d] = t; W_wts[d] = W_gate[t * 8 + lane]; W_pos[t * 8 + lane] = d;
            }
        }
    }
    SEAM(10);

    if (IN(11)) {
        TIDS
        __syncthreads();
        if (tid < 256) cntL[tid] = (int)__hip_atomic_load(&cntg[tid * CNT_STRIDE], __ATOMIC_RELAXED, __HIP_MEMORY_SCOPE_AGENT);
        __syncthreads();
        if (tid <= 256) { int sa = 0, tb = 0; for (int j = 0; j < tid; ++j) { sa += cntL[j]; tb += (cntL[j] + 255) >> 8; } startL[tid] = sa; tbL[tid] = tb; }
        __syncthreads();
        const int T1 = 2 * tbL[256];
        const int g0 = (int)(((long)vblk * T1) / G), g1 = (int)(((long)(vblk + 1) * T1) / G);
        for (int c0 = g0; c0 < g1; c0 += 8) {
            TIDS
            const int nch = (g1 - c0) < 8 ? (g1 - c0) : 8;
            __syncthreads();
            if (tid < nch) {
                const int g = c0 + tid; int e = 0;
                for (int j = 1; j < 256; ++j) if (2 * tbL[j] <= g) e = j;
                const int r = g - 2 * tbL[e], nt = tbL[e + 1] - tbL[e];
                itemD[tid * 4 + 0] = e; itemD[tid * 4 + 1] = r / nt; itemD[tid * 4 + 2] = r % nt;
            }
            __syncthreads();
            for (int idx = tid; idx < nch * 256; idx += 512) {
                const int it = idx >> 8, e = itemD[it * 4], ti = itemD[it * 4 + 2];
                const int rr = ti * 256 + (idx & 255); const int sr = startL[e] + (rr < cntL[e] ? rr : 0);
                rowoff[idx] = (unsigned)W_toks[sr] * DM;
            }
            __syncthreads();
            int R0, C0; g8_rc(tid, R0, C0);
            auto nextf = [&](int i, GDesc& d) {
                if (i >= nch) return false;
                const int e = itemD[i * 4], pn = itemD[i * 4 + 1], ti = itemD[i * 4 + 2];
                const int vo = (e & ~1) | pn; const int bo = (G == 256) ? ((vo & 31) * 8 + (vo >> 5)) : vo;
                d.Ab = (const char*)W_hbuf; d.Bb = (const char*)(ws + OFF_SCR + (size_t)bo * SCR_PER_BLK) + (size_t)(e & 1) * 512 * 1024;
                d.va0 = (rowoff[i * 256 + R0] + C0) * 2u; d.va1 = (rowoff[i * 256 + R0 + 64] + C0) * 2u; d.va2 = (rowoff[i * 256 + R0 + 128] + C0) * 2u; d.va3 = (rowoff[i * 256 + R0 + 192] + C0) * 2u;
                const int left = cntL[e] - ti * 256;
                d.i0 = startL[e] + ti * 256; d.i1 = left < 256 ? left : 256; d.i2 = pn; return true;
            };
            auto epi = [&](const f32x4 (&acc)[2][2][4][2], const GDesc& d, int wr, int wc, int fr, int fq) {
                const int rowbase = d.i0, nvalid = d.i1, pn = d.i2;
#pragma unroll
                for (int ai = 0; ai < 2; ++ai)
#pragma unroll
                    for (int m = 0; m < 4; ++m) {
                        const int r = ai * 128 + wr * 64 + m * 16 + fr;
                        if (r < nvalid) {
                            const f32x4 a0 = acc[ai][0][m][0], a1 = acc[ai][0][m][1], b0 = acc[ai][1][m][0], b1 = acc[ai][1][m][1];
                            f32x4 h0, h1;
#pragma unroll
                            for (int j = 0; j < 4; ++j) { h0[j] = siluf(a0[j]) * b0[j]; h1[j] = siluf(a1[j]) * b1[j]; }
                            u32x4 w; PK8(w, h0, h1);
                            *(u32x4*)(W_hdn + (size_t)(rowbase + r) * EFF + pn * 128 + wc * 32 + fq * 8) = w;
                        }
                    }
            };
            gemm_stream(ldsL, tid, DM, nextf, epi);
        }
    }
    SEAM(11);

    if (IN(12)) {
        TIDS
        __syncthreads();
        if (tid < 256) cntL[tid] = (int)__hip_atomic_load(&cntg[tid * CNT_STRIDE], __ATOMIC_RELAXED, __HIP_MEMORY_SCOPE_AGENT);
        if (tid == 256) cntL[256] = NTOK;
        __syncthreads();
        if (tid <= 257) { int sa = 0, tb = 0; for (int j = 0; j < tid; ++j) { sa += cntL[j]; tb += (cntL[j] + 255) >> 8; } if (tid <= 256) startL[tid] = sa; tbL[tid] = tb; }
        __syncthreads();
        const int T2 = 4 * tbL[257];
        const int g0 = (int)(((long)vblk * T2) / G), g1 = (int)(((long)(vblk + 1) * T2) / G);
#define Y_STORE(ROWG, COL0, G_) do { _Pragma("unroll") for (int bj = 0; bj < 2; ++bj) { const f32x4 a_ = acc[ai][bj][m][0], b_ = acc[ai][bj][m][1]; int w0_ = 0, w1_ = 0; \
            w0_ = __builtin_amdgcn_cvt_pk_fp8_f32(a_[0] * (G_), a_[1] * (G_), w0_, false); w0_ = __builtin_amdgcn_cvt_pk_fp8_f32(a_[2] * (G_), a_[3] * (G_), w0_, true); \
            w1_ = __builtin_amdgcn_cvt_pk_fp8_f32(b_[0] * (G_), b_[1] * (G_), w1_, false); w1_ = __builtin_amdgcn_cvt_pk_fp8_f32(b_[2] * (G_), b_[3] * (G_), w1_, true); \
            u32x2 w_; w_.x = (unsigned)w0_; w_.y = (unsigned)w1_; *(u32x2*)(W_y8 + (size_t)(ROWG) * DM + (COL0) + bj * 128 + wc * 32 + fq * 8) = w_; } } while (0)
        for (int c0 = g0; c0 < g1; c0 += 8) {
            TIDS
            const int nch = (g1 - c0) < 8 ? (g1 - c0) : 8;
            __syncthreads();
            if (tid < nch) {
                const int g = c0 + tid; int e = 0;
                for (int j = 1; j < 257; ++j) if (4 * tbL[j] <= g) e = j;
                const int r = g - 4 * tbL[e], nt = tbL[e + 1] - tbL[e];
                itemD[tid * 4 + 0] = e; itemD[tid * 4 + 1] = r / nt; itemD[tid * 4 + 2] = r % nt;
            }
            __syncthreads();
            for (int idx = tid; idx < nch * 256; idx += 512) {
                const int it = idx >> 8, e = itemD[it * 4], ti = itemD[it * 4 + 2];
                const int rr = ti * 256 + (idx & 255); const int sr = startL[e] + (rr < cntL[e] ? rr : 0);
                rowoff[idx] = (unsigned)sr * EFF; rowsc[idx] = (e < 256) ? W_wts[sr] : 1.0f;
            }
            __syncthreads();
            int R0, C0; g8_rc(tid, R0, C0);
            auto nextf = [&](int i, GDesc& d) {
                if (i >= nch) return false;
                const int e = itemD[i * 4], pn = itemD[i * 4 + 1], ti = itemD[i * 4 + 2];
                const int vo = (e & ~3) | pn; const int bo = (G == 256) ? ((vo & 31) * 8 + (vo >> 5)) : vo;
                d.Ab = (const char*)W_hdn;
                d.Bb = (e < 256) ? (const char*)(ws + OFF_SCR + (size_t)bo * SCR_PER_BLK) + (size_t)2 * 512 * 1024 + (size_t)(e & 3) * 128 * 1024 : (const char*)(W_Ws2T + (size_t)pn * 256 * EFF);
                d.va0 = (rowoff[i * 256 + R0] + C0) * 2u; d.va1 = (rowoff[i * 256 + R0 + 64] + C0) * 2u; d.va2 = (rowoff[i * 256 + R0 + 128] + C0) * 2u; d.va3 = (rowoff[i * 256 + R0 + 192] + C0) * 2u;
                const int left = cntL[e] - ti * 256;
                d.i0 = startL[e] + ti * 256; d.i1 = (left < 256 ? left : 256) | (i << 16); d.i2 = pn; return true;
            };
            auto epi = [&](const f32x4 (&acc)[2][2][4][2], const GDesc& d, int wr, int wc, int fr, int fq) {
                const int rowbase = d.i0, nvalid = d.i1 & 0xffff, tl = d.i1 >> 16, pn = d.i2;
#pragma unroll
                for (int ai = 0; ai < 2; ++ai)
#pragma unroll
                    for (int m = 0; m < 4; ++m) {
                        const int r = ai * 128 + wr * 64 + m * 16 + fr;
                        if (r < nvalid) { const float g = rowsc[tl * 256 + r]; Y_STORE(rowbase + r, pn * 256, g); }
                    }
            };
            gemm_stream(ldsL, tid, EFF, nextf, epi);
        }
#undef Y_STORE
    }
    SEAM(12);

    if (IN(13)) {
        TIDS
        const float* fg = P.in[I_FG];
        for (int row = blk * 8 + wave; row < NTOK; row += G * 8) {
            const int b = row >> 12;
            float a[16];
#pragma unroll
            for (int j = 0; j < 16; ++j) a[j] = 0.f;
#pragma unroll
            for (int k = 0; k < 9; ++k) {
                const int pr = (k < 8) ? W_pos[row * 8 + k] : (NASG + row);
                const u32x4 w = *(const u32x4*)(W_y8 + (size_t)pr * DM + lane * 16);
#pragma unroll
                for (int q = 0; q < 4; ++q) {
                    a[4 * q + 0] += __builtin_amdgcn_cvt_f32_fp8((int)w[q], 0); a[4 * q + 1] += __builtin_amdgcn_cvt_f32_fp8((int)w[q], 1);
                    a[4 * q + 2] += __builtin_amdgcn_cvt_f32_fp8((int)w[q], 2); a[4 * q + 3] += __builtin_amdgcn_cvt_f32_fp8((int)w[q], 3);
                }
            }
            float* xr = P.out + (size_t)row * DM + lane * 16;
            const bf16_t* x1r = W_xt + (size_t)row * DM + lane * 16;
            const u32x4 xw0 = *(const u32x4*)x1r, xw1 = *(const u32x4*)(x1r + 8);
            const float* g2 = W_mod + b * 6144 + 5120 + lane * 16;
            float v[16]; float ss = 0.f;
#pragma unroll
            for (int q = 0; q < 4; ++q) {
                const unsigned wa = (q < 2) ? xw0[2 * q] : xw1[2 * (q - 2)], wb = (q < 2) ? xw0[2 * q + 1] : xw1[2 * (q - 2) + 1];
                const f32x4 xa = {__uint_as_float(wa << 16), __uint_as_float(wa & 0xffff0000u), __uint_as_float(wb << 16), __uint_as_float(wb & 0xffff0000u)};
                const f32x4 ga = *(const f32x4*)(g2 + q * 4);
#pragma unroll
                for (int j = 0; j < 4; ++j) { v[q * 4 + j] = xa[j] + ga[j] * a[q * 4 + j]; ss += v[q * 4 + j] * v[q * 4 + j]; }
            }
            ss = wave_sum(ss);
            const float rinv = rsqrtf(ss * (1.0f / 1024.0f) + EPS);
#pragma unroll
            for (int q = 0; q < 4; ++q) {
                const f32x4 fa = *(const f32x4*)(fg + lane * 16 + q * 4);
                f32x4 oa;
#pragma unroll
                for (int j = 0; j < 4; ++j) oa[j] = v[q * 4 + j] * rinv * fa[j];
                *(f32x4*)(xr + q * 4) = oa;
            }
        }
    }
#ifdef DBG_STOP
    if (IN(14)) {
        TIDS
        const size_t NO = (size_t)NTOK * DM;
        for (size_t i = (size_t)blk * 512 + tid; i < NO; i += (size_t)G * 512) {
            unsigned hsh = 0u;
            const size_t row = i >> 10, c = i & 1023;
#define RB(p, idx) ((unsigned)(p)[(idx)])
#define RF(p, idx) (__float_as_uint((p)[(idx)]))
#if DBG_STOP == 0
            hsh = RB(W_WinT, i % (2304 * 1024)) ^ RB(W_WoT, i % (1024 * 1024)) ^ RB(W_WuqT, i % (768 * 384)) ^ RB(W_WukvT, i % (1024 * 256)) ^ RB(W_Ws13T, i % (512 * 1024)) ^ RB(W_Ws2T, i % (1024 * 256)) ^ RB(W_WrT, i % (256 * 1024))
                ^ RF(W_mod, i % (8 * 6144)) ^ RF(W_ropecs, i % (4096 * 32)) ^ RF(W_biasT, i % (3 * 8 * 129));
#elif DBG_STOP == 1 || DBG_STOP == 7
            hsh = RB(W_hbuf, i);
#elif DBG_STOP == 2
            hsh = RB(W_proj, row * INCP + c) ^ (RB(W_proj, row * INCP + 1024 + c) << 1) ^ (c < 160 ? (RB(W_proj, row * INCP + 2048 + c) << 2) : 0u);
#elif DBG_STOP == 3
            hsh = RB(W_kvb, i) ^ (c < 768 ? (RB(W_qb, row * 768 + c) << 1) : 0u);
#elif DBG_STOP == 4
            if (c < 512) hsh = RB(W_bout, row * 512 + c); else if (DBG_SUB) { const size_t cc = c - 512; hsh = RB(W_aparts, row * 512 + cc) ^ (RB(W_aparts, ((size_t)NTOK + row) * 512 + cc) << 1) ^ (RB(W_aparts, ((size_t)2 * NTOK + row) * 512 + cc) << 2) ^ RF(W_lsebuf, row * 8 + (cc >> 6)) ^ (RF(W_lsebuf, ((size_t)NTOK + row) * 8 + (cc >> 6)) << 1) ^ (RF(W_lsebuf, ((size_t)2 * NTOK + row) * 8 + (cc >> 6)) << 2); }
#elif DBG_STOP == 5
            hsh = RB(W_mixb, i);
#elif DBG_STOP == 6
            hsh = RF(P.out, i);
#elif DBG_STOP == 8
            if (c < 256) hsh = RF(W_logits, row * 256 + c); else if (c < 512) hsh = RB(W_hdn, ((size_t)NASG + row) * EFF + (c - 256));
#elif DBG_STOP == 9
            if (c < 8) hsh = (unsigned)W_eidx[row * 8 + c]; else if (c < 16) hsh = RF(W_gate, row * 8 + (c - 8));
#elif DBG_STOP == 11
            { const int k = (int)(c >> 8); hsh = RB(W_hdn, (size_t)W_pos[row * 8 + k] * EFF + (c & 255)) ^ (RB(W_hdn, (size_t)W_pos[row * 8 + 4 + k] * EFF + (c & 255)) << 1); }
#elif DBG_STOP == 12
            { for (int k = 0; k < 8; ++k) hsh ^= RB(W_ybuf, (size_t)W_pos[row * 8 + k] * DM + c) << (k & 3); hsh ^= RB(W_ybuf, ((size_t)NASG + row) * DM + c); }
#endif
            P.out[i] = (float)(hsh & 0xFu);
        }
    }
#endif
#undef IN
#undef SEAM
}

extern "C" void kernel_launch(void* const* d_in, const int* in_sizes, int n_in, void* d_out, int out_size, void* d_ws, size_t ws_size, hipStream_t stream) {
    static int grid = 0;
    if (grid == 0) {
        if (n_in != 24 || ws_size < WS_END) { fprintf(stderr, "kernel_launch: need 24 inputs and %zu bytes of workspace (got %d, %zu)\n", (size_t)WS_END, n_in, ws_size); grid = -1; return; }
        int dev = 0, cus = 0, per_cu = 0;
        if (hipGetDevice(&dev) != hipSuccess || hipDeviceGetAttribute(&cus, hipDeviceAttributeMultiprocessorCount, dev) != hipSuccess) { grid = -1; return; }
        if (hipFuncSetAttribute((const void*)fwd_kernel, hipFuncAttributeMaxDynamicSharedMemorySize, LDS_BYTES) != hipSuccess) { fprintf(stderr, "kernel_launch: hipFuncSetAttribute failed\n"); grid = -1; return; }
        if (hipOccupancyMaxActiveBlocksPerMultiprocessor(&per_cu, (const void*)fwd_kernel, 512, LDS_BYTES) != hipSuccess || per_cu < 1) { fprintf(stderr, "kernel_launch: occupancy query says %d\n", per_cu); }
        (void)hipGetLastError();
        if (cus < 256) { fprintf(stderr, "kernel_launch: this kernel needs 256 CUs (device reports %d)\n", cus); grid = -1; return; }
        grid = 256;
    }
    if (grid < 0) return;
    (void)hipMemsetAsync((char*)d_ws + OFF_CTL, 0, CTL_BYTES, stream);
    Params p{};
    for (int i = 0; i < 24; ++i) p.in[i] = (const float*)d_in[i];
    p.out = (float*)d_out; p.ws = (unsigned char*)d_ws;
#if MK_N_LAUNCHES == 1
    p.ph_lo = 0; p.ph_hi = NPHASE;
    hipLaunchKernelGGL(fwd_kernel, dim3(grid), dim3(512), LDS_BYTES, stream, p);
#else
#ifdef DBG_STOP
    for (int k = 0; k <= DBG_STOP; ++k) { p.ph_lo = k; p.ph_hi = k + 1; hipLaunchKernelGGL(fwd_kernel, dim3(grid), dim3(512), LDS_BYTES, stream, p); }
    p.ph_lo = 14; p.ph_hi = 15; hipLaunchKernelGGL(fwd_kernel, dim3(grid), dim3(512), LDS_BYTES, stream, p);
#else
#ifndef DBL_MASK
#define DBL_MASK 0u
#endif
#ifndef DBL_FLAGS
#define DBL_FLAGS 0
#endif
    for (int k = 0; k < 14; ++k) { p.ph_lo = k; p.ph_hi = k + 1; hipLaunchKernelGGL(fwd_kernel, dim3(grid), dim3(512), LDS_BYTES, stream, p);
        if ((DBL_MASK >> k) & 1u) { p.flags = DBL_FLAGS; hipLaunchKernelGGL(fwd_kernel, dim3(grid), dim3(512), LDS_BYTES, stream, p); p.flags = 0; } }
#endif
#endif
}
```

```cpp
#include <hip/hip_runtime.h>
#include <stdint.h>
#include <stdio.h>

#ifndef MK_N_LAUNCHES
#define MK_N_LAUNCHES 1
#endif

#define DEVI __device__ __forceinline__
typedef unsigned short bf16_t;
typedef short bf16x8 __attribute__((ext_vector_type(8)));
typedef short s16x4 __attribute__((ext_vector_type(4)));
typedef float f32x4 __attribute__((ext_vector_type(4)));
typedef float f32x16 __attribute__((ext_vector_type(16)));
typedef unsigned u32x4 __attribute__((ext_vector_type(4)));
typedef unsigned u32x2 __attribute__((ext_vector_type(2)));

constexpr int NTOK = 32768, SEQ = 4096, DM = 1024;
constexpr int INC = 2208, INCP = 2304;
constexpr int QLORA = 384, KVLORA = 256;
constexpr int NEXP = 256, EFF = 256;
constexpr int NASG = NTOK * 8;
constexpr int NROWS = NASG + NTOK;
constexpr float EPS = 1e-6f;
constexpr float LOG2E = 1.4426950408889634f;

constexpr size_t MiB = 1u << 20;
constexpr size_t OFF_CTL = 0, CTL_BYTES = 1 * MiB;
constexpr size_t OFF_MOD = 1 * MiB;
constexpr size_t OFF_ROPE = OFF_MOD + 256 * 1024;
constexpr size_t OFF_BIAS = OFF_ROPE + 512 * 1024;
constexpr size_t OFF_WIN = 2 * MiB;
constexpr size_t OFF_WUQ = OFF_WIN + 4608 * 1024;
constexpr size_t OFF_WUKV = OFF_WUQ + 1 * MiB;
constexpr size_t OFF_WO = OFF_WUKV + 512 * 1024;
constexpr size_t OFF_WR = OFF_WO + 2 * MiB;
constexpr size_t OFF_WS13 = OFF_WR + 512 * 1024;
constexpr size_t OFF_WS2 = OFF_WS13 + 1 * MiB;
constexpr size_t OFF_H = 12 * MiB;
constexpr size_t OFF_LOGITS = OFF_H + 64 * MiB;
constexpr size_t OFF_EIDX = OFF_LOGITS + 32 * MiB;
constexpr size_t OFF_GATE = OFF_EIDX + 1 * MiB;
constexpr size_t OFF_RNK = OFF_GATE + 1 * MiB;
constexpr size_t OFF_POS = OFF_RNK + 1 * MiB;
constexpr size_t OFF_TOKS = OFF_POS + 1 * MiB;
constexpr size_t OFF_WTS = OFF_TOKS + 1 * MiB;
constexpr size_t OFF_SSQ = OFF_WTS + 1 * MiB;
constexpr size_t OFF_SCR = OFF_SSQ + 4 * MiB;
constexpr size_t SCR_PER_BLK = 1536 * 1024;
constexpr size_t OFF_R = OFF_SCR + 384 * MiB;
constexpr size_t OFF_XT = OFF_R + 452 * MiB;
constexpr size_t WS_END = OFF_XT + 64 * MiB;
constexpr size_t OFF_PROJ = OFF_R;
constexpr size_t OFF_QB = OFF_PROJ + 144 * MiB;
constexpr size_t OFF_KVB = OFF_QB + 48 * MiB;
constexpr size_t OFF_BOUT = OFF_KVB + 64 * MiB;
constexpr size_t OFF_APARTS = OFF_BOUT + 32 * MiB;
constexpr size_t OFF_LSE = OFF_APARTS + 96 * MiB;
constexpr size_t OFF_MIX = OFF_LSE + 4 * MiB;
constexpr size_t OFF_Y = OFF_R;
constexpr size_t OFF_HDN = OFF_R + 288 * MiB;
static_assert(OFF_MIX + 64 * MiB <= WS_END, "alias map");
constexpr int CNT_WORD0 = 8192, CNT_STRIDE = 16;

constexpr int LDS_STAGE = 0;
constexpr int LDS_ROWOFF = 131072;
constexpr int LDS_ROWSC = LDS_ROWOFF + 8192;
constexpr int LDS_MISC = LDS_ROWSC + 8192;
constexpr int LDS_START = LDS_MISC + 256;
constexpr int LDS_CNT = LDS_START + 1280;
constexpr int LDS_TB = LDS_CNT + 1280;
constexpr int LDS_BYTES = 155648;
static_assert(LDS_TB + 1280 <= LDS_BYTES, "lds map");

#define XB_TMO      128
#define XB_XCNT(j)  (256  + 64 * (j))
#define XB_XSUB(j)  (1280 + 64 * (j))
#define XB_XGEN(j)  (2304 + 64 * (j))
#define XB_TOP      3328
#define XB_TOPGEN   3392
#define XCD_BAR_WORDS 3456
#define XB_SPIN_CAP (1u << 22)
#define LAS __attribute__((address_space(3)))

__device__ __forceinline__ unsigned xb_ld(unsigned* p)              { return __hip_atomic_load(p, __ATOMIC_RELAXED, __HIP_MEMORY_SCOPE_AGENT); }
__device__ __forceinline__ unsigned xb_add(unsigned* p, unsigned v) { return __hip_atomic_fetch_add(p, v, __ATOMIC_RELAXED, __HIP_MEMORY_SCOPE_AGENT); }
__device__ __forceinline__ unsigned xb_xcc_id() { return (unsigned)__builtin_amdgcn_s_getreg((3 << 11) | 20) & 0xFu; }
#define XB_SPIN(cond, bar) do { unsigned _sp = 0; while (cond) { __builtin_amdgcn_s_sleep(1); \
    if ((++_sp & 255u) == 0u) { if (xb_ld(&(bar)[XB_TMO])) break; if (_sp > XB_SPIN_CAP) { atomicAdd(&(bar)[XB_TMO], 1u); break; } } } } while (0)

struct XcdBarrier { unsigned* bar; unsigned x; volatile LAS unsigned* st; };

__device__ __forceinline__ XcdBarrier xcd_barrier_post(unsigned* bar, volatile LAS unsigned* st, const bool leader) {
    XcdBarrier b; b.bar = bar; b.x = xb_xcc_id(); b.st = st;
    if (leader) (void)xb_add(&bar[XB_XCNT(b.x)], 1u);
    return b;
}
__device__ __forceinline__ void xcd_barrier_complete(unsigned* bar, unsigned x, unsigned& nloc, unsigned& nx) {
    const unsigned G = gridDim.x * gridDim.y * gridDim.z;
    unsigned sum, cnt, mine, sp = 0u;
    for (;;) {
        sum = 0u; cnt = 0u; mine = 0u;
#pragma unroll
        for (unsigned j = 0; j < 16; ++j) { const unsigned c = xb_ld(&bar[XB_XCNT(j)]); sum += c; cnt += (c > 0u) ? 1u : 0u; mine = (j == x) ? c : mine; }
        if (sum == G) break;
        __builtin_amdgcn_s_sleep(1);
        if ((++sp & 255u) == 0u) { if (xb_ld(&bar[XB_TMO])) break; if (sp > XB_SPIN_CAP) { atomicAdd(&bar[XB_TMO], 1u); break; } }
    }
    nloc = mine > 0u ? mine : 1u; nx = cnt > 0u ? cnt : 1u;
}
__device__ __forceinline__ void xcd_barrier(const XcdBarrier& b, const bool leader) {
    asm volatile("s_waitcnt vmcnt(0)" ::: "memory");
    __syncthreads();
    if (leader) {
        unsigned* bar = b.bar;
        __builtin_amdgcn_s_waitcnt(0);
        unsigned nloc = b.st[0], nx = b.st[1];
        if (nloc == 0u) { xcd_barrier_complete(bar, b.x, nloc, nx); b.st[0] = nloc; b.st[1] = nx; }
        const unsigned old = xb_add(&bar[XB_XSUB(b.x)], 1u);
        const unsigned gen = old / nloc;
        if (old + 1u == (gen + 1u) * nloc) {
            __builtin_amdgcn_fence(__ATOMIC_RELEASE, "agent");
            asm volatile("s_waitcnt vmcnt(0)" ::: "memory");
            const unsigned og = xb_add(&bar[XB_TOP], 1u);
            const unsigned tg = og / nx;
            if (og + 1u == (tg + 1u) * nx) xb_add(&bar[XB_TOPGEN], 1u);
            else XB_SPIN(xb_ld(&bar[XB_TOPGEN]) == tg, bar);
            __builtin_amdgcn_fence(__ATOMIC_ACQUIRE, "agent");
            xb_add(&bar[XB_XGEN(b.x)], 1u);
            asm volatile("s_waitcnt vmcnt(0)" ::: "memory");
        } else {
            XB_SPIN(xb_ld(&bar[XB_XGEN(b.x)]) == gen, bar);
            __builtin_amdgcn_fence(__ATOMIC_ACQUIRE, "agent");
            asm volatile("s_waitcnt vmcnt(0)" ::: "memory");
        }
    }
    __syncthreads();
}

DEVI float bf2f(bf16_t v) { return __uint_as_float(((unsigned)v) << 16); }
typedef float f32x2_t __attribute__((ext_vector_type(2)));
typedef __bf16 bf16x2_t __attribute__((ext_vector_type(2)));
DEVI unsigned pk2(float lo, float hi) { f32x2_t v = {lo, hi}; bf16x2_t b = __builtin_convertvector(v, bf16x2_t); return __builtin_bit_cast(unsigned, b); }
#define dppf(v, ctrl) __int_as_float(__builtin_amdgcn_update_dpp(0, __float_as_int(v), (ctrl), 0xf, 0xf, false))
#define dppi(v, ctrl) __builtin_amdgcn_update_dpp(0, (v), (ctrl), 0xf, 0xf, false)
#define DPP_X1 0xB1
#define DPP_X2 0x4E
#define DPP_HM 0x141
#define DPP_RM 0x140
DEVI float x16f(float v, float& o) { auto r = __builtin_amdgcn_permlane16_swap(__float_as_uint(v), __float_as_uint(v), false, false); o = __uint_as_float(r[1]); return __uint_as_float(r[0]); }
DEVI float x32f(float v, float& o) { auto r = __builtin_amdgcn_permlane32_swap(__float_as_uint(v), __float_as_uint(v), false, false); o = __uint_as_float(r[1]); return __uint_as_float(r[0]); }
DEVI float sum32(float v) { float o; const float a = x32f(v, o); return a + o; }
DEVI float max32(float v) { float o; const float a = x32f(v, o); return fmaxf(a, o); }
DEVI float wave_sum(float v) {
    v += dppf(v, DPP_X1); v += dppf(v, DPP_X2); v += dppf(v, DPP_HM); v += dppf(v, DPP_RM);
    { float o; const float a = x16f(v, o); v = a + o; }
    { float o; const float a = x32f(v, o); v = a + o; }
    return v;
}
DEVI int perm_slot(int cl) { return 16 * ((cl >> 2) & 1) + 4 * (cl >> 3) + (cl & 3); }
DEVI int perm_row(int n) { return (n & ~31) + perm_slot(n & 31); }
DEVI float ex2(float x) { return __builtin_amdgcn_exp2f(x); }
DEVI float siluf(float v) { return v * __builtin_amdgcn_rcpf(1.0f + __expf(-v)); }

namespace g8 {
constexpr int BK = 64, HALF = 128, HT = HALF * BK;
DEVI int lds_byte(int r, int c) { int st = (r >> 4) * 2 + (c >> 5), rr = r & 15, cc = c & 31, ob = rr * 64 + cc * 2; return st * 1024 + (ob ^ (((ob >> 9) & 1) << 5)); }
DEVI void stage_rc(int b, int& R, int& C) { int st = b / 1024, sb = b % 1024, swz = sb ^ (((sb >> 9) & 1) << 5); R = (st >> 1) * 16 + swz / 64; C = (st & 1) * 32 + (swz % 64) / 2; }
}

DEVI void g8_rc(int tid, int& R0, int& C0) { g8::stage_rc(tid * 16, R0, C0); }
DEVI void g8_voff_lin(unsigned (&v)[4], int ld, int tid) { int R0, C0; g8_rc(tid, R0, C0);
    v[0] = (unsigned)(R0 * ld + C0) * 2u; v[1] = (unsigned)((R0 + 64) * ld + C0) * 2u; v[2] = (unsigned)((R0 + 128) * ld + C0) * 2u; v[3] = (unsigned)((R0 + 192) * ld + C0) * 2u; }
DEVI void g8_voff_tab(unsigned (&v)[4], const LAS unsigned* tab, int tid) { int R0, C0; g8_rc(tid, R0, C0);
    v[0] = (tab[R0] + C0) * 2u; v[1] = (tab[R0 + 64] + C0) * 2u; v[2] = (tab[R0 + 128] + C0) * 2u; v[3] = (tab[R0 + 192] + C0) * 2u; }

template <class Epi>
DEVI void gemm_tile(LAS unsigned char* lds, const int tid_in, const char* Ab, const unsigned (&voffA_)[4], const char* Bb, const int K, const Epi& epi) {
    using namespace g8;
    constexpr int HTB = HALF * BK * 2;
    int tz = tid_in; asm volatile("" : "+v"(tz));
    int wid = tz >> 6, lane = tz & 63, wr = wid >> 2, wc = wid & 3, fr = lane & 15, fq = lane >> 4;
    unsigned voffA[4] = {voffA_[0], voffA_[1], voffA_[2], voffA_[3]};
    asm volatile("" : "+v"(voffA[0]), "+v"(voffA[1]), "+v"(voffA[2]), "+v"(voffA[3]));
    unsigned voffB[2];
    { int R0, C0; stage_rc(tz * 16, R0, C0); voffB[0] = (unsigned)(R0 * K + C0) * 2u; voffB[1] = (unsigned)((R0 + 64) * K + C0) * 2u; }
    const size_t kstep = (size_t)(BK * 2);
    const size_t hstepB = (size_t)HALF * K * 2;
    const unsigned ldsw = (unsigned)wid * 1024u;
    const int aoff = lds_byte(wr * 64 + fr, fq * 8), boff = lds_byte(wc * 32 + fr, fq * 8);
#define G8_SA(b, h) (((b) * 2 + (h)) * HTB)
#define G8_SB(b, h) ((4 + (b) * 2 + (h)) * HTB)
#define G8_GL(gp, lofs) __builtin_amdgcn_global_load_lds((const unsigned*)(gp), (LAS unsigned*)(lds + (lofs)), 16, 0, 0)
#define STAGE_A(b, h, kt) do { const char* g_ = Ab + (size_t)(kt) * kstep; G8_GL(g_ + voffA[(h) * 2], G8_SA(b, h) + ldsw); G8_GL(g_ + voffA[(h) * 2 + 1], G8_SA(b, h) + ldsw + 8192); } while (0)
#define STAGE_B(b, h, kt) do { const char* g_ = Bb + (size_t)(kt) * kstep + ((h) ? hstepB : 0); G8_GL(g_ + voffB[0], G8_SB(b, h) + ldsw); G8_GL(g_ + voffB[1], G8_SB(b, h) + ldsw + 8192); } while (0)
#define LDA(dst, b, h) do { _Pragma("unroll") for (int m = 0; m < 4; ++m) _Pragma("unroll") for (int k = 0; k < 2; ++k) dst[m][k] = *(const LAS bf16x8*)(lds + G8_SA(b, h) + aoff + m * 2048 + k * 1024); } while (0)
#define LDB(dst, b, h) do { _Pragma("unroll") for (int n = 0; n < 2; ++n) _Pragma("unroll") for (int k = 0; k < 2; ++k) dst[n][k] = *(const LAS bf16x8*)(lds + G8_SB(b, h) + boff + n * 2048 + k * 1024); } while (0)
#define MMA(ai, bj, Af, Bf) do { __builtin_amdgcn_s_setprio(1); \
    _Pragma("unroll") for (int m = 0; m < 4; ++m) _Pragma("unroll") for (int n = 0; n < 2; ++n) _Pragma("unroll") for (int k = 0; k < 2; ++k) \
      acc[ai][bj][m][n] = __builtin_amdgcn_mfma_f32_16x16x32_bf16(Bf[n][k], Af[m][k], acc[ai][bj][m][n], 0, 0, 0); \
    __builtin_amdgcn_s_setprio(0); } while (0)
#define WAIT_V(n) asm volatile("s_waitcnt vmcnt(" #n ")" ::: "memory")
#define WAIT_L(n) asm volatile("s_waitcnt lgkmcnt(" #n ")" ::: "memory")
#define BAR __builtin_amdgcn_s_barrier()
#define SCHED __builtin_amdgcn_sched_barrier(0)
    f32x4 acc[2][2][4][2];
#pragma unroll
    for (int a = 0; a < 2; ++a)
#pragma unroll
        for (int b = 0; b < 2; ++b)
#pragma unroll
            for (int m = 0; m < 4; ++m)
#pragma unroll
                for (int n = 0; n < 2; ++n) acc[a][b][m][n] = (f32x4){0.f, 0.f, 0.f, 0.f};
    bf16x8 At[4][2], B0[2][2], B1[2][2];
    const int nt = K / BK;
    STAGE_B(0, 0, 0); STAGE_A(0, 0, 0); STAGE_B(0, 1, 0); STAGE_A(0, 1, 0);
    if (wr == 1) BAR;
    WAIT_V(4); BAR;
    STAGE_B(1, 0, 1); STAGE_A(1, 0, 1); STAGE_B(1, 1, 1);
    WAIT_V(6); BAR;
#pragma unroll 1
    for (int t = 0; t < nt; t += 2) {
        const int t2 = (t == nt - 2) ? 0 : t + 2;
        const int t3 = t2 + 1;
        LDB(B0, 0, 0); SCHED; LDA(At, 0, 0); STAGE_A(1, 1, t + 1);
        WAIT_L(8); BAR; WAIT_L(0); MMA(0, 0, At, B0); BAR; SCHED;
        LDB(B1, 0, 1); STAGE_B(0, 0, t2);
        BAR; WAIT_L(0); MMA(0, 1, At, B1); BAR;
        LDA(At, 0, 1); STAGE_A(0, 0, t2);
        BAR; WAIT_L(0); MMA(1, 0, At, B0); BAR; SCHED;
        STAGE_B(0, 1, t2);
        WAIT_V(6); BAR; MMA(1, 1, At, B1); BAR;
        LDB(B0, 1, 0); SCHED; LDA(At, 1, 0); STAGE_A(0, 1, t2);
        WAIT_L(8); BAR; WAIT_L(0); MMA(0, 0, At, B0); BAR; SCHED;
        LDB(B1, 1, 1); STAGE_B(1, 0, t3);
        BAR; WAIT_L(0); MMA(0, 1, At, B1); BAR;
        LDA(At, 1, 1); STAGE_A(1, 0, t3);
        BAR; WAIT_L(0); MMA(1, 0, At, B0); BAR; SCHED;
        STAGE_B(1, 1, t3);
        WAIT_V(6); BAR; MMA(1, 1, At, B1); BAR;
    }
    WAIT_V(0);
    if (wr == 0) BAR;
    BAR;
    asm volatile("" : "+v"(tz)); wid = tz >> 6; lane = tz & 63; wr = wid >> 2; wc = wid & 3; fr = lane & 15; fq = lane >> 4;
    epi(acc, wr, wc, fr, fq);
#undef G8_SA
#undef G8_SB
#undef G8_GL
#undef STAGE_A
#undef STAGE_B
#undef LDA
#undef LDB
#undef MMA
}
struct GDesc { const char* Ab; const char* Bb; unsigned va0, va1, va2, va3; int i0, i1, i2; };
template <class Next, class Epi>
DEVI void gemm_stream(LAS unsigned char* lds, const int tid_in, const int K, Next& next, const Epi& epi) {
    using namespace g8;
    constexpr int HTB = HALF * BK * 2;
    int tz = tid_in; asm volatile("" : "+v"(tz));
    int wid = tz >> 6, lane = tz & 63, wr = wid >> 2, wc = wid & 3, fr = lane & 15, fq = lane >> 4;
    unsigned voffB[2];
    { int R0, C0; stage_rc(tz * 16, R0, C0); voffB[0] = (unsigned)(R0 * K + C0) * 2u; voffB[1] = (unsigned)((R0 + 64) * K + C0) * 2u; }
    const size_t kstep = (size_t)(BK * 2);
    const size_t hstepB = (size_t)HALF * K * 2;
    const unsigned ldsw = (unsigned)wid * 1024u;
    const int aoff = lds_byte(wr * 64 + fr, fq * 8), boff = lds_byte(wc * 32 + fr, fq * 8);
#define G8_SA(b, h) (((b) * 2 + (h)) * HTB)
#define G8_SB(b, h) ((4 + (b) * 2 + (h)) * HTB)
#define G8_GL(gp, lofs) __builtin_amdgcn_global_load_lds((const unsigned*)(gp), (LAS unsigned*)(lds + (lofs)), 16, 0, 0)
#define STG_A(b, h, gb, v0, v1) do { G8_GL((gb) + (v0), G8_SA(b, h) + ldsw); G8_GL((gb) + (v1), G8_SA(b, h) + ldsw + 8192); } while (0)
#define STG_B(b, h, gb) do { const char* g_ = (gb) + ((h) ? hstepB : 0); G8_GL(g_ + voffB[0], G8_SB(b, h) + ldsw); G8_GL(g_ + voffB[1], G8_SB(b, h) + ldsw + 8192); } while (0)
#define LDA(dst, b, h) do { _Pragma("unroll") for (int m = 0; m < 4; ++m) _Pragma("unroll") for (int k = 0; k < 2; ++k) dst[m][k] = *(const LAS bf16x8*)(lds + G8_SA(b, h) + aoff + m * 2048 + k * 1024); } while (0)
#define LDB(dst, b, h) do { _Pragma("unroll") for (int n = 0; n < 2; ++n) _Pragma("unroll") for (int k = 0; k < 2; ++k) dst[n][k] = *(const LAS bf16x8*)(lds + G8_SB(b, h) + boff + n * 2048 + k * 1024); } while (0)
#define MMA(ai, bj, Af, Bf) do { __builtin_amdgcn_s_setprio(1); \
    _Pragma("unroll") for (int m = 0; m < 4; ++m) _Pragma("unroll") for (int n = 0; n < 2; ++n) _Pragma("unroll") for (int k = 0; k < 2; ++k) \
      acc[ai][bj][m][n] = __builtin_amdgcn_mfma_f32_16x16x32_bf16(Bf[n][k], Af[m][k], acc[ai][bj][m][n], 0, 0, 0); \
    __builtin_amdgcn_s_setprio(0); } while (0)
#define ZACC() do { _Pragma("unroll") for (int a = 0; a < 2; ++a) _Pragma("unroll") for (int b = 0; b < 2; ++b) _Pragma("unroll") for (int m = 0; m < 4; ++m) _Pragma("unroll") for (int n = 0; n < 2; ++n) acc[a][b][m][n] = (f32x4){0.f, 0.f, 0.f, 0.f}; } while (0)
    GDesc cur, nxt;
    if (!next(0, cur)) return;
    nxt = cur;
    f32x4 acc[2][2][4][2];
    ZACC();
    bf16x8 At[4][2], B0[2][2], B1[2][2];
    const int nt = K / BK;
    STG_B(0, 0, cur.Bb); STG_A(0, 0, cur.Ab, cur.va0, cur.va1); STG_B(0, 1, cur.Bb); STG_A(0, 1, cur.Ab, cur.va2, cur.va3);
    if (wr == 1) BAR;
    WAIT_V(4); BAR;
    STG_B(1, 0, cur.Bb + kstep); STG_A(1, 0, cur.Ab + kstep, cur.va0, cur.va1); STG_B(1, 1, cur.Bb + kstep);
    WAIT_V(6); BAR;
    int ui = 0; bool has_next = false;
#pragma unroll 1
    for (;;) {
#pragma unroll 1
        for (int t = 0; t < nt; t += 2) {
            const bool last = (t == nt - 2);
            if (last) { has_next = next(ui + 1, nxt); if (!has_next) nxt = cur; }
            const char* a2 = last ? nxt.Ab : cur.Ab + (size_t)(t + 2) * kstep;
            const char* b2 = last ? nxt.Bb : cur.Bb + (size_t)(t + 2) * kstep;
            const unsigned s0 = last ? nxt.va0 : cur.va0, s1 = last ? nxt.va1 : cur.va1, s2 = last ? nxt.va2 : cur.va2, s3 = last ? nxt.va3 : cur.va3;
            LDB(B0, 0, 0); SCHED; LDA(At, 0, 0); STG_A(1, 1, cur.Ab + (size_t)(t + 1) * kstep, cur.va2, cur.va3);
            WAIT_L(8); BAR; WAIT_L(0); MMA(0, 0, At, B0); BAR; SCHED;
            LDB(B1, 0, 1); STG_B(0, 0, b2);
            BAR; WAIT_L(0); MMA(0, 1, At, B1); BAR;
            LDA(At, 0, 1); STG_A(0, 0, a2, s0, s1);
            BAR; WAIT_L(0); MMA(1, 0, At, B0); BAR; SCHED;
            STG_B(0, 1, b2);
            WAIT_V(6); BAR; MMA(1, 1, At, B1); BAR;
            LDB(B0, 1, 0); SCHED; LDA(At, 1, 0); STG_A(0, 1, a2, s2, s3);
            WAIT_L(8); BAR; WAIT_L(0); MMA(0, 0, At, B0); BAR; SCHED;
            LDB(B1, 1, 1); STG_B(1, 0, b2 + kstep);
            BAR; WAIT_L(0); MMA(0, 1, At, B1); BAR;
            LDA(At, 1, 1); STG_A(1, 0, a2 + kstep, s0, s1);
            BAR; WAIT_L(0); MMA(1, 0, At, B0); BAR; SCHED;
            STG_B(1, 1, b2 + kstep);
            WAIT_V(6); BAR; MMA(1, 1, At, B1); BAR;
        }
        {
            int tq = tz; asm volatile("" : "+v"(tq));
            const int wid_ = tq >> 6, lane_ = tq & 63;
            epi(acc, cur, wid_ >> 2, wid_ & 3, lane_ & 15, lane_ >> 4);
        }
        if (!has_next) break;
        ZACC();
        cur = nxt; ++ui;
    }
    WAIT_V(0);
    if (wr == 0) BAR;
    BAR;
#undef G8_SA
#undef G8_SB
#undef G8_GL
#undef STG_A
#undef STG_B
#undef LDA
#undef LDB
#undef MMA
#undef ZACC
}
#define EPI_FOREACH8(acc, wr, wc, fr, fq, ROW, COL8, V0, V1, ...) \
    _Pragma("unroll") for (int ai_ = 0; ai_ < 2; ++ai_) _Pragma("unroll") for (int m_ = 0; m_ < 4; ++m_) { const int ROW = ai_ * 128 + (wr) * 64 + m_ * 16 + (fr); \
    _Pragma("unroll") for (int bj_ = 0; bj_ < 2; ++bj_) { const int COL8 = bj_ * 128 + (wc) * 32 + (fq) * 8; const f32x4 V0 = acc[ai_][bj_][m_][0]; const f32x4 V1 = acc[ai_][bj_][m_][1]; __VA_ARGS__ } }
#define PK8(w, a, b) do { w.x = pk2(a[0], a[1]); w.y = pk2(a[2], a[3]); w.z = pk2(b[0], b[1]); w.w = pk2(b[2], b[3]); } while (0)

template <class SCol, class DRow, class KS, class NS>
DEVI void convert_T(bf16_t* __restrict__ dst, const float* __restrict__ src, int ld, int K, int NR, SCol scol, DRow drow, KS ks, NS ns, int wi, int nw) {
    const int k8n = K >> 3; const int items = NR * k8n;
    for (int it = wi; it < items; it += nw) {
        const int n = it % NR, k0 = (it / NR) << 3;
        const int sc = scol(n);
        float v[8];
#pragma unroll
        for (int j = 0; j < 8; ++j) v[j] = (sc >= 0) ? src[(size_t)(k0 + j) * ld + sc] * ks(k0 + j) : 0.f;
        const float s = ns(n);
        u32x4 w; w.x = pk2(v[0] * s, v[1] * s); w.y = pk2(v[2] * s, v[3] * s); w.z = pk2(v[4] * s, v[5] * s); w.w = pk2(v[6] * s, v[7] * s);
        *(u32x4*)(dst + (size_t)drow(n) * K + k0) = w;
    }
}
struct IdCol { DEVI int operator()(int n) const { return n; } };
struct OneK { DEVI float operator()(int) const { return 1.f; } };
struct VecK { const float* g; DEVI float operator()(int k) const { return g[k]; } };

template <int NB, bool PERM>
DEVI void convert_panel(bf16_t* __restrict__ dst, const float* __restrict__ src, const int ld, const int K, const int tid) {
    constexpr int N4 = NB / 4;
    const int items = (K >> 3) * N4;
#pragma unroll 1
    for (int it0 = tid; it0 < items; it0 += 1024) {
        f32x4 v[2][8];
#pragma unroll
        for (int u = 0; u < 2; ++u) {
            const int it = it0 + u * 512; const int n4 = it % N4, k8 = it / N4;
            const float* sp = src + (size_t)(k8 * 8) * ld + n4 * 4;
#pragma unroll
            for (int j = 0; j < 8; ++j) v[u][j] = *(const f32x4*)(sp + (size_t)j * ld);
        }
#pragma unroll
        for (int u = 0; u < 2; ++u) {
            const int it = it0 + u * 512; const int n4 = it % N4, k8 = it / N4;
#pragma unroll
            for (int c = 0; c < 4; ++c) {
                u32x4 w; w.x = pk2(v[u][0][c], v[u][1][c]); w.y = pk2(v[u][2][c], v[u][3][c]); w.z = pk2(v[u][4][c], v[u][5][c]); w.w = pk2(v[u][6][c], v[u][7][c]);
                const int n = n4 * 4 + c; const int dr = PERM ? ((n & ~31) + perm_slot(n & 31)) : n;
                *(u32x4*)(dst + (size_t)dr * K + k8 * 8) = w;
            }
        }
    }
}

template <int NB, bool PERM>
DEVI void convert_panel_lds(bf16_t* __restrict__ dst, const float* __restrict__ src, const int ld, const int K, const int tid, LAS unsigned char* lds) {
    constexpr int N4 = NB / 4;
    constexpr int K8C = 512 / N4;
    constexpr int KC = K8C * 8;
    constexpr int PITCH = KC * 2 + 8;
    constexpr int PPR = KC / 8;
    const int n4 = tid % N4, k8 = tid / N4;
    const float* sp = src + (size_t)(k8 * 8) * ld + n4 * 4;
    const int nchunk = K / KC;
    f32x4 va[8], vb[8], vc[8];
#define CPL_LOAD(V, c) do { const float* q_ = sp + (size_t)(c) * KC * ld; _Pragma("unroll") for (int j = 0; j < 8; ++j) V[j] = *(const f32x4*)(q_ + (size_t)j * ld); } while (0)
#define CPL_PROC(V, c) do { \
        _Pragma("unroll") for (int cc = 0; cc < 4; ++cc) { \
            u32x2 lo, hi; lo.x = pk2(V[0][cc], V[1][cc]); lo.y = pk2(V[2][cc], V[3][cc]); hi.x = pk2(V[4][cc], V[5][cc]); hi.y = pk2(V[6][cc], V[7][cc]); \
            LAS unsigned char* wp = lds + (n4 * 4 + cc) * PITCH + k8 * 16; \
            *(LAS u32x2*)wp = lo; *(LAS u32x2*)(wp + 8) = hi; } \
        __syncthreads(); \
        _Pragma("unroll") for (int q = 0; q < 4; ++q) { \
            const int p = tid + 512 * q; const int row = p / PPR, pc = p % PPR; \
            const LAS unsigned char* rp = lds + row * PITCH + pc * 16; \
            const u32x2 a = *(const LAS u32x2*)rp, b = *(const LAS u32x2*)(rp + 8); \
            const int dr = PERM ? ((row & ~31) + perm_slot(row & 31)) : row; \
            u32x4 w; w.x = a.x; w.y = a.y; w.z = b.x; w.w = b.y; \
            *(u32x4*)(dst + (size_t)dr * K + (c) * KC + pc * 8) = w; } \
        __syncthreads(); } while (0)
    CPL_LOAD(va, 0); if (nchunk > 1) CPL_LOAD(vb, 1); if (nchunk > 2) CPL_LOAD(vc, 2);
#pragma unroll 1
    for (int c = 0; c < nchunk; c += 3) {
        CPL_PROC(va, c); if (c + 3 < nchunk) CPL_LOAD(va, c + 3);
        if (c + 1 < nchunk) { CPL_PROC(vb, c + 1); if (c + 4 < nchunk) CPL_LOAD(vb, c + 4); }
        if (c + 2 < nchunk) { CPL_PROC(vc, c + 2); if (c + 5 < nchunk) CPL_LOAD(vc, c + 5); }
    }
#undef CPL_LOAD
#undef CPL_PROC
}

struct Params {
    const float* in[24];
    float* out;
    unsigned char* ws;
    int ph_lo, ph_hi;
    int flags, pad;
};
enum { I_X = 0, I_C, I_WADA, I_BADA, I_N1G, I_WIN, I_QNG, I_WUQ, I_KVNG, I_WUKV, I_REL, I_AOG, I_BOG, I_WO, I_N2G, I_WR, I_EB, I_W1, I_W3, I_W2, I_WS1, I_WS3, I_WS2, I_FG };
constexpr int NPHASE = 15;

#define W_x (P.in[I_X])
#define W_mod ((float*)(ws + OFF_MOD))
#define W_ropecs ((float*)(ws + OFF_ROPE))
#define W_biasT ((float*)(ws + OFF_BIAS))
#define W_WinT ((bf16_t*)(ws + OFF_WIN))
#define W_WuqT ((bf16_t*)(ws + OFF_WUQ))
#define W_WukvT ((bf16_t*)(ws + OFF_WUKV))
#define W_WoT ((bf16_t*)(ws + OFF_WO))
#define W_WrT ((bf16_t*)(ws + OFF_WR))
#define W_Ws13T ((bf16_t*)(ws + OFF_WS13))
#define W_Ws2T ((bf16_t*)(ws + OFF_WS2))
#define W_hbuf ((bf16_t*)(ws + OFF_H))
#define W_logits ((float*)(ws + OFF_LOGITS))
#define W_eidx ((int*)(ws + OFF_EIDX))
#define W_gate ((float*)(ws + OFF_GATE))
#define W_rnk ((int*)(ws + OFF_RNK))
#define W_pos ((int*)(ws + OFF_POS))
#define W_toks ((int*)(ws + OFF_TOKS))
#define W_wts ((float*)(ws + OFF_WTS))
#define W_ssq ((float*)(ws + OFF_SSQ))
#define W_scr ((bf16_t*)(ws + OFF_SCR + (size_t)blk * SCR_PER_BLK))
#define W_hdn ((bf16_t*)(ws + OFF_HDN))
#define W_ybuf ((bf16_t*)(ws + OFF_Y))
#define W_y8 ((unsigned char*)(ws + OFF_Y))
#define W_proj ((bf16_t*)(ws + OFF_PROJ))
#define W_qb ((bf16_t*)(ws + OFF_QB))
#define W_kvb ((bf16_t*)(ws + OFF_KVB))
#define W_bout ((bf16_t*)(ws + OFF_BOUT))
#define W_aparts ((bf16_t*)(ws + OFF_APARTS))
#define W_lsebuf ((float*)(ws + OFF_LSE))
#define W_mixb ((bf16_t*)(ws + OFF_MIX))
#define W_xt ((bf16_t*)(ws + OFF_XT))

__global__ void __launch_bounds__(512, 2) fwd_kernel(Params P) {
    extern __shared__ __attribute__((aligned(16))) unsigned char lds[];
    const int blk = blockIdx.x, G = gridDim.x;
    const int wave_s = __builtin_amdgcn_readfirstlane((int)threadIdx.x >> 6);
#define TIDS0 int tid; asm volatile("v_mbcnt_lo_u32_b32 %0, -1, 0\n\tv_mbcnt_hi_u32_b32 %0, -1, %0" : "=v"(tid)); tid += wave_s * 64;
    const int vblk = (G % 8 == 0) ? (blk % 8) * (G / 8) + blk / 8 : blk;
    unsigned char* ws = P.ws;
    unsigned* ctl = (unsigned*)(ws + OFF_CTL);
    { TIDS0 if (tid < 64) ((LAS unsigned*)(lds + LDS_MISC))[tid] = 0u; }
    __syncthreads();
    XcdBarrier bar; bar.bar = ctl; bar.x = 0; bar.st = nullptr;
    if (MK_N_LAUNCHES == 1) { TIDS0 bar = xcd_barrier_post(ctl, (volatile LAS unsigned*)(lds + LDS_MISC), tid == 0); }
#ifndef PH_MASK
#define PH_MASK 0xffffffffu
#endif
#define TIDS int tid; asm volatile("v_mbcnt_lo_u32_b32 %0, -1, 0\n\tv_mbcnt_hi_u32_b32 %0, -1, %0" : "=v"(tid)); tid += wave_s * 64; const int lane = tid & 63; const int wave = wave_s; (void)lane; (void)wave;
#define IN(k) ((((PH_MASK) >> (k)) & 1u) && P.ph_lo <= (k) && (k) < P.ph_hi)
#define SEAM(k) do { if (MK_N_LAUNCHES == 1 && IN(k) && IN((k) + 1)) { TIDS0 xcd_barrier(bar, tid == 0); } } while (0)

    unsigned* cntg = ctl + CNT_WORD0;
    LAS unsigned* rowoff = (LAS unsigned*)(lds + LDS_ROWOFF);
    LAS float* rowsc = (LAS float*)(lds + LDS_ROWSC);
    LAS int* startL = (LAS int*)(lds + LDS_START);
    LAS int* cntL = (LAS int*)(lds + LDS_CNT);
    LAS int* tbL = (LAS int*)(lds + LDS_TB);
    LAS int* itemD = (LAS int*)(lds + LDS_MISC + 64);
    char* stage = (char*)lds + LDS_STAGE;
    LAS unsigned char* ldsL = (LAS unsigned char*)lds;

    if (IN(0)) {
        TIDS
        {
            float* sc = (float*)(lds);
            float* red = (float*)(lds + 32768);
            const float* c = P.in[I_C];
            for (int i = tid; i < 8192; i += 512) sc[i] = siluf(c[i]);
            __syncthreads();
            for (int cb = blk; cb < 256; cb += G) {
                const int cj = tid & 31, kg = tid >> 5;
                float a0 = 0, a1 = 0, a2 = 0, a3 = 0, a4 = 0, a5 = 0, a6 = 0, a7 = 0;
                if (cj < 24) {
                    const float* w = P.in[I_WADA] + cb * 24 + cj;
                    for (int k = kg * 64; k < kg * 64 + 64; ++k) {
                        const float wv = w[(size_t)k * 6144];
                        a0 += sc[k] * wv; a1 += sc[1024 + k] * wv; a2 += sc[2048 + k] * wv; a3 += sc[3072 + k] * wv;
                        a4 += sc[4096 + k] * wv; a5 += sc[5120 + k] * wv; a6 += sc[6144 + k] * wv; a7 += sc[7168 + k] * wv;
                    }
                }
                float* rp = red + (kg * 8) * 32 + cj;
                rp[0] = a0; rp[32] = a1; rp[64] = a2; rp[96] = a3; rp[128] = a4; rp[160] = a5; rp[192] = a6; rp[224] = a7;
                __syncthreads();
                if (tid < 256) {
                    const int b = tid >> 5, j = tid & 31;
                    if (j < 24) {
                        float s = 0.f;
                        for (int g = 0; g < 16; ++g) s += red[(g * 8 + b) * 32 + j];
                        const int col = cb * 24 + j;
                        W_mod[b * 6144 + col] = s + P.in[I_BADA][col];
                    }
                }
                __syncthreads();
            }
        }
        {
            for (int idx = blk * 512 + tid; idx < 4096 * 16; idx += G * 512) {
                const int s = idx >> 4, i = idx & 15;
                double inv = 1.0; for (int j = 0; j < i; ++j) inv *= 0.5623413251903491;
                const float invf = (float)inv;
                const float angf = (float)s * invf;
                const double xa = (double)angf;
                const double nrev = __builtin_rint(xa * 0.15915494309189535);
                const double r = xa - nrev * 6.283185307179586;
                const double r2 = r * r;
                double ts = r, ss = r, tc = 1.0, cc = 1.0;
#pragma unroll
                for (int n = 1; n <= 14; ++n) {
                    ts *= -r2 / (double)((2 * n) * (2 * n + 1)); ss += ts;
                    tc *= -r2 / (double)((2 * n - 1) * (2 * n)); cc += tc;
                }
                W_ropecs[idx * 2] = (float)cc; W_ropecs[idx * 2 + 1] = (float)ss;
            }
        }
        {
            for (int idx = blk * 512 + tid; idx < 3 * 8 * 129; idx += G * 512) {
                const int j = idx % 129, hh = (idx / 129) % 8, p = idx / (129 * 8);
                const int dil = (p == 0) ? 1 : (p == 1 ? 4 : 16);
                const int rel = (j - 64) * dil;
                const int n = rel < 0 ? -rel : rel;
                const float nf = (float)(n > 1 ? n : 1);
                int large = 8 + (int)(__logf(nf * 0.125f) / 4.852030263919617f * 8.0f);
                large = large < 15 ? large : 15;
                const int bucket = (rel > 0 ? 16 : 0) + (n < 8 ? n : large);
                W_biasT[idx] = P.in[I_REL][bucket * 8 + hh] * LOG2E;
            }
        }
        {
            const int wi = blk * 512 + tid, nw = G * 512;
            convert_T(W_WinT, P.in[I_WIN], INC, 1024, INCP,
                      [](int n) { if (n >= INC) return -1; if (n < 2176) return n; const int i = n - 2176; return 2176 + ((i & 1) ? 16 : 0) + (i >> 1); },
                      [](int n) { return perm_row(n); }, OneK{}, [](int n) { return n < 512 ? 0.125f * LOG2E : 1.0f; }, wi, nw);
            convert_T(W_WuqT, P.in[I_WUQ], 768, 384, 768,
                      [](int n) { if (n < 512) return (n >> 6) * 96 + (n & 63); const int hh = (n - 512) >> 5, i = n & 31; return hh * 96 + 64 + ((i & 1) ? 16 : 0) + (i >> 1); },
                      [](int n) { return perm_row(n); }, VecK{P.in[I_QNG]}, [](int) { return 0.10206207261596577f * LOG2E; }, wi, nw);
            convert_T(W_WukvT, P.in[I_WUKV], 1024, 256, 1024, IdCol{}, [](int n) { return perm_row(n); }, VecK{P.in[I_KVNG]}, [](int) { return 1.f; }, wi, nw);
            {
                const float* ag = P.in[I_AOG]; const float* bg = P.in[I_BOG];
                convert_T(W_WoT, P.in[I_WO], 1024, 1024, 1024, IdCol{}, [](int n) { return perm_row(n); }, [=](int k) { return k < 512 ? ag[k] : bg[k - 512]; }, [](int) { return 1.f; }, wi, nw);
            }
            convert_T(W_WrT, P.in[I_WR], 256, 1024, 256, IdCol{}, [](int n) { return perm_row(n); }, OneK{}, [](int) { return 1.f; }, wi, nw);
            convert_T(W_Ws13T, P.in[I_WS1], 256, 1024, 256, IdCol{}, [](int n) { return perm_row((n >> 7) * 256 + (n & 127)); }, OneK{}, [](int) { return 1.f; }, wi, nw);
            convert_T(W_Ws13T, P.in[I_WS3], 256, 1024, 256, IdCol{}, [](int n) { return perm_row((n >> 7) * 256 + 128 + (n & 127)); }, OneK{}, [](int) { return 1.f; }, wi, nw);
            convert_T(W_Ws2T, P.in[I_WS2], 1024, 256, 1024, IdCol{}, [](int n) { return perm_row(n); }, OneK{}, [](int) { return 1.f; }, wi, nw);
        }
    }
    SEAM(0);

    if (IN(1)) {
        TIDS
        const float* g = P.in[I_N1G];
        f32x4 vn[4];
        {
            const float* xr = W_x + (size_t)(blk * 8 + wave) * DM;
#pragma unroll
            for (int i = 0; i < 4; ++i) vn[i] = *(const f32x4*)(xr + i * 256 + lane * 4);
        }
        for (int row = blk * 8 + wave; row < NTOK; row += G * 8) {
            const int b = row >> 12;
            f32x4 v[4]; float ss = 0.f;
#pragma unroll
            for (int i = 0; i < 4; ++i) v[i] = vn[i];
            if (row + G * 8 < NTOK) {
                const float* xn = W_x + (size_t)(row + G * 8) * DM;
#pragma unroll
                for (int i = 0; i < 4; ++i) vn[i] = *(const f32x4*)(xn + i * 256 + lane * 4);
            }
#pragma unroll
            for (int i = 0; i < 4; ++i) ss += v[i][0] * v[i][0] + v[i][1] * v[i][1] + v[i][2] * v[i][2] + v[i][3] * v[i][3];
            ss = wave_sum(ss);
            const float rinv = rsqrtf(ss * (1.0f / 1024.0f) + EPS);
            const float* mb = W_mod + b * 6144;
#pragma unroll
            for (int i = 0; i < 4; ++i) {
                const int c = i * 256 + lane * 4;
                const f32x4 gg = *(const f32x4*)(g + c), sh = *(const f32x4*)(mb + c), sc = *(const f32x4*)(mb + 1024 + c);
                float o[4];
#pragma unroll
                for (int j = 0; j < 4; ++j) o[j] = v[i][j] * rinv * gg[j] * (1.0f + sc[j]) + sh[j];
                u32x2 w; w.x = pk2(o[0], o[1]); w.y = pk2(o[2], o[3]);
                *(u32x2*)(W_hbuf + (size_t)row * DM + c) = w;
            }
        }
    }
    SEAM(1);

    if (IN(2)) {
        TIDS
        unsigned vl_[4]; g8_voff_lin(vl_, DM, tid);
        auto nextf = [&](int i, GDesc& d) {
            const int ul = i * 32 + (vblk & 31); if (ul >= 144 || vblk >= 256) return false;
            const int pm = (vblk >> 5) * 16 + ul / 9, pn = ul % 9;
            d.Ab = (const char*)(W_hbuf + (size_t)pm * 256 * DM); d.Bb = (const char*)(W_WinT + (size_t)pn * 256 * DM);
            d.va0 = vl_[0]; d.va1 = vl_[1]; d.va2 = vl_[2]; d.va3 = vl_[3]; d.i0 = pm; d.i1 = pn; d.i2 = 0; return true;
        };
        auto epi = [&](const f32x4 (&acc)[2][2][4][2], const GDesc& d, int wr, int wc, int fr, int fq) {
            const int pm = d.i0, pn = d.i1;
            if (pn < 8) {
                EPI_FOREACH8(acc, wr, wc, fr, fq, r, c8, v0, v1, {
                    u32x4 w; PK8(w, v0, v1);
                    *(u32x4*)(W_proj + (size_t)(pm * 256 + r) * INCP + pn * 256 + c8) = w;
                })
            } else {
                EPI_FOREACH8(acc, wr, wc, fr, fq, r, c8, v0, v1, {
                    const int row = pm * 256 + r;
                    if (c8 < 160) {
                        f32x4 o0 = v0, o1 = v1;
                        if (c8 >= 128) {
                            const int i = (c8 - 128) >> 1; const int s = row & 4095;
                            const f32x4 ca = *(const f32x4*)(W_ropecs + (s * 16 + i) * 2), cb = *(const f32x4*)(W_ropecs + (s * 16 + i) * 2 + 4);
                            o0[0] = v0[0] * ca[0] - v0[1] * ca[1]; o0[1] = v0[1] * ca[0] + v0[0] * ca[1];
                            o0[2] = v0[2] * ca[2] - v0[3] * ca[3]; o0[3] = v0[3] * ca[2] + v0[2] * ca[3];
                            o1[0] = v1[0] * cb[0] - v1[1] * cb[1]; o1[1] = v1[1] * cb[0] + v1[0] * cb[1];
                            o1[2] = v1[2] * cb[2] - v1[3] * cb[3]; o1[3] = v1[3] * cb[2] + v1[2] * cb[3];
                        }
                        u32x4 w; PK8(w, o0, o1);
                        *(u32x4*)(W_proj + (size_t)row * INCP + 2048 + c8) = w;
                    }
                })
            }
            if (pn >= 6) {
#pragma unroll
                for (int ai = 0; ai < 2; ++ai)
#pragma unroll
                    for (int m = 0; m < 4; ++m)
#pragma unroll
                        for (int bj = 0; bj < 2; ++bj) {
                            const f32x4 a = acc[ai][bj][m][0], b = acc[ai][bj][m][1];
                            float ss = a[0] * a[0] + a[1] * a[1] + a[2] * a[2] + a[3] * a[3] + b[0] * b[0] + b[1] * b[1] + b[2] * b[2] + b[3] * b[3];
                            { float o; const float t = x16f(ss, o); ss = t + o; }
                            { float o; const float t = x32f(ss, o); ss = t + o; }
                            if (fq == 0) W_ssq[(size_t)(pm * 256 + ai * 128 + wr * 64 + m * 16 + fr) * 24 + (pn - 6) * 8 + bj * 4 + wc] = ss;
                        }
            }
        };
        gemm_stream(ldsL, tid, DM, nextf, epi);
        if ((vblk & 31) >= 16) {
            TIDS
#pragma unroll 1
            for (int q = 0; q < 2; ++q) {
                const int uu = blk + q * G;
                const int e = (G == 256) ? ((vblk & ~3) + q) : (uu >> 2), pn = (G == 256) ? (vblk & 3) : (uu & 3);
                __syncthreads();
                if (uu < 1024) convert_panel_lds<256, true>(W_scr + (size_t)2 * 256 * 1024 + (size_t)q * 256 * 256, P.in[I_W2] + (size_t)e * 256 * 1024 + pn * 256, 1024, 256, tid, ldsL);
            }
        }
    }
    SEAM(2);

    if (IN(3)) {
        {
            TIDS
            const int xb = (vblk >> 5) * 16, lb = vblk & 31;
            __syncthreads();
            for (int j = 0; j < 2; ++j) { const int ul = j * 32 + lb; if (ul < 48 && tid < 256) {
                const float* sp = W_ssq + (size_t)((xb + ul / 3) * 256 + tid) * 24;
                const f32x4 s0 = *(const f32x4*)sp, s1 = *(const f32x4*)(sp + 4), s2 = *(const f32x4*)(sp + 8);
                const float ss = ((s0[0] + s0[1]) + (s0[2] + s0[3])) + ((s1[0] + s1[1]) + (s1[2] + s1[3])) + ((s2[0] + s2[1]) + (s2[2] + s2[3]));
                rowsc[j * 256 + tid] = rsqrtf(ss * (1.0f / 384.0f) + EPS); } }
            __syncthreads();
            unsigned vl_[4]; g8_voff_lin(vl_, INCP, tid);
            auto nextf = [&](int i, GDesc& d) {
                const int ul = i * 32 + lb; if (ul >= 48 || vblk >= 256) return false;
                const int pm = xb + ul / 3, pn = ul % 3;
                d.Ab = (const char*)(W_proj + (size_t)pm * 256 * INCP + 1536); d.Bb = (const char*)(W_WuqT + (size_t)pn * 256 * QLORA);
                d.va0 = vl_[0]; d.va1 = vl_[1]; d.va2 = vl_[2]; d.va3 = vl_[3]; d.i0 = pm * 4 + pn; d.i1 = i; d.i2 = 0; return true;
            };
            auto epi = [&](const f32x4 (&acc)[2][2][4][2], const GDesc& d, int wr, int wc, int fr, int fq) {
                const int pm = d.i0 >> 2, pn = d.i0 & 3, sl = d.i1 * 256;
                if (pn < 2) {
                    EPI_FOREACH8(acc, wr, wc, fr, fq, r, c8, v0, v1, {
                        const float rs = rowsc[sl + r];
                        const f32x4 a = v0 * rs, b = v1 * rs;
                        u32x4 w; PK8(w, a, b);
                        *(u32x4*)(W_qb + (size_t)(pm * 256 + r) * 768 + pn * 256 + c8) = w;
                    })
                } else {
                    EPI_FOREACH8(acc, wr, wc, fr, fq, r, c8, v0, v1, {
                        const int row = pm * 256 + r;
                        const float rs = rowsc[sl + r];
                        const int i = (c8 & 31) >> 1; const int s = row & 4095;
                        const f32x4 ca = *(const f32x4*)(W_ropecs + (s * 16 + i) * 2), cb = *(const f32x4*)(W_ropecs + (s * 16 + i) * 2 + 4);
                        const f32x4 t0 = v0 * rs, t1 = v1 * rs;
                        f32x4 o0, o1;
                        o0[0] = t0[0] * ca[0] - t0[1] * ca[1]; o0[1] = t0[1] * ca[0] + t0[0] * ca[1];
                        o0[2] = t0[2] * ca[2] - t0[3] * ca[3]; o0[3] = t0[3] * ca[2] + t0[2] * ca[3];
                        o1[0] = t1[0] * cb[0] - t1[1] * cb[1]; o1[1] = t1[1] * cb[0] + t1[0] * cb[1];
                        o1[2] = t1[2] * cb[2] - t1[3] * cb[3]; o1[3] = t1[3] * cb[2] + t1[2] * cb[3];
                        u32x4 w; PK8(w, o0, o1);
                        *(u32x4*)(W_qb + (size_t)row * 768 + 512 + c8) = w;
                    })
                }
            };
            gemm_stream(ldsL, tid, QLORA, nextf, epi);
        }
        {
            TIDS
            const int xb = (vblk >> 5) * 16, lb = vblk & 31;
            __syncthreads();
            for (int j = 0; j < 2; ++j) { const int ul = j * 32 + lb; if (tid < 256) {
                const float* sp = W_ssq + (size_t)((xb + ul / 4) * 256 + tid) * 24 + 12;
                const f32x4 s0 = *(const f32x4*)sp, s1 = *(const f32x4*)(sp + 4);
                const float ss = ((s0[0] + s0[1]) + (s0[2] + s0[3])) + ((s1[0] + s1[1]) + (s1[2] + s1[3]));
                rowsc[j * 256 + tid] = rsqrtf(ss * (1.0f / 256.0f) + EPS); } }
            __syncthreads();
            unsigned vl_[4]; g8_voff_lin(vl_, INCP, tid);
            auto nextf = [&](int i, GDesc& d) {
                const int ul = i * 32 + lb; if (ul >= 64 || vblk >= 256) return false;
                const int pm = xb + ul / 4, pn = ul % 4;
                d.Ab = (const char*)(W_proj + (size_t)pm * 256 * INCP + 1920); d.Bb = (const char*)(W_WukvT + (size_t)pn * 256 * KVLORA);
                d.va0 = vl_[0]; d.va1 = vl_[1]; d.va2 = vl_[2]; d.va3 = vl_[3]; d.i0 = pm * 4 + pn; d.i1 = i; d.i2 = 0; return true;
            };
            auto epi = [&](const f32x4 (&acc)[2][2][4][2], const GDesc& d, int wr, int wc, int fr, int fq) {
                const int pm = d.i0 >> 2, pn = d.i0 & 3, sl = d.i1 * 256;
                EPI_FOREACH8(acc, wr, wc, fr, fq, r, c8, v0, v1, {
                    const float rs = rowsc[sl + r];
                    const f32x4 a = v0 * rs, b = v1 * rs;
                    u32x4 w; PK8(w, a, b);
                    *(u32x4*)(W_kvb + (size_t)(pm * 256 + r) * 1024 + pn * 256 + c8) = w;
                })
            };
            gemm_stream(ldsL, tid, KVLORA, nextf, epi);
        }
    }
    SEAM(3);

    if (IN(4)) {
        for (int ui = 0; ui < ((P.flags & 4) ? 0 : 4); ++ui) {
            TIDS
            const int r32 = lane & 31, hh = lane >> 5;
            if (vblk >= 256) break;
            const int qblk = vblk & 15, bh = (vblk >> 5) * 8 + ui * 2 + ((vblk >> 4) & 1), h = bh & 7, b = bh >> 3;
            const size_t tok0 = (size_t)b * SEQ;
            bf16x8 qf[6];
            {
                const size_t tq = tok0 + qblk * 256 + wave * 32 + r32;
#pragma unroll
                for (int d0 = 0; d0 < 6; ++d0) qf[d0] = *(const bf16x8*)(W_qb + tq * 768 + (d0 < 4 ? h * 64 + d0 * 16 : 512 + h * 32 + (d0 - 4) * 16) + hh * 8);
            }
            f32x16 o0 = {}, o1 = {};
            f32x16 mneg = {};
            float m_run = 0.f, l_run = 0.f;
            const int skey = tid >> 3, sch = tid & 7;
            const bf16_t* kn_src = W_kvb + (tok0 + skey) * 1024 + h * 128 + sch * 8;
            const int pkey = tid >> 2, pch = tid & 3;
            const bf16_t* kp_src = W_proj + (tok0 + pkey) * INCP + 2176 + pch * 8;
            constexpr int KBUF = 12 * 2048, VBUF = 2 * 8192, BUFB = KBUF + VBUF;
            const int k_dst = sch * 2048 + ((skey ^ sch) * 16);
            const int kp_dst = (8 + pch) * 2048 + ((pkey ^ pch) * 16);
            const int v_dst = KBUF + (sch >> 2) * 8192 + skey * 64 + (sch & 3) * 16;
            const int kfo = hh * 2048;
            const int vfo = KBUF + (4 * hh + ((lane & 15) >> 2)) * 64 + ((lane >> 4) & 1) * 32 + (lane & 3) * 8;
            __syncthreads();
            {
                const u32x4 k0 = *(const u32x4*)kn_src, v0 = *(const u32x4*)(kn_src + 64);
                const u32x4 k1 = *(const u32x4*)(kn_src + 64 * 1024), v1 = *(const u32x4*)(kn_src + 64 * 1024 + 64);
                const u32x4 pr = *(const u32x4*)kp_src;
                *(LAS u32x4*)(ldsL + k_dst) = k0; *(LAS u32x4*)(ldsL + k_dst + 1024) = k1;
                *(LAS u32x4*)(ldsL + v_dst) = v0; *(LAS u32x4*)(ldsL + v_dst + 4096) = v1;
                *(LAS u32x4*)(ldsL + kp_dst) = pr;
            }
            __syncthreads();
#pragma unroll 1
            for (int t = 0; t < 32; ++t) {
                const int cur = t & 1;
                const int tn = (t + 1 < 32) ? t + 1 : t;
                const bf16_t* ks = kn_src + (size_t)tn * 128 * 1024;
                const u32x4 nk0 = *(const u32x4*)ks, nv0 = *(const u32x4*)(ks + 64);
                const u32x4 nk1 = *(const u32x4*)(ks + 64 * 1024), nv1 = *(const u32x4*)(ks + 64 * 1024 + 64);
                const u32x4 npr = *(const u32x4*)(kp_src + (size_t)tn * 128 * INCP);
                f32x16 sc[2][2];
#pragma unroll
                for (int sub = 0; sub < 2; ++sub) {
                    const int kb = cur * BUFB + kfo + sub * 1024;
#pragma unroll
                    for (int d0 = 0; d0 < 6; ++d0) {
                        const int sw = (2 * d0 + hh) & 7;
                        const bf16x8 k0 = *(const LAS bf16x8*)(ldsL + kb + d0 * 4096 + ((r32 ^ sw) * 16));
                        const bf16x8 k1 = *(const LAS bf16x8*)(ldsL + kb + d0 * 4096 + (((32 + r32) ^ sw) * 16));
                        if (d0 == 0) { sc[sub][0] = __builtin_amdgcn_mfma_f32_32x32x16_bf16(k0, qf[0], mneg, 0, 0, 0); sc[sub][1] = __builtin_amdgcn_mfma_f32_32x32x16_bf16(k1, qf[0], mneg, 0, 0, 0); }
                        else { sc[sub][0] = __builtin_amdgcn_mfma_f32_32x32x16_bf16(k0, qf[d0], sc[sub][0], 0, 0, 0); sc[sub][1] = __builtin_amdgcn_mfma_f32_32x32x16_bf16(k1, qf[d0], sc[sub][1], 0, 0, 0); }
                    }
                }
#pragma unroll
                for (int sub = 0; sub < 2; ++sub) {
                    const int vb = cur * BUFB + vfo + sub * 4096;
                    f32x16& s0 = sc[sub][0]; f32x16& s1 = sc[sub][1];
#define MX3(a, b, c) __builtin_fmaxf(__builtin_fmaxf((a), (b)), (c))
                    float mxa = MX3(s0[0], s0[1], s1[0]), mxb = MX3(s0[2], s0[3], s1[1]); mxa = MX3(mxa, s1[2], s1[3]);
#pragma unroll
                    for (int i = 4; i < 16; i += 4) { mxa = MX3(mxa, s0[i], s0[i + 1]); mxb = MX3(mxb, s0[i + 2], s0[i + 3]); mxa = MX3(mxa, s1[i], s1[i + 1]); mxb = MX3(mxb, s1[i + 2], s1[i + 3]); }
#undef MX3
                    float mx = max32(__builtin_fmaxf(mxa, mxb));
                    const bool first = (t == 0 && sub == 0);
                    if (first || __builtin_amdgcn_ballot_w64(mx > 8.0f) != 0ull) {
                        const float d = first ? mx : fmaxf(mx, 0.f);
                        const float alpha = first ? 0.f : ex2(-d);
                        m_run += d; l_run *= alpha;
#pragma unroll
                        for (int i = 0; i < 16; ++i) { o0[i] *= alpha; o1[i] *= alpha; s0[i] -= d; s1[i] -= d; mneg[i] = -m_run; }
                        if (sub == 0) {
#pragma unroll
                            for (int i = 0; i < 16; ++i) { sc[1][0][i] -= d; sc[1][1][i] -= d; }
                        }
                    }
                    f32x2_t psv = {0.f, 0.f};
#pragma unroll
                    for (int i = 0; i < 16; i += 2) { s0[i] = ex2(s0[i]); s0[i + 1] = ex2(s0[i + 1]); s1[i] = ex2(s1[i]); s1[i + 1] = ex2(s1[i + 1]);
                        psv += (f32x2_t){s0[i], s0[i + 1]}; psv += (f32x2_t){s1[i], s1[i + 1]}; }
                    l_run += psv[0] + psv[1];
                    bf16x8 pf[2][2];
#pragma unroll
                    for (int s = 0; s < 2; ++s) {
                        u32x4 w0, w1;
                        w0.x = pk2(s0[8 * s + 0], s0[8 * s + 1]); w0.y = pk2(s0[8 * s + 2], s0[8 * s + 3]); w0.z = pk2(s0[8 * s + 4], s0[8 * s + 5]); w0.w = pk2(s0[8 * s + 6], s0[8 * s + 7]);
                        w1.x = pk2(s1[8 * s + 0], s1[8 * s + 1]); w1.y = pk2(s1[8 * s + 2], s1[8 * s + 3]); w1.z = pk2(s1[8 * s + 4], s1[8 * s + 5]); w1.w = pk2(s1[8 * s + 6], s1[8 * s + 7]);
                        pf[0][s] = __builtin_bit_cast(bf16x8, w0); pf[1][s] = __builtin_bit_cast(bf16x8, w1);
                    }
#pragma unroll
                    for (int n = 0; n < 2; ++n)
#pragma unroll
                        for (int s = 0; s < 2; ++s) {
                            const int ko = (32 * n + 16 * s) * 64;
#pragma unroll
                            for (int db = 0; db < 2; ++db) {
                                const s16x4 lo = __builtin_bit_cast(s16x4, __builtin_amdgcn_ds_read_tr16_b64_v4i16((LAS s16x4*)(ldsL + vb + db * 8192 + ko)));
                                const s16x4 hi = __builtin_bit_cast(s16x4, __builtin_amdgcn_ds_read_tr16_b64_v4i16((LAS s16x4*)(ldsL + vb + db * 8192 + ko + 512)));
                                const bf16x8 vf = {lo[0], lo[1], lo[2], lo[3], hi[0], hi[1], hi[2], hi[3]};
                                if (db == 0) o0 = __builtin_amdgcn_mfma_f32_32x32x16_bf16(vf, pf[n][s], o0, 0, 0, 0);
                                else o1 = __builtin_amdgcn_mfma_f32_32x32x16_bf16(vf, pf[n][s], o1, 0, 0, 0);
                            }
                        }
                }
                {
                    const int nb = (cur ^ 1) * BUFB;
                    *(LAS u32x4*)(ldsL + nb + k_dst) = nk0; *(LAS u32x4*)(ldsL + nb + k_dst + 1024) = nk1;
                    *(LAS u32x4*)(ldsL + nb + v_dst) = nv0; *(LAS u32x4*)(ldsL + nb + v_dst + 4096) = nv1;
                    *(LAS u32x4*)(ldsL + nb + kp_dst) = npr;
                }
                __syncthreads();
            }
            {
                const float lt = sum32(l_run);
                const float inv = 1.0f / lt;
                const int sc = 81920 + wave * 4352;
#pragma unroll
                for (int g = 0; g < 4; ++g) {
                    u32x2 w;
                    w.x = pk2(o0[4 * g] * inv, o0[4 * g + 1] * inv); w.y = pk2(o0[4 * g + 2] * inv, o0[4 * g + 3] * inv);
                    *(LAS u32x2*)(ldsL + sc + r32 * 136 + (8 * g + 4 * hh) * 2) = w;
                    w.x = pk2(o1[4 * g] * inv, o1[4 * g + 1] * inv); w.y = pk2(o1[4 * g + 2] * inv, o1[4 * g + 3] * inv);
                    *(LAS u32x2*)(ldsL + sc + r32 * 136 + (32 + 8 * g + 4 * hh) * 2) = w;
                }
                __syncthreads();
#pragma unroll
                for (int it = 0; it < 8; ++it) {
                    const int row = it * 4 + (lane >> 4), pc = lane & 15;
                    const u32x2 w = *(const LAS u32x2*)(ldsL + sc + row * 136 + pc * 8);
                    *(u32x2*)(W_bout + (tok0 + qblk * 256 + wave * 32 + row) * 512 + h * 64 + pc * 4) = w;
                }
            }
            if ((vblk & 3) == ui) {
#pragma unroll 1
                for (int sl = 0; sl < 4; ++sl) {
                    const int j = sl >> 1; const int uu = blk + j * G;
                    const int e = (G == 256) ? ((vblk & ~1) + j) : (uu >> 1), pn = (G == 256) ? (vblk & 1) : (uu & 1);
                    __syncthreads();
                    if (uu < 512) convert_panel_lds<128, true>(W_scr + (size_t)j * 256 * 1024 + (sl & 1) * 128 * 1024, P.in[(sl & 1) ? I_W3 : I_W1] + (size_t)e * 1024 * 256 + pn * 128, 256, 1024, tid, ldsL);
                }
            }
        }
        for (int ui = 0; ui < ((P.flags & 8) ? 0 : 12); ++ui) {
            TIDS
            const int r32 = lane & 31, hh = lane >> 5;
            const int u = vblk * 12 + ui;
            if (u >= 3072) break;
            const int bh = u / 48, w48 = u % 48, h = bh & 7, b = bh >> 3;
            const int p = w48 >> 4, j16 = w48 & 15;
            const int dil = (p == 0) ? 1 : (p == 1 ? 4 : 16);
            const int res = (p == 0) ? 0 : (p == 1 ? (j16 >> 2) : j16);
            const int m0 = (p == 0) ? j16 * 256 : (p == 1 ? (j16 & 3) * 256 : 0);
            const int L = SEQ / dil;
            const size_t tok0 = (size_t)b * SEQ;
            __syncthreads();
            for (int idx = tid; idx < 672; idx += 512) { const int oi = idx - 255; *(LAS float*)(ldsL + 98304 + idx * 4) = (oi >= 0 && oi <= 128) ? W_biasT[(p * 8 + h) * 129 + oi] : -1e30f; }
            {
                u32x4 kr[6], vr[6];
#pragma unroll
                for (int it = 0; it < 6; ++it) {
                    const int idx = it * 512 + tid, row = idx >> 3, ch = idx & 7;
                    const int mk = m0 - 64 + row;
                    kr[it] = (u32x4){0, 0, 0, 0}; vr[it] = (u32x4){0, 0, 0, 0};
                    if (mk >= 0 && mk < L) {
                        const bf16_t* src = W_proj + (tok0 + (size_t)mk * dil + res) * INCP + 512 + h * 64 + ch * 8;
                        kr[it] = *(const u32x4*)src; vr[it] = *(const u32x4*)(src + 512);
                    }
                }
#pragma unroll
                for (int it = 0; it < 6; ++it) {
                    const int idx = it * 512 + tid, row = idx >> 3, ch = idx & 7;
                    *(LAS u32x4*)(ldsL + ch * 6144 + ((row ^ ch) * 16)) = kr[it];
                    *(LAS u32x4*)(ldsL + 49152 + (ch >> 2) * 24576 + row * 64 + (ch & 3) * 16) = vr[it];
                }
            }
            const int qrel = wave * 32 + r32;
            const size_t tq = tok0 + (size_t)(m0 + qrel) * dil + res;
            bf16x8 qf[4];
#pragma unroll
            for (int d0 = 0; d0 < 4; ++d0) qf[d0] = *(const bf16x8*)(W_proj + tq * INCP + h * 64 + d0 * 16 + hh * 8);
            __syncthreads();
            f32x16 o0 = {}, o1 = {};
            float m_run = -1e20f, l_run = 0.f;
            const int vfo = 49152 + (4 * hh + ((lane & 15) >> 2)) * 64 + ((lane >> 4) & 1) * 32 + (lane & 3) * 8;
#pragma unroll 1
            for (int jj = 0; jj < 3; ++jj) {
                const int jt = (wave >> 1) + jj;
                f32x16 s0 = {}, s1 = {};
#pragma unroll
                for (int d0 = 0; d0 < 4; ++d0) {
                    const int ch = 2 * d0 + hh;
                    const bf16x8 k0 = *(const LAS bf16x8*)(ldsL + ch * 6144 + (((64 * jt + r32) ^ ch) * 16));
                    const bf16x8 k1 = *(const LAS bf16x8*)(ldsL + ch * 6144 + (((64 * jt + 32 + r32) ^ ch) * 16));
                    s0 = __builtin_amdgcn_mfma_f32_32x32x16_bf16(k0, qf[d0], s0, 0, 0, 0);
                    s1 = __builtin_amdgcn_mfma_f32_32x32x16_bf16(k1, qf[d0], s1, 0, 0, 0);
                }
                const LAS float* bl = (const LAS float*)(ldsL + 98304) + (64 * jt - qrel + 4 * hh + 255);
                const int mkb = m0 - 64 + 64 * jt;
                const bool edge = (mkb < 0) || (mkb + 64 > L);
                float mx = -1e30f;
#pragma unroll
                for (int i = 0; i < 16; ++i) {
                    const int cr = (i & 3) + 8 * (i >> 2);
                    s0[i] += bl[cr]; s1[i] += bl[cr + 32];
                    if (edge) {
                        const int mk0 = mkb + cr + 4 * hh;
                        if (mk0 < 0 || mk0 >= L) s0[i] = -1e30f;
                        if (mk0 + 32 < 0 || mk0 + 32 >= L) s1[i] = -1e30f;
                    }
                    mx = fmaxf(mx, fmaxf(s0[i], s1[i]));
                }
                mx = max32(mx);
                const float m_new = fmaxf(m_run, mx);
                const float alpha = ex2(m_run - m_new);
                m_run = m_new;
                float ps = 0.f;
#pragma unroll
                for (int i = 0; i < 16; ++i) { s0[i] = ex2(s0[i] - m_new); s1[i] = ex2(s1[i] - m_new); ps += s0[i] + s1[i]; }
                l_run = l_run * alpha + ps;
#pragma unroll
                for (int i = 0; i < 16; ++i) { o0[i] *= alpha; o1[i] *= alpha; }
                bf16x8 pf[2][2];
#pragma unroll
                for (int s = 0; s < 2; ++s) {
                    u32x4 w0, w1;
                    w0.x = pk2(s0[8 * s + 0], s0[8 * s + 1]); w0.y = pk2(s0[8 * s + 2], s0[8 * s + 3]); w0.z = pk2(s0[8 * s + 4], s0[8 * s + 5]); w0.w = pk2(s0[8 * s + 6], s0[8 * s + 7]);
                    w1.x = pk2(s1[8 * s + 0], s1[8 * s + 1]); w1.y = pk2(s1[8 * s + 2], s1[8 * s + 3]); w1.z = pk2(s1[8 * s + 4], s1[8 * s + 5]); w1.w = pk2(s1[8 * s + 6], s1[8 * s + 7]);
                    pf[0][s] = __builtin_bit_cast(bf16x8, w0); pf[1][s] = __builtin_bit_cast(bf16x8, w1);
                }
#pragma unroll
                for (int n = 0; n < 2; ++n)
#pragma unroll
                    for (int s = 0; s < 2; ++s) {
                        const int ko = (64 * jt + 32 * n + 16 * s) * 64;
#pragma unroll
                        for (int db = 0; db < 2; ++db) {
                            const s16x4 lo = __builtin_bit_cast(s16x4, __builtin_amdgcn_ds_read_tr16_b64_v4i16((LAS s16x4*)(ldsL + vfo + db * 24576 + ko)));
                            const s16x4 hi = __builtin_bit_cast(s16x4, __builtin_amdgcn_ds_read_tr16_b64_v4i16((LAS s16x4*)(ldsL + vfo + db * 24576 + ko + 512)));
                            const bf16x8 vf = {lo[0], lo[1], lo[2], lo[3], hi[0], hi[1], hi[2], hi[3]};
                            if (db == 0) o0 = __builtin_amdgcn_mfma_f32_32x32x16_bf16(vf, pf[n][s], o0, 0, 0, 0);
                            else o1 = __builtin_amdgcn_mfma_f32_32x32x16_bf16(vf, pf[n][s], o1, 0, 0, 0);
                        }
                    }
            }
            __syncthreads();
            {
                const float lt = sum32(l_run);
                const float inv = 1.0f / lt;
                if (hh == 0) W_lsebuf[((size_t)p * NTOK + tq) * 8 + h] = m_run + __log2f(lt);
                const int sc = wave * 4352;
#pragma unroll
                for (int g = 0; g < 4; ++g) {
                    u32x2 w;
                    w.x = pk2(o0[4 * g] * inv, o0[4 * g + 1] * inv); w.y = pk2(o0[4 * g + 2] * inv, o0[4 * g + 3] * inv);
                    *(LAS u32x2*)(ldsL + sc + r32 * 136 + (8 * g + 4 * hh) * 2) = w;
                    w.x = pk2(o1[4 * g] * inv, o1[4 * g + 1] * inv); w.y = pk2(o1[4 * g + 2] * inv, o1[4 * g + 3] * inv);
                    *(LAS u32x2*)(ldsL + sc + r32 * 136 + (32 + 8 * g + 4 * hh) * 2) = w;
                }
                __syncthreads();
#pragma unroll
                for (int it = 0; it < 8; ++it) {
                    const int row = it * 4 + (lane >> 4), pc = lane & 15;
                    const u32x2 w = *(const LAS u32x2*)(ldsL + sc + row * 136 + pc * 8);
                    const size_t tr = tok0 + (size_t)(m0 + wave * 32 + row) * dil + res;
                    *(u32x2*)(W_aparts + ((size_t)p * NTOK + tr) * 512 + h * 64 + pc * 4) = w;
                }
            }
            if ((vblk % 12) == ui) {
#pragma unroll 1
                for (int q = 2; q < 4; ++q) {
                    const int uu = blk + q * G;
                    const int e = (G == 256) ? ((vblk & ~3) + q) : (uu >> 2), pn = (G == 256) ? (vblk & 3) : (uu & 3);
                    __syncthreads();
                    if (uu < 1024) convert_panel_lds<256, true>(W_scr + (size_t)2 * 256 * 1024 + (size_t)q * 256 * 256, P.in[I_W2] + (size_t)e * 256 * 1024 + pn * 256, 1024, 256, tid, ldsL);
                }
            }
        }
    }
    SEAM(4);

    if (IN(5)) {
        TIDS
        const int hd = lane >> 3;
        float nl0, nl1, nl2; u32x4 na0, na1, na2, nbb;
#define P5_LOAD(ROW) do { const size_t r_ = (size_t)(ROW); nl0 = W_lsebuf[((size_t)0 * NTOK + r_) * 8 + hd]; nl1 = W_lsebuf[((size_t)1 * NTOK + r_) * 8 + hd]; nl2 = W_lsebuf[((size_t)2 * NTOK + r_) * 8 + hd]; \
            na0 = *(const u32x4*)(W_aparts + ((size_t)0 * NTOK + r_) * 512 + lane * 8); na1 = *(const u32x4*)(W_aparts + ((size_t)1 * NTOK + r_) * 512 + lane * 8); \
            na2 = *(const u32x4*)(W_aparts + ((size_t)2 * NTOK + r_) * 512 + lane * 8); nbb = *(const u32x4*)(W_bout + r_ * 512 + lane * 8); } while (0)
        P5_LOAD(blk * 8 + wave);
        for (int row = blk * 8 + wave; row < NTOK; row += G * 8) {
            const float ls0 = nl0, ls1 = nl1, ls2 = nl2; const u32x4 a0 = na0, a1 = na1, a2 = na2, bb = nbb;
            if (row + G * 8 < NTOK) P5_LOAD(row + G * 8);
            const float M = fmaxf(ls0, fmaxf(ls1, ls2));
            float w0 = ex2(ls0 - M), w1 = ex2(ls1 - M), w2 = ex2(ls2 - M);
            const float wsn = 1.0f / (w0 + w1 + w2); w0 *= wsn; w1 *= wsn; w2 *= wsn;
            float av[8], bv[8]; float sa = 0.f, sb = 0.f;
#pragma unroll
            for (int j = 0; j < 4; ++j) {
                av[2 * j] = w0 * __uint_as_float(a0[j] << 16) + w1 * __uint_as_float(a1[j] << 16) + w2 * __uint_as_float(a2[j] << 16);
                av[2 * j + 1] = w0 * __uint_as_float(a0[j] & 0xffff0000u) + w1 * __uint_as_float(a1[j] & 0xffff0000u) + w2 * __uint_as_float(a2[j] & 0xffff0000u);
                bv[2 * j] = __uint_as_float(bb[j] << 16); bv[2 * j + 1] = __uint_as_float(bb[j] & 0xffff0000u);
                sa += av[2 * j] * av[2 * j] + av[2 * j + 1] * av[2 * j + 1];
                sb += bv[2 * j] * bv[2 * j] + bv[2 * j + 1] * bv[2 * j + 1];
            }
            sa = wave_sum(sa); sb = wave_sum(sb);
            const float ra = rsqrtf(sa * (1.0f / 512.0f) + EPS), rb = rsqrtf(sb * (1.0f / 512.0f) + EPS);
            u32x4 wa, wb;
            wa.x = pk2(av[0] * ra, av[1] * ra); wa.y = pk2(av[2] * ra, av[3] * ra); wa.z = pk2(av[4] * ra, av[5] * ra); wa.w = pk2(av[6] * ra, av[7] * ra);
            wb.x = pk2(bv[0] * rb, bv[1] * rb); wb.y = pk2(bv[2] * rb, bv[3] * rb); wb.z = pk2(bv[4] * rb, bv[5] * rb); wb.w = pk2(bv[6] * rb, bv[7] * rb);
            *(u32x4*)(W_mixb + (size_t)row * DM + lane * 8) = wa;
            *(u32x4*)(W_mixb + (size_t)row * DM + 512 + lane * 8) = wb;
        }
    }
    SEAM(5);

    if (IN(6)) {
        TIDS
        unsigned vl_[4]; g8_voff_lin(vl_, DM, tid);
        auto nextf = [&](int i, GDesc& d) {
            const int ul = i * 32 + (vblk & 31); if (ul >= 64 || vblk >= 256) return false;
            const int pm = (vblk >> 5) * 16 + (ul >> 2), pn = ul & 3;
            d.Ab = (const char*)(W_mixb + (size_t)pm * 256 * DM); d.Bb = (const char*)(W_WoT + (size_t)pn * 256 * DM);
            d.va0 = vl_[0]; d.va1 = vl_[1]; d.va2 = vl_[2]; d.va3 = vl_[3]; d.i0 = pm; d.i1 = pn; d.i2 = 0; return true;
        };
        auto epi = [&](const f32x4 (&acc)[2][2][4][2], const GDesc& d, int wr, int wc, int fr, int fq) {
            const int pm = d.i0, pn = d.i1;
            const float* gbase = W_mod + ((pm * 256) >> 12) * 6144 + 2048 + pn * 256 + wc * 32 + fq * 8;
            const f32x4 g00 = *(const f32x4*)gbase, g01 = *(const f32x4*)(gbase + 4), g10 = *(const f32x4*)(gbase + 128), g11 = *(const f32x4*)(gbase + 132);
#pragma unroll
            for (int ai = 0; ai < 2; ++ai)
#pragma unroll
                for (int m = 0; m < 4; ++m) {
                    const int row = pm * 256 + ai * 128 + wr * 64 + m * 16 + fr;
                    bf16_t* op = W_xt + (size_t)row * DM + pn * 256 + wc * 32 + fq * 8;
                    { const f32x4 a = g00 * acc[ai][0][m][0], b = g01 * acc[ai][0][m][1]; u32x4 w; PK8(w, a, b); *(u32x4*)op = w; }
                    { const f32x4 a = g10 * acc[ai][1][m][0], b = g11 * acc[ai][1][m][1]; u32x4 w; PK8(w, a, b); *(u32x4*)(op + 128) = w; }
                }
        };
        gemm_stream(ldsL, tid, DM, nextf, epi);
    }
    SEAM(6);

    if (IN(7)) {
        TIDS
        const float* g = P.in[I_N2G];
        u32x2 tn[4]; f32x4 xn[4];
        {
            const size_t r0 = (size_t)(blk * 8 + wave) * DM;
#pragma unroll
            for (int i = 0; i < 4; ++i) { tn[i] = *(const u32x2*)(W_xt + r0 + i * 256 + lane * 4); xn[i] = *(const f32x4*)(W_x + r0 + i * 256 + lane * 4); }
        }
        for (int row = blk * 8 + wave; row < NTOK; row += G * 8) {
            const int b = row >> 12;
            bf16_t* xr = W_xt + (size_t)row * DM;
            f32x4 v[4]; float ss = 0.f;
#pragma unroll
            for (int i = 0; i < 4; ++i) {
                const u32x2 tw = tn[i];
                const f32x4 tv = {__uint_as_float(tw.x << 16), __uint_as_float(tw.x & 0xffff0000u), __uint_as_float(tw.y << 16), __uint_as_float(tw.y & 0xffff0000u)};
                v[i] = tv + xn[i];
            }
            if (row + G * 8 < NTOK) {
                const size_t r1 = (size_t)(row + G * 8) * DM;
#pragma unroll
                for (int i = 0; i < 4; ++i) { tn[i] = *(const u32x2*)(W_xt + r1 + i * 256 + lane * 4); xn[i] = *(const f32x4*)(W_x + r1 + i * 256 + lane * 4); }
            }
#pragma unroll
            for (int i = 0; i < 4; ++i) {
                u32x2 xw; xw.x = pk2(v[i][0], v[i][1]); xw.y = pk2(v[i][2], v[i][3]);
                *(u32x2*)(xr + i * 256 + lane * 4) = xw;
                ss += v[i][0] * v[i][0] + v[i][1] * v[i][1] + v[i][2] * v[i][2] + v[i][3] * v[i][3]; }
            ss = wave_sum(ss);
            const float rinv = rsqrtf(ss * (1.0f / 1024.0f) + EPS);
            const float* mb = W_mod + b * 6144 + 3072;
#pragma unroll
            for (int i = 0; i < 4; ++i) {
                const int c = i * 256 + lane * 4;
                const f32x4 gg = *(const f32x4*)(g + c), sh = *(const f32x4*)(mb + c), sc = *(const f32x4*)(mb + 1024 + c);
                float o[4];
#pragma unroll
                for (int j = 0; j < 4; ++j) o[j] = v[i][j] * rinv * gg[j] * (1.0f + sc[j]) + sh[j];
                u32x2 w; w.x = pk2(o[0], o[1]); w.y = pk2(o[2], o[3]);
                *(u32x2*)(W_hbuf + (size_t)row * DM + c) = w;
            }
        }
    }
    SEAM(7);

    if (IN(8)) {
        {
            TIDS
            unsigned vl_[4]; g8_voff_lin(vl_, DM, tid);
            auto nextf = [&](int i, GDesc& d) {
                const int ul = vblk & 31; if (i > 0 || vblk >= 256) return false;
                const int pm = (vblk >> 5) * 16 + (ul >> 1), pn = ul & 1;
                d.Ab = (const char*)(W_hbuf + (size_t)pm * 256 * DM); d.Bb = (const char*)(W_Ws13T + (size_t)pn * 256 * DM);
                d.va0 = vl_[0]; d.va1 = vl_[1]; d.va2 = vl_[2]; d.va3 = vl_[3]; d.i0 = pm; d.i1 = pn; d.i2 = 0; return true;
            };
            auto epi = [&](const f32x4 (&acc)[2][2][4][2], const GDesc& d, int wr, int wc, int fr, int fq) {
                const int pm = d.i0, pn = d.i1;
#pragma unroll
                for (int ai = 0; ai < 2; ++ai)
#pragma unroll
                    for (int m = 0; m < 4; ++m) {
                        const int r = ai * 128 + wr * 64 + m * 16 + fr;
                        const f32x4 a0 = acc[ai][0][m][0], a1 = acc[ai][0][m][1], b0 = acc[ai][1][m][0], b1 = acc[ai][1][m][1];
                        f32x4 h0, h1;
#pragma unroll
                        for (int j = 0; j < 4; ++j) { h0[j] = siluf(a0[j]) * b0[j]; h1[j] = siluf(a1[j]) * b1[j]; }
                        u32x4 w; PK8(w, h0, h1);
                        *(u32x4*)(W_hdn + (size_t)(NASG + pm * 256 + r) * EFF + pn * 128 + wc * 32 + fq * 8) = w;
                    }
            };
            gemm_stream(ldsL, tid, DM, nextf, epi);
        }
        {
            TIDS
            unsigned vl_[4]; g8_voff_lin(vl_, DM, tid);
            auto nextf = [&](int i, GDesc& d) {
                const int ul = vblk & 31; if (i > 0 || ul < 16 || vblk >= 256) return false;
                const int pm = (vblk >> 5) * 16 + (ul - 16);
                d.Ab = (const char*)(W_hbuf + (size_t)pm * 256 * DM); d.Bb = (const char*)(W_WrT);
                d.va0 = vl_[0]; d.va1 = vl_[1]; d.va2 = vl_[2]; d.va3 = vl_[3]; d.i0 = pm; d.i1 = 0; d.i2 = 0; return true;
            };
            auto epi = [&](const f32x4 (&acc)[2][2][4][2], const GDesc& d, int wr, int wc, int fr, int fq) {
                const int pm = d.i0;
                EPI_FOREACH8(acc, wr, wc, fr, fq, r, c8, v0, v1, {
                    *(f32x4*)(W_logits + (size_t)(pm * 256 + r) * 256 + c8) = v0;
                    *(f32x4*)(W_logits + (size_t)(pm * 256 + r) * 256 + c8 + 4) = v1;
                })
            };
            gemm_stream(ldsL, tid, DM, nextf, epi);
        }
        if ((vblk & 31) < 16) {
            TIDS
#pragma unroll 1
            for (int q = 0; q < 2; ++q) {
                const int uu = blk + q * G;
                const int e = (G == 256) ? ((vblk & ~3) + q) : (uu >> 2), pn = (G == 256) ? (vblk & 3) : (uu & 3);
                __syncthreads();
                if (uu < 1024) convert_panel_lds<256, true>(W_scr + (size_t)2 * 256 * 1024 + (size_t)q * 256 * 256, P.in[I_W2] + (size_t)e * 256 * 1024 + pn * 256, 1024, 256, tid, ldsL);
            }
        }
    }
    SEAM(8);

    if (IN(9)) {
        TIDS
        const float* ebias = P.in[I_EB];
        const f32x4 eb = *(const f32x4*)(ebias + lane * 4);
        f32x4 lgn = *(const f32x4*)(W_logits + (size_t)(blk * 8 + wave) * 256 + lane * 4);
        for (int t = blk * 8 + wave; t < NTOK; t += G * 8) {
            const f32x4 lg = lgn;
            if (t + G * 8 < NTOK) lgn = *(const f32x4*)(W_logits + (size_t)(t + G * 8) * 256 + lane * 4);
            float sc[4], sel[4];
#pragma unroll
            for (int i = 0; i < 4; ++i) { sc[i] = 1.0f / (1.0f + expf(-lg[i])); sel[i] = sc[i] + eb[i]; }
            float a1 = fmaxf(sel[0], sel[1]), a2 = fminf(sel[0], sel[1]);
#pragma unroll
            for (int i = 2; i < 4; ++i) { const float v = sel[i]; a2 = fmaxf(a2, fminf(a1, v)); a1 = fmaxf(a1, v); }
            {
                float b1, b2, n1, n2;
                b1 = dppf(a1, DPP_X1); b2 = dppf(a2, DPP_X1); n1 = fmaxf(a1, b1); n2 = fmaxf(fminf(a1, b1), fmaxf(a2, b2)); a1 = n1; a2 = n2;
                b1 = dppf(a1, DPP_X2); b2 = dppf(a2, DPP_X2); n1 = fmaxf(a1, b1); n2 = fmaxf(fminf(a1, b1), fmaxf(a2, b2)); a1 = n1; a2 = n2;
                b1 = dppf(a1, DPP_HM); b2 = dppf(a2, DPP_HM); n1 = fmaxf(a1, b1); n2 = fmaxf(fminf(a1, b1), fmaxf(a2, b2)); a1 = n1; a2 = n2;
            }
            const float gs = a1 + a2; const int myg = lane >> 3;
            int rank = 0;
#pragma unroll
            for (int g = 0; g < 8; ++g) { const float v = __int_as_float(__builtin_amdgcn_readlane(__float_as_int(gs), g * 8)); rank += (v > gs || (v == gs && g < myg)) ? 1 : 0; }
            const bool gsel = rank < 4;
            unsigned key[4];
#pragma unroll
            for (int i = 0; i < 4; ++i) { const unsigned u = __float_as_uint(sel[i]); const unsigned mono = u ^ ((u >> 31) ? 0xFFFFFFFFu : 0x80000000u);
                key[i] = gsel ? ((mono & 0xFFFFFF00u) | (unsigned)(255 - (lane * 4 + i))) : 0u; }
            int my_e = 0; float my_g = 0.f; float gsum = 0.f;
#pragma unroll
            for (int k = 0; k < 8; ++k) {
                unsigned v = key[0] > key[1] ? key[0] : key[1]; { const unsigned w = key[2] > key[3] ? key[2] : key[3]; v = v > w ? v : w; }
#define UMX(o) do { const unsigned o_ = (unsigned)(o); v = v > o_ ? v : o_; } while (0)
                UMX(dppi((int)v, DPP_X1)); UMX(dppi((int)v, DPP_X2)); UMX(dppi((int)v, DPP_HM)); UMX(dppi((int)v, DPP_RM));
                { auto rv = __builtin_amdgcn_permlane16_swap(v, v, false, false); v = rv[0]; UMX(rv[1]); }
                { auto rv = __builtin_amdgcn_permlane32_swap(v, v, false, false); v = rv[0]; UMX(rv[1]); }
#undef UMX
                v = (unsigned)__builtin_amdgcn_readfirstlane((int)v);
                const int ix = 255 - (int)(v & 255u);
                float myscore = 0.f;
#pragma unroll
                for (int i = 0; i < 4; ++i) if (key[i] == v) { key[i] = 0u; myscore = sc[i]; }
                const float gw = __int_as_float(__builtin_amdgcn_readlane(__float_as_int(myscore), ix >> 2));
                gsum += gw;
                if (lane == k) { my_e = ix; my_g = gw; }
            }
            if (lane < 8) {
                const unsigned rk = atomicAdd(&cntg[my_e * CNT_STRIDE], 1u);
                W_eidx[t * 8 + lane] = my_e; W_gate[t * 8 + lane] = my_g / gsum * 2.5f; W_rnk[t * 8 + lane] = (int)rk;
            }
        }
    }
    SEAM(9);

    if (IN(10)) {
        TIDS
        if (tid < 256) cntL[tid] = (int)__hip_atomic_load(&cntg[tid * CNT_STRIDE], __ATOMIC_RELAXED, __HIP_MEMORY_SCOPE_AGENT);
        __syncthreads();
        if (tid < 256) { int s = 0; for (int j = 0; j < tid; ++j) s += cntL[j]; startL[tid] = s; }
        __syncthreads();
        for (int t = blk * 8 + wave; t < NTOK; t += G * 8) {
            if (lane < 8) {
                const int e = W_eidx[t * 8 + lane];
                const int d = startL[e] + W_rnk[t * 8 + lane];
                W_toks[d] = t; W_wts[d] = W_gate[t * 8 + lane]; W_pos[t * 8 + lane] = d;
            }
        }
    }
    SEAM(10);

    if (IN(11)) {
        TIDS
        __syncthreads();
        if (tid < 256) cntL[tid] = (int)__hip_atomic_load(&cntg[tid * CNT_STRIDE], __ATOMIC_RELAXED, __HIP_MEMORY_SCOPE_AGENT);
        __syncthreads();
        if (tid <= 256) { int sa = 0, tb = 0; for (int j = 0; j < tid; ++j) { sa += cntL[j]; tb += (cntL[j] + 255) >> 8; } startL[tid] = sa; tbL[tid] = tb; }
        __syncthreads();
        const int T1 = 2 * tbL[256];
        const int g0 = (int)(((long)vblk * T1) / G), g1 = (int)(((long)(vblk + 1) * T1) / G);
        for (int c0 = g0; c0 < g1; c0 += 8) {
            TIDS
            const int nch = (g1 - c0) < 8 ? (g1 - c0) : 8;
            __syncthreads();
            if (tid < nch) {
                const int g = c0 + tid; int e = 0;
                for (int j = 1; j < 256; ++j) if (2 * tbL[j] <= g) e = j;
                const int r = g - 2 * tbL[e], nt = tbL[e + 1] - tbL[e];
                itemD[tid * 4 + 0] = e; itemD[tid * 4 + 1] = r / nt; itemD[tid * 4 + 2] = r % nt;
            }
            __syncthreads();
            for (int idx = tid; idx < nch * 256; idx += 512) {
                const int it = idx >> 8, e = itemD[it * 4], ti = itemD[it * 4 + 2];
                const int rr = ti * 256 + (idx & 255); const int sr = startL[e] + (rr < cntL[e] ? rr : 0);
                rowoff[idx] = (unsigned)W_toks[sr] * DM;
            }
            __syncthreads();
            int R0, C0; g8_rc(tid, R0, C0);
            auto nextf = [&](int i, GDesc& d) {
                if (i >= nch) return false;
                const int e = itemD[i * 4], pn = itemD[i * 4 + 1], ti = itemD[i * 4 + 2];
                const int vo = (e & ~1) | pn; const int bo = (G == 256) ? ((vo & 31) * 8 + (vo >> 5)) : vo;
                d.Ab = (const char*)W_hbuf; d.Bb = (const char*)(ws + OFF_SCR + (size_t)bo * SCR_PER_BLK) + (size_t)(e & 1) * 512 * 1024;
                d.va0 = (rowoff[i * 256 + R0] + C0) * 2u; d.va1 = (rowoff[i * 256 + R0 + 64] + C0) * 2u; d.va2 = (rowoff[i * 256 + R0 + 128] + C0) * 2u; d.va3 = (rowoff[i * 256 + R0 + 192] + C0) * 2u;
                const int left = cntL[e] - ti * 256;
                d.i0 = startL[e] + ti * 256; d.i1 = left < 256 ? left : 256; d.i2 = pn; return true;
            };
            auto epi = [&](const f32x4 (&acc)[2][2][4][2], const GDesc& d, int wr, int wc, int fr, int fq) {
                const int rowbase = d.i0, nvalid = d.i1, pn = d.i2;
#pragma unroll
                for (int ai = 0; ai < 2; ++ai)
#pragma unroll
                    for (int m = 0; m < 4; ++m) {
                        const int r = ai * 128 + wr * 64 + m * 16 + fr;
                        if (r < nvalid) {
                            const f32x4 a0 = acc[ai][0][m][0], a1 = acc[ai][0][m][1], b0 = acc[ai][1][m][0], b1 = acc[ai][1][m][1];
                            f32x4 h0, h1;
#pragma unroll
                            for (int j = 0; j < 4; ++j) { h0[j] = siluf(a0[j]) * b0[j]; h1[j] = siluf(a1[j]) * b1[j]; }
                            u32x4 w; PK8(w, h0, h1);
                            *(u32x4*)(W_hdn + (size_t)(rowbase + r) * EFF + pn * 128 + wc * 32 + fq * 8) = w;
                        }
                    }
            };
            gemm_stream(ldsL, tid, DM, nextf, epi);
        }
    }
    SEAM(11);

    if (IN(12)) {
        TIDS
        __syncthreads();
        if (tid < 256) cntL[tid] = (int)__hip_atomic_load(&cntg[tid * CNT_STRIDE], __ATOMIC_RELAXED, __HIP_MEMORY_SCOPE_AGENT);
        if (tid == 256) cntL[256] = NTOK;
        __syncthreads();
        if (tid <= 257) { int sa = 0, tb = 0; for (int j = 0; j < tid; ++j) { sa += cntL[j]; tb += (cntL[j] + 255) >> 8; } if (tid <= 256) startL[tid] = sa; tbL[tid] = tb; }
        __syncthreads();
        const int T2 = 4 * tbL[257];
        const int g0 = (int)(((long)vblk * T2) / G), g1 = (int)(((long)(vblk + 1) * T2) / G);
#define Y_STORE(ROWG, COL0, G_) do { _Pragma("unroll") for (int bj = 0; bj < 2; ++bj) { const f32x4 a_ = acc[ai][bj][m][0], b_ = acc[ai][bj][m][1]; int w0_ = 0, w1_ = 0; \
            w0_ = __builtin_amdgcn_cvt_pk_fp8_f32(a_[0] * (G_), a_[1] * (G_), w0_, false); w0_ = __builtin_amdgcn_cvt_pk_fp8_f32(a_[2] * (G_), a_[3] * (G_), w0_, true); \
            w1_ = __builtin_amdgcn_cvt_pk_fp8_f32(b_[0] * (G_), b_[1] * (G_), w1_, false); w1_ = __builtin_amdgcn_cvt_pk_fp8_f32(b_[2] * (G_), b_[3] * (G_), w1_, true); \
            u32x2 w_; w_.x = (unsigned)w0_; w_.y = (unsigned)w1_; *(u32x2*)(W_y8 + (size_t)(ROWG) * DM + (COL0) + bj * 128 + wc * 32 + fq * 8) = w_; } } while (0)
        for (int c0 = g0; c0 < g1; c0 += 8) {
            TIDS
            const int nch = (g1 - c0) < 8 ? (g1 - c0) : 8;
            __syncthreads();
            if (tid < nch) {
                const int g = c0 + tid; int e = 0;
                for (int j = 1; j < 257; ++j) if (4 * tbL[j] <= g) e = j;
                const int r = g - 4 * tbL[e], nt = tbL[e + 1] - tbL[e];
                itemD[tid * 4 + 0] = e; itemD[tid * 4 + 1] = r / nt; itemD[tid * 4 + 2] = r % nt;
            }
            __syncthreads();
            for (int idx = tid; idx < nch * 256; idx += 512) {
                const int it = idx >> 8, e = itemD[it * 4], ti = itemD[it * 4 + 2];
                const int rr = ti * 256 + (idx & 255); const int sr = startL[e] + (rr < cntL[e] ? rr : 0);
                rowoff[idx] = (unsigned)sr * EFF; rowsc[idx] = (e < 256) ? W_wts[sr] : 1.0f;
            }
            __syncthreads();
            int R0, C0; g8_rc(tid, R0, C0);
            auto nextf = [&](int i, GDesc& d) {
                if (i >= nch) return false;
                const int e = itemD[i * 4], pn = itemD[i * 4 + 1], ti = itemD[i * 4 + 2];
                const int vo = (e & ~3) | pn; const int bo = (G == 256) ? ((vo & 31) * 8 + (vo >> 5)) : vo;
                d.Ab = (const char*)W_hdn;
                d.Bb = (e < 256) ? (const char*)(ws + OFF_SCR + (size_t)bo * SCR_PER_BLK) + (size_t)2 * 512 * 1024 + (size_t)(e & 3) * 128 * 1024 : (const char*)(W_Ws2T + (size_t)pn * 256 * EFF);
                d.va0 = (rowoff[i * 256 + R0] + C0) * 2u; d.va1 = (rowoff[i * 256 + R0 + 64] + C0) * 2u; d.va2 = (rowoff[i * 256 + R0 + 128] + C0) * 2u; d.va3 = (rowoff[i * 256 + R0 + 192] + C0) * 2u;
                const int left = cntL[e] - ti * 256;
                d.i0 = startL[e] + ti * 256; d.i1 = (left < 256 ? left : 256) | (i << 16); d.i2 = pn; return true;
            };
            auto epi = [&](const f32x4 (&acc)[2][2][4][2], const GDesc& d, int wr, int wc, int fr, int fq) {
                const int rowbase = d.i0, nvalid = d.i1 & 0xffff, tl = d.i1 >> 16, pn = d.i2;
#pragma unroll
                for (int ai = 0; ai < 2; ++ai)
#pragma unroll
                    for (int m = 0; m < 4; ++m) {
                        const int r = ai * 128 + wr * 64 + m * 16 + fr;
                        if (r < nvalid) { const float g = rowsc[tl * 256 + r]; Y_STORE(rowbase + r, pn * 256, g); }
                    }
            };
            gemm_stream(ldsL, tid, EFF, nextf, epi);
        }
#undef Y_STORE
    }
    SEAM(12);

    if (IN(13)) {
        TIDS
        const float* fg = P.in[I_FG];
        u32x4 yn[9]; u32x4 xn0, xn1;
#define P13_LOAD(ROW) do { const int row_ = (ROW); _Pragma("unroll") for (int k = 0; k < 9; ++k) { const int pr = (k < 8) ? W_pos[row_ * 8 + k] : (NASG + row_); \
            yn[k] = *(const u32x4*)(W_y8 + (size_t)pr * DM + lane * 16); } \
            const bf16_t* x1r = W_xt + (size_t)row_ * DM + lane * 16; xn0 = *(const u32x4*)x1r; xn1 = *(const u32x4*)(x1r + 8); } while (0)
        P13_LOAD(blk * 8 + wave);
        for (int row = blk * 8 + wave; row < NTOK; row += G * 8) {
            const int b = row >> 12;
            float a[16];
#pragma unroll
            for (int j = 0; j < 16; ++j) a[j] = 0.f;
            u32x4 yc[9];
#pragma unroll
            for (int k = 0; k < 9; ++k) yc[k] = yn[k];
            const u32x4 xw0 = xn0, xw1 = xn1;
            if (row + G * 8 < NTOK) P13_LOAD(row + G * 8);
#pragma unroll
            for (int k = 0; k < 9; ++k) {
                const u32x4 w = yc[k];
#pragma unroll
                for (int q = 0; q < 4; ++q) {
                    a[4 * q + 0] += __builtin_amdgcn_cvt_f32_fp8((int)w[q], 0); a[4 * q + 1] += __builtin_amdgcn_cvt_f32_fp8((int)w[q], 1);
                    a[4 * q + 2] += __builtin_amdgcn_cvt_f32_fp8((int)w[q], 2); a[4 * q + 3] += __builtin_amdgcn_cvt_f32_fp8((int)w[q], 3);
                }
            }
            float* xr = P.out + (size_t)row * DM + lane * 16;
            const float* g2 = W_mod + b * 6144 + 5120 + lane * 16;
            float v[16]; float ss = 0.f;
#pragma unroll
            for (int q = 0; q < 4; ++q) {
                const unsigned wa = (q < 2) ? xw0[2 * q] : xw1[2 * (q - 2)], wb = (q < 2) ? xw0[2 * q + 1] : xw1[2 * (q - 2) + 1];
                const f32x4 xa = {__uint_as_float(wa << 16), __uint_as_float(wa & 0xffff0000u), __uint_as_float(wb << 16), __uint_as_float(wb & 0xffff0000u)};
                const f32x4 ga = *(const f32x4*)(g2 + q * 4);
#pragma unroll
                for (int j = 0; j < 4; ++j) { v[q * 4 + j] = xa[j] + ga[j] * a[q * 4 + j]; ss += v[q * 4 + j] * v[q * 4 + j]; }
            }
            ss = wave_sum(ss);
            const float rinv = rsqrtf(ss * (1.0f / 1024.0f) + EPS);
#pragma unroll
            for (int q = 0; q < 4; ++q) {
                const f32x4 fa = *(const f32x4*)(fg + lane * 16 + q * 4);
                f32x4 oa;
#pragma unroll
                for (int j = 0; j < 4; ++j) oa[j] = v[q * 4 + j] * rinv * fa[j];
                *(f32x4*)(xr + q * 4) = oa;
            }
        }
    }
#ifdef DBG_STOP
    if (IN(14)) {
        TIDS
        const size_t NO = (size_t)NTOK * DM;
        for (size_t i = (size_t)blk * 512 + tid; i < NO; i += (size_t)G * 512) {
            unsigned hsh = 0u;
            const size_t row = i >> 10, c = i & 1023;
#define RB(p, idx) ((unsigned)(p)[(idx)])
#define RF(p, idx) (__float_as_uint((p)[(idx)]))
#if DBG_STOP == 0
            hsh = RB(W_WinT, i % (2304 * 1024)) ^ RB(W_WoT, i % (1024 * 1024)) ^ RB(W_WuqT, i % (768 * 384)) ^ RB(W_WukvT, i % (1024 * 256)) ^ RB(W_Ws13T, i % (512 * 1024)) ^ RB(W_Ws2T, i % (1024 * 256)) ^ RB(W_WrT, i % (256 * 1024))
                ^ RF(W_mod, i % (8 * 6144)) ^ RF(W_ropecs, i % (4096 * 32)) ^ RF(W_biasT, i % (3 * 8 * 129));
#elif DBG_STOP == 1 || DBG_STOP == 7
            hsh = RB(W_hbuf, i);
#elif DBG_STOP == 2
            hsh = RB(W_proj, row * INCP + c) ^ (RB(W_proj, row * INCP + 1024 + c) << 1) ^ (c < 160 ? (RB(W_proj, row * INCP + 2048 + c) << 2) : 0u);
#elif DBG_STOP == 3
            hsh = RB(W_kvb, i) ^ (c < 768 ? (RB(W_qb, row * 768 + c) << 1) : 0u);
#elif DBG_STOP == 4
            if (c < 512) hsh = RB(W_bout, row * 512 + c); else if (DBG_SUB) { const size_t cc = c - 512; hsh = RB(W_aparts, row * 512 + cc) ^ (RB(W_aparts, ((size_t)NTOK + row) * 512 + cc) << 1) ^ (RB(W_aparts, ((size_t)2 * NTOK + row) * 512 + cc) << 2) ^ RF(W_lsebuf, row * 8 + (cc >> 6)) ^ (RF(W_lsebuf, ((size_t)NTOK + row) * 8 + (cc >> 6)) << 1) ^ (RF(W_lsebuf, ((size_t)2 * NTOK + row) * 8 + (cc >> 6)) << 2); }
#elif DBG_STOP == 5
            hsh = RB(W_mixb, i);
#elif DBG_STOP == 6
            hsh = RF(P.out, i);
#elif DBG_STOP == 8
            if (c < 256) hsh = RF(W_logits, row * 256 + c); else if (c < 512) hsh = RB(W_hdn, ((size_t)NASG + row) * EFF + (c - 256));
#elif DBG_STOP == 9
            if (c < 8) hsh = (unsigned)W_eidx[row * 8 + c]; else if (c < 16) hsh = RF(W_gate, row * 8 + (c - 8));
#elif DBG_STOP == 11
            { const int k = (int)(c >> 8); hsh = RB(W_hdn, (size_t)W_pos[row * 8 + k] * EFF + (c & 255)) ^ (RB(W_hdn, (size_t)W_pos[row * 8 + 4 + k] * EFF + (c & 255)) << 1); }
#elif DBG_STOP == 12
            { for (int k = 0; k < 8; ++k) hsh ^= RB(W_ybuf, (size_t)W_pos[row * 8 + k] * DM + c) << (k & 3); hsh ^= RB(W_ybuf, ((size_t)NASG + row) * DM + c); }
#endif
            P.out[i] = (float)(hsh & 0xFu);
        }
    }
#endif
#undef IN
#undef SEAM
}

extern "C" void kernel_launch(void* const* d_in, const int* in_sizes, int n_in, void* d_out, int out_size, void* d_ws, size_t ws_size, hipStream_t stream) {
    static int grid = 0;
    if (grid == 0) {
        if (n_in != 24 || ws_size < WS_END) { fprintf(stderr, "kernel_launch: need 24 inputs and %zu bytes of workspace (got %d, %zu)\n", (size_t)WS_END, n_in, ws_size); grid = -1; return; }
        int dev = 0, cus = 0, per_cu = 0;
        if (hipGetDevice(&dev) != hipSuccess || hipDeviceGetAttribute(&cus, hipDeviceAttributeMultiprocessorCount, dev) != hipSuccess) { grid = -1; return; }
        if (hipFuncSetAttribute((const void*)fwd_kernel, hipFuncAttributeMaxDynamicSharedMemorySize, LDS_BYTES) != hipSuccess) { fprintf(stderr, "kernel_launch: hipFuncSetAttribute failed\n"); grid = -1; return; }
        if (hipOccupancyMaxActiveBlocksPerMultiprocessor(&per_cu, (const void*)fwd_kernel, 512, LDS_BYTES) != hipSuccess || per_cu < 1) { fprintf(stderr, "kernel_launch: occupancy query says %d\n", per_cu); }
        (void)hipGetLastError();
        if (cus < 256) { fprintf(stderr, "kernel_launch: this kernel needs 256 CUs (device reports %d)\n", cus); grid = -1; return; }
        grid = 256;
    }
    if (grid < 0) return;
    (void)hipMemsetAsync((char*)d_ws + OFF_CTL, 0, CTL_BYTES, stream);
    Params p{};
    for (int i = 0; i < 24; ++i) p.in[i] = (const float*)d_in[i];
    p.out = (float*)d_out; p.ws = (unsigned char*)d_ws;
#if MK_N_LAUNCHES == 1
    p.ph_lo = 0; p.ph_hi = NPHASE;
    hipLaunchKernelGGL(fwd_kernel, dim3(grid), dim3(512), LDS_BYTES, stream, p);
#else
#ifdef DBG_STOP
    for (int k = 0; k <= DBG_STOP; ++k) { p.ph_lo = k; p.ph_hi = k + 1; hipLaunchKernelGGL(fwd_kernel, dim3(grid), dim3(512), LDS_BYTES, stream, p); }
    p.ph_lo = 14; p.ph_hi = 15; hipLaunchKernelGGL(fwd_kernel, dim3(grid), dim3(512), LDS_BYTES, stream, p);
#else
#ifndef DBL_MASK
#define DBL_MASK 0u
#endif
#ifndef DBL_FLAGS
#define DBL_FLAGS 0
#endif
    for (int k = 0; k < 14; ++k) { p.ph_lo = k; p.ph_hi = k + 1; hipLaunchKernelGGL(fwd_kernel, dim3(grid), dim3(512), LDS_BYTES, stream, p);
        if ((DBL_MASK >> k) & 1u) { p.flags = DBL_FLAGS; hipLaunchKernelGGL(fwd_kernel, dim3(grid), dim3(512), LDS_BYTES, stream, p); p.flags = 0; } }
#endif
#endif
}
```

```cpp
#include <hip/hip_runtime.h>
#include <stdint.h>
#include <stdio.h>

#ifndef MK_N_LAUNCHES
#define MK_N_LAUNCHES 1
#endif

#define DEVI __device__ __forceinline__
typedef unsigned short bf16_t;
typedef short bf16x8 __attribute__((ext_vector_type(8)));
typedef short s16x4 __attribute__((ext_vector_type(4)));
typedef float f32x4 __attribute__((ext_vector_type(4)));
typedef float f32x16 __attribute__((ext_vector_type(16)));
typedef unsigned u32x4 __attribute__((ext_vector_type(4)));
typedef unsigned u32x2 __attribute__((ext_vector_type(2)));

constexpr int NTOK = 32768, SEQ = 4096, DM = 1024;
constexpr int INC = 2208, INCP = 2304;
constexpr int QLORA = 384, KVLORA = 256;
constexpr int NEXP = 256, EFF = 256;
constexpr int NASG = NTOK * 8;
constexpr int NROWS = NASG + NTOK;
constexpr float EPS = 1e-6f;
constexpr float LOG2E = 1.4426950408889634f;

constexpr size_t MiB = 1u << 20;
constexpr size_t OFF_CTL = 0, CTL_BYTES = 1 * MiB;
constexpr size_t OFF_MOD = 1 * MiB;
constexpr size_t OFF_ROPE = OFF_MOD + 256 * 1024;
constexpr size_t OFF_BIAS = OFF_ROPE + 512 * 1024;
constexpr size_t OFF_WIN = 2 * MiB;
constexpr size_t OFF_WUQ = OFF_WIN + 4608 * 1024;
constexpr size_t OFF_WUKV = OFF_WUQ + 1 * MiB;
constexpr size_t OFF_WO = OFF_WUKV + 512 * 1024;
constexpr size_t OFF_WR = OFF_WO + 2 * MiB;
constexpr size_t OFF_WS13 = OFF_WR + 512 * 1024;
constexpr size_t OFF_WS2 = OFF_WS13 + 1 * MiB;
constexpr size_t OFF_H = 12 * MiB;
constexpr size_t OFF_LOGITS = OFF_H + 64 * MiB;
constexpr size_t OFF_EIDX = OFF_LOGITS + 32 * MiB;
constexpr size_t OFF_GATE = OFF_EIDX + 1 * MiB;
constexpr size_t OFF_RNK = OFF_GATE + 1 * MiB;
constexpr size_t OFF_POS = OFF_RNK + 1 * MiB;
constexpr size_t OFF_TOKS = OFF_POS + 1 * MiB;
constexpr size_t OFF_WTS = OFF_TOKS + 1 * MiB;
constexpr size_t OFF_SSQ = OFF_WTS + 1 * MiB;
constexpr size_t OFF_SCR = OFF_SSQ + 4 * MiB;
constexpr size_t SCR_PER_BLK = 1536 * 1024;
constexpr size_t OFF_R = OFF_SCR + 384 * MiB;
constexpr size_t OFF_XT = OFF_R + 452 * MiB;
constexpr size_t WS_END = OFF_XT + 64 * MiB;
constexpr size_t OFF_PROJ = OFF_R;
constexpr size_t OFF_QB = OFF_PROJ + 144 * MiB;
constexpr size_t OFF_KVB = OFF_QB + 48 * MiB;
constexpr size_t OFF_BOUT = OFF_KVB + 64 * MiB;
constexpr size_t OFF_APARTS = OFF_BOUT + 32 * MiB;
constexpr size_t OFF_LSE = OFF_APARTS + 96 * MiB;
constexpr size_t OFF_MIX = OFF_LSE + 4 * MiB;
constexpr size_t OFF_Y = OFF_R;
constexpr size_t OFF_HDN = OFF_R + 288 * MiB;
static_assert(OFF_MIX + 64 * MiB <= WS_END, "alias map");
constexpr int CNT_WORD0 = 8192, CNT_STRIDE = 16;

constexpr int LDS_STAGE = 0;
constexpr int LDS_ROWOFF = 131072;
constexpr int LDS_ROWSC = LDS_ROWOFF + 8192;
constexpr int LDS_MISC = LDS_ROWSC + 8192;
constexpr int LDS_START = LDS_MISC + 256;
constexpr int LDS_CNT = LDS_START + 1280;
constexpr int LDS_TB = LDS_CNT + 1280;
constexpr int LDS_BYTES = 155648;
static_assert(LDS_TB + 1280 <= LDS_BYTES, "lds map");

#define XB_TMO      128
#define XB_XCNT(j)  (256  + 64 * (j))
#define XB_XSUB(j)  (1280 + 64 * (j))
#define XB_XGEN(j)  (2304 + 64 * (j))
#define XB_TOP      3328
#define XB_TOPGEN   3392
#define XCD_BAR_WORDS 3456
#define XB_SPIN_CAP (1u << 22)
#define LAS __attribute__((address_space(3)))

__device__ __forceinline__ unsigned xb_ld(unsigned* p)              { return __hip_atomic_load(p, __ATOMIC_RELAXED, __HIP_MEMORY_SCOPE_AGENT); }
__device__ __forceinline__ unsigned xb_add(unsigned* p, unsigned v) { return __hip_atomic_fetch_add(p, v, __ATOMIC_RELAXED, __HIP_MEMORY_SCOPE_AGENT); }
__device__ __forceinline__ unsigned xb_xcc_id() { return (unsigned)__builtin_amdgcn_s_getreg((3 << 11) | 20) & 0xFu; }
#define XB_SPIN(cond, bar) do { unsigned _sp = 0; while (cond) { __builtin_amdgcn_s_sleep(1); \
    if ((++_sp & 255u) == 0u) { if (xb_ld(&(bar)[XB_TMO])) break; if (_sp > XB_SPIN_CAP) { atomicAdd(&(bar)[XB_TMO], 1u); break; } } } } while (0)

struct XcdBarrier { unsigned* bar; unsigned x; volatile LAS unsigned* st; };

__device__ __forceinline__ XcdBarrier xcd_barrier_post(unsigned* bar, volatile LAS unsigned* st, const bool leader) {
    XcdBarrier b; b.bar = bar; b.x = xb_xcc_id(); b.st = st;
    if (leader) (void)xb_add(&bar[XB_XCNT(b.x)], 1u);
    return b;
}
__device__ __forceinline__ void xcd_barrier_complete(unsigned* bar, unsigned x, unsigned& nloc, unsigned& nx) {
    const unsigned G = gridDim.x * gridDim.y * gridDim.z;
    unsigned sum, cnt, mine, sp = 0u;
    for (;;) {
        sum = 0u; cnt = 0u; mine = 0u;
#pragma unroll
        for (unsigned j = 0; j < 16; ++j) { const unsigned c = xb_ld(&bar[XB_XCNT(j)]); sum += c; cnt += (c > 0u) ? 1u : 0u; mine = (j == x) ? c : mine; }
        if (sum == G) break;
        __builtin_amdgcn_s_sleep(1);
        if ((++sp & 255u) == 0u) { if (xb_ld(&bar[XB_TMO])) break; if (sp > XB_SPIN_CAP) { atomicAdd(&bar[XB_TMO], 1u); break; } }
    }
    nloc = mine > 0u ? mine : 1u; nx = cnt > 0u ? cnt : 1u;
}
__device__ __forceinline__ void xcd_barrier(const XcdBarrier& b, const bool leader) {
    asm volatile("s_waitcnt vmcnt(0)" ::: "memory");
    __syncthreads();
    if (leader) {
        unsigned* bar = b.bar;
        __builtin_amdgcn_s_waitcnt(0);
        unsigned nloc = b.st[0], nx = b.st[1];
        if (nloc == 0u) { xcd_barrier_complete(bar, b.x, nloc, nx); b.st[0] = nloc; b.st[1] = nx; }
        const unsigned old = xb_add(&bar[XB_XSUB(b.x)], 1u);
        const unsigned gen = old / nloc;
        if (old + 1u == (gen + 1u) * nloc) {
            __builtin_amdgcn_fence(__ATOMIC_RELEASE, "agent");
            asm volatile("s_waitcnt vmcnt(0)" ::: "memory");
            const unsigned og = xb_add(&bar[XB_TOP], 1u);
            const unsigned tg = og / nx;
            if (og + 1u == (tg + 1u) * nx) xb_add(&bar[XB_TOPGEN], 1u);
            else XB_SPIN(xb_ld(&bar[XB_TOPGEN]) == tg, bar);
            __builtin_amdgcn_fence(__ATOMIC_ACQUIRE, "agent");
            xb_add(&bar[XB_XGEN(b.x)], 1u);
            asm volatile("s_waitcnt vmcnt(0)" ::: "memory");
        } else {
            XB_SPIN(xb_ld(&bar[XB_XGEN(b.x)]) == gen, bar);
            __builtin_amdgcn_fence(__ATOMIC_ACQUIRE, "agent");
            asm volatile("s_waitcnt vmcnt(0)" ::: "memory");
        }
    }
    __syncthreads();
}

DEVI float bf2f(bf16_t v) { return __uint_as_float(((unsigned)v) << 16); }
typedef float f32x2_t __attribute__((ext_vector_type(2)));
typedef __bf16 bf16x2_t __attribute__((ext_vector_type(2)));
DEVI unsigned pk2(float lo, float hi) { f32x2_t v = {lo, hi}; bf16x2_t b = __builtin_convertvector(v, bf16x2_t); return __builtin_bit_cast(unsigned, b); }
#define dppf(v, ctrl) __int_as_float(__builtin_amdgcn_update_dpp(0, __float_as_int(v), (ctrl), 0xf, 0xf, false))
#define dppi(v, ctrl) __builtin_amdgcn_update_dpp(0, (v), (ctrl), 0xf, 0xf, false)
#define DPP_X1 0xB1
#define DPP_X2 0x4E
#define DPP_HM 0x141
#define DPP_RM 0x140
DEVI float x16f(float v, float& o) { auto r = __builtin_amdgcn_permlane16_swap(__float_as_uint(v), __float_as_uint(v), false, false); o = __uint_as_float(r[1]); return __uint_as_float(r[0]); }
DEVI float x32f(float v, float& o) { auto r = __builtin_amdgcn_permlane32_swap(__float_as_uint(v), __float_as_uint(v), false, false); o = __uint_as_float(r[1]); return __uint_as_float(r[0]); }
DEVI float sum32(float v) { float o; const float a = x32f(v, o); return a + o; }
DEVI float max32(float v) { float o; const float a = x32f(v, o); return fmaxf(a, o); }
DEVI float wave_sum(float v) {
    v += dppf(v, DPP_X1); v += dppf(v, DPP_X2); v += dppf(v, DPP_HM); v += dppf(v, DPP_RM);
    { float o; const float a = x16f(v, o); v = a + o; }
    { float o; const float a = x32f(v, o); v = a + o; }
    return v;
}
DEVI int perm_slot(int cl) { return 16 * ((cl >> 2) & 1) + 4 * (cl >> 3) + (cl & 3); }
DEVI int perm_row(int n) { return (n & ~31) + perm_slot(n & 31); }
DEVI float ex2(float x) { return __builtin_amdgcn_exp2f(x); }
DEVI float siluf(float v) { return v * __builtin_amdgcn_rcpf(1.0f + __expf(-v)); }

namespace g8 {
constexpr int BK = 64, HALF = 128, HT = HALF * BK;
DEVI int lds_byte(int r, int c) { int st = (r >> 4) * 2 + (c >> 5), rr = r & 15, cc = c & 31, ob = rr * 64 + cc * 2; return st * 1024 + (ob ^ (((ob >> 9) & 1) << 5)); }
DEVI void stage_rc(int b, int& R, int& C) { int st = b / 1024, sb = b % 1024, swz = sb ^ (((sb >> 9) & 1) << 5); R = (st >> 1) * 16 + swz / 64; C = (st & 1) * 32 + (swz % 64) / 2; }
}

DEVI void g8_rc(int tid, int& R0, int& C0) { g8::stage_rc(tid * 16, R0, C0); }
DEVI void g8_voff_lin(unsigned (&v)[4], int ld, int tid) { int R0, C0; g8_rc(tid, R0, C0);
    v[0] = (unsigned)(R0 * ld + C0) * 2u; v[1] = (unsigned)((R0 + 64) * ld + C0) * 2u; v[2] = (unsigned)((R0 + 128) * ld + C0) * 2u; v[3] = (unsigned)((R0 + 192) * ld + C0) * 2u; }
DEVI void g8_voff_tab(unsigned (&v)[4], const LAS unsigned* tab, int tid) { int R0, C0; g8_rc(tid, R0, C0);
    v[0] = (tab[R0] + C0) * 2u; v[1] = (tab[R0 + 64] + C0) * 2u; v[2] = (tab[R0 + 128] + C0) * 2u; v[3] = (tab[R0 + 192] + C0) * 2u; }

template <class Epi>
DEVI void gemm_tile(LAS unsigned char* lds, const int tid_in, const char* Ab, const unsigned (&voffA_)[4], const char* Bb, const int K, const Epi& epi) {
    using namespace g8;
    constexpr int HTB = HALF * BK * 2;
    int tz = tid_in; asm volatile("" : "+v"(tz));
    int wid = tz >> 6, lane = tz & 63, wr = wid >> 2, wc = wid & 3, fr = lane & 15, fq = lane >> 4;
    unsigned voffA[4] = {voffA_[0], voffA_[1], voffA_[2], voffA_[3]};
    asm volatile("" : "+v"(voffA[0]), "+v"(voffA[1]), "+v"(voffA[2]), "+v"(voffA[3]));
    unsigned voffB[2];
    { int R0, C0; stage_rc(tz * 16, R0, C0); voffB[0] = (unsigned)(R0 * K + C0) * 2u; voffB[1] = (unsigned)((R0 + 64) * K + C0) * 2u; }
    const size_t kstep = (size_t)(BK * 2);
    const size_t hstepB = (size_t)HALF * K * 2;
    const unsigned ldsw = (unsigned)wid * 1024u;
    const int aoff = lds_byte(wr * 64 + fr, fq * 8), boff = lds_byte(wc * 32 + fr, fq * 8);
#define G8_SA(b, h) (((b) * 2 + (h)) * HTB)
#define G8_SB(b, h) ((4 + (b) * 2 + (h)) * HTB)
#define G8_GL(gp, lofs) __builtin_amdgcn_global_load_lds((const unsigned*)(gp), (LAS unsigned*)(lds + (lofs)), 16, 0, 0)
#define STAGE_A(b, h, kt) do { const char* g_ = Ab + (size_t)(kt) * kstep; G8_GL(g_ + voffA[(h) * 2], G8_SA(b, h) + ldsw); G8_GL(g_ + voffA[(h) * 2 + 1], G8_SA(b, h) + ldsw + 8192); } while (0)
#define STAGE_B(b, h, kt) do { const char* g_ = Bb + (size_t)(kt) * kstep + ((h) ? hstepB : 0); G8_GL(g_ + voffB[0], G8_SB(b, h) + ldsw); G8_GL(g_ + voffB[1], G8_SB(b, h) + ldsw + 8192); } while (0)
#define LDA(dst, b, h) do { _Pragma("unroll") for (int m = 0; m < 4; ++m) _Pragma("unroll") for (int k = 0; k < 2; ++k) dst[m][k] = *(const LAS bf16x8*)(lds + G8_SA(b, h) + aoff + m * 2048 + k * 1024); } while (0)
#define LDB(dst, b, h) do { _Pragma("unroll") for (int n = 0; n < 2; ++n) _Pragma("unroll") for (int k = 0; k < 2; ++k) dst[n][k] = *(const LAS bf16x8*)(lds + G8_SB(b, h) + boff + n * 2048 + k * 1024); } while (0)
#define MMA(ai, bj, Af, Bf) do { __builtin_amdgcn_s_setprio(1); \
    _Pragma("unroll") for (int m = 0; m < 4; ++m) _Pragma("unroll") for (int n = 0; n < 2; ++n) _Pragma("unroll") for (int k = 0; k < 2; ++k) \
      acc[ai][bj][m][n] = __builtin_amdgcn_mfma_f32_16x16x32_bf16(Bf[n][k], Af[m][k], acc[ai][bj][m][n], 0, 0, 0); \
    __builtin_amdgcn_s_setprio(0); } while (0)
#define WAIT_V(n) asm volatile("s_waitcnt vmcnt(" #n ")" ::: "memory")
#define WAIT_L(n) asm volatile("s_waitcnt lgkmcnt(" #n ")" ::: "memory")
#define BAR __builtin_amdgcn_s_barrier()
#define SCHED __builtin_amdgcn_sched_barrier(0)
    f32x4 acc[2][2][4][2];
#pragma unroll
    for (int a = 0; a < 2; ++a)
#pragma unroll
        for (int b = 0; b < 2; ++b)
#pragma unroll
            for (int m = 0; m < 4; ++m)
#pragma unroll
                for (int n = 0; n < 2; ++n) acc[a][b][m][n] = (f32x4){0.f, 0.f, 0.f, 0.f};
    bf16x8 At[4][2], B0[2][2], B1[2][2];
    const int nt = K / BK;
    STAGE_B(0, 0, 0); STAGE_A(0, 0, 0); STAGE_B(0, 1, 0); STAGE_A(0, 1, 0);
    if (wr == 1) BAR;
    WAIT_V(4); BAR;
    STAGE_B(1, 0, 1); STAGE_A(1, 0, 1); STAGE_B(1, 1, 1);
    WAIT_V(6); BAR;
#pragma unroll 1
    for (int t = 0; t < nt; t += 2) {
        const int t2 = (t == nt - 2) ? 0 : t + 2;
        const int t3 = t2 + 1;
        LDB(B0, 0, 0); SCHED; LDA(At, 0, 0); STAGE_A(1, 1, t + 1);
        WAIT_L(8); BAR; WAIT_L(0); MMA(0, 0, At, B0); BAR; SCHED;
        LDB(B1, 0, 1); STAGE_B(0, 0, t2);
        BAR; WAIT_L(0); MMA(0, 1, At, B1); BAR;
        LDA(At, 0, 1); STAGE_A(0, 0, t2);
        BAR; WAIT_L(0); MMA(1, 0, At, B0); BAR; SCHED;
        STAGE_B(0, 1, t2);
        WAIT_V(6); BAR; MMA(1, 1, At, B1); BAR;
        LDB(B0, 1, 0); SCHED; LDA(At, 1, 0); STAGE_A(0, 1, t2);
        WAIT_L(8); BAR; WAIT_L(0); MMA(0, 0, At, B0); BAR; SCHED;
        LDB(B1, 1, 1); STAGE_B(1, 0, t3);
        BAR; WAIT_L(0); MMA(0, 1, At, B1); BAR;
        LDA(At, 1, 1); STAGE_A(1, 0, t3);
        BAR; WAIT_L(0); MMA(1, 0, At, B0); BAR; SCHED;
        STAGE_B(1, 1, t3);
        WAIT_V(6); BAR; MMA(1, 1, At, B1); BAR;
    }
    WAIT_V(0);
    if (wr == 0) BAR;
    BAR;
    asm volatile("" : "+v"(tz)); wid = tz >> 6; lane = tz & 63; wr = wid >> 2; wc = wid & 3; fr = lane & 15; fq = lane >> 4;
    epi(acc, wr, wc, fr, fq);
#undef G8_SA
#undef G8_SB
#undef G8_GL
#undef STAGE_A
#undef STAGE_B
#undef LDA
#undef LDB
#undef MMA
}
struct GDesc { const char* Ab; const char* Bb; unsigned va0, va1, va2, va3; int i0, i1, i2; };
template <class Next, class Epi>
DEVI void gemm_stream(LAS unsigned char* lds, const int tid_in, const int K, Next& next, const Epi& epi) {
    using namespace g8;
    constexpr int HTB = HALF * BK * 2;
    int tz = tid_in; asm volatile("" : "+v"(tz));
    int wid = tz >> 6, lane = tz & 63, wr = wid >> 2, wc = wid & 3, fr = lane & 15, fq = lane >> 4;
    unsigned voffB[2];
    { int R0, C0; stage_rc(tz * 16, R0, C0); voffB[0] = (unsigned)(R0 * K + C0) * 2u; voffB[1] = (unsigned)((R0 + 64) * K + C0) * 2u; }
    const size_t kstep = (size_t)(BK * 2);
    const size_t hstepB = (size_t)HALF * K * 2;
    const unsigned ldsw = (unsigned)wid * 1024u;
    const int aoff = lds_byte(wr * 64 + fr, fq * 8), boff = lds_byte(wc * 32 + fr, fq * 8);
#define G8_SA(b, h) (((b) * 2 + (h)) * HTB)
#define G8_SB(b, h) ((4 + (b) * 2 + (h)) * HTB)
#define G8_GL(gp, lofs) __builtin_amdgcn_global_load_lds((const unsigned*)(gp), (LAS unsigned*)(lds + (lofs)), 16, 0, 0)
#define STG_A(b, h, gb, v0, v1) do { G8_GL((gb) + (v0), G8_SA(b, h) + ldsw); G8_GL((gb) + (v1), G8_SA(b, h) + ldsw + 8192); } while (0)
#define STG_B(b, h, gb) do { const char* g_ = (gb) + ((h) ? hstepB : 0); G8_GL(g_ + voffB[0], G8_SB(b, h) + ldsw); G8_GL(g_ + voffB[1], G8_SB(b, h) + ldsw + 8192); } while (0)
#define LDA(dst, b, h) do { _Pragma("unroll") for (int m = 0; m < 4; ++m) _Pragma("unroll") for (int k = 0; k < 2; ++k) dst[m][k] = *(const LAS bf16x8*)(lds + G8_SA(b, h) + aoff + m * 2048 + k * 1024); } while (0)
#define LDB(dst, b, h) do { _Pragma("unroll") for (int n = 0; n < 2; ++n) _Pragma("unroll") for (int k = 0; k < 2; ++k) dst[n][k] = *(const LAS bf16x8*)(lds + G8_SB(b, h) + boff + n * 2048 + k * 1024); } while (0)
#define MMA(ai, bj, Af, Bf) do { __builtin_amdgcn_s_setprio(1); \
    _Pragma("unroll") for (int m = 0; m < 4; ++m) _Pragma("unroll") for (int n = 0; n < 2; ++n) _Pragma("unroll") for (int k = 0; k < 2; ++k) \
      acc[ai][bj][m][n] = __builtin_amdgcn_mfma_f32_16x16x32_bf16(Bf[n][k], Af[m][k], acc[ai][bj][m][n], 0, 0, 0); \
    __builtin_amdgcn_s_setprio(0); } while (0)
#define ZACC() do { _Pragma("unroll") for (int a = 0; a < 2; ++a) _Pragma("unroll") for (int b = 0; b < 2; ++b) _Pragma("unroll") for (int m = 0; m < 4; ++m) _Pragma("unroll") for (int n = 0; n < 2; ++n) acc[a][b][m][n] = (f32x4){0.f, 0.f, 0.f, 0.f}; } while (0)
    GDesc cur, nxt;
    if (!next(0, cur)) return;
    nxt = cur;
    f32x4 acc[2][2][4][2];
    ZACC();
    bf16x8 At[4][2], B0[2][2], B1[2][2];
    const int nt = K / BK;
    STG_B(0, 0, cur.Bb); STG_A(0, 0, cur.Ab, cur.va0, cur.va1); STG_B(0, 1, cur.Bb); STG_A(0, 1, cur.Ab, cur.va2, cur.va3);
    if (wr == 1) BAR;
    WAIT_V(4); BAR;
    STG_B(1, 0, cur.Bb + kstep); STG_A(1, 0, cur.Ab + kstep, cur.va0, cur.va1); STG_B(1, 1, cur.Bb + kstep);
    WAIT_V(6); BAR;
    int ui = 0; bool has_next = false;
#pragma unroll 1
    for (;;) {
#pragma unroll 1
        for (int t = 0; t < nt; t += 2) {
            const bool last = (t == nt - 2);
            if (last) { has_next = next(ui + 1, nxt); if (!has_next) nxt = cur; }
            const char* a2 = last ? nxt.Ab : cur.Ab + (size_t)(t + 2) * kstep;
            const char* b2 = last ? nxt.Bb : cur.Bb + (size_t)(t + 2) * kstep;
            const unsigned s0 = last ? nxt.va0 : cur.va0, s1 = last ? nxt.va1 : cur.va1, s2 = last ? nxt.va2 : cur.va2, s3 = last ? nxt.va3 : cur.va3;
            LDB(B0, 0, 0); SCHED; LDA(At, 0, 0); STG_A(1, 1, cur.Ab + (size_t)(t + 1) * kstep, cur.va2, cur.va3);
            WAIT_L(8); BAR; WAIT_L(0); MMA(0, 0, At, B0); BAR; SCHED;
            LDB(B1, 0, 1); STG_B(0, 0, b2);
            BAR; WAIT_L(0); MMA(0, 1, At, B1); BAR;
            LDA(At, 0, 1); STG_A(0, 0, a2, s0, s1);
            BAR; WAIT_L(0); MMA(1, 0, At, B0); BAR; SCHED;
            STG_B(0, 1, b2);
            WAIT_V(6); BAR; MMA(1, 1, At, B1); BAR;
            LDB(B0, 1, 0); SCHED; LDA(At, 1, 0); STG_A(0, 1, a2, s2, s3);
            WAIT_L(8); BAR; WAIT_L(0); MMA(0, 0, At, B0); BAR; SCHED;
            LDB(B1, 1, 1); STG_B(1, 0, b2 + kstep);
            BAR; WAIT_L(0); MMA(0, 1, At, B1); BAR;
            LDA(At, 1, 1); STG_A(1, 0, a2 + kstep, s0, s1);
            BAR; WAIT_L(0); MMA(1, 0, At, B0); BAR; SCHED;
            STG_B(1, 1, b2 + kstep);
            WAIT_V(6); BAR; MMA(1, 1, At, B1); BAR;
        }
        {
            int tq = tz; asm volatile("" : "+v"(tq));
            const int wid_ = tq >> 6, lane_ = tq & 63;
            epi(acc, cur, wid_ >> 2, wid_ & 3, lane_ & 15, lane_ >> 4);
        }
        if (!has_next) break;
        ZACC();
        cur = nxt; ++ui;
    }
    WAIT_V(0);
    if (wr == 0) BAR;
    BAR;
#undef G8_SA
#undef G8_SB
#undef G8_GL
#undef STG_A
#undef STG_B
#undef LDA
#undef LDB
#undef MMA
#undef ZACC
}
#define EPI_FOREACH8(acc, wr, wc, fr, fq, ROW, COL8, V0, V1, ...) \
    _Pragma("unroll") for (int ai_ = 0; ai_ < 2; ++ai_) _Pragma("unroll") for (int m_ = 0; m_ < 4; ++m_) { const int ROW = ai_ * 128 + (wr) * 64 + m_ * 16 + (fr); \
    _Pragma("unroll") for (int bj_ = 0; bj_ < 2; ++bj_) { const int COL8 = bj_ * 128 + (wc) * 32 + (fq) * 8; const f32x4 V0 = acc[ai_][bj_][m_][0]; const f32x4 V1 = acc[ai_][bj_][m_][1]; __VA_ARGS__ } }
#define PK8(w, a, b) do { w.x = pk2(a[0], a[1]); w.y = pk2(a[2], a[3]); w.z = pk2(b[0], b[1]); w.w = pk2(b[2], b[3]); } while (0)

template <class SCol, class DRow, class KS, class NS>
DEVI void convert_T(bf16_t* __restrict__ dst, const float* __restrict__ src, int ld, int K, int NR, SCol scol, DRow drow, KS ks, NS ns, int wi, int nw) {
    const int k8n = K >> 3; const int items = NR * k8n;
    for (int it = wi; it < items; it += nw) {
        const int n = it % NR, k0 = (it / NR) << 3;
        const int sc = scol(n);
        float v[8];
#pragma unroll
        for (int j = 0; j < 8; ++j) v[j] = (sc >= 0) ? src[(size_t)(k0 + j) * ld + sc] * ks(k0 + j) : 0.f;
        const float s = ns(n);
        u32x4 w; w.x = pk2(v[0] * s, v[1] * s); w.y = pk2(v[2] * s, v[3] * s); w.z = pk2(v[4] * s, v[5] * s); w.w = pk2(v[6] * s, v[7] * s);
        *(u32x4*)(dst + (size_t)drow(n) * K + k0) = w;
    }
}
struct IdCol { DEVI int operator()(int n) const { return n; } };
struct OneK { DEVI float operator()(int) const { return 1.f; } };
struct VecK { const float* g; DEVI float operator()(int k) const { return g[k]; } };

template <int NB, bool PERM>
DEVI void convert_panel(bf16_t* __restrict__ dst, const float* __restrict__ src, const int ld, const int K, const int tid) {
    constexpr int N4 = NB / 4;
    const int items = (K >> 3) * N4;
#pragma unroll 1
    for (int it0 = tid; it0 < items; it0 += 1024) {
        f32x4 v[2][8];
#pragma unroll
        for (int u = 0; u < 2; ++u) {
            const int it = it0 + u * 512; const int n4 = it % N4, k8 = it / N4;
            const float* sp = src + (size_t)(k8 * 8) * ld + n4 * 4;
#pragma unroll
            for (int j = 0; j < 8; ++j) v[u][j] = *(const f32x4*)(sp + (size_t)j * ld);
        }
#pragma unroll
        for (int u = 0; u < 2; ++u) {
            const int it = it0 + u * 512; const int n4 = it % N4, k8 = it / N4;
#pragma unroll
            for (int c = 0; c < 4; ++c) {
                u32x4 w; w.x = pk2(v[u][0][c], v[u][1][c]); w.y = pk2(v[u][2][c], v[u][3][c]); w.z = pk2(v[u][4][c], v[u][5][c]); w.w = pk2(v[u][6][c], v[u][7][c]);
                const int n = n4 * 4 + c; const int dr = PERM ? ((n & ~31) + perm_slot(n & 31)) : n;
                *(u32x4*)(dst + (size_t)dr * K + k8 * 8) = w;
            }
        }
    }
}

template <int NB, bool PERM>
DEVI void convert_panel_lds(bf16_t* __restrict__ dst, const float* __restrict__ src, const int ld, const int K, const int tid, LAS unsigned char* lds) {
    constexpr int N4 = NB / 4;
    constexpr int K8C = 512 / N4;
    constexpr int KC = K8C * 8;
    constexpr int PITCH = KC * 2 + 8;
    constexpr int PPR = KC / 8;
    const int n4 = tid % N4, k8 = tid / N4;
    const float* sp = src + (size_t)(k8 * 8) * ld + n4 * 4;
    const int nchunk = K / KC;
    f32x4 va[8], vb[8], vc[8];
#define CPL_LOAD(V, c) do { const float* q_ = sp + (size_t)(c) * KC * ld; _Pragma("unroll") for (int j = 0; j < 8; ++j) V[j] = *(const f32x4*)(q_ + (size_t)j * ld); } while (0)
#define CPL_PROC(V, c) do { \
        _Pragma("unroll") for (int cc = 0; cc < 4; ++cc) { \
            u32x2 lo, hi; lo.x = pk2(V[0][cc], V[1][cc]); lo.y = pk2(V[2][cc], V[3][cc]); hi.x = pk2(V[4][cc], V[5][cc]); hi.y = pk2(V[6][cc], V[7][cc]); \
            LAS unsigned char* wp = lds + (n4 * 4 + cc) * PITCH + k8 * 16; \
            *(LAS u32x2*)wp = lo; *(LAS u32x2*)(wp + 8) = hi; } \
        __syncthreads(); \
        _Pragma("unroll") for (int q = 0; q < 4; ++q) { \
            const int p = tid + 512 * q; const int row = p / PPR, pc = p % PPR; \
            const LAS unsigned char* rp = lds + row * PITCH + pc * 16; \
            const u32x2 a = *(const LAS u32x2*)rp, b = *(const LAS u32x2*)(rp + 8); \
            const int dr = PERM ? ((row & ~31) + perm_slot(row & 31)) : row; \
            u32x4 w; w.x = a.x; w.y = a.y; w.z = b.x; w.w = b.y; \
            *(u32x4*)(dst + (size_t)dr * K + (c) * KC + pc * 8) = w; } \
        __syncthreads(); } while (0)
    CPL_LOAD(va, 0); if (nchunk > 1) CPL_LOAD(vb, 1); if (nchunk > 2) CPL_LOAD(vc, 2);
#pragma unroll 1
    for (int c = 0; c < nchunk; c += 3) {
        CPL_PROC(va, c); if (c + 3 < nchunk) CPL_LOAD(va, c + 3);
        if (c + 1 < nchunk) { CPL_PROC(vb, c + 1); if (c + 4 < nchunk) CPL_LOAD(vb, c + 4); }
        if (c + 2 < nchunk) { CPL_PROC(vc, c + 2); if (c + 5 < nchunk) CPL_LOAD(vc, c + 5); }
    }
#undef CPL_LOAD
#undef CPL_PROC
}

struct Params {
    const float* in[24];
    float* out;
    unsigned char* ws;
    int ph_lo, ph_hi;
    int flags, pad;
};
enum { I_X = 0, I_C, I_WADA, I_BADA, I_N1G, I_WIN, I_QNG, I_WUQ, I_KVNG, I_WUKV, I_REL, I_AOG, I_BOG, I_WO, I_N2G, I_WR, I_EB, I_W1, I_W3, I_W2, I_WS1, I_WS3, I_WS2, I_FG };
constexpr int NPHASE = 15;

#define W_x (P.in[I_X])
#define W_mod ((float*)(ws + OFF_MOD))
#define W_ropecs ((float*)(ws + OFF_ROPE))
#define W_biasT ((float*)(ws + OFF_BIAS))
#define W_WinT ((bf16_t*)(ws + OFF_WIN))
#define W_WuqT ((bf16_t*)(ws + OFF_WUQ))
#define W_WukvT ((bf16_t*)(ws + OFF_WUKV))
#define W_WoT ((bf16_t*)(ws + OFF_WO))
#define W_WrT ((bf16_t*)(ws + OFF_WR))
#define W_Ws13T ((bf16_t*)(ws + OFF_WS13))
#define W_Ws2T ((bf16_t*)(ws + OFF_WS2))
#define W_hbuf ((bf16_t*)(ws + OFF_H))
#define W_logits ((float*)(ws + OFF_LOGITS))
#define W_eidx ((int*)(ws + OFF_EIDX))
#define W_gate ((float*)(ws + OFF_GATE))
#define W_rnk ((int*)(ws + OFF_RNK))
#define W_pos ((int*)(ws + OFF_POS))
#define W_toks ((int*)(ws + OFF_TOKS))
#define W_wts ((float*)(ws + OFF_WTS))
#define W_ssq ((float*)(ws + OFF_SSQ))
#define W_scr ((bf16_t*)(ws + OFF_SCR + (size_t)blk * SCR_PER_BLK))
#define W_hdn ((bf16_t*)(ws + OFF_HDN))
#define W_ybuf ((bf16_t*)(ws + OFF_Y))
#define W_y8 ((unsigned char*)(ws + OFF_Y))
#define W_proj ((bf16_t*)(ws + OFF_PROJ))
#define W_qb ((bf16_t*)(ws + OFF_QB))
#define W_kvb ((bf16_t*)(ws + OFF_KVB))
#define W_bout ((bf16_t*)(ws + OFF_BOUT))
#define W_aparts ((bf16_t*)(ws + OFF_APARTS))
#define W_lsebuf ((float*)(ws + OFF_LSE))
#define W_mixb ((bf16_t*)(ws + OFF_MIX))
#define W_xt ((bf16_t*)(ws + OFF_XT))

__global__ void __launch_bounds__(512, 2) fwd_kernel(Params P) {
    extern __shared__ __attribute__((aligned(16))) unsigned char lds[];
    const int blk = blockIdx.x, G = gridDim.x;
    const int wave_s = __builtin_amdgcn_readfirstlane((int)threadIdx.x >> 6);
#define TIDS0 int tid; asm volatile("v_mbcnt_lo_u32_b32 %0, -1, 0\n\tv_mbcnt_hi_u32_b32 %0, -1, %0" : "=v"(tid)); tid += wave_s * 64;
    const int vblk = (G % 8 == 0) ? (blk % 8) * (G / 8) + blk / 8 : blk;
    unsigned char* ws = P.ws;
    unsigned* ctl = (unsigned*)(ws + OFF_CTL);
    { TIDS0 if (tid < 64) ((LAS unsigned*)(lds + LDS_MISC))[tid] = 0u; }
    __syncthreads();
    XcdBarrier bar; bar.bar = ctl; bar.x = 0; bar.st = nullptr;
    if (MK_N_LAUNCHES == 1) { TIDS0 bar = xcd_barrier_post(ctl, (volatile LAS unsigned*)(lds + LDS_MISC), tid == 0); }
#ifndef PH_MASK
#define PH_MASK 0xffffffffu
#endif
#define TIDS int tid; asm volatile("v_mbcnt_lo_u32_b32 %0, -1, 0\n\tv_mbcnt_hi_u32_b32 %0, -1, %0" : "=v"(tid)); tid += wave_s * 64; const int lane = tid & 63; const int wave = wave_s; (void)lane; (void)wave;
#define IN(k) ((((PH_MASK) >> (k)) & 1u) && P.ph_lo <= (k) && (k) < P.ph_hi)
#define SEAM(k) do { if (MK_N_LAUNCHES == 1 && IN(k) && IN((k) + 1)) { TIDS0 xcd_barrier(bar, tid == 0); } } while (0)

    unsigned* cntg = ctl + CNT_WORD0;
    LAS unsigned* rowoff = (LAS unsigned*)(lds + LDS_ROWOFF);
    LAS float* rowsc = (LAS float*)(lds + LDS_ROWSC);
    LAS int* startL = (LAS int*)(lds + LDS_START);
    LAS int* cntL = (LAS int*)(lds + LDS_CNT);
    LAS int* tbL = (LAS int*)(lds + LDS_TB);
    LAS int* itemD = (LAS int*)(lds + LDS_MISC + 64);
    char* stage = (char*)lds + LDS_STAGE;
    LAS unsigned char* ldsL = (LAS unsigned char*)lds;

    if (IN(0)) {
        TIDS
        {
            float* sc = (float*)(lds);
            float* red = (float*)(lds + 32768);
            const float* c = P.in[I_C];
            for (int i = tid; i < 8192; i += 512) sc[i] = siluf(c[i]);
            __syncthreads();
            for (int cb = blk; cb < 256; cb += G) {
                const int cj = tid & 31, kg = tid >> 5;
                float a0 = 0, a1 = 0, a2 = 0, a3 = 0, a4 = 0, a5 = 0, a6 = 0, a7 = 0;
                if (cj < 24) {
                    const float* w = P.in[I_WADA] + cb * 24 + cj;
                    for (int k = kg * 64; k < kg * 64 + 64; ++k) {
                        const float wv = w[(size_t)k * 6144];
                        a0 += sc[k] * wv; a1 += sc[1024 + k] * wv; a2 += sc[2048 + k] * wv; a3 += sc[3072 + k] * wv;
                        a4 += sc[4096 + k] * wv; a5 += sc[5120 + k] * wv; a6 += sc[6144 + k] * wv; a7 += sc[7168 + k] * wv;
                    }
                }
                float* rp = red + (kg * 8) * 32 + cj;
                rp[0] = a0; rp[32] = a1; rp[64] = a2; rp[96] = a3; rp[128] = a4; rp[160] = a5; rp[192] = a6; rp[224] = a7;
                __syncthreads();
                if (tid < 256) {
                    const int b = tid >> 5, j = tid & 31;
                    if (j < 24) {
                        float s = 0.f;
                        for (int g = 0; g < 16; ++g) s += red[(g * 8 + b) * 32 + j];
                        const int col = cb * 24 + j;
                        W_mod[b * 6144 + col] = s + P.in[I_BADA][col];
                    }
                }
                __syncthreads();
            }
        }
        {
            for (int idx = blk * 512 + tid; idx < 4096 * 16; idx += G * 512) {
                const int s = idx >> 4, i = idx & 15;
                double inv = 1.0; for (int j = 0; j < i; ++j) inv *= 0.5623413251903491;
                const float invf = (float)inv;
                const float angf = (float)s * invf;
                const double xa = (double)angf;
                const double nrev = __builtin_rint(xa * 0.15915494309189535);
                const double r = xa - nrev * 6.283185307179586;
                const double r2 = r * r;
                double ts = r, ss = r, tc = 1.0, cc = 1.0;
#pragma unroll
                for (int n = 1; n <= 14; ++n) {
                    ts *= -r2 / (double)((2 * n) * (2 * n + 1)); ss += ts;
                    tc *= -r2 / (double)((2 * n - 1) * (2 * n)); cc += tc;
                }
                W_ropecs[idx * 2] = (float)cc; W_ropecs[idx * 2 + 1] = (float)ss;
            }
        }
        {
            for (int idx = blk * 512 + tid; idx < 3 * 8 * 129; idx += G * 512) {
                const int j = idx % 129, hh = (idx / 129) % 8, p = idx / (129 * 8);
                const int dil = (p == 0) ? 1 : (p == 1 ? 4 : 16);
                const int rel = (j - 64) * dil;
                const int n = rel < 0 ? -rel : rel;
                const float nf = (float)(n > 1 ? n : 1);
                int large = 8 + (int)(__logf(nf * 0.125f) / 4.852030263919617f * 8.0f);
                large = large < 15 ? large : 15;
                const int bucket = (rel > 0 ? 16 : 0) + (n < 8 ? n : large);
                W_biasT[idx] = P.in[I_REL][bucket * 8 + hh] * LOG2E;
            }
        }
        {
            const int wi = blk * 512 + tid, nw = G * 512;
            convert_T(W_WinT, P.in[I_WIN], INC, 1024, INCP,
                      [](int n) { if (n >= INC) return -1; if (n < 2176) return n; const int i = n - 2176; return 2176 + ((i & 1) ? 16 : 0) + (i >> 1); },
                      [](int n) { return perm_row(n); }, OneK{}, [](int n) { return n < 512 ? 0.125f * LOG2E : 1.0f; }, wi, nw);
            convert_T(W_WuqT, P.in[I_WUQ], 768, 384, 768,
                      [](int n) { if (n < 512) return (n >> 6) * 96 + (n & 63); const int hh = (n - 512) >> 5, i = n & 31; return hh * 96 + 64 + ((i & 1) ? 16 : 0) + (i >> 1); },
                      [](int n) { return perm_row(n); }, VecK{P.in[I_QNG]}, [](int) { return 0.10206207261596577f * LOG2E; }, wi, nw);
            convert_T(W_WukvT, P.in[I_WUKV], 1024, 256, 1024, IdCol{}, [](int n) { return perm_row(n); }, VecK{P.in[I_KVNG]}, [](int) { return 1.f; }, wi, nw);
            {
                const float* ag = P.in[I_AOG]; const float* bg = P.in[I_BOG];
                convert_T(W_WoT, P.in[I_WO], 1024, 1024, 1024, IdCol{}, [](int n) { return perm_row(n); }, [=](int k) { return k < 512 ? ag[k] : bg[k - 512]; }, [](int) { return 1.f; }, wi, nw);
            }
            convert_T(W_WrT, P.in[I_WR], 256, 1024, 256, IdCol{}, [](int n) { return perm_row(n); }, OneK{}, [](int) { return 1.f; }, wi, nw);
            convert_T(W_Ws13T, P.in[I_WS1], 256, 1024, 256, IdCol{}, [](int n) { return perm_row((n >> 7) * 256 + (n & 127)); }, OneK{}, [](int) { return 1.f; }, wi, nw);
            convert_T(W_Ws13T, P.in[I_WS3], 256, 1024, 256, IdCol{}, [](int n) { return perm_row((n >> 7) * 256 + 128 + (n & 127)); }, OneK{}, [](int) { return 1.f; }, wi, nw);
            convert_T(W_Ws2T, P.in[I_WS2], 1024, 256, 1024, IdCol{}, [](int n) { return perm_row(n); }, OneK{}, [](int) { return 1.f; }, wi, nw);
        }
    }
    SEAM(0);

    if (IN(1)) {
        TIDS
        const float* g = P.in[I_N1G];
        f32x4 vn[4];
        {
            const float* xr = W_x + (size_t)(blk * 8 + wave) * DM;
#pragma unroll
            for (int i = 0; i < 4; ++i) vn[i] = *(const f32x4*)(xr + i * 256 + lane * 4);
        }
        for (int row = blk * 8 + wave; row < NTOK; row += G * 8) {
            const int b = row >> 12;
            f32x4 v[4]; float ss = 0.f;
#pragma unroll
            for (int i = 0; i < 4; ++i) v[i] = vn[i];
            if (row + G * 8 < NTOK) {
                const float* xn = W_x + (size_t)(row + G * 8) * DM;
#pragma unroll
                for (int i = 0; i < 4; ++i) vn[i] = *(const f32x4*)(xn + i * 256 + lane * 4);
            }
#pragma unroll
            for (int i = 0; i < 4; ++i) ss += v[i][0] * v[i][0] + v[i][1] * v[i][1] + v[i][2] * v[i][2] + v[i][3] * v[i][3];
            ss = wave_sum(ss);
            const float rinv = rsqrtf(ss * (1.0f / 1024.0f) + EPS);
            const float* mb = W_mod + b * 6144;
#pragma unroll
            for (int i = 0; i < 4; ++i) {
                const int c = i * 256 + lane * 4;
                const f32x4 gg = *(const f32x4*)(g + c), sh = *(const f32x4*)(mb + c), sc = *(const f32x4*)(mb + 1024 + c);
                float o[4];
#pragma unroll
                for (int j = 0; j < 4; ++j) o[j] = v[i][j] * rinv * gg[j] * (1.0f + sc[j]) + sh[j];
                u32x2 w; w.x = pk2(o[0], o[1]); w.y = pk2(o[2], o[3]);
                *(u32x2*)(W_hbuf + (size_t)row * DM + c) = w;
            }
        }
    }
    SEAM(1);

    if (IN(2)) {
        TIDS
        unsigned vl_[4]; g8_voff_lin(vl_, DM, tid);
        auto nextf = [&](int i, GDesc& d) {
            const int ul = i * 32 + (vblk & 31); if (ul >= 144 || vblk >= 256) return false;
            const int pm = (vblk >> 5) * 16 + ul / 9, pn = ul % 9;
            d.Ab = (const char*)(W_hbuf + (size_t)pm * 256 * DM); d.Bb = (const char*)(W_WinT + (size_t)pn * 256 * DM);
            d.va0 = vl_[0]; d.va1 = vl_[1]; d.va2 = vl_[2]; d.va3 = vl_[3]; d.i0 = pm; d.i1 = pn; d.i2 = 0; return true;
        };
        auto epi = [&](const f32x4 (&acc)[2][2][4][2], const GDesc& d, int wr, int wc, int fr, int fq) {
            const int pm = d.i0, pn = d.i1;
            if (pn < 8) {
                EPI_FOREACH8(acc, wr, wc, fr, fq, r, c8, v0, v1, {
                    u32x4 w; PK8(w, v0, v1);
                    *(u32x4*)(W_proj + (size_t)(pm * 256 + r) * INCP + pn * 256 + c8) = w;
                })
            } else {
                EPI_FOREACH8(acc, wr, wc, fr, fq, r, c8, v0, v1, {
                    const int row = pm * 256 + r;
                    if (c8 < 160) {
                        f32x4 o0 = v0, o1 = v1;
                        if (c8 >= 128) {
                            const int i = (c8 - 128) >> 1; const int s = row & 4095;
                            const f32x4 ca = *(const f32x4*)(W_ropecs + (s * 16 + i) * 2), cb = *(const f32x4*)(W_ropecs + (s * 16 + i) * 2 + 4);
                            o0[0] = v0[0] * ca[0] - v0[1] * ca[1]; o0[1] = v0[1] * ca[0] + v0[0] * ca[1];
                            o0[2] = v0[2] * ca[2] - v0[3] * ca[3]; o0[3] = v0[3] * ca[2] + v0[2] * ca[3];
                            o1[0] = v1[0] * cb[0] - v1[1] * cb[1]; o1[1] = v1[1] * cb[0] + v1[0] * cb[1];
                            o1[2] = v1[2] * cb[2] - v1[3] * cb[3]; o1[3] = v1[3] * cb[2] + v1[2] * cb[3];
                        }
                        u32x4 w; PK8(w, o0, o1);
                        *(u32x4*)(W_proj + (size_t)row * INCP + 2048 + c8) = w;
                    }
                })
            }
            if (pn >= 6) {
#pragma unroll
                for (int ai = 0; ai < 2; ++ai)
#pragma unroll
                    for (int m = 0; m < 4; ++m)
#pragma unroll
                        for (int bj = 0; bj < 2; ++bj) {
                            const f32x4 a = acc[ai][bj][m][0], b = acc[ai][bj][m][1];
                            float ss = a[0] * a[0] + a[1] * a[1] + a[2] * a[2] + a[3] * a[3] + b[0] * b[0] + b[1] * b[1] + b[2] * b[2] + b[3] * b[3];
                            { float o; const float t = x16f(ss, o); ss = t + o; }
                            { float o; const float t = x32f(ss, o); ss = t + o; }
                            if (fq == 0) W_ssq[(size_t)(pm * 256 + ai * 128 + wr * 64 + m * 16 + fr) * 24 + (pn - 6) * 8 + bj * 4 + wc] = ss;
                        }
            }
        };
        gemm_stream(ldsL, tid, DM, nextf, epi);
        if ((vblk & 31) >= 16) {
            TIDS
#pragma unroll 1
            for (int q = 0; q < 2; ++q) {
                const int uu = blk + q * G;
                const int e = (G == 256) ? ((vblk & ~3) + q) : (uu >> 2), pn = (G == 256) ? (vblk & 3) : (uu & 3);
                __syncthreads();
                if (uu < 1024) convert_panel_lds<256, true>(W_scr + (size_t)2 * 256 * 1024 + (size_t)q * 256 * 256, P.in[I_W2] + (size_t)e * 256 * 1024 + pn * 256, 1024, 256, tid, ldsL);
            }
        }
    }
    SEAM(2);

    if (IN(3)) {
        {
            TIDS
            const int xb = (vblk >> 5) * 16, lb = vblk & 31;
            __syncthreads();
            for (int j = 0; j < 2; ++j) { const int ul = j * 32 + lb; if (ul < 48 && tid < 256) {
                const float* sp = W_ssq + (size_t)((xb + ul / 3) * 256 + tid) * 24;
                const f32x4 s0 = *(const f32x4*)sp, s1 = *(const f32x4*)(sp + 4), s2 = *(const f32x4*)(sp + 8);
                const float ss = ((s0[0] + s0[1]) + (s0[2] + s0[3])) + ((s1[0] + s1[1]) + (s1[2] + s1[3])) + ((s2[0] + s2[1]) + (s2[2] + s2[3]));
                rowsc[j * 256 + tid] = rsqrtf(ss * (1.0f / 384.0f) + EPS); } }
            __syncthreads();
            unsigned vl_[4]; g8_voff_lin(vl_, INCP, tid);
            auto nextf = [&](int i, GDesc& d) {
                const int ul = i * 32 + lb; if (ul >= 48 || vblk >= 256) return false;
                const int pm = xb + ul / 3, pn = ul % 3;
                d.Ab = (const char*)(W_proj + (size_t)pm * 256 * INCP + 1536); d.Bb = (const char*)(W_WuqT + (size_t)pn * 256 * QLORA);
                d.va0 = vl_[0]; d.va1 = vl_[1]; d.va2 = vl_[2]; d.va3 = vl_[3]; d.i0 = pm * 4 + pn; d.i1 = i; d.i2 = 0; return true;
            };
            auto epi = [&](const f32x4 (&acc)[2][2][4][2], const GDesc& d, int wr, int wc, int fr, int fq) {
                const int pm = d.i0 >> 2, pn = d.i0 & 3, sl = d.i1 * 256;
                if (pn < 2) {
                    EPI_FOREACH8(acc, wr, wc, fr, fq, r, c8, v0, v1, {
                        const float rs = rowsc[sl + r];
                        const f32x4 a = v0 * rs, b = v1 * rs;
                        u32x4 w; PK8(w, a, b);
                        *(u32x4*)(W_qb + (size_t)(pm * 256 + r) * 768 + pn * 256 + c8) = w;
                    })
                } else {
                    EPI_FOREACH8(acc, wr, wc, fr, fq, r, c8, v0, v1, {
                        const int row = pm * 256 + r;
                        const float rs = rowsc[sl + r];
                        const int i = (c8 & 31) >> 1; const int s = row & 4095;
                        const f32x4 ca = *(const f32x4*)(W_ropecs + (s * 16 + i) * 2), cb = *(const f32x4*)(W_ropecs + (s * 16 + i) * 2 + 4);
                        const f32x4 t0 = v0 * rs, t1 = v1 * rs;
                        f32x4 o0, o1;
                        o0[0] = t0[0] * ca[0] - t0[1] * ca[1]; o0[1] = t0[1] * ca[0] + t0[0] * ca[1];
                        o0[2] = t0[2] * ca[2] - t0[3] * ca[3]; o0[3] = t0[3] * ca[2] + t0[2] * ca[3];
                        o1[0] = t1[0] * cb[0] - t1[1] * cb[1]; o1[1] = t1[1] * cb[0] + t1[0] * cb[1];
                        o1[2] = t1[2] * cb[2] - t1[3] * cb[3]; o1[3] = t1[3] * cb[2] + t1[2] * cb[3];
                        u32x4 w; PK8(w, o0, o1);
                        *(u32x4*)(W_qb + (size_t)row * 768 + 512 + c8) = w;
                    })
                }
            };
            gemm_stream(ldsL, tid, QLORA, nextf, epi);
        }
        {
            TIDS
            const int xb = (vblk >> 5) * 16, lb = vblk & 31;
            __syncthreads();
            for (int j = 0; j < 2; ++j) { const int ul = j * 32 + lb; if (tid < 256) {
                const float* sp = W_ssq + (size_t)((xb + ul / 4) * 256 + tid) * 24 + 12;
                const f32x4 s0 = *(const f32x4*)sp, s1 = *(const f32x4*)(sp + 4);
                const float ss = ((s0[0] + s0[1]) + (s0[2] + s0[3])) + ((s1[0] + s1[1]) + (s1[2] + s1[3]));
                rowsc[j * 256 + tid] = rsqrtf(ss * (1.0f / 256.0f) + EPS); } }
            __syncthreads();
            unsigned vl_[4]; g8_voff_lin(vl_, INCP, tid);
            auto nextf = [&](int i, GDesc& d) {
                const int ul = i * 32 + lb; if (ul >= 64 || vblk >= 256) return false;
                const int pm = xb + ul / 4, pn = ul % 4;
                d.Ab = (const char*)(W_proj + (size_t)pm * 256 * INCP + 1920); d.Bb = (const char*)(W_WukvT + (size_t)pn * 256 * KVLORA);
                d.va0 = vl_[0]; d.va1 = vl_[1]; d.va2 = vl_[2]; d.va3 = vl_[3]; d.i0 = pm * 4 + pn; d.i1 = i; d.i2 = 0; return true;
            };
            auto epi = [&](const f32x4 (&acc)[2][2][4][2], const GDesc& d, int wr, int wc, int fr, int fq) {
                const int pm = d.i0 >> 2, pn = d.i0 & 3, sl = d.i1 * 256;
                EPI_FOREACH8(acc, wr, wc, fr, fq, r, c8, v0, v1, {
                    const float rs = rowsc[sl + r];
                    const f32x4 a = v0 * rs, b = v1 * rs;
                    u32x4 w; PK8(w, a, b);
                    *(u32x4*)(W_kvb + (size_t)(pm * 256 + r) * 1024 + pn * 256 + c8) = w;
                })
            };
            gemm_stream(ldsL, tid, KVLORA, nextf, epi);
        }
    }
    SEAM(3);

    if (IN(4)) {
        for (int ui = 0; ui < ((P.flags & 4) ? 0 : 4); ++ui) {
            TIDS
            const int r32 = lane & 31, hh = lane >> 5;
            if (vblk >= 256) break;
            const int qblk = vblk & 15, bh = (vblk >> 5) * 8 + ui * 2 + ((vblk >> 4) & 1), h = bh & 7, b = bh >> 3;
            const size_t tok0 = (size_t)b * SEQ;
            bf16x8 qf[6];
            {
                const size_t tq = tok0 + qblk * 256 + wave * 32 + r32;
#pragma unroll
                for (int d0 = 0; d0 < 6; ++d0) qf[d0] = *(const bf16x8*)(W_qb + tq * 768 + (d0 < 4 ? h * 64 + d0 * 16 : 512 + h * 32 + (d0 - 4) * 16) + hh * 8);
            }
            f32x16 o0 = {}, o1 = {};
            f32x16 mneg = {};
            float m_run = 0.f, l_run = 0.f;
            const int skey = tid >> 3, sch = tid & 7;
            const bf16_t* kn_src = W_kvb + (tok0 + skey) * 1024 + h * 128 + sch * 8;
            const int pkey = tid >> 2, pch = tid & 3;
            const bf16_t* kp_src = W_proj + (tok0 + pkey) * INCP + 2176 + pch * 8;
            constexpr int KBUF = 12 * 2048, VBUF = 2 * 8192, BUFB = KBUF + VBUF;
            const int k_dst = sch * 2048 + ((skey ^ sch) * 16);
            const int kp_dst = (8 + pch) * 2048 + ((pkey ^ pch) * 16);
            const int v_dst = KBUF + (sch >> 2) * 8192 + skey * 64 + (sch & 3) * 16;
            const int kfo = hh * 2048;
            const int vfo = KBUF + (4 * hh + ((lane & 15) >> 2)) * 64 + ((lane >> 4) & 1) * 32 + (lane & 3) * 8;
            __syncthreads();
            {
                const u32x4 k0 = *(const u32x4*)kn_src, v0 = *(const u32x4*)(kn_src + 64);
                const u32x4 k1 = *(const u32x4*)(kn_src + 64 * 1024), v1 = *(const u32x4*)(kn_src + 64 * 1024 + 64);
                const u32x4 pr = *(const u32x4*)kp_src;
                *(LAS u32x4*)(ldsL + k_dst) = k0; *(LAS u32x4*)(ldsL + k_dst + 1024) = k1;
                *(LAS u32x4*)(ldsL + v_dst) = v0; *(LAS u32x4*)(ldsL + v_dst + 4096) = v1;
                *(LAS u32x4*)(ldsL + kp_dst) = pr;
            }
            __syncthreads();
#pragma unroll 1
            for (int t = 0; t < 32; ++t) {
                const int cur = t & 1;
                const int tn = (t + 1 < 32) ? t + 1 : t;
                const bf16_t* ks = kn_src + (size_t)tn * 128 * 1024;
                const u32x4 nk0 = *(const u32x4*)ks, nv0 = *(const u32x4*)(ks + 64);
                const u32x4 nk1 = *(const u32x4*)(ks + 64 * 1024), nv1 = *(const u32x4*)(ks + 64 * 1024 + 64);
                const u32x4 npr = *(const u32x4*)(kp_src + (size_t)tn * 128 * INCP);
                f32x16 sc[2][2];
#pragma unroll
                for (int sub = 0; sub < 2; ++sub) {
                    const int kb = cur * BUFB + kfo + sub * 1024;
#pragma unroll
                    for (int d0 = 0; d0 < 6; ++d0) {
                        const int sw = (2 * d0 + hh) & 7;
                        const bf16x8 k0 = *(const LAS bf16x8*)(ldsL + kb + d0 * 4096 + ((r32 ^ sw) * 16));
                        const bf16x8 k1 = *(const LAS bf16x8*)(ldsL + kb + d0 * 4096 + (((32 + r32) ^ sw) * 16));
                        if (d0 == 0) { sc[sub][0] = __builtin_amdgcn_mfma_f32_32x32x16_bf16(k0, qf[0], mneg, 0, 0, 0); sc[sub][1] = __builtin_amdgcn_mfma_f32_32x32x16_bf16(k1, qf[0], mneg, 0, 0, 0); }
                        else { sc[sub][0] = __builtin_amdgcn_mfma_f32_32x32x16_bf16(k0, qf[d0], sc[sub][0], 0, 0, 0); sc[sub][1] = __builtin_amdgcn_mfma_f32_32x32x16_bf16(k1, qf[d0], sc[sub][1], 0, 0, 0); }
                    }
                }
#pragma unroll
                for (int sub = 0; sub < 2; ++sub) {
                    const int vb = cur * BUFB + vfo + sub * 4096;
                    f32x16& s0 = sc[sub][0]; f32x16& s1 = sc[sub][1];
#define MX3(a, b, c) __builtin_fmaxf(__builtin_fmaxf((a), (b)), (c))
                    float mxa = MX3(s0[0], s0[1], s1[0]), mxb = MX3(s0[2], s0[3], s1[1]); mxa = MX3(mxa, s1[2], s1[3]);
#pragma unroll
                    for (int i = 4; i < 16; i += 4) { mxa = MX3(mxa, s0[i], s0[i + 1]); mxb = MX3(mxb, s0[i + 2], s0[i + 3]); mxa = MX3(mxa, s1[i], s1[i + 1]); mxb = MX3(mxb, s1[i + 2], s1[i + 3]); }
#undef MX3
                    float mx = max32(__builtin_fmaxf(mxa, mxb));
                    const bool first = (t == 0 && sub == 0);
                    if (first || __builtin_amdgcn_ballot_w64(mx > 8.0f) != 0ull) {
                        const float d = first ? mx : fmaxf(mx, 0.f);
                        const float alpha = first ? 0.f : ex2(-d);
                        m_run += d; l_run *= alpha;
#pragma unroll
                        for (int i = 0; i < 16; ++i) { o0[i] *= alpha; o1[i] *= alpha; s0[i] -= d; s1[i] -= d; mneg[i] = -m_run; }
                        if (sub == 0) {
#pragma unroll
                            for (int i = 0; i < 16; ++i) { sc[1][0][i] -= d; sc[1][1][i] -= d; }
                        }
                    }
                    f32x2_t psv = {0.f, 0.f};
#pragma unroll
                    for (int i = 0; i < 16; i += 2) { s0[i] = ex2(s0[i]); s0[i + 1] = ex2(s0[i + 1]); s1[i] = ex2(s1[i]); s1[i + 1] = ex2(s1[i + 1]);
                        psv += (f32x2_t){s0[i], s0[i + 1]}; psv += (f32x2_t){s1[i], s1[i + 1]}; }
                    l_run += psv[0] + psv[1];
                    bf16x8 pf[2][2];
#pragma unroll
                    for (int s = 0; s < 2; ++s) {
                        u32x4 w0, w1;
                        w0.x = pk2(s0[8 * s + 0], s0[8 * s + 1]); w0.y = pk2(s0[8 * s + 2], s0[8 * s + 3]); w0.z = pk2(s0[8 * s + 4], s0[8 * s + 5]); w0.w = pk2(s0[8 * s + 6], s0[8 * s + 7]);
                        w1.x = pk2(s1[8 * s + 0], s1[8 * s + 1]); w1.y = pk2(s1[8 * s + 2], s1[8 * s + 3]); w1.z = pk2(s1[8 * s + 4], s1[8 * s + 5]); w1.w = pk2(s1[8 * s + 6], s1[8 * s + 7]);
                        pf[0][s] = __builtin_bit_cast(bf16x8, w0); pf[1][s] = __builtin_bit_cast(bf16x8, w1);
                    }
#pragma unroll
                    for (int n = 0; n < 2; ++n)
#pragma unroll
                        for (int s = 0; s < 2; ++s) {
                            const int ko = (32 * n + 16 * s) * 64;
#pragma unroll
                            for (int db = 0; db < 2; ++db) {
                                const s16x4 lo = __builtin_bit_cast(s16x4, __builtin_amdgcn_ds_read_tr16_b64_v4i16((LAS s16x4*)(ldsL + vb + db * 8192 + ko)));
                                const s16x4 hi = __builtin_bit_cast(s16x4, __builtin_amdgcn_ds_read_tr16_b64_v4i16((LAS s16x4*)(ldsL + vb + db * 8192 + ko + 512)));
                                const bf16x8 vf = {lo[0], lo[1], lo[2], lo[3], hi[0], hi[1], hi[2], hi[3]};
                                if (db == 0) o0 = __builtin_amdgcn_mfma_f32_32x32x16_bf16(vf, pf[n][s], o0, 0, 0, 0);
                                else o1 = __builtin_amdgcn_mfma_f32_32x32x16_bf16(vf, pf[n][s], o1, 0, 0, 0);
                            }
                        }
                }
                {
                    const int nb = (cur ^ 1) * BUFB;
                    *(LAS u32x4*)(ldsL + nb + k_dst) = nk0; *(LAS u32x4*)(ldsL + nb + k_dst + 1024) = nk1;
                    *(LAS u32x4*)(ldsL + nb + v_dst) = nv0; *(LAS u32x4*)(ldsL + nb + v_dst + 4096) = nv1;
                    *(LAS u32x4*)(ldsL + nb + kp_dst) = npr;
                }
                __syncthreads();
            }
            {
                const float lt = sum32(l_run);
                const float inv = 1.0f / lt;
                const int sc = 81920 + wave * 4352;
#pragma unroll
                for (int g = 0; g < 4; ++g) {
                    u32x2 w;
                    w.x = pk2(o0[4 * g] * inv, o0[4 * g + 1] * inv); w.y = pk2(o0[4 * g + 2] * inv, o0[4 * g + 3] * inv);
                    *(LAS u32x2*)(ldsL + sc + r32 * 136 + (8 * g + 4 * hh) * 2) = w;
                    w.x = pk2(o1[4 * g] * inv, o1[4 * g + 1] * inv); w.y = pk2(o1[4 * g + 2] * inv, o1[4 * g + 3] * inv);
                    *(LAS u32x2*)(ldsL + sc + r32 * 136 + (32 + 8 * g + 4 * hh) * 2) = w;
                }
                __syncthreads();
#pragma unroll
                for (int it = 0; it < 8; ++it) {
                    const int row = it * 4 + (lane >> 4), pc = lane & 15;
                    const u32x2 w = *(const LAS u32x2*)(ldsL + sc + row * 136 + pc * 8);
                    *(u32x2*)(W_bout + (tok0 + qblk * 256 + wave * 32 + row) * 512 + h * 64 + pc * 4) = w;
                }
            }
            if ((vblk & 3) == ui) {
#pragma unroll 1
                for (int sl = 0; sl < 4; ++sl) {
                    const int j = sl >> 1; const int uu = blk + j * G;
                    const int e = (G == 256) ? ((vblk & ~1) + j) : (uu >> 1), pn = (G == 256) ? (vblk & 1) : (uu & 1);
                    __syncthreads();
                    if (uu < 512) convert_panel_lds<128, true>(W_scr + (size_t)j * 256 * 1024 + (sl & 1) * 128 * 1024, P.in[(sl & 1) ? I_W3 : I_W1] + (size_t)e * 1024 * 256 + pn * 128, 256, 1024, tid, ldsL);
                }
            }
        }
        for (int ui = 0; ui < ((P.flags & 8) ? 0 : 12); ++ui) {
            TIDS
            const int r32 = lane & 31, hh = lane >> 5;
            const int u = vblk * 12 + ui;
            if (u >= 3072) break;
            const int bh = u / 48, w48 = u % 48, h = bh & 7, b = bh >> 3;
            const int p = w48 >> 4, j16 = w48 & 15;
            const int dil = (p == 0) ? 1 : (p == 1 ? 4 : 16);
            const int res = (p == 0) ? 0 : (p == 1 ? (j16 >> 2) : j16);
            const int m0 = (p == 0) ? j16 * 256 : (p == 1 ? (j16 & 3) * 256 : 0);
            const int L = SEQ / dil;
            const size_t tok0 = (size_t)b * SEQ;
            __syncthreads();
            for (int idx = tid; idx < 672; idx += 512) { const int oi = idx - 255; *(LAS float*)(ldsL + 98304 + idx * 4) = (oi >= 0 && oi <= 128) ? W_biasT[(p * 8 + h) * 129 + oi] : -1e30f; }
            {
                u32x4 kr[6], vr[6];
#pragma unroll
                for (int it = 0; it < 6; ++it) {
                    const int idx = it * 512 + tid, row = idx >> 3, ch = idx & 7;
                    const int mk = m0 - 64 + row;
                    kr[it] = (u32x4){0, 0, 0, 0}; vr[it] = (u32x4){0, 0, 0, 0};
                    if (mk >= 0 && mk < L) {
                        const bf16_t* src = W_proj + (tok0 + (size_t)mk * dil + res) * INCP + 512 + h * 64 + ch * 8;
                        kr[it] = *(const u32x4*)src; vr[it] = *(const u32x4*)(src + 512);
                    }
                }
#pragma unroll
                for (int it = 0; it < 6; ++it) {
                    const int idx = it * 512 + tid, row = idx >> 3, ch = idx & 7;
                    *(LAS u32x4*)(ldsL + ch * 6144 + ((row ^ ch) * 16)) = kr[it];
                    *(LAS u32x4*)(ldsL + 49152 + (ch >> 2) * 24576 + row * 64 + (ch & 3) * 16) = vr[it];
                }
            }
            const int qrel = wave * 32 + r32;
            const size_t tq = tok0 + (size_t)(m0 + qrel) * dil + res;
            bf16x8 qf[4];
#pragma unroll
            for (int d0 = 0; d0 < 4; ++d0) qf[d0] = *(const bf16x8*)(W_proj + tq * INCP + h * 64 + d0 * 16 + hh * 8);
            __syncthreads();
            f32x16 o0 = {}, o1 = {};
            float m_run = -1e20f, l_run = 0.f;
            const int vfo = 49152 + (4 * hh + ((lane & 15) >> 2)) * 64 + ((lane >> 4) & 1) * 32 + (lane & 3) * 8;
#pragma unroll 1
            for (int jj = 0; jj < 3; ++jj) {
                const int jt = (wave >> 1) + jj;
                f32x16 s0 = {}, s1 = {};
#pragma unroll
                for (int d0 = 0; d0 < 4; ++d0) {
                    const int ch = 2 * d0 + hh;
                    const bf16x8 k0 = *(const LAS bf16x8*)(ldsL + ch * 6144 + (((64 * jt + r32) ^ ch) * 16));
                    const bf16x8 k1 = *(const LAS bf16x8*)(ldsL + ch * 6144 + (((64 * jt + 32 + r32) ^ ch) * 16));
                    s0 = __builtin_amdgcn_mfma_f32_32x32x16_bf16(k0, qf[d0], s0, 0, 0, 0);
                    s1 = __builtin_amdgcn_mfma_f32_32x32x16_bf16(k1, qf[d0], s1, 0, 0, 0);
                }
                const LAS float* bl = (const LAS float*)(ldsL + 98304) + (64 * jt - qrel + 4 * hh + 255);
                const int mkb = m0 - 64 + 64 * jt;
                const bool edge = (mkb < 0) || (mkb + 64 > L);
                float mx = -1e30f;
#pragma unroll
                for (int i = 0; i < 16; ++i) {
                    const int cr = (i & 3) + 8 * (i >> 2);
                    s0[i] += bl[cr]; s1[i] += bl[cr + 32];
                    if (edge) {
                        const int mk0 = mkb + cr + 4 * hh;
                        if (mk0 < 0 || mk0 >= L) s0[i] = -1e30f;
                        if (mk0 + 32 < 0 || mk0 + 32 >= L) s1[i] = -1e30f;
                    }
                    mx = fmaxf(mx, fmaxf(s0[i], s1[i]));
                }
                mx = max32(mx);
                const float m_new = fmaxf(m_run, mx);
                const float alpha = ex2(m_run - m_new);
                m_run = m_new;
                float ps = 0.f;
#pragma unroll
                for (int i = 0; i < 16; ++i) { s0[i] = ex2(s0[i] - m_new); s1[i] = ex2(s1[i] - m_new); ps += s0[i] + s1[i]; }
                l_run = l_run * alpha + ps;
#pragma unroll
                for (int i = 0; i < 16; ++i) { o0[i] *= alpha; o1[i] *= alpha; }
                bf16x8 pf[2][2];
#pragma unroll
                for (int s = 0; s < 2; ++s) {
                    u32x4 w0, w1;
                    w0.x = pk2(s0[8 * s + 0], s0[8 * s + 1]); w0.y = pk2(s0[8 * s + 2], s0[8 * s + 3]); w0.z = pk2(s0[8 * s + 4], s0[8 * s + 5]); w0.w = pk2(s0[8 * s + 6], s0[8 * s + 7]);
                    w1.x = pk2(s1[8 * s + 0], s1[8 * s + 1]); w1.y = pk2(s1[8 * s + 2], s1[8 * s + 3]); w1.z = pk2(s1[8 * s + 4], s1[8 * s + 5]); w1.w = pk2(s1[8 * s + 6], s1[8 * s + 7]);
                    pf[0][s] = __builtin_bit_cast(bf16x8, w0); pf[1][s] = __builtin_bit_cast(bf16x8, w1);
                }
#pragma unroll
                for (int n = 0; n < 2; ++n)
#pragma unroll
                    for (int s = 0; s < 2; ++s) {
                        const int ko = (64 * jt + 32 * n + 16 * s) * 64;
#pragma unroll
                        for (int db = 0; db < 2; ++db) {
                            const s16x4 lo = __builtin_bit_cast(s16x4, __builtin_amdgcn_ds_read_tr16_b64_v4i16((LAS s16x4*)(ldsL + vfo + db * 24576 + ko)));
                            const s16x4 hi = __builtin_bit_cast(s16x4, __builtin_amdgcn_ds_read_tr16_b64_v4i16((LAS s16x4*)(ldsL + vfo + db * 24576 + ko + 512)));
                            const bf16x8 vf = {lo[0], lo[1], lo[2], lo[3], hi[0], hi[1], hi[2], hi[3]};
                            if (db == 0) o0 = __builtin_amdgcn_mfma_f32_32x32x16_bf16(vf, pf[n][s], o0, 0, 0, 0);
                            else o1 = __builtin_amdgcn_mfma_f32_32x32x16_bf16(vf, pf[n][s], o1, 0, 0, 0);
                        }
                    }
            }
            __syncthreads();
            {
                const float lt = sum32(l_run);
                const float inv = 1.0f / lt;
                if (hh == 0) W_lsebuf[((size_t)p * NTOK + tq) * 8 + h] = m_run + __log2f(lt);
                const int sc = wave * 4352;
#pragma unroll
                for (int g = 0; g < 4; ++g) {
                    u32x2 w;
                    w.x = pk2(o0[4 * g] * inv, o0[4 * g + 1] * inv); w.y = pk2(o0[4 * g + 2] * inv, o0[4 * g + 3] * inv);
                    *(LAS u32x2*)(ldsL + sc + r32 * 136 + (8 * g + 4 * hh) * 2) = w;
                    w.x = pk2(o1[4 * g] * inv, o1[4 * g + 1] * inv); w.y = pk2(o1[4 * g + 2] * inv, o1[4 * g + 3] * inv);
                    *(LAS u32x2*)(ldsL + sc + r32 * 136 + (32 + 8 * g + 4 * hh) * 2) = w;
                }
                __syncthreads();
#pragma unroll
                for (int it = 0; it < 8; ++it) {
                    const int row = it * 4 + (lane >> 4), pc = lane & 15;
                    const u32x2 w = *(const LAS u32x2*)(ldsL + sc + row * 136 + pc * 8);
                    const size_t tr = tok0 + (size_t)(m0 + wave * 32 + row) * dil + res;
                    *(u32x2*)(W_aparts + ((size_t)p * NTOK + tr) * 512 + h * 64 + pc * 4) = w;
                }
            }
            if ((vblk % 12) == ui) {
#pragma unroll 1
                for (int q = 2; q < 4; ++q) {
                    const int uu = blk + q * G;
                    const int e = (G == 256) ? ((vblk & ~3) + q) : (uu >> 2), pn = (G == 256) ? (vblk & 3) : (uu & 3);
                    __syncthreads();
                    if (uu < 1024) convert_panel_lds<256, true>(W_scr + (size_t)2 * 256 * 1024 + (size_t)q * 256 * 256, P.in[I_W2] + (size_t)e * 256 * 1024 + pn * 256, 1024, 256, tid, ldsL);
                }
            }
        }
    }
    SEAM(4);

    if (IN(5)) {
        TIDS
        const int hd = lane >> 3;
        float nl0, nl1, nl2; u32x4 na0, na1, na2, nbb;
#define P5_LOAD(ROW) do { const size_t r_ = (size_t)(ROW); nl0 = W_lsebuf[((size_t)0 * NTOK + r_) * 8 + hd]; nl1 = W_lsebuf[((size_t)1 * NTOK + r_) * 8 + hd]; nl2 = W_lsebuf[((size_t)2 * NTOK + r_) * 8 + hd]; \
            na0 = *(const u32x4*)(W_aparts + ((size_t)0 * NTOK + r_) * 512 + lane * 8); na1 = *(const u32x4*)(W_aparts + ((size_t)1 * NTOK + r_) * 512 + lane * 8); \
            na2 = *(const u32x4*)(W_aparts + ((size_t)2 * NTOK + r_) * 512 + lane * 8); nbb = *(const u32x4*)(W_bout + r_ * 512 + lane * 8); } while (0)
        P5_LOAD(blk * 8 + wave);
        for (int row = blk * 8 + wave; row < NTOK; row += G * 8) {
            const float ls0 = nl0, ls1 = nl1, ls2 = nl2; const u32x4 a0 = na0, a1 = na1, a2 = na2, bb = nbb;
            if (row + G * 8 < NTOK) P5_LOAD(row + G * 8);
            const float M = fmaxf(ls0, fmaxf(ls1, ls2));
            float w0 = ex2(ls0 - M), w1 = ex2(ls1 - M), w2 = ex2(ls2 - M);
            const float wsn = 1.0f / (w0 + w1 + w2); w0 *= wsn; w1 *= wsn; w2 *= wsn;
            float av[8], bv[8]; float sa = 0.f, sb = 0.f;
#pragma unroll
            for (int j = 0; j < 4; ++j) {
                av[2 * j] = w0 * __uint_as_float(a0[j] << 16) + w1 * __uint_as_float(a1[j] << 16) + w2 * __uint_as_float(a2[j] << 16);
                av[2 * j + 1] = w0 * __uint_as_float(a0[j] & 0xffff0000u) + w1 * __uint_as_float(a1[j] & 0xffff0000u) + w2 * __uint_as_float(a2[j] & 0xffff0000u);
                bv[2 * j] = __uint_as_float(bb[j] << 16); bv[2 * j + 1] = __uint_as_float(bb[j] & 0xffff0000u);
                sa += av[2 * j] * av[2 * j] + av[2 * j + 1] * av[2 * j + 1];
                sb += bv[2 * j] * bv[2 * j] + bv[2 * j + 1] * bv[2 * j + 1];
            }
            sa = wave_sum(sa); sb = wave_sum(sb);
            const float ra = rsqrtf(sa * (1.0f / 512.0f) + EPS), rb = rsqrtf(sb * (1.0f / 512.0f) + EPS);
            u32x4 wa, wb;
            wa.x = pk2(av[0] * ra, av[1] * ra); wa.y = pk2(av[2] * ra, av[3] * ra); wa.z = pk2(av[4] * ra, av[5] * ra); wa.w = pk2(av[6] * ra, av[7] * ra);
            wb.x = pk2(bv[0] * rb, bv[1] * rb); wb.y = pk2(bv[2] * rb, bv[3] * rb); wb.z = pk2(bv[4] * rb, bv[5] * rb); wb.w = pk2(bv[6] * rb, bv[7] * rb);
            *(u32x4*)(W_mixb + (size_t)row * DM + lane * 8) = wa;
            *(u32x4*)(W_mixb + (size_t)row * DM + 512 + lane * 8) = wb;
        }
    }
    SEAM(5);

    if (IN(6)) {
        TIDS
        unsigned vl_[4]; g8_voff_lin(vl_, DM, tid);
        auto nextf = [&](int i, GDesc& d) {
            const int ul = i * 32 + (vblk & 31); if (ul >= 64 || vblk >= 256) return false;
            const int pm = (vblk >> 5) * 16 + (ul >> 2), pn = ul & 3;
            d.Ab = (const char*)(W_mixb + (size_t)pm * 256 * DM); d.Bb = (const char*)(W_WoT + (size_t)pn * 256 * DM);
            d.va0 = vl_[0]; d.va1 = vl_[1]; d.va2 = vl_[2]; d.va3 = vl_[3]; d.i0 = pm; d.i1 = pn; d.i2 = 0; return true;
        };
        auto epi = [&](const f32x4 (&acc)[2][2][4][2], const GDesc& d, int wr, int wc, int fr, int fq) {
            const int pm = d.i0, pn = d.i1;
            const float* gbase = W_mod + ((pm * 256) >> 12) * 6144 + 2048 + pn * 256 + wc * 32 + fq * 8;
            const f32x4 g00 = *(const f32x4*)gbase, g01 = *(const f32x4*)(gbase + 4), g10 = *(const f32x4*)(gbase + 128), g11 = *(const f32x4*)(gbase + 132);
#pragma unroll
            for (int ai = 0; ai < 2; ++ai)
#pragma unroll
                for (int m = 0; m < 4; ++m) {
                    const int row = pm * 256 + ai * 128 + wr * 64 + m * 16 + fr;
                    bf16_t* op = W_xt + (size_t)row * DM + pn * 256 + wc * 32 + fq * 8;
                    { const f32x4 a = g00 * acc[ai][0][m][0], b = g01 * acc[ai][0][m][1]; u32x4 w; PK8(w, a, b); *(u32x4*)op = w; }
                    { const f32x4 a = g10 * acc[ai][1][m][0], b = g11 * acc[ai][1][m][1]; u32x4 w; PK8(w, a, b); *(u32x4*)(op + 128) = w; }
                }
        };
        gemm_stream(ldsL, tid, DM, nextf, epi);
    }
    SEAM(6);

    if (IN(7)) {
        TIDS
        const float* g = P.in[I_N2G];
        u32x2 tn[4]; f32x4 xn[4];
        {
            const size_t r0 = (size_t)(blk * 8 + wave) * DM;
#pragma unroll
            for (int i = 0; i < 4; ++i) { tn[i] = *(const u32x2*)(W_xt + r0 + i * 256 + lane * 4); xn[i] = *(const f32x4*)(W_x + r0 + i * 256 + lane * 4); }
        }
        for (int row = blk * 8 + wave; row < NTOK; row += G * 8) {
            const int b = row >> 12;
            bf16_t* xr = W_xt + (size_t)row * DM;
            f32x4 v[4]; float ss = 0.f;
#pragma unroll
            for (int i = 0; i < 4; ++i) {
                const u32x2 tw = tn[i];
                const f32x4 tv = {__uint_as_float(tw.x << 16), __uint_as_float(tw.x & 0xffff0000u), __uint_as_float(tw.y << 16), __uint_as_float(tw.y & 0xffff0000u)};
                v[i] = tv + xn[i];
            }
            if (row + G * 8 < NTOK) {
                const size_t r1 = (size_t)(row + G * 8) * DM;
#pragma unroll
                for (int i = 0; i < 4; ++i) { tn[i] = *(const u32x2*)(W_xt + r1 + i * 256 + lane * 4); xn[i] = *(const f32x4*)(W_x + r1 + i * 256 + lane * 4); }
            }
#pragma unroll
            for (int i = 0; i < 4; ++i) {
                u32x2 xw; xw.x = pk2(v[i][0], v[i][1]); xw.y = pk2(v[i][2], v[i][3]);
                *(u32x2*)(xr + i * 256 + lane * 4) = xw;
                ss += v[i][0] * v[i][0] + v[i][1] * v[i][1] + v[i][2] * v[i][2] + v[i][3] * v[i][3]; }
            ss = wave_sum(ss);
            const float rinv = rsqrtf(ss * (1.0f / 1024.0f) + EPS);
            const float* mb = W_mod + b * 6144 + 3072;
#pragma unroll
            for (int i = 0; i < 4; ++i) {
                const int c = i * 256 + lane * 4;
                const f32x4 gg = *(const f32x4*)(g + c), sh = *(const f32x4*)(mb + c), sc = *(const f32x4*)(mb + 1024 + c);
                float o[4];
#pragma unroll
                for (int j = 0; j < 4; ++j) o[j] = v[i][j] * rinv * gg[j] * (1.0f + sc[j]) + sh[j];
                u32x2 w; w.x = pk2(o[0], o[1]); w.y = pk2(o[2], o[3]);
                *(u32x2*)(W_hbuf + (size_t)row * DM + c) = w;
            }
        }
    }
    SEAM(7);

    if (IN(8)) {
        {
            TIDS
            unsigned vl_[4]; g8_voff_lin(vl_, DM, tid);
            auto nextf = [&](int i, GDesc& d) {
                const int ul = vblk & 31; if (i > 0 || vblk >= 256) return false;
                const int pm = (vblk >> 5) * 16 + (ul >> 1), pn = ul & 1;
                d.Ab = (const char*)(W_hbuf + (size_t)pm * 256 * DM); d.Bb = (const char*)(W_Ws13T + (size_t)pn * 256 * DM);
                d.va0 = vl_[0]; d.va1 = vl_[1]; d.va2 = vl_[2]; d.va3 = vl_[3]; d.i0 = pm; d.i1 = pn; d.i2 = 0; return true;
            };
            auto epi = [&](const f32x4 (&acc)[2][2][4][2], const GDesc& d, int wr, int wc, int fr, int fq) {
                const int pm = d.i0, pn = d.i1;
#pragma unroll
                for (int ai = 0; ai < 2; ++ai)
#pragma unroll
                    for (int m = 0; m < 4; ++m) {
                        const int r = ai * 128 + wr * 64 + m * 16 + fr;
                        const f32x4 a0 = acc[ai][0][m][0], a1 = acc[ai][0][m][1], b0 = acc[ai][1][m][0], b1 = acc[ai][1][m][1];
                        f32x4 h0, h1;
#pragma unroll
                        for (int j = 0; j < 4; ++j) { h0[j] = siluf(a0[j]) * b0[j]; h1[j] = siluf(a1[j]) * b1[j]; }
                        u32x4 w; PK8(w, h0, h1);
                        *(u32x4*)(W_hdn + (size_t)(NASG + pm * 256 + r) * EFF + pn * 128 + wc * 32 + fq * 8) = w;
                    }
            };
            gemm_stream(ldsL, tid, DM, nextf, epi);
        }
        {
            TIDS
            unsigned vl_[4]; g8_voff_lin(vl_, DM, tid);
            auto nextf = [&](int i, GDesc& d) {
                const int ul = vblk & 31; if (i > 0 || ul < 16 || vblk >= 256) return false;
                const int pm = (vblk >> 5) * 16 + (ul - 16);
                d.Ab = (const char*)(W_hbuf + (size_t)pm * 256 * DM); d.Bb = (const char*)(W_WrT);
                d.va0 = vl_[0]; d.va1 = vl_[1]; d.va2 = vl_[2]; d.va3 = vl_[3]; d.i0 = pm; d.i1 = 0; d.i2 = 0; return true;
            };
            auto epi = [&](const f32x4 (&acc)[2][2][4][2], const GDesc& d, int wr, int wc, int fr, int fq) {
                const int pm = d.i0;
                EPI_FOREACH8(acc, wr, wc, fr, fq, r, c8, v0, v1, {
                    *(f32x4*)(W_logits + (size_t)(pm * 256 + r) * 256 + c8) = v0;
                    *(f32x4*)(W_logits + (size_t)(pm * 256 + r) * 256 + c8 + 4) = v1;
                })
            };
            gemm_stream(ldsL, tid, DM, nextf, epi);
        }
        if ((vblk & 31) < 16) {
            TIDS
#pragma unroll 1
            for (int q = 0; q < 2; ++q) {
                const int uu = blk + q * G;
                const int e = (G == 256) ? ((vblk & ~3) + q) : (uu >> 2), pn = (G == 256) ? (vblk & 3) : (uu & 3);
                __syncthreads();
                if (uu < 1024) convert_panel_lds<256, true>(W_scr + (size_t)2 * 256 * 1024 + (size_t)q * 256 * 256, P.in[I_W2] + (size_t)e * 256 * 1024 + pn * 256, 1024, 256, tid, ldsL);
            }
        }
    }
    SEAM(8);

    if (IN(9)) {
        TIDS
        const float* ebias = P.in[I_EB];
        const f32x4 eb = *(const f32x4*)(ebias + lane * 4);
        f32x4 lgn = *(const f32x4*)(W_logits + (size_t)(blk * 8 + wave) * 256 + lane * 4);
        for (int t = blk * 8 + wave; t < NTOK; t += G * 8) {
            const f32x4 lg = lgn;
            if (t + G * 8 < NTOK) lgn = *(const f32x4*)(W_logits + (size_t)(t + G * 8) * 256 + lane * 4);
            float sc[4], sel[4];
#pragma unroll
            for (int i = 0; i < 4; ++i) { sc[i] = 1.0f / (1.0f + expf(-lg[i])); sel[i] = sc[i] + eb[i]; }
            float a1 = fmaxf(sel[0], sel[1]), a2 = fminf(sel[0], sel[1]);
#pragma unroll
            for (int i = 2; i < 4; ++i) { const float v = sel[i]; a2 = fmaxf(a2, fminf(a1, v)); a1 = fmaxf(a1, v); }
            {
                float b1, b2, n1, n2;
                b1 = dppf(a1, DPP_X1); b2 = dppf(a2, DPP_X1); n1 = fmaxf(a1, b1); n2 = fmaxf(fminf(a1, b1), fmaxf(a2, b2)); a1 = n1; a2 = n2;
                b1 = dppf(a1, DPP_X2); b2 = dppf(a2, DPP_X2); n1 = fmaxf(a1, b1); n2 = fmaxf(fminf(a1, b1), fmaxf(a2, b2)); a1 = n1; a2 = n2;
                b1 = dppf(a1, DPP_HM); b2 = dppf(a2, DPP_HM); n1 = fmaxf(a1, b1); n2 = fmaxf(fminf(a1, b1), fmaxf(a2, b2)); a1 = n1; a2 = n2;
            }
            const float gs = a1 + a2; const int myg = lane >> 3;
            int rank = 0;
#pragma unroll
            for (int g = 0; g < 8; ++g) { const float v = __int_as_float(__builtin_amdgcn_readlane(__float_as_int(gs), g * 8)); rank += (v > gs || (v == gs && g < myg)) ? 1 : 0; }
            const bool gsel = rank < 4;
            unsigned key[4];
#pragma unroll
            for (int i = 0; i < 4; ++i) { const unsigned u = __float_as_uint(sel[i]); const unsigned mono = u ^ ((u >> 31) ? 0xFFFFFFFFu : 0x80000000u);
                key[i] = gsel ? ((mono & 0xFFFFFF00u) | (unsigned)(255 - (lane * 4 + i))) : 0u; }
            int my_e = 0; float my_g = 0.f; float gsum = 0.f;
#pragma unroll
            for (int k = 0; k < 8; ++k) {
                unsigned v = key[0] > key[1] ? key[0] : key[1]; { const unsigned w = key[2] > key[3] ? key[2] : key[3]; v = v > w ? v : w; }
#define UMX(o) do { const unsigned o_ = (unsigned)(o); v = v > o_ ? v : o_; } while (0)
                UMX(dppi((int)v, DPP_X1)); UMX(dppi((int)v, DPP_X2)); UMX(dppi((int)v, DPP_HM)); UMX(dppi((int)v, DPP_RM));
                { auto rv = __builtin_amdgcn_permlane16_swap(v, v, false, false); v = rv[0]; UMX(rv[1]); }
                { auto rv = __builtin_amdgcn_permlane32_swap(v, v, false, false); v = rv[0]; UMX(rv[1]); }
#undef UMX
                v = (unsigned)__builtin_amdgcn_readfirstlane((int)v);
                const int ix = 255 - (int)(v & 255u);
                float myscore = 0.f;
#pragma unroll
                for (int i = 0; i < 4; ++i) if (key[i] == v) { key[i] = 0u; myscore = sc[i]; }
                const float gw = __int_as_float(__builtin_amdgcn_readlane(__float_as_int(myscore), ix >> 2));
                gsum += gw;
                if (lane == k) { my_e = ix; my_g = gw; }
            }
            if (lane < 8) {
                const unsigned rk = atomicAdd(&cntg[my_e * CNT_STRIDE], 1u);
                W_eidx[t * 8 + lane] = my_e; W_gate[t * 8 + lane] = my_g / gsum * 2.5f; W_rnk[t * 8 + lane] = (int)rk;
            }
        }
    }
    SEAM(9);

    if (IN(10)) {
        TIDS
        if (tid < 256) cntL[tid] = (int)__hip_atomic_load(&cntg[tid * CNT_STRIDE], __ATOMIC_RELAXED, __HIP_MEMORY_SCOPE_AGENT);
        __syncthreads();
        if (tid < 256) { int s = 0; for (int j = 0; j < tid; ++j) s += cntL[j]; startL[tid] = s; }
        __syncthreads();
        for (int t = blk * 8 + wave; t < NTOK; t += G * 8) {
            if (lane < 8) {
                const int e = W_eidx[t * 8 + lane];
                const int d = startL[e] + W_rnk[t * 8 + lane];
                W_toks[d] = t; W_wts[d] = W_gate[t * 8 + lane]; W_pos[t * 8 + lane] = d;
            }
        }
    }
    SEAM(10);

    if (IN(11)) {
        TIDS
        __syncthreads();
        if (tid < 256) cntL[tid] = (int)__hip_atomic_load(&cntg[tid * CNT_STRIDE], __ATOMIC_RELAXED, __HIP_MEMORY_SCOPE_AGENT);
        __syncthreads();
        if (tid <= 256) { int sa = 0, tb = 0; for (int j = 0; j < tid; ++j) { sa += cntL[j]; tb += (cntL[j] + 255) >> 8; } startL[tid] = sa; tbL[tid] = tb; }
        __syncthreads();
        const int T1 = 2 * tbL[256];
        const int g0 = (int)(((long)vblk * T1) / G), g1 = (int)(((long)(vblk + 1) * T1) / G);
        for (int c0 = g0; c0 < g1; c0 += 8) {
            TIDS
            const int nch = (g1 - c0) < 8 ? (g1 - c0) : 8;
            __syncthreads();
            if (tid < nch) {
                const int g = c0 + tid; int e = 0;
                for (int j = 1; j < 256; ++j) if (2 * tbL[j] <= g) e = j;
                const int r = g - 2 * tbL[e];
                itemD[tid * 4 + 0] = e; itemD[tid * 4 + 1] = r & 1; itemD[tid * 4 + 2] = r >> 1;
            }
            __syncthreads();
            for (int idx = tid; idx < nch * 256; idx += 512) {
                const int it = idx >> 8, e = itemD[it * 4], ti = itemD[it * 4 + 2];
                const int rr = ti * 256 + (idx & 255); const int sr = startL[e] + (rr < cntL[e] ? rr : 0);
                rowoff[idx] = (unsigned)W_toks[sr] * DM;
            }
            __syncthreads();
            int R0, C0; g8_rc(tid, R0, C0);
            auto nextf = [&](int i, GDesc& d) {
                if (i >= nch) return false;
                const int e = itemD[i * 4], pn = itemD[i * 4 + 1], ti = itemD[i * 4 + 2];
                const int vo = (e & ~1) | pn; const int bo = (G == 256) ? ((vo & 31) * 8 + (vo >> 5)) : vo;
                d.Ab = (const char*)W_hbuf; d.Bb = (const char*)(ws + OFF_SCR + (size_t)bo * SCR_PER_BLK) + (size_t)(e & 1) * 512 * 1024;
                d.va0 = (rowoff[i * 256 + R0] + C0) * 2u; d.va1 = (rowoff[i * 256 + R0 + 64] + C0) * 2u; d.va2 = (rowoff[i * 256 + R0 + 128] + C0) * 2u; d.va3 = (rowoff[i * 256 + R0 + 192] + C0) * 2u;
                const int left = cntL[e] - ti * 256;
                d.i0 = startL[e] + ti * 256; d.i1 = left < 256 ? left : 256; d.i2 = pn; return true;
            };
            auto epi = [&](const f32x4 (&acc)[2][2][4][2], const GDesc& d, int wr, int wc, int fr, int fq) {
                const int rowbase = d.i0, nvalid = d.i1, pn = d.i2;
#pragma unroll
                for (int ai = 0; ai < 2; ++ai)
#pragma unroll
                    for (int m = 0; m < 4; ++m) {
                        const int r = ai * 128 + wr * 64 + m * 16 + fr;
                        if (r < nvalid) {
                            const f32x4 a0 = acc[ai][0][m][0], a1 = acc[ai][0][m][1], b0 = acc[ai][1][m][0], b1 = acc[ai][1][m][1];
                            f32x4 h0, h1;
#pragma unroll
                            for (int j = 0; j < 4; ++j) { h0[j] = siluf(a0[j]) * b0[j]; h1[j] = siluf(a1[j]) * b1[j]; }
                            u32x4 w; PK8(w, h0, h1);
                            *(u32x4*)(W_hdn + (size_t)(rowbase + r) * EFF + pn * 128 + wc * 32 + fq * 8) = w;
                        }
                    }
            };
            gemm_stream(ldsL, tid, DM, nextf, epi);
        }
    }
    SEAM(11);

    if (IN(12)) {
        TIDS
        __syncthreads();
        if (tid < 256) cntL[tid] = (int)__hip_atomic_load(&cntg[tid * CNT_STRIDE], __ATOMIC_RELAXED, __HIP_MEMORY_SCOPE_AGENT);
        if (tid == 256) cntL[256] = NTOK;
        __syncthreads();
        if (tid <= 257) { int sa = 0, tb = 0; for (int j = 0; j < tid; ++j) { sa += cntL[j]; tb += (cntL[j] + 255) >> 8; } if (tid <= 256) startL[tid] = sa; tbL[tid] = tb; }
        __syncthreads();
        const int T2 = 4 * tbL[257];
        const int g0 = (int)(((long)vblk * T2) / G), g1 = (int)(((long)(vblk + 1) * T2) / G);
#define Y_STORE(ROWG, COL0, G_) do { _Pragma("unroll") for (int bj = 0; bj < 2; ++bj) { const f32x4 a_ = acc[ai][bj][m][0], b_ = acc[ai][bj][m][1]; int w0_ = 0, w1_ = 0; \
            w0_ = __builtin_amdgcn_cvt_pk_fp8_f32(a_[0] * (G_), a_[1] * (G_), w0_, false); w0_ = __builtin_amdgcn_cvt_pk_fp8_f32(a_[2] * (G_), a_[3] * (G_), w0_, true); \
            w1_ = __builtin_amdgcn_cvt_pk_fp8_f32(b_[0] * (G_), b_[1] * (G_), w1_, false); w1_ = __builtin_amdgcn_cvt_pk_fp8_f32(b_[2] * (G_), b_[3] * (G_), w1_, true); \
            u32x2 w_; w_.x = (unsigned)w0_; w_.y = (unsigned)w1_; *(u32x2*)(W_y8 + (size_t)(ROWG) * DM + (COL0) + bj * 128 + wc * 32 + fq * 8) = w_; } } while (0)
        for (int c0 = g0; c0 < g1; c0 += 8) {
            TIDS
            const int nch = (g1 - c0) < 8 ? (g1 - c0) : 8;
            __syncthreads();
            if (tid < nch) {
                const int g = c0 + tid; int e = 0;
                for (int j = 1; j < 257; ++j) if (4 * tbL[j] <= g) e = j;
                const int r = g - 4 * tbL[e];
                itemD[tid * 4 + 0] = e; itemD[tid * 4 + 1] = r & 3; itemD[tid * 4 + 2] = r >> 2;
            }
            __syncthreads();
            for (int idx = tid; idx < nch * 256; idx += 512) {
                const int it = idx >> 8, e = itemD[it * 4], ti = itemD[it * 4 + 2];
                const int rr = ti * 256 + (idx & 255); const int sr = startL[e] + (rr < cntL[e] ? rr : 0);
                rowoff[idx] = (unsigned)sr * EFF; rowsc[idx] = (e < 256) ? W_wts[sr] : 1.0f;
            }
            __syncthreads();
            int R0, C0; g8_rc(tid, R0, C0);
            auto nextf = [&](int i, GDesc& d) {
                if (i >= nch) return false;
                const int e = itemD[i * 4], pn = itemD[i * 4 + 1], ti = itemD[i * 4 + 2];
                const int vo = (e & ~3) | pn; const int bo = (G == 256) ? ((vo & 31) * 8 + (vo >> 5)) : vo;
                d.Ab = (const char*)W_hdn;
                d.Bb = (e < 256) ? (const char*)(ws + OFF_SCR + (size_t)bo * SCR_PER_BLK) + (size_t)2 * 512 * 1024 + (size_t)(e & 3) * 128 * 1024 : (const char*)(W_Ws2T + (size_t)pn * 256 * EFF);
                d.va0 = (rowoff[i * 256 + R0] + C0) * 2u; d.va1 = (rowoff[i * 256 + R0 + 64] + C0) * 2u; d.va2 = (rowoff[i * 256 + R0 + 128] + C0) * 2u; d.va3 = (rowoff[i * 256 + R0 + 192] + C0) * 2u;
                const int left = cntL[e] - ti * 256;
                d.i0 = startL[e] + ti * 256; d.i1 = (left < 256 ? left : 256) | (i << 16); d.i2 = pn; return true;
            };
            auto epi = [&](const f32x4 (&acc)[2][2][4][2], const GDesc& d, int wr, int wc, int fr, int fq) {
                const int rowbase = d.i0, nvalid = d.i1 & 0xffff, tl = d.i1 >> 16, pn = d.i2;
#pragma unroll
                for (int ai = 0; ai < 2; ++ai)
#pragma unroll
                    for (int m = 0; m < 4; ++m) {
                        const int r = ai * 128 + wr * 64 + m * 16 + fr;
                        if (r < nvalid) { const float g = rowsc[tl * 256 + r]; Y_STORE(rowbase + r, pn * 256, g); }
                    }
            };
            gemm_stream(ldsL, tid, EFF, nextf, epi);
        }
#undef Y_STORE
    }
    SEAM(12);

    if (IN(13)) {
        TIDS
        const float* fg = P.in[I_FG];
        u32x4 yn[9]; u32x4 xn0, xn1;
#define P13_LOAD(ROW) do { const int row_ = (ROW); _Pragma("unroll") for (int k = 0; k < 9; ++k) { const int pr = (k < 8) ? W_pos[row_ * 8 + k] : (NASG + row_); \
            yn[k] = *(const u32x4*)(W_y8 + (size_t)pr * DM + lane * 16); } \
            const bf16_t* x1r = W_xt + (size_t)row_ * DM + lane * 16; xn0 = *(const u32x4*)x1r; xn1 = *(const u32x4*)(x1r + 8); } while (0)
        P13_LOAD(blk * 8 + wave);
        for (int row = blk * 8 + wave; row < NTOK; row += G * 8) {
            const int b = row >> 12;
            float a[16];
#pragma unroll
            for (int j = 0; j < 16; ++j) a[j] = 0.f;
            u32x4 yc[9];
#pragma unroll
            for (int k = 0; k < 9; ++k) yc[k] = yn[k];
            const u32x4 xw0 = xn0, xw1 = xn1;
            if (row + G * 8 < NTOK) P13_LOAD(row + G * 8);
#pragma unroll
            for (int k = 0; k < 9; ++k) {
                const u32x4 w = yc[k];
#pragma unroll
                for (int q = 0; q < 4; ++q) {
                    a[4 * q + 0] += __builtin_amdgcn_cvt_f32_fp8((int)w[q], 0); a[4 * q + 1] += __builtin_amdgcn_cvt_f32_fp8((int)w[q], 1);
                    a[4 * q + 2] += __builtin_amdgcn_cvt_f32_fp8((int)w[q], 2); a[4 * q + 3] += __builtin_amdgcn_cvt_f32_fp8((int)w[q], 3);
                }
            }
            float* xr = P.out + (size_t)row * DM + lane * 16;
            const float* g2 = W_mod + b * 6144 + 5120 + lane * 16;
            float v[16]; float ss = 0.f;
#pragma unroll
            for (int q = 0; q < 4; ++q) {
                const unsigned wa = (q < 2) ? xw0[2 * q] : xw1[2 * (q - 2)], wb = (q < 2) ? xw0[2 * q + 1] : xw1[2 * (q - 2) + 1];
                const f32x4 xa = {__uint_as_float(wa << 16), __uint_as_float(wa & 0xffff0000u), __uint_as_float(wb << 16), __uint_as_float(wb & 0xffff0000u)};
                const f32x4 ga = *(const f32x4*)(g2 + q * 4);
#pragma unroll
                for (int j = 0; j < 4; ++j) { v[q * 4 + j] = xa[j] + ga[j] * a[q * 4 + j]; ss += v[q * 4 + j] * v[q * 4 + j]; }
            }
            ss = wave_sum(ss);
            const float rinv = rsqrtf(ss * (1.0f / 1024.0f) + EPS);
#pragma unroll
            for (int q = 0; q < 4; ++q) {
                const f32x4 fa = *(const f32x4*)(fg + lane * 16 + q * 4);
                f32x4 oa;
#pragma unroll
                for (int j = 0; j < 4; ++j) oa[j] = v[q * 4 + j] * rinv * fa[j];
                *(f32x4*)(xr + q * 4) = oa;
            }
        }
    }
#ifdef DBG_STOP
    if (IN(14)) {
        TIDS
        const size_t NO = (size_t)NTOK * DM;
        for (size_t i = (size_t)blk * 512 + tid; i < NO; i += (size_t)G * 512) {
            unsigned hsh = 0u;
            const size_t row = i >> 10, c = i & 1023;
#define RB(p, idx) ((unsigned)(p)[(idx)])
#define RF(p, idx) (__float_as_uint((p)[(idx)]))
#if DBG_STOP == 0
            hsh = RB(W_WinT, i % (2304 * 1024)) ^ RB(W_WoT, i % (1024 * 1024)) ^ RB(W_WuqT, i % (768 * 384)) ^ RB(W_WukvT, i % (1024 * 256)) ^ RB(W_Ws13T, i % (512 * 1024)) ^ RB(W_Ws2T, i % (1024 * 256)) ^ RB(W_WrT, i % (256 * 1024))
                ^ RF(W_mod, i % (8 * 6144)) ^ RF(W_ropecs, i % (4096 * 32)) ^ RF(W_biasT, i % (3 * 8 * 129));
#elif DBG_STOP == 1 || DBG_STOP == 7
            hsh = RB(W_hbuf, i);
#elif DBG_STOP == 2
            hsh = RB(W_proj, row * INCP + c) ^ (RB(W_proj, row * INCP + 1024 + c) << 1) ^ (c < 160 ? (RB(W_proj, row * INCP + 2048 + c) << 2) : 0u);
#elif DBG_STOP == 3
            hsh = RB(W_kvb, i) ^ (c < 768 ? (RB(W_qb, row * 768 + c) << 1) : 0u);
#elif DBG_STOP == 4
            if (c < 512) hsh = RB(W_bout, row * 512 + c); else if (DBG_SUB) { const size_t cc = c - 512; hsh = RB(W_aparts, row * 512 + cc) ^ (RB(W_aparts, ((size_t)NTOK + row) * 512 + cc) << 1) ^ (RB(W_aparts, ((size_t)2 * NTOK + row) * 512 + cc) << 2) ^ RF(W_lsebuf, row * 8 + (cc >> 6)) ^ (RF(W_lsebuf, ((size_t)NTOK + row) * 8 + (cc >> 6)) << 1) ^ (RF(W_lsebuf, ((size_t)2 * NTOK + row) * 8 + (cc >> 6)) << 2); }
#elif DBG_STOP == 5
            hsh = RB(W_mixb, i);
#elif DBG_STOP == 6
            hsh = RF(P.out, i);
#elif DBG_STOP == 8
            if (c < 256) hsh = RF(W_logits, row * 256 + c); else if (c < 512) hsh = RB(W_hdn, ((size_t)NASG + row) * EFF + (c - 256));
#elif DBG_STOP == 9
            if (c < 8) hsh = (unsigned)W_eidx[row * 8 + c]; else if (c < 16) hsh = RF(W_gate, row * 8 + (c - 8));
#elif DBG_STOP == 11
            { const int k = (int)(c >> 8); hsh = RB(W_hdn, (size_t)W_pos[row * 8 + k] * EFF + (c & 255)) ^ (RB(W_hdn, (size_t)W_pos[row * 8 + 4 + k] * EFF + (c & 255)) << 1); }
#elif DBG_STOP == 12
            { for (int k = 0; k < 8; ++k) hsh ^= RB(W_ybuf, (size_t)W_pos[row * 8 + k] * DM + c) << (k & 3); hsh ^= RB(W_ybuf, ((size_t)NASG + row) * DM + c); }
#endif
            P.out[i] = (float)(hsh & 0xFu);
        }
    }
#endif
#undef IN
#undef SEAM
}

extern "C" void kernel_launch(void* const* d_in, const int* in_sizes, int n_in, void* d_out, int out_size, void* d_ws, size_t ws_size, hipStream_t stream) {
    static int grid = 0;
    if (grid == 0) {
        if (n_in != 24 || ws_size < WS_END) { fprintf(stderr, "kernel_launch: need 24 inputs and %zu bytes of workspace (got %d, %zu)\n", (size_t)WS_END, n_in, ws_size); grid = -1; return; }
        int dev = 0, cus = 0, per_cu = 0;
        if (hipGetDevice(&dev) != hipSuccess || hipDeviceGetAttribute(&cus, hipDeviceAttributeMultiprocessorCount, dev) != hipSuccess) { grid = -1; return; }
        if (hipFuncSetAttribute((const void*)fwd_kernel, hipFuncAttributeMaxDynamicSharedMemorySize, LDS_BYTES) != hipSuccess) { fprintf(stderr, "kernel_launch: hipFuncSetAttribute failed\n"); grid = -1; return; }
        if (hipOccupancyMaxActiveBlocksPerMultiprocessor(&per_cu, (const void*)fwd_kernel, 512, LDS_BYTES) != hipSuccess || per_cu < 1) { fprintf(stderr, "kernel_launch: occupancy query says %d\n", per_cu); }
        (void)hipGetLastError();
        if (cus < 256) { fprintf(stderr, "kernel_launch: this kernel needs 256 CUs (device reports %d)\n", cus); grid = -1; return; }
        grid = 256;
    }
    if (grid < 0) return;
    (void)hipMemsetAsync((char*)d_ws + OFF_CTL, 0, CTL_BYTES, stream);
    Params p{};
    for (int i = 0; i < 24; ++i) p.in[i] = (const float*)d_in[i];
    p.out = (float*)d_out; p.ws = (unsigned char*)d_ws;
#if MK_N_LAUNCHES == 1
    p.ph_lo = 0; p.ph_hi = NPHASE;
    hipLaunchKernelGGL(fwd_kernel, dim3(grid), dim3(512), LDS_BYTES, stream, p);
#else
#ifdef DBG_STOP
    for (int k = 0; k <= DBG_STOP; ++k) { p.ph_lo = k; p.ph_hi = k + 1; hipLaunchKernelGGL(fwd_kernel, dim3(grid), dim3(512), LDS_BYTES, stream, p); }
    p.ph_lo = 14; p.ph_hi = 15; hipLaunchKernelGGL(fwd_kernel, dim3(grid), dim3(512), LDS_BYTES, stream, p);
#else
#ifndef DBL_MASK
#define DBL_MASK 0u
#endif
#ifndef DBL_FLAGS
#define DBL_FLAGS 0
#endif
    for (int k = 0; k < 14; ++k) { p.ph_lo = k; p.ph_hi = k + 1; hipLaunchKernelGGL(fwd_kernel, dim3(grid), dim3(512), LDS_BYTES, stream, p);
        if ((DBL_MASK >> k) & 1u) { p.flags = DBL_FLAGS; hipLaunchKernelGGL(fwd_kernel, dim3(grid), dim3(512), LDS_BYTES, stream, p); p.flags = 0; } }
#endif
#endif
}
```

```cpp
#include <hip/hip_runtime.h>
#include <stdint.h>
#include <stdio.h>

#ifndef MK_N_LAUNCHES
#define MK_N_LAUNCHES 1
#endif

#define DEVI __device__ __forceinline__
typedef unsigned short bf16_t;
typedef short bf16x8 __attribute__((ext_vector_type(8)));
typedef short s16x4 __attribute__((ext_vector_type(4)));
typedef float f32x4 __attribute__((ext_vector_type(4)));
typedef float f32x16 __attribute__((ext_vector_type(16)));
typedef unsigned u32x4 __attribute__((ext_vector_type(4)));
typedef unsigned u32x2 __attribute__((ext_vector_type(2)));

constexpr int NTOK = 32768, SEQ = 4096, DM = 1024;
constexpr int INC = 2208, INCP = 2304;
constexpr int QLORA = 384, KVLORA = 256;
constexpr int NEXP = 256, EFF = 256;
constexpr int NASG = NTOK * 8;
constexpr int NROWS = NASG + NTOK;
constexpr float EPS = 1e-6f;
constexpr float LOG2E = 1.4426950408889634f;

constexpr size_t MiB = 1u << 20;
constexpr size_t OFF_CTL = 0, CTL_BYTES = 1 * MiB;
constexpr size_t OFF_MOD = 1 * MiB;
constexpr size_t OFF_ROPE = OFF_MOD + 256 * 1024;
constexpr size_t OFF_BIAS = OFF_ROPE + 512 * 1024;
constexpr size_t OFF_WIN = 2 * MiB;
constexpr size_t OFF_WUQ = OFF_WIN + 4608 * 1024;
constexpr size_t OFF_WUKV = OFF_WUQ + 1 * MiB;
constexpr size_t OFF_WO = OFF_WUKV + 512 * 1024;
constexpr size_t OFF_WR = OFF_WO + 2 * MiB;
constexpr size_t OFF_WS13 = OFF_WR + 512 * 1024;
constexpr size_t OFF_WS2 = OFF_WS13 + 1 * MiB;
constexpr size_t OFF_H = 12 * MiB;
constexpr size_t OFF_LOGITS = OFF_H + 64 * MiB;
constexpr size_t OFF_EIDX = OFF_LOGITS + 32 * MiB;
constexpr size_t OFF_GATE = OFF_EIDX + 1 * MiB;
constexpr size_t OFF_RNK = OFF_GATE + 1 * MiB;
constexpr size_t OFF_POS = OFF_RNK + 1 * MiB;
constexpr size_t OFF_TOKS = OFF_POS + 1 * MiB;
constexpr size_t OFF_WTS = OFF_TOKS + 1 * MiB;
constexpr size_t OFF_SSQ = OFF_WTS + 1 * MiB;
constexpr size_t OFF_SCR = OFF_SSQ + 4 * MiB;
constexpr size_t SCR_PER_BLK = 1536 * 1024;
constexpr size_t OFF_R = OFF_SCR + 384 * MiB;
constexpr size_t OFF_XT = OFF_R + 452 * MiB;
constexpr size_t WS_END = OFF_XT + 64 * MiB;
constexpr size_t OFF_PROJ = OFF_R;
constexpr size_t OFF_QB = OFF_PROJ + 144 * MiB;
constexpr size_t OFF_KVB = OFF_QB + 48 * MiB;
constexpr size_t OFF_BOUT = OFF_KVB + 64 * MiB;
constexpr size_t OFF_APARTS = OFF_BOUT + 32 * MiB;
constexpr size_t OFF_LSE = OFF_APARTS + 96 * MiB;
constexpr size_t OFF_MIX = OFF_LSE + 4 * MiB;
constexpr size_t OFF_Y = OFF_R;
constexpr size_t OFF_HDN = OFF_R + 288 * MiB;
static_assert(OFF_MIX + 64 * MiB <= WS_END, "alias map");
constexpr int CNT_WORD0 = 8192, CNT_STRIDE = 16;

constexpr int LDS_STAGE = 0;
constexpr int LDS_ROWOFF = 131072;
constexpr int LDS_ROWSC = LDS_ROWOFF + 8192;
constexpr int LDS_MISC = LDS_ROWSC + 8192;
constexpr int LDS_START = LDS_MISC + 256;
constexpr int LDS_CNT = LDS_START + 1280;
constexpr int LDS_TB = LDS_CNT + 1280;
constexpr int LDS_BYTES = 155648;
static_assert(LDS_TB + 1280 <= LDS_BYTES, "lds map");

#define XB_TMO      128
#define XB_XCNT(j)  (256  + 64 * (j))
#define XB_XSUB(j)  (1280 + 64 * (j))
#define XB_XGEN(j)  (2304 + 64 * (j))
#define XB_TOP      3328
#define XB_TOPGEN   3392
#define XCD_BAR_WORDS 3456
#define XB_SPIN_CAP (1u << 22)
#define LAS __attribute__((address_space(3)))

__device__ __forceinline__ unsigned xb_ld(unsigned* p)              { return __hip_atomic_load(p, __ATOMIC_RELAXED, __HIP_MEMORY_SCOPE_AGENT); }
__device__ __forceinline__ unsigned xb_add(unsigned* p, unsigned v) { return __hip_atomic_fetch_add(p, v, __ATOMIC_RELAXED, __HIP_MEMORY_SCOPE_AGENT); }
__device__ __forceinline__ unsigned xb_xcc_id() { return (unsigned)__builtin_amdgcn_s_getreg((3 << 11) | 20) & 0xFu; }
#define XB_SPIN(cond, bar) do { unsigned _sp = 0; while (cond) { __builtin_amdgcn_s_sleep(1); \
    if ((++_sp & 255u) == 0u) { if (xb_ld(&(bar)[XB_TMO])) break; if (_sp > XB_SPIN_CAP) { atomicAdd(&(bar)[XB_TMO], 1u); break; } } } } while (0)

struct XcdBarrier { unsigned* bar; unsigned x; volatile LAS unsigned* st; };

__device__ __forceinline__ XcdBarrier xcd_barrier_post(unsigned* bar, volatile LAS unsigned* st, const bool leader) {
    XcdBarrier b; b.bar = bar; b.x = xb_xcc_id(); b.st = st;
    if (leader) (void)xb_add(&bar[XB_XCNT(b.x)], 1u);
    return b;
}
__device__ __forceinline__ void xcd_barrier_complete(unsigned* bar, unsigned x, unsigned& nloc, unsigned& nx) {
    const unsigned G = gridDim.x * gridDim.y * gridDim.z;
    unsigned sum, cnt, mine, sp = 0u;
    for (;;) {
        sum = 0u; cnt = 0u; mine = 0u;
#pragma unroll
        for (unsigned j = 0; j < 16; ++j) { const unsigned c = xb_ld(&bar[XB_XCNT(j)]); sum += c; cnt += (c > 0u) ? 1u : 0u; mine = (j == x) ? c : mine; }
        if (sum == G) break;
        __builtin_amdgcn_s_sleep(1);
        if ((++sp & 255u) == 0u) { if (xb_ld(&bar[XB_TMO])) break; if (sp > XB_SPIN_CAP) { atomicAdd(&bar[XB_TMO], 1u); break; } }
    }
    nloc = mine > 0u ? mine : 1u; nx = cnt > 0u ? cnt : 1u;
}
__device__ __forceinline__ void xcd_barrier(const XcdBarrier& b, const bool leader) {
    asm volatile("s_waitcnt vmcnt(0)" ::: "memory");
    __syncthreads();
    if (leader) {
        unsigned* bar = b.bar;
        __builtin_amdgcn_s_waitcnt(0);
        unsigned nloc = b.st[0], nx = b.st[1];
        if (nloc == 0u) { xcd_barrier_complete(bar, b.x, nloc, nx); b.st[0] = nloc; b.st[1] = nx; }
        const unsigned old = xb_add(&bar[XB_XSUB(b.x)], 1u);
        const unsigned gen = old / nloc;
        if (old + 1u == (gen + 1u) * nloc) {
            __builtin_amdgcn_fence(__ATOMIC_RELEASE, "agent");
            asm volatile("s_waitcnt vmcnt(0)" ::: "memory");
            const unsigned og = xb_add(&bar[XB_TOP], 1u);
            const unsigned tg = og / nx;
            if (og + 1u == (tg + 1u) * nx) xb_add(&bar[XB_TOPGEN], 1u);
            else XB_SPIN(xb_ld(&bar[XB_TOPGEN]) == tg, bar);
            __builtin_amdgcn_fence(__ATOMIC_ACQUIRE, "agent");
            xb_add(&bar[XB_XGEN(b.x)], 1u);
            asm volatile("s_waitcnt vmcnt(0)" ::: "memory");
        } else {
            XB_SPIN(xb_ld(&bar[XB_XGEN(b.x)]) == gen, bar);
            __builtin_amdgcn_fence(__ATOMIC_ACQUIRE, "agent");
            asm volatile("s_waitcnt vmcnt(0)" ::: "memory");
        }
    }
    __syncthreads();
}

DEVI float bf2f(bf16_t v) { return __uint_as_float(((unsigned)v) << 16); }
typedef float f32x2_t __attribute__((ext_vector_type(2)));
typedef __bf16 bf16x2_t __attribute__((ext_vector_type(2)));
DEVI unsigned pk2(float lo, float hi) { f32x2_t v = {lo, hi}; bf16x2_t b = __builtin_convertvector(v, bf16x2_t); return __builtin_bit_cast(unsigned, b); }
#define dppf(v, ctrl) __int_as_float(__builtin_amdgcn_update_dpp(0, __float_as_int(v), (ctrl), 0xf, 0xf, false))
#define dppi(v, ctrl) __builtin_amdgcn_update_dpp(0, (v), (ctrl), 0xf, 0xf, false)
#define DPP_X1 0xB1
#define DPP_X2 0x4E
#define DPP_HM 0x141
#define DPP_RM 0x140
DEVI float x16f(float v, float& o) { auto r = __builtin_amdgcn_permlane16_swap(__float_as_uint(v), __float_as_uint(v), false, false); o = __uint_as_float(r[1]); return __uint_as_float(r[0]); }
DEVI float x32f(float v, float& o) { auto r = __builtin_amdgcn_permlane32_swap(__float_as_uint(v), __float_as_uint(v), false, false); o = __uint_as_float(r[1]); return __uint_as_float(r[0]); }
DEVI float sum32(float v) { float o; const float a = x32f(v, o); return a + o; }
DEVI float max32(float v) { float o; const float a = x32f(v, o); return fmaxf(a, o); }
DEVI float wave_sum(float v) {
    v += dppf(v, DPP_X1); v += dppf(v, DPP_X2); v += dppf(v, DPP_HM); v += dppf(v, DPP_RM);
    { float o; const float a = x16f(v, o); v = a + o; }
    { float o; const float a = x32f(v, o); v = a + o; }
    return v;
}
DEVI int perm_slot(int cl) { return 16 * ((cl >> 2) & 1) + 4 * (cl >> 3) + (cl & 3); }
DEVI int perm_row(int n) { return (n & ~31) + perm_slot(n & 31); }
DEVI float ex2(float x) { return __builtin_amdgcn_exp2f(x); }
DEVI float siluf(float v) { return v * __builtin_amdgcn_rcpf(1.0f + __expf(-v)); }

namespace g8 {
constexpr int BK = 64, HALF = 128, HT = HALF * BK;
DEVI int lds_byte(int r, int c) { int st = (r >> 4) * 2 + (c >> 5), rr = r & 15, cc = c & 31, ob = rr * 64 + cc * 2; return st * 1024 + (ob ^ (((ob >> 9) & 1) << 5)); }
DEVI void stage_rc(int b, int& R, int& C) { int st = b / 1024, sb = b % 1024, swz = sb ^ (((sb >> 9) & 1) << 5); R = (st >> 1) * 16 + swz / 64; C = (st & 1) * 32 + (swz % 64) / 2; }
}

DEVI void g8_rc(int tid, int& R0, int& C0) { g8::stage_rc(tid * 16, R0, C0); }
DEVI void g8_voff_lin(unsigned (&v)[4], int ld, int tid) { int R0, C0; g8_rc(tid, R0, C0);
    v[0] = (unsigned)(R0 * ld + C0) * 2u; v[1] = (unsigned)((R0 + 64) * ld + C0) * 2u; v[2] = (unsigned)((R0 + 128) * ld + C0) * 2u; v[3] = (unsigned)((R0 + 192) * ld + C0) * 2u; }
DEVI void g8_voff_tab(unsigned (&v)[4], const LAS unsigned* tab, int tid) { int R0, C0; g8_rc(tid, R0, C0);
    v[0] = (tab[R0] + C0) * 2u; v[1] = (tab[R0 + 64] + C0) * 2u; v[2] = (tab[R0 + 128] + C0) * 2u; v[3] = (tab[R0 + 192] + C0) * 2u; }

template <class Epi>
DEVI void gemm_tile(LAS unsigned char* lds, const int tid_in, const char* Ab, const unsigned (&voffA_)[4], const char* Bb, const int K, const Epi& epi) {
    using namespace g8;
    constexpr int HTB = HALF * BK * 2;
    int tz = tid_in; asm volatile("" : "+v"(tz));
    int wid = tz >> 6, lane = tz & 63, wr = wid >> 2, wc = wid & 3, fr = lane & 15, fq = lane >> 4;
    unsigned voffA[4] = {voffA_[0], voffA_[1], voffA_[2], voffA_[3]};
    asm volatile("" : "+v"(voffA[0]), "+v"(voffA[1]), "+v"(voffA[2]), "+v"(voffA[3]));
    unsigned voffB[2];
    { int R0, C0; stage_rc(tz * 16, R0, C0); voffB[0] = (unsigned)(R0 * K + C0) * 2u; voffB[1] = (unsigned)((R0 + 64) * K + C0) * 2u; }
    const size_t kstep = (size_t)(BK * 2);
    const size_t hstepB = (size_t)HALF * K * 2;
    const unsigned ldsw = (unsigned)wid * 1024u;
    const int aoff = lds_byte(wr * 64 + fr, fq * 8), boff = lds_byte(wc * 32 + fr, fq * 8);
#define G8_SA(b, h) (((b) * 2 + (h)) * HTB)
#define G8_SB(b, h) ((4 + (b) * 2 + (h)) * HTB)
#define G8_GL(gp, lofs) __builtin_amdgcn_global_load_lds((const unsigned*)(gp), (LAS unsigned*)(lds + (lofs)), 16, 0, 0)
#define STAGE_A(b, h, kt) do { const char* g_ = Ab + (size_t)(kt) * kstep; G8_GL(g_ + voffA[(h) * 2], G8_SA(b, h) + ldsw); G8_GL(g_ + voffA[(h) * 2 + 1], G8_SA(b, h) + ldsw + 8192); } while (0)
#define STAGE_B(b, h, kt) do { const char* g_ = Bb + (size_t)(kt) * kstep + ((h) ? hstepB : 0); G8_GL(g_ + voffB[0], G8_SB(b, h) + ldsw); G8_GL(g_ + voffB[1], G8_SB(b, h) + ldsw + 8192); } while (0)
#define LDA(dst, b, h) do { _Pragma("unroll") for (int m = 0; m < 4; ++m) _Pragma("unroll") for (int k = 0; k < 2; ++k) dst[m][k] = *(const LAS bf16x8*)(lds + G8_SA(b, h) + aoff + m * 2048 + k * 1024); } while (0)
#define LDB(dst, b, h) do { _Pragma("unroll") for (int n = 0; n < 2; ++n) _Pragma("unroll") for (int k = 0; k < 2; ++k) dst[n][k] = *(const LAS bf16x8*)(lds + G8_SB(b, h) + boff + n * 2048 + k * 1024); } while (0)
#define MMA(ai, bj, Af, Bf) do { __builtin_amdgcn_s_setprio(1); \
    _Pragma("unroll") for (int m = 0; m < 4; ++m) _Pragma("unroll") for (int n = 0; n < 2; ++n) _Pragma("unroll") for (int k = 0; k < 2; ++k) \
      acc[ai][bj][m][n] = __builtin_amdgcn_mfma_f32_16x16x32_bf16(Bf[n][k], Af[m][k], acc[ai][bj][m][n], 0, 0, 0); \
    __builtin_amdgcn_s_setprio(0); } while (0)
#define WAIT_V(n) asm volatile("s_waitcnt vmcnt(" #n ")" ::: "memory")
#define WAIT_L(n) asm volatile("s_waitcnt lgkmcnt(" #n ")" ::: "memory")
#define BAR __builtin_amdgcn_s_barrier()
#define SCHED __builtin_amdgcn_sched_barrier(0)
    f32x4 acc[2][2][4][2];
#pragma unroll
    for (int a = 0; a < 2; ++a)
#pragma unroll
        for (int b = 0; b < 2; ++b)
#pragma unroll
            for (int m = 0; m < 4; ++m)
#pragma unroll
                for (int n = 0; n < 2; ++n) acc[a][b][m][n] = (f32x4){0.f, 0.f, 0.f, 0.f};
    bf16x8 At[4][2], B0[2][2], B1[2][2];
    const int nt = K / BK;
    STAGE_B(0, 0, 0); STAGE_A(0, 0, 0); STAGE_B(0, 1, 0); STAGE_A(0, 1, 0);
    if (wr == 1) BAR;
    WAIT_V(4); BAR;
    STAGE_B(1, 0, 1); STAGE_A(1, 0, 1); STAGE_B(1, 1, 1);
    WAIT_V(6); BAR;
#pragma unroll 1
    for (int t = 0; t < nt; t += 2) {
        const int t2 = (t == nt - 2) ? 0 : t + 2;
        const int t3 = t2 + 1;
        LDB(B0, 0, 0); SCHED; LDA(At, 0, 0); STAGE_A(1, 1, t + 1);
        WAIT_L(8); BAR; WAIT_L(0); MMA(0, 0, At, B0); BAR; SCHED;
        LDB(B1, 0, 1); STAGE_B(0, 0, t2);
        BAR; WAIT_L(0); MMA(0, 1, At, B1); BAR;
        LDA(At, 0, 1); STAGE_A(0, 0, t2);
        BAR; WAIT_L(0); MMA(1, 0, At, B0); BAR; SCHED;
        STAGE_B(0, 1, t2);
        WAIT_V(6); BAR; MMA(1, 1, At, B1); BAR;
        LDB(B0, 1, 0); SCHED; LDA(At, 1, 0); STAGE_A(0, 1, t2);
        WAIT_L(8); BAR; WAIT_L(0); MMA(0, 0, At, B0); BAR; SCHED;
        LDB(B1, 1, 1); STAGE_B(1, 0, t3);
        BAR; WAIT_L(0); MMA(0, 1, At, B1); BAR;
        LDA(At, 1, 1); STAGE_A(1, 0, t3);
        BAR; WAIT_L(0); MMA(1, 0, At, B0); BAR; SCHED;
        STAGE_B(1, 1, t3);
        WAIT_V(6); BAR; MMA(1, 1, At, B1); BAR;
    }
    WAIT_V(0);
    if (wr == 0) BAR;
    BAR;
    asm volatile("" : "+v"(tz)); wid = tz >> 6; lane = tz & 63; wr = wid >> 2; wc = wid & 3; fr = lane & 15; fq = lane >> 4;
    epi(acc, wr, wc, fr, fq);
#undef G8_SA
#undef G8_SB
#undef G8_GL
#undef STAGE_A
#undef STAGE_B
#undef LDA
#undef LDB
#undef MMA
}
struct GDesc { const char* Ab; const char* Bb; unsigned va0, va1, va2, va3; int i0, i1, i2; };
template <class Next, class Epi>
DEVI void gemm_stream(LAS unsigned char* lds, const int tid_in, const int K, Next& next, const Epi& epi) {
    using namespace g8;
    constexpr int HTB = HALF * BK * 2;
    int tz = tid_in; asm volatile("" : "+v"(tz));
    int wid = tz >> 6, lane = tz & 63, wr = wid >> 2, wc = wid & 3, fr = lane & 15, fq = lane >> 4;
    unsigned voffB[2];
    { int R0, C0; stage_rc(tz * 16, R0, C0); voffB[0] = (unsigned)(R0 * K + C0) * 2u; voffB[1] = (unsigned)((R0 + 64) * K + C0) * 2u; }
    const size_t kstep = (size_t)(BK * 2);
    const size_t hstepB = (size_t)HALF * K * 2;
    const unsigned ldsw = (unsigned)wid * 1024u;
    const int aoff = lds_byte(wr * 64 + fr, fq * 8), boff = lds_byte(wc * 32 + fr, fq * 8);
#define G8_SA(b, h) (((b) * 2 + (h)) * HTB)
#define G8_SB(b, h) ((4 + (b) * 2 + (h)) * HTB)
#define G8_GL(gp, lofs) __builtin_amdgcn_global_load_lds((const unsigned*)(gp), (LAS unsigned*)(lds + (lofs)), 16, 0, 0)
#define STG_A(b, h, gb, v0, v1) do { G8_GL((gb) + (v0), G8_SA(b, h) + ldsw); G8_GL((gb) + (v1), G8_SA(b, h) + ldsw + 8192); } while (0)
#define STG_B(b, h, gb) do { const char* g_ = (gb) + ((h) ? hstepB : 0); G8_GL(g_ + voffB[0], G8_SB(b, h) + ldsw); G8_GL(g_ + voffB[1], G8_SB(b, h) + ldsw + 8192); } while (0)
#define LDA(dst, b, h) do { _Pragma("unroll") for (int m = 0; m < 4; ++m) _Pragma("unroll") for (int k = 0; k < 2; ++k) dst[m][k] = *(const LAS bf16x8*)(lds + G8_SA(b, h) + aoff + m * 2048 + k * 1024); } while (0)
#define LDB(dst, b, h) do { _Pragma("unroll") for (int n = 0; n < 2; ++n) _Pragma("unroll") for (int k = 0; k < 2; ++k) dst[n][k] = *(const LAS bf16x8*)(lds + G8_SB(b, h) + boff + n * 2048 + k * 1024); } while (0)
#define MMA(ai, bj, Af, Bf) do { __builtin_amdgcn_s_setprio(1); \
    _Pragma("unroll") for (int m = 0; m < 4; ++m) _Pragma("unroll") for (int n = 0; n < 2; ++n) _Pragma("unroll") for (int k = 0; k < 2; ++k) \
      acc[ai][bj][m][n] = __builtin_amdgcn_mfma_f32_16x16x32_bf16(Bf[n][k], Af[m][k], acc[ai][bj][m][n], 0, 0, 0); \
    __builtin_amdgcn_s_setprio(0); } while (0)
#define ZACC() do { _Pragma("unroll") for (int a = 0; a < 2; ++a) _Pragma("unroll") for (int b = 0; b < 2; ++b) _Pragma("unroll") for (int m = 0; m < 4; ++m) _Pragma("unroll") for (int n = 0; n < 2; ++n) acc[a][b][m][n] = (f32x4){0.f, 0.f, 0.f, 0.f}; } while (0)
    GDesc cur, nxt;
    if (!next(0, cur)) return;
    nxt = cur;
    f32x4 acc[2][2][4][2];
    ZACC();
    bf16x8 At[4][2], B0[2][2], B1[2][2];
    const int nt = K / BK;
    STG_B(0, 0, cur.Bb); STG_A(0, 0, cur.Ab, cur.va0, cur.va1); STG_B(0, 1, cur.Bb); STG_A(0, 1, cur.Ab, cur.va2, cur.va3);
    if (wr == 1) BAR;
    WAIT_V(4); BAR;
    STG_B(1, 0, cur.Bb + kstep); STG_A(1, 0, cur.Ab + kstep, cur.va0, cur.va1); STG_B(1, 1, cur.Bb + kstep);
    WAIT_V(6); BAR;
    int ui = 0; bool has_next = false;
#pragma unroll 1
    for (;;) {
#pragma unroll 1
        for (int t = 0; t < nt; t += 2) {
            const bool last = (t == nt - 2);
            if (last) { has_next = next(ui + 1, nxt); if (!has_next) nxt = cur; }
            const char* a2 = last ? nxt.Ab : cur.Ab + (size_t)(t + 2) * kstep;
            const char* b2 = last ? nxt.Bb : cur.Bb + (size_t)(t + 2) * kstep;
            const unsigned s0 = last ? nxt.va0 : cur.va0, s1 = last ? nxt.va1 : cur.va1, s2 = last ? nxt.va2 : cur.va2, s3 = last ? nxt.va3 : cur.va3;
            LDB(B0, 0, 0); SCHED; LDA(At, 0, 0); STG_A(1, 1, cur.Ab + (size_t)(t + 1) * kstep, cur.va2, cur.va3);
            WAIT_L(8); BAR; WAIT_L(0); MMA(0, 0, At, B0); BAR; SCHED;
            LDB(B1, 0, 1); STG_B(0, 0, b2);
            BAR; WAIT_L(0); MMA(0, 1, At, B1); BAR;
            LDA(At, 0, 1); STG_A(0, 0, a2, s0, s1);
            BAR; WAIT_L(0); MMA(1, 0, At, B0); BAR; SCHED;
            STG_B(0, 1, b2);
            WAIT_V(6); BAR; MMA(1, 1, At, B1); BAR;
            LDB(B0, 1, 0); SCHED; LDA(At, 1, 0); STG_A(0, 1, a2, s2, s3);
            WAIT_L(8); BAR; WAIT_L(0); MMA(0, 0, At, B0); BAR; SCHED;
            LDB(B1, 1, 1); STG_B(1, 0, b2 + kstep);
            BAR; WAIT_L(0); MMA(0, 1, At, B1); BAR;
            LDA(At, 1, 1); STG_A(1, 0, a2 + kstep, s0, s1);
            BAR; WAIT_L(0); MMA(1, 0, At, B0); BAR; SCHED;
            STG_B(1, 1, b2 + kstep);
            WAIT_V(6); BAR; MMA(1, 1, At, B1); BAR;
        }
        {
            int tq = tz; asm volatile("" : "+v"(tq));
            const int wid_ = tq >> 6, lane_ = tq & 63;
            epi(acc, cur, wid_ >> 2, wid_ & 3, lane_ & 15, lane_ >> 4);
        }
        if (!has_next) break;
        ZACC();
        cur = nxt; ++ui;
    }
    WAIT_V(0);
    if (wr == 0) BAR;
    BAR;
#undef G8_SA
#undef G8_SB
#undef G8_GL
#undef STG_A
#undef STG_B
#undef LDA
#undef LDB
#undef MMA
#undef ZACC
}
#define EPI_FOREACH8(acc, wr, wc, fr, fq, ROW, COL8, V0, V1, ...) \
    _Pragma("unroll") for (int ai_ = 0; ai_ < 2; ++ai_) _Pragma("unroll") for (int m_ = 0; m_ < 4; ++m_) { const int ROW = ai_ * 128 + (wr) * 64 + m_ * 16 + (fr); \
    _Pragma("unroll") for (int bj_ = 0; bj_ < 2; ++bj_) { const int COL8 = bj_ * 128 + (wc) * 32 + (fq) * 8; const f32x4 V0 = acc[ai_][bj_][m_][0]; const f32x4 V1 = acc[ai_][bj_][m_][1]; __VA_ARGS__ } }
#define PK8(w, a, b) do { w.x = pk2(a[0], a[1]); w.y = pk2(a[2], a[3]); w.z = pk2(b[0], b[1]); w.w = pk2(b[2], b[3]); } while (0)

template <class SCol, class DRow, class KS, class NS>
DEVI void convert_T(bf16_t* __restrict__ dst, const float* __restrict__ src, int ld, int K, int NR, SCol scol, DRow drow, KS ks, NS ns, int wi, int nw) {
    const int k8n = K >> 3; const int items = NR * k8n;
    for (int it = wi; it < items; it += nw) {
        const int n = it % NR, k0 = (it / NR) << 3;
        const int sc = scol(n);
        float v[8];
#pragma unroll
        for (int j = 0; j < 8; ++j) v[j] = (sc >= 0) ? src[(size_t)(k0 + j) * ld + sc] * ks(k0 + j) : 0.f;
        const float s = ns(n);
        u32x4 w; w.x = pk2(v[0] * s, v[1] * s); w.y = pk2(v[2] * s, v[3] * s); w.z = pk2(v[4] * s, v[5] * s); w.w = pk2(v[6] * s, v[7] * s);
        *(u32x4*)(dst + (size_t)drow(n) * K + k0) = w;
    }
}
struct IdCol { DEVI int operator()(int n) const { return n; } };
struct OneK { DEVI float operator()(int) const { return 1.f; } };
struct VecK { const float* g; DEVI float operator()(int k) const { return g[k]; } };

template <int NB, bool PERM>
DEVI void convert_panel(bf16_t* __restrict__ dst, const float* __restrict__ src, const int ld, const int K, const int tid) {
    constexpr int N4 = NB / 4;
    const int items = (K >> 3) * N4;
#pragma unroll 1
    for (int it0 = tid; it0 < items; it0 += 1024) {
        f32x4 v[2][8];
#pragma unroll
        for (int u = 0; u < 2; ++u) {
            const int it = it0 + u * 512; const int n4 = it % N4, k8 = it / N4;
            const float* sp = src + (size_t)(k8 * 8) * ld + n4 * 4;
#pragma unroll
            for (int j = 0; j < 8; ++j) v[u][j] = *(const f32x4*)(sp + (size_t)j * ld);
        }
#pragma unroll
        for (int u = 0; u < 2; ++u) {
            const int it = it0 + u * 512; const int n4 = it % N4, k8 = it / N4;
#pragma unroll
            for (int c = 0; c < 4; ++c) {
                u32x4 w; w.x = pk2(v[u][0][c], v[u][1][c]); w.y = pk2(v[u][2][c], v[u][3][c]); w.z = pk2(v[u][4][c], v[u][5][c]); w.w = pk2(v[u][6][c], v[u][7][c]);
                const int n = n4 * 4 + c; const int dr = PERM ? ((n & ~31) + perm_slot(n & 31)) : n;
                *(u32x4*)(dst + (size_t)dr * K + k8 * 8) = w;
            }
        }
    }
}

template <int NB, bool PERM>
DEVI void convert_panel_lds(bf16_t* __restrict__ dst, const float* __restrict__ src, const int ld, const int K, const int tid, LAS unsigned char* lds) {
    constexpr int N4 = NB / 4;
    constexpr int K8C = 512 / N4;
    constexpr int KC = K8C * 8;
    constexpr int PITCH = KC * 2 + 8;
    constexpr int PPR = KC / 8;
    const int n4 = tid % N4, k8 = tid / N4;
    const float* sp = src + (size_t)(k8 * 8) * ld + n4 * 4;
    const int nchunk = K / KC;
    f32x4 va[8], vb[8], vc[8];
#define CPL_LOAD(V, c) do { const float* q_ = sp + (size_t)(c) * KC * ld; _Pragma("unroll") for (int j = 0; j < 8; ++j) V[j] = *(const f32x4*)(q_ + (size_t)j * ld); } while (0)
#define CPL_PROC(V, c) do { \
        _Pragma("unroll") for (int cc = 0; cc < 4; ++cc) { \
            u32x2 lo, hi; lo.x = pk2(V[0][cc], V[1][cc]); lo.y = pk2(V[2][cc], V[3][cc]); hi.x = pk2(V[4][cc], V[5][cc]); hi.y = pk2(V[6][cc], V[7][cc]); \
            LAS unsigned char* wp = lds + (n4 * 4 + cc) * PITCH + k8 * 16; \
            *(LAS u32x2*)wp = lo; *(LAS u32x2*)(wp + 8) = hi; } \
        __syncthreads(); \
        _Pragma("unroll") for (int q = 0; q < 4; ++q) { \
            const int p = tid + 512 * q; const int row = p / PPR, pc = p % PPR; \
            const LAS unsigned char* rp = lds + row * PITCH + pc * 16; \
            const u32x2 a = *(const LAS u32x2*)rp, b = *(const LAS u32x2*)(rp + 8); \
            const int dr = PERM ? ((row & ~31) + perm_slot(row & 31)) : row; \
            u32x4 w; w.x = a.x; w.y = a.y; w.z = b.x; w.w = b.y; \
            *(u32x4*)(dst + (size_t)dr * K + (c) * KC + pc * 8) = w; } \
        __syncthreads(); } while (0)
    CPL_LOAD(va, 0); if (nchunk > 1) CPL_LOAD(vb, 1); if (nchunk > 2) CPL_LOAD(vc, 2);
#pragma unroll 1
    for (int c = 0; c < nchunk; c += 3) {
        CPL_PROC(va, c); if (c + 3 < nchunk) CPL_LOAD(va, c + 3);
        if (c + 1 < nchunk) { CPL_PROC(vb, c + 1); if (c + 4 < nchunk) CPL_LOAD(vb, c + 4); }
        if (c + 2 < nchunk) { CPL_PROC(vc, c + 2); if (c + 5 < nchunk) CPL_LOAD(vc, c + 5); }
    }
#undef CPL_LOAD
#undef CPL_PROC
}

struct Params {
    const float* in[24];
    float* out;
    unsigned char* ws;
    int ph_lo, ph_hi;
    int flags, pad;
};
enum { I_X = 0, I_C, I_WADA, I_BADA, I_N1G, I_WIN, I_QNG, I_WUQ, I_KVNG, I_WUKV, I_REL, I_AOG, I_BOG, I_WO, I_N2G, I_WR, I_EB, I_W1, I_W3, I_W2, I_WS1, I_WS3, I_WS2, I_FG };
constexpr int NPHASE = 15;

#define W_x (P.in[I_X])
#define W_mod ((float*)(ws + OFF_MOD))
#define W_ropecs ((float*)(ws + OFF_ROPE))
#define W_biasT ((float*)(ws + OFF_BIAS))
#define W_WinT ((bf16_t*)(ws + OFF_WIN))
#define W_WuqT ((bf16_t*)(ws + OFF_WUQ))
#define W_WukvT ((bf16_t*)(ws + OFF_WUKV))
#define W_WoT ((bf16_t*)(ws + OFF_WO))
#define W_WrT ((bf16_t*)(ws + OFF_WR))
#define W_Ws13T ((bf16_t*)(ws + OFF_WS13))
#define W_Ws2T ((bf16_t*)(ws + OFF_WS2))
#define W_hbuf ((bf16_t*)(ws + OFF_H))
#define W_logits ((float*)(ws + OFF_LOGITS))
#define W_eidx ((int*)(ws + OFF_EIDX))
#define W_gate ((float*)(ws + OFF_GATE))
#define W_rnk ((int*)(ws + OFF_RNK))
#define W_pos ((int*)(ws + OFF_POS))
#define W_toks ((int*)(ws + OFF_TOKS))
#define W_wts ((float*)(ws + OFF_WTS))
#define W_ssq ((float*)(ws + OFF_SSQ))
#define W_scr ((bf16_t*)(ws + OFF_SCR + (size_t)blk * SCR_PER_BLK))
#define W_hdn ((bf16_t*)(ws + OFF_HDN))
#define W_ybuf ((bf16_t*)(ws + OFF_Y))
#define W_y8 ((unsigned char*)(ws + OFF_Y))
#define W_proj ((bf16_t*)(ws + OFF_PROJ))
#define W_qb ((bf16_t*)(ws + OFF_QB))
#define W_kvb ((bf16_t*)(ws + OFF_KVB))
#define W_bout ((bf16_t*)(ws + OFF_BOUT))
#define W_aparts ((bf16_t*)(ws + OFF_APARTS))
#define W_lsebuf ((float*)(ws + OFF_LSE))
#define W_mixb ((bf16_t*)(ws + OFF_MIX))
#define W_xt ((bf16_t*)(ws + OFF_XT))

__global__ void __launch_bounds__(512, 2) fwd_kernel(Params P) {
    extern __shared__ __attribute__((aligned(16))) unsigned char lds[];
    const int blk = blockIdx.x, G = gridDim.x;
    const int wave_s = __builtin_amdgcn_readfirstlane((int)threadIdx.x >> 6);
#define TIDS0 int tid; asm volatile("v_mbcnt_lo_u32_b32 %0, -1, 0\n\tv_mbcnt_hi_u32_b32 %0, -1, %0" : "=v"(tid)); tid += wave_s * 64;
    const int vblk = (G % 8 == 0) ? (blk % 8) * (G / 8) + blk / 8 : blk;
    unsigned char* ws = P.ws;
    unsigned* ctl = (unsigned*)(ws + OFF_CTL);
    { TIDS0 if (tid < 64) ((LAS unsigned*)(lds + LDS_MISC))[tid] = 0u; }
    __syncthreads();
    XcdBarrier bar; bar.bar = ctl; bar.x = 0; bar.st = nullptr;
    if (MK_N_LAUNCHES == 1) { TIDS0 bar = xcd_barrier_post(ctl, (volatile LAS unsigned*)(lds + LDS_MISC), tid == 0); }
#ifndef PH_MASK
#define PH_MASK 0xffffffffu
#endif
#define TIDS int tid; asm volatile("v_mbcnt_lo_u32_b32 %0, -1, 0\n\tv_mbcnt_hi_u32_b32 %0, -1, %0" : "=v"(tid)); tid += wave_s * 64; const int lane = tid & 63; const int wave = wave_s; (void)lane; (void)wave;
#define IN(k) ((((PH_MASK) >> (k)) & 1u) && P.ph_lo <= (k) && (k) < P.ph_hi)
#define SEAM(k) do { if (MK_N_LAUNCHES == 1 && IN(k) && IN((k) + 1)) { TIDS0 xcd_barrier(bar, tid == 0); } } while (0)

    unsigned* cntg = ctl + CNT_WORD0;
    LAS unsigned* rowoff = (LAS unsigned*)(lds + LDS_ROWOFF);
    LAS float* rowsc = (LAS float*)(lds + LDS_ROWSC);
    LAS int* startL = (LAS int*)(lds + LDS_START);
    LAS int* cntL = (LAS int*)(lds + LDS_CNT);
    LAS int* tbL = (LAS int*)(lds + LDS_TB);
    LAS int* itemD = (LAS int*)(lds + LDS_MISC + 64);
    char* stage = (char*)lds + LDS_STAGE;
    LAS unsigned char* ldsL = (LAS unsigned char*)lds;

    if (IN(0)) {
        TIDS
        {
            float* sc = (float*)(lds);
            float* red = (float*)(lds + 32768);
            const float* c = P.in[I_C];
            for (int i = tid; i < 8192; i += 512) sc[i] = siluf(c[i]);
            __syncthreads();
            for (int cb = blk; cb < 256; cb += G) {
                const int cj = tid & 31, kg = tid >> 5;
                float a0 = 0, a1 = 0, a2 = 0, a3 = 0, a4 = 0, a5 = 0, a6 = 0, a7 = 0;
                if (cj < 24) {
                    const float* w = P.in[I_WADA] + cb * 24 + cj;
                    for (int k = kg * 64; k < kg * 64 + 64; ++k) {
                        const float wv = w[(size_t)k * 6144];
                        a0 += sc[k] * wv; a1 += sc[1024 + k] * wv; a2 += sc[2048 + k] * wv; a3 += sc[3072 + k] * wv;
                        a4 += sc[4096 + k] * wv; a5 += sc[5120 + k] * wv; a6 += sc[6144 + k] * wv; a7 += sc[7168 + k] * wv;
                    }
                }
                float* rp = red + (kg * 8) * 32 + cj;
                rp[0] = a0; rp[32] = a1; rp[64] = a2; rp[96] = a3; rp[128] = a4; rp[160] = a5; rp[192] = a6; rp[224] = a7;
                __syncthreads();
                if (tid < 256) {
                    const int b = tid >> 5, j = tid & 31;
                    if (j < 24) {
                        float s = 0.f;
                        for (int g = 0; g < 16; ++g) s += red[(g * 8 + b) * 32 + j];
                        const int col = cb * 24 + j;
                        W_mod[b * 6144 + col] = s + P.in[I_BADA][col];
                    }
                }
                __syncthreads();
            }
        }
        {
            for (int idx = blk * 512 + tid; idx < 4096 * 16; idx += G * 512) {
                const int s = idx >> 4, i = idx & 15;
                double inv = 1.0; for (int j = 0; j < i; ++j) inv *= 0.5623413251903491;
                const float invf = (float)inv;
                const float angf = (float)s * invf;
                const double xa = (double)angf;
                const double nrev = __builtin_rint(xa * 0.15915494309189535);
                const double r = xa - nrev * 6.283185307179586;
                const double r2 = r * r;
                double ts = r, ss = r, tc = 1.0, cc = 1.0;
#pragma unroll
                for (int n = 1; n <= 14; ++n) {
                    ts *= -r2 / (double)((2 * n) * (2 * n + 1)); ss += ts;
                    tc *= -r2 / (double)((2 * n - 1) * (2 * n)); cc += tc;
                }
                W_ropecs[idx * 2] = (float)cc; W_ropecs[idx * 2 + 1] = (float)ss;
            }
        }
        {
            for (int idx = blk * 512 + tid; idx < 3 * 8 * 129; idx += G * 512) {
                const int j = idx % 129, hh = (idx / 129) % 8, p = idx / (129 * 8);
                const int dil = (p == 0) ? 1 : (p == 1 ? 4 : 16);
                const int rel = (j - 64) * dil;
                const int n = rel < 0 ? -rel : rel;
                const float nf = (float)(n > 1 ? n : 1);
                int large = 8 + (int)(__logf(nf * 0.125f) / 4.852030263919617f * 8.0f);
                large = large < 15 ? large : 15;
                const int bucket = (rel > 0 ? 16 : 0) + (n < 8 ? n : large);
                W_biasT[idx] = P.in[I_REL][bucket * 8 + hh] * LOG2E;
            }
        }
        {
            const int wi = blk * 512 + tid, nw = G * 512;
            convert_T(W_WinT, P.in[I_WIN], INC, 1024, INCP,
                      [](int n) { if (n >= INC) return -1; if (n < 2176) return n; const int i = n - 2176; return 2176 + ((i & 1) ? 16 : 0) + (i >> 1); },
                      [](int n) { return perm_row(n); }, OneK{}, [](int n) { return n < 512 ? 0.125f * LOG2E : 1.0f; }, wi, nw);
            convert_T(W_WuqT, P.in[I_WUQ], 768, 384, 768,
                      [](int n) { if (n < 512) return (n >> 6) * 96 + (n & 63); const int hh = (n - 512) >> 5, i = n & 31; return hh * 96 + 64 + ((i & 1) ? 16 : 0) + (i >> 1); },
                      [](int n) { return perm_row(n); }, VecK{P.in[I_QNG]}, [](int) { return 0.10206207261596577f * LOG2E; }, wi, nw);
            convert_T(W_WukvT, P.in[I_WUKV], 1024, 256, 1024, IdCol{}, [](int n) { return perm_row(n); }, VecK{P.in[I_KVNG]}, [](int) { return 1.f; }, wi, nw);
            {
                const float* ag = P.in[I_AOG]; const float* bg = P.in[I_BOG];
                convert_T(W_WoT, P.in[I_WO], 1024, 1024, 1024, IdCol{}, [](int n) { return perm_row(n); }, [=](int k) { return k < 512 ? ag[k] : bg[k - 512]; }, [](int) { return 1.f; }, wi, nw);
            }
            convert_T(W_WrT, P.in[I_WR], 256, 1024, 256, IdCol{}, [](int n) { return perm_row(n); }, OneK{}, [](int) { return 1.f; }, wi, nw);
            convert_T(W_Ws13T, P.in[I_WS1], 256, 1024, 256, IdCol{}, [](int n) { return perm_row((n >> 7) * 256 + (n & 127)); }, OneK{}, [](int) { return 1.f; }, wi, nw);
            convert_T(W_Ws13T, P.in[I_WS3], 256, 1024, 256, IdCol{}, [](int n) { return perm_row((n >> 7) * 256 + 128 + (n & 127)); }, OneK{}, [](int) { return 1.f; }, wi, nw);
            convert_T(W_Ws2T, P.in[I_WS2], 1024, 256, 1024, IdCol{}, [](int n) { return perm_row(n); }, OneK{}, [](int) { return 1.f; }, wi, nw);
        }
    }
    SEAM(0);

    if (IN(1)) {
        TIDS
        const float* g = P.in[I_N1G];
        f32x4 vn[4];
        {
            const float* xr = W_x + (size_t)(blk * 8 + wave) * DM;
#pragma unroll
            for (int i = 0; i < 4; ++i) vn[i] = *(const f32x4*)(xr + i * 256 + lane * 4);
        }
        for (int row = blk * 8 + wave; row < NTOK; row += G * 8) {
            const int b = row >> 12;
            f32x4 v[4]; float ss = 0.f;
#pragma unroll
            for (int i = 0; i < 4; ++i) v[i] = vn[i];
            if (row + G * 8 < NTOK) {
                const float* xn = W_x + (size_t)(row + G * 8) * DM;
#pragma unroll
                for (int i = 0; i < 4; ++i) vn[i] = *(const f32x4*)(xn + i * 256 + lane * 4);
            }
#pragma unroll
            for (int i = 0; i < 4; ++i) ss += v[i][0] * v[i][0] + v[i][1] * v[i][1] + v[i][2] * v[i][2] + v[i][3] * v[i][3];
            ss = wave_sum(ss);
            const float rinv = rsqrtf(ss * (1.0f / 1024.0f) + EPS);
            const float* mb = W_mod + b * 6144;
#pragma unroll
            for (int i = 0; i < 4; ++i) {
                const int c = i * 256 + lane * 4;
                const f32x4 gg = *(const f32x4*)(g + c), sh = *(const f32x4*)(mb + c), sc = *(const f32x4*)(mb + 1024 + c);
                float o[4];
#pragma unroll
                for (int j = 0; j < 4; ++j) o[j] = v[i][j] * rinv * gg[j] * (1.0f + sc[j]) + sh[j];
                u32x2 w; w.x = pk2(o[0], o[1]); w.y = pk2(o[2], o[3]);
                *(u32x2*)(W_hbuf + (size_t)row * DM + c) = w;
            }
        }
    }
    SEAM(1);

    if (IN(2)) {
        TIDS
        unsigned vl_[4]; g8_voff_lin(vl_, DM, tid);
        auto nextf = [&](int i, GDesc& d) {
            const int ul = i * 32 + (vblk & 31); if (ul >= 144 || vblk >= 256) return false;
            const int pm = (vblk >> 5) * 16 + ul / 9, pn = ul % 9;
            d.Ab = (const char*)(W_hbuf + (size_t)pm * 256 * DM); d.Bb = (const char*)(W_WinT + (size_t)pn * 256 * DM);
            d.va0 = vl_[0]; d.va1 = vl_[1]; d.va2 = vl_[2]; d.va3 = vl_[3]; d.i0 = pm; d.i1 = pn; d.i2 = 0; return true;
        };
        auto epi = [&](const f32x4 (&acc)[2][2][4][2], const GDesc& d, int wr, int wc, int fr, int fq) {
            const int pm = d.i0, pn = d.i1;
            if (pn < 8) {
                EPI_FOREACH8(acc, wr, wc, fr, fq, r, c8, v0, v1, {
                    u32x4 w; PK8(w, v0, v1);
                    *(u32x4*)(W_proj + (size_t)(pm * 256 + r) * INCP + pn * 256 + c8) = w;
                })
            } else {
                EPI_FOREACH8(acc, wr, wc, fr, fq, r, c8, v0, v1, {
                    const int row = pm * 256 + r;
                    if (c8 < 160) {
                        f32x4 o0 = v0, o1 = v1;
                        if (c8 >= 128) {
                            const int i = (c8 - 128) >> 1; const int s = row & 4095;
                            const f32x4 ca = *(const f32x4*)(W_ropecs + (s * 16 + i) * 2), cb = *(const f32x4*)(W_ropecs + (s * 16 + i) * 2 + 4);
                            o0[0] = v0[0] * ca[0] - v0[1] * ca[1]; o0[1] = v0[1] * ca[0] + v0[0] * ca[1];
                            o0[2] = v0[2] * ca[2] - v0[3] * ca[3]; o0[3] = v0[3] * ca[2] + v0[2] * ca[3];
                            o1[0] = v1[0] * cb[0] - v1[1] * cb[1]; o1[1] = v1[1] * cb[0] + v1[0] * cb[1];
                            o1[2] = v1[2] * cb[2] - v1[3] * cb[3]; o1[3] = v1[3] * cb[2] + v1[2] * cb[3];
                        }
                        u32x4 w; PK8(w, o0, o1);
                        *(u32x4*)(W_proj + (size_t)row * INCP + 2048 + c8) = w;
                    }
                })
            }
            if (pn >= 6) {
#pragma unroll
                for (int ai = 0; ai < 2; ++ai)
#pragma unroll
                    for (int m = 0; m < 4; ++m)
#pragma unroll
                        for (int bj = 0; bj < 2; ++bj) {
                            const f32x4 a = acc[ai][bj][m][0], b = acc[ai][bj][m][1];
                            float ss = a[0] * a[0] + a[1] * a[1] + a[2] * a[2] + a[3] * a[3] + b[0] * b[0] + b[1] * b[1] + b[2] * b[2] + b[3] * b[3];
                            { float o; const float t = x16f(ss, o); ss = t + o; }
                            { float o; const float t = x32f(ss, o); ss = t + o; }
                            if (fq == 0) W_ssq[(size_t)(pm * 256 + ai * 128 + wr * 64 + m * 16 + fr) * 24 + (pn - 6) * 8 + bj * 4 + wc] = ss;
                        }
            }
        };
        gemm_stream(ldsL, tid, DM, nextf, epi);
        if ((vblk & 31) >= 16) {
            TIDS
#pragma unroll 1
            for (int q = 0; q < 2; ++q) {
                const int uu = blk + q * G;
                const int e = (G == 256) ? ((vblk & ~3) + q) : (uu >> 2), pn = (G == 256) ? (vblk & 3) : (uu & 3);
                __syncthreads();
                if (uu < 1024) convert_panel_lds<256, true>(W_scr + (size_t)2 * 256 * 1024 + (size_t)q * 256 * 256, P.in[I_W2] + (size_t)e * 256 * 1024 + pn * 256, 1024, 256, tid, ldsL);
            }
        }
    }
    SEAM(2);

    if (IN(3)) {
        {
            TIDS
            const int xb = (vblk >> 5) * 16, lb = vblk & 31;
            __syncthreads();
            for (int j = 0; j < 2; ++j) { const int ul = j * 32 + lb; if (ul < 48 && tid < 256) {
                const float* sp = W_ssq + (size_t)((xb + ul / 3) * 256 + tid) * 24;
                const f32x4 s0 = *(const f32x4*)sp, s1 = *(const f32x4*)(sp + 4), s2 = *(const f32x4*)(sp + 8);
                const float ss = ((s0[0] + s0[1]) + (s0[2] + s0[3])) + ((s1[0] + s1[1]) + (s1[2] + s1[3])) + ((s2[0] + s2[1]) + (s2[2] + s2[3]));
                rowsc[j * 256 + tid] = rsqrtf(ss * (1.0f / 384.0f) + EPS); } }
            __syncthreads();
            unsigned vl_[4]; g8_voff_lin(vl_, INCP, tid);
            auto nextf = [&](int i, GDesc& d) {
                const int ul = i * 32 + lb; if (ul >= 48 || vblk >= 256) return false;
                const int pm = xb + ul / 3, pn = ul % 3;
                d.Ab = (const char*)(W_proj + (size_t)pm * 256 * INCP + 1536); d.Bb = (const char*)(W_WuqT + (size_t)pn * 256 * QLORA);
                d.va0 = vl_[0]; d.va1 = vl_[1]; d.va2 = vl_[2]; d.va3 = vl_[3]; d.i0 = pm * 4 + pn; d.i1 = i; d.i2 = 0; return true;
            };
            auto epi = [&](const f32x4 (&acc)[2][2][4][2], const GDesc& d, int wr, int wc, int fr, int fq) {
                const int pm = d.i0 >> 2, pn = d.i0 & 3, sl = d.i1 * 256;
                if (pn < 2) {
                    EPI_FOREACH8(acc, wr, wc, fr, fq, r, c8, v0, v1, {
                        const float rs = rowsc[sl + r];
                        const f32x4 a = v0 * rs, b = v1 * rs;
                        u32x4 w; PK8(w, a, b);
                        *(u32x4*)(W_qb + (size_t)(pm * 256 + r) * 768 + pn * 256 + c8) = w;
                    })
                } else {
                    EPI_FOREACH8(acc, wr, wc, fr, fq, r, c8, v0, v1, {
                        const int row = pm * 256 + r;
                        const float rs = rowsc[sl + r];
                        const int i = (c8 & 31) >> 1; const int s = row & 4095;
                        const f32x4 ca = *(const f32x4*)(W_ropecs + (s * 16 + i) * 2), cb = *(const f32x4*)(W_ropecs + (s * 16 + i) * 2 + 4);
                        const f32x4 t0 = v0 * rs, t1 = v1 * rs;
                        f32x4 o0, o1;
                        o0[0] = t0[0] * ca[0] - t0[1] * ca[1]; o0[1] = t0[1] * ca[0] + t0[0] * ca[1];
                        o0[2] = t0[2] * ca[2] - t0[3] * ca[3]; o0[3] = t0[3] * ca[2] + t0[2] * ca[3];
                        o1[0] = t1[0] * cb[0] - t1[1] * cb[1]; o1[1] = t1[1] * cb[0] + t1[0] * cb[1];
                        o1[2] = t1[2] * cb[2] - t1[3] * cb[3]; o1[3] = t1[3] * cb[2] + t1[2] * cb[3];
                        u32x4 w; PK8(w, o0, o1);
                        *(u32x4*)(W_qb + (size_t)row * 768 + 512 + c8) = w;
                    })
                }
            };
            gemm_stream(ldsL, tid, QLORA, nextf, epi);
        }
        {
            TIDS
            const int xb = (vblk >> 5) * 16, lb = vblk & 31;
            __syncthreads();
            for (int j = 0; j < 2; ++j) { const int ul = j * 32 + lb; if (tid < 256) {
                const float* sp = W_ssq + (size_t)((xb + ul / 4) * 256 + tid) * 24 + 12;
                const f32x4 s0 = *(const f32x4*)sp, s1 = *(const f32x4*)(sp + 4);
                const float ss = ((s0[0] + s0[1]) + (s0[2] + s0[3])) + ((s1[0] + s1[1]) + (s1[2] + s1[3]));
                rowsc[j * 256 + tid] = rsqrtf(ss * (1.0f / 256.0f) + EPS); } }
            __syncthreads();
            unsigned vl_[4]; g8_voff_lin(vl_, INCP, tid);
            auto nextf = [&](int i, GDesc& d) {
                const int ul = i * 32 + lb; if (ul >= 64 || vblk >= 256) return false;
                const int pm = xb + ul / 4, pn = ul % 4;
                d.Ab = (const char*)(W_proj + (size_t)pm * 256 * INCP + 1920); d.Bb = (const char*)(W_WukvT + (size_t)pn * 256 * KVLORA);
                d.va0 = vl_[0]; d.va1 = vl_[1]; d.va2 = vl_[2]; d.va3 = vl_[3]; d.i0 = pm * 4 + pn; d.i1 = i; d.i2 = 0; return true;
            };
            auto epi = [&](const f32x4 (&acc)[2][2][4][2], const GDesc& d, int wr, int wc, int fr, int fq) {
                const int pm = d.i0 >> 2, pn = d.i0 & 3, sl = d.i1 * 256;
                EPI_FOREACH8(acc, wr, wc, fr, fq, r, c8, v0, v1, {
                    const float rs = rowsc[sl + r];
                    const f32x4 a = v0 * rs, b = v1 * rs;
                    u32x4 w; PK8(w, a, b);
                    *(u32x4*)(W_kvb + (size_t)(pm * 256 + r) * 1024 + pn * 256 + c8) = w;
                })
            };
            gemm_stream(ldsL, tid, KVLORA, nextf, epi);
        }
    }
    SEAM(3);

    if (IN(4)) {
        for (int ui = 0; ui < ((P.flags & 4) ? 0 : 4); ++ui) {
            TIDS
            const int r32 = lane & 31, hh = lane >> 5;
            if (vblk >= 256) break;
            const int qblk = vblk & 15, bh = (vblk >> 5) * 8 + ui * 2 + ((vblk >> 4) & 1), h = bh & 7, b = bh >> 3;
            const size_t tok0 = (size_t)b * SEQ;
            bf16x8 qf[6];
            {
                const size_t tq = tok0 + qblk * 256 + wave * 32 + r32;
#pragma unroll
                for (int d0 = 0; d0 < 6; ++d0) qf[d0] = *(const bf16x8*)(W_qb + tq * 768 + (d0 < 4 ? h * 64 + d0 * 16 : 512 + h * 32 + (d0 - 4) * 16) + hh * 8);
            }
            f32x16 o0 = {}, o1 = {};
            f32x16 mneg = {};
            float m_run = 0.f, l_run = 0.f;
            const int skey = tid >> 3, sch = tid & 7;
            const bf16_t* kn_src = W_kvb + (tok0 + skey) * 1024 + h * 128 + sch * 8;
            const int pkey = tid >> 2, pch = tid & 3;
            const bf16_t* kp_src = W_proj + (tok0 + pkey) * INCP + 2176 + pch * 8;
            constexpr int KBUF = 12 * 2048, VBUF = 2 * 8192, BUFB = KBUF + VBUF;
            const int k_dst = sch * 2048 + ((skey ^ sch) * 16);
            const int kp_dst = (8 + pch) * 2048 + ((pkey ^ pch) * 16);
            const int v_dst = KBUF + (sch >> 2) * 8192 + skey * 64 + (sch & 3) * 16;
            const int kfo = hh * 2048;
            const int vfo = KBUF + (4 * hh + ((lane & 15) >> 2)) * 64 + ((lane >> 4) & 1) * 32 + (lane & 3) * 8;
            __syncthreads();
            u32x4 nk0, nv0, nk1, nv1, npr;
            {
                const u32x4 k0 = *(const u32x4*)kn_src, v0 = *(const u32x4*)(kn_src + 64);
                const u32x4 k1 = *(const u32x4*)(kn_src + 64 * 1024), v1 = *(const u32x4*)(kn_src + 64 * 1024 + 64);
                const u32x4 pr = *(const u32x4*)kp_src;
                const bf16_t* ks = kn_src + (size_t)128 * 1024;
                const u32x4 a0 = *(const u32x4*)ks, b0 = *(const u32x4*)(ks + 64);
                const u32x4 a1 = *(const u32x4*)(ks + 64 * 1024), b1 = *(const u32x4*)(ks + 64 * 1024 + 64);
                const u32x4 pr1 = *(const u32x4*)(kp_src + (size_t)128 * INCP);
                const bf16_t* ks2 = kn_src + (size_t)256 * 1024;
                nk0 = *(const u32x4*)ks2; nv0 = *(const u32x4*)(ks2 + 64);
                nk1 = *(const u32x4*)(ks2 + 64 * 1024); nv1 = *(const u32x4*)(ks2 + 64 * 1024 + 64);
                npr = *(const u32x4*)(kp_src + (size_t)256 * INCP);
                *(LAS u32x4*)(ldsL + k_dst) = k0; *(LAS u32x4*)(ldsL + k_dst + 1024) = k1;
                *(LAS u32x4*)(ldsL + v_dst) = v0; *(LAS u32x4*)(ldsL + v_dst + 4096) = v1;
                *(LAS u32x4*)(ldsL + kp_dst) = pr;
                *(LAS u32x4*)(ldsL + BUFB + k_dst) = a0; *(LAS u32x4*)(ldsL + BUFB + k_dst + 1024) = a1;
                *(LAS u32x4*)(ldsL + BUFB + v_dst) = b0; *(LAS u32x4*)(ldsL + BUFB + v_dst + 4096) = b1;
                *(LAS u32x4*)(ldsL + BUFB + kp_dst) = pr1;
            }
            __syncthreads();
            auto qk = [&](f32x16& y0, f32x16& y1, const int kb) __attribute__((always_inline)) {
#pragma unroll
                for (int d0 = 0; d0 < 6; ++d0) {
                    const int sw = (2 * d0 + hh) & 7;
                    const bf16x8 k0 = *(const LAS bf16x8*)(ldsL + kb + d0 * 4096 + ((r32 ^ sw) * 16));
                    const bf16x8 k1 = *(const LAS bf16x8*)(ldsL + kb + d0 * 4096 + (((32 + r32) ^ sw) * 16));
                    if (d0 == 0) { y0 = __builtin_amdgcn_mfma_f32_32x32x16_bf16(k0, qf[0], mneg, 0, 0, 0); y1 = __builtin_amdgcn_mfma_f32_32x32x16_bf16(k1, qf[0], mneg, 0, 0, 0); }
                    else { y0 = __builtin_amdgcn_mfma_f32_32x32x16_bf16(k0, qf[d0], y0, 0, 0, 0); y1 = __builtin_amdgcn_mfma_f32_32x32x16_bf16(k1, qf[d0], y1, 0, 0, 0); }
                }
            };
            auto rowmax = [&](const f32x16& s0, const f32x16& s1) __attribute__((always_inline)) -> float {
#define MX3(a, b, c) __builtin_fmaxf(__builtin_fmaxf((a), (b)), (c))
                float mxa = MX3(s0[0], s0[1], s1[0]), mxb = MX3(s0[2], s0[3], s1[1]); mxa = MX3(mxa, s1[2], s1[3]);
#pragma unroll
                for (int i = 4; i < 16; i += 4) { mxa = MX3(mxa, s0[i], s0[i + 1]); mxb = MX3(mxb, s0[i + 2], s0[i + 3]); mxa = MX3(mxa, s1[i], s1[i + 1]); mxb = MX3(mxb, s1[i + 2], s1[i + 3]); }
#undef MX3
                return max32(__builtin_fmaxf(mxa, mxb));
            };
            auto step = [&](f32x16& x0, f32x16& x1, f32x16& y0, f32x16& y1, const int kb, const int vb) __attribute__((always_inline)) {
                qk(y0, y1, kb);
                f32x2_t psv = {0.f, 0.f};
#pragma unroll
                for (int i = 0; i < 16; i += 2) { x0[i] = ex2(x0[i]); x0[i + 1] = ex2(x0[i + 1]); x1[i] = ex2(x1[i]); x1[i + 1] = ex2(x1[i + 1]);
                    psv += (f32x2_t){x0[i], x0[i + 1]}; psv += (f32x2_t){x1[i], x1[i + 1]}; }
                l_run += psv[0] + psv[1];
                bf16x8 pf[2][2];
#pragma unroll
                for (int s = 0; s < 2; ++s) {
                    u32x4 w0, w1;
                    w0.x = pk2(x0[8 * s + 0], x0[8 * s + 1]); w0.y = pk2(x0[8 * s + 2], x0[8 * s + 3]); w0.z = pk2(x0[8 * s + 4], x0[8 * s + 5]); w0.w = pk2(x0[8 * s + 6], x0[8 * s + 7]);
                    w1.x = pk2(x1[8 * s + 0], x1[8 * s + 1]); w1.y = pk2(x1[8 * s + 2], x1[8 * s + 3]); w1.z = pk2(x1[8 * s + 4], x1[8 * s + 5]); w1.w = pk2(x1[8 * s + 6], x1[8 * s + 7]);
                    pf[0][s] = __builtin_bit_cast(bf16x8, w0); pf[1][s] = __builtin_bit_cast(bf16x8, w1);
                }
#pragma unroll
                for (int n = 0; n < 2; ++n)
#pragma unroll
                    for (int s = 0; s < 2; ++s) {
                        const int ko = (32 * n + 16 * s) * 64;
#pragma unroll
                        for (int db = 0; db < 2; ++db) {
                            const s16x4 lo = __builtin_bit_cast(s16x4, __builtin_amdgcn_ds_read_tr16_b64_v4i16((LAS s16x4*)(ldsL + vb + db * 8192 + ko)));
                            const s16x4 hi = __builtin_bit_cast(s16x4, __builtin_amdgcn_ds_read_tr16_b64_v4i16((LAS s16x4*)(ldsL + vb + db * 8192 + ko + 512)));
                            const bf16x8 vf = {lo[0], lo[1], lo[2], lo[3], hi[0], hi[1], hi[2], hi[3]};
                            if (db == 0) o0 = __builtin_amdgcn_mfma_f32_32x32x16_bf16(vf, pf[n][s], o0, 0, 0, 0);
                            else o1 = __builtin_amdgcn_mfma_f32_32x32x16_bf16(vf, pf[n][s], o1, 0, 0, 0);
                        }
                    }
                const float mx = rowmax(y0, y1);
                if (__builtin_amdgcn_ballot_w64(mx > 8.0f) != 0ull) {
                    const float d = fmaxf(mx, 0.f);
                    const float alpha = ex2(-d);
                    m_run += d; l_run *= alpha;
#pragma unroll
                    for (int i = 0; i < 16; ++i) { o0[i] *= alpha; o1[i] *= alpha; y0[i] -= d; y1[i] -= d; mneg[i] = -m_run; }
                }
            };
            f32x16 sa0, sa1, sb0, sb1;
            qk(sa0, sa1, kfo);
            {
                const float mx = rowmax(sa0, sa1);
                m_run = mx;
#pragma unroll
                for (int i = 0; i < 16; ++i) { sa0[i] -= mx; sa1[i] -= mx; mneg[i] = -mx; }
            }
            int cur = 0, nxt = BUFB, wr = 2 * BUFB;
#pragma unroll 1
            for (int t = 0; t < 32; ++t) {
                *(LAS u32x4*)(ldsL + wr + k_dst) = nk0; *(LAS u32x4*)(ldsL + wr + k_dst + 1024) = nk1;
                *(LAS u32x4*)(ldsL + wr + v_dst) = nv0; *(LAS u32x4*)(ldsL + wr + v_dst + 4096) = nv1;
                *(LAS u32x4*)(ldsL + wr + kp_dst) = npr;
                const int tn = (t + 3 < 32) ? t + 3 : 31;
                const bf16_t* ks = kn_src + (size_t)tn * 128 * 1024;
                nk0 = *(const u32x4*)ks; nv0 = *(const u32x4*)(ks + 64);
                nk1 = *(const u32x4*)(ks + 64 * 1024); nv1 = *(const u32x4*)(ks + 64 * 1024 + 64);
                npr = *(const u32x4*)(kp_src + (size_t)tn * 128 * INCP);
                step(sa0, sa1, sb0, sb1, cur + kfo + 1024, cur + vfo);
                step(sb0, sb1, sa0, sa1, nxt + kfo, cur + vfo + 4096);
                const int tmp = cur; cur = nxt; nxt = wr; wr = tmp;
                __syncthreads();
            }
            {
                const float lt = sum32(l_run);
                const float inv = 1.0f / lt;
                const int sc = 81920 + wave * 4352;
#pragma unroll
                for (int g = 0; g < 4; ++g) {
                    u32x2 w;
                    w.x = pk2(o0[4 * g] * inv, o0[4 * g + 1] * inv); w.y = pk2(o0[4 * g + 2] * inv, o0[4 * g + 3] * inv);
                    *(LAS u32x2*)(ldsL + sc + r32 * 136 + (8 * g + 4 * hh) * 2) = w;
                    w.x = pk2(o1[4 * g] * inv, o1[4 * g + 1] * inv); w.y = pk2(o1[4 * g + 2] * inv, o1[4 * g + 3] * inv);
                    *(LAS u32x2*)(ldsL + sc + r32 * 136 + (32 + 8 * g + 4 * hh) * 2) = w;
                }
                __syncthreads();
#pragma unroll
                for (int it = 0; it < 8; ++it) {
                    const int row = it * 4 + (lane >> 4), pc = lane & 15;
                    const u32x2 w = *(const LAS u32x2*)(ldsL + sc + row * 136 + pc * 8);
                    *(u32x2*)(W_bout + (tok0 + qblk * 256 + wave * 32 + row) * 512 + h * 64 + pc * 4) = w;
                }
            }
            if ((vblk & 3) == ui) {
#pragma unroll 1
                for (int sl = 0; sl < 4; ++sl) {
                    const int j = sl >> 1; const int uu = blk + j * G;
                    const int e = (G == 256) ? ((vblk & ~1) + j) : (uu >> 1), pn = (G == 256) ? (vblk & 1) : (uu & 1);
                    __syncthreads();
                    if (uu < 512) convert_panel_lds<128, true>(W_scr + (size_t)j * 256 * 1024 + (sl & 1) * 128 * 1024, P.in[(sl & 1) ? I_W3 : I_W1] + (size_t)e * 1024 * 256 + pn * 128, 256, 1024, tid, ldsL);
                }
            }
        }
        for (int ui = 0; ui < ((P.flags & 8) ? 0 : 12); ++ui) {
            TIDS
            const int r32 = lane & 31, hh = lane >> 5;
            const int u = vblk * 12 + ui;
            if (u >= 3072) break;
            const int bh = u / 48, w48 = u % 48, h = bh & 7, b = bh >> 3;
            const int p = w48 >> 4, j16 = w48 & 15;
            const int dil = (p == 0) ? 1 : (p == 1 ? 4 : 16);
            const int res = (p == 0) ? 0 : (p == 1 ? (j16 >> 2) : j16);
            const int m0 = (p == 0) ? j16 * 256 : (p == 1 ? (j16 & 3) * 256 : 0);
            const int L = SEQ / dil;
            const size_t tok0 = (size_t)b * SEQ;
            __syncthreads();
            for (int idx = tid; idx < 672; idx += 512) { const int oi = idx - 255; *(LAS float*)(ldsL + 98304 + idx * 4) = (oi >= 0 && oi <= 128) ? W_biasT[(p * 8 + h) * 129 + oi] : -1e30f; }
            {
                u32x4 kr[6], vr[6];
#pragma unroll
                for (int it = 0; it < 6; ++it) {
                    const int idx = it * 512 + tid, row = idx >> 3, ch = idx & 7;
                    const int mk = m0 - 64 + row;
                    kr[it] = (u32x4){0, 0, 0, 0}; vr[it] = (u32x4){0, 0, 0, 0};
                    if (mk >= 0 && mk < L) {
                        const bf16_t* src = W_proj + (tok0 + (size_t)mk * dil + res) * INCP + 512 + h * 64 + ch * 8;
                        kr[it] = *(const u32x4*)src; vr[it] = *(const u32x4*)(src + 512);
                    }
                }
#pragma unroll
                for (int it = 0; it < 6; ++it) {
                    const int idx = it * 512 + tid, row = idx >> 3, ch = idx & 7;
                    *(LAS u32x4*)(ldsL + ch * 6144 + ((row ^ ch) * 16)) = kr[it];
                    *(LAS u32x4*)(ldsL + 49152 + (ch >> 2) * 24576 + row * 64 + (ch & 3) * 16) = vr[it];
                }
            }
            const int qrel = wave * 32 + r32;
            const size_t tq = tok0 + (size_t)(m0 + qrel) * dil + res;
            bf16x8 qf[4];
#pragma unroll
            for (int d0 = 0; d0 < 4; ++d0) qf[d0] = *(const bf16x8*)(W_proj + tq * INCP + h * 64 + d0 * 16 + hh * 8);
            __syncthreads();
            f32x16 o0 = {}, o1 = {};
            float m_run = -1e20f, l_run = 0.f;
            const int vfo = 49152 + (4 * hh + ((lane & 15) >> 2)) * 64 + ((lane >> 4) & 1) * 32 + (lane & 3) * 8;
#pragma unroll 1
            for (int jj = 0; jj < 3; ++jj) {
                const int jt = (wave >> 1) + jj;
                f32x16 s0 = {}, s1 = {};
#pragma unroll
                for (int d0 = 0; d0 < 4; ++d0) {
                    const int ch = 2 * d0 + hh;
                    const bf16x8 k0 = *(const LAS bf16x8*)(ldsL + ch * 6144 + (((64 * jt + r32) ^ ch) * 16));
                    const bf16x8 k1 = *(const LAS bf16x8*)(ldsL + ch * 6144 + (((64 * jt + 32 + r32) ^ ch) * 16));
                    s0 = __builtin_amdgcn_mfma_f32_32x32x16_bf16(k0, qf[d0], s0, 0, 0, 0);
                    s1 = __builtin_amdgcn_mfma_f32_32x32x16_bf16(k1, qf[d0], s1, 0, 0, 0);
                }
                const LAS float* bl = (const LAS float*)(ldsL + 98304) + (64 * jt - qrel + 4 * hh + 255);
                const int mkb = m0 - 64 + 64 * jt;
                const bool edge = (mkb < 0) || (mkb + 64 > L);
                float mx = -1e30f;
#pragma unroll
                for (int i = 0; i < 16; ++i) {
                    const int cr = (i & 3) + 8 * (i >> 2);
                    s0[i] += bl[cr]; s1[i] += bl[cr + 32];
                    if (edge) {
                        const int mk0 = mkb + cr + 4 * hh;
                        if (mk0 < 0 || mk0 >= L) s0[i] = -1e30f;
                        if (mk0 + 32 < 0 || mk0 + 32 >= L) s1[i] = -1e30f;
                    }
                    mx = fmaxf(mx, fmaxf(s0[i], s1[i]));
                }
                mx = max32(mx);
                const float m_new = fmaxf(m_run, mx);
                const float alpha = ex2(m_run - m_new);
                m_run = m_new;
                float ps = 0.f;
#pragma unroll
                for (int i = 0; i < 16; ++i) { s0[i] = ex2(s0[i] - m_new); s1[i] = ex2(s1[i] - m_new); ps += s0[i] + s1[i]; }
                l_run = l_run * alpha + ps;
#pragma unroll
                for (int i = 0; i < 16; ++i) { o0[i] *= alpha; o1[i] *= alpha; }
                bf16x8 pf[2][2];
#pragma unroll
                for (int s = 0; s < 2; ++s) {
                    u32x4 w0, w1;
                    w0.x = pk2(s0[8 * s + 0], s0[8 * s + 1]); w0.y = pk2(s0[8 * s + 2], s0[8 * s + 3]); w0.z = pk2(s0[8 * s + 4], s0[8 * s + 5]); w0.w = pk2(s0[8 * s + 6], s0[8 * s + 7]);
                    w1.x = pk2(s1[8 * s + 0], s1[8 * s + 1]); w1.y = pk2(s1[8 * s + 2], s1[8 * s + 3]); w1.z = pk2(s1[8 * s + 4], s1[8 * s + 5]); w1.w = pk2(s1[8 * s + 6], s1[8 * s + 7]);
                    pf[0][s] = __builtin_bit_cast(bf16x8, w0); pf[1][s] = __builtin_bit_cast(bf16x8, w1);
                }
#pragma unroll
                for (int n = 0; n < 2; ++n)
#pragma unroll
                    for (int s = 0; s < 2; ++s) {
                        const int ko = (64 * jt + 32 * n + 16 * s) * 64;
#pragma unroll
                        for (int db = 0; db < 2; ++db) {
                            const s16x4 lo = __builtin_bit_cast(s16x4, __builtin_amdgcn_ds_read_tr16_b64_v4i16((LAS s16x4*)(ldsL + vfo + db * 24576 + ko)));
                            const s16x4 hi = __builtin_bit_cast(s16x4, __builtin_amdgcn_ds_read_tr16_b64_v4i16((LAS s16x4*)(ldsL + vfo + db * 24576 + ko + 512)));
                            const bf16x8 vf = {lo[0], lo[1], lo[2], lo[3], hi[0], hi[1], hi[2], hi[3]};
                            if (db == 0) o0 = __builtin_amdgcn_mfma_f32_32x32x16_bf16(vf, pf[n][s], o0, 0, 0, 0);
                            else o1 = __builtin_amdgcn_mfma_f32_32x32x16_bf16(vf, pf[n][s], o1, 0, 0, 0);
                        }
                    }
            }
            __syncthreads();
            {
                const float lt = sum32(l_run);
                const float inv = 1.0f / lt;
                if (hh == 0) W_lsebuf[((size_t)p * NTOK + tq) * 8 + h] = m_run + __log2f(lt);
                const int sc = wave * 4352;
#pragma unroll
                for (int g = 0; g < 4; ++g) {
                    u32x2 w;
                    w.x = pk2(o0[4 * g] * inv, o0[4 * g + 1] * inv); w.y = pk2(o0[4 * g + 2] * inv, o0[4 * g + 3] * inv);
                    *(LAS u32x2*)(ldsL + sc + r32 * 136 + (8 * g + 4 * hh) * 2) = w;
                    w.x = pk2(o1[4 * g] * inv, o1[4 * g + 1] * inv); w.y = pk2(o1[4 * g + 2] * inv, o1[4 * g + 3] * inv);
                    *(LAS u32x2*)(ldsL + sc + r32 * 136 + (32 + 8 * g + 4 * hh) * 2) = w;
                }
                __syncthreads();
#pragma unroll
                for (int it = 0; it < 8; ++it) {
                    const int row = it * 4 + (lane >> 4), pc = lane & 15;
                    const u32x2 w = *(const LAS u32x2*)(ldsL + sc + row * 136 + pc * 8);
                    const size_t tr = tok0 + (size_t)(m0 + wave * 32 + row) * dil + res;
                    *(u32x2*)(W_aparts + ((size_t)p * NTOK + tr) * 512 + h * 64 + pc * 4) = w;
                }
            }
            if ((vblk % 12) == ui) {
#pragma unroll 1
                for (int q = 2; q < 4; ++q) {
                    const int uu = blk + q * G;
                    const int e = (G == 256) ? ((vblk & ~3) + q) : (uu >> 2), pn = (G == 256) ? (vblk & 3) : (uu & 3);
                    __syncthreads();
                    if (uu < 1024) convert_panel_lds<256, true>(W_scr + (size_t)2 * 256 * 1024 + (size_t)q * 256 * 256, P.in[I_W2] + (size_t)e * 256 * 1024 + pn * 256, 1024, 256, tid, ldsL);
                }
            }
        }
    }
    SEAM(4);

    if (IN(5)) {
        TIDS
        const int hd = lane >> 3;
        float nl0, nl1, nl2; u32x4 na0, na1, na2, nbb;
#define P5_LOAD(ROW) do { const size_t r_ = (size_t)(ROW); nl0 = W_lsebuf[((size_t)0 * NTOK + r_) * 8 + hd]; nl1 = W_lsebuf[((size_t)1 * NTOK + r_) * 8 + hd]; nl2 = W_lsebuf[((size_t)2 * NTOK + r_) * 8 + hd]; \
            na0 = *(const u32x4*)(W_aparts + ((size_t)0 * NTOK + r_) * 512 + lane * 8); na1 = *(const u32x4*)(W_aparts + ((size_t)1 * NTOK + r_) * 512 + lane * 8); \
            na2 = *(const u32x4*)(W_aparts + ((size_t)2 * NTOK + r_) * 512 + lane * 8); nbb = *(const u32x4*)(W_bout + r_ * 512 + lane * 8); } while (0)
        P5_LOAD(blk * 8 + wave);
        for (int row = blk * 8 + wave; row < NTOK; row += G * 8) {
            const float ls0 = nl0, ls1 = nl1, ls2 = nl2; const u32x4 a0 = na0, a1 = na1, a2 = na2, bb = nbb;
            if (row + G * 8 < NTOK) P5_LOAD(row + G * 8);
            const float M = fmaxf(ls0, fmaxf(ls1, ls2));
            float w0 = ex2(ls0 - M), w1 = ex2(ls1 - M), w2 = ex2(ls2 - M);
            const float wsn = 1.0f / (w0 + w1 + w2); w0 *= wsn; w1 *= wsn; w2 *= wsn;
            float av[8], bv[8]; float sa = 0.f, sb = 0.f;
#pragma unroll
            for (int j = 0; j < 4; ++j) {
                av[2 * j] = w0 * __uint_as_float(a0[j] << 16) + w1 * __uint_as_float(a1[j] << 16) + w2 * __uint_as_float(a2[j] << 16);
                av[2 * j + 1] = w0 * __uint_as_float(a0[j] & 0xffff0000u) + w1 * __uint_as_float(a1[j] & 0xffff0000u) + w2 * __uint_as_float(a2[j] & 0xffff0000u);
                bv[2 * j] = __uint_as_float(bb[j] << 16); bv[2 * j + 1] = __uint_as_float(bb[j] & 0xffff0000u);
                sa += av[2 * j] * av[2 * j] + av[2 * j + 1] * av[2 * j + 1];
                sb += bv[2 * j] * bv[2 * j] + bv[2 * j + 1] * bv[2 * j + 1];
            }
            sa = wave_sum(sa); sb = wave_sum(sb);
            const float ra = rsqrtf(sa * (1.0f / 512.0f) + EPS), rb = rsqrtf(sb * (1.0f / 512.0f) + EPS);
            u32x4 wa, wb;
            wa.x = pk2(av[0] * ra, av[1] * ra); wa.y = pk2(av[2] * ra, av[3] * ra); wa.z = pk2(av[4] * ra, av[5] * ra); wa.w = pk2(av[6] * ra, av[7] * ra);
            wb.x = pk2(bv[0] * rb, bv[1] * rb); wb.y = pk2(bv[2] * rb, bv[3] * rb); wb.z = pk2(bv[4] * rb, bv[5] * rb); wb.w = pk2(bv[6] * rb, bv[7] * rb);
            *(u32x4*)(W_mixb + (size_t)row * DM + lane * 8) = wa;
            *(u32x4*)(W_mixb + (size_t)row * DM + 512 + lane * 8) = wb;
        }
    }
    SEAM(5);

    if (IN(6)) {
        TIDS
        unsigned vl_[4]; g8_voff_lin(vl_, DM, tid);
        auto nextf = [&](int i, GDesc& d) {
            const int ul = i * 32 + (vblk & 31); if (ul >= 64 || vblk >= 256) return false;
            const int pm = (vblk >> 5) * 16 + (ul >> 2), pn = ul & 3;
            d.Ab = (const char*)(W_mixb + (size_t)pm * 256 * DM); d.Bb = (const char*)(W_WoT + (size_t)pn * 256 * DM);
            d.va0 = vl_[0]; d.va1 = vl_[1]; d.va2 = vl_[2]; d.va3 = vl_[3]; d.i0 = pm; d.i1 = pn; d.i2 = 0; return true;
        };
        auto epi = [&](const f32x4 (&acc)[2][2][4][2], const GDesc& d, int wr, int wc, int fr, int fq) {
            const int pm = d.i0, pn = d.i1;
            const float* gbase = W_mod + ((pm * 256) >> 12) * 6144 + 2048 + pn * 256 + wc * 32 + fq * 8;
            const f32x4 g00 = *(const f32x4*)gbase, g01 = *(const f32x4*)(gbase + 4), g10 = *(const f32x4*)(gbase + 128), g11 = *(const f32x4*)(gbase + 132);
#pragma unroll
            for (int ai = 0; ai < 2; ++ai)
#pragma unroll
                for (int m = 0; m < 4; ++m) {
                    const int row = pm * 256 + ai * 128 + wr * 64 + m * 16 + fr;
                    bf16_t* op = W_xt + (size_t)row * DM + pn * 256 + wc * 32 + fq * 8;
                    { const f32x4 a = g00 * acc[ai][0][m][0], b = g01 * acc[ai][0][m][1]; u32x4 w; PK8(w, a, b); *(u32x4*)op = w; }
                    { const f32x4 a = g10 * acc[ai][1][m][0], b = g11 * acc[ai][1][m][1]; u32x4 w; PK8(w, a, b); *(u32x4*)(op + 128) = w; }
                }
        };
        gemm_stream(ldsL, tid, DM, nextf, epi);
    }
    SEAM(6);

    if (IN(7)) {
        TIDS
        const float* g = P.in[I_N2G];
        u32x2 tn[4]; f32x4 xn[4];
        {
            const size_t r0 = (size_t)(blk * 8 + wave) * DM;
#pragma unroll
            for (int i = 0; i < 4; ++i) { tn[i] = *(const u32x2*)(W_xt + r0 + i * 256 + lane * 4); xn[i] = *(const f32x4*)(W_x + r0 + i * 256 + lane * 4); }
        }
        for (int row = blk * 8 + wave; row < NTOK; row += G * 8) {
            const int b = row >> 12;
            bf16_t* xr = W_xt + (size_t)row * DM;
            f32x4 v[4]; float ss = 0.f;
#pragma unroll
            for (int i = 0; i < 4; ++i) {
                const u32x2 tw = tn[i];
                const f32x4 tv = {__uint_as_float(tw.x << 16), __uint_as_float(tw.x & 0xffff0000u), __uint_as_float(tw.y << 16), __uint_as_float(tw.y & 0xffff0000u)};
                v[i] = tv + xn[i];
            }
            if (row + G * 8 < NTOK) {
                const size_t r1 = (size_t)(row + G * 8) * DM;
#pragma unroll
                for (int i = 0; i < 4; ++i) { tn[i] = *(const u32x2*)(W_xt + r1 + i * 256 + lane * 4); xn[i] = *(const f32x4*)(W_x + r1 + i * 256 + lane * 4); }
            }
#pragma unroll
            for (int i = 0; i < 4; ++i) {
                u32x2 xw; xw.x = pk2(v[i][0], v[i][1]); xw.y = pk2(v[i][2], v[i][3]);
                *(u32x2*)(xr + i * 256 + lane * 4) = xw;
                ss += v[i][0] * v[i][0] + v[i][1] * v[i][1] + v[i][2] * v[i][2] + v[i][3] * v[i][3]; }
            ss = wave_sum(ss);
            const float rinv = rsqrtf(ss * (1.0f / 1024.0f) + EPS);
            const float* mb = W_mod + b * 6144 + 3072;
#pragma unroll
            for (int i = 0; i < 4; ++i) {
                const int c = i * 256 + lane * 4;
                const f32x4 gg = *(const f32x4*)(g + c), sh = *(const f32x4*)(mb + c), sc = *(const f32x4*)(mb + 1024 + c);
                float o[4];
#pragma unroll
                for (int j = 0; j < 4; ++j) o[j] = v[i][j] * rinv * gg[j] * (1.0f + sc[j]) + sh[j];
                u32x2 w; w.x = pk2(o[0], o[1]); w.y = pk2(o[2], o[3]);
                *(u32x2*)(W_hbuf + (size_t)row * DM + c) = w;
            }
        }
    }
    SEAM(7);

    if (IN(8)) {
        {
            TIDS
            unsigned vl_[4]; g8_voff_lin(vl_, DM, tid);
            auto nextf = [&](int i, GDesc& d) {
                const int ul = vblk & 31; if (i > 0 || vblk >= 256) return false;
                const int pm = (vblk >> 5) * 16 + (ul >> 1), pn = ul & 1;
                d.Ab = (const char*)(W_hbuf + (size_t)pm * 256 * DM); d.Bb = (const char*)(W_Ws13T + (size_t)pn * 256 * DM);
                d.va0 = vl_[0]; d.va1 = vl_[1]; d.va2 = vl_[2]; d.va3 = vl_[3]; d.i0 = pm; d.i1 = pn; d.i2 = 0; return true;
            };
            auto epi = [&](const f32x4 (&acc)[2][2][4][2], const GDesc& d, int wr, int wc, int fr, int fq) {
                const int pm = d.i0, pn = d.i1;
#pragma unroll
                for (int ai = 0; ai < 2; ++ai)
#pragma unroll
                    for (int m = 0; m < 4; ++m) {
                        const int r = ai * 128 + wr * 64 + m * 16 + fr;
                        const f32x4 a0 = acc[ai][0][m][0], a1 = acc[ai][0][m][1], b0 = acc[ai][1][m][0], b1 = acc[ai][1][m][1];
                        f32x4 h0, h1;
#pragma unroll
                        for (int j = 0; j < 4; ++j) { h0[j] = siluf(a0[j]) * b0[j]; h1[j] = siluf(a1[j]) * b1[j]; }
                        u32x4 w; PK8(w, h0, h1);
                        *(u32x4*)(W_hdn + (size_t)(NASG + pm * 256 + r) * EFF + pn * 128 + wc * 32 + fq * 8) = w;
                    }
            };
            gemm_stream(ldsL, tid, DM, nextf, epi);
        }
        {
            TIDS
            unsigned vl_[4]; g8_voff_lin(vl_, DM, tid);
            auto nextf = [&](int i, GDesc& d) {
                const int ul = vblk & 31; if (i > 0 || ul < 16 || vblk >= 256) return false;
                const int pm = (vblk >> 5) * 16 + (ul - 16);
                d.Ab = (const char*)(W_hbuf + (size_t)pm * 256 * DM); d.Bb = (const char*)(W_WrT);
                d.va0 = vl_[0]; d.va1 = vl_[1]; d.va2 = vl_[2]; d.va3 = vl_[3]; d.i0 = pm; d.i1 = 0; d.i2 = 0; return true;
            };
            auto epi = [&](const f32x4 (&acc)[2][2][4][2], const GDesc& d, int wr, int wc, int fr, int fq) {
                const int pm = d.i0;
                EPI_FOREACH8(acc, wr, wc, fr, fq, r, c8, v0, v1, {
                    *(f32x4*)(W_logits + (size_t)(pm * 256 + r) * 256 + c8) = v0;
                    *(f32x4*)(W_logits + (size_t)(pm * 256 + r) * 256 + c8 + 4) = v1;
                })
            };
            gemm_stream(ldsL, tid, DM, nextf, epi);
        }
        if ((vblk & 31) < 16) {
            TIDS
#pragma unroll 1
            for (int q = 0; q < 2; ++q) {
                const int uu = blk + q * G;
                const int e = (G == 256) ? ((vblk & ~3) + q) : (uu >> 2), pn = (G == 256) ? (vblk & 3) : (uu & 3);
                __syncthreads();
                if (uu < 1024) convert_panel_lds<256, true>(W_scr + (size_t)2 * 256 * 1024 + (size_t)q * 256 * 256, P.in[I_W2] + (size_t)e * 256 * 1024 + pn * 256, 1024, 256, tid, ldsL);
            }
        }
    }
    SEAM(8);

    if (IN(9)) {
        TIDS
        const float* ebias = P.in[I_EB];
        const f32x4 eb = *(const f32x4*)(ebias + lane * 4);
        f32x4 lgn = *(const f32x4*)(W_logits + (size_t)(blk * 8 + wave) * 256 + lane * 4);
        for (int t = blk * 8 + wave; t < NTOK; t += G * 8) {
            const f32x4 lg = lgn;
            if (t + G * 8 < NTOK) lgn = *(const f32x4*)(W_logits + (size_t)(t + G * 8) * 256 + lane * 4);
            float sc[4], sel[4];
#pragma unroll
            for (int i = 0; i < 4; ++i) { sc[i] = 1.0f / (1.0f + expf(-lg[i])); sel[i] = sc[i] + eb[i]; }
            float a1 = fmaxf(sel[0], sel[1]), a2 = fminf(sel[0], sel[1]);
#pragma unroll
            for (int i = 2; i < 4; ++i) { const float v = sel[i]; a2 = fmaxf(a2, fminf(a1, v)); a1 = fmaxf(a1, v); }
            {
                float b1, b2, n1, n2;
                b1 = dppf(a1, DPP_X1); b2 = dppf(a2, DPP_X1); n1 = fmaxf(a1, b1); n2 = fmaxf(fminf(a1, b1), fmaxf(a2, b2)); a1 = n1; a2 = n2;
                b1 = dppf(a1, DPP_X2); b2 = dppf(a2, DPP_X2); n1 = fmaxf(a1, b1); n2 = fmaxf(fminf(a1, b1), fmaxf(a2, b2)); a1 = n1; a2 = n2;
                b1 = dppf(a1, DPP_HM); b2 = dppf(a2, DPP_HM); n1 = fmaxf(a1, b1); n2 = fmaxf(fminf(a1, b1), fmaxf(a2, b2)); a1 = n1; a2 = n2;
            }
            const float gs = a1 + a2; const int myg = lane >> 3;
            int rank = 0;
#pragma unroll
            for (int g = 0; g < 8; ++g) { const float v = __int_as_float(__builtin_amdgcn_readlane(__float_as_int(gs), g * 8)); rank += (v > gs || (v == gs && g < myg)) ? 1 : 0; }
            const bool gsel = rank < 4;
            unsigned key[4];
#pragma unroll
            for (int i = 0; i < 4; ++i) { const unsigned u = __float_as_uint(sel[i]); const unsigned mono = u ^ ((u >> 31) ? 0xFFFFFFFFu : 0x80000000u);
                key[i] = gsel ? ((mono & 0xFFFFFF00u) | (unsigned)(255 - (lane * 4 + i))) : 0u; }
            int my_e = 0; float my_g = 0.f; float gsum = 0.f;
#pragma unroll
            for (int k = 0; k < 8; ++k) {
                unsigned v = key[0] > key[1] ? key[0] : key[1]; { const unsigned w = key[2] > key[3] ? key[2] : key[3]; v = v > w ? v : w; }
#define UMX(o) do { const unsigned o_ = (unsigned)(o); v = v > o_ ? v : o_; } while (0)
                UMX(dppi((int)v, DPP_X1)); UMX(dppi((int)v, DPP_X2)); UMX(dppi((int)v, DPP_HM)); UMX(dppi((int)v, DPP_RM));
                { auto rv = __builtin_amdgcn_permlane16_swap(v, v, false, false); v = rv[0]; UMX(rv[1]); }
                { auto rv = __builtin_amdgcn_permlane32_swap(v, v, false, false); v = rv[0]; UMX(rv[1]); }
#undef UMX
                v = (unsigned)__builtin_amdgcn_readfirstlane((int)v);
                const int ix = 255 - (int)(v & 255u);
                float myscore = 0.f;
#pragma unroll
                for (int i = 0; i < 4; ++i) if (key[i] == v) { key[i] = 0u; myscore = sc[i]; }
                const float gw = __int_as_float(__builtin_amdgcn_readlane(__float_as_int(myscore), ix >> 2));
                gsum += gw;
                if (lane == k) { my_e = ix; my_g = gw; }
            }
            if (lane < 8) {
                const unsigned rk = atomicAdd(&cntg[my_e * CNT_STRIDE], 1u);
                W_eidx[t * 8 + lane] = my_e; W_gate[t * 8 + lane] = my_g / gsum * 2.5f; W_rnk[t * 8 + lane] = (int)rk;
            }
        }
    }
    SEAM(9);

    if (IN(10)) {
        TIDS
        if (tid < 256) cntL[tid] = (int)__hip_atomic_load(&cntg[tid * CNT_STRIDE], __ATOMIC_RELAXED, __HIP_MEMORY_SCOPE_AGENT);
        __syncthreads();
        if (tid < 256) { int s = 0; for (int j = 0; j < tid; ++j) s += cntL[j]; startL[tid] = s; }
        __syncthreads();
        for (int t = blk * 8 + wave; t < NTOK; t += G * 8) {
            if (lane < 8) {
                const int e = W_eidx[t * 8 + lane];
                const int d = startL[e] + W_rnk[t * 8 + lane];
                W_toks[d] = t; W_wts[d] = W_gate[t * 8 + lane]; W_pos[t * 8 + lane] = d;
            }
        }
    }
    SEAM(10);

    if (IN(11)) {
        TIDS
        __syncthreads();
        if (tid < 256) cntL[tid] = (int)__hip_atomic_load(&cntg[tid * CNT_STRIDE], __ATOMIC_RELAXED, __HIP_MEMORY_SCOPE_AGENT);
        __syncthreads();
        if (tid <= 256) { int sa = 0, tb = 0; for (int j = 0; j < tid; ++j) { sa += cntL[j]; tb += (cntL[j] + 255) >> 8; } startL[tid] = sa; tbL[tid] = tb; }
        __syncthreads();
        const int T1 = 2 * tbL[256];
        const int g0 = (int)(((long)vblk * T1) / G), g1 = (int)(((long)(vblk + 1) * T1) / G);
        for (int c0 = g0; c0 < g1; c0 += 8) {
            TIDS
            const int nch = (g1 - c0) < 8 ? (g1 - c0) : 8;
            __syncthreads();
            if (tid < nch) {
                const int g = c0 + tid; int e = 0;
                for (int j = 1; j < 256; ++j) if (2 * tbL[j] <= g) e = j;
                const int r = g - 2 * tbL[e];
                itemD[tid * 4 + 0] = e; itemD[tid * 4 + 1] = r & 1; itemD[tid * 4 + 2] = r >> 1;
            }
            __syncthreads();
            for (int idx = tid; idx < nch * 256; idx += 512) {
                const int it = idx >> 8, e = itemD[it * 4], ti = itemD[it * 4 + 2];
                const int rr = ti * 256 + (idx & 255); const int sr = startL[e] + (rr < cntL[e] ? rr : 0);
                rowoff[idx] = (unsigned)W_toks[sr] * DM;
            }
            __syncthreads();
            int R0, C0; g8_rc(tid, R0, C0);
            auto nextf = [&](int i, GDesc& d) {
                if (i >= nch) return false;
                const int e = itemD[i * 4], pn = itemD[i * 4 + 1], ti = itemD[i * 4 + 2];
                const int vo = (e & ~1) | pn; const int bo = (G == 256) ? ((vo & 31) * 8 + (vo >> 5)) : vo;
                d.Ab = (const char*)W_hbuf; d.Bb = (const char*)(ws + OFF_SCR + (size_t)bo * SCR_PER_BLK) + (size_t)(e & 1) * 512 * 1024;
                d.va0 = (rowoff[i * 256 + R0] + C0) * 2u; d.va1 = (rowoff[i * 256 + R0 + 64] + C0) * 2u; d.va2 = (rowoff[i * 256 + R0 + 128] + C0) * 2u; d.va3 = (rowoff[i * 256 + R0 + 192] + C0) * 2u;
                const int left = cntL[e] - ti * 256;
                d.i0 = startL[e] + ti * 256; d.i1 = left < 256 ? left : 256; d.i2 = pn; return true;
            };
            auto epi = [&](const f32x4 (&acc)[2][2][4][2], const GDesc& d, int wr, int wc, int fr, int fq) {
                const int rowbase = d.i0, nvalid = d.i1, pn = d.i2;
#pragma unroll
                for (int ai = 0; ai < 2; ++ai)
#pragma unroll
                    for (int m = 0; m < 4; ++m) {
                        const int r = ai * 128 + wr * 64 + m * 16 + fr;
                        if (r < nvalid) {
                            const f32x4 a0 = acc[ai][0][m][0], a1 = acc[ai][0][m][1], b0 = acc[ai][1][m][0], b1 = acc[ai][1][m][1];
                            f32x4 h0, h1;
#pragma unroll
                            for (int j = 0; j < 4; ++j) { h0[j] = siluf(a0[j]) * b0[j]; h1[j] = siluf(a1[j]) * b1[j]; }
                            u32x4 w; PK8(w, h0, h1);
                            *(u32x4*)(W_hdn + (size_t)(rowbase + r) * EFF + pn * 128 + wc * 32 + fq * 8) = w;
                        }
                    }
            };
            gemm_stream(ldsL, tid, DM, nextf, epi);
        }
    }
    SEAM(11);

    if (IN(12)) {
        TIDS
        __syncthreads();
        if (tid < 256) cntL[tid] = (int)__hip_atomic_load(&cntg[tid * CNT_STRIDE], __ATOMIC_RELAXED, __HIP_MEMORY_SCOPE_AGENT);
        if (tid == 256) cntL[256] = NTOK;
        __syncthreads();
        if (tid <= 257) { int sa = 0, tb = 0; for (int j = 0; j < tid; ++j) { sa += cntL[j]; tb += (cntL[j] + 255) >> 8; } if (tid <= 256) startL[tid] = sa; tbL[tid] = tb; }
        __syncthreads();
        const int T2 = 4 * tbL[257];
        const int g0 = (int)(((long)vblk * T2) / G), g1 = (int)(((long)(vblk + 1) * T2) / G);
#define Y_STORE(ROWG, COL0, G_) do { _Pragma("unroll") for (int bj = 0; bj < 2; ++bj) { const f32x4 a_ = acc[ai][bj][m][0], b_ = acc[ai][bj][m][1]; int w0_ = 0, w1_ = 0; \
            w0_ = __builtin_amdgcn_cvt_pk_fp8_f32(a_[0] * (G_), a_[1] * (G_), w0_, false); w0_ = __builtin_amdgcn_cvt_pk_fp8_f32(a_[2] * (G_), a_[3] * (G_), w0_, true); \
            w1_ = __builtin_amdgcn_cvt_pk_fp8_f32(b_[0] * (G_), b_[1] * (G_), w1_, false); w1_ = __builtin_amdgcn_cvt_pk_fp8_f32(b_[2] * (G_), b_[3] * (G_), w1_, true); \
            u32x2 w_; w_.x = (unsigned)w0_; w_.y = (unsigned)w1_; *(u32x2*)(W_y8 + (size_t)(ROWG) * DM + (COL0) + bj * 128 + wc * 32 + fq * 8) = w_; } } while (0)
        for (int c0 = g0; c0 < g1; c0 += 8) {
            TIDS
            const int nch = (g1 - c0) < 8 ? (g1 - c0) : 8;
            __syncthreads();
            if (tid < nch) {
                const int g = c0 + tid; int e = 0;
                for (int j = 1; j < 257; ++j) if (4 * tbL[j] <= g) e = j;
                const int r = g - 4 * tbL[e];
                itemD[tid * 4 + 0] = e; itemD[tid * 4 + 1] = r & 3; itemD[tid * 4 + 2] = r >> 2;
            }
            __syncthreads();
            for (int idx = tid; idx < nch * 256; idx += 512) {
                const int it = idx >> 8, e = itemD[it * 4], ti = itemD[it * 4 + 2];
                const int rr = ti * 256 + (idx & 255); const int sr = startL[e] + (rr < cntL[e] ? rr : 0);
                rowoff[idx] = (unsigned)sr * EFF; rowsc[idx] = (e < 256) ? W_wts[sr] : 1.0f;
            }
            __syncthreads();
            int R0, C0; g8_rc(tid, R0, C0);
            auto nextf = [&](int i, GDesc& d) {
                if (i >= nch) return false;
                const int e = itemD[i * 4], pn = itemD[i * 4 + 1], ti = itemD[i * 4 + 2];
                const int vo = (e & ~3) | pn; const int bo = (G == 256) ? ((vo & 31) * 8 + (vo >> 5)) : vo;
                d.Ab = (const char*)W_hdn;
                d.Bb = (e < 256) ? (const char*)(ws + OFF_SCR + (size_t)bo * SCR_PER_BLK) + (size_t)2 * 512 * 1024 + (size_t)(e & 3) * 128 * 1024 : (const char*)(W_Ws2T + (size_t)pn * 256 * EFF);
                d.va0 = (rowoff[i * 256 + R0] + C0) * 2u; d.va1 = (rowoff[i * 256 + R0 + 64] + C0) * 2u; d.va2 = (rowoff[i * 256 + R0 + 128] + C0) * 2u; d.va3 = (rowoff[i * 256 + R0 + 192] + C0) * 2u;
                const int left = cntL[e] - ti * 256;
                d.i0 = startL[e] + ti * 256; d.i1 = (left < 256 ? left : 256) | (i << 16); d.i2 = pn; return true;
            };
            auto epi = [&](const f32x4 (&acc)[2][2][4][2], const GDesc& d, int wr, int wc, int fr, int fq) {
                const int rowbase = d.i0, nvalid = d.i1 & 0xffff, tl = d.i1 >> 16, pn = d.i2;
#pragma unroll
                for (int ai = 0; ai < 2; ++ai)
#pragma unroll
                    for (int m = 0; m < 4; ++m) {
                        const int r = ai * 128 + wr * 64 + m * 16 + fr;
                        if (r < nvalid) { const float g = rowsc[tl * 256 + r]; Y_STORE(rowbase + r, pn * 256, g); }
                    }
            };
            gemm_stream(ldsL, tid, EFF, nextf, epi);
        }
#undef Y_STORE
    }
    SEAM(12);

    if (IN(13)) {
        TIDS
        const float* fg = P.in[I_FG];
        u32x4 yn[9]; u32x4 xn0, xn1;
#define P13_LOAD(ROW) do { const int row_ = (ROW); _Pragma("unroll") for (int k = 0; k < 9; ++k) { const int pr = (k < 8) ? W_pos[row_ * 8 + k] : (NASG + row_); \
            yn[k] = *(const u32x4*)(W_y8 + (size_t)pr * DM + lane * 16); } \
            const bf16_t* x1r = W_xt + (size_t)row_ * DM + lane * 16; xn0 = *(const u32x4*)x1r; xn1 = *(const u32x4*)(x1r + 8); } while (0)
        P13_LOAD(blk * 8 + wave);
        for (int row = blk * 8 + wave; row < NTOK; row += G * 8) {
            const int b = row >> 12;
            float a[16];
#pragma unroll
            for (int j = 0; j < 16; ++j) a[j] = 0.f;
            u32x4 yc[9];
#pragma unroll
            for (int k = 0; k < 9; ++k) yc[k] = yn[k];
            const u32x4 xw0 = xn0, xw1 = xn1;
            if (row + G * 8 < NTOK) P13_LOAD(row + G * 8);
#pragma unroll
            for (int k = 0; k < 9; ++k) {
                const u32x4 w = yc[k];
#pragma unroll
                for (int q = 0; q < 4; ++q) {
                    a[4 * q + 0] += __builtin_amdgcn_cvt_f32_fp8((int)w[q], 0); a[4 * q + 1] += __builtin_amdgcn_cvt_f32_fp8((int)w[q], 1);
                    a[4 * q + 2] += __builtin_amdgcn_cvt_f32_fp8((int)w[q], 2); a[4 * q + 3] += __builtin_amdgcn_cvt_f32_fp8((int)w[q], 3);
                }
            }
            float* xr = P.out + (size_t)row * DM + lane * 16;
            const float* g2 = W_mod + b * 6144 + 5120 + lane * 16;
            float v[16]; float ss = 0.f;
#pragma unroll
            for (int q = 0; q < 4; ++q) {
                const unsigned wa = (q < 2) ? xw0[2 * q] : xw1[2 * (q - 2)], wb = (q < 2) ? xw0[2 * q + 1] : xw1[2 * (q - 2) + 1];
                const f32x4 xa = {__uint_as_float(wa << 16), __uint_as_float(wa & 0xffff0000u), __uint_as_float(wb << 16), __uint_as_float(wb & 0xffff0000u)};
                const f32x4 ga = *(const f32x4*)(g2 + q * 4);
#pragma unroll
                for (int j = 0; j < 4; ++j) { v[q * 4 + j] = xa[j] + ga[j] * a[q * 4 + j]; ss += v[q * 4 + j] * v[q * 4 + j]; }
            }
            ss = wave_sum(ss);
            const float rinv = rsqrtf(ss * (1.0f / 1024.0f) + EPS);
#pragma unroll
            for (int q = 0; q < 4; ++q) {
                const f32x4 fa = *(const f32x4*)(fg + lane * 16 + q * 4);
                f32x4 oa;
#pragma unroll
                for (int j = 0; j < 4; ++j) oa[j] = v[q * 4 + j] * rinv * fa[j];
                *(f32x4*)(xr + q * 4) = oa;
            }
        }
    }
#ifdef DBG_STOP
    if (IN(14)) {
        TIDS
        const size_t NO = (size_t)NTOK * DM;
        for (size_t i = (size_t)blk * 512 + tid; i < NO; i += (size_t)G * 512) {
            unsigned hsh = 0u;
            const size_t row = i >> 10, c = i & 1023;
#define RB(p, idx) ((unsigned)(p)[(idx)])
#define RF(p, idx) (__float_as_uint((p)[(idx)]))
#if DBG_STOP == 0
            hsh = RB(W_WinT, i % (2304 * 1024)) ^ RB(W_WoT, i % (1024 * 1024)) ^ RB(W_WuqT, i % (768 * 384)) ^ RB(W_WukvT, i % (1024 * 256)) ^ RB(W_Ws13T, i % (512 * 1024)) ^ RB(W_Ws2T, i % (1024 * 256)) ^ RB(W_WrT, i % (256 * 1024))
                ^ RF(W_mod, i % (8 * 6144)) ^ RF(W_ropecs, i % (4096 * 32)) ^ RF(W_biasT, i % (3 * 8 * 129));
#elif DBG_STOP == 1 || DBG_STOP == 7
            hsh = RB(W_hbuf, i);
#elif DBG_STOP == 2
            hsh = RB(W_proj, row * INCP + c) ^ (RB(W_proj, row * INCP + 1024 + c) << 1) ^ (c < 160 ? (RB(W_proj, row * INCP + 2048 + c) << 2) : 0u);
#elif DBG_STOP == 3
            hsh = RB(W_kvb, i) ^ (c < 768 ? (RB(W_qb, row * 768 + c) << 1) : 0u);
#elif DBG_STOP == 4
            if (c < 512) hsh = RB(W_bout, row * 512 + c); else if (DBG_SUB) { const size_t cc = c - 512; hsh = RB(W_aparts, row * 512 + cc) ^ (RB(W_aparts, ((size_t)NTOK + row) * 512 + cc) << 1) ^ (RB(W_aparts, ((size_t)2 * NTOK + row) * 512 + cc) << 2) ^ RF(W_lsebuf, row * 8 + (cc >> 6)) ^ (RF(W_lsebuf, ((size_t)NTOK + row) * 8 + (cc >> 6)) << 1) ^ (RF(W_lsebuf, ((size_t)2 * NTOK + row) * 8 + (cc >> 6)) << 2); }
#elif DBG_STOP == 5
            hsh = RB(W_mixb, i);
#elif DBG_STOP == 6
            hsh = RF(P.out, i);
#elif DBG_STOP == 8
            if (c < 256) hsh = RF(W_logits, row * 256 + c); else if (c < 512) hsh = RB(W_hdn, ((size_t)NASG + row) * EFF + (c - 256));
#elif DBG_STOP == 9
            if (c < 8) hsh = (unsigned)W_eidx[row * 8 + c]; else if (c < 16) hsh = RF(W_gate, row * 8 + (c - 8));
#elif DBG_STOP == 11
            { const int k = (int)(c >> 8); hsh = RB(W_hdn, (size_t)W_pos[row * 8 + k] * EFF + (c & 255)) ^ (RB(W_hdn, (size_t)W_pos[row * 8 + 4 + k] * EFF + (c & 255)) << 1); }
#elif DBG_STOP == 12
            { for (int k = 0; k < 8; ++k) hsh ^= RB(W_ybuf, (size_t)W_pos[row * 8 + k] * DM + c) << (k & 3); hsh ^= RB(W_ybuf, ((size_t)NASG + row) * DM + c); }
#endif
            P.out[i] = (float)(hsh & 0xFu);
        }
    }
#endif
#undef IN
#undef SEAM
}

extern "C" void kernel_launch(void* const* d_in, const int* in_sizes, int n_in, void* d_out, int out_size, void* d_ws, size_t ws_size, hipStream_t stream) {
    static int grid = 0;
    if (grid == 0) {
        if (n_in != 24 || ws_size < WS_END) { fprintf(stderr, "kernel_launch: need 24 inputs and %zu bytes of workspace (got %d, %zu)\n", (size_t)WS_END, n_in, ws_size); grid = -1; return; }
        int dev = 0, cus = 0, per_cu = 0;
        if (hipGetDevice(&dev) != hipSuccess || hipDeviceGetAttribute(&cus, hipDeviceAttributeMultiprocessorCount, dev) != hipSuccess) { grid = -1; return; }
        if (hipFuncSetAttribute((const void*)fwd_kernel, hipFuncAttributeMaxDynamicSharedMemorySize, LDS_BYTES) != hipSuccess) { fprintf(stderr, "kernel_launch: hipFuncSetAttribute failed\n"); grid = -1; return; }
        if (hipOccupancyMaxActiveBlocksPerMultiprocessor(&per_cu, (const void*)fwd_kernel, 512, LDS_BYTES) != hipSuccess || per_cu < 1) { fprintf(stderr, "kernel_launch: occupancy query says %d\n", per_cu); }
        (void)hipGetLastError();
        if (cus < 256) { fprintf(stderr, "kernel_launch: this kernel needs 256 CUs (device reports %d)\n", cus); grid = -1; return; }
        grid = 256;
    }
    if (grid < 0) return;
    (void)hipMemsetAsync((char*)d_ws + OFF_CTL, 0, CTL_BYTES, stream);
    Params p{};
    for (int i = 0; i < 24; ++i) p.in[i] = (const float*)d_in[i];
    p.out = (float*)d_out; p.ws = (unsigned char*)d_ws;
#if MK_N_LAUNCHES == 1
    p.ph_lo = 0; p.ph_hi = NPHASE;
    hipLaunchKernelGGL(fwd_kernel, dim3(grid), dim3(512), LDS_BYTES, stream, p);
#else
#ifdef DBG_STOP
    for (int k = 0; k <= DBG_STOP; ++k) { p.ph_lo = k; p.ph_hi = k + 1; hipLaunchKernelGGL(fwd_kernel, dim3(grid), dim3(512), LDS_BYTES, stream, p); }
    p.ph_lo = 14; p.ph_hi = 15; hipLaunchKernelGGL(fwd_kernel, dim3(grid), dim3(512), LDS_BYTES, stream, p);
#else
#ifndef DBL_MASK
#define DBL_MASK 0u
#endif
#ifndef DBL_FLAGS
#define DBL_FLAGS 0
#endif
    for (int k = 0; k < 14; ++k) { p.ph_lo = k; p.ph_hi = k + 1; hipLaunchKernelGGL(fwd_kernel, dim3(grid), dim3(512), LDS_BYTES, stream, p);
        if ((DBL_MASK >> k) & 1u) { p.flags = DBL_FLAGS; hipLaunchKernelGGL(fwd_kernel, dim3(grid), dim3(512), LDS_BYTES, stream, p); p.flags = 0; } }
#endif
#endif
}
```

```cpp
#include <hip/hip_runtime.h>
#include <stdint.h>
#include <stdio.h>

#ifndef MK_N_LAUNCHES
#define MK_N_LAUNCHES 1
#endif

#define DEVI __device__ __forceinline__
typedef unsigned short bf16_t;
typedef short bf16x8 __attribute__((ext_vector_type(8)));
typedef short s16x4 __attribute__((ext_vector_type(4)));
typedef float f32x4 __attribute__((ext_vector_type(4)));
typedef float f32x16 __attribute__((ext_vector_type(16)));
typedef unsigned u32x4 __attribute__((ext_vector_type(4)));
typedef unsigned u32x2 __attribute__((ext_vector_type(2)));

constexpr int NTOK = 32768, SEQ = 4096, DM = 1024;
constexpr int INC = 2208, INCP = 2304;
constexpr int QLORA = 384, KVLORA = 256;
constexpr int NEXP = 256, EFF = 256;
constexpr int NASG = NTOK * 8;
constexpr int NROWS = NASG + NTOK;
constexpr float EPS = 1e-6f;
constexpr float LOG2E = 1.4426950408889634f;

constexpr size_t MiB = 1u << 20;
constexpr size_t OFF_CTL = 0, CTL_BYTES = 1 * MiB;
constexpr size_t OFF_MOD = 1 * MiB;
constexpr size_t OFF_ROPE = OFF_MOD + 256 * 1024;
constexpr size_t OFF_BIAS = OFF_ROPE + 512 * 1024;
constexpr size_t OFF_WIN = 2 * MiB;
constexpr size_t OFF_WUQ = OFF_WIN + 4608 * 1024;
constexpr size_t OFF_WUKV = OFF_WUQ + 1 * MiB;
constexpr size_t OFF_WO = OFF_WUKV + 512 * 1024;
constexpr size_t OFF_WR = OFF_WO + 2 * MiB;
constexpr size_t OFF_WS13 = OFF_WR + 512 * 1024;
constexpr size_t OFF_WS2 = OFF_WS13 + 1 * MiB;
constexpr size_t OFF_H = 12 * MiB;
constexpr size_t OFF_LOGITS = OFF_H + 64 * MiB;
constexpr size_t OFF_EIDX = OFF_LOGITS + 32 * MiB;
constexpr size_t OFF_GATE = OFF_EIDX + 1 * MiB;
constexpr size_t OFF_RNK = OFF_GATE + 1 * MiB;
constexpr size_t OFF_POS = OFF_RNK + 1 * MiB;
constexpr size_t OFF_TOKS = OFF_POS + 1 * MiB;
constexpr size_t OFF_WTS = OFF_TOKS + 1 * MiB;
constexpr size_t OFF_SSQ = OFF_WTS + 1 * MiB;
constexpr size_t OFF_SCR = OFF_SSQ + 4 * MiB;
constexpr size_t SCR_PER_BLK = 1536 * 1024;
constexpr size_t OFF_R = OFF_SCR + 384 * MiB;
constexpr size_t OFF_XT = OFF_R + 452 * MiB;
constexpr size_t WS_END = OFF_XT + 64 * MiB;
constexpr size_t OFF_PROJ = OFF_R;
constexpr size_t OFF_QB = OFF_PROJ + 144 * MiB;
constexpr size_t OFF_KVB = OFF_QB + 48 * MiB;
constexpr size_t OFF_BOUT = OFF_KVB + 64 * MiB;
constexpr size_t OFF_APARTS = OFF_BOUT + 32 * MiB;
constexpr size_t OFF_LSE = OFF_APARTS + 96 * MiB;
constexpr size_t OFF_MIX = OFF_LSE + 4 * MiB;
constexpr size_t OFF_Y = OFF_R;
constexpr size_t OFF_HDN = OFF_R + 288 * MiB;
static_assert(OFF_MIX + 64 * MiB <= WS_END, "alias map");
constexpr int CNT_WORD0 = 8192, CNT_STRIDE = 16;

constexpr int LDS_STAGE = 0;
constexpr int LDS_ROWOFF = 131072;
constexpr int LDS_MISC = LDS_ROWOFF + 16384;
constexpr int LDS_START = LDS_MISC + 256;
constexpr int LDS_CNT = LDS_START + 1280;
constexpr int LDS_TB = LDS_CNT + 1280;
constexpr int LDS_ROWSC = LDS_TB + 1280;
constexpr int LDS_ITEMD = LDS_ROWSC + 11264;
constexpr int LDS_BYTES = 163840;
static_assert(LDS_ITEMD + 384 <= LDS_BYTES, "lds map");
constexpr int CH11 = 11, CH12 = 24;

#define XB_TMO      128
#define XB_XCNT(j)  (256  + 64 * (j))
#define XB_XSUB(j)  (1280 + 64 * (j))
#define XB_XGEN(j)  (2304 + 64 * (j))
#define XB_TOP      3328
#define XB_TOPGEN   3392
#define XCD_BAR_WORDS 3456
#define XB_SPIN_CAP (1u << 22)
#define LAS __attribute__((address_space(3)))

__device__ __forceinline__ unsigned xb_ld(unsigned* p)              { return __hip_atomic_load(p, __ATOMIC_RELAXED, __HIP_MEMORY_SCOPE_AGENT); }
__device__ __forceinline__ unsigned xb_add(unsigned* p, unsigned v) { return __hip_atomic_fetch_add(p, v, __ATOMIC_RELAXED, __HIP_MEMORY_SCOPE_AGENT); }
__device__ __forceinline__ unsigned xb_xcc_id() { return (unsigned)__builtin_amdgcn_s_getreg((3 << 11) | 20) & 0xFu; }
#define XB_SPIN(cond, bar) do { unsigned _sp = 0; while (cond) { __builtin_amdgcn_s_sleep(1); \
    if ((++_sp & 255u) == 0u) { if (xb_ld(&(bar)[XB_TMO])) break; if (_sp > XB_SPIN_CAP) { atomicAdd(&(bar)[XB_TMO], 1u); break; } } } } while (0)

struct XcdBarrier { unsigned* bar; unsigned x; volatile LAS unsigned* st; };

__device__ __forceinline__ XcdBarrier xcd_barrier_post(unsigned* bar, volatile LAS unsigned* st, const bool leader) {
    XcdBarrier b; b.bar = bar; b.x = xb_xcc_id(); b.st = st;
    if (leader) (void)xb_add(&bar[XB_XCNT(b.x)], 1u);
    return b;
}
__device__ __forceinline__ void xcd_barrier_complete(unsigned* bar, unsigned x, unsigned& nloc, unsigned& nx) {
    const unsigned G = gridDim.x * gridDim.y * gridDim.z;
    unsigned sum, cnt, mine, sp = 0u;
    for (;;) {
        sum = 0u; cnt = 0u; mine = 0u;
#pragma unroll
        for (unsigned j = 0; j < 16; ++j) { const unsigned c = xb_ld(&bar[XB_XCNT(j)]); sum += c; cnt += (c > 0u) ? 1u : 0u; mine = (j == x) ? c : mine; }
        if (sum == G) break;
        __builtin_amdgcn_s_sleep(1);
        if ((++sp & 255u) == 0u) { if (xb_ld(&bar[XB_TMO])) break; if (sp > XB_SPIN_CAP) { atomicAdd(&bar[XB_TMO], 1u); break; } }
    }
    nloc = mine > 0u ? mine : 1u; nx = cnt > 0u ? cnt : 1u;
}
__device__ __forceinline__ void xcd_barrier(const XcdBarrier& b, const bool leader) {
    asm volatile("s_waitcnt vmcnt(0)" ::: "memory");
    __syncthreads();
    if (leader) {
        unsigned* bar = b.bar;
        __builtin_amdgcn_s_waitcnt(0);
        unsigned nloc = b.st[0], nx = b.st[1];
        if (nloc == 0u) { xcd_barrier_complete(bar, b.x, nloc, nx); b.st[0] = nloc; b.st[1] = nx; }
        const unsigned old = xb_add(&bar[XB_XSUB(b.x)], 1u);
        const unsigned gen = old / nloc;
        if (old + 1u == (gen + 1u) * nloc) {
            __builtin_amdgcn_fence(__ATOMIC_RELEASE, "agent");
            asm volatile("s_waitcnt vmcnt(0)" ::: "memory");
            const unsigned og = xb_add(&bar[XB_TOP], 1u);
            const unsigned tg = og / nx;
            if (og + 1u == (tg + 1u) * nx) xb_add(&bar[XB_TOPGEN], 1u);
            else XB_SPIN(xb_ld(&bar[XB_TOPGEN]) == tg, bar);
            __builtin_amdgcn_fence(__ATOMIC_ACQUIRE, "agent");
            xb_add(&bar[XB_XGEN(b.x)], 1u);
            asm volatile("s_waitcnt vmcnt(0)" ::: "memory");
        } else {
            XB_SPIN(xb_ld(&bar[XB_XGEN(b.x)]) == gen, bar);
            __builtin_amdgcn_fence(__ATOMIC_ACQUIRE, "agent");
            asm volatile("s_waitcnt vmcnt(0)" ::: "memory");
        }
    }
    __syncthreads();
}

DEVI float bf2f(bf16_t v) { return __uint_as_float(((unsigned)v) << 16); }
typedef float f32x2_t __attribute__((ext_vector_type(2)));
typedef __bf16 bf16x2_t __attribute__((ext_vector_type(2)));
DEVI unsigned pk2(float lo, float hi) { f32x2_t v = {lo, hi}; bf16x2_t b = __builtin_convertvector(v, bf16x2_t); return __builtin_bit_cast(unsigned, b); }
#define dppf(v, ctrl) __int_as_float(__builtin_amdgcn_update_dpp(0, __float_as_int(v), (ctrl), 0xf, 0xf, false))
#define dppi(v, ctrl) __builtin_amdgcn_update_dpp(0, (v), (ctrl), 0xf, 0xf, false)
#define DPP_X1 0xB1
#define DPP_X2 0x4E
#define DPP_HM 0x141
#define DPP_RM 0x140
DEVI float x16f(float v, float& o) { auto r = __builtin_amdgcn_permlane16_swap(__float_as_uint(v), __float_as_uint(v), false, false); o = __uint_as_float(r[1]); return __uint_as_float(r[0]); }
DEVI float x32f(float v, float& o) { auto r = __builtin_amdgcn_permlane32_swap(__float_as_uint(v), __float_as_uint(v), false, false); o = __uint_as_float(r[1]); return __uint_as_float(r[0]); }
DEVI float sum32(float v) { float o; const float a = x32f(v, o); return a + o; }
DEVI float max32(float v) { float o; const float a = x32f(v, o); return fmaxf(a, o); }
DEVI float wave_sum(float v) {
    v += dppf(v, DPP_X1); v += dppf(v, DPP_X2); v += dppf(v, DPP_HM); v += dppf(v, DPP_RM);
    { float o; const float a = x16f(v, o); v = a + o; }
    { float o; const float a = x32f(v, o); v = a + o; }
    return v;
}
DEVI int perm_slot(int cl) { return 16 * ((cl >> 2) & 1) + 4 * (cl >> 3) + (cl & 3); }
DEVI int perm_row(int n) { return (n & ~31) + perm_slot(n & 31); }
DEVI float ex2(float x) { return __builtin_amdgcn_exp2f(x); }
DEVI float siluf(float v) { return v * __builtin_amdgcn_rcpf(1.0f + __expf(-v)); }

namespace g8 {
constexpr int BK = 64, HALF = 128, HT = HALF * BK;
DEVI int lds_byte(int r, int c) { int st = (r >> 4) * 2 + (c >> 5), rr = r & 15, cc = c & 31, ob = rr * 64 + cc * 2; return st * 1024 + (ob ^ (((ob >> 9) & 1) << 5)); }
DEVI void stage_rc(int b, int& R, int& C) { int st = b / 1024, sb = b % 1024, swz = sb ^ (((sb >> 9) & 1) << 5); R = (st >> 1) * 16 + swz / 64; C = (st & 1) * 32 + (swz % 64) / 2; }
}

DEVI void g8_rc(int tid, int& R0, int& C0) { g8::stage_rc(tid * 16, R0, C0); }
DEVI void g8_voff_lin(unsigned (&v)[4], int ld, int tid) { int R0, C0; g8_rc(tid, R0, C0);
    v[0] = (unsigned)(R0 * ld + C0) * 2u; v[1] = (unsigned)((R0 + 64) * ld + C0) * 2u; v[2] = (unsigned)((R0 + 128) * ld + C0) * 2u; v[3] = (unsigned)((R0 + 192) * ld + C0) * 2u; }
DEVI void g8_voff_tab(unsigned (&v)[4], const LAS unsigned* tab, int tid) { int R0, C0; g8_rc(tid, R0, C0);
    v[0] = (tab[R0] + C0) * 2u; v[1] = (tab[R0 + 64] + C0) * 2u; v[2] = (tab[R0 + 128] + C0) * 2u; v[3] = (tab[R0 + 192] + C0) * 2u; }

template <class Epi>
DEVI void gemm_tile(LAS unsigned char* lds, const int tid_in, const char* Ab, const unsigned (&voffA_)[4], const char* Bb, const int K, const Epi& epi) {
    using namespace g8;
    constexpr int HTB = HALF * BK * 2;
    int tz = tid_in; asm volatile("" : "+v"(tz));
    int wid = tz >> 6, lane = tz & 63, wr = wid >> 2, wc = wid & 3, fr = lane & 15, fq = lane >> 4;
    unsigned voffA[4] = {voffA_[0], voffA_[1], voffA_[2], voffA_[3]};
    asm volatile("" : "+v"(voffA[0]), "+v"(voffA[1]), "+v"(voffA[2]), "+v"(voffA[3]));
    unsigned voffB[2];
    { int R0, C0; stage_rc(tz * 16, R0, C0); voffB[0] = (unsigned)(R0 * K + C0) * 2u; voffB[1] = (unsigned)((R0 + 64) * K + C0) * 2u; }
    const size_t kstep = (size_t)(BK * 2);
    const size_t hstepB = (size_t)HALF * K * 2;
    const unsigned ldsw = (unsigned)wid * 1024u;
    const int aoff = lds_byte(wr * 64 + fr, fq * 8), boff = lds_byte(wc * 32 + fr, fq * 8);
#define G8_SA(b, h) (((b) * 2 + (h)) * HTB)
#define G8_SB(b, h) ((4 + (b) * 2 + (h)) * HTB)
#define G8_GL(gp, lofs) __builtin_amdgcn_global_load_lds((const unsigned*)(gp), (LAS unsigned*)(lds + (lofs)), 16, 0, 0)
#define STAGE_A(b, h, kt) do { const char* g_ = Ab + (size_t)(kt) * kstep; G8_GL(g_ + voffA[(h) * 2], G8_SA(b, h) + ldsw); G8_GL(g_ + voffA[(h) * 2 + 1], G8_SA(b, h) + ldsw + 8192); } while (0)
#define STAGE_B(b, h, kt) do { const char* g_ = Bb + (size_t)(kt) * kstep + ((h) ? hstepB : 0); G8_GL(g_ + voffB[0], G8_SB(b, h) + ldsw); G8_GL(g_ + voffB[1], G8_SB(b, h) + ldsw + 8192); } while (0)
#define LDA(dst, b, h) do { _Pragma("unroll") for (int m = 0; m < 4; ++m) _Pragma("unroll") for (int k = 0; k < 2; ++k) dst[m][k] = *(const LAS bf16x8*)(lds + G8_SA(b, h) + aoff + m * 2048 + k * 1024); } while (0)
#define LDB(dst, b, h) do { _Pragma("unroll") for (int n = 0; n < 2; ++n) _Pragma("unroll") for (int k = 0; k < 2; ++k) dst[n][k] = *(const LAS bf16x8*)(lds + G8_SB(b, h) + boff + n * 2048 + k * 1024); } while (0)
#define MMA(ai, bj, Af, Bf) do { __builtin_amdgcn_s_setprio(1); \
    _Pragma("unroll") for (int m = 0; m < 4; ++m) _Pragma("unroll") for (int n = 0; n < 2; ++n) _Pragma("unroll") for (int k = 0; k < 2; ++k) \
      acc[ai][bj][m][n] = __builtin_amdgcn_mfma_f32_16x16x32_bf16(Bf[n][k], Af[m][k], acc[ai][bj][m][n], 0, 0, 0); \
    __builtin_amdgcn_s_setprio(0); } while (0)
#define WAIT_V(n) asm volatile("s_waitcnt vmcnt(" #n ")" ::: "memory")
#define WAIT_L(n) asm volatile("s_waitcnt lgkmcnt(" #n ")" ::: "memory")
#define BAR __builtin_amdgcn_s_barrier()
#define SCHED __builtin_amdgcn_sched_barrier(0)
    f32x4 acc[2][2][4][2];
#pragma unroll
    for (int a = 0; a < 2; ++a)
#pragma unroll
        for (int b = 0; b < 2; ++b)
#pragma unroll
            for (int m = 0; m < 4; ++m)
#pragma unroll
                for (int n = 0; n < 2; ++n) acc[a][b][m][n] = (f32x4){0.f, 0.f, 0.f, 0.f};
    bf16x8 At[4][2], B0[2][2], B1[2][2];
    const int nt = K / BK;
    STAGE_B(0, 0, 0); STAGE_A(0, 0, 0); STAGE_B(0, 1, 0); STAGE_A(0, 1, 0);
    if (wr == 1) BAR;
    WAIT_V(4); BAR;
    STAGE_B(1, 0, 1); STAGE_A(1, 0, 1); STAGE_B(1, 1, 1);
    WAIT_V(6); BAR;
#pragma unroll 1
    for (int t = 0; t < nt; t += 2) {
        const int t2 = (t == nt - 2) ? 0 : t + 2;
        const int t3 = t2 + 1;
        LDB(B0, 0, 0); SCHED; LDA(At, 0, 0); STAGE_A(1, 1, t + 1);
        WAIT_L(8); BAR; WAIT_L(0); MMA(0, 0, At, B0); BAR; SCHED;
        LDB(B1, 0, 1); STAGE_B(0, 0, t2);
        BAR; WAIT_L(0); MMA(0, 1, At, B1); BAR;
        LDA(At, 0, 1); STAGE_A(0, 0, t2);
        BAR; WAIT_L(0); MMA(1, 0, At, B0); BAR; SCHED;
        STAGE_B(0, 1, t2);
        WAIT_V(6); BAR; MMA(1, 1, At, B1); BAR;
        LDB(B0, 1, 0); SCHED; LDA(At, 1, 0); STAGE_A(0, 1, t2);
        WAIT_L(8); BAR; WAIT_L(0); MMA(0, 0, At, B0); BAR; SCHED;
        LDB(B1, 1, 1); STAGE_B(1, 0, t3);
        BAR; WAIT_L(0); MMA(0, 1, At, B1); BAR;
        LDA(At, 1, 1); STAGE_A(1, 0, t3);
        BAR; WAIT_L(0); MMA(1, 0, At, B0); BAR; SCHED;
        STAGE_B(1, 1, t3);
        WAIT_V(6); BAR; MMA(1, 1, At, B1); BAR;
    }
    WAIT_V(0);
    if (wr == 0) BAR;
    BAR;
    asm volatile("" : "+v"(tz)); wid = tz >> 6; lane = tz & 63; wr = wid >> 2; wc = wid & 3; fr = lane & 15; fq = lane >> 4;
    epi(acc, wr, wc, fr, fq);
#undef G8_SA
#undef G8_SB
#undef G8_GL
#undef STAGE_A
#undef STAGE_B
#undef LDA
#undef LDB
#undef MMA
}
struct GDesc { const char* Ab; const char* Bb; unsigned va0, va1, va2, va3; int i0, i1, i2; };
template <class Next, class Epi>
DEVI void gemm_stream(LAS unsigned char* lds, const int tid_in, const int K, Next& next, const Epi& epi) {
    using namespace g8;
    constexpr int HTB = HALF * BK * 2;
    int tz = tid_in; asm volatile("" : "+v"(tz));
    int wid = tz >> 6, lane = tz & 63, wr = wid >> 2, wc = wid & 3, fr = lane & 15, fq = lane >> 4;
    unsigned voffB[2];
    { int R0, C0; stage_rc(tz * 16, R0, C0); voffB[0] = (unsigned)(R0 * K + C0) * 2u; voffB[1] = (unsigned)((R0 + 64) * K + C0) * 2u; }
    const size_t kstep = (size_t)(BK * 2);
    const size_t hstepB = (size_t)HALF * K * 2;
    const unsigned ldsw = (unsigned)wid * 1024u;
    const int aoff = lds_byte(wr * 64 + fr, fq * 8), boff = lds_byte(wc * 32 + fr, fq * 8);
#define G8_SA(b, h) (((b) * 2 + (h)) * HTB)
#define G8_SB(b, h) ((4 + (b) * 2 + (h)) * HTB)
#define G8_GL(gp, lofs) __builtin_amdgcn_global_load_lds((const unsigned*)(gp), (LAS unsigned*)(lds + (lofs)), 16, 0, 0)
#define STG_A(b, h, gb, v0, v1) do { G8_GL((gb) + (v0), G8_SA(b, h) + ldsw); G8_GL((gb) + (v1), G8_SA(b, h) + ldsw + 8192); } while (0)
#define STG_B(b, h, gb) do { const char* g_ = (gb) + ((h) ? hstepB : 0); G8_GL(g_ + voffB[0], G8_SB(b, h) + ldsw); G8_GL(g_ + voffB[1], G8_SB(b, h) + ldsw + 8192); } while (0)
#define LDA(dst, b, h) do { _Pragma("unroll") for (int m = 0; m < 4; ++m) _Pragma("unroll") for (int k = 0; k < 2; ++k) dst[m][k] = *(const LAS bf16x8*)(lds + G8_SA(b, h) + aoff + m * 2048 + k * 1024); } while (0)
#define LDB(dst, b, h) do { _Pragma("unroll") for (int n = 0; n < 2; ++n) _Pragma("unroll") for (int k = 0; k < 2; ++k) dst[n][k] = *(const LAS bf16x8*)(lds + G8_SB(b, h) + boff + n * 2048 + k * 1024); } while (0)
#define MMA(ai, bj, Af, Bf) do { __builtin_amdgcn_s_setprio(1); \
    _Pragma("unroll") for (int m = 0; m < 4; ++m) _Pragma("unroll") for (int n = 0; n < 2; ++n) _Pragma("unroll") for (int k = 0; k < 2; ++k) \
      acc[ai][bj][m][n] = __builtin_amdgcn_mfma_f32_16x16x32_bf16(Bf[n][k], Af[m][k], acc[ai][bj][m][n], 0, 0, 0); \
    __builtin_amdgcn_s_setprio(0); } while (0)
#define ZACC() do { _Pragma("unroll") for (int a = 0; a < 2; ++a) _Pragma("unroll") for (int b = 0; b < 2; ++b) _Pragma("unroll") for (int m = 0; m < 4; ++m) _Pragma("unroll") for (int n = 0; n < 2; ++n) acc[a][b][m][n] = (f32x4){0.f, 0.f, 0.f, 0.f}; } while (0)
    GDesc cur, nxt;
    if (!next(0, cur)) return;
    nxt = cur;
    f32x4 acc[2][2][4][2];
    ZACC();
    bf16x8 At[4][2], B0[2][2], B1[2][2];
    const int nt = K / BK;
    STG_B(0, 0, cur.Bb); STG_A(0, 0, cur.Ab, cur.va0, cur.va1); STG_B(0, 1, cur.Bb); STG_A(0, 1, cur.Ab, cur.va2, cur.va3);
    if (wr == 1) BAR;
    WAIT_V(4); BAR;
    STG_B(1, 0, cur.Bb + kstep); STG_A(1, 0, cur.Ab + kstep, cur.va0, cur.va1); STG_B(1, 1, cur.Bb + kstep);
    WAIT_V(6); BAR;
    int ui = 0; bool has_next = false;
#pragma unroll 1
    for (;;) {
        const bool half = (cur.i2 >> 8) & 1;
#pragma unroll 1
        for (int t = 0; t < nt; t += 2) {
            const bool last = (t == nt - 2);
            if (last) { has_next = next(ui + 1, nxt); if (!has_next) nxt = cur; }
            const char* a2 = last ? nxt.Ab : cur.Ab + (size_t)(t + 2) * kstep;
            const char* b2 = last ? nxt.Bb : cur.Bb + (size_t)(t + 2) * kstep;
            const unsigned s0 = last ? nxt.va0 : cur.va0, s1 = last ? nxt.va1 : cur.va1, s2 = last ? nxt.va2 : cur.va2, s3 = last ? nxt.va3 : cur.va3;
            LDB(B0, 0, 0); SCHED; LDA(At, 0, 0); STG_A(1, 1, cur.Ab + (size_t)(t + 1) * kstep, cur.va2, cur.va3);
            WAIT_L(8); BAR; WAIT_L(0); MMA(0, 0, At, B0); BAR; SCHED;
            LDB(B1, 0, 1); STG_B(0, 0, b2);
            BAR; WAIT_L(0); MMA(0, 1, At, B1); BAR;
            if (!half) LDA(At, 0, 1); STG_A(0, 0, a2, s0, s1);
            BAR; WAIT_L(0); if (!half) MMA(1, 0, At, B0); BAR; SCHED;
            STG_B(0, 1, b2);
            WAIT_V(6); BAR; if (!half) MMA(1, 1, At, B1); BAR;
            LDB(B0, 1, 0); SCHED; LDA(At, 1, 0); STG_A(0, 1, a2, s2, s3);
            WAIT_L(8); BAR; WAIT_L(0); MMA(0, 0, At, B0); BAR; SCHED;
            LDB(B1, 1, 1); STG_B(1, 0, b2 + kstep);
            BAR; WAIT_L(0); MMA(0, 1, At, B1); BAR;
            if (!half) LDA(At, 1, 1); STG_A(1, 0, a2 + kstep, s0, s1);
            BAR; WAIT_L(0); if (!half) MMA(1, 0, At, B0); BAR; SCHED;
            STG_B(1, 1, b2 + kstep);
            WAIT_V(6); BAR; if (!half) MMA(1, 1, At, B1); BAR;
        }
        {
            int tq = tz; asm volatile("" : "+v"(tq));
            const int wid_ = tq >> 6, lane_ = tq & 63;
            epi(acc, cur, wid_ >> 2, wid_ & 3, lane_ & 15, lane_ >> 4);
        }
        if (!has_next) break;
        ZACC();
        cur = nxt; ++ui;
    }
    WAIT_V(0);
    if (wr == 0) BAR;
    BAR;
#undef G8_SA
#undef G8_SB
#undef G8_GL
#undef STG_A
#undef STG_B
#undef LDA
#undef LDB
#undef MMA
#undef ZACC
}
#define EPI_FOREACH8(acc, wr, wc, fr, fq, ROW, COL8, V0, V1, ...) \
    _Pragma("unroll") for (int ai_ = 0; ai_ < 2; ++ai_) _Pragma("unroll") for (int m_ = 0; m_ < 4; ++m_) { const int ROW = ai_ * 128 + (wr) * 64 + m_ * 16 + (fr); \
    _Pragma("unroll") for (int bj_ = 0; bj_ < 2; ++bj_) { const int COL8 = bj_ * 128 + (wc) * 32 + (fq) * 8; const f32x4 V0 = acc[ai_][bj_][m_][0]; const f32x4 V1 = acc[ai_][bj_][m_][1]; __VA_ARGS__ } }
#define PK8(w, a, b) do { w.x = pk2(a[0], a[1]); w.y = pk2(a[2], a[3]); w.z = pk2(b[0], b[1]); w.w = pk2(b[2], b[3]); } while (0)
DEVI int tile_hf(const int c) { const int t = c & 255; return (t >= 1 && t <= 128) ? 1 : 0; }
DEVI int tile_nf(const int c) { return ((c + 255) >> 8) - tile_hf(c); }
DEVI void prefix_cnt(const LAS int* cnt, LAS int* part, const int n, const int tid, int& s_out, int& t_out, int& h_out) {
    if (tid < 17) {
        int s = 0, t = 0, h = 0;
#pragma unroll
        for (int j = 0; j < 16; ++j) { const int idx = tid * 16 + j; const int c = idx < n ? cnt[idx] : 0; s += c; t += tile_nf(c); h += tile_hf(c); }
        part[tid] = s; part[17 + tid] = t; part[34 + tid] = h;
    }
    __syncthreads();
    int s = 0, t = 0, h = 0;
    if (tid <= n) {
        const int qb = tid >> 4, rj = tid & 15;
#pragma unroll
        for (int q = 0; q < 17; ++q) { const int ps = part[q], pt = part[17 + q], ph = part[34 + q]; s += q < qb ? ps : 0; t += q < qb ? pt : 0; h += q < qb ? ph : 0; }
#pragma unroll
        for (int j = 0; j < 16; ++j) { const int c = cnt[qb * 16 + j]; s += j < rj ? c : 0; t += j < rj ? tile_nf(c) : 0; h += j < rj ? tile_hf(c) : 0; }
    }
    s_out = s; t_out = t; h_out = h;
}

template <class SCol, class DRow, class KS, class NS>
DEVI void convert_T(bf16_t* __restrict__ dst, const float* __restrict__ src, int ld, int K, int NR, SCol scol, DRow drow, KS ks, NS ns, int wi, int nw) {
    const int k8n = K >> 3; const int items = NR * k8n;
    for (int it0 = wi; it0 < items; it0 += 3 * nw) {
        float v[3][8]; int nn[3], kk[3];
#pragma unroll
        for (int u = 0; u < 3; ++u) {
            int it = it0 + u * nw; it = it < items ? it : it0;
            const int n = it % NR, k0 = (it / NR) << 3; nn[u] = n; kk[u] = k0;
            const int sc = scol(n);
#pragma unroll
            for (int j = 0; j < 8; ++j) v[u][j] = (sc >= 0) ? src[(size_t)(k0 + j) * ld + sc] : 0.f;
        }
#pragma unroll
        for (int u = 0; u < 3; ++u) {
            const int n = nn[u], k0 = kk[u];
            const float s = ns(n);
            float x[8];
#pragma unroll
            for (int j = 0; j < 8; ++j) x[j] = v[u][j] * ks(k0 + j) * s;
            u32x4 w; w.x = pk2(x[0], x[1]); w.y = pk2(x[2], x[3]); w.z = pk2(x[4], x[5]); w.w = pk2(x[6], x[7]);
            *(u32x4*)(dst + (size_t)drow(n) * K + k0) = w;
        }
    }
}
struct IdCol { DEVI int operator()(int n) const { return n; } };
struct OneK { DEVI float operator()(int) const { return 1.f; } };
struct VecK { const float* g; DEVI float operator()(int k) const { return g[k]; } };

template <int NB, bool PERM>
DEVI void convert_panel(bf16_t* __restrict__ dst, const float* __restrict__ src, const int ld, const int K, const int tid) {
    constexpr int N4 = NB / 4;
    const int items = (K >> 3) * N4;
#pragma unroll 1
    for (int it0 = tid; it0 < items; it0 += 1024) {
        f32x4 v[2][8];
#pragma unroll
        for (int u = 0; u < 2; ++u) {
            const int it = it0 + u * 512; const int n4 = it % N4, k8 = it / N4;
            const float* sp = src + (size_t)(k8 * 8) * ld + n4 * 4;
#pragma unroll
            for (int j = 0; j < 8; ++j) v[u][j] = *(const f32x4*)(sp + (size_t)j * ld);
        }
#pragma unroll
        for (int u = 0; u < 2; ++u) {
            const int it = it0 + u * 512; const int n4 = it % N4, k8 = it / N4;
#pragma unroll
            for (int c = 0; c < 4; ++c) {
                u32x4 w; w.x = pk2(v[u][0][c], v[u][1][c]); w.y = pk2(v[u][2][c], v[u][3][c]); w.z = pk2(v[u][4][c], v[u][5][c]); w.w = pk2(v[u][6][c], v[u][7][c]);
                const int n = n4 * 4 + c; const int dr = PERM ? ((n & ~31) + perm_slot(n & 31)) : n;
                *(u32x4*)(dst + (size_t)dr * K + k8 * 8) = w;
            }
        }
    }
}

template <int NB, bool PERM>
DEVI void convert_panel_lds(bf16_t* __restrict__ dst, const float* __restrict__ src, const int ld, const int K, const int tid, LAS unsigned char* lds) {
    constexpr int N4 = NB / 4;
    constexpr int K8C = 512 / N4;
    constexpr int KC = K8C * 8;
    constexpr int PITCH = KC * 2 + 8;
    constexpr int PPR = KC / 8;
    const int n4 = tid % N4, k8 = tid / N4;
    const float* sp = src + (size_t)(k8 * 8) * ld + n4 * 4;
    const int nchunk = K / KC;
    f32x4 va[8], vb[8], vc[8];
#define CPL_LOAD(V, c) do { const float* q_ = sp + (size_t)(c) * KC * ld; _Pragma("unroll") for (int j = 0; j < 8; ++j) V[j] = __builtin_nontemporal_load((const f32x4*)(q_ + (size_t)j * ld)); } while (0)
#define CPL_PROC(V, c) do { \
        _Pragma("unroll") for (int cc = 0; cc < 4; ++cc) { \
            u32x2 lo, hi; lo.x = pk2(V[0][cc], V[1][cc]); lo.y = pk2(V[2][cc], V[3][cc]); hi.x = pk2(V[4][cc], V[5][cc]); hi.y = pk2(V[6][cc], V[7][cc]); \
            LAS unsigned char* wp = lds + (n4 * 4 + cc) * PITCH + k8 * 16; \
            *(LAS u32x2*)wp = lo; *(LAS u32x2*)(wp + 8) = hi; } \
        __syncthreads(); \
        _Pragma("unroll") for (int q = 0; q < 4; ++q) { \
            const int p = tid + 512 * q; const int row = p / PPR, pc = p % PPR; \
            const LAS unsigned char* rp = lds + row * PITCH + pc * 16; \
            const u32x2 a = *(const LAS u32x2*)rp, b = *(const LAS u32x2*)(rp + 8); \
            const int dr = PERM ? ((row & ~31) + perm_slot(row & 31)) : row; \
            u32x4 w; w.x = a.x; w.y = a.y; w.z = b.x; w.w = b.y; \
            *(u32x4*)(dst + (size_t)dr * K + (c) * KC + pc * 8) = w; } \
        __syncthreads(); } while (0)
    CPL_LOAD(va, 0); if (nchunk > 1) CPL_LOAD(vb, 1); if (nchunk > 2) CPL_LOAD(vc, 2);
#pragma unroll 1
    for (int c = 0; c < nchunk; c += 3) {
        CPL_PROC(va, c); if (c + 3 < nchunk) CPL_LOAD(va, c + 3);
        if (c + 1 < nchunk) { CPL_PROC(vb, c + 1); if (c + 4 < nchunk) CPL_LOAD(vb, c + 4); }
        if (c + 2 < nchunk) { CPL_PROC(vc, c + 2); if (c + 5 < nchunk) CPL_LOAD(vc, c + 5); }
    }
#undef CPL_LOAD
#undef CPL_PROC
}

struct Params {
    const float* in[24];
    float* out;
    unsigned char* ws;
    int ph_lo, ph_hi;
    int flags, pad;
};
enum { I_X = 0, I_C, I_WADA, I_BADA, I_N1G, I_WIN, I_QNG, I_WUQ, I_KVNG, I_WUKV, I_REL, I_AOG, I_BOG, I_WO, I_N2G, I_WR, I_EB, I_W1, I_W3, I_W2, I_WS1, I_WS3, I_WS2, I_FG };
constexpr int NPHASE = 15;

#define W_x (P.in[I_X])
#define W_mod ((float*)(ws + OFF_MOD))
#define W_ropecs ((float*)(ws + OFF_ROPE))
#define W_biasT ((float*)(ws + OFF_BIAS))
#define W_WinT ((bf16_t*)(ws + OFF_WIN))
#define W_WuqT ((bf16_t*)(ws + OFF_WUQ))
#define W_WukvT ((bf16_t*)(ws + OFF_WUKV))
#define W_WoT ((bf16_t*)(ws + OFF_WO))
#define W_WrT ((bf16_t*)(ws + OFF_WR))
#define W_Ws13T ((bf16_t*)(ws + OFF_WS13))
#define W_Ws2T ((bf16_t*)(ws + OFF_WS2))
#define W_hbuf ((bf16_t*)(ws + OFF_H))
#define W_logits ((float*)(ws + OFF_LOGITS))
#define W_eidx ((int*)(ws + OFF_EIDX))
#define W_gate ((float*)(ws + OFF_GATE))
#define W_rnk ((int*)(ws + OFF_RNK))
#define W_pos ((int*)(ws + OFF_POS))
#define W_toks ((int*)(ws + OFF_TOKS))
#define W_wts ((float*)(ws + OFF_WTS))
#define W_toks2 ((int*)(ws + OFF_R))
#define W_wts2 ((float*)(ws + OFF_R + 32 * MiB))
#define W_ssq ((float*)(ws + OFF_SSQ))
#define W_scr ((bf16_t*)(ws + OFF_SCR + (size_t)blk * SCR_PER_BLK))
#define W_hdn ((bf16_t*)(ws + OFF_HDN))
#define W_ybuf ((bf16_t*)(ws + OFF_Y))
#define W_y8 ((unsigned char*)(ws + OFF_Y))
#define W_proj ((bf16_t*)(ws + OFF_PROJ))
#define W_qb ((bf16_t*)(ws + OFF_QB))
#define W_kvb ((bf16_t*)(ws + OFF_KVB))
#define W_bout ((bf16_t*)(ws + OFF_BOUT))
#define W_aparts ((bf16_t*)(ws + OFF_APARTS))
#define W_lsebuf ((float*)(ws + OFF_LSE))
#define W_mixb ((bf16_t*)(ws + OFF_MIX))
#define W_xt ((bf16_t*)(ws + OFF_XT))

__global__ void __launch_bounds__(512, 2) fwd_kernel(Params P) {
    extern __shared__ __attribute__((aligned(16))) unsigned char lds[];
    const int blk = blockIdx.x, G = gridDim.x;
    const int wave_s = __builtin_amdgcn_readfirstlane((int)threadIdx.x >> 6);
#define TIDS0 int tid; asm volatile("v_mbcnt_lo_u32_b32 %0, -1, 0\n\tv_mbcnt_hi_u32_b32 %0, -1, %0" : "=v"(tid)); tid += wave_s * 64;
    const int vblk = (G % 8 == 0) ? (blk % 8) * (G / 8) + blk / 8 : blk;
    unsigned char* ws = P.ws;
    unsigned* ctl = (unsigned*)(ws + OFF_CTL);
    { TIDS0 if (tid < 64) ((LAS unsigned*)(lds + LDS_MISC))[tid] = 0u; }
    __syncthreads();
    XcdBarrier bar; bar.bar = ctl; bar.x = 0; bar.st = nullptr;
    if (MK_N_LAUNCHES == 1) { TIDS0 bar = xcd_barrier_post(ctl, (volatile LAS unsigned*)(lds + LDS_MISC), tid == 0); }
#ifndef PH_MASK
#define PH_MASK 0xffffffffu
#endif
#define TIDS int tid; asm volatile("v_mbcnt_lo_u32_b32 %0, -1, 0\n\tv_mbcnt_hi_u32_b32 %0, -1, %0" : "=v"(tid)); tid += wave_s * 64; const int lane = tid & 63; const int wave = wave_s; (void)lane; (void)wave;
#define IN(k) ((((PH_MASK) >> (k)) & 1u) && P.ph_lo <= (k) && (k) < P.ph_hi)
#define SEAM(k) do { if (MK_N_LAUNCHES == 1 && IN(k) && IN((k) + 1)) { TIDS0 xcd_barrier(bar, tid == 0); } } while (0)

    unsigned* cntg = ctl + CNT_WORD0;
    LAS unsigned* rowoff = (LAS unsigned*)(lds + LDS_ROWOFF);
    LAS float* rowsc = (LAS float*)(lds + LDS_ROWSC);
    LAS int* startL = (LAS int*)(lds + LDS_START);
    LAS int* cntL = (LAS int*)(lds + LDS_CNT);
    LAS int* tbL = (LAS int*)(lds + LDS_TB);
    LAS int* thL = (LAS int*)(lds + LDS_ROWOFF + 11264);
    LAS int* itemD = (LAS int*)(lds + LDS_ITEMD);
    char* stage = (char*)lds + LDS_STAGE;
    LAS unsigned char* ldsL = (LAS unsigned char*)lds;

    if (IN(0)) {
        TIDS
        {
            float* sc = (float*)(lds);
            float* red = (float*)(lds + 32768);
            const float* c = P.in[I_C];
#pragma unroll
            for (int i = 0; i < 16; ++i) sc[tid + i * 512] = siluf(c[tid + i * 512]);
            __syncthreads();
            for (int cb = blk; cb < 256; cb += G) {
                const int cj = tid & 31, kg = tid >> 5;
                float a0 = 0, a1 = 0, a2 = 0, a3 = 0, a4 = 0, a5 = 0, a6 = 0, a7 = 0;
                if (cj < 24) {
                    const float* w = P.in[I_WADA] + cb * 24 + cj + (size_t)(kg * 64) * 6144;
                    float wv[64];
#pragma unroll
                    for (int i = 0; i < 64; ++i) wv[i] = w[(size_t)i * 6144];
#pragma unroll
                    for (int i = 0; i < 64; ++i) {
                        const int k = kg * 64 + i;
                        a0 += sc[k] * wv[i]; a1 += sc[1024 + k] * wv[i]; a2 += sc[2048 + k] * wv[i]; a3 += sc[3072 + k] * wv[i];
                        a4 += sc[4096 + k] * wv[i]; a5 += sc[5120 + k] * wv[i]; a6 += sc[6144 + k] * wv[i]; a7 += sc[7168 + k] * wv[i];
                    }
                }
                float* rp = red + (kg * 8) * 32 + cj;
                rp[0] = a0; rp[32] = a1; rp[64] = a2; rp[96] = a3; rp[128] = a4; rp[160] = a5; rp[192] = a6; rp[224] = a7;
                __syncthreads();
                if (tid < 256) {
                    const int b = tid >> 5, j = tid & 31;
                    if (j < 24) {
                        float s = 0.f;
                        for (int g = 0; g < 16; ++g) s += red[(g * 8 + b) * 32 + j];
                        const int col = cb * 24 + j;
                        W_mod[b * 6144 + col] = s + P.in[I_BADA][col];
                    }
                }
                __syncthreads();
            }
        }
        {
            for (int idx = blk * 512 + tid; idx < 4096 * 16; idx += G * 512) {
                const int s = idx >> 4, i = idx & 15;
                double inv = 1.0; for (int j = 0; j < i; ++j) inv *= 0.5623413251903491;
                const float invf = (float)inv;
                const float angf = (float)s * invf;
                const double xa = (double)angf;
                const double nrev = __builtin_rint(xa * 0.15915494309189535);
                const double r = xa - nrev * 6.283185307179586;
                const double r2 = r * r;
                double ts = r, ss = r, tc = 1.0, cc = 1.0;
#pragma unroll
                for (int n = 1; n <= 14; ++n) {
                    ts *= -r2 / (double)((2 * n) * (2 * n + 1)); ss += ts;
                    tc *= -r2 / (double)((2 * n - 1) * (2 * n)); cc += tc;
                }
                W_ropecs[idx * 2] = (float)cc; W_ropecs[idx * 2 + 1] = (float)ss;
            }
        }
        {
            for (int idx = blk * 512 + tid; idx < 3 * 8 * 129; idx += G * 512) {
                const int j = idx % 129, hh = (idx / 129) % 8, p = idx / (129 * 8);
                const int dil = (p == 0) ? 1 : (p == 1 ? 4 : 16);
                const int rel = (j - 64) * dil;
                const int n = rel < 0 ? -rel : rel;
                const float nf = (float)(n > 1 ? n : 1);
                int large = 8 + (int)(__logf(nf * 0.125f) / 4.852030263919617f * 8.0f);
                large = large < 15 ? large : 15;
                const int bucket = (rel > 0 ? 16 : 0) + (n < 8 ? n : large);
                W_biasT[idx] = P.in[I_REL][bucket * 8 + hh] * LOG2E;
            }
        }
        {
            const int wi0 = tid; constexpr int T = 512;
#define CV_RANGE(B0, NB) const bool in_ = (G == 256) ? (blk >= (B0) && blk < (B0) + (NB)) : true; const int wi = (G == 256) ? (blk - (B0)) * T + wi0 : blk * T + wi0, nw = (G == 256) ? (NB) * T : G * T; if (in_)
            { CV_RANGE(0, 120) convert_T(W_WinT, P.in[I_WIN], INC, 1024, INCP,
                      [](int n) { if (n >= INC) return -1; if (n < 2176) return n; const int i = n - 2176; return 2176 + ((i & 1) ? 16 : 0) + (i >> 1); },
                      [](int n) { return perm_row(n); }, OneK{}, [](int n) { return n < 512 ? 0.125f * LOG2E : 1.0f; }, wi, nw); }
            { CV_RANGE(120, 15) convert_T(W_WuqT, P.in[I_WUQ], 768, 384, 768,
                      [](int n) { if (n < 512) return (n >> 6) * 96 + (n & 63); const int hh = (n - 512) >> 5, i = n & 31; return hh * 96 + 64 + ((i & 1) ? 16 : 0) + (i >> 1); },
                      [](int n) { return perm_row(n); }, VecK{P.in[I_QNG]}, [](int) { return 0.10206207261596577f * LOG2E; }, wi, nw); }
            { CV_RANGE(135, 13) convert_T(W_WukvT, P.in[I_WUKV], 1024, 256, 1024, IdCol{}, [](int n) { return perm_row(n); }, VecK{P.in[I_KVNG]}, [](int) { return 1.f; }, wi, nw); }
            {
                const float* ag = P.in[I_AOG]; const float* bg = P.in[I_BOG];
                CV_RANGE(148, 56) convert_T(W_WoT, P.in[I_WO], 1024, 1024, 1024, IdCol{}, [](int n) { return perm_row(n); }, [=](int k) { return k < 512 ? ag[k] : bg[k - 512]; }, [](int) { return 1.f; }, wi, nw);
            }
            { CV_RANGE(204, 13) convert_T(W_WrT, P.in[I_WR], 256, 1024, 256, IdCol{}, [](int n) { return perm_row(n); }, OneK{}, [](int) { return 1.f; }, wi, nw); }
            { CV_RANGE(217, 13) convert_T(W_Ws13T, P.in[I_WS1], 256, 1024, 256, IdCol{}, [](int n) { return perm_row((n >> 7) * 256 + (n & 127)); }, OneK{}, [](int) { return 1.f; }, wi, nw); }
            { CV_RANGE(230, 13) convert_T(W_Ws13T, P.in[I_WS3], 256, 1024, 256, IdCol{}, [](int n) { return perm_row((n >> 7) * 256 + 128 + (n & 127)); }, OneK{}, [](int) { return 1.f; }, wi, nw); }
            { CV_RANGE(243, 13) convert_T(W_Ws2T, P.in[I_WS2], 1024, 256, 1024, IdCol{}, [](int n) { return perm_row(n); }, OneK{}, [](int) { return 1.f; }, wi, nw); }
#undef CV_RANGE
        }
    }
    SEAM(0);

    if (IN(1)) {
        TIDS
        const float* g = P.in[I_N1G];
        f32x4 vn[4];
        {
            const float* xr = W_x + (size_t)(blk * 8 + wave) * DM;
#pragma unroll
            for (int i = 0; i < 4; ++i) vn[i] = __builtin_nontemporal_load((const f32x4*)(xr + i * 256 + lane * 4));
        }
        for (int row = blk * 8 + wave; row < NTOK; row += G * 8) {
            const int b = row >> 12;
            f32x4 v[4]; float ss = 0.f;
#pragma unroll
            for (int i = 0; i < 4; ++i) v[i] = vn[i];
            if (row + G * 8 < NTOK) {
                const float* xn = W_x + (size_t)(row + G * 8) * DM;
#pragma unroll
                for (int i = 0; i < 4; ++i) vn[i] = __builtin_nontemporal_load((const f32x4*)(xn + i * 256 + lane * 4));
            }
#pragma unroll
            for (int i = 0; i < 4; ++i) ss += v[i][0] * v[i][0] + v[i][1] * v[i][1] + v[i][2] * v[i][2] + v[i][3] * v[i][3];
            ss = wave_sum(ss);
            const float rinv = rsqrtf(ss * (1.0f / 1024.0f) + EPS);
            const float* mb = W_mod + b * 6144;
#pragma unroll
            for (int i = 0; i < 4; ++i) {
                const int c = i * 256 + lane * 4;
                const f32x4 gg = *(const f32x4*)(g + c), sh = *(const f32x4*)(mb + c), sc = *(const f32x4*)(mb + 1024 + c);
                float o[4];
#pragma unroll
                for (int j = 0; j < 4; ++j) o[j] = v[i][j] * rinv * gg[j] * (1.0f + sc[j]) + sh[j];
                u32x2 w; w.x = pk2(o[0], o[1]); w.y = pk2(o[2], o[3]);
                *(u32x2*)(W_hbuf + (size_t)row * DM + c) = w;
            }
        }
    }
    SEAM(1);

    if (IN(2)) {
        TIDS
        unsigned vl_[4]; g8_voff_lin(vl_, DM, tid);
        auto nextf = [&](int i, GDesc& d) {
            const int ul = i * 32 + (vblk & 31); if (ul >= 144 || vblk >= 256) return false;
            const int pm = (vblk >> 5) * 16 + ul / 9, pn = ul % 9;
            d.Ab = (const char*)(W_hbuf + (size_t)pm * 256 * DM); d.Bb = (const char*)(W_WinT + (size_t)pn * 256 * DM);
            d.va0 = vl_[0]; d.va1 = vl_[1]; d.va2 = vl_[2]; d.va3 = vl_[3]; d.i0 = pm; d.i1 = pn; d.i2 = 0; return true;
        };
        auto epi = [&](const f32x4 (&acc)[2][2][4][2], const GDesc& d, int wr, int wc, int fr, int fq) {
            const int pm = d.i0, pn = d.i1;
            if (pn < 8) {
                EPI_FOREACH8(acc, wr, wc, fr, fq, r, c8, v0, v1, {
                    u32x4 w; PK8(w, v0, v1);
                    *(u32x4*)(W_proj + (size_t)(pm * 256 + r) * INCP + pn * 256 + c8) = w;
                })
            } else {
                EPI_FOREACH8(acc, wr, wc, fr, fq, r, c8, v0, v1, {
                    const int row = pm * 256 + r;
                    if (c8 < 160) {
                        f32x4 o0 = v0, o1 = v1;
                        if (c8 >= 128) {
                            const int i = (c8 - 128) >> 1; const int s = row & 4095;
                            const f32x4 ca = *(const f32x4*)(W_ropecs + (s * 16 + i) * 2), cb = *(const f32x4*)(W_ropecs + (s * 16 + i) * 2 + 4);
                            o0[0] = v0[0] * ca[0] - v0[1] * ca[1]; o0[1] = v0[1] * ca[0] + v0[0] * ca[1];
                            o0[2] = v0[2] * ca[2] - v0[3] * ca[3]; o0[3] = v0[3] * ca[2] + v0[2] * ca[3];
                            o1[0] = v1[0] * cb[0] - v1[1] * cb[1]; o1[1] = v1[1] * cb[0] + v1[0] * cb[1];
                            o1[2] = v1[2] * cb[2] - v1[3] * cb[3]; o1[3] = v1[3] * cb[2] + v1[2] * cb[3];
                        }
                        u32x4 w; PK8(w, o0, o1);
                        *(u32x4*)(W_proj + (size_t)row * INCP + 2048 + c8) = w;
                    }
                })
            }
            if (pn >= 6) {
#pragma unroll
                for (int ai = 0; ai < 2; ++ai)
#pragma unroll
                    for (int m = 0; m < 4; ++m)
#pragma unroll
                        for (int bj = 0; bj < 2; ++bj) {
                            const f32x4 a = acc[ai][bj][m][0], b = acc[ai][bj][m][1];
                            float ss = a[0] * a[0] + a[1] * a[1] + a[2] * a[2] + a[3] * a[3] + b[0] * b[0] + b[1] * b[1] + b[2] * b[2] + b[3] * b[3];
                            { float o; const float t = x16f(ss, o); ss = t + o; }
                            { float o; const float t = x32f(ss, o); ss = t + o; }
                            if (fq == 0) W_ssq[(size_t)(pm * 256 + ai * 128 + wr * 64 + m * 16 + fr) * 24 + (pn - 6) * 8 + bj * 4 + wc] = ss;
                        }
            }
        };
        gemm_stream(ldsL, tid, DM, nextf, epi);
        if ((vblk & 31) >= 16) {
            TIDS
#pragma unroll 1
            for (int q = 0; q < 2; ++q) {
                const int uu = blk + q * G;
                const int e = (G == 256) ? ((vblk & ~3) + q) : (uu >> 2), pn = (G == 256) ? (vblk & 3) : (uu & 3);
                __syncthreads();
                if (uu < 1024) convert_panel_lds<256, true>(W_scr + (size_t)2 * 256 * 1024 + (size_t)q * 256 * 256, P.in[I_W2] + (size_t)e * 256 * 1024 + pn * 256, 1024, 256, tid, ldsL);
            }
        }
    }
    SEAM(2);

    if (IN(3)) {
        {
            TIDS
            const int xb = (vblk >> 5) * 16, lb = vblk & 31;
            __syncthreads();
            for (int j = 0; j < 2; ++j) { const int ul = j * 32 + lb; if (ul < 48 && tid < 256) {
                const float* sp = W_ssq + (size_t)((xb + ul / 3) * 256 + tid) * 24;
                const f32x4 s0 = *(const f32x4*)sp, s1 = *(const f32x4*)(sp + 4), s2 = *(const f32x4*)(sp + 8);
                const float ss = ((s0[0] + s0[1]) + (s0[2] + s0[3])) + ((s1[0] + s1[1]) + (s1[2] + s1[3])) + ((s2[0] + s2[1]) + (s2[2] + s2[3]));
                rowsc[j * 256 + tid] = rsqrtf(ss * (1.0f / 384.0f) + EPS); } }
            __syncthreads();
            unsigned vl_[4]; g8_voff_lin(vl_, INCP, tid);
            auto nextf = [&](int i, GDesc& d) {
                const int ul = i * 32 + lb; if (ul >= 48 || vblk >= 256) return false;
                const int pm = xb + ul / 3, pn = ul % 3;
                d.Ab = (const char*)(W_proj + (size_t)pm * 256 * INCP + 1536); d.Bb = (const char*)(W_WuqT + (size_t)pn * 256 * QLORA);
                d.va0 = vl_[0]; d.va1 = vl_[1]; d.va2 = vl_[2]; d.va3 = vl_[3]; d.i0 = pm * 4 + pn; d.i1 = i; d.i2 = 0; return true;
            };
            auto epi = [&](const f32x4 (&acc)[2][2][4][2], const GDesc& d, int wr, int wc, int fr, int fq) {
                const int pm = d.i0 >> 2, pn = d.i0 & 3, sl = d.i1 * 256;
                if (pn < 2) {
                    EPI_FOREACH8(acc, wr, wc, fr, fq, r, c8, v0, v1, {
                        const float rs = rowsc[sl + r];
                        const f32x4 a = v0 * rs, b = v1 * rs;
                        u32x4 w; PK8(w, a, b);
                        *(u32x4*)(W_qb + (size_t)(pm * 256 + r) * 768 + pn * 256 + c8) = w;
                    })
                } else {
                    EPI_FOREACH8(acc, wr, wc, fr, fq, r, c8, v0, v1, {
                        const int row = pm * 256 + r;
                        const float rs = rowsc[sl + r];
                        const int i = (c8 & 31) >> 1; const int s = row & 4095;
                        const f32x4 ca = *(const f32x4*)(W_ropecs + (s * 16 + i) * 2), cb = *(const f32x4*)(W_ropecs + (s * 16 + i) * 2 + 4);
                        const f32x4 t0 = v0 * rs, t1 = v1 * rs;
                        f32x4 o0, o1;
                        o0[0] = t0[0] * ca[0] - t0[1] * ca[1]; o0[1] = t0[1] * ca[0] + t0[0] * ca[1];
                        o0[2] = t0[2] * ca[2] - t0[3] * ca[3]; o0[3] = t0[3] * ca[2] + t0[2] * ca[3];
                        o1[0] = t1[0] * cb[0] - t1[1] * cb[1]; o1[1] = t1[1] * cb[0] + t1[0] * cb[1];
                        o1[2] = t1[2] * cb[2] - t1[3] * cb[3]; o1[3] = t1[3] * cb[2] + t1[2] * cb[3];
                        u32x4 w; PK8(w, o0, o1);
                        *(u32x4*)(W_qb + (size_t)row * 768 + 512 + c8) = w;
                    })
                }
            };
            gemm_stream(ldsL, tid, QLORA, nextf, epi);
        }
        {
            TIDS
            const int xb = (vblk >> 5) * 16, lb = vblk & 31;
            __syncthreads();
            for (int j = 0; j < 2; ++j) { const int ul = j * 32 + lb; if (tid < 256) {
                const float* sp = W_ssq + (size_t)((xb + ul / 4) * 256 + tid) * 24 + 12;
                const f32x4 s0 = *(const f32x4*)sp, s1 = *(const f32x4*)(sp + 4);
                const float ss = ((s0[0] + s0[1]) + (s0[2] + s0[3])) + ((s1[0] + s1[1]) + (s1[2] + s1[3]));
                rowsc[j * 256 + tid] = rsqrtf(ss * (1.0f / 256.0f) + EPS); } }
            __syncthreads();
            unsigned vl_[4]; g8_voff_lin(vl_, INCP, tid);
            auto nextf = [&](int i, GDesc& d) {
                const int ul = i * 32 + lb; if (ul >= 64 || vblk >= 256) return false;
                const int pm = xb + ul / 4, pn = ul % 4;
                d.Ab = (const char*)(W_proj + (size_t)pm * 256 * INCP + 1920); d.Bb = (const char*)(W_WukvT + (size_t)pn * 256 * KVLORA);
                d.va0 = vl_[0]; d.va1 = vl_[1]; d.va2 = vl_[2]; d.va3 = vl_[3]; d.i0 = pm * 4 + pn; d.i1 = i; d.i2 = 0; return true;
            };
            auto epi = [&](const f32x4 (&acc)[2][2][4][2], const GDesc& d, int wr, int wc, int fr, int fq) {
                const int pm = d.i0 >> 2, pn = d.i0 & 3, sl = d.i1 * 256;
                EPI_FOREACH8(acc, wr, wc, fr, fq, r, c8, v0, v1, {
                    const float rs = rowsc[sl + r];
                    const f32x4 a = v0 * rs, b = v1 * rs;
                    u32x4 w; PK8(w, a, b);
                    *(u32x4*)(W_kvb + (size_t)(pm * 256 + r) * 1024 + pn * 256 + c8) = w;
                })
            };
            gemm_stream(ldsL, tid, KVLORA, nextf, epi);
        }
    }
    SEAM(3);

    if (IN(4)) {
        constexpr int CVB = 122880, CVBUF = 8448;
        f32x4 cva0 = {0.f, 0.f, 0.f, 0.f}, cva1 = {0.f, 0.f, 0.f, 0.f}, cvb0 = {0.f, 0.f, 0.f, 0.f}, cvb1 = {0.f, 0.f, 0.f, 0.f}; int gi = 0;
        for (int ui = 0; ui < ((P.flags & 4) ? 0 : 4); ++ui) {
            TIDS
            const int r32 = lane & 31, hh = lane >> 5;
            if (vblk >= 256) break;
            const int qblk = vblk & 15, bh = (vblk >> 5) * 8 + ui * 2 + ((vblk >> 4) & 1), h = bh & 7, b = bh >> 3;
            const size_t tok0 = (size_t)b * SEQ;
            bf16x8 qf[6];
            {
                const size_t tq = tok0 + qblk * 256 + wave * 32 + r32;
#pragma unroll
                for (int d0 = 0; d0 < 6; ++d0) qf[d0] = *(const bf16x8*)(W_qb + tq * 768 + (d0 < 4 ? h * 64 + d0 * 16 : 512 + h * 32 + (d0 - 4) * 16) + hh * 8);
            }
            f32x16 o0 = {}, o1 = {};
            f32x16 mneg = {};
            float m_run = 0.f, l_run = 0.f;
            const int skey = tid >> 3, sch = tid & 7;
            const bf16_t* kn_src = W_kvb + (tok0 + skey) * 1024 + h * 128 + sch * 8;
            const int pkey = tid >> 2, pch = tid & 3;
            const bf16_t* kp_src = W_proj + (tok0 + pkey) * INCP + 2176 + pch * 8;
            constexpr int KBUF = 12 * 2048, VBUF = 2 * 8192, BUFB = KBUF + VBUF;
            const int k_dst = sch * 2048 + ((skey ^ sch) * 16);
            const int kp_dst = (8 + pch) * 2048 + ((pkey ^ pch) * 16);
            const int v_dst = KBUF + (sch >> 2) * 8192 + skey * 64 + (sch & 3) * 16;
            const int kfo = hh * 2048;
            const int vfo = KBUF + (4 * hh + ((lane & 15) >> 2)) * 64 + ((lane >> 4) & 1) * 32 + (lane & 3) * 8;
            __syncthreads();
            u32x4 nk0, nv0, nk1, nv1, npr;
            {
                const u32x4 k0 = *(const u32x4*)kn_src, v0 = *(const u32x4*)(kn_src + 64);
                const u32x4 k1 = *(const u32x4*)(kn_src + 64 * 1024), v1 = *(const u32x4*)(kn_src + 64 * 1024 + 64);
                const u32x4 pr = *(const u32x4*)kp_src;
                const bf16_t* ks = kn_src + (size_t)128 * 1024;
                const u32x4 a0 = *(const u32x4*)ks, b0 = *(const u32x4*)(ks + 64);
                const u32x4 a1 = *(const u32x4*)(ks + 64 * 1024), b1 = *(const u32x4*)(ks + 64 * 1024 + 64);
                const u32x4 pr1 = *(const u32x4*)(kp_src + (size_t)128 * INCP);
                const bf16_t* ks2 = kn_src + (size_t)256 * 1024;
                nk0 = *(const u32x4*)ks2; nv0 = *(const u32x4*)(ks2 + 64);
                nk1 = *(const u32x4*)(ks2 + 64 * 1024); nv1 = *(const u32x4*)(ks2 + 64 * 1024 + 64);
                npr = *(const u32x4*)(kp_src + (size_t)256 * INCP);
                *(LAS u32x4*)(ldsL + k_dst) = k0; *(LAS u32x4*)(ldsL + k_dst + 1024) = k1;
                *(LAS u32x4*)(ldsL + v_dst) = v0; *(LAS u32x4*)(ldsL + v_dst + 4096) = v1;
                *(LAS u32x4*)(ldsL + kp_dst) = pr;
                *(LAS u32x4*)(ldsL + BUFB + k_dst) = a0; *(LAS u32x4*)(ldsL + BUFB + k_dst + 1024) = a1;
                *(LAS u32x4*)(ldsL + BUFB + v_dst) = b0; *(LAS u32x4*)(ldsL + BUFB + v_dst + 4096) = b1;
                *(LAS u32x4*)(ldsL + BUFB + kp_dst) = pr1;
            }
            __syncthreads();
            auto qk = [&](f32x16& y0, f32x16& y1, const int kb) __attribute__((always_inline)) {
#pragma unroll
                for (int d0 = 0; d0 < 6; ++d0) {
                    const int sw = (2 * d0 + hh) & 7;
                    const bf16x8 k0 = *(const LAS bf16x8*)(ldsL + kb + d0 * 4096 + ((r32 ^ sw) * 16));
                    const bf16x8 k1 = *(const LAS bf16x8*)(ldsL + kb + d0 * 4096 + (((32 + r32) ^ sw) * 16));
                    if (d0 == 0) { y0 = __builtin_amdgcn_mfma_f32_32x32x16_bf16(k0, qf[0], mneg, 0, 0, 0); y1 = __builtin_amdgcn_mfma_f32_32x32x16_bf16(k1, qf[0], mneg, 0, 0, 0); }
                    else { y0 = __builtin_amdgcn_mfma_f32_32x32x16_bf16(k0, qf[d0], y0, 0, 0, 0); y1 = __builtin_amdgcn_mfma_f32_32x32x16_bf16(k1, qf[d0], y1, 0, 0, 0); }
                }
            };
            auto rowmax = [&](const f32x16& s0, const f32x16& s1) __attribute__((always_inline)) -> float {
#define MX3(a, b, c) __builtin_fmaxf(__builtin_fmaxf((a), (b)), (c))
                float mxa = MX3(s0[0], s0[1], s1[0]), mxb = MX3(s0[2], s0[3], s1[1]); mxa = MX3(mxa, s1[2], s1[3]);
#pragma unroll
                for (int i = 4; i < 16; i += 4) { mxa = MX3(mxa, s0[i], s0[i + 1]); mxb = MX3(mxb, s0[i + 2], s0[i + 3]); mxa = MX3(mxa, s1[i], s1[i + 1]); mxb = MX3(mxb, s1[i + 2], s1[i + 3]); }
#undef MX3
                return max32(__builtin_fmaxf(mxa, mxb));
            };
            int klo[4];
#pragma unroll
            for (int j = 0; j < 4; ++j) klo[j] = (r32 ^ ((2 * j + hh) & 7)) * 16;
            const int cwof = (tid >> 5) * 528 + (tid & 31) * 16, crof = (4 * (tid & 3)) * 528 + (tid >> 2) * 4;
            const int cdr = perm_row(tid >> 2);
            bf16_t* cdst = nullptr; const float* csrc = nullptr; int cbA = CVB, cbB = CVB + CVBUF;
            auto step = [&](f32x16& x0, f32x16& x1, f32x16& y0, f32x16& y1, const int kb, const int vb, const bool CONV, f32x4& cv0, f32x4& cv1) __attribute__((always_inline)) {
unsigned wq[16]; f32x2_t psv = {0.f, 0.f}; unsigned cr0 = 0u, cr1 = 0u, cr2 = 0u, cr3 = 0u;
#define MX3(a, b, c) __builtin_fmaxf(__builtin_fmaxf((a), (b)), (c))
#define SB __builtin_amdgcn_sched_barrier(0)
                const bf16x8 fr0 = *(const LAS bf16x8*)(ldsL + kb + 0 + klo[0]); const bf16x8 fr1 = *(const LAS bf16x8*)(ldsL + kb + 512 + klo[0]); const bf16x8 fr2 = *(const LAS bf16x8*)(ldsL + kb + 4096 + klo[1]); const bf16x8 fr3 = *(const LAS bf16x8*)(ldsL + kb + 4608 + klo[1]); SB;
                const bf16x8 fr4 = *(const LAS bf16x8*)(ldsL + kb + 8192 + klo[2]); y0 = __builtin_amdgcn_mfma_f32_32x32x16_bf16(fr0, qf[0], mneg, 0, 0, 0); x0[0] = ex2(x0[0]); x0[1] = ex2(x0[1]); SB;
                const bf16x8 fr5 = *(const LAS bf16x8*)(ldsL + kb + 8704 + klo[2]); y1 = __builtin_amdgcn_mfma_f32_32x32x16_bf16(fr1, qf[0], mneg, 0, 0, 0); x0[2] = ex2(x0[2]); x0[3] = ex2(x0[3]); psv += (f32x2_t){x0[0], x0[1]}; wq[0] = pk2(x0[0], x0[1]); SB;
                const s16x4 lo6 = __builtin_bit_cast(s16x4, __builtin_amdgcn_ds_read_tr16_b64_v4i16((LAS s16x4*)(ldsL + vb + 0))); const s16x4 hi6 = __builtin_bit_cast(s16x4, __builtin_amdgcn_ds_read_tr16_b64_v4i16((LAS s16x4*)(ldsL + vb + 512))); y0 = __builtin_amdgcn_mfma_f32_32x32x16_bf16(fr2, qf[1], y0, 0, 0, 0); x0[4] = ex2(x0[4]); x0[5] = ex2(x0[5]); psv += (f32x2_t){x0[2], x0[3]}; wq[1] = pk2(x0[2], x0[3]); SB;
                const s16x4 lo7 = __builtin_bit_cast(s16x4, __builtin_amdgcn_ds_read_tr16_b64_v4i16((LAS s16x4*)(ldsL + vb + 8192))); const s16x4 hi7 = __builtin_bit_cast(s16x4, __builtin_amdgcn_ds_read_tr16_b64_v4i16((LAS s16x4*)(ldsL + vb + 8704))); y1 = __builtin_amdgcn_mfma_f32_32x32x16_bf16(fr3, qf[1], y1, 0, 0, 0); x0[6] = ex2(x0[6]); x0[7] = ex2(x0[7]); psv += (f32x2_t){x0[4], x0[5]}; wq[2] = pk2(x0[4], x0[5]); SB;
                const bf16x8 fr8 = *(const LAS bf16x8*)(ldsL + kb + 12288 + klo[3]); y0 = __builtin_amdgcn_mfma_f32_32x32x16_bf16(fr4, qf[2], y0, 0, 0, 0); x0[8] = ex2(x0[8]); x0[9] = ex2(x0[9]); psv += (f32x2_t){x0[6], x0[7]}; wq[3] = pk2(x0[6], x0[7]); SB;
                const bf16x8 fr9 = *(const LAS bf16x8*)(ldsL + kb + 12800 + klo[3]); y1 = __builtin_amdgcn_mfma_f32_32x32x16_bf16(fr5, qf[2], y1, 0, 0, 0); x0[10] = ex2(x0[10]); x0[11] = ex2(x0[11]); psv += (f32x2_t){x0[8], x0[9]}; wq[4] = pk2(x0[8], x0[9]); SB;
                const bf16x8 fr10 = *(const LAS bf16x8*)(ldsL + kb + 16384 + klo[0]); { const bf16x8 vf = {lo6[0], lo6[1], lo6[2], lo6[3], hi6[0], hi6[1], hi6[2], hi6[3]}; o0 = __builtin_amdgcn_mfma_f32_32x32x16_bf16(vf, __builtin_bit_cast(bf16x8, (u32x4){wq[0], wq[1], wq[2], wq[3]}), o0, 0, 0, 0); } x0[12] = ex2(x0[12]); x0[13] = ex2(x0[13]); psv += (f32x2_t){x0[10], x0[11]}; wq[5] = pk2(x0[10], x0[11]); SB;
                const bf16x8 fr11 = *(const LAS bf16x8*)(ldsL + kb + 16896 + klo[0]); { const bf16x8 vf = {lo7[0], lo7[1], lo7[2], lo7[3], hi7[0], hi7[1], hi7[2], hi7[3]}; o1 = __builtin_amdgcn_mfma_f32_32x32x16_bf16(vf, __builtin_bit_cast(bf16x8, (u32x4){wq[0], wq[1], wq[2], wq[3]}), o1, 0, 0, 0); } x0[14] = ex2(x0[14]); x0[15] = ex2(x0[15]); psv += (f32x2_t){x0[12], x0[13]}; wq[6] = pk2(x0[12], x0[13]); SB;
                const bf16x8 fr12 = *(const LAS bf16x8*)(ldsL + kb + 20480 + klo[1]); y0 = __builtin_amdgcn_mfma_f32_32x32x16_bf16(fr8, qf[3], y0, 0, 0, 0); x1[0] = ex2(x1[0]); x1[1] = ex2(x1[1]); psv += (f32x2_t){x0[14], x0[15]}; wq[7] = pk2(x0[14], x0[15]); SB;
                const bf16x8 fr13 = *(const LAS bf16x8*)(ldsL + kb + 20992 + klo[1]); y1 = __builtin_amdgcn_mfma_f32_32x32x16_bf16(fr9, qf[3], y1, 0, 0, 0); x1[2] = ex2(x1[2]); x1[3] = ex2(x1[3]); psv += (f32x2_t){x1[0], x1[1]}; wq[8] = pk2(x1[0], x1[1]); SB;
                const s16x4 lo14 = __builtin_bit_cast(s16x4, __builtin_amdgcn_ds_read_tr16_b64_v4i16((LAS s16x4*)(ldsL + vb + 1024))); const s16x4 hi14 = __builtin_bit_cast(s16x4, __builtin_amdgcn_ds_read_tr16_b64_v4i16((LAS s16x4*)(ldsL + vb + 1536))); y0 = __builtin_amdgcn_mfma_f32_32x32x16_bf16(fr10, qf[4], y0, 0, 0, 0); x1[4] = ex2(x1[4]); x1[5] = ex2(x1[5]); psv += (f32x2_t){x1[2], x1[3]}; wq[9] = pk2(x1[2], x1[3]); SB;
                const s16x4 lo15 = __builtin_bit_cast(s16x4, __builtin_amdgcn_ds_read_tr16_b64_v4i16((LAS s16x4*)(ldsL + vb + 9216))); const s16x4 hi15 = __builtin_bit_cast(s16x4, __builtin_amdgcn_ds_read_tr16_b64_v4i16((LAS s16x4*)(ldsL + vb + 9728))); y1 = __builtin_amdgcn_mfma_f32_32x32x16_bf16(fr11, qf[4], y1, 0, 0, 0); x1[6] = ex2(x1[6]); x1[7] = ex2(x1[7]); psv += (f32x2_t){x1[4], x1[5]}; wq[10] = pk2(x1[4], x1[5]); SB;
                const s16x4 lo16 = __builtin_bit_cast(s16x4, __builtin_amdgcn_ds_read_tr16_b64_v4i16((LAS s16x4*)(ldsL + vb + 2048))); const s16x4 hi16 = __builtin_bit_cast(s16x4, __builtin_amdgcn_ds_read_tr16_b64_v4i16((LAS s16x4*)(ldsL + vb + 2560))); y0 = __builtin_amdgcn_mfma_f32_32x32x16_bf16(fr12, qf[5], y0, 0, 0, 0); x1[8] = ex2(x1[8]); x1[9] = ex2(x1[9]); psv += (f32x2_t){x1[6], x1[7]}; wq[11] = pk2(x1[6], x1[7]); SB;
                const s16x4 lo17 = __builtin_bit_cast(s16x4, __builtin_amdgcn_ds_read_tr16_b64_v4i16((LAS s16x4*)(ldsL + vb + 10240))); const s16x4 hi17 = __builtin_bit_cast(s16x4, __builtin_amdgcn_ds_read_tr16_b64_v4i16((LAS s16x4*)(ldsL + vb + 10752))); y1 = __builtin_amdgcn_mfma_f32_32x32x16_bf16(fr13, qf[5], y1, 0, 0, 0); x1[10] = ex2(x1[10]); x1[11] = ex2(x1[11]); psv += (f32x2_t){x1[8], x1[9]}; wq[12] = pk2(x1[8], x1[9]); SB;
                const s16x4 lo18 = __builtin_bit_cast(s16x4, __builtin_amdgcn_ds_read_tr16_b64_v4i16((LAS s16x4*)(ldsL + vb + 3072))); const s16x4 hi18 = __builtin_bit_cast(s16x4, __builtin_amdgcn_ds_read_tr16_b64_v4i16((LAS s16x4*)(ldsL + vb + 3584))); { const bf16x8 vf = {lo14[0], lo14[1], lo14[2], lo14[3], hi14[0], hi14[1], hi14[2], hi14[3]}; o0 = __builtin_amdgcn_mfma_f32_32x32x16_bf16(vf, __builtin_bit_cast(bf16x8, (u32x4){wq[4], wq[5], wq[6], wq[7]}), o0, 0, 0, 0); } x1[12] = ex2(x1[12]); x1[13] = ex2(x1[13]); psv += (f32x2_t){x1[10], x1[11]}; wq[13] = pk2(x1[10], x1[11]); SB;
                const s16x4 lo19 = __builtin_bit_cast(s16x4, __builtin_amdgcn_ds_read_tr16_b64_v4i16((LAS s16x4*)(ldsL + vb + 11264))); const s16x4 hi19 = __builtin_bit_cast(s16x4, __builtin_amdgcn_ds_read_tr16_b64_v4i16((LAS s16x4*)(ldsL + vb + 11776))); { const bf16x8 vf = {lo15[0], lo15[1], lo15[2], lo15[3], hi15[0], hi15[1], hi15[2], hi15[3]}; o1 = __builtin_amdgcn_mfma_f32_32x32x16_bf16(vf, __builtin_bit_cast(bf16x8, (u32x4){wq[4], wq[5], wq[6], wq[7]}), o1, 0, 0, 0); } x1[14] = ex2(x1[14]); x1[15] = ex2(x1[15]); psv += (f32x2_t){x1[12], x1[13]}; wq[14] = pk2(x1[12], x1[13]); SB;
                { const bf16x8 vf = {lo16[0], lo16[1], lo16[2], lo16[3], hi16[0], hi16[1], hi16[2], hi16[3]}; o0 = __builtin_amdgcn_mfma_f32_32x32x16_bf16(vf, __builtin_bit_cast(bf16x8, (u32x4){wq[8], wq[9], wq[10], wq[11]}), o0, 0, 0, 0); } psv += (f32x2_t){x1[14], x1[15]}; wq[15] = pk2(x1[14], x1[15]); float mxa = MX3(y0[0], y0[1], y1[0]); float mxb = MX3(y0[2], y0[3], y1[1]); mxa = MX3(mxa, y1[2], y1[3]); mxa = MX3(mxa, y0[4], y0[5]); if (CONV) { cr0 = *(const LAS unsigned*)(ldsL + cbA + crof); cr1 = *(const LAS unsigned*)(ldsL + cbA + crof + 528); cr2 = *(const LAS unsigned*)(ldsL + cbA + crof + 1056); cr3 = *(const LAS unsigned*)(ldsL + cbA + crof + 1584); } SB;
                { const bf16x8 vf = {lo17[0], lo17[1], lo17[2], lo17[3], hi17[0], hi17[1], hi17[2], hi17[3]}; o1 = __builtin_amdgcn_mfma_f32_32x32x16_bf16(vf, __builtin_bit_cast(bf16x8, (u32x4){wq[8], wq[9], wq[10], wq[11]}), o1, 0, 0, 0); } mxb = MX3(mxb, y0[6], y0[7]); mxa = MX3(mxa, y1[4], y1[5]); mxb = MX3(mxb, y1[6], y1[7]); mxa = MX3(mxa, y0[8], y0[9]); if (CONV) { u32x4 cw; cw.x = pk2(cv0[0], cv1[0]); cw.y = pk2(cv0[1], cv1[1]); cw.z = pk2(cv0[2], cv1[2]); cw.w = pk2(cv0[3], cv1[3]); *(LAS u32x4*)(ldsL + cbB + cwof) = cw; } SB;
                { const bf16x8 vf = {lo18[0], lo18[1], lo18[2], lo18[3], hi18[0], hi18[1], hi18[2], hi18[3]}; o0 = __builtin_amdgcn_mfma_f32_32x32x16_bf16(vf, __builtin_bit_cast(bf16x8, (u32x4){wq[12], wq[13], wq[14], wq[15]}), o0, 0, 0, 0); } mxb = MX3(mxb, y0[10], y0[11]); mxa = MX3(mxa, y1[8], y1[9]); mxb = MX3(mxb, y1[10], y1[11]); mxa = MX3(mxa, y0[12], y0[13]); if (CONV) { cv0 = __builtin_nontemporal_load((const f32x4*)csrc); cv1 = __builtin_nontemporal_load((const f32x4*)(csrc + 256)); } SB;
                { const bf16x8 vf = {lo19[0], lo19[1], lo19[2], lo19[3], hi19[0], hi19[1], hi19[2], hi19[3]}; o1 = __builtin_amdgcn_mfma_f32_32x32x16_bf16(vf, __builtin_bit_cast(bf16x8, (u32x4){wq[12], wq[13], wq[14], wq[15]}), o1, 0, 0, 0); } mxb = MX3(mxb, y0[14], y0[15]); mxa = MX3(mxa, y1[12], y1[13]); mxb = MX3(mxb, y1[14], y1[15]); if (CONV) { u32x4 cs; cs.x = cr0; cs.y = cr1; cs.z = cr2; cs.w = cr3; *(u32x4*)cdst = cs; } SB;
#undef SB
#undef MX3
                l_run += psv[0] + psv[1];
                const float mx = max32(__builtin_fmaxf(mxa, mxb));
                if (__builtin_amdgcn_ballot_w64(mx > 8.0f) != 0ull) {
                    const float d = fmaxf(mx, 0.f);
                    const float alpha = ex2(-d);
                    m_run += d; l_run *= alpha;
#pragma unroll
                    for (int i = 0; i < 16; ++i) { o0[i] *= alpha; o1[i] *= alpha; y0[i] -= d; y1[i] -= d; mneg[i] = -m_run; }
                }
            };
            f32x16 sa0, sa1, sb0, sb1;
            qk(sa0, sa1, kfo);
            {
                const float mx = rowmax(sa0, sa1);
                m_run = mx;
#pragma unroll
                for (int i = 0; i < 16; ++i) { sa0[i] -= mx; sa1[i] -= mx; mneg[i] = -mx; }
            }
            int cur = 0, nxt = BUFB, wr = 2 * BUFB;
            auto iter = [&](const int t, f32x4& cv0, f32x4& cv1) __attribute__((always_inline)) {
                *(LAS u32x4*)(ldsL + wr + k_dst) = nk0; *(LAS u32x4*)(ldsL + wr + k_dst + 1024) = nk1;
                *(LAS u32x4*)(ldsL + wr + v_dst) = nv0; *(LAS u32x4*)(ldsL + wr + v_dst + 4096) = nv1;
                *(LAS u32x4*)(ldsL + wr + kp_dst) = npr;
                const int tn = (t + 3 < 32) ? t + 3 : 31;
                const bf16_t* ks = kn_src + (size_t)tn * 128 * 1024;
                nk0 = *(const u32x4*)ks; nv0 = *(const u32x4*)(ks + 64);
                nk1 = *(const u32x4*)(ks + 64 * 1024); nv1 = *(const u32x4*)(ks + 64 * 1024 + 64);
                npr = *(const u32x4*)(kp_src + (size_t)tn * 128 * INCP);
                {
                    const int cA = gi >= 3 ? gi - 3 : 0, slA = cA >> 5, slC = gi >> 5;
                    cdst = W_scr + (size_t)(slA >> 1) * 256 * 1024 + (slA & 1) * 128 * 1024 + (size_t)cdr * 1024 + (cA & 31) * 32 + (tid & 3) * 8;
                    const int jC = slC >> 1, uuC = blk + jC * G;
                    const int eC = (G == 256) ? ((vblk & ~1) + jC) : (uuC >> 1), pnC = (G == 256) ? (vblk & 1) : (uuC & 1);
                    csrc = P.in[(slC & 1) ? I_W3 : I_W1] + (size_t)eC * 1024 * 256 + pnC * 128 + (size_t)((gi & 31) * 32 + 2 * (tid >> 5)) * 256 + (tid & 31) * 4;
                    cbA = CVB + ((gi & 1) ^ 1) * CVBUF; cbB = CVB + (gi & 1) * CVBUF;
                }
                step(sa0, sa1, sb0, sb1, cur + kfo + 1024, cur + vfo, true, cv0, cv1);
                step(sb0, sb1, sa0, sa1, nxt + kfo, cur + vfo + 4096, false, cv0, cv1);
                const int tmp = cur; cur = nxt; nxt = wr; wr = tmp; ++gi;
                __syncthreads();
            };
#pragma unroll 1
            for (int t = 0; t < 32; t += 2) { iter(t, cva0, cva1); iter(t + 1, cvb0, cvb1); }
            {
                const float lt = sum32(l_run);
                const float inv = 1.0f / lt;
                const int sc = 81920 + wave * 4352;
#pragma unroll
                for (int g = 0; g < 4; ++g) {
                    u32x2 w;
                    w.x = pk2(o0[4 * g] * inv, o0[4 * g + 1] * inv); w.y = pk2(o0[4 * g + 2] * inv, o0[4 * g + 3] * inv);
                    *(LAS u32x2*)(ldsL + sc + r32 * 136 + (8 * g + 4 * hh) * 2) = w;
                    w.x = pk2(o1[4 * g] * inv, o1[4 * g + 1] * inv); w.y = pk2(o1[4 * g + 2] * inv, o1[4 * g + 3] * inv);
                    *(LAS u32x2*)(ldsL + sc + r32 * 136 + (32 + 8 * g + 4 * hh) * 2) = w;
                }
#pragma unroll
                for (int it = 0; it < 4; ++it) {
                    const int row = it * 8 + (lane >> 3), pc = lane & 7;
                    const u32x2 wa = *(const LAS u32x2*)(ldsL + sc + row * 136 + pc * 16), wb = *(const LAS u32x2*)(ldsL + sc + row * 136 + pc * 16 + 8);
                    u32x4 w; w.x = wa.x; w.y = wa.y; w.z = wb.x; w.w = wb.y;
                    *(u32x4*)(W_bout + (tok0 + qblk * 256 + wave * 32 + row) * 512 + h * 64 + pc * 8) = w;
                }
            }
        }
        if (gi == 128) {
            TIDS
            const int cwof = (tid >> 5) * 528 + (tid & 31) * 16, crof = (4 * (tid & 3)) * 528 + (tid >> 2) * 4, cdr = perm_row(tid >> 2);
#pragma unroll
            for (int d = 0; d < 3; ++d, ++gi) {
                const int cA = gi - 3, slA = cA >> 5;
                bf16_t* cdst = W_scr + (size_t)(slA >> 1) * 256 * 1024 + (slA & 1) * 128 * 1024 + (size_t)cdr * 1024 + (cA & 31) * 32 + (tid & 3) * 8;
                const int cbA = CVB + ((gi & 1) ^ 1) * CVBUF, cbB = CVB + (gi & 1) * CVBUF;
                u32x4 cs;
                cs.x = *(const LAS unsigned*)(ldsL + cbA + crof); cs.y = *(const LAS unsigned*)(ldsL + cbA + crof + 528); cs.z = *(const LAS unsigned*)(ldsL + cbA + crof + 1056); cs.w = *(const LAS unsigned*)(ldsL + cbA + crof + 1584);
                *(u32x4*)cdst = cs;
                if (d < 2) { const f32x4 c0 = d ? cvb0 : cva0, c1 = d ? cvb1 : cva1; u32x4 cw; cw.x = pk2(c0[0], c1[0]); cw.y = pk2(c0[1], c1[1]); cw.z = pk2(c0[2], c1[2]); cw.w = pk2(c0[3], c1[3]); *(LAS u32x4*)(ldsL + cbB + cwof) = cw; }
                __syncthreads();
            }
        }
        for (int ui = 0; ui < ((P.flags & 8) ? 0 : 12); ++ui) {
            TIDS
            const int r32 = lane & 31, hh = lane >> 5;
            const int u = vblk * 12 + ui;
            if (u >= 3072) break;
            const int bh = u / 48, w48 = u % 48, h = bh & 7, b = bh >> 3;
            const int p = w48 >> 4, j16 = w48 & 15;
            const int dil = (p == 0) ? 1 : (p == 1 ? 4 : 16);
            const int res = (p == 0) ? 0 : (p == 1 ? (j16 >> 2) : j16);
            const int m0 = (p == 0) ? j16 * 256 : (p == 1 ? (j16 & 3) * 256 : 0);
            const int L = SEQ / dil;
            const size_t tok0 = (size_t)b * SEQ;
            __syncthreads();
            for (int idx = tid; idx < 672; idx += 512) { const int oi = idx - 255; *(LAS float*)(ldsL + 98304 + idx * 4) = (oi >= 0 && oi <= 128) ? W_biasT[(p * 8 + h) * 129 + oi] : -1e30f; }
            {
                u32x4 kr[6], vr[6];
#pragma unroll
                for (int it = 0; it < 6; ++it) {
                    const int idx = it * 512 + tid, row = idx >> 3, ch = idx & 7;
                    const int mk = m0 - 64 + row;
                    kr[it] = (u32x4){0, 0, 0, 0}; vr[it] = (u32x4){0, 0, 0, 0};
                    if (mk >= 0 && mk < L) {
                        const bf16_t* src = W_proj + (tok0 + (size_t)mk * dil + res) * INCP + 512 + h * 64 + ch * 8;
                        kr[it] = *(const u32x4*)src; vr[it] = *(const u32x4*)(src + 512);
                    }
                }
#pragma unroll
                for (int it = 0; it < 6; ++it) {
                    const int idx = it * 512 + tid, row = idx >> 3, ch = idx & 7;
                    *(LAS u32x4*)(ldsL + ch * 6144 + ((row ^ ch) * 16)) = kr[it];
                    *(LAS u32x4*)(ldsL + 49152 + (ch >> 2) * 24576 + row * 64 + (ch & 3) * 16) = vr[it];
                }
            }
            const int qrel = wave * 32 + r32;
            const size_t tq = tok0 + (size_t)(m0 + qrel) * dil + res;
            bf16x8 qf[4];
#pragma unroll
            for (int d0 = 0; d0 < 4; ++d0) qf[d0] = *(const bf16x8*)(W_proj + tq * INCP + h * 64 + d0 * 16 + hh * 8);
            __syncthreads();
            f32x16 o0 = {}, o1 = {};
            float m_run = -1e20f, l_run = 0.f;
            const int vfo = 49152 + (4 * hh + ((lane & 15) >> 2)) * 64 + ((lane >> 4) & 1) * 32 + (lane & 3) * 8;
#pragma unroll 1
            for (int jj = 0; jj < 3; ++jj) {
                const int jt = (wave >> 1) + jj;
                f32x16 s0 = {}, s1 = {};
#pragma unroll
                for (int d0 = 0; d0 < 4; ++d0) {
                    const int ch = 2 * d0 + hh;
                    const bf16x8 k0 = *(const LAS bf16x8*)(ldsL + ch * 6144 + (((64 * jt + r32) ^ ch) * 16));
                    const bf16x8 k1 = *(const LAS bf16x8*)(ldsL + ch * 6144 + (((64 * jt + 32 + r32) ^ ch) * 16));
                    s0 = __builtin_amdgcn_mfma_f32_32x32x16_bf16(k0, qf[d0], s0, 0, 0, 0);
                    s1 = __builtin_amdgcn_mfma_f32_32x32x16_bf16(k1, qf[d0], s1, 0, 0, 0);
                }
                const LAS float* bl = (const LAS float*)(ldsL + 98304) + (64 * jt - qrel + 4 * hh + 255);
                const int mkb = m0 - 64 + 64 * jt;
                const bool edge = (mkb < 0) || (mkb + 64 > L);
#pragma unroll
                for (int i = 0; i < 16; ++i) {
                    const int cr = (i & 3) + 8 * (i >> 2);
                    s0[i] += bl[cr]; s1[i] += bl[cr + 32];
                    if (edge) {
                        const int mk0 = mkb + cr + 4 * hh;
                        if (mk0 < 0 || mk0 >= L) s0[i] = -1e30f;
                        if (mk0 + 32 < 0 || mk0 + 32 >= L) s1[i] = -1e30f;
                    }
                }
#define MX3(a, b, c) __builtin_fmaxf(__builtin_fmaxf((a), (b)), (c))
                float mxa = MX3(s0[0], s0[1], s1[0]), mxb = MX3(s0[2], s0[3], s1[1]); mxa = MX3(mxa, s1[2], s1[3]);
#pragma unroll
                for (int i = 4; i < 16; i += 4) { mxa = MX3(mxa, s0[i], s0[i + 1]); mxb = MX3(mxb, s0[i + 2], s0[i + 3]); mxa = MX3(mxa, s1[i], s1[i + 1]); mxb = MX3(mxb, s1[i + 2], s1[i + 3]); }
#undef MX3
                float mx = max32(__builtin_fmaxf(mxa, mxb));
                const float m_new = fmaxf(m_run, mx);
                const float alpha = ex2(m_run - m_new);
                m_run = m_new;
                f32x2_t psv = {0.f, 0.f};
#pragma unroll
                for (int i = 0; i < 16; i += 2) { s0[i] = ex2(s0[i] - m_new); s0[i + 1] = ex2(s0[i + 1] - m_new); s1[i] = ex2(s1[i] - m_new); s1[i + 1] = ex2(s1[i + 1] - m_new);
                    psv += (f32x2_t){s0[i], s0[i + 1]}; psv += (f32x2_t){s1[i], s1[i + 1]}; }
                l_run = l_run * alpha + (psv[0] + psv[1]);
#pragma unroll
                for (int i = 0; i < 16; ++i) { o0[i] *= alpha; o1[i] *= alpha; }
                bf16x8 pf[2][2];
#pragma unroll
                for (int s = 0; s < 2; ++s) {
                    u32x4 w0, w1;
                    w0.x = pk2(s0[8 * s + 0], s0[8 * s + 1]); w0.y = pk2(s0[8 * s + 2], s0[8 * s + 3]); w0.z = pk2(s0[8 * s + 4], s0[8 * s + 5]); w0.w = pk2(s0[8 * s + 6], s0[8 * s + 7]);
                    w1.x = pk2(s1[8 * s + 0], s1[8 * s + 1]); w1.y = pk2(s1[8 * s + 2], s1[8 * s + 3]); w1.z = pk2(s1[8 * s + 4], s1[8 * s + 5]); w1.w = pk2(s1[8 * s + 6], s1[8 * s + 7]);
                    pf[0][s] = __builtin_bit_cast(bf16x8, w0); pf[1][s] = __builtin_bit_cast(bf16x8, w1);
                }
#pragma unroll
                for (int n = 0; n < 2; ++n)
#pragma unroll
                    for (int s = 0; s < 2; ++s) {
                        const int ko = (64 * jt + 32 * n + 16 * s) * 64;
#pragma unroll
                        for (int db = 0; db < 2; ++db) {
                            const s16x4 lo = __builtin_bit_cast(s16x4, __builtin_amdgcn_ds_read_tr16_b64_v4i16((LAS s16x4*)(ldsL + vfo + db * 24576 + ko)));
                            const s16x4 hi = __builtin_bit_cast(s16x4, __builtin_amdgcn_ds_read_tr16_b64_v4i16((LAS s16x4*)(ldsL + vfo + db * 24576 + ko + 512)));
                            const bf16x8 vf = {lo[0], lo[1], lo[2], lo[3], hi[0], hi[1], hi[2], hi[3]};
                            if (db == 0) o0 = __builtin_amdgcn_mfma_f32_32x32x16_bf16(vf, pf[n][s], o0, 0, 0, 0);
                            else o1 = __builtin_amdgcn_mfma_f32_32x32x16_bf16(vf, pf[n][s], o1, 0, 0, 0);
                        }
                    }
            }
            __syncthreads();
            {
                const float lt = sum32(l_run);
                const float inv = 1.0f / lt;
                if (hh == 0) W_lsebuf[((size_t)p * NTOK + tq) * 8 + h] = m_run + __log2f(lt);
                const int sc = wave * 4352;
#pragma unroll
                for (int g = 0; g < 4; ++g) {
                    u32x2 w;
                    w.x = pk2(o0[4 * g] * inv, o0[4 * g + 1] * inv); w.y = pk2(o0[4 * g + 2] * inv, o0[4 * g + 3] * inv);
                    *(LAS u32x2*)(ldsL + sc + r32 * 136 + (8 * g + 4 * hh) * 2) = w;
                    w.x = pk2(o1[4 * g] * inv, o1[4 * g + 1] * inv); w.y = pk2(o1[4 * g + 2] * inv, o1[4 * g + 3] * inv);
                    *(LAS u32x2*)(ldsL + sc + r32 * 136 + (32 + 8 * g + 4 * hh) * 2) = w;
                }
#pragma unroll
                for (int it = 0; it < 4; ++it) {
                    const int row = it * 8 + (lane >> 3), pc = lane & 7;
                    const u32x2 wa = *(const LAS u32x2*)(ldsL + sc + row * 136 + pc * 16), wb = *(const LAS u32x2*)(ldsL + sc + row * 136 + pc * 16 + 8);
                    u32x4 w; w.x = wa.x; w.y = wa.y; w.z = wb.x; w.w = wb.y;
                    const size_t tr = tok0 + (size_t)(m0 + wave * 32 + row) * dil + res;
                    *(u32x4*)(W_aparts + ((size_t)p * NTOK + tr) * 512 + h * 64 + pc * 8) = w;
                }
            }
            if ((vblk % 12) == ui) {
#pragma unroll 1
                for (int q = 2; q < 4; ++q) {
                    const int uu = blk + q * G;
                    const int e = (G == 256) ? ((vblk & ~3) + q) : (uu >> 2), pn = (G == 256) ? (vblk & 3) : (uu & 3);
                    __syncthreads();
                    if (uu < 1024) convert_panel_lds<256, true>(W_scr + (size_t)2 * 256 * 1024 + (size_t)q * 256 * 256, P.in[I_W2] + (size_t)e * 256 * 1024 + pn * 256, 1024, 256, tid, ldsL);
                }
            }
        }
    }
    SEAM(4);

    if (IN(5)) {
        TIDS
        const int hd = lane >> 3;
        float nl0, nl1, nl2; u32x4 na0, na1, na2, nbb;
#define P5_LOAD(ROW) do { const size_t r_ = (size_t)(ROW); nl0 = W_lsebuf[((size_t)0 * NTOK + r_) * 8 + hd]; nl1 = W_lsebuf[((size_t)1 * NTOK + r_) * 8 + hd]; nl2 = W_lsebuf[((size_t)2 * NTOK + r_) * 8 + hd]; \
            na0 = __builtin_nontemporal_load((const u32x4*)(W_aparts + ((size_t)0 * NTOK + r_) * 512 + lane * 8)); na1 = __builtin_nontemporal_load((const u32x4*)(W_aparts + ((size_t)1 * NTOK + r_) * 512 + lane * 8)); \
            na2 = __builtin_nontemporal_load((const u32x4*)(W_aparts + ((size_t)2 * NTOK + r_) * 512 + lane * 8)); nbb = __builtin_nontemporal_load((const u32x4*)(W_bout + r_ * 512 + lane * 8)); } while (0)
        P5_LOAD(blk * 8 + wave);
        for (int row = blk * 8 + wave; row < NTOK; row += G * 8) {
            const float ls0 = nl0, ls1 = nl1, ls2 = nl2; const u32x4 a0 = na0, a1 = na1, a2 = na2, bb = nbb;
            if (row + G * 8 < NTOK) P5_LOAD(row + G * 8);
            const float M = fmaxf(ls0, fmaxf(ls1, ls2));
            float w0 = ex2(ls0 - M), w1 = ex2(ls1 - M), w2 = ex2(ls2 - M);
            const float wsn = 1.0f / (w0 + w1 + w2); w0 *= wsn; w1 *= wsn; w2 *= wsn;
            float av[8], bv[8]; float sa = 0.f, sb = 0.f;
#pragma unroll
            for (int j = 0; j < 4; ++j) {
                av[2 * j] = w0 * __uint_as_float(a0[j] << 16) + w1 * __uint_as_float(a1[j] << 16) + w2 * __uint_as_float(a2[j] << 16);
                av[2 * j + 1] = w0 * __uint_as_float(a0[j] & 0xffff0000u) + w1 * __uint_as_float(a1[j] & 0xffff0000u) + w2 * __uint_as_float(a2[j] & 0xffff0000u);
                bv[2 * j] = __uint_as_float(bb[j] << 16); bv[2 * j + 1] = __uint_as_float(bb[j] & 0xffff0000u);
                sa += av[2 * j] * av[2 * j] + av[2 * j + 1] * av[2 * j + 1];
                sb += bv[2 * j] * bv[2 * j] + bv[2 * j + 1] * bv[2 * j + 1];
            }
            sa = wave_sum(sa); sb = wave_sum(sb);
            const float ra = rsqrtf(sa * (1.0f / 512.0f) + EPS), rb = rsqrtf(sb * (1.0f / 512.0f) + EPS);
            u32x4 wa, wb;
            wa.x = pk2(av[0] * ra, av[1] * ra); wa.y = pk2(av[2] * ra, av[3] * ra); wa.z = pk2(av[4] * ra, av[5] * ra); wa.w = pk2(av[6] * ra, av[7] * ra);
            wb.x = pk2(bv[0] * rb, bv[1] * rb); wb.y = pk2(bv[2] * rb, bv[3] * rb); wb.z = pk2(bv[4] * rb, bv[5] * rb); wb.w = pk2(bv[6] * rb, bv[7] * rb);
            *(u32x4*)(W_mixb + (size_t)row * DM + lane * 8) = wa;
            *(u32x4*)(W_mixb + (size_t)row * DM + 512 + lane * 8) = wb;
        }
    }
    SEAM(5);

    if (IN(6)) {
        TIDS
        unsigned vl_[4]; g8_voff_lin(vl_, DM, tid);
        auto nextf = [&](int i, GDesc& d) {
            const int ul = i * 32 + (vblk & 31); if (ul >= 64 || vblk >= 256) return false;
            const int pm = (vblk >> 5) * 16 + (ul >> 2), pn = ul & 3;
            d.Ab = (const char*)(W_mixb + (size_t)pm * 256 * DM); d.Bb = (const char*)(W_WoT + (size_t)pn * 256 * DM);
            d.va0 = vl_[0]; d.va1 = vl_[1]; d.va2 = vl_[2]; d.va3 = vl_[3]; d.i0 = pm; d.i1 = pn; d.i2 = 0; return true;
        };
        auto epi = [&](const f32x4 (&acc)[2][2][4][2], const GDesc& d, int wr, int wc, int fr, int fq) {
            const int pm = d.i0, pn = d.i1;
            const float* gbase = W_mod + ((pm * 256) >> 12) * 6144 + 2048 + pn * 256 + wc * 32 + fq * 8;
            const f32x4 g00 = *(const f32x4*)gbase, g01 = *(const f32x4*)(gbase + 4), g10 = *(const f32x4*)(gbase + 128), g11 = *(const f32x4*)(gbase + 132);
#pragma unroll
            for (int am = 0; am < 4; ++am) {
                const int ai = am >> 1;
                f32x4 xv[2][4];
#pragma unroll
                for (int mm = 0; mm < 2; ++mm) {
                    const int m = (am & 1) * 2 + mm;
                    const float* xp = W_x + (size_t)(pm * 256 + ai * 128 + wr * 64 + m * 16 + fr) * DM + pn * 256 + wc * 32 + fq * 8;
                    xv[mm][0] = __builtin_nontemporal_load((const f32x4*)xp); xv[mm][1] = __builtin_nontemporal_load((const f32x4*)(xp + 4)); xv[mm][2] = __builtin_nontemporal_load((const f32x4*)(xp + 128)); xv[mm][3] = __builtin_nontemporal_load((const f32x4*)(xp + 132));
                }
#pragma unroll
                for (int mm = 0; mm < 2; ++mm) {
                    const int m = (am & 1) * 2 + mm;
                    const int row = pm * 256 + ai * 128 + wr * 64 + m * 16 + fr;
                    bf16_t* op = W_xt + (size_t)row * DM + pn * 256 + wc * 32 + fq * 8;
                    { const f32x4 a = xv[mm][0] + g00 * acc[ai][0][m][0], b = xv[mm][1] + g01 * acc[ai][0][m][1]; u32x4 w; PK8(w, a, b); *(u32x4*)op = w; }
                    { const f32x4 a = xv[mm][2] + g10 * acc[ai][1][m][0], b = xv[mm][3] + g11 * acc[ai][1][m][1]; u32x4 w; PK8(w, a, b); *(u32x4*)(op + 128) = w; }
                }
            }
        };
        gemm_stream(ldsL, tid, DM, nextf, epi);
    }
    SEAM(6);

    if (IN(7)) {
        TIDS
        const float* g = P.in[I_N2G];
        u32x4 tn[2];
        {
            const size_t r0 = (size_t)(blk * 8 + wave) * DM;
#pragma unroll
            for (int i = 0; i < 2; ++i) tn[i] = __builtin_nontemporal_load((const u32x4*)(W_xt + r0 + i * 512 + lane * 8));
        }
        for (int row = blk * 8 + wave; row < NTOK; row += G * 8) {
            const int b = row >> 12;
            f32x4 v[4]; float ss = 0.f;
#pragma unroll
            for (int i = 0; i < 4; ++i) {
                const unsigned ta = tn[i >> 1][(i & 1) * 2], tb = tn[i >> 1][(i & 1) * 2 + 1];
                v[i] = (f32x4){__uint_as_float(ta << 16), __uint_as_float(ta & 0xffff0000u), __uint_as_float(tb << 16), __uint_as_float(tb & 0xffff0000u)};
            }
            if (row + G * 8 < NTOK) {
                const size_t r1 = (size_t)(row + G * 8) * DM;
#pragma unroll
                for (int i = 0; i < 2; ++i) tn[i] = __builtin_nontemporal_load((const u32x4*)(W_xt + r1 + i * 512 + lane * 8));
            }
#pragma unroll
            for (int i = 0; i < 4; ++i) ss += v[i][0] * v[i][0] + v[i][1] * v[i][1] + v[i][2] * v[i][2] + v[i][3] * v[i][3];
            ss = wave_sum(ss);
            const float rinv = rsqrtf(ss * (1.0f / 1024.0f) + EPS);
            const float* mb = W_mod + b * 6144 + 3072;
#pragma unroll
            for (int i2 = 0; i2 < 2; ++i2) {
                u32x4 w;
#pragma unroll
                for (int hf = 0; hf < 2; ++hf) {
                    const int i = i2 * 2 + hf, c = i2 * 512 + lane * 8 + hf * 4;
                    const f32x4 gg = *(const f32x4*)(g + c), sh = *(const f32x4*)(mb + c), sc = *(const f32x4*)(mb + 1024 + c);
                    float o[4];
#pragma unroll
                    for (int j = 0; j < 4; ++j) o[j] = v[i][j] * rinv * gg[j] * (1.0f + sc[j]) + sh[j];
                    if (hf == 0) { w.x = pk2(o[0], o[1]); w.y = pk2(o[2], o[3]); } else { w.z = pk2(o[0], o[1]); w.w = pk2(o[2], o[3]); }
                }
                *(u32x4*)(W_hbuf + (size_t)row * DM + i2 * 512 + lane * 8) = w;
            }
        }
    }
    SEAM(7);

    if (IN(8)) {
        {
            TIDS
            unsigned vl_[4]; g8_voff_lin(vl_, DM, tid);
            auto nextf = [&](int i, GDesc& d) {
                const int ul = vblk & 31; if (vblk >= 256) return false;
                if (i == 0) {
                    const int pm = (vblk >> 5) * 16 + (ul >> 1), pn = ul & 1;
                    d.Ab = (const char*)(W_hbuf + (size_t)pm * 256 * DM); d.Bb = (const char*)(W_Ws13T + (size_t)pn * 256 * DM);
                    d.va0 = vl_[0]; d.va1 = vl_[1]; d.va2 = vl_[2]; d.va3 = vl_[3]; d.i0 = pm; d.i1 = pn; d.i2 = 0; return true;
                }
                if (i > 1 || ul < 16) return false;
                const int pm = (vblk >> 5) * 16 + (ul - 16);
                d.Ab = (const char*)(W_hbuf + (size_t)pm * 256 * DM); d.Bb = (const char*)(W_WrT);
                d.va0 = vl_[0]; d.va1 = vl_[1]; d.va2 = vl_[2]; d.va3 = vl_[3]; d.i0 = pm; d.i1 = 2; d.i2 = 0; return true;
            };
            auto epi = [&](const f32x4 (&acc)[2][2][4][2], const GDesc& d, int wr, int wc, int fr, int fq) {
                const int pm = d.i0, pn = d.i1;
                if (pn < 2) {
#pragma unroll
                    for (int ai = 0; ai < 2; ++ai)
#pragma unroll
                        for (int m = 0; m < 4; ++m) {
                            const int r = ai * 128 + wr * 64 + m * 16 + fr;
                            const f32x4 a0 = acc[ai][0][m][0], a1 = acc[ai][0][m][1], b0 = acc[ai][1][m][0], b1 = acc[ai][1][m][1];
                            f32x4 h0, h1;
#pragma unroll
                            for (int j = 0; j < 4; ++j) { h0[j] = siluf(a0[j]) * b0[j]; h1[j] = siluf(a1[j]) * b1[j]; }
                            u32x4 w; PK8(w, h0, h1);
                            *(u32x4*)(W_hdn + (size_t)(NASG + pm * 256 + r) * EFF + pn * 128 + wc * 32 + fq * 8) = w;
                        }
                } else {
                    EPI_FOREACH8(acc, wr, wc, fr, fq, r, c8, v0, v1, {
                        *(f32x4*)(W_logits + (size_t)(pm * 256 + r) * 256 + c8) = v0;
                        *(f32x4*)(W_logits + (size_t)(pm * 256 + r) * 256 + c8 + 4) = v1;
                    })
                }
            };
            gemm_stream(ldsL, tid, DM, nextf, epi);
        }
        if ((vblk & 31) < 16) {
            TIDS
#pragma unroll 1
            for (int q = 0; q < 2; ++q) {
                const int uu = blk + q * G;
                const int e = (G == 256) ? ((vblk & ~3) + q) : (uu >> 2), pn = (G == 256) ? (vblk & 3) : (uu & 3);
                __syncthreads();
                if (uu < 1024) convert_panel_lds<256, true>(W_scr + (size_t)2 * 256 * 1024 + (size_t)q * 256 * 256, P.in[I_W2] + (size_t)e * 256 * 1024 + pn * 256, 1024, 256, tid, ldsL);
            }
        }
    }
    SEAM(8);

    if (IN(9)) {
        TIDS
        const float* ebias = P.in[I_EB];
        const f32x4 eb = *(const f32x4*)(ebias + lane * 4);
        f32x4 lgn = __builtin_nontemporal_load((const f32x4*)(W_logits + (size_t)(blk * 8 + wave) * 256 + lane * 4));
        for (int t = blk * 8 + wave; t < NTOK; t += G * 8) {
            const f32x4 lg = lgn;
            if (t + G * 8 < NTOK) lgn = __builtin_nontemporal_load((const f32x4*)(W_logits + (size_t)(t + G * 8) * 256 + lane * 4));
            float sc[4], sel[4];
#pragma unroll
            for (int i = 0; i < 4; ++i) { sc[i] = 1.0f / (1.0f + expf(-lg[i])); sel[i] = sc[i] + eb[i]; }
            float a1 = fmaxf(sel[0], sel[1]), a2 = fminf(sel[0], sel[1]);
#pragma unroll
            for (int i = 2; i < 4; ++i) { const float v = sel[i]; a2 = fmaxf(a2, fminf(a1, v)); a1 = fmaxf(a1, v); }
            {
                float b1, b2, n1, n2;
                b1 = dppf(a1, DPP_X1); b2 = dppf(a2, DPP_X1); n1 = fmaxf(a1, b1); n2 = fmaxf(fminf(a1, b1), fmaxf(a2, b2)); a1 = n1; a2 = n2;
                b1 = dppf(a1, DPP_X2); b2 = dppf(a2, DPP_X2); n1 = fmaxf(a1, b1); n2 = fmaxf(fminf(a1, b1), fmaxf(a2, b2)); a1 = n1; a2 = n2;
                b1 = dppf(a1, DPP_HM); b2 = dppf(a2, DPP_HM); n1 = fmaxf(a1, b1); n2 = fmaxf(fminf(a1, b1), fmaxf(a2, b2)); a1 = n1; a2 = n2;
            }
            const float gs = a1 + a2; const int myg = lane >> 3;
            int rank = 0;
#pragma unroll
            for (int g = 0; g < 8; ++g) { const float v = __int_as_float(__builtin_amdgcn_readlane(__float_as_int(gs), g * 8)); rank += (v > gs || (v == gs && g < myg)) ? 1 : 0; }
            const bool gsel = rank < 4;
            unsigned key[4];
#pragma unroll
            for (int i = 0; i < 4; ++i) { const unsigned u = __float_as_uint(sel[i]); const unsigned mono = u ^ ((u >> 31) ? 0xFFFFFFFFu : 0x80000000u);
                key[i] = gsel ? ((mono & 0xFFFFFF00u) | (unsigned)(255 - (lane * 4 + i))) : 0u; }
            int my_e = 0; float my_g = 0.f; float gsum = 0.f;
#pragma unroll
            for (int k = 0; k < 8; ++k) {
                unsigned v = key[0] > key[1] ? key[0] : key[1]; { const unsigned w = key[2] > key[3] ? key[2] : key[3]; v = v > w ? v : w; }
#define UMX(o) do { const unsigned o_ = (unsigned)(o); v = v > o_ ? v : o_; } while (0)
                UMX(dppi((int)v, DPP_X1)); UMX(dppi((int)v, DPP_X2)); UMX(dppi((int)v, DPP_HM)); UMX(dppi((int)v, DPP_RM));
                { auto rv = __builtin_amdgcn_permlane16_swap(v, v, false, false); v = rv[0]; UMX(rv[1]); }
                { auto rv = __builtin_amdgcn_permlane32_swap(v, v, false, false); v = rv[0]; UMX(rv[1]); }
#undef UMX
                v = (unsigned)__builtin_amdgcn_readfirstlane((int)v);
                const int ix = 255 - (int)(v & 255u);
                float myscore = 0.f;
#pragma unroll
                for (int i = 0; i < 4; ++i) if (key[i] == v) { key[i] = 0u; myscore = sc[i]; }
                const float gw = __int_as_float(__builtin_amdgcn_readlane(__float_as_int(myscore), ix >> 2));
                gsum += gw;
                if (lane == k) { my_e = ix; my_g = gw; }
            }
            if (lane < 8) {
                const unsigned rk = atomicAdd(&cntg[my_e * CNT_STRIDE], 1u);
                W_eidx[t * 8 + lane] = my_e; W_rnk[t * 8 + lane] = (int)rk;
                W_toks2[(size_t)my_e * 32768 + rk] = t; W_wts2[(size_t)my_e * 32768 + rk] = my_g / gsum * 2.5f;
            }
        }
    }
    SEAM(9);


    if (IN(11)) {
        TIDS
        __syncthreads();
        if (tid < 256) cntL[tid] = (int)__hip_atomic_load(&cntg[tid * CNT_STRIDE], __ATOMIC_RELAXED, __HIP_MEMORY_SCOPE_AGENT);
        if (tid == 256) cntL[256] = NTOK;
        __syncthreads();
        { int sa, tb, th; prefix_cnt(cntL, itemD, 257, tid, sa, tb, th); if (tid <= 257) { if (tid <= 256) startL[tid] = sa; tbL[tid] = tb; thL[tid] = th; } }
        __syncthreads();
        const int TF1 = 2 * tbL[256], TH1 = 2 * thL[256];
        const int XW = (G % 8 == 0) ? G / 8 : G, xq = vblk / XW, jl = vblk % XW, NX = G / XW;
        const int X0 = (int)(((long)xq * TF1) / NX), X1 = (int)(((long)(xq + 1) * TF1) / NX), H0 = (int)(((long)xq * TH1) / NX), H1 = (int)(((long)(xq + 1) * TH1) / NX);
        const int nF = (X1 - X0 - jl + XW - 1) / XW, jh = (jl - (X1 - X0) % XW + XW) % XW, nH = (H1 - H0 - jh + XW - 1) / XW;
        const int nmine = nF + nH;
        for (int c0 = 0; c0 < nmine; c0 += CH11) {
            TIDS
            const int nch = (nmine - c0) < CH11 ? (nmine - c0) : CH11;
            __syncthreads();
            if (tid < nch) {
                const int k = c0 + tid; const bool hreg = k >= nF;
                const int g = hreg ? H0 + jh + (k - nF) * XW : X0 + jl + k * XW;
                const LAS int* pf = hreg ? thL : tbL;
                int e = 0; { int hi = 255; while (e < hi) { const int mid = (e + hi + 1) >> 1; if (2 * pf[mid] <= g) e = mid; else hi = mid - 1; } }
                const int r = g - 2 * pf[e];
                itemD[tid * 4 + 0] = e; itemD[tid * 4 + 1] = r & 1; itemD[tid * 4 + 2] = hreg ? tbL[e + 1] - tbL[e] : r >> 1;
            }
            __syncthreads();
            {
                constexpr int NQ = (CH11 * 256 + 511) / 512;
                int tk[NQ]; float wt[NQ];
#pragma unroll
                for (int q = 0; q < NQ; ++q) {
                    const int idx = tid + q * 512; tk[q] = 0; wt[q] = 0.f;
                    if (idx < nch * 256) {
                        const int it = idx >> 8, e = itemD[it * 4], ti = itemD[it * 4 + 2];
                        const int rr = ti * 256 + (idx & 255); const int sr = startL[e] + (rr < cntL[e] ? rr : 0);
                        const size_t sg = (size_t)e * 32768 + (rr < cntL[e] ? rr : 0); tk[q] = W_toks2[sg]; wt[q] = W_wts2[sg];
                    }
                }
#pragma unroll
                for (int q = 0; q < NQ; ++q) {
                    const int idx = tid + q * 512;
                    if (idx < nch * 256) { rowoff[idx] = (unsigned)tk[q] * DM; rowsc[idx] = wt[q]; }
                }
            }
            __syncthreads();
            int R0, C0; g8_rc(tid, R0, C0);
            auto nextf = [&](int i, GDesc& d) {
                if (i >= nch) return false;
                const int e = itemD[i * 4], pn = itemD[i * 4 + 1], ti = itemD[i * 4 + 2];
                const int vo = (e & ~1) | pn; const int bo = (G == 256) ? ((vo & 31) * 8 + (vo >> 5)) : vo;
                d.Ab = (const char*)W_hbuf; d.Bb = (const char*)(ws + OFF_SCR + (size_t)bo * SCR_PER_BLK) + (size_t)(e & 1) * 512 * 1024;
                d.va0 = (rowoff[i * 256 + R0] + C0) * 2u; d.va1 = (rowoff[i * 256 + R0 + 64] + C0) * 2u; d.va2 = (rowoff[i * 256 + R0 + 128] + C0) * 2u; d.va3 = (rowoff[i * 256 + R0 + 192] + C0) * 2u;
                const int left = cntL[e] - ti * 256;
                d.i0 = startL[e] + ti * 256; d.i1 = (left < 256 ? left : 256) | (i << 16); d.i2 = pn | ((left <= 128) << 8); return true;
            };
            auto epi = [&](const f32x4 (&acc)[2][2][4][2], const GDesc& d, int wr, int wc, int fr, int fq) {
                const int rowbase = d.i0, nvalid = d.i1 & 0xffff, tl = d.i1 >> 16, pn = d.i2 & 255;
#pragma unroll
                for (int ai = 0; ai < 2; ++ai)
#pragma unroll
                    for (int m = 0; m < 4; ++m) {
                        const int r = ai * 128 + wr * 64 + m * 16 + fr;
                        if (r < nvalid) {
                            const float g = rowsc[tl * 256 + r];
                            const f32x4 a0 = acc[ai][0][m][0], a1 = acc[ai][0][m][1], b0 = acc[ai][1][m][0], b1 = acc[ai][1][m][1];
                            f32x4 h0, h1;
#pragma unroll
                            for (int j = 0; j < 4; ++j) { h0[j] = siluf(a0[j]) * (b0[j] * g); h1[j] = siluf(a1[j]) * (b1[j] * g); }
                            u32x4 w; PK8(w, h0, h1);
                            *(u32x4*)(W_hdn + (size_t)(rowbase + r) * EFF + pn * 128 + wc * 32 + fq * 8) = w;
                        }
                    }
            };
            gemm_stream(ldsL, tid, DM, nextf, epi);
        }
        {
            TIDS
            for (int t0 = blk * 8 + wave; t0 < NTOK; t0 += G * 64) {
                const int t = t0 + (lane >> 3) * (G * 8), sl = lane & 7;
                if (t < NTOK) W_pos[t * 8 + sl] = startL[W_eidx[t * 8 + sl]] + W_rnk[t * 8 + sl];
            }
        }
    }
    SEAM(11);

    if (IN(12)) {
        TIDS
        __syncthreads();
        if (MK_N_LAUNCHES != 1) {
            if (tid < 256) cntL[tid] = (int)__hip_atomic_load(&cntg[tid * CNT_STRIDE], __ATOMIC_RELAXED, __HIP_MEMORY_SCOPE_AGENT);
            if (tid == 256) cntL[256] = NTOK;
            __syncthreads();
            { int sa, tb, th; prefix_cnt(cntL, itemD, 257, tid, sa, tb, th); if (tid <= 257) { if (tid <= 256) startL[tid] = sa; tbL[tid] = tb; thL[tid] = th; } }
            __syncthreads();
        }
        const int TF2 = 4 * tbL[257], TH2 = 4 * thL[257];
        const int XW = (G % 8 == 0) ? G / 8 : G, xq = vblk / XW, jl = vblk % XW, NX = G / XW;
        const int X0 = (int)(((long)xq * TF2) / NX), X1 = (int)(((long)(xq + 1) * TF2) / NX), H0 = (int)(((long)xq * TH2) / NX), H1 = (int)(((long)(xq + 1) * TH2) / NX);
        const int nF = (X1 - X0 - jl + XW - 1) / XW, jh = (jl - (X1 - X0) % XW + XW) % XW, nH = (H1 - H0 - jh + XW - 1) / XW;
        const int nmine = nF + nH;
#define Y_STORE(ROWG, COL0) do { const f32x4 a_ = acc[ai][0][m][0], b_ = acc[ai][0][m][1], c_ = acc[ai][1][m][0], d_ = acc[ai][1][m][1]; int w0_ = 0, w1_ = 0, w2_ = 0, w3_ = 0; \
            w0_ = __builtin_amdgcn_cvt_pk_fp8_f32(a_[0], a_[1], w0_, false); w0_ = __builtin_amdgcn_cvt_pk_fp8_f32(a_[2], a_[3], w0_, true); \
            w1_ = __builtin_amdgcn_cvt_pk_fp8_f32(b_[0], b_[1], w1_, false); w1_ = __builtin_amdgcn_cvt_pk_fp8_f32(b_[2], b_[3], w1_, true); \
            w2_ = __builtin_amdgcn_cvt_pk_fp8_f32(c_[0], c_[1], w2_, false); w2_ = __builtin_amdgcn_cvt_pk_fp8_f32(c_[2], c_[3], w2_, true); \
            w3_ = __builtin_amdgcn_cvt_pk_fp8_f32(d_[0], d_[1], w3_, false); w3_ = __builtin_amdgcn_cvt_pk_fp8_f32(d_[2], d_[3], w3_, true); \
            u32x4 w_; w_.x = (unsigned)w0_; w_.y = (unsigned)w1_; w_.z = (unsigned)w2_; w_.w = (unsigned)w3_; *(u32x4*)(W_y8 + (size_t)(ROWG) * DM + (COL0) + wc * 64 + fq * 16) = w_; } while (0)
        for (int c0 = 0; c0 < nmine; c0 += CH12) {
            TIDS
            const int nch = (nmine - c0) < CH12 ? (nmine - c0) : CH12;
            __syncthreads();
            if (tid < nch) {
                const int k = c0 + tid; const bool hreg = k >= nF;
                const int g = hreg ? H0 + jh + (k - nF) * XW : TF2 - 1 - (X0 + jl + k * XW);
                const LAS int* pf = hreg ? thL : tbL;
                int e = 0; { int hi = 256; while (e < hi) { const int mid = (e + hi + 1) >> 1; if (4 * pf[mid] <= g) e = mid; else hi = mid - 1; } }
                const int r = g - 4 * pf[e];
                itemD[tid * 4 + 0] = e; itemD[tid * 4 + 1] = r & 3; itemD[tid * 4 + 2] = hreg ? tbL[e + 1] - tbL[e] : r >> 2;
            }
            __syncthreads();
            int R0, C0; g8_rc(tid, R0, C0);
            auto nextf = [&](int i, GDesc& d) {
                if (i >= nch) return false;
                const int e = itemD[i * 4], pn = itemD[i * 4 + 1], ti = itemD[i * 4 + 2];
                const int vo = (e & ~3) | pn; const int bo = (G == 256) ? ((vo & 31) * 8 + (vo >> 5)) : vo;
                d.Ab = (const char*)W_hdn;
                d.Bb = (e < 256) ? (const char*)(ws + OFF_SCR + (size_t)bo * SCR_PER_BLK) + (size_t)2 * 512 * 1024 + (size_t)(e & 3) * 128 * 1024 : (const char*)(W_Ws2T + (size_t)pn * 256 * EFF);
                const int left = cntL[e] - ti * 256, nv = left < 256 ? left : 256, s0 = startL[e], rb = s0 + ti * 256;
                d.va0 = ((unsigned)(R0 < nv ? rb + R0 : s0) * EFF + C0) * 2u; d.va1 = ((unsigned)(R0 + 64 < nv ? rb + R0 + 64 : s0) * EFF + C0) * 2u;
                d.va2 = ((unsigned)(R0 + 128 < nv ? rb + R0 + 128 : s0) * EFF + C0) * 2u; d.va3 = ((unsigned)(R0 + 192 < nv ? rb + R0 + 192 : s0) * EFF + C0) * 2u;
                d.i0 = rb; d.i1 = nv | (i << 16); d.i2 = pn | ((nv <= 128) << 8); return true;
            };
            auto epi = [&](const f32x4 (&acc)[2][2][4][2], const GDesc& d, int wr, int wc, int fr, int fq) {
                const int rowbase = d.i0, nvalid = d.i1 & 0xffff, pn = d.i2 & 255;
#pragma unroll
                for (int ai = 0; ai < 2; ++ai)
#pragma unroll
                    for (int m = 0; m < 4; ++m) {
                        const int r = ai * 128 + wr * 64 + m * 16 + fr;
                        if (r < nvalid) Y_STORE(rowbase + r, pn * 256);
                    }
            };
            gemm_stream(ldsL, tid, EFF, nextf, epi);
        }
#undef Y_STORE
    }
    SEAM(12);

    if (IN(13)) {
        TIDS
        const float* fg = P.in[I_FG];
        const int colA = (lane >> 4) * 256 + (lane & 15) * 8;
        u32x4 yn[9]; u32x4 xn0, xn1;
#define P13_LOAD(ROW) do { const int row_ = (ROW); _Pragma("unroll") for (int k = 0; k < 9; ++k) { const int pr = (k < 8) ? W_pos[row_ * 8 + k] : (NASG + row_); \
            yn[k] = __builtin_nontemporal_load((const u32x4*)(W_y8 + (size_t)pr * DM + lane * 16)); } \
            const bf16_t* x1r = W_xt + (size_t)row_ * DM + colA; xn0 = __builtin_nontemporal_load((const u32x4*)x1r); xn1 = __builtin_nontemporal_load((const u32x4*)(x1r + 128)); } while (0)
        P13_LOAD(blk * 8 + wave);
        for (int row = blk * 8 + wave; row < NTOK; row += G * 8) {
            const int b = row >> 12;
            float a[16];
#pragma unroll
            for (int j = 0; j < 16; ++j) a[j] = 0.f;
            u32x4 yc[9];
#pragma unroll
            for (int k = 0; k < 9; ++k) yc[k] = yn[k];
            const u32x4 xw0 = xn0, xw1 = xn1;
            if (row + G * 8 < NTOK) P13_LOAD(row + G * 8);
#pragma unroll
            for (int k = 0; k < 9; ++k) {
                const u32x4 w = yc[k];
#pragma unroll
                for (int q = 0; q < 4; ++q) {
                    a[4 * q + 0] += __builtin_amdgcn_cvt_f32_fp8((int)w[q], 0); a[4 * q + 1] += __builtin_amdgcn_cvt_f32_fp8((int)w[q], 1);
                    a[4 * q + 2] += __builtin_amdgcn_cvt_f32_fp8((int)w[q], 2); a[4 * q + 3] += __builtin_amdgcn_cvt_f32_fp8((int)w[q], 3);
                }
            }
            float* xr = P.out + (size_t)row * DM + colA;
            const float* g2 = W_mod + b * 6144 + 5120 + colA;
            float v[16]; float ss = 0.f;
#pragma unroll
            for (int q = 0; q < 4; ++q) {
                const unsigned wa = (q < 2) ? xw0[2 * q] : xw1[2 * (q - 2)], wb = (q < 2) ? xw0[2 * q + 1] : xw1[2 * (q - 2) + 1];
                const f32x4 xa = {__uint_as_float(wa << 16), __uint_as_float(wa & 0xffff0000u), __uint_as_float(wb << 16), __uint_as_float(wb & 0xffff0000u)};
                const f32x4 ga = *(const f32x4*)(g2 + (q & 1) * 4 + (q >> 1) * 128);
#pragma unroll
                for (int j = 0; j < 4; ++j) { v[q * 4 + j] = xa[j] + ga[j] * a[q * 4 + j]; ss += v[q * 4 + j] * v[q * 4 + j]; }
            }
            ss = wave_sum(ss);
            const float rinv = rsqrtf(ss * (1.0f / 1024.0f) + EPS);
#pragma unroll
            for (int q = 0; q < 4; ++q) {
                const f32x4 fa = *(const f32x4*)(fg + colA + (q & 1) * 4 + (q >> 1) * 128);
                f32x4 oa;
#pragma unroll
                for (int j = 0; j < 4; ++j) oa[j] = v[q * 4 + j] * rinv * fa[j];
                *(f32x4*)(xr + (q & 1) * 4 + (q >> 1) * 128) = oa;
            }
        }
    }
#ifdef DBG_STOP
    if (IN(14)) {
        TIDS
        const size_t NO = (size_t)NTOK * DM;
        for (size_t i = (size_t)blk * 512 + tid; i < NO; i += (size_t)G * 512) {
            unsigned hsh = 0u;
            const size_t row = i >> 10, c = i & 1023;
#define RB(p, idx) ((unsigned)(p)[(idx)])
#define RF(p, idx) (__float_as_uint((p)[(idx)]))
#if DBG_STOP == 0
            hsh = RB(W_WinT, i % (2304 * 1024)) ^ RB(W_WoT, i % (1024 * 1024)) ^ RB(W_WuqT, i % (768 * 384)) ^ RB(W_WukvT, i % (1024 * 256)) ^ RB(W_Ws13T, i % (512 * 1024)) ^ RB(W_Ws2T, i % (1024 * 256)) ^ RB(W_WrT, i % (256 * 1024))
                ^ RF(W_mod, i % (8 * 6144)) ^ RF(W_ropecs, i % (4096 * 32)) ^ RF(W_biasT, i % (3 * 8 * 129));
#elif DBG_STOP == 1 || DBG_STOP == 7
            hsh = RB(W_hbuf, i);
#elif DBG_STOP == 2
            hsh = RB(W_proj, row * INCP + c) ^ (RB(W_proj, row * INCP + 1024 + c) << 1) ^ (c < 160 ? (RB(W_proj, row * INCP + 2048 + c) << 2) : 0u);
#elif DBG_STOP == 3
            hsh = RB(W_kvb, i) ^ (c < 768 ? (RB(W_qb, row * 768 + c) << 1) : 0u);
#elif DBG_STOP == 4
            if (c < 512) hsh = RB(W_bout, row * 512 + c); else if (DBG_SUB) { const size_t cc = c - 512; hsh = RB(W_aparts, row * 512 + cc) ^ (RB(W_aparts, ((size_t)NTOK + row) * 512 + cc) << 1) ^ (RB(W_aparts, ((size_t)2 * NTOK + row) * 512 + cc) << 2) ^ RF(W_lsebuf, row * 8 + (cc >> 6)) ^ (RF(W_lsebuf, ((size_t)NTOK + row) * 8 + (cc >> 6)) << 1) ^ (RF(W_lsebuf, ((size_t)2 * NTOK + row) * 8 + (cc >> 6)) << 2); }
#elif DBG_STOP == 5
            hsh = RB(W_mixb, i);
#elif DBG_STOP == 6
            hsh = RF(P.out, i);
#elif DBG_STOP == 8
            if (c < 256) hsh = RF(W_logits, row * 256 + c); else if (c < 512) hsh = RB(W_hdn, ((size_t)NASG + row) * EFF + (c - 256));
#elif DBG_STOP == 9
            if (c < 8) hsh = (unsigned)W_eidx[row * 8 + c]; else if (c < 16) hsh = RF(W_gate, row * 8 + (c - 8));
#elif DBG_STOP == 11
            { const int k = (int)(c >> 8); hsh = RB(W_hdn, (size_t)W_pos[row * 8 + k] * EFF + (c & 255)) ^ (RB(W_hdn, (size_t)W_pos[row * 8 + 4 + k] * EFF + (c & 255)) << 1); }
#elif DBG_STOP == 12
            { for (int k = 0; k < 8; ++k) hsh ^= RB(W_ybuf, (size_t)W_pos[row * 8 + k] * DM + c) << (k & 3); hsh ^= RB(W_ybuf, ((size_t)NASG + row) * DM + c); }
#endif
            P.out[i] = (float)(hsh & 0xFu);
        }
    }
#endif
#undef IN
#undef SEAM
}

extern "C" void kernel_launch(void* const* d_in, const int* in_sizes, int n_in, void* d_out, int out_size, void* d_ws, size_t ws_size, hipStream_t stream) {
    static int grid = 0;
    if (grid == 0) {
        if (n_in != 24 || ws_size < WS_END) { fprintf(stderr, "kernel_launch: need 24 inputs and %zu bytes of workspace (got %d, %zu)\n", (size_t)WS_END, n_in, ws_size); grid = -1; return; }
        int dev = 0, cus = 0, per_cu = 0;
        if (hipGetDevice(&dev) != hipSuccess || hipDeviceGetAttribute(&cus, hipDeviceAttributeMultiprocessorCount, dev) != hipSuccess) { grid = -1; return; }
        if (hipFuncSetAttribute((const void*)fwd_kernel, hipFuncAttributeMaxDynamicSharedMemorySize, LDS_BYTES) != hipSuccess) { fprintf(stderr, "kernel_launch: hipFuncSetAttribute failed\n"); grid = -1; return; }
        if (hipOccupancyMaxActiveBlocksPerMultiprocessor(&per_cu, (const void*)fwd_kernel, 512, LDS_BYTES) != hipSuccess || per_cu < 1) { fprintf(stderr, "kernel_launch: occupancy query says %d\n", per_cu); }
        (void)hipGetLastError();
        if (cus < 256) { fprintf(stderr, "kernel_launch: this kernel needs 256 CUs (device reports %d)\n", cus); grid = -1; return; }
        grid = 256;
    }
    if (grid < 0) return;
    (void)hipMemsetAsync((char*)d_ws + OFF_CTL, 0, CTL_BYTES, stream);
    Params p{};
    for (int i = 0; i < 24; ++i) p.in[i] = (const float*)d_in[i];
    p.out = (float*)d_out; p.ws = (unsigned char*)d_ws;
#if MK_N_LAUNCHES == 1
    p.ph_lo = 0; p.ph_hi = NPHASE;
    hipLaunchKernelGGL(fwd_kernel, dim3(grid), dim3(512), LDS_BYTES, stream, p);
#else
#ifdef DBG_STOP
    for (int k = 0; k <= DBG_STOP; ++k) { p.ph_lo = k; p.ph_hi = k + 1; hipLaunchKernelGGL(fwd_kernel, dim3(grid), dim3(512), LDS_BYTES, stream, p); }
    p.ph_lo = 14; p.ph_hi = 15; hipLaunchKernelGGL(fwd_kernel, dim3(grid), dim3(512), LDS_BYTES, stream, p);
#else
#ifndef DBL_MASK
#define DBL_MASK 0u
#endif
#ifndef DBL_FLAGS
#define DBL_FLAGS 0
#endif
    for (int k = 0; k < 14; ++k) { p.ph_lo = k; p.ph_hi = k + 1; hipLaunchKernelGGL(fwd_kernel, dim3(grid), dim3(512), LDS_BYTES, stream, p);
        if ((DBL_MASK >> k) & 1u) { p.flags = DBL_FLAGS; hipLaunchKernelGGL(fwd_kernel, dim3(grid), dim3(512), LDS_BYTES, stream, p); p.flags = 0; } }
#endif
#endif
}
```
